# Optimizing an MI355X kernel written in HIP

```python
import jax, jax.numpy as jnp
from jax import lax
import numpy as np


D_MODEL = 1024
BATCH = 4
SEQ = 4096
DEPTH = 1

EPS = 1e-6
D_RNN = D_MODEL
RNN_BLOCKS = 8
RNN_BW = D_RNN // RNN_BLOCKS
CONV_W = 4
LRU_C = 8.0
N_HEADS = 8
HEAD_DIM = 128
D_ATT = N_HEADS * HEAD_DIM
MOBA_BLOCK = 256
MOBA_TOPK = 3
Q_CHUNK = 16
ROPE_DIMS = HEAD_DIM // 4
ROPE_THETA = 500000.0
N_BRANCH = 2
D_BRANCH = D_MODEL
D_IN = 2 * D_RNN + 3 * D_ATT + N_BRANCH * D_MODEL
N_EXPERTS = 32
TOP_K = 4
D_FF = D_MODEL
SWIGLU_LIMIT = 7.0
SWIGLU_ALPHA = 1.702
EXPERT_ROWS = 256

kernel_name = 'hybrid_rglru_moba_moe_adaln'


def rms_norm(x, g):
    x32 = x.astype(jnp.float32)
    y = x32 * lax.rsqrt(jnp.mean(x32 * x32, axis=-1, keepdims=True) + EPS)
    return (y * g.astype(jnp.float32)).astype(x.dtype)


def partial_rope(x, positions):
    half = ROPE_DIMS // 2
    freqs = ROPE_THETA ** (-jnp.arange(half, dtype=jnp.float32) / half)
    ang = positions.astype(jnp.float32)[:, :, None] * freqs
    cos = jnp.cos(ang)[:, :, None, :]
    sin = jnp.sin(ang)[:, :, None, :]
    x1 = x[..., :half].astype(jnp.float32)
    x2 = x[..., half:ROPE_DIMS].astype(jnp.float32)
    rot = jnp.concatenate([x1 * cos - x2 * sin, x2 * cos + x1 * sin], axis=-1).astype(x.dtype)
    return jnp.concatenate([rot, x[..., ROPE_DIMS:]], axis=-1)


def _lin_combine(left, right):
    a_l, b_l = left
    a_r, b_r = right
    return a_l * a_r, a_r * b_l + b_r


def recurrent_branch(xr, gr, conv_w, conv_b, w_rg_a, b_rg_a, w_rg_x, b_rg_x, lru_lambda):
    B, S, _ = xr.shape
    xp = jnp.pad(xr, ((0, 0), (CONV_W - 1, 0), (0, 0)))
    xc = conv_b + conv_w[0] * xp[:, CONV_W - 1:CONV_W - 1 + S]
    for i in range(1, CONV_W):
        xc = xc + conv_w[i] * xp[:, CONV_W - 1 - i:CONV_W - 1 - i + S]
    xb = xc.reshape(B, S, RNN_BLOCKS, RNN_BW)
    r = jax.nn.sigmoid(jnp.einsum('bsnw,nwv->bsnv', xb, w_rg_a).reshape(B, S, D_RNN) + b_rg_a)
    ig = jax.nn.sigmoid(jnp.einsum('bsnw,nwv->bsnv', xb, w_rg_x).reshape(B, S, D_RNN) + b_rg_x)
    log_a = -LRU_C * r.astype(jnp.float32) * jax.nn.softplus(-lru_lambda.astype(jnp.float32))
    a = jnp.exp(log_a)
    mult = jnp.sqrt(-jnp.expm1(2.0 * log_a))
    mult = mult.at[:, 0].set(1.0)
    u = mult * (ig * xc).astype(jnp.float32)
    _, h = lax.associative_scan(_lin_combine, (a, u), axis=1)
    return h.astype(xr.dtype) * jax.nn.gelu(gr)


def moba_attention(q, k, v):
    B, H, S, dh = q.shape
    nb = -(-S // MOBA_BLOCK)
    pad = nb * MOBA_BLOCK - S
    kp = jnp.pad(k, ((0, 0), (0, 0), (0, pad), (0, 0))).reshape(B, H, nb, MOBA_BLOCK, dh)
    vp = jnp.pad(v, ((0, 0), (0, 0), (0, pad), (0, 0))).reshape(B, H, nb, MOBA_BLOCK, dh)
    k_mean = jnp.mean(kp.astype(jnp.float32), axis=3)
    q_blk = jnp.arange(S) // MOBA_BLOCK
    gate = jnp.einsum('bhsd,bhnd->bhsn', q.astype(jnp.float32), k_mean)
    past = jnp.arange(nb)[None, :] < q_blk[:, None]
    gate = jnp.where(past, gate, -jnp.inf)
    topk = min(MOBA_TOPK, nb)
    _, sel = lax.top_k(gate, topk)
    sel_ok = jnp.arange(topk)[None, :] < jnp.minimum(q_blk, MOBA_TOPK)[:, None]
    nc = S // Q_CHUNK

    def to_chunks(t):
        t = t.reshape(t.shape[:2] + (nc, Q_CHUNK) + t.shape[3:])
        return jnp.moveaxis(t, 2, 0)

    b_ix = jnp.arange(B)[:, None, None, None]
    h_ix = jnp.arange(H)[None, :, None, None]
    scale = dh ** -0.5

    def chunk_attn(args):
        ci, qc, sc, okc = args
        start = ci * Q_CHUNK
        blk = start // MOBA_BLOCK
        k_own = lax.dynamic_index_in_dim(kp, blk, axis=2, keepdims=False)
        v_own = lax.dynamic_index_in_dim(vp, blk, axis=2, keepdims=False)
        k_sel = kp[b_ix, h_ix, sc]
        v_sel = vp[b_ix, h_ix, sc]
        q_pos = start + jnp.arange(Q_CHUNK)
        k_pos = blk * MOBA_BLOCK + jnp.arange(MOBA_BLOCK)
        s_own = jnp.einsum('bhqd,bhkd->bhqk', qc, k_own).astype(jnp.float32) * scale
        s_own = jnp.where(k_pos[None, :] <= q_pos[:, None], s_own, -jnp.inf)
        s_sel = jnp.einsum('bhqd,bhqjkd->bhqjk', qc, k_sel).astype(jnp.float32) * scale
        s_sel = jnp.where(okc[:, :, None], s_sel, -jnp.inf).reshape(B, H, Q_CHUNK, topk * MOBA_BLOCK)
        p = jax.nn.softmax(jnp.concatenate([s_own, s_sel], axis=-1), axis=-1).astype(v.dtype)
        p_own = p[..., :MOBA_BLOCK]
        p_sel = p[..., MOBA_BLOCK:].reshape(B, H, Q_CHUNK, topk, MOBA_BLOCK)
        return (jnp.einsum('bhqk,bhkd->bhqd', p_own, v_own)
                + jnp.einsum('bhqjk,bhqjkd->bhqd', p_sel, v_sel))

    out = lax.map(chunk_attn, (jnp.arange(nc), to_chunks(q), to_chunks(sel),
                               sel_ok.reshape(nc, Q_CHUNK, topk)))
    out = jnp.moveaxis(out, 0, 2).reshape(B, H, S, dh)
    return out.transpose(0, 2, 1, 3).reshape(B, S, H * dh)


def moe_ffn(h, w_router, b_router, w_up, b_up, w_down, b_down):
    B, S, D = h.shape
    N = B * S
    xt = h.reshape(N, D)
    logits = (xt @ w_router + b_router).astype(jnp.float32)
    top_val, top_idx = lax.top_k(logits, TOP_K)
    gates = jax.nn.softmax(top_val, axis=-1)
    A = N * TOP_K
    e_flat = top_idx.reshape(A)
    tok_flat = jnp.arange(A, dtype=jnp.int32) // TOP_K
    g_flat = gates.reshape(A)
    order = jnp.argsort(e_flat)
    e_sorted = e_flat[order]
    counts = jnp.zeros((N_EXPERTS,), jnp.int32).at[e_flat].add(1)
    padded = (counts + EXPERT_ROWS - 1) // EXPERT_ROWS * EXPERT_ROWS
    start = jnp.cumsum(counts) - counts
    pad_end = jnp.cumsum(padded)
    pad_start = pad_end - padded
    dest = pad_start[e_sorted] + jnp.arange(A, dtype=jnp.int32) - start[e_sorted]
    n_blocks = -(-A // EXPERT_ROWS) + N_EXPERTS
    R = n_blocks * EXPERT_ROWS
    row_tok = jnp.full((R,), N, jnp.int32).at[dest].set(tok_flat[order])
    row_gate = jnp.zeros((R,), jnp.float32).at[dest].set(g_flat[order])
    block_start = jnp.arange(n_blocks, dtype=jnp.int32) * EXPERT_ROWS
    block_exp = jnp.minimum(jnp.sum(block_start[:, None] >= pad_end[None, :], axis=1), N_EXPERTS - 1)
    x_pad = jnp.concatenate([xt, jnp.zeros((1, D), xt.dtype)], axis=0)
    x_rows = x_pad[row_tok].reshape(n_blocks, EXPERT_ROWS, D)

    def expert_block(args):
        xb, e = args
        hc = xb @ w_up[e] + b_up[e]
        g = jnp.minimum(hc[:, :D_FF], SWIGLU_LIMIT)
        lin = jnp.clip(hc[:, D_FF:], -SWIGLU_LIMIT, SWIGLU_LIMIT)
        act = (lin + 1.0) * g * jax.nn.sigmoid(SWIGLU_ALPHA * g)
        return act @ w_down[e] + b_down[e]

    y_rows = lax.map(expert_block, (x_rows, block_exp)).reshape(R, D)
    y_rows = y_rows * row_gate[:, None].astype(y_rows.dtype)
    y = jax.ops.segment_sum(y_rows, row_tok, num_segments=N + 1)[:N]
    return y.reshape(B, S, D)


def setup_inputs(seed: int = 0) -> dict:
    key = jax.random.key(seed)
    ks = jax.random.split(key, 32)
    f32 = jnp.float32
    L = DEPTH

    def nrm(k, shape, scale):
        return jax.random.normal(k, shape, f32) * scale

    u = jax.random.uniform(ks[13], (L, D_RNN), f32, 0.9, 0.999)
    a0 = u ** (1.0 / LRU_C)
    return {
        'x': nrm(ks[0], (BATCH, SEQ, D_MODEL), 1.0),
        'c': nrm(ks[1], (BATCH, D_MODEL), 1.0),
        'positions': jnp.tile(jnp.arange(SEQ, dtype=jnp.int32)[None, :], (BATCH, 1)),
        'ada_w': nrm(ks[2], (L, D_MODEL, 6 * D_MODEL), 0.5 * D_MODEL ** -0.5),
        'ada_b': nrm(ks[3], (L, 6 * D_MODEL), 0.01),
        'norm1_g': 1.0 + nrm(ks[4], (L, D_MODEL), 0.02),
        'norm2_g': 1.0 + nrm(ks[5], (L, D_MODEL), 0.02),
        'w_in': nrm(ks[6], (L, D_MODEL, D_IN), D_MODEL ** -0.5),
        'conv_w': nrm(ks[7], (L, CONV_W, D_RNN), CONV_W ** -0.5),
        'conv_b': nrm(ks[8], (L, D_RNN), 0.01),
        'w_rg_a': nrm(ks[9], (L, RNN_BLOCKS, RNN_BW, RNN_BW), RNN_BW ** -0.5),
        'b_rg_a': nrm(ks[10], (L, D_RNN), 0.01),
        'w_rg_x': nrm(ks[11], (L, RNN_BLOCKS, RNN_BW, RNN_BW), RNN_BW ** -0.5),
        'b_rg_x': nrm(ks[12], (L, D_RNN), 0.01),
        'lru_lambda': jnp.log(a0) - jnp.log1p(-a0),
        'q_norm_g': 1.0 + nrm(ks[14], (L, HEAD_DIM), 0.02),
        'k_norm_g': 1.0 + nrm(ks[15], (L, HEAD_DIM), 0.02),
        'b_gate': nrm(ks[16], (L, N_BRANCH, D_MODEL), 0.01),
        'w_branch': nrm(ks[17], (L, N_BRANCH, D_BRANCH, D_MODEL), D_BRANCH ** -0.5),
        'w_out': nrm(ks[18], (L, D_MODEL, D_MODEL), D_MODEL ** -0.5),
        'w_router': nrm(ks[19], (L, D_MODEL, N_EXPERTS), D_MODEL ** -0.5),
        'b_router': nrm(ks[20], (L, N_EXPERTS), 0.01),
        'w_up': nrm(ks[21], (L, N_EXPERTS, D_MODEL, 2 * D_FF), D_MODEL ** -0.5),
        'b_up': nrm(ks[22], (L, N_EXPERTS, 2 * D_FF), 0.01),
        'w_down': nrm(ks[23], (L, N_EXPERTS, D_FF, D_MODEL), D_FF ** -0.5),
        'b_down': nrm(ks[24], (L, N_EXPERTS, D_MODEL), 0.01),
    }


def reference(x, c, positions, ada_w, ada_b, norm1_g, norm2_g, w_in, conv_w, conv_b,
              w_rg_a, b_rg_a, w_rg_x, b_rg_x, lru_lambda, q_norm_g, k_norm_g, b_gate,
              w_branch, w_out, w_router, b_router, w_up, b_up, w_down, b_down):
    B, S, D = x.shape
    split_at = [D_RNN, 2 * D_RNN, 2 * D_RNN + D_ATT, 2 * D_RNN + 2 * D_ATT, 2 * D_RNN + 3 * D_ATT]
    for l in range(DEPTH):
        mod = jax.nn.silu(c) @ ada_w[l] + ada_b[l]
        sh1, sc1, g1, sh2, sc2, g2 = jnp.split(mod[:, None, :], 6, axis=-1)
        h = rms_norm(x, norm1_g[l]) * (1.0 + sc1) + sh1
        proj = h @ w_in[l]
        xr, gr, q, k, v, gl = jnp.split(proj, split_at, axis=-1)
        y_rnn = recurrent_branch(xr, gr, conv_w[l], conv_b[l], w_rg_a[l], b_rg_a[l],
                                 w_rg_x[l], b_rg_x[l], lru_lambda[l])
        q = partial_rope(rms_norm(q.reshape(B, S, N_HEADS, HEAD_DIM), q_norm_g[l]), positions)
        k = partial_rope(rms_norm(k.reshape(B, S, N_HEADS, HEAD_DIM), k_norm_g[l]), positions)
        v = v.reshape(B, S, N_HEADS, HEAD_DIM)
        y_att = moba_attention(q.transpose(0, 2, 1, 3), k.transpose(0, 2, 1, 3),
                               v.transpose(0, 2, 1, 3))
        branches = jnp.stack([y_rnn, y_att], axis=2)
        z = jnp.einsum('bsgi,gid->bsgd', branches, w_branch[l])
        gates = jax.nn.sigmoid(gl.reshape(B, S, N_BRANCH, D_MODEL) + b_gate[l])
        mixed = jnp.sum(gates * z, axis=2) @ w_out[l]
        x = x + g1 * mixed
        h2 = rms_norm(x, norm2_g[l]) * (1.0 + sc2) + sh2
        x = x + g2 * moe_ffn(h2, w_router[l], b_router[l], w_up[l], b_up[l], w_down[l], b_down[l])
    return x
```

```cpp
#include <hip/hip_runtime.h>
#include <hip/hip_bf16.h>
#include <cstdio>
#include <cstdint>
#include <cmath>
namespace pg8 {
#define PG8_LAS __attribute__((address_space(3)))
typedef unsigned short bf16_t;
typedef short bf16x8 __attribute__((ext_vector_type(8)));
typedef float f32x4 __attribute__((ext_vector_type(4)));
typedef unsigned u32x4 __attribute__((ext_vector_type(4)));
constexpr int BM = 256, BK = 64, HALF = 128, HTB = HALF * BK * 2  , STAGE_BYTES = 8 * HTB, NXCD = 8, WGM = 8;

__host__ __device__ __forceinline__ int lds_byte(int r, int c) { const int st = (r >> 4) * 2 + (c >> 5), rr = r & 15, cc = c & 31, ob = rr * 64 + cc * 2; return st * 1024 + (ob ^ (((ob >> 9) & 1) << 5)); }
__host__ __device__ __forceinline__ void stage_rc(int b, int& R, int& C) { const int st = b / 1024, sb = b % 1024, swz = sb ^ (((sb >> 9) & 1) << 5); R = (st >> 1) * 16 + swz / 64; C = (st & 1) * 32 + (swz % 64) / 2; }
__host__ __device__ __forceinline__ int perm32(int rho) { const int n = rho >> 4, i = rho & 15; return 8 * (i >> 2) + 4 * n + (i & 3); }

struct Unit { int pm, pn; };
struct Gemm { const bf16_t* A; const bf16_t* Bt; int M, N, K; };

struct StaticOrder {
    int nM, nN, nwg, G, c;
    __host__ __device__ void init(int M, int N, int G_, int c_) { nM = M / BM; nN = N / BM; nwg = nM * nN; G = G_; c = c_; }
    __host__ __device__ bool next(int i, Unit& u) const {
        const long L = (long)i * G + c; if (L >= nwg) return false;
        int wgid = (int)L; { const int q = nwg / NXCD, r = nwg % NXCD, xcd = wgid % NXCD, off = wgid / NXCD; wgid = (xcd < r ? xcd * (q + 1) : r * (q + 1) + (xcd - r) * q) + off; }
        const int nig = WGM * nN, gid = wgid / nig, fm = gid * WGM, gsz = (nM - fm) < WGM ? (nM - fm) : WGM;
        u.pm = fm + ((wgid % nig) % gsz); u.pn = (wgid % nig) / gsz; return true;
    }
    __device__ __forceinline__ void a_ready(const Unit&) const {}
    __device__ __forceinline__ void done(const Unit&) const {}
};

__device__ __forceinline__ unsigned cvt_pk_bf16(float lo, float hi) { unsigned r; asm volatile("v_cvt_pk_bf16_f32 %0, %1, %2" : "=v"(r) : "v"(lo), "v"(hi)); return r; }
template <class Epi, class Sched, bool ALIGN_EPI = false, bool SP2 = false>
__device__ __forceinline__ void gemm_phase(PG8_LAS unsigned char* lds, const Gemm g, const Sched& S, const Epi& E) {
    const int tid = threadIdx.x, wid = __builtin_amdgcn_readfirstlane(tid >> 6), lane = tid & 63, wr = wid >> 2, wc = wid & 3, fr = lane & 15, fq = lane >> 4;
    const int K = g.K, nt = K / BK;
    unsigned voffA[2], voffB[2];
#pragma unroll
    for (int i = 0; i < 2; ++i) { int R, C; stage_rc(tid * 16 + i * 8192, R, C); const int Rb = Epi::PERM ? ((R & ~31) + perm32(R & 31)) : R;
        voffA[i] = (unsigned)(R * K + C) * 2u; voffB[i] = (unsigned)(Rb * K + C) * 2u; }
    const size_t kstep = (size_t)(BK * 2);
    const size_t hstep = (size_t)HALF * K * 2;
    const size_t tstep = 2 * hstep;
    const unsigned ldsw = (unsigned)wid * 1024u;
    const int aoff = lds_byte(wr * 64 + fr, fq * 8), boff = lds_byte(wc * 32 + fr, fq * 8);
#define PG8_SA(b, h) (((b) * 2 + (h)) * HTB)
#define PG8_SB(b, h) ((4 + (b) * 2 + (h)) * HTB)
#define PG8_STAGE(bufoff, gbase, voff) do { _Pragma("unroll") for (int _i = 0; _i < 2; ++_i) \
        __builtin_amdgcn_global_load_lds((const unsigned*)((const char*)(gbase) + (voff)[_i]), (PG8_LAS unsigned*)(lds + (bufoff) + ldsw + _i * 8192), 16, 0, 0); } while (0)
#define PG8_LDA(dst, b, h) do { _Pragma("unroll") for (int m = 0; m < 4; ++m) _Pragma("unroll") for (int k = 0; k < 2; ++k) dst[m][k] = *(const PG8_LAS bf16x8*)(lds + PG8_SA(b, h) + aoff + m * 2048 + k * 1024); } while (0)
#define PG8_LDB(dst, b, h) do { _Pragma("unroll") for (int n = 0; n < 2; ++n) _Pragma("unroll") for (int k = 0; k < 2; ++k) dst[n][k] = *(const PG8_LAS bf16x8*)(lds + PG8_SB(b, h) + boff + n * 2048 + k * 1024); } while (0)
#define PG8_MMA(ai, bj, At, Bt) do { __builtin_amdgcn_s_setprio(1); _Pragma("unroll") for (int m = 0; m < 4; ++m) _Pragma("unroll") for (int n = 0; n < 2; ++n) _Pragma("unroll") for (int k = 0; k < 2; ++k) \
        acc[ai][bj][m][n] = __builtin_amdgcn_mfma_f32_16x16x32_bf16(Bt[n][k], At[m][k], acc[ai][bj][m][n], 0, 0, 0); __builtin_amdgcn_s_setprio(0); } while (0)
#define PG8_WAIT_V(n) asm volatile("s_waitcnt vmcnt(" #n ")" ::: "memory")
#define PG8_WAIT_L(n) asm volatile("s_waitcnt lgkmcnt(" #n ")" ::: "memory")
#define PG8_BAR __builtin_amdgcn_s_barrier()
#define PG8_SCHED __builtin_amdgcn_sched_barrier(0)
    Unit cur, nxt; int ui = 0;
    if (!S.next(0, cur)) return;
    f32x4 acc[2][2][4][2];
#pragma unroll
    for (int a = 0; a < 2; ++a)
#pragma unroll
        for (int b = 0; b < 2; ++b)
#pragma unroll
            for (int m = 0; m < 4; ++m)
#pragma unroll
                for (int n = 0; n < 2; ++n) acc[a][b][m][n] = (f32x4){0.f, 0.f, 0.f, 0.f};
    bf16x8 At[4][2], B0[2][2], B1[2][2];
    const char* cA = (const char*)g.A + (size_t)cur.pm * tstep; const char* cB = (const char*)g.Bt + (size_t)cur.pn * tstep;
    S.a_ready(cur);
    if constexpr (SP2) {
        PG8_STAGE(PG8_SB(0, 0), cB, voffB); PG8_STAGE(PG8_SB(0, 1), cB + hstep, voffB); PG8_STAGE(PG8_SA(0, 0), cA, voffA); PG8_STAGE(PG8_SA(0, 1), cA + hstep, voffA);
        if (wr == 1) PG8_BAR;
        PG8_WAIT_V(2); PG8_BAR;
        PG8_STAGE(PG8_SB(1, 0), cB + kstep, voffB); PG8_STAGE(PG8_SA(1, 0), cA + kstep, voffA); PG8_STAGE(PG8_SB(1, 1), cB + hstep + kstep, voffB);
        PG8_WAIT_V(6); PG8_BAR;
    } else {
        PG8_STAGE(PG8_SB(0, 0), cB, voffB); PG8_STAGE(PG8_SA(0, 0), cA, voffA); PG8_STAGE(PG8_SB(0, 1), cB + hstep, voffB); PG8_STAGE(PG8_SA(0, 1), cA + hstep, voffA);
        if (wr == 1) PG8_BAR;
        PG8_WAIT_V(4); PG8_BAR;
        PG8_STAGE(PG8_SB(1, 0), cB + kstep, voffB); PG8_STAGE(PG8_SA(1, 0), cA + kstep, voffA); PG8_STAGE(PG8_SB(1, 1), cB + hstep + kstep, voffB);
        PG8_WAIT_V(6); PG8_BAR;
    }
    for (;;) {
        const bool has_next = S.next(ui + 1, nxt);
        const char* nA = has_next ? (const char*)g.A + (size_t)nxt.pm * tstep : cA; const char* nB = has_next ? (const char*)g.Bt + (size_t)nxt.pn * tstep : cB;
        for (int t = 0; t < nt; t += 2) {
            const bool last = (t == nt - 2);
            const char* a1 = cA + (size_t)(t + 1) * kstep;
            const char* a2 = last ? nA : cA + (size_t)(t + 2) * kstep; const char* b2 = last ? nB : cB + (size_t)(t + 2) * kstep;
            const char* a3 = a2 + kstep; const char* b3 = b2 + kstep;
            if (last && has_next) S.a_ready(nxt);
            if constexpr (SP2) {
            PG8_LDB(B0, 0, 0); PG8_LDB(B1, 0, 1); PG8_SCHED; PG8_LDA(At, 0, 0); PG8_STAGE(PG8_SA(1, 1), a1 + hstep, voffA);
            PG8_WAIT_V(8); PG8_WAIT_L(0); PG8_BAR; PG8_MMA(0, 0, At, B0); PG8_MMA(0, 1, At, B1); PG8_BAR; PG8_SCHED;
            PG8_LDA(At, 0, 1); PG8_STAGE(PG8_SB(0, 0), b2, voffB); PG8_STAGE(PG8_SB(0, 1), b2 + hstep, voffB); PG8_STAGE(PG8_SA(0, 0), a2, voffA);
            PG8_WAIT_V(8); PG8_WAIT_L(0); PG8_BAR; PG8_MMA(1, 0, At, B0); PG8_MMA(1, 1, At, B1); PG8_BAR; PG8_SCHED;
            PG8_LDB(B0, 1, 0); PG8_LDB(B1, 1, 1); PG8_SCHED; PG8_LDA(At, 1, 0); PG8_STAGE(PG8_SA(0, 1), a2 + hstep, voffA);
            PG8_WAIT_V(8); PG8_WAIT_L(0); PG8_BAR; PG8_MMA(0, 0, At, B0); PG8_MMA(0, 1, At, B1); PG8_BAR; PG8_SCHED;
            PG8_LDA(At, 1, 1); PG8_STAGE(PG8_SB(1, 0), b3, voffB); PG8_STAGE(PG8_SB(1, 1), b3 + hstep, voffB); PG8_STAGE(PG8_SA(1, 0), a3, voffA);
            PG8_WAIT_V(8); PG8_WAIT_L(0); PG8_BAR; PG8_MMA(1, 0, At, B0); PG8_MMA(1, 1, At, B1); PG8_BAR; PG8_SCHED;
            } else {
            PG8_LDB(B0, 0, 0); PG8_SCHED; PG8_LDA(At, 0, 0); PG8_STAGE(PG8_SA(1, 1), a1 + hstep, voffA);
            PG8_WAIT_L(8); PG8_BAR; PG8_WAIT_L(0); PG8_MMA(0, 0, At, B0); PG8_BAR; PG8_SCHED;
            PG8_LDB(B1, 0, 1); PG8_STAGE(PG8_SB(0, 0), b2, voffB);
            PG8_BAR; PG8_WAIT_L(0); PG8_MMA(0, 1, At, B1); PG8_BAR;
            PG8_LDA(At, 0, 1); PG8_STAGE(PG8_SA(0, 0), a2, voffA);
            PG8_BAR; PG8_WAIT_L(0); PG8_MMA(1, 0, At, B0); PG8_BAR; PG8_SCHED;
            PG8_STAGE(PG8_SB(0, 1), b2 + hstep, voffB);
            PG8_WAIT_V(6); PG8_BAR; PG8_MMA(1, 1, At, B1); PG8_BAR;
            PG8_LDB(B0, 1, 0); PG8_SCHED; PG8_LDA(At, 1, 0); PG8_STAGE(PG8_SA(0, 1), a2 + hstep, voffA);
            PG8_WAIT_L(8); PG8_BAR; PG8_WAIT_L(0); PG8_MMA(0, 0, At, B0); PG8_BAR; PG8_SCHED;
            PG8_LDB(B1, 1, 1); PG8_STAGE(PG8_SB(1, 0), b3, voffB);
            PG8_BAR; PG8_WAIT_L(0); PG8_MMA(0, 1, At, B1); PG8_BAR;
            PG8_LDA(At, 1, 1); PG8_STAGE(PG8_SA(1, 0), a3, voffA);
            PG8_BAR; PG8_WAIT_L(0); PG8_MMA(1, 0, At, B0); PG8_BAR; PG8_SCHED;
            PG8_STAGE(PG8_SB(1, 1), b3 + hstep, voffB);
            PG8_WAIT_V(6); PG8_BAR; PG8_MMA(1, 1, At, B1); PG8_BAR;
            }
        }
        if constexpr (ALIGN_EPI) { if (wr == 0) PG8_BAR; }
        if constexpr (!Epi::AFTER_DRAIN) { E(acc, cur, wr, wc, fr, fq); S.done(cur); }
        if (!has_next) break;
#pragma unroll
        for (int a = 0; a < 2; ++a)
#pragma unroll
            for (int b = 0; b < 2; ++b)
#pragma unroll
                for (int m = 0; m < 4; ++m)
#pragma unroll
                    for (int n = 0; n < 2; ++n) acc[a][b][m][n] = (f32x4){0.f, 0.f, 0.f, 0.f};
        cur = nxt; cA = nA; cB = nB; ++ui;
        if constexpr (ALIGN_EPI) { if (wr == 1) PG8_BAR; }
    }
    PG8_WAIT_V(0);
    if constexpr (!ALIGN_EPI) { if (wr == 0) PG8_BAR; }
    PG8_BAR;
    if constexpr (Epi::AFTER_DRAIN) { E.fused(acc, cur, wr, wc, fr, fq, lds, wid, lane); S.done(cur); }
#undef PG8_SA
#undef PG8_SB
#undef PG8_STAGE
#undef PG8_LDA
#undef PG8_LDB
#undef PG8_MMA
#undef PG8_WAIT_V
#undef PG8_WAIT_L
#undef PG8_BAR
#undef PG8_SCHED
}
}

constexpr int NB = 4, SEQ = 4096, DM = 1024, NTOK = NB * SEQ, DIN = 7168, NH = 8, HD = 128;
constexpr int NEXP = 32, TOPK = 4, MAXBLK = 288, RMAX = MAXBLK * 256;
constexpr float EPS = 1e-6f;
constexpr int NWAVES = 8;

constexpr size_t MiB = 1u << 20, KiB = 1u << 10;
constexpr size_t WS_CTL = 0, CTL_ZERO_BYTES = 1 * MiB;
constexpr size_t WS_MOD = 1 * MiB;
constexpr size_t WS_KMEAN = 1 * MiB + 128 * KiB;
constexpr size_t WS_AGGP = 1 * MiB + 384 * KiB;
constexpr size_t WS_AGGH = 1 * MiB + 640 * KiB;
constexpr size_t WS_WRT = 2 * MiB;
constexpr size_t WS_WGCNT = 2 * MiB + 128 * KiB;
constexpr size_t WS_BLKEXP = 2 * MiB + 192 * KiB;
constexpr size_t WS_ROWGATE = 2 * MiB + 256 * KiB;
constexpr size_t WS_TOKE = 3 * MiB, WS_TOKLR = 3 * MiB + 256 * KiB, WS_TOKG = 3 * MiB + 512 * KiB, WS_DEST = 3 * MiB + 768 * KiB;
constexpr size_t WS_TRIG = 4 * MiB;
constexpr size_t WS_WRG = 6 * MiB;
constexpr size_t WS_WIN = 8 * MiB;
constexpr size_t WS_WB = 22 * MiB;
constexpr size_t WS_WO = 26 * MiB;
constexpr size_t WS_WUP = 32 * MiB;
constexpr size_t WS_WDN = 160 * MiB;
constexpr size_t WS_HB = 224 * MiB;
constexpr size_t WS_E = 256 * MiB;
constexpr size_t E_STRIDE = (size_t)NTOK * DM;
constexpr size_t WS_HL = 480 * MiB, WS_PP = 512 * MiB, WS_YRNN = 544 * MiB, WS_YATT = 576 * MiB;
constexpr size_t WS_T0 = WS_E;
constexpr size_t WS_XG = 256 * MiB, WS_ACT = 400 * MiB, WS_YR = 544 * MiB;
constexpr size_t WS_END = 688 * MiB;
constexpr int CW_BAR = 4096;

constexpr int RING_OFF = 0, RING_BYTES = 131072;
constexpr int LDSCTL_OFF = RING_BYTES, MISC_OFF = LDSCTL_OFF + 320;
constexpr int XTRA_OFF = LDSCTL_OFF + 1024;
constexpr int LDS_BYTES = 147456;

#define GAS __attribute__((address_space(1)))
#define LAS __attribute__((address_space(3)))
typedef unsigned short bf16;
typedef unsigned v4u __attribute__((ext_vector_type(4)));
typedef unsigned v2u __attribute__((ext_vector_type(2)));
typedef float f32x4 __attribute__((ext_vector_type(4)));
typedef float f32x2 __attribute__((ext_vector_type(2)));
typedef float f32x16 __attribute__((ext_vector_type(16)));
typedef short bf16x8 __attribute__((ext_vector_type(8)));
typedef short s16x4 __attribute__((ext_vector_type(4)));
typedef GAS unsigned gu32;
#define RLX_AGENT __ATOMIC_RELAXED, __HIP_MEMORY_SCOPE_AGENT
#define LDS_WAIT() asm volatile("s_waitcnt lgkmcnt(0)" ::: "memory")
#define VM_WAIT() asm volatile("s_waitcnt vmcnt(0)" ::: "memory")
#define SBAR() __builtin_amdgcn_sched_barrier(0)
__device__ __forceinline__ unsigned f2bf(float f) { unsigned u = __builtin_bit_cast(unsigned, f); return (u + 0x7fffu + ((u >> 16) & 1u)) >> 16; }
__device__ __forceinline__ unsigned pk2(float lo, float hi) { return f2bf(lo) | (f2bf(hi) << 16); }
__device__ __forceinline__ float bf2f(unsigned short h) { return __builtin_bit_cast(float, (unsigned)h << 16); }
__device__ __forceinline__ float bflo(unsigned w) { return __builtin_bit_cast(float, w << 16); }
__device__ __forceinline__ float bfhi(unsigned w) { return __builtin_bit_cast(float, w & 0xffff0000u); }
__device__ __forceinline__ unsigned cvtpk(float lo, float hi) { unsigned r; asm volatile("v_cvt_pk_bf16_f32 %0, %1, %2" : "=v"(r) : "v"(lo), "v"(hi)); return r; }
__device__ __forceinline__ float fast_sigmoid(float x) { return __builtin_amdgcn_rcpf(1.0f + __builtin_amdgcn_exp2f(-1.4426950408889634f * x)); }
__device__ __forceinline__ float gelu_tanh(float x) { const float z = 1.5957691216057308f * (x + 0.044715f * x * x * x); return x * fast_sigmoid(z); }
__device__ __forceinline__ float wave_sum(float v) {
#pragma unroll
    for (int o = 1; o < 64; o <<= 1) v += __shfl_xor(v, o);
    return v;
}
__device__ __forceinline__ float wave_max(float v) {
#pragma unroll
    for (int o = 1; o < 64; o <<= 1) v = fmaxf(v, __shfl_xor(v, o));
    return v;
}

#define XB_TMO      128
#define XB_XCNT(j)  (256  + 64 * (j))
#define XB_XSUB(j)  (1280 + 64 * (j))
#define XB_XGEN(j)  (2304 + 64 * (j))
#define XB_TOP      3328
#define XB_TOPGEN   3392
#define XCD_BAR_WORDS 3456
#define XB_SPIN_CAP (1u << 20)
__device__ __forceinline__ unsigned xb_ld(unsigned* p)              { return __hip_atomic_load(p, __ATOMIC_RELAXED, __HIP_MEMORY_SCOPE_AGENT); }
__device__ __forceinline__ unsigned xb_add(unsigned* p, unsigned v) { return __hip_atomic_fetch_add(p, v, __ATOMIC_RELAXED, __HIP_MEMORY_SCOPE_AGENT); }
__device__ __forceinline__ unsigned xb_xcc_id() { return (unsigned)__builtin_amdgcn_s_getreg((3 << 11) | 20) & 0xFu; }
#define XB_SPIN(cond, bar) do { unsigned _sp = 0; while (cond) { __builtin_amdgcn_s_sleep(1); \
    if ((++_sp & 255u) == 0u) { if (xb_ld(&(bar)[XB_TMO])) break; if (_sp > XB_SPIN_CAP) { atomicAdd(&(bar)[XB_TMO], 1u); break; } } } } while (0)
struct XcdBarrier { unsigned* bar; unsigned x; volatile LAS unsigned* st; };
__device__ __forceinline__ XcdBarrier xcd_barrier_post(unsigned* bar, volatile LAS unsigned* st) {
    XcdBarrier b; b.bar = bar; b.x = xb_xcc_id(); b.st = st;
    if (threadIdx.x == 0) (void)xb_add(&bar[XB_XCNT(b.x)], 1u);
    return b;
}
__device__ __forceinline__ void xcd_barrier_complete(unsigned* bar, unsigned x, unsigned& nloc, unsigned& nx) {
    const unsigned G = gridDim.x * gridDim.y * gridDim.z;
    unsigned sum, cnt, mine, sp = 0u;
    for (;;) {
        sum = 0u; cnt = 0u; mine = 0u;
#pragma unroll
        for (unsigned j = 0; j < 16; ++j) { const unsigned c = xb_ld(&bar[XB_XCNT(j)]); sum += c; cnt += (c > 0u) ? 1u : 0u; mine = (j == x) ? c : mine; }
        if (sum == G) break;
        __builtin_amdgcn_s_sleep(1);
        if ((++sp & 255u) == 0u) { if (xb_ld(&bar[XB_TMO])) break; if (sp > XB_SPIN_CAP) { atomicAdd(&bar[XB_TMO], 1u); break; } }
    }
    nloc = mine > 0u ? mine : 1u; nx = cnt > 0u ? cnt : 1u;
}
__device__ __forceinline__ void xcd_barrier(const XcdBarrier& b) {
    asm volatile("s_waitcnt vmcnt(0)" ::: "memory");
    __syncthreads();
    if (threadIdx.x == 0) {
        unsigned* bar = b.bar;
        __builtin_amdgcn_s_waitcnt(0);
        unsigned nloc = b.st[0], nx = b.st[1];
        if (nloc == 0u) { xcd_barrier_complete(bar, b.x, nloc, nx); b.st[0] = nloc; b.st[1] = nx; }
        const unsigned old = xb_add(&bar[XB_XSUB(b.x)], 1u);
        const unsigned gen = old / nloc;
        if (old + 1u == (gen + 1u) * nloc) {
            __builtin_amdgcn_fence(__ATOMIC_RELEASE, "agent");
            asm volatile("s_waitcnt vmcnt(0)" ::: "memory");
            const unsigned og = xb_add(&bar[XB_TOP], 1u);
            const unsigned tg = og / nx;
            if (og + 1u == (tg + 1u) * nx) xb_add(&bar[XB_TOPGEN], 1u);
            else XB_SPIN(xb_ld(&bar[XB_TOPGEN]) == tg, bar);
            __builtin_amdgcn_fence(__ATOMIC_ACQUIRE, "agent");
            xb_add(&bar[XB_XGEN(b.x)], 1u);
            asm volatile("s_waitcnt vmcnt(0)" ::: "memory");
        } else {
            XB_SPIN(xb_ld(&bar[XB_XGEN(b.x)]) == gen, bar);
            __builtin_amdgcn_fence(__ATOMIC_ACQUIRE, "agent");
            asm volatile("s_waitcnt vmcnt(0)" ::: "memory");
        }
    }
    __syncthreads();
}

struct Args { const void* in[26]; float* out; unsigned char* ws; int ph_lo, ph_hi; };
struct Frame {
    LAS unsigned char* lds; char* ldsg;
    volatile LAS unsigned* MISC;
    int tid, lane, wave, vcu, G;
    unsigned char* ws; float* out;
};
#define IN_F(k) ((const float*)args.in[k])
#define IN_I(k) ((const int*)args.in[k])
#define WSP(T, off) ((T*)(F.ws + (off)))

namespace pg8 {
struct TileOrder {
    int nM, nN, nwg, G, c; const int* blk_exp;
    __device__ void init(int nM_, int nN_, int G_, int c_, const int* be) { nM = nM_; nN = nN_; nwg = nM * nN; G = G_; c = c_; blk_exp = be; }
    __device__ bool next(int i, Unit& u) const {
        const long L = (long)i * G + c; if (L >= nwg) return false;
        int wgid = (int)L; { const int q = nwg / NXCD, r = nwg % NXCD, xcd = wgid % NXCD, off = wgid / NXCD; wgid = (xcd < r ? xcd * (q + 1) : r * (q + 1) + (xcd - r) * q) + off; }
        const int nig = WGM * nN, gid = wgid / nig, fm = gid * WGM, gsz = (nM - fm) < WGM ? (nM - fm) : WGM;
        u.pm = fm + ((wgid % nig) % gsz); u.pn = (wgid % nig) / gsz;
        if (blk_exp) { const int e = __builtin_amdgcn_readfirstlane(__hip_atomic_load(blk_exp + u.pm, __ATOMIC_RELAXED, __HIP_MEMORY_SCOPE_AGENT)); u.pn += e * nN; }
        return true;
    }
    __device__ __forceinline__ void a_ready(const Unit&) const {}
    __device__ __forceinline__ void done(const Unit&) const {}
};

struct EpiWin {
    static constexpr bool PERM = true, AFTER_DRAIN = false;
    bf16_t* E; const float* b_gate;
    __device__ __forceinline__ void operator()(const f32x4 (&acc)[2][2][4][2], const Unit& u, int wr, int wc, int fr, int fq) const {
        const int t = u.pn >> 2, colt = (u.pn & 3) * BM;
        bf16_t* base = E + (size_t)t * ((size_t)16384 * 1024);
        const int row0 = u.pm * BM + wr * 64 + fr, col0 = colt + wc * 32 + 8 * fq;
        f32x4 bv[2][2];
#pragma unroll
        for (int bj = 0; bj < 2; ++bj)
#pragma unroll
            for (int n = 0; n < 2; ++n) bv[bj][n] = (t >= 5) ? *(const f32x4*)(b_gate + (t - 5) * 1024 + col0 + bj * HALF + 4 * n) : (f32x4){0.f, 0.f, 0.f, 0.f};
#pragma unroll
        for (int ai = 0; ai < 2; ++ai)
#pragma unroll
            for (int m = 0; m < 4; ++m) { bf16_t* rowp = base + (size_t)(row0 + ai * HALF + m * 16) * 1024 + col0;
#pragma unroll
                for (int bj = 0; bj < 2; ++bj) { f32x4 v0 = acc[ai][bj][m][0] + bv[bj][0], v1 = acc[ai][bj][m][1] + bv[bj][1];
                    if (t == 1) {
#pragma unroll
                        for (int j = 0; j < 4; ++j) { v0[j] = gelu_tanh(v0[j]); v1[j] = gelu_tanh(v1[j]); } }
                    else if (t >= 5) {
#pragma unroll
                        for (int j = 0; j < 4; ++j) { v0[j] = fast_sigmoid(v0[j]); v1[j] = fast_sigmoid(v1[j]); } }
                    u32x4 w; w.x = cvt_pk_bf16(v0[0], v0[1]); w.y = cvt_pk_bf16(v0[2], v0[3]); w.z = cvt_pk_bf16(v1[0], v1[1]); w.w = cvt_pk_bf16(v1[2], v1[3]);
                    *(u32x4*)(rowp + bj * HALF) = w; } }
    }
};
template <int PART> struct EpiBranch {
    static constexpr bool PERM = true, AFTER_DRAIN = false;
    const bf16_t* SG; float* T0; bf16_t* MIX;
    __device__ __forceinline__ void operator()(const f32x4 (&acc)[2][2][4][2], const Unit& u, int wr, int wc, int fr, int fq) const {
        const int row0 = u.pm * BM + wr * 64 + fr, col0 = u.pn * BM + wc * 32 + 8 * fq;
#pragma unroll
        for (int ai = 0; ai < 2; ++ai)
#pragma unroll
            for (int m = 0; m < 4; ++m) { const size_t ro = (size_t)(row0 + ai * HALF + m * 16) * 1024 + col0;
#pragma unroll
                for (int bj = 0; bj < 2; ++bj) { const size_t o = ro + bj * HALF;
                    const u32x4 g = *(const u32x4*)(SG + o);
                    f32x4 g0 = {bflo(g.x), bfhi(g.x), bflo(g.y), bfhi(g.y)}, g1 = {bflo(g.z), bfhi(g.z), bflo(g.w), bfhi(g.w)};
                    f32x4 v0 = acc[ai][bj][m][0] * g0, v1 = acc[ai][bj][m][1] * g1;
                    if (PART == 0) { *(f32x4*)(T0 + o) = v0; *(f32x4*)(T0 + o + 4) = v1; }
                    else { v0 += *(const f32x4*)(T0 + o); v1 += *(const f32x4*)(T0 + o + 4);
                        u32x4 w; w.x = cvt_pk_bf16(v0[0], v0[1]); w.y = cvt_pk_bf16(v0[2], v0[3]); w.z = cvt_pk_bf16(v1[0], v1[1]); w.w = cvt_pk_bf16(v1[2], v1[3]);
                        *(u32x4*)(MIX + o) = w; } } }
    }
};
struct EpiWout {
    static constexpr bool PERM = false, AFTER_DRAIN = false;
    const float* x; float* out; const float* mod;
    __device__ __forceinline__ void operator()(const f32x4 (&acc)[2][2][4][2], const Unit& u, int wr, int wc, int fr, int fq) const {
        const int row0 = u.pm * BM + wr * 64 + fr, col0 = u.pn * BM + wc * 32 + 4 * fq;
        const float* g1p = mod + (size_t)(u.pm >> 4) * 6144 + 2048;
        f32x4 gv[2][2];
#pragma unroll
        for (int bj = 0; bj < 2; ++bj)
#pragma unroll
            for (int n = 0; n < 2; ++n) gv[bj][n] = *(const f32x4*)(g1p + col0 + bj * HALF + n * 16);
#pragma unroll
        for (int ai = 0; ai < 2; ++ai)
#pragma unroll
            for (int m = 0; m < 4; ++m) { const size_t ro = (size_t)(row0 + ai * HALF + m * 16) * 1024 + col0;
#pragma unroll
                for (int bj = 0; bj < 2; ++bj)
#pragma unroll
                    for (int n = 0; n < 2; ++n) { const size_t o = ro + bj * HALF + n * 16; *(f32x4*)(out + o) = *(const f32x4*)(x + o) + gv[bj][n] * acc[ai][bj][m][n]; } }
    }
};
struct EpiUp {
    static constexpr bool PERM = true, AFTER_DRAIN = false;
    bf16_t* ACT; const float* b_up;
    __device__ __forceinline__ void operator()(const f32x4 (&acc)[2][2][4][2], const Unit& u, int wr, int wc, int fr, int fq) const {
        const int e = u.pn >> 3, p = u.pn & 7;
        const int row0 = u.pm * BM + wr * 64 + fr, c0 = p * 128 + wc * 32 + 8 * fq;
        const float* bg = b_up + (size_t)e * 2048 + c0; const float* bl = bg + 1024;
        f32x4 bgv[2], blv[2];
#pragma unroll
        for (int n = 0; n < 2; ++n) { bgv[n] = *(const f32x4*)(bg + 4 * n); blv[n] = *(const f32x4*)(bl + 4 * n); }
#pragma unroll
        for (int ai = 0; ai < 2; ++ai)
#pragma unroll
            for (int m = 0; m < 4; ++m) { bf16_t* rowp = ACT + (size_t)(row0 + ai * HALF + m * 16) * 1024 + c0;
                f32x4 a[2];
#pragma unroll
                for (int n = 0; n < 2; ++n) { const f32x4 g = acc[ai][0][m][n] + bgv[n], l = acc[ai][1][m][n] + blv[n];
#pragma unroll
                    for (int j = 0; j < 4; ++j) { const float gg = fminf(g[j], 7.0f), ll = fminf(fmaxf(l[j], -7.0f), 7.0f); a[n][j] = (ll + 1.0f) * gg * fast_sigmoid(1.702f * gg); } }
                u32x4 w; w.x = cvt_pk_bf16(a[0][0], a[0][1]); w.y = cvt_pk_bf16(a[0][2], a[0][3]); w.z = cvt_pk_bf16(a[1][0], a[1][1]); w.w = cvt_pk_bf16(a[1][2], a[1][3]);
                *(u32x4*)rowp = w; }
    }
};
struct EpiDown {
    static constexpr bool PERM = true, AFTER_DRAIN = false;
    bf16_t* YR; const float* b_down; const float* row_gate;
    __device__ __forceinline__ void operator()(const f32x4 (&acc)[2][2][4][2], const Unit& u, int wr, int wc, int fr, int fq) const {
        const int e = u.pn >> 2, p = u.pn & 3;
        const int row0 = u.pm * BM + wr * 64 + fr, c0 = p * BM + wc * 32 + 8 * fq;
        f32x4 bv[2][2];
#pragma unroll
        for (int bj = 0; bj < 2; ++bj)
#pragma unroll
            for (int n = 0; n < 2; ++n) bv[bj][n] = *(const f32x4*)(b_down + (size_t)e * 1024 + c0 + bj * HALF + 4 * n);
#pragma unroll
        for (int ai = 0; ai < 2; ++ai)
#pragma unroll
            for (int m = 0; m < 4; ++m) { const int r = row0 + ai * HALF + m * 16; const float gt = __hip_atomic_load(row_gate + r, __ATOMIC_RELAXED, __HIP_MEMORY_SCOPE_AGENT);
                bf16_t* rowp = YR + (size_t)r * 1024 + c0;
#pragma unroll
                for (int bj = 0; bj < 2; ++bj) { const f32x4 v0 = (acc[ai][bj][m][0] + bv[bj][0]) * gt, v1 = (acc[ai][bj][m][1] + bv[bj][1]) * gt;
                    u32x4 w; w.x = cvt_pk_bf16(v0[0], v0[1]); w.y = cvt_pk_bf16(v0[2], v0[3]); w.z = cvt_pk_bf16(v1[0], v1[1]); w.w = cvt_pk_bf16(v1[2], v1[3]);
                    *(u32x4*)(rowp + bj * HALF) = w; } }
    }
};
}

__device__ __forceinline__ void p0_transpose_item(const float* W, int N, bf16* WT, int Kd, size_t dst_row0, LAS float* scr, int k0, int n0, int lane) {
#pragma unroll 8
    for (int i = 0; i < 32; ++i) { const int kk = 2 * i + (lane >> 5); scr[kk * 33 + (lane & 31)] = W[(size_t)(k0 + kk) * N + n0 + (lane & 31)]; }
    LDS_WAIT(); asm volatile("" ::: "memory");
    const int c = lane & 7;
#pragma unroll
    for (int j = 0; j < 4; ++j) { const int n = (lane >> 3) + 8 * j; const LAS float* s = scr + (8 * c) * 33 + n;
        v4u o; o.x = pk2(s[0 * 33], s[1 * 33]); o.y = pk2(s[2 * 33], s[3 * 33]); o.z = pk2(s[4 * 33], s[5 * 33]); o.w = pk2(s[6 * 33], s[7 * 33]);
        *(GAS v4u*)(WT + (dst_row0 + n) * (size_t)Kd + k0 + 8 * c) = o; }
    LDS_WAIT(); asm volatile("" ::: "memory");
}
__device__ __forceinline__ void p0_prologue(Frame& F, const Args& args) {
    const float* c_in = IN_F(1); const int* pos = IN_I(2); const float* ada_w = IN_F(3); const float* ada_b = IN_F(4);
    for (int task = F.vcu; task < 96; task += F.G) {
        LAS float* sc = (LAS float*)F.lds;
        LAS float* red = (LAS float*)(F.lds + 16384);
        for (int i = F.tid; i < 4096; i += 512) { const float v = c_in[i]; sc[i] = v / (1.0f + expf(-v)); }
        __syncthreads();
        const int colq = F.lane & 15, kq = F.lane >> 4, col = task * 64 + colq * 4;
        float acc[4][4];
#pragma unroll
        for (int b = 0; b < 4; ++b)
#pragma unroll
            for (int j = 0; j < 4; ++j) acc[b][j] = 0.f;
#pragma unroll 4
        for (int s = 0; s < 32; ++s) { const int k = F.wave * 128 + s * 4 + kq; const f32x4 wv = *(const f32x4*)(ada_w + (size_t)k * 6144 + col);
#pragma unroll
            for (int b = 0; b < 4; ++b) { const float sv = sc[b * 1024 + k];
#pragma unroll
                for (int j = 0; j < 4; ++j) acc[b][j] += sv * wv[j]; } }
#pragma unroll
        for (int b = 0; b < 4; ++b)
#pragma unroll
            for (int j = 0; j < 4; ++j) { float v = acc[b][j]; v += __shfl_xor(v, 16); v += __shfl_xor(v, 32); if (kq == 0) red[(F.wave * 4 + b) * 64 + colq * 4 + j] = v; }
        __syncthreads();
        if (F.tid < 256) { const int b = F.tid >> 6, cc = F.tid & 63; float s = ada_b[task * 64 + cc];
#pragma unroll
            for (int w = 0; w < 8; ++w) s += red[(w * 4 + b) * 64 + cc];
            WSP(float, WS_MOD)[b * 6144 + task * 64 + cc] = s; }
        __syncthreads();
    }
    const int gt = F.vcu * 512 + F.tid, NGT = F.G * 512;
    for (int idx = gt; idx < NTOK * 16; idx += NGT) { const int m = idx >> 4, i = idx & 15;
        double freq = 1.0; for (int q = 0; q < i; ++q) freq *= 0.44036660267178046;
        const double ang = (double)pos[m] * freq; const double nr = __builtin_rint(ang * 0.15915494309189535);
        const float r = (float)__builtin_fma(-nr, 6.283185307179586, ang);
        float sn, cs; sincosf(r, &sn, &cs);
        WSP(float, WS_TRIG)[m * 32 + i] = cs; WSP(float, WS_TRIG)[m * 32 + 16 + i] = sn; }
    { const float* wr = IN_F(20); for (int idx = gt; idx < 32 * 1024; idx += NGT) { const int e = idx >> 10, k = idx & 1023; WSP(float, WS_WRT)[idx] = wr[k * 32 + e]; } }
    LAS float* scr = (LAS float*)(F.lds + 32768 + F.wave * 8704);
    const int gw = F.vcu * NWAVES + F.wave, NGW = F.G * NWAVES;
    constexpr int I_IN = 16 * 224, I_RG = 128, I_B = 1024, I_O = 512, I_UP = 32 * 1024, I_DN = 32 * 512;
    constexpr int NITEMS = I_IN + I_RG + I_B + I_O + I_UP + I_DN;
    for (int it = gw; it < NITEMS; it += NGW) {
        int r = it;
        if (r < I_IN) { const int kb = r / 224, nb = r % 224; p0_transpose_item(IN_F(7), DIN, WSP(bf16, WS_WIN), 1024, (size_t)nb * 32, scr, kb * 64, nb * 32, F.lane); continue; } r -= I_IN;
        if (r < I_RG) { const int mat = r >> 6, blk = (r >> 3) & 7, kb = (r >> 2) & 1, nb = r & 3;
            p0_transpose_item(IN_F(mat ? 12 : 10) + (size_t)blk * 16384, 128, WSP(bf16, WS_WRG) + (size_t)(mat * 8 + blk) * 16384, 128, (size_t)nb * 32, scr, kb * 64, nb * 32, F.lane); continue; } r -= I_RG;
        if (r < I_B) { const int g = r >> 9, q = r & 511, kb = q >> 5, nb = q & 31;
            p0_transpose_item(IN_F(18) + (size_t)g * 1048576, 1024, WSP(bf16, WS_WB) + (size_t)g * 1048576, 1024, (size_t)nb * 32, scr, kb * 64, nb * 32, F.lane); continue; } r -= I_B;
        if (r < I_O) { const int kb = r >> 5, nb = r & 31; p0_transpose_item(IN_F(19), 1024, WSP(bf16, WS_WO), 1024, (size_t)nb * 32, scr, kb * 64, nb * 32, F.lane); continue; } r -= I_O;
        if (r < I_UP) { const int e = r >> 10, q = r & 1023, kb = q >> 6, nb = q & 63, n0 = nb * 32;
            const int bj = n0 >> 10, p = (n0 & 1023) >> 7, oo = n0 & 127;
            p0_transpose_item(IN_F(22) + (size_t)e * 2097152, 2048, WSP(bf16, WS_WUP) + (size_t)e * 2097152, 1024, (size_t)(p * 256 + bj * 128 + oo), scr, kb * 64, n0, F.lane); continue; } r -= I_UP;
        { const int e = r >> 9, q = r & 511, kb = q >> 5, nb = q & 31;
            p0_transpose_item(IN_F(24) + (size_t)e * 1048576, 1024, WSP(bf16, WS_WDN) + (size_t)e * 1048576, 1024, (size_t)nb * 32, scr, kb * 64, nb * 32, F.lane); }
    }
}

__device__ __forceinline__ void p1_hrows(Frame& F, const Args& args) {
    const float* x = IN_F(0); const float* g1n = IN_F(5); const float* mod = WSP(float, WS_MOD); bf16* H = WSP(bf16, WS_HB);
    const int gw = F.vcu * NWAVES + F.wave, NGW = F.G * NWAVES;
    for (int m = gw; m < NTOK; m += NGW) {
        const int b = m >> 12;
        const f32x4* xr = (const f32x4*)(x + (size_t)m * DM) + F.lane;
        f32x4 v[4]; float s = 0.f;
#pragma unroll
        for (int j = 0; j < 4; ++j) { v[j] = xr[64 * j]; s += (v[j].x * v[j].x + v[j].y * v[j].y) + (v[j].z * v[j].z + v[j].w * v[j].w); }
        const float rstd = 1.0f / sqrtf(wave_sum(s) * (1.f / DM) + EPS);
        unsigned long long* o8 = (unsigned long long*)(H + (size_t)m * DM) + F.lane;
#pragma unroll
        for (int j = 0; j < 4; ++j) { const int col = 4 * F.lane + 256 * j;
            const f32x4 g = *(const f32x4*)(g1n + col), sh = *(const f32x4*)(mod + b * 6144 + col), sc = *(const f32x4*)(mod + b * 6144 + 1024 + col);
            const f32x4 h = v[j] * rstd * g * (sc + 1.0f) + sh;
            o8[64 * j] = (unsigned long long)pk2(h.x, h.y) | ((unsigned long long)pk2(h.z, h.w) << 32); }
    }
}

__device__ __forceinline__ void p3_knorm_unit(Frame& F, const Args& args, int unit) {
    const int h = unit & 7, j = (unit >> 3) & 15, b = unit >> 7;
    bf16* KR = WSP(bf16, WS_E) + 3 * E_STRIDE; const float* trig = WSP(float, WS_TRIG); const float* kg = IN_F(16);
    const int rsub = F.lane >> 4, c16 = F.lane & 15;
    float gk[8];
#pragma unroll
    for (int i = 0; i < 8; ++i) gk[i] = kg[c16 * 8 + i];
    float km[8];
#pragma unroll
    for (int i = 0; i < 8; ++i) km[i] = 0.f;
    for (int it = 0; it < 8; ++it) {
        const int m = b * SEQ + j * 256 + F.wave * 32 + it * 4 + rsub;
        bf16* p = KR + (size_t)m * DM + h * HD + c16 * 8;
        const v4u raw = *(const v4u*)p;
        float v[8] = {bflo(raw.x), bfhi(raw.x), bflo(raw.y), bfhi(raw.y), bflo(raw.z), bfhi(raw.z), bflo(raw.w), bfhi(raw.w)};
        float ss = 0.f;
#pragma unroll
        for (int i = 0; i < 8; ++i) ss += v[i] * v[i];
        ss += __shfl_xor(ss, 1); ss += __shfl_xor(ss, 2); ss += __shfl_xor(ss, 4); ss += __shfl_xor(ss, 8);
        const float rstd = 1.0f / sqrtf(ss * (1.f / HD) + EPS);
#pragma unroll
        for (int i = 0; i < 8; ++i) v[i] = v[i] * rstd * gk[i];
        const int fi = (c16 & 1) * 8;
#pragma unroll
        for (int i = 0; i < 8; ++i) { const float other = __shfl_xor(v[i], 2);
            if (c16 < 4) { const float cs = trig[(size_t)m * 32 + fi + i], sn = trig[(size_t)m * 32 + 16 + fi + i];
                v[i] = (c16 < 2) ? (v[i] * cs - other * sn) : (v[i] * cs + other * sn); } }
#pragma unroll
        for (int i = 0; i < 8; ++i) km[i] += v[i];
        v4u o; o.x = pk2(v[0], v[1]); o.y = pk2(v[2], v[3]); o.z = pk2(v[4], v[5]); o.w = pk2(v[6], v[7]);
        *(v4u*)p = o;
    }
    LAS float* red = (LAS float*)(F.lds + XTRA_OFF);
#pragma unroll
    for (int i = 0; i < 8; ++i) { float v = km[i]; v += __shfl_xor(v, 16); v += __shfl_xor(v, 32); if (rsub == 0) red[F.wave * 128 + c16 * 8 + i] = v; }
    __syncthreads();
    if (F.tid < 128) { float s = 0.f;
#pragma unroll
        for (int w = 0; w < 8; ++w) s += red[w * 128 + F.tid];
        WSP(float, WS_KMEAN)[((size_t)(b * NH + h) * 16 + j) * HD + F.tid] = s * (1.f / 256.f); }
    __syncthreads();
}

__device__ __forceinline__ void p3_rnn_local_unit(Frame& F, const Args& args, int unit) {
    const int n = unit & 7, c = (unit >> 3) & 15, b = unit >> 7;
    const int t0 = c * 256, m0 = b * SEQ + t0, ch0 = n * 128;
    const bf16* XR = WSP(bf16, WS_E);
    LAS unsigned char* At = F.lds;
    {
        const int cg = F.tid & 15, rs = F.tid >> 4; const int chb = ch0 + cg * 8;
        const float* cw = IN_F(8); const float* cb = IN_F(9);
        float w0[8], w1[8], w2[8], w3[8], bb[8];
#pragma unroll
        for (int i = 0; i < 8; ++i) { w0[i] = cw[chb + i]; w1[i] = cw[1024 + chb + i]; w2[i] = cw[2048 + chb + i]; w3[i] = cw[3072 + chb + i]; bb[i] = cb[chb + i]; }
        float p1[8], p2[8], p3[8];
        const int tr0 = t0 + rs * 8;
#define LDROW(dst, tt) do { if ((tt) >= 0) { const v4u r_ = *(const v4u*)(XR + (size_t)(b * SEQ + (tt)) * DM + chb); \
            dst[0] = bflo(r_.x); dst[1] = bfhi(r_.x); dst[2] = bflo(r_.y); dst[3] = bfhi(r_.y); dst[4] = bflo(r_.z); dst[5] = bfhi(r_.z); dst[6] = bflo(r_.w); dst[7] = bfhi(r_.w); } \
            else { _Pragma("unroll") for (int i_ = 0; i_ < 8; ++i_) dst[i_] = 0.f; } } while (0)
        LDROW(p3, tr0 - 3); LDROW(p2, tr0 - 2); LDROW(p1, tr0 - 1);
#pragma unroll
        for (int r = 0; r < 8; ++r) { float cur[8]; LDROW(cur, tr0 + r);
            float xc[8];
#pragma unroll
            for (int i = 0; i < 8; ++i) xc[i] = bb[i] + w0[i] * cur[i] + w1[i] * p1[i] + w2[i] * p2[i] + w3[i] * p3[i];
            const int row = rs * 8 + r;
            v4u o; o.x = pk2(xc[0], xc[1]); o.y = pk2(xc[2], xc[3]); o.z = pk2(xc[4], xc[5]); o.w = pk2(xc[6], xc[7]);
            *(LAS v4u*)(At + row * 256 + ((cg ^ (row & 15)) << 4)) = o;
#pragma unroll
            for (int i = 0; i < 8; ++i) { p3[i] = p2[i]; p2[i] = p1[i]; p1[i] = cur[i]; } }
#undef LDROW
    }
    __syncthreads();
    const int fr = F.lane & 15, fq = F.lane >> 4;
    const int vloc = F.wave * 16 + fr, ch = ch0 + vloc;
    const bf16* WA = WSP(bf16, WS_WRG) + (size_t)n * 16384 + (size_t)vloc * 128 + fq * 8;
    const bf16* WX = WA + 8 * 16384;
    bf16x8 Ba[4], Bx[4];
#pragma unroll
    for (int s = 0; s < 4; ++s) { Ba[s] = *(const bf16x8*)(WA + 32 * s); Bx[s] = *(const bf16x8*)(WX + 32 * s); }
    const float ba = IN_F(11)[ch], bx = IN_F(13)[ch];
    const float sp8 = 8.0f * log1pf(expf(-IN_F(14)[ch]));
    float cP = 1.f, cH = 0.f;
    bf16* HL = WSP(bf16, WS_HL); bf16* PP = WSP(bf16, WS_PP);
    LAS unsigned short* stg = (LAS unsigned short*)(F.lds + 65536);
    for (int rt = 0; rt < 16; ++rt) {
        f32x4 accr = {0.f, 0.f, 0.f, 0.f}, accx = {0.f, 0.f, 0.f, 0.f};
        const int arow = rt * 16 + fr;
#pragma unroll
        for (int s = 0; s < 4; ++s) { const bf16x8 a = *(const LAS bf16x8*)(At + arow * 256 + (((fq + 4 * s) ^ (arow & 15)) << 4));
            accr = __builtin_amdgcn_mfma_f32_16x16x32_bf16(a, Ba[s], accr, 0, 0, 0);
            accx = __builtin_amdgcn_mfma_f32_16x16x32_bf16(a, Bx[s], accx, 0, 0, 0); }
        float pj[4], hj[4];
#pragma unroll
        for (int j = 0; j < 4; ++j) { const int row = rt * 16 + 4 * fq + j;
            const float xcv = bf2f(*(const LAS unsigned short*)(At + row * 256 + ((((vloc >> 3)) ^ (row & 15)) << 4) + (vloc & 7) * 2));
            const float r = fast_sigmoid(accr[j] + ba), ig = fast_sigmoid(accx[j] + bx);
            const float la = -sp8 * r, a = __builtin_amdgcn_exp2f(la * 1.4426950408889634f);
            float mult = sqrtf(-expm1f(2.0f * la)); if (t0 + row == 0) mult = 1.0f;
            const float u = mult * ig * xcv;
            pj[j] = (j ? pj[j - 1] : 1.0f) * a; hj[j] = (j ? hj[j - 1] * a : 0.0f) + u; }
        const float tp = pj[3], th = hj[3];
        const float pa = __shfl(tp, F.lane - 16), ha = __shfl(th, F.lane - 16);
        const float pb = __shfl(tp, F.lane - 32), hb = __shfl(th, F.lane - 32);
        const float pc = __shfl(tp, F.lane - 48), hc = __shfl(th, F.lane - 48);
        float Pq, Hq;
        if (fq == 0) { Pq = 1.f; Hq = 0.f; } else if (fq == 1) { Pq = pa; Hq = ha; } else if (fq == 2) { Pq = pb * pa; Hq = pa * hb + ha; } else { Pq = pc * pb * pa; Hq = pa * (pb * hc + hb) + ha; }
        const float hstart = Hq + Pq * cH, pstart = Pq * cP;
        LAS unsigned short* sb = stg + (rt & 1) * 4096;
        float hl3 = 0.f, pp3 = 0.f;
#pragma unroll
        for (int j = 0; j < 4; ++j) { const float hv = hj[j] + pj[j] * hstart, pv = pj[j] * pstart; const int rl = 4 * fq + j;
            sb[rl * 128 + vloc] = (unsigned short)f2bf(hv); sb[2048 + rl * 128 + vloc] = (unsigned short)f2bf(pv); if (j == 3) { hl3 = hv; pp3 = pv; } }
        cH = __shfl(hl3, fr + 48); cP = __shfl(pp3, fr + 48);
        __syncthreads();
        { const int arr = F.tid >> 8, rr = (F.tid >> 4) & 15, c16 = F.tid & 15;
            const v4u val = *(const LAS v4u*)(sb + arr * 2048 + rr * 128 + c16 * 8);
            bf16* dst = (arr ? PP : HL) + (size_t)(m0 + rt * 16 + rr) * DM + ch0 + c16 * 8;
            *(v4u*)dst = val; }
    }
    if (fq == 0) { WSP(float, WS_AGGP)[(size_t)(b * 16 + c) * 1024 + ch] = cP; WSP(float, WS_AGGH)[(size_t)(b * 16 + c) * 1024 + ch] = cH; }
    __syncthreads();
}

__device__ __forceinline__ void p4_rnn_final_unit(Frame& F, const Args& args, int unit) {
    const int n = unit & 7, c = (unit >> 3) & 15, b = unit >> 7;
    const int m0 = b * SEQ + c * 256, ch0 = n * 128;
    LAS float* car = (LAS float*)(F.lds + XTRA_OFF);
    if (F.tid < 128) { const int ch = ch0 + F.tid; float h = 0.f;
        for (int cc = 0; cc < c; ++cc) { const float p = WSP(float, WS_AGGP)[(size_t)(b * 16 + cc) * 1024 + ch], hh = WSP(float, WS_AGGH)[(size_t)(b * 16 + cc) * 1024 + ch]; h = p * h + hh; }
        car[F.tid] = h; }
    __syncthreads();
    const bf16* HL = WSP(bf16, WS_HL); const bf16* PP = WSP(bf16, WS_PP); const bf16* GG = WSP(bf16, WS_E) + E_STRIDE; bf16* Y = WSP(bf16, WS_YRNN);
    const int c16 = F.tid & 15, r0 = F.tid >> 4;
    float cv[8];
#pragma unroll
    for (int i = 0; i < 8; ++i) cv[i] = car[c16 * 8 + i];
#pragma unroll 2
    for (int it = 0; it < 8; ++it) { const size_t o = (size_t)(m0 + it * 32 + r0) * DM + ch0 + c16 * 8;
        const v4u hl = *(const v4u*)(HL + o), pp = *(const v4u*)(PP + o), gg = *(const v4u*)(GG + o);
        v4u y;
        y.x = pk2((bflo(hl.x) + bflo(pp.x) * cv[0]) * bflo(gg.x), (bfhi(hl.x) + bfhi(pp.x) * cv[1]) * bfhi(gg.x));
        y.y = pk2((bflo(hl.y) + bflo(pp.y) * cv[2]) * bflo(gg.y), (bfhi(hl.y) + bfhi(pp.y) * cv[3]) * bfhi(gg.y));
        y.z = pk2((bflo(hl.z) + bflo(pp.z) * cv[4]) * bflo(gg.z), (bfhi(hl.z) + bfhi(pp.z) * cv[5]) * bfhi(gg.z));
        y.w = pk2((bflo(hl.w) + bflo(pp.w) * cv[6]) * bflo(gg.w), (bfhi(hl.w) + bfhi(pp.w) * cv[7]) * bfhi(gg.w));
        *(v4u*)(Y + o) = y; }
    __syncthreads();
}

namespace att {
constexpr int KVBLK = 64, SHM_K = KVBLK * HD * 2, SHM_V = SHM_K;
constexpr float C2 = 0.08838834764831845f * 1.4426950408889634f;
#define KSWZ(row, colB) ((row) * 256 + ((colB) ^ (((row) & 7) << 4)))
__device__ __forceinline__ int v_st(int k, int c) { const int kk = (k & ~0xC) | ((k & 4) << 1) | ((k & 8) >> 1); return ((kk >> 3) * 4 + (c >> 5)) * 512 + ((kk & 7) * 32 + (c & 31)) * 2; }
__device__ __forceinline__ int v_rd_base(int lane) { return ((lane & 3) << 3) | (((lane >> 2) & 3) << 6) | (((lane >> 4) & 1) << 5) | (((lane >> 5) & 1) << 8); }
constexpr int v_rd_off(int d0, int ks, int half) { return d0 * 512 + ks * 4096 + half * 2048; }
__device__ __forceinline__ int crow(int r, int hi) { return (r & 3) + 8 * (r >> 2) + 4 * hi; }

template <int KB>
__device__ __forceinline__ void qkt(f32x16& p0, f32x16& p1, const char* K_lds, int r32, int hi, const char* qfrag, bool act) {
    if (!act) { const float NEG = -__builtin_inff();
#pragma unroll
        for (int r = 0; r < 16; ++r) { p0[r] = NEG; p1[r] = NEG; } return; }
    p0 = f32x16{}; p1 = f32x16{};
    const char* kb[4];
#pragma unroll
    for (int dd = 0; dd < 4; ++dd) kb[dd] = K_lds + KB * SHM_K + KSWZ(r32, (dd * 16 + hi * 8) * 2);
#pragma unroll
    for (int d0 = 0; d0 < 8; ++d0) { const char* a = kb[d0 & 3] + (d0 >> 2) * 128;
        bf16x8 b0 = *reinterpret_cast<const bf16x8*>(a);
        bf16x8 b1 = *reinterpret_cast<const bf16x8*>(a + 32 * 256);
        const bf16x8 q = *reinterpret_cast<const bf16x8*>(qfrag + d0 * 1024);
        p0 = __builtin_amdgcn_mfma_f32_32x32x16_bf16(b0, q, p0, 0, 0, 0);
        p1 = __builtin_amdgcn_mfma_f32_32x32x16_bf16(b1, q, p1, 0, 0, 0); }
}
template <int VB>
__device__ __forceinline__ void pv_tile(f32x16* o, int vb0, bf16x8 pa0, bf16x8 pa1, bf16x8 pa2, bf16x8 pa3, bool act) {
    if (!act) return;
#define TRRD(dst, off) asm volatile("ds_read_b64_tr_b16 %0, %1 offset:%2" : "=&v"(dst) : "v"(vb0), "i"(off) : "memory")
#define PV_D0(d0) do { s16x4 l0, l1, l2, l3, h0, h1, h2, h3; constexpr int b_ = VB * SHM_V + v_rd_off(d0, 0, 0); \
        TRRD(l0, b_); TRRD(h0, b_ + 2048); TRRD(l1, b_ + 4096); TRRD(h1, b_ + 6144); TRRD(l2, b_ + 8192); TRRD(h2, b_ + 10240); TRRD(l3, b_ + 12288); TRRD(h3, b_ + 14336); \
        asm volatile("s_waitcnt lgkmcnt(0)" ::: "memory"); SBAR(); \
        o[d0] = __builtin_amdgcn_mfma_f32_32x32x16_bf16(pa0, (bf16x8){l0[0], l0[1], l0[2], l0[3], h0[0], h0[1], h0[2], h0[3]}, o[d0], 0, 0, 0);   \
        o[d0] = __builtin_amdgcn_mfma_f32_32x32x16_bf16(pa1, (bf16x8){l1[0], l1[1], l1[2], l1[3], h1[0], h1[1], h1[2], h1[3]}, o[d0], 0, 0, 0);   \
        o[d0] = __builtin_amdgcn_mfma_f32_32x32x16_bf16(pa2, (bf16x8){l2[0], l2[1], l2[2], l2[3], h2[0], h2[1], h2[2], h2[3]}, o[d0], 0, 0, 0);   \
        o[d0] = __builtin_amdgcn_mfma_f32_32x32x16_bf16(pa3, (bf16x8){l3[0], l3[1], l3[2], l3[3], h3[0], h3[1], h3[2], h3[3]}, o[d0], 0, 0, 0); } while (0)
    PV_D0(0); PV_D0(1); PV_D0(2); PV_D0(3);
#undef PV_D0
#undef TRRD
}
__device__ __forceinline__ void sm_a(f32x16& p0) {
#pragma unroll
    for (int r = 0; r < 16; ++r) p0[r] = __builtin_amdgcn_exp2f(p0[r]);
}
__device__ __forceinline__ void sm_b(f32x16& p0, f32x16& p1, float& l_reg, bf16x8& pa0, bf16x8& pa1, bf16x8& pa2, bf16x8& pa3) {
#pragma unroll
    for (int r = 0; r < 16; ++r) p1[r] = __builtin_amdgcn_exp2f(p1[r]);
    float ps = 0;
#pragma unroll
    for (int r = 0; r < 16; ++r) ps += p0[r];
#pragma unroll
    for (int r = 0; r < 16; ++r) ps += p1[r];
    l_reg += ps;
#define PK4(P, B_, OUT) do { unsigned a0 = cvtpk(P[B_+0], P[B_+1]), a1 = cvtpk(P[B_+2], P[B_+3]); \
        unsigned b0 = cvtpk(P[B_+4], P[B_+5]), b1 = cvtpk(P[B_+6], P[B_+7]); \
        auto r0 = __builtin_amdgcn_permlane32_swap(a0, b0, false, false); auto r1 = __builtin_amdgcn_permlane32_swap(a1, b1, false, false); \
        v4u w = {r0[0], r1[0], r0[1], r1[1]}; OUT = *reinterpret_cast<bf16x8*>(&w); } while (0)
    PK4(p0, 0, pa0); PK4(p0, 8, pa1); PK4(p1, 0, pa2); PK4(p1, 8, pa3);
#undef PK4
}

__device__ __forceinline__ void attn_unit(Frame& F, const Args& args, int b, int h, int iq) {
    int tid = F.tid; asm volatile("" : "+v"(tid));
    const int wid = F.wave, lane = tid & 63, r32 = lane & 31, hi = lane >> 5;
    char* lds = F.ldsg;
    char* V_lds = lds; char* K_lds = lds + 2 * SHM_V;
    float* kml = (float*)(lds + XTRA_OFF);
    char* qfrag = lds + 65536 + wid * 8192 + lane * 16;
    const bf16* QR = WSP(bf16, WS_E) + 2 * E_STRIDE; const bf16* KN = WSP(bf16, WS_E) + 3 * E_STRIDE; const bf16* VV = WSP(bf16, WS_E) + 4 * E_STRIDE;
    bf16* YA = WSP(bf16, WS_YATT);
    const size_t mb = (size_t)b * SEQ;
    const int q0 = iq * 256, NT = 4 * (iq + 1);
    const bf16* Kh = KN + mb * DM + h * HD; const bf16* Vh = VV + mb * DM + h * HD;
    { const float* kmg = WSP(float, WS_KMEAN) + (size_t)(b * NH + h) * 16 * HD; for (int idx = tid; idx < iq * HD; idx += 512) kml[idx] = kmg[idx]; }
    const int sr = tid >> 4, sc = (tid & 15) * 8, vst0 = v_st(sr, sc), vst1 = v_st(32 + sr, sc), kws = KSWZ(sr, sc * 2);
    const int vb0 = (int)(uintptr_t)V_lds + v_rd_base(lane);
    bf16x8 st_v0, st_v1, st_k0, st_k1;
    const unsigned goff = (unsigned)(sr * DM + sc) * 2u;
#define ROWP(p, k0, rr) ((const char*)((p) + (size_t)((k0) + (rr)) * DM) + goff)
#define SLOAD(k0) do { st_v0 = *(const bf16x8*)ROWP(Vh, k0, 0); st_v1 = *(const bf16x8*)ROWP(Vh, k0, 32); st_k0 = *(const bf16x8*)ROWP(Kh, k0, 0); st_k1 = *(const bf16x8*)ROWP(Kh, k0, 32); } while (0)
#define SWRITE(bf) do { *(bf16x8*)(V_lds + (bf) * SHM_V + vst0) = st_v0; *(bf16x8*)(V_lds + (bf) * SHM_V + vst1) = st_v1; \
                        *(bf16x8*)(K_lds + (bf) * SHM_K + kws) = st_k0; *(bf16x8*)(K_lds + (bf) * SHM_K + kws + 32 * 256) = st_k1; } while (0)
    SLOAD(0);
    const size_t mq = mb + q0 + wid * 32 + r32;
    unsigned selmask;
    {
        bf16x8 qr[8];
        const bf16* qp = QR + mq * DM + h * HD + hi * 8;
        v4u raw[8];
#pragma unroll
        for (int d0 = 0; d0 < 8; ++d0) raw[d0] = *(const v4u*)(qp + d0 * 16);
        float ss = 0.f;
#pragma unroll
        for (int d0 = 0; d0 < 8; ++d0) { const float a0 = bflo(raw[d0].x), a1 = bfhi(raw[d0].x), a2 = bflo(raw[d0].y), a3 = bfhi(raw[d0].y), a4 = bflo(raw[d0].z), a5 = bfhi(raw[d0].z), a6 = bflo(raw[d0].w), a7 = bfhi(raw[d0].w);
            ss += (a0 * a0 + a1 * a1) + (a2 * a2 + a3 * a3) + (a4 * a4 + a5 * a5) + (a6 * a6 + a7 * a7); }
        ss += __shfl_xor(ss, 32);
        const float rs = C2 / sqrtf(ss * (1.f / HD) + EPS);
        const float* qg = IN_F(15) + hi * 8;
#define UNPK(f, W_) do { const v4u t_ = (W_); f[0] = bflo(t_.x); f[1] = bfhi(t_.x); f[2] = bflo(t_.y); f[3] = bfhi(t_.y); f[4] = bflo(t_.z); f[5] = bfhi(t_.z); f[6] = bflo(t_.w); f[7] = bfhi(t_.w); } while (0)
#define PACK(f) ({ v4u w_; w_.x = cvtpk(f[0], f[1]); w_.y = cvtpk(f[2], f[3]); w_.z = cvtpk(f[4], f[5]); w_.w = cvtpk(f[6], f[7]); *reinterpret_cast<bf16x8*>(&w_); })
        { float f0[8], f1[8]; UNPK(f0, raw[0]); UNPK(f1, raw[1]);
          const float* tg = WSP(float, WS_TRIG) + mq * 32 + hi * 8;
#pragma unroll
          for (int j = 0; j < 8; ++j) { const float x1 = f0[j] * rs * qg[j], x2 = f1[j] * rs * qg[16 + j], cs = tg[j], sn = tg[16 + j]; f0[j] = x1 * cs - x2 * sn; f1[j] = x2 * cs + x1 * sn; }
          qr[0] = PACK(f0); qr[1] = PACK(f1); }
#pragma unroll
        for (int d0 = 2; d0 < 8; ++d0) { float f[8]; UNPK(f, raw[d0]);
#pragma unroll
            for (int j = 0; j < 8; ++j) f[j] *= rs * qg[d0 * 16 + j];
            qr[d0] = PACK(f); }
        __syncthreads();
        float v1 = -__builtin_inff(), v2 = v1, v3 = v1; int i1 = 0, i2 = 0, i3 = 0;
#pragma unroll 1
        for (int jb = 0; jb < iq; ++jb) { const float* km = kml + jb * HD + hi * 8; float g = 0.f;
#pragma unroll
            for (int d0 = 0; d0 < 8; ++d0) { float f[8]; UNPK(f, *reinterpret_cast<const v4u*>(&qr[d0]));
                const f32x4 k0 = *(const f32x4*)(km + d0 * 16), k1 = *(const f32x4*)(km + d0 * 16 + 4);
                g += (f[0] * k0[0] + f[1] * k0[1]) + (f[2] * k0[2] + f[3] * k0[3]) + (f[4] * k1[0] + f[5] * k1[1]) + (f[6] * k1[2] + f[7] * k1[3]); }
            g += __shfl_xor(g, 32);
            if (g > v1) { v3 = v2; i3 = i2; v2 = v1; i2 = i1; v1 = g; i1 = jb; }
            else if (g > v2) { v3 = v2; i3 = i2; v2 = g; i2 = jb; }
            else if (g > v3) { v3 = g; i3 = jb; } }
#undef UNPK
#undef PACK
        selmask = 0u; if (iq >= 1) selmask |= 1u << i1; if (iq >= 2) selmask |= 1u << i2; if (iq >= 3) selmask |= 1u << i3;
#pragma unroll
        for (int d0 = 0; d0 < 8; ++d0) *reinterpret_cast<bf16x8*>(qfrag + d0 * 1024) = qr[d0];
    }
    float l_reg = 0.f; f32x16 o[4] = {};
    const int wrow0 = wid * 32;
#define ACT(t) (((t) >> 2) < iq ? (__ballot((selmask >> ((t) >> 2)) & 1u) != 0ull) : ((((t) - 4 * iq) * 64) <= wrow0 + 31))
#define MASKT(P0_, P1_, t) do { const int blk_ = (t) >> 2; const float NEG_ = -__builtin_inff(); \
        if (blk_ < iq) { if (!((selmask >> blk_) & 1u)) { _Pragma("unroll") for (int r = 0; r < 16; ++r) { P0_[r] = NEG_; P1_[r] = NEG_; } } } \
        else { const int kb_ = ((t) - 4 * iq) * 64; if (kb_ + 63 > wrow0) { int dq_ = wrow0 + r32 - kb_ - 4 * hi; asm volatile("" : "+v"(dq_)); \
            _Pragma("unroll") for (int r = 0; r < 16; ++r) { const int c_ = (r & 3) + 8 * (r >> 2); if (c_ > dq_) P0_[r] = NEG_; if (c_ + 32 > dq_) P1_[r] = NEG_; } } } } while (0)
    f32x16 pA0, pA1, pB0, pB1; bf16x8 pa0, pa1, pa2, pa3;
    VM_WAIT(); SWRITE(0); SBAR();
    SLOAD(64);
    __syncthreads();
    SBAR(); qkt<0>(pA0, pA1, K_lds, r32, hi, qfrag, ACT(0));
    MASKT(pA0, pA1, 0); sm_a(pA0);
    VM_WAIT(); SWRITE(1);
    __syncthreads();
#define HALF_STEP(PX0, PX1, PY0, PY1, t, KB, VB, SB) do { \
        SBAR(); qkt<KB>(PX0, PX1, K_lds, r32, hi, qfrag, ACT(t)); \
        sm_b(PY0, PY1, l_reg, pa0, pa1, pa2, pa3); SBAR(); \
        if ((t) + 1 < NT) { SLOAD(((t) + 1) * 64); SBAR(); } \
        pv_tile<VB>(o, vb0, pa0, pa1, pa2, pa3, ACT((t) - 1)); MASKT(PX0, PX1, (t)); sm_a(PX0); \
        __syncthreads(); \
        if ((t) + 1 < NT) { VM_WAIT(); SWRITE(SB); } \
        __syncthreads(); } while (0)
    for (int t = 1; t + 1 < NT; t += 2) {
        HALF_STEP(pB0, pB1, pA0, pA1, t, 1, 0, 0);
        HALF_STEP(pA0, pA1, pB0, pB1, t + 1, 0, 1, 1);
    }
    SBAR(); qkt<1>(pB0, pB1, K_lds, r32, hi, qfrag, ACT(NT - 1)); SBAR();
    sm_b(pA0, pA1, l_reg, pa0, pa1, pa2, pa3); SBAR();
    pv_tile<0>(o, vb0, pa0, pa1, pa2, pa3, ACT(NT - 2));
    MASKT(pB0, pB1, NT - 1); sm_a(pB0);
    sm_b(pB0, pB1, l_reg, pa0, pa1, pa2, pa3); SBAR();
    pv_tile<1>(o, vb0, pa0, pa1, pa2, pa3, ACT(NT - 1));
    l_reg += __shfl_xor(l_reg, 32);
    float* li_l = (float*)(lds + XTRA_OFF + 8192) + wid * 32;
    if (hi == 0) li_l[r32] = l_reg;
    asm volatile("s_waitcnt lgkmcnt(0)" ::: "memory");
    float rli[16];
#pragma unroll
    for (int r = 0; r < 16; ++r) rli[r] = __builtin_amdgcn_rcpf(li_l[crow(r, hi)]);
    bf16* Ow = YA + (mb + q0 + wid * 32) * DM + h * HD;
#pragma unroll
    for (int r = 0; r < 16; ++r) { const int orow = crow(r, hi);
#pragma unroll
        for (int d0 = 0; d0 < 4; ++d0) { const float v = o[d0][r] * rli[r]; const float vn = __shfl_xor(v, 1);
            if ((r32 & 1) == 0) *(unsigned*)(Ow + (size_t)orow * DM + d0 * 32 + r32) = cvtpk(v, vn); } }
    __syncthreads();
#undef ROWP
#undef SLOAD
#undef SWRITE
#undef ACT
#undef MASKT
#undef HALF_STEP
}
#undef KSWZ
}

__device__ __forceinline__ void p7_router(Frame& F, const Args& args) {
    LAS float* Wl = (LAS float*)F.lds;
    LAS int* hist = (LAS int*)(F.lds + XTRA_OFF);
    { const f32x4* src = (const f32x4*)WSP(float, WS_WRT); for (int i = F.tid; i < 8192; i += 512) ((LAS f32x4*)Wl)[i] = src[i]; }
    const float* g2n = IN_F(6); const float* mod = WSP(float, WS_MOD); const float* brt = IN_F(21);
    bf16* H2 = WSP(bf16, WS_HB);
    for (int vw = F.vcu; vw < 256; vw += F.G) {
        if (F.tid < 32) hist[F.tid] = 0;
        __syncthreads();
        for (int rr = 0; rr < 8; ++rr) {
            const int m = vw * 64 + F.wave * 8 + rr, b = m >> 12;
            const f32x4* xr = (const f32x4*)(F.out + (size_t)m * DM) + F.lane;
            f32x4 v[4]; float s = 0.f;
#pragma unroll
            for (int j = 0; j < 4; ++j) { v[j] = xr[64 * j]; s += (v[j].x * v[j].x + v[j].y * v[j].y) + (v[j].z * v[j].z + v[j].w * v[j].w); }
            const float rstd = 1.0f / sqrtf(wave_sum(s) * (1.f / DM) + EPS);
            unsigned long long* o8 = (unsigned long long*)(H2 + (size_t)m * DM) + F.lane;
#pragma unroll
            for (int j = 0; j < 4; ++j) { const int col = 4 * F.lane + 256 * j;
                const f32x4 g = *(const f32x4*)(g2n + col), sh = *(const f32x4*)(mod + b * 6144 + 3072 + col), sc = *(const f32x4*)(mod + b * 6144 + 4096 + col);
                v[j] = v[j] * rstd * g * (sc + 1.0f) + sh;
                o8[64 * j] = (unsigned long long)pk2(v[j].x, v[j].y) | ((unsigned long long)pk2(v[j].z, v[j].w) << 32); }
            float acc[32];
#pragma unroll
            for (int e = 0; e < 32; ++e) { float a = 0.f;
#pragma unroll
                for (int j = 0; j < 4; ++j) { const f32x4 w = *(const LAS f32x4*)(Wl + e * 1024 + 4 * F.lane + 256 * j); a += (v[j].x * w.x + v[j].y * w.y) + (v[j].z * w.z + v[j].w * w.w); }
                acc[e] = a; }
            float r16[16], r8[8], r4[4], r2[2], r1;
            { const bool up = (F.lane & 32) != 0;
#pragma unroll
              for (int i = 0; i < 16; ++i) { const float send = up ? acc[i] : acc[i + 16], keep = up ? acc[i + 16] : acc[i]; r16[i] = keep + __shfl_xor(send, 32); } }
            { const bool up = (F.lane & 16) != 0;
#pragma unroll
              for (int i = 0; i < 8; ++i) { const float send = up ? r16[i] : r16[i + 8], keep = up ? r16[i + 8] : r16[i]; r8[i] = keep + __shfl_xor(send, 16); } }
            { const bool up = (F.lane & 8) != 0;
#pragma unroll
              for (int i = 0; i < 4; ++i) { const float send = up ? r8[i] : r8[i + 4], keep = up ? r8[i + 4] : r8[i]; r4[i] = keep + __shfl_xor(send, 8); } }
            { const bool up = (F.lane & 4) != 0;
#pragma unroll
              for (int i = 0; i < 2; ++i) { const float send = up ? r4[i] : r4[i + 2], keep = up ? r4[i + 2] : r4[i]; r2[i] = keep + __shfl_xor(send, 4); } }
            { const bool up = (F.lane & 2) != 0; const float send = up ? r2[0] : r2[1], keep = up ? r2[1] : r2[0]; r1 = keep + __shfl_xor(send, 2); }
            r1 += __shfl_xor(r1, 1);
            const int myE = F.lane >> 1;
            float cur = r1 + brt[myE];
            float tv[4]; int te[4];
#pragma unroll
            for (int k = 0; k < 4; ++k) { const float mx = wave_max(cur); const unsigned long long bal = __ballot(cur == mx); const int src = __ffsll((long long)bal) - 1;
                te[k] = src >> 1; tv[k] = mx; if (myE == te[k]) cur = -__builtin_inff(); }
            const float w1 = __expf(tv[1] - tv[0]), w2 = __expf(tv[2] - tv[0]), w3 = __expf(tv[3] - tv[0]);
            const float inv = 1.0f / (1.0f + w1 + w2 + w3);
            if (F.lane < 4) { const int e = F.lane == 0 ? te[0] : F.lane == 1 ? te[1] : F.lane == 2 ? te[2] : te[3];
                const float g = (F.lane == 0 ? 1.0f : F.lane == 1 ? w1 : F.lane == 2 ? w2 : w3) * inv;
                const int lr = atomicAdd((int*)&hist[e], 1);
                WSP(int, WS_TOKE)[m * 4 + F.lane] = e; WSP(int, WS_TOKLR)[m * 4 + F.lane] = lr; WSP(float, WS_TOKG)[m * 4 + F.lane] = g; }
        }
        __syncthreads();
        if (F.tid < 32) WSP(int, WS_WGCNT)[vw * 32 + F.tid] = hist[F.tid];
        __syncthreads();
    }
}

__device__ __forceinline__ void p8_scatter(Frame& F, const Args& args) {
    LAS int* part = (LAS int*)F.lds;
    LAS int* base = (LAS int*)(F.lds + 8192);
    const bf16* H2 = WSP(bf16, WS_HB); bf16* XG = WSP(bf16, WS_XG);
    for (int vw = F.vcu; vw < 256; vw += F.G) {
        { const int e = F.tid & 31, pt = F.tid >> 5; int tot = 0, bef = 0;
          for (int q = 0; q < 16; ++q) { const int w = pt * 16 + q; const int cn = __hip_atomic_load(WSP(int, WS_WGCNT) + w * 32 + e, RLX_AGENT); tot += cn; if (w < vw) bef += cn; }
          part[pt * 32 + e] = tot; part[512 + pt * 32 + e] = bef; }
        __syncthreads();
        if (F.tid < 32) { int tot = 0, bef = 0;
#pragma unroll
            for (int q = 0; q < 16; ++q) { tot += part[q * 32 + F.tid]; bef += part[512 + q * 32 + F.tid]; }
            part[1024 + F.tid] = tot; part[1056 + F.tid] = bef; }
        __syncthreads();
        if (F.tid == 0) { int run = 0;
            for (int e = 0; e < 32; ++e) { const int ps = run; run += ((part[1024 + e] + 255) >> 8) << 8; base[e] = ps + part[1056 + e];
                if (vw == 0) { for (int blk = ps >> 8; blk < (run >> 8); ++blk) WSP(int, WS_BLKEXP)[blk] = e; } }
            if (vw == 0) WSP(int, WS_BLKEXP)[511] = run >> 8; }
        __syncthreads();
        for (int rr = 0; rr < 8; ++rr) {
            const int m = vw * 64 + F.wave * 8 + rr;
            const v4u a0 = *(const v4u*)(H2 + (size_t)m * DM + F.lane * 8), a1 = *(const v4u*)(H2 + (size_t)m * DM + 512 + F.lane * 8);
            int dk = 0;
            if (F.lane < 4) { const int e = __hip_atomic_load(WSP(int, WS_TOKE) + m * 4 + F.lane, RLX_AGENT), lr = __hip_atomic_load(WSP(int, WS_TOKLR) + m * 4 + F.lane, RLX_AGENT);
                dk = base[e] + lr; WSP(int, WS_DEST)[m * 4 + F.lane] = dk; WSP(float, WS_ROWGATE)[dk] = __hip_atomic_load(WSP(float, WS_TOKG) + m * 4 + F.lane, RLX_AGENT); }
#pragma unroll
            for (int k = 0; k < 4; ++k) { const int d = __shfl(dk, k); bf16* dst = XG + (size_t)d * DM;
                *(v4u*)(dst + F.lane * 8) = a0; *(v4u*)(dst + 512 + F.lane * 8) = a1; }
        }
        __syncthreads();
    }
}

__device__ __forceinline__ void p11_combine(Frame& F, const Args& args) {
    const float* mod = WSP(float, WS_MOD); const bf16* YR = WSP(bf16, WS_YR);
    const int gw = F.vcu * NWAVES + F.wave, NGW = F.G * NWAVES;
    for (int m = gw; m < NTOK; m += NGW) {
        const int b = m >> 12;
        int dk = 0; if (F.lane < 4) dk = __hip_atomic_load(WSP(int, WS_DEST) + m * 4 + F.lane, RLX_AGENT);
        const int d0 = __shfl(dk, 0), d1 = __shfl(dk, 1), d2 = __shfl(dk, 2), d3 = __shfl(dk, 3);
        f32x4* xr = (f32x4*)(F.out + (size_t)m * DM) + F.lane;
#pragma unroll
        for (int j = 0; j < 4; ++j) { const int col = 4 * F.lane + 256 * j;
            const v2u y0 = *(const v2u*)(YR + (size_t)d0 * DM + col), y1 = *(const v2u*)(YR + (size_t)d1 * DM + col), y2 = *(const v2u*)(YR + (size_t)d2 * DM + col), y3 = *(const v2u*)(YR + (size_t)d3 * DM + col);
            f32x4 s;
            s.x = (bflo(y0.x) + bflo(y1.x)) + (bflo(y2.x) + bflo(y3.x)); s.y = (bfhi(y0.x) + bfhi(y1.x)) + (bfhi(y2.x) + bfhi(y3.x));
            s.z = (bflo(y0.y) + bflo(y1.y)) + (bflo(y2.y) + bflo(y3.y)); s.w = (bfhi(y0.y) + bfhi(y1.y)) + (bfhi(y2.y) + bfhi(y3.y));
            const f32x4 g2 = *(const f32x4*)(mod + b * 6144 + 5120 + col);
            xr[64 * j] = xr[64 * j] + g2 * s; }
    }
}

#ifndef MK_N_LAUNCHES
#define MK_N_LAUNCHES 1
#endif
constexpr int PER_PHASE = 12;
constexpr int N_LAUNCHES = MK_N_LAUNCHES;

__global__ void __launch_bounds__(NWAVES * 64, 2) hybrid_fwd(Args args) {
    extern __shared__ __attribute__((aligned(16))) unsigned char lds[];
    Frame F;
    F.lds = (LAS unsigned char*)lds; F.ldsg = (char*)lds;
    F.MISC = (volatile LAS unsigned*)(F.lds + MISC_OFF);
    F.tid = threadIdx.x; F.lane = F.tid & 63; F.wave = __builtin_amdgcn_readfirstlane(F.tid >> 6);
    F.G = gridDim.x; { const int bx = blockIdx.x; F.vcu = (F.G % 8 == 0) ? (bx % 8) * (F.G / 8) + bx / 8 : bx; }
    F.ws = args.ws; F.out = args.out;
    gu32* ctl = (gu32*)(args.ws + WS_CTL);
    for (int u = F.tid; u < (LDS_BYTES - LDSCTL_OFF) / 4; u += NWAVES * 64) ((LAS unsigned*)(F.lds + LDSCTL_OFF))[u] = 0u;
    __syncthreads();
    XcdBarrier bar; bar.bar = (unsigned*)(ctl + CW_BAR); bar.x = 0; bar.st = nullptr;
    if (N_LAUNCHES == 1) bar = xcd_barrier_post((unsigned*)(ctl + CW_BAR), F.MISC + 8);
    const int lo = args.ph_lo, hi = args.ph_hi;
#ifndef PHASE_MASK
#define PHASE_MASK 0xFFF
#endif
#define IN(k) (((PHASE_MASK >> (k)) & 1) && lo <= (k) && (k) < hi)
#define SEAM(k) do { if (IN(k) && IN((k) + 1)) xcd_barrier(bar); } while (0)

    if (IN(0)) { p0_prologue(F, args); } SEAM(0);
    if (IN(1)) { p1_hrows(F, args); } SEAM(1);
    if (IN(2)) {
        pg8::Gemm g{WSP(bf16, WS_HB), WSP(bf16, WS_WIN), NTOK, DIN, DM}; pg8::TileOrder S; S.init(NTOK / 256, DIN / 256, F.G, (int)blockIdx.x, nullptr);
        pg8::EpiWin E{WSP(bf16, WS_E), IN_F(17)};
        pg8::gemm_phase<pg8::EpiWin, pg8::TileOrder, true, true>(F.lds + RING_OFF, g, S, E);
    } SEAM(2);
    if (IN(3)) {
        for (int u = F.vcu; u < 512; u += F.G) p3_rnn_local_unit(F, args, u);
        for (int u = F.vcu; u < 512; u += F.G) p3_knorm_unit(F, args, u);
    } SEAM(3);
    if (IN(4)) {
        for (int it = F.vcu; it < 256; it += F.G) { const int bh = it >> 3, s = it & 7;
            att::attn_unit(F, args, bh >> 3, bh & 7, 15 - s);
            att::attn_unit(F, args, bh >> 3, bh & 7, s); }
        for (int u = F.vcu; u < 512; u += F.G) p4_rnn_final_unit(F, args, u);
    } SEAM(4);
    if (IN(5)) {
        { pg8::Gemm g{WSP(bf16, WS_YRNN), WSP(bf16, WS_WB), NTOK, DM, DM}; pg8::TileOrder S; S.init(NTOK / 256, DM / 256, F.G, (int)blockIdx.x, nullptr);
          pg8::EpiBranch<0> E{WSP(bf16, WS_E) + 5 * E_STRIDE, WSP(float, WS_T0), nullptr};
          pg8::gemm_phase<pg8::EpiBranch<0>, pg8::TileOrder, false, true>(F.lds + RING_OFF, g, S, E); }
        { pg8::Gemm g{WSP(bf16, WS_YATT), WSP(bf16, WS_WB) + 1048576, NTOK, DM, DM}; pg8::TileOrder S; S.init(NTOK / 256, DM / 256, F.G, (int)blockIdx.x, nullptr);
          pg8::EpiBranch<1> E{WSP(bf16, WS_E) + 6 * E_STRIDE, WSP(float, WS_T0), WSP(bf16, WS_HB)};
          pg8::gemm_phase<pg8::EpiBranch<1>, pg8::TileOrder, false, true>(F.lds + RING_OFF, g, S, E); }
    } SEAM(5);
    if (IN(6)) {
        pg8::Gemm g{WSP(bf16, WS_HB), WSP(bf16, WS_WO), NTOK, DM, DM}; pg8::TileOrder S; S.init(NTOK / 256, DM / 256, F.G, (int)blockIdx.x, nullptr);
        pg8::EpiWout E{IN_F(0), F.out, WSP(float, WS_MOD)};
        pg8::gemm_phase<pg8::EpiWout, pg8::TileOrder, false, true>(F.lds + RING_OFF, g, S, E);
    } SEAM(6);
    if (IN(7)) { p7_router(F, args); } SEAM(7);
    if (IN(8)) { p8_scatter(F, args); } SEAM(8);
    if (IN(9)) {
        int nblk = __builtin_amdgcn_readfirstlane(__hip_atomic_load(WSP(int, WS_BLKEXP) + 511, RLX_AGENT)); if (nblk > MAXBLK) nblk = MAXBLK; if (nblk < 1) nblk = 1;
        pg8::Gemm g{WSP(bf16, WS_XG), WSP(bf16, WS_WUP), RMAX, 2048 * NEXP, DM}; pg8::TileOrder S; S.init(nblk, 8, F.G, (int)blockIdx.x, WSP(int, WS_BLKEXP));
        pg8::EpiUp E{WSP(bf16, WS_ACT), IN_F(23)};
        pg8::gemm_phase<pg8::EpiUp, pg8::TileOrder, true, true>(F.lds + RING_OFF, g, S, E);
    } SEAM(9);
    if (IN(10)) {
        int nblk = __builtin_amdgcn_readfirstlane(__hip_atomic_load(WSP(int, WS_BLKEXP) + 511, RLX_AGENT)); if (nblk > MAXBLK) nblk = MAXBLK; if (nblk < 1) nblk = 1;
        pg8::Gemm g{WSP(bf16, WS_ACT), WSP(bf16, WS_WDN), RMAX, 1024 * NEXP, DM}; pg8::TileOrder S; S.init(nblk, 4, F.G, (int)blockIdx.x, WSP(int, WS_BLKEXP));
        pg8::EpiDown E{WSP(bf16, WS_YR), IN_F(25), WSP(float, WS_ROWGATE)};
        pg8::gemm_phase<pg8::EpiDown, pg8::TileOrder, true, true>(F.lds + RING_OFF, g, S, E);
    } SEAM(10);
    if (IN(11)) { p11_combine(F, args); }
#undef IN
#undef SEAM
}

extern "C" void kernel_launch(void* const* d_in, const int* in_sizes, int n_in, void* d_out, int out_size, void* d_ws, size_t ws_size, hipStream_t stream) {
    static int grid = 0;
    if (grid == 0) {
        if (n_in != 26 || in_sizes[0] != NTOK * DM || out_size != NTOK * DM || ws_size < WS_END) {
            fprintf(stderr, "kernel_launch: shape/workspace mismatch (n_in %d, in0 %d, out %d, ws %zu; need ws >= %zu); nothing launched\n", n_in, n_in > 0 ? in_sizes[0] : -1, out_size, ws_size, (size_t)WS_END); grid = -1; return; }
        int dev = 0, cus = 0, per_cu = 0;
        if (hipGetDevice(&dev) != hipSuccess || hipDeviceGetAttribute(&cus, hipDeviceAttributeMultiprocessorCount, dev) != hipSuccess) { fprintf(stderr, "kernel_launch: device query failed\n"); grid = -1; return; }
        if (hipFuncSetAttribute((const void*)hybrid_fwd, hipFuncAttributeMaxDynamicSharedMemorySize, LDS_BYTES) != hipSuccess) { fprintf(stderr, "kernel_launch: hipFuncSetAttribute failed\n"); grid = -1; return; }
        if (hipOccupancyMaxActiveBlocksPerMultiprocessor(&per_cu, (const void*)hybrid_fwd, NWAVES * 64, LDS_BYTES) != hipSuccess || per_cu < 1) { fprintf(stderr, "kernel_launch: occupancy query says %d blocks/CU\n", per_cu); per_cu = 1; }
        (void)hipGetLastError();
        grid = cus;
        if (grid > 256) grid = 256;
    }
    if (grid < 0) return;
    (void)hipMemsetAsync((char*)d_ws + WS_CTL, 0, CTL_ZERO_BYTES, stream);
    Args a{};
    for (int i = 0; i < 26; ++i) a.in[i] = d_in[i];
    a.out = (float*)d_out; a.ws = (unsigned char*)d_ws;
    for (int li = 0; li < N_LAUNCHES; ++li) {
        a.ph_lo = (N_LAUNCHES == 1) ? 0 : li; a.ph_hi = (N_LAUNCHES == 1) ? PER_PHASE : li + 1;
        hipLaunchKernelGGL(hybrid_fwd, dim3(grid), dim3(NWAVES * 64), LDS_BYTES, stream, a);
        const hipError_t le = hipPeekAtLastError();
        if (le != hipSuccess) { fprintf(stderr, "kernel_launch: launch %d failed: %s\n", li, hipGetErrorName(le)); break; }
    }
}
```

```cpp
#include <hip/hip_runtime.h>
#include <hip/hip_bf16.h>
#include <cstdio>
#include <cstdint>
#include <cmath>
namespace pg8 {
#define PG8_LAS __attribute__((address_space(3)))
typedef unsigned short bf16_t;
typedef short bf16x8 __attribute__((ext_vector_type(8)));
typedef float f32x4 __attribute__((ext_vector_type(4)));
typedef unsigned u32x4 __attribute__((ext_vector_type(4)));
constexpr int BM = 256, BK = 64, HALF = 128, HTB = HALF * BK * 2  , STAGE_BYTES = 8 * HTB, NXCD = 8, WGM = 8;

__host__ __device__ __forceinline__ int lds_byte(int r, int c) { const int st = (r >> 4) * 2 + (c >> 5), rr = r & 15, cc = c & 31, ob = rr * 64 + cc * 2; return st * 1024 + (ob ^ (((ob >> 9) & 1) << 5)); }
__host__ __device__ __forceinline__ void stage_rc(int b, int& R, int& C) { const int st = b / 1024, sb = b % 1024, swz = sb ^ (((sb >> 9) & 1) << 5); R = (st >> 1) * 16 + swz / 64; C = (st & 1) * 32 + (swz % 64) / 2; }
__host__ __device__ __forceinline__ int perm32(int rho) { const int n = rho >> 4, i = rho & 15; return 8 * (i >> 2) + 4 * n + (i & 3); }

struct Unit { int pm, pn; };
struct Gemm { const bf16_t* A; const bf16_t* Bt; int M, N, K; };

struct StaticOrder {
    int nM, nN, nwg, G, c;
    __host__ __device__ void init(int M, int N, int G_, int c_) { nM = M / BM; nN = N / BM; nwg = nM * nN; G = G_; c = c_; }
    __host__ __device__ bool next(int i, Unit& u) const {
        const long L = (long)i * G + c; if (L >= nwg) return false;
        int wgid = (int)L; { const int q = nwg / NXCD, r = nwg % NXCD, xcd = wgid % NXCD, off = wgid / NXCD; wgid = (xcd < r ? xcd * (q + 1) : r * (q + 1) + (xcd - r) * q) + off; }
        const int nig = WGM * nN, gid = wgid / nig, fm = gid * WGM, gsz = (nM - fm) < WGM ? (nM - fm) : WGM;
        u.pm = fm + ((wgid % nig) % gsz); u.pn = (wgid % nig) / gsz; return true;
    }
    __device__ __forceinline__ void a_ready(const Unit&) const {}
    __device__ __forceinline__ void done(const Unit&) const {}
};

__device__ __forceinline__ unsigned cvt_pk_bf16(float lo, float hi) { unsigned r; asm volatile("v_cvt_pk_bf16_f32 %0, %1, %2" : "=v"(r) : "v"(lo), "v"(hi)); return r; }
template <class Epi, class Sched, bool ALIGN_EPI = false, bool SP2 = false, bool GATHER = false>
__device__ __forceinline__ void gemm_phase(PG8_LAS unsigned char* lds, const Gemm g, const Sched& S, const Epi& E, const PG8_LAS int* rowlists = nullptr) {
    static_assert(!GATHER || SP2, "GATHER is implemented for the SP2 loop");
    const int tid = threadIdx.x, wid = __builtin_amdgcn_readfirstlane(tid >> 6), lane = tid & 63, wr = wid >> 2, wc = wid & 3, fr = lane & 15, fq = lane >> 4;
    const int K = g.K, nt = K / BK;
    unsigned voffA[2], voffB[2]; int gR[2], gC[2];
#pragma unroll
    for (int i = 0; i < 2; ++i) { int R, C; stage_rc(tid * 16 + i * 8192, R, C); const int Rb = Epi::PERM ? ((R & ~31) + perm32(R & 31)) : R; gR[i] = R; gC[i] = C;
        voffA[i] = (unsigned)(R * K + C) * 2u; voffB[i] = (unsigned)(Rb * K + C) * 2u; }
    unsigned vC0[2], vC1[2], vN0[2], vN1[2];
#define PG8_ROWOFFS(d0, d1, ui_) do { _Pragma("unroll") for (int i_ = 0; i_ < 2; ++i_) { \
        d0[i_] = (unsigned)(rowlists[(ui_) * 256 + gR[i_]] * K + gC[i_]) * 2u; d1[i_] = (unsigned)(rowlists[(ui_) * 256 + HALF + gR[i_]] * K + gC[i_]) * 2u; } } while (0)
    const size_t kstep = (size_t)(BK * 2);
    const size_t hstep = (size_t)HALF * K * 2;
    const size_t tstep = 2 * hstep;
    const unsigned ldsw = (unsigned)wid * 1024u;
    const int aoff = lds_byte(wr * 64 + fr, fq * 8), boff = lds_byte(wc * 32 + fr, fq * 8);
#define PG8_SA(b, h) (((b) * 2 + (h)) * HTB)
#define PG8_SB(b, h) ((4 + (b) * 2 + (h)) * HTB)
#define PG8_STAGE(bufoff, gbase, voff) do { _Pragma("unroll") for (int _i = 0; _i < 2; ++_i) \
        __builtin_amdgcn_global_load_lds((const unsigned*)((const char*)(gbase) + (voff)[_i]), (PG8_LAS unsigned*)(lds + (bufoff) + ldsw + _i * 8192), 16, 0, 0); } while (0)
#define PG8_LDA(dst, b, h) do { _Pragma("unroll") for (int m = 0; m < 4; ++m) _Pragma("unroll") for (int k = 0; k < 2; ++k) dst[m][k] = *(const PG8_LAS bf16x8*)(lds + PG8_SA(b, h) + aoff + m * 2048 + k * 1024); } while (0)
#define PG8_LDB(dst, b, h) do { _Pragma("unroll") for (int n = 0; n < 2; ++n) _Pragma("unroll") for (int k = 0; k < 2; ++k) dst[n][k] = *(const PG8_LAS bf16x8*)(lds + PG8_SB(b, h) + boff + n * 2048 + k * 1024); } while (0)
#define PG8_MMA(ai, bj, At, Bt) do { __builtin_amdgcn_s_setprio(1); _Pragma("unroll") for (int m = 0; m < 4; ++m) _Pragma("unroll") for (int n = 0; n < 2; ++n) _Pragma("unroll") for (int k = 0; k < 2; ++k) \
        acc[ai][bj][m][n] = __builtin_amdgcn_mfma_f32_16x16x32_bf16(Bt[n][k], At[m][k], acc[ai][bj][m][n], 0, 0, 0); __builtin_amdgcn_s_setprio(0); } while (0)
#define PG8_WAIT_V(n) asm volatile("s_waitcnt vmcnt(" #n ")" ::: "memory")
#define PG8_WAIT_L(n) asm volatile("s_waitcnt lgkmcnt(" #n ")" ::: "memory")
#define PG8_BAR __builtin_amdgcn_s_barrier()
#define PG8_SCHED __builtin_amdgcn_sched_barrier(0)
    Unit cur, nxt; int ui = 0;
    if (!S.next(0, cur)) return;
    f32x4 acc[2][2][4][2];
#pragma unroll
    for (int a = 0; a < 2; ++a)
#pragma unroll
        for (int b = 0; b < 2; ++b)
#pragma unroll
            for (int m = 0; m < 4; ++m)
#pragma unroll
                for (int n = 0; n < 2; ++n) acc[a][b][m][n] = (f32x4){0.f, 0.f, 0.f, 0.f};
    bf16x8 At[4][2], B0[2][2], B1[2][2];
    const char* cA = GATHER ? (const char*)g.A : (const char*)g.A + (size_t)cur.pm * tstep; const char* cB = (const char*)g.Bt + (size_t)cur.pn * tstep;
    if constexpr (GATHER) { PG8_ROWOFFS(vC0, vC1, 0); vN0[0] = vC0[0]; vN0[1] = vC0[1]; vN1[0] = vC1[0]; vN1[1] = vC1[1]; }
#define PG8_STAGE_A(bufoff, kptr, half, v0, v1) do { if constexpr (GATHER) { if ((half) == 0) PG8_STAGE(bufoff, kptr, v0); else PG8_STAGE(bufoff, kptr, v1); } \
        else { PG8_STAGE(bufoff, (kptr) + (half) * hstep, voffA); } } while (0)
    S.a_ready(cur);
    if constexpr (SP2) {
        PG8_STAGE(PG8_SB(0, 0), cB, voffB); PG8_STAGE(PG8_SB(0, 1), cB + hstep, voffB); PG8_STAGE_A(PG8_SA(0, 0), cA, 0, vC0, vC1); PG8_STAGE_A(PG8_SA(0, 1), cA, 1, vC0, vC1);
        if (wr == 1) PG8_BAR;
        PG8_WAIT_V(2); PG8_BAR;
        PG8_STAGE(PG8_SB(1, 0), cB + kstep, voffB); PG8_STAGE_A(PG8_SA(1, 0), cA + kstep, 0, vC0, vC1); PG8_STAGE(PG8_SB(1, 1), cB + hstep + kstep, voffB);
        PG8_WAIT_V(6); PG8_BAR;
    } else {
        PG8_STAGE(PG8_SB(0, 0), cB, voffB); PG8_STAGE(PG8_SA(0, 0), cA, voffA); PG8_STAGE(PG8_SB(0, 1), cB + hstep, voffB); PG8_STAGE(PG8_SA(0, 1), cA + hstep, voffA);
        if (wr == 1) PG8_BAR;
        PG8_WAIT_V(4); PG8_BAR;
        PG8_STAGE(PG8_SB(1, 0), cB + kstep, voffB); PG8_STAGE(PG8_SA(1, 0), cA + kstep, voffA); PG8_STAGE(PG8_SB(1, 1), cB + hstep + kstep, voffB);
        PG8_WAIT_V(6); PG8_BAR;
    }
    for (;;) {
        const bool has_next = S.next(ui + 1, nxt);
        const char* nA = GATHER ? cA : (has_next ? (const char*)g.A + (size_t)nxt.pm * tstep : cA);
        if constexpr (GATHER) { if (has_next) { PG8_ROWOFFS(vN0, vN1, ui + 1); } else { vN0[0] = vC0[0]; vN0[1] = vC0[1]; vN1[0] = vC1[0]; vN1[1] = vC1[1]; } } const char* nB = has_next ? (const char*)g.Bt + (size_t)nxt.pn * tstep : cB;
        for (int t = 0; t < nt; t += 2) {
            const bool last = (t == nt - 2);
            const char* a1 = cA + (size_t)(t + 1) * kstep;
            const char* a2 = last ? nA : cA + (size_t)(t + 2) * kstep; const char* b2 = last ? nB : cB + (size_t)(t + 2) * kstep;
            const char* a3 = a2 + kstep; const char* b3 = b2 + kstep;
            if (last && has_next) S.a_ready(nxt);
            unsigned vS0[2], vS1[2];
            if constexpr (GATHER) { vS0[0] = last ? vN0[0] : vC0[0]; vS0[1] = last ? vN0[1] : vC0[1]; vS1[0] = last ? vN1[0] : vC1[0]; vS1[1] = last ? vN1[1] : vC1[1]; }
            if constexpr (SP2) {
            PG8_LDB(B0, 0, 0); PG8_LDB(B1, 0, 1); PG8_SCHED; PG8_LDA(At, 0, 0); PG8_STAGE_A(PG8_SA(1, 1), a1, 1, vC0, vC1);
            PG8_WAIT_V(8); PG8_WAIT_L(0); PG8_BAR; PG8_MMA(0, 0, At, B0); PG8_MMA(0, 1, At, B1); PG8_BAR; PG8_SCHED;
            PG8_LDA(At, 0, 1); PG8_STAGE(PG8_SB(0, 0), b2, voffB); PG8_STAGE(PG8_SB(0, 1), b2 + hstep, voffB); PG8_STAGE_A(PG8_SA(0, 0), a2, 0, vS0, vS1);
            PG8_WAIT_V(8); PG8_WAIT_L(0); PG8_BAR; PG8_MMA(1, 0, At, B0); PG8_MMA(1, 1, At, B1); PG8_BAR; PG8_SCHED;
            PG8_LDB(B0, 1, 0); PG8_LDB(B1, 1, 1); PG8_SCHED; PG8_LDA(At, 1, 0); PG8_STAGE_A(PG8_SA(0, 1), a2, 1, vS0, vS1);
            PG8_WAIT_V(8); PG8_WAIT_L(0); PG8_BAR; PG8_MMA(0, 0, At, B0); PG8_MMA(0, 1, At, B1); PG8_BAR; PG8_SCHED;
            PG8_LDA(At, 1, 1); PG8_STAGE(PG8_SB(1, 0), b3, voffB); PG8_STAGE(PG8_SB(1, 1), b3 + hstep, voffB); PG8_STAGE_A(PG8_SA(1, 0), a3, 0, vS0, vS1);
            PG8_WAIT_V(8); PG8_WAIT_L(0); PG8_BAR; PG8_MMA(1, 0, At, B0); PG8_MMA(1, 1, At, B1); PG8_BAR; PG8_SCHED;
            } else {
            PG8_LDB(B0, 0, 0); PG8_SCHED; PG8_LDA(At, 0, 0); PG8_STAGE(PG8_SA(1, 1), a1 + hstep, voffA);
            PG8_WAIT_L(8); PG8_BAR; PG8_WAIT_L(0); PG8_MMA(0, 0, At, B0); PG8_BAR; PG8_SCHED;
            PG8_LDB(B1, 0, 1); PG8_STAGE(PG8_SB(0, 0), b2, voffB);
            PG8_BAR; PG8_WAIT_L(0); PG8_MMA(0, 1, At, B1); PG8_BAR;
            PG8_LDA(At, 0, 1); PG8_STAGE(PG8_SA(0, 0), a2, voffA);
            PG8_BAR; PG8_WAIT_L(0); PG8_MMA(1, 0, At, B0); PG8_BAR; PG8_SCHED;
            PG8_STAGE(PG8_SB(0, 1), b2 + hstep, voffB);
            PG8_WAIT_V(6); PG8_BAR; PG8_MMA(1, 1, At, B1); PG8_BAR;
            PG8_LDB(B0, 1, 0); PG8_SCHED; PG8_LDA(At, 1, 0); PG8_STAGE(PG8_SA(0, 1), a2 + hstep, voffA);
            PG8_WAIT_L(8); PG8_BAR; PG8_WAIT_L(0); PG8_MMA(0, 0, At, B0); PG8_BAR; PG8_SCHED;
            PG8_LDB(B1, 1, 1); PG8_STAGE(PG8_SB(1, 0), b3, voffB);
            PG8_BAR; PG8_WAIT_L(0); PG8_MMA(0, 1, At, B1); PG8_BAR;
            PG8_LDA(At, 1, 1); PG8_STAGE(PG8_SA(1, 0), a3, voffA);
            PG8_BAR; PG8_WAIT_L(0); PG8_MMA(1, 0, At, B0); PG8_BAR; PG8_SCHED;
            PG8_STAGE(PG8_SB(1, 1), b3 + hstep, voffB);
            PG8_WAIT_V(6); PG8_BAR; PG8_MMA(1, 1, At, B1); PG8_BAR;
            }
        }
        if constexpr (ALIGN_EPI) { if (wr == 0) PG8_BAR; }
        if constexpr (!Epi::AFTER_DRAIN) { E(acc, cur, wr, wc, fr, fq); S.done(cur); }
        if (!has_next) break;
#pragma unroll
        for (int a = 0; a < 2; ++a)
#pragma unroll
            for (int b = 0; b < 2; ++b)
#pragma unroll
                for (int m = 0; m < 4; ++m)
#pragma unroll
                    for (int n = 0; n < 2; ++n) acc[a][b][m][n] = (f32x4){0.f, 0.f, 0.f, 0.f};
        cur = nxt; cA = nA; cB = nB; ++ui;
        if constexpr (GATHER) { vC0[0] = vN0[0]; vC0[1] = vN0[1]; vC1[0] = vN1[0]; vC1[1] = vN1[1]; }
        if constexpr (ALIGN_EPI) { if (wr == 1) PG8_BAR; }
    }
    PG8_WAIT_V(0);
    if constexpr (!ALIGN_EPI) { if (wr == 0) PG8_BAR; }
    PG8_BAR;
    if constexpr (Epi::AFTER_DRAIN) { E.fused(acc, cur, wr, wc, fr, fq, lds, wid, lane); S.done(cur); }
#undef PG8_SA
#undef PG8_STAGE_A
#undef PG8_ROWOFFS
#undef PG8_SB
#undef PG8_STAGE
#undef PG8_LDA
#undef PG8_LDB
#undef PG8_MMA
#undef PG8_WAIT_V
#undef PG8_WAIT_L
#undef PG8_BAR
#undef PG8_SCHED
}
}

constexpr int NB = 4, SEQ = 4096, DM = 1024, NTOK = NB * SEQ, DIN = 7168, NH = 8, HD = 128;
constexpr int NEXP = 32, TOPK = 4, MAXBLK = 288, RMAX = MAXBLK * 256;
constexpr float EPS = 1e-6f;
constexpr int NWAVES = 8;

constexpr size_t MiB = 1u << 20, KiB = 1u << 10;
constexpr size_t WS_CTL = 0, CTL_ZERO_BYTES = 1 * MiB;
constexpr size_t WS_MOD = 1 * MiB;
constexpr size_t WS_KMEAN = 1 * MiB + 128 * KiB;
constexpr size_t WS_AGGP = 1 * MiB + 384 * KiB;
constexpr size_t WS_AGGH = 1 * MiB + 640 * KiB;
constexpr size_t WS_WRH = 2 * MiB, WS_WRL = 2 * MiB + 64 * KiB;
constexpr size_t WS_TOKE = 3 * MiB, WS_TOKPOS = 3 * MiB + 256 * KiB;
constexpr int ECAP = 16384;
constexpr size_t WS_ROWTOK = 28 * MiB, WS_ROWGATE = 30 * MiB;
constexpr int CW_CNT = 8192;
constexpr size_t WS_TRIG = 4 * MiB;
constexpr size_t WS_WRG = 6 * MiB;
constexpr size_t WS_WIN = 8 * MiB;
constexpr size_t WS_WB = 22 * MiB;
constexpr size_t WS_WO = 26 * MiB;
constexpr size_t WS_WUP = 32 * MiB;
constexpr size_t WS_WDN = 160 * MiB;
constexpr size_t WS_HB = 224 * MiB;
constexpr size_t WS_E = 256 * MiB;
constexpr size_t E_STRIDE = (size_t)NTOK * DM;
constexpr size_t WS_HL = 480 * MiB, WS_PP = 512 * MiB, WS_YRNN = 544 * MiB, WS_YATT = 576 * MiB;
constexpr size_t WS_T0 = WS_E;
constexpr size_t WS_ACT = 400 * MiB, WS_YR = 544 * MiB;
constexpr size_t WS_END = 688 * MiB;
constexpr int CW_BAR = 4096;

constexpr int RING_OFF = 0, RING_BYTES = 131072;
constexpr int LDSCTL_OFF = RING_BYTES, MISC_OFF = LDSCTL_OFF + 320;
constexpr int XTRA_OFF = LDSCTL_OFF + 1024;
constexpr int LDS_BYTES = 147456;

#define GAS __attribute__((address_space(1)))
#define LAS __attribute__((address_space(3)))
typedef unsigned short bf16;
typedef unsigned v4u __attribute__((ext_vector_type(4)));
typedef unsigned v2u __attribute__((ext_vector_type(2)));
typedef float f32x4 __attribute__((ext_vector_type(4)));
typedef float f32x2 __attribute__((ext_vector_type(2)));
typedef float f32x16 __attribute__((ext_vector_type(16)));
typedef short bf16x8 __attribute__((ext_vector_type(8)));
typedef short s16x4 __attribute__((ext_vector_type(4)));
typedef GAS unsigned gu32;
#define RLX_AGENT __ATOMIC_RELAXED, __HIP_MEMORY_SCOPE_AGENT
#define LDS_WAIT() asm volatile("s_waitcnt lgkmcnt(0)" ::: "memory")
#define VM_WAIT() asm volatile("s_waitcnt vmcnt(0)" ::: "memory")
#define SBAR() __builtin_amdgcn_sched_barrier(0)
__device__ __forceinline__ unsigned f2bf(float f) { unsigned u = __builtin_bit_cast(unsigned, f); return (u + 0x7fffu + ((u >> 16) & 1u)) >> 16; }
__device__ __forceinline__ unsigned pk2(float lo, float hi) { return f2bf(lo) | (f2bf(hi) << 16); }
__device__ __forceinline__ float bf2f(unsigned short h) { return __builtin_bit_cast(float, (unsigned)h << 16); }
__device__ __forceinline__ float bflo(unsigned w) { return __builtin_bit_cast(float, w << 16); }
__device__ __forceinline__ float bfhi(unsigned w) { return __builtin_bit_cast(float, w & 0xffff0000u); }
__device__ __forceinline__ unsigned cvtpk(float lo, float hi) { unsigned r; asm volatile("v_cvt_pk_bf16_f32 %0, %1, %2" : "=v"(r) : "v"(lo), "v"(hi)); return r; }
__device__ __forceinline__ float fast_sigmoid(float x) { return __builtin_amdgcn_rcpf(1.0f + __builtin_amdgcn_exp2f(-1.4426950408889634f * x)); }
__device__ __forceinline__ float gelu_tanh(float x) { const float z = 1.5957691216057308f * (x + 0.044715f * x * x * x); return x * fast_sigmoid(z); }
__device__ __forceinline__ float wave_sum(float v) {
#pragma unroll
    for (int o = 1; o < 64; o <<= 1) v += __shfl_xor(v, o);
    return v;
}
__device__ __forceinline__ float wave_max(float v) {
#pragma unroll
    for (int o = 1; o < 64; o <<= 1) v = fmaxf(v, __shfl_xor(v, o));
    return v;
}

#define XB_TMO      128
#define XB_XCNT(j)  (256  + 64 * (j))
#define XB_XSUB(j)  (1280 + 64 * (j))
#define XB_XGEN(j)  (2304 + 64 * (j))
#define XB_TOP      3328
#define XB_TOPGEN   3392
#define XCD_BAR_WORDS 3456
#define XB_SPIN_CAP (1u << 20)
__device__ __forceinline__ unsigned xb_ld(unsigned* p)              { return __hip_atomic_load(p, __ATOMIC_RELAXED, __HIP_MEMORY_SCOPE_AGENT); }
__device__ __forceinline__ unsigned xb_add(unsigned* p, unsigned v) { return __hip_atomic_fetch_add(p, v, __ATOMIC_RELAXED, __HIP_MEMORY_SCOPE_AGENT); }
__device__ __forceinline__ unsigned xb_xcc_id() { return (unsigned)__builtin_amdgcn_s_getreg((3 << 11) | 20) & 0xFu; }
#define XB_SPIN(cond, bar) do { unsigned _sp = 0; while (cond) { __builtin_amdgcn_s_sleep(1); \
    if ((++_sp & 255u) == 0u) { if (xb_ld(&(bar)[XB_TMO])) break; if (_sp > XB_SPIN_CAP) { atomicAdd(&(bar)[XB_TMO], 1u); break; } } } } while (0)
struct XcdBarrier { unsigned* bar; unsigned x; volatile LAS unsigned* st; };
__device__ __forceinline__ XcdBarrier xcd_barrier_post(unsigned* bar, volatile LAS unsigned* st) {
    XcdBarrier b; b.bar = bar; b.x = xb_xcc_id(); b.st = st;
    if (threadIdx.x == 0) (void)xb_add(&bar[XB_XCNT(b.x)], 1u);
    return b;
}
__device__ __forceinline__ void xcd_barrier_complete(unsigned* bar, unsigned x, unsigned& nloc, unsigned& nx) {
    const unsigned G = gridDim.x * gridDim.y * gridDim.z;
    unsigned sum, cnt, mine, sp = 0u;
    for (;;) {
        sum = 0u; cnt = 0u; mine = 0u;
#pragma unroll
        for (unsigned j = 0; j < 16; ++j) { const unsigned c = xb_ld(&bar[XB_XCNT(j)]); sum += c; cnt += (c > 0u) ? 1u : 0u; mine = (j == x) ? c : mine; }
        if (sum == G) break;
        __builtin_amdgcn_s_sleep(1);
        if ((++sp & 255u) == 0u) { if (xb_ld(&bar[XB_TMO])) break; if (sp > XB_SPIN_CAP) { atomicAdd(&bar[XB_TMO], 1u); break; } }
    }
    nloc = mine > 0u ? mine : 1u; nx = cnt > 0u ? cnt : 1u;
}
__device__ __forceinline__ void xcd_barrier(const XcdBarrier& b) {
    asm volatile("s_waitcnt vmcnt(0)" ::: "memory");
    __syncthreads();
    if (threadIdx.x == 0) {
        unsigned* bar = b.bar;
        __builtin_amdgcn_s_waitcnt(0);
        unsigned nloc = b.st[0], nx = b.st[1];
        if (nloc == 0u) { xcd_barrier_complete(bar, b.x, nloc, nx); b.st[0] = nloc; b.st[1] = nx; }
        const unsigned old = xb_add(&bar[XB_XSUB(b.x)], 1u);
        const unsigned gen = old / nloc;
        if (old + 1u == (gen + 1u) * nloc) {
            __builtin_amdgcn_fence(__ATOMIC_RELEASE, "agent");
            asm volatile("s_waitcnt vmcnt(0)" ::: "memory");
            const unsigned og = xb_add(&bar[XB_TOP], 1u);
            const unsigned tg = og / nx;
            if (og + 1u == (tg + 1u) * nx) xb_add(&bar[XB_TOPGEN], 1u);
            else XB_SPIN(xb_ld(&bar[XB_TOPGEN]) == tg, bar);
            __builtin_amdgcn_fence(__ATOMIC_ACQUIRE, "agent");
            xb_add(&bar[XB_XGEN(b.x)], 1u);
            asm volatile("s_waitcnt vmcnt(0)" ::: "memory");
        } else {
            XB_SPIN(xb_ld(&bar[XB_XGEN(b.x)]) == gen, bar);
            __builtin_amdgcn_fence(__ATOMIC_ACQUIRE, "agent");
            asm volatile("s_waitcnt vmcnt(0)" ::: "memory");
        }
    }
    __syncthreads();
}

struct Args { const void* in[26]; float* out; unsigned char* ws; int ph_lo, ph_hi; };
struct Frame {
    LAS unsigned char* lds; char* ldsg;
    volatile LAS unsigned* MISC;
    int tid, lane, wave, vcu, G;
    unsigned char* ws; float* out;
};
#define IN_F(k) ((const float*)args.in[k])
#define IN_I(k) ((const int*)args.in[k])
#define WSP(T, off) ((T*)(F.ws + (off)))

namespace pg8 {
struct TileOrder {
    int nM, nN, nwg, G, c; const LAS int* blk_exp;
    __device__ void init(int nM_, int nN_, int G_, int c_, const LAS int* be) { nM = nM_; nN = nN_; nwg = nM * nN; G = G_; c = c_; blk_exp = be; }
    __device__ bool next(int i, Unit& u) const {
        const long L = (long)i * G + c; if (L >= nwg) return false;
        int wgid = (int)L; { const int q = nwg / NXCD, r = nwg % NXCD, xcd = wgid % NXCD, off = wgid / NXCD; wgid = (xcd < r ? xcd * (q + 1) : r * (q + 1) + (xcd - r) * q) + off; }
        const int nig = WGM * nN, gid = wgid / nig, fm = gid * WGM, gsz = (nM - fm) < WGM ? (nM - fm) : WGM;
        u.pm = fm + ((wgid % nig) % gsz); u.pn = (wgid % nig) / gsz;
        if (blk_exp) { const int e = __builtin_amdgcn_readfirstlane(blk_exp[u.pm]); u.pn += e * nN; }
        return true;
    }
    __device__ __forceinline__ void a_ready(const Unit&) const {}
    __device__ __forceinline__ void done(const Unit&) const {}
};

struct EpiWin {
    static constexpr bool PERM = true, AFTER_DRAIN = false;
    bf16_t* E; const float* b_gate;
    __device__ __forceinline__ void operator()(const f32x4 (&acc)[2][2][4][2], const Unit& u, int wr, int wc, int fr, int fq) const {
        const int t = u.pn >> 2, colt = (u.pn & 3) * BM;
        bf16_t* base = E + (size_t)t * ((size_t)16384 * 1024);
        const int row0 = u.pm * BM + wr * 64 + fr, col0 = colt + wc * 32 + 8 * fq;
        f32x4 bv[2][2];
#pragma unroll
        for (int bj = 0; bj < 2; ++bj)
#pragma unroll
            for (int n = 0; n < 2; ++n) bv[bj][n] = (t >= 5) ? *(const f32x4*)(b_gate + (t - 5) * 1024 + col0 + bj * HALF + 4 * n) : (f32x4){0.f, 0.f, 0.f, 0.f};
#pragma unroll
        for (int ai = 0; ai < 2; ++ai)
#pragma unroll
            for (int m = 0; m < 4; ++m) { bf16_t* rowp = base + (size_t)(row0 + ai * HALF + m * 16) * 1024 + col0;
#pragma unroll
                for (int bj = 0; bj < 2; ++bj) { f32x4 v0 = acc[ai][bj][m][0] + bv[bj][0], v1 = acc[ai][bj][m][1] + bv[bj][1];
                    if (t == 1) {
#pragma unroll
                        for (int j = 0; j < 4; ++j) { v0[j] = gelu_tanh(v0[j]); v1[j] = gelu_tanh(v1[j]); } }
                    else if (t >= 5) {
#pragma unroll
                        for (int j = 0; j < 4; ++j) { v0[j] = fast_sigmoid(v0[j]); v1[j] = fast_sigmoid(v1[j]); } }
                    u32x4 w; w.x = cvt_pk_bf16(v0[0], v0[1]); w.y = cvt_pk_bf16(v0[2], v0[3]); w.z = cvt_pk_bf16(v1[0], v1[1]); w.w = cvt_pk_bf16(v1[2], v1[3]);
                    *(u32x4*)(rowp + bj * HALF) = w; } }
    }
};
template <int PART> struct EpiBranch {
    static constexpr bool PERM = true, AFTER_DRAIN = false;
    const bf16_t* SG; float* T0; bf16_t* MIX;
    __device__ __forceinline__ void operator()(const f32x4 (&acc)[2][2][4][2], const Unit& u, int wr, int wc, int fr, int fq) const {
        const int row0 = u.pm * BM + wr * 64 + fr, col0 = u.pn * BM + wc * 32 + 8 * fq;
#pragma unroll
        for (int ai = 0; ai < 2; ++ai)
#pragma unroll
            for (int m = 0; m < 4; ++m) { const size_t ro = (size_t)(row0 + ai * HALF + m * 16) * 1024 + col0;
#pragma unroll
                for (int bj = 0; bj < 2; ++bj) { const size_t o = ro + bj * HALF;
                    const u32x4 g = *(const u32x4*)(SG + o);
                    f32x4 g0 = {bflo(g.x), bfhi(g.x), bflo(g.y), bfhi(g.y)}, g1 = {bflo(g.z), bfhi(g.z), bflo(g.w), bfhi(g.w)};
                    f32x4 v0 = acc[ai][bj][m][0] * g0, v1 = acc[ai][bj][m][1] * g1;
                    if (PART == 0) { *(f32x4*)(T0 + o) = v0; *(f32x4*)(T0 + o + 4) = v1; }
                    else { v0 += *(const f32x4*)(T0 + o); v1 += *(const f32x4*)(T0 + o + 4);
                        u32x4 w; w.x = cvt_pk_bf16(v0[0], v0[1]); w.y = cvt_pk_bf16(v0[2], v0[3]); w.z = cvt_pk_bf16(v1[0], v1[1]); w.w = cvt_pk_bf16(v1[2], v1[3]);
                        *(u32x4*)(MIX + o) = w; } } }
    }
};
struct EpiWout {
    static constexpr bool PERM = false, AFTER_DRAIN = false;
    const float* x; float* out; const float* mod;
    __device__ __forceinline__ void operator()(const f32x4 (&acc)[2][2][4][2], const Unit& u, int wr, int wc, int fr, int fq) const {
        const int row0 = u.pm * BM + wr * 64 + fr, col0 = u.pn * BM + wc * 32 + 4 * fq;
        const float* g1p = mod + (size_t)(u.pm >> 4) * 6144 + 2048;
        f32x4 gv[2][2];
#pragma unroll
        for (int bj = 0; bj < 2; ++bj)
#pragma unroll
            for (int n = 0; n < 2; ++n) gv[bj][n] = *(const f32x4*)(g1p + col0 + bj * HALF + n * 16);
#pragma unroll
        for (int ai = 0; ai < 2; ++ai)
#pragma unroll
            for (int m = 0; m < 4; ++m) { const size_t ro = (size_t)(row0 + ai * HALF + m * 16) * 1024 + col0;
#pragma unroll
                for (int bj = 0; bj < 2; ++bj)
#pragma unroll
                    for (int n = 0; n < 2; ++n) { const size_t o = ro + bj * HALF + n * 16; *(f32x4*)(out + o) = *(const f32x4*)(x + o) + gv[bj][n] * acc[ai][bj][m][n]; } }
    }
};
struct EpiUp {
    static constexpr bool PERM = true, AFTER_DRAIN = false;
    bf16_t* ACT; const float* b_up;
    __device__ __forceinline__ void operator()(const f32x4 (&acc)[2][2][4][2], const Unit& u, int wr, int wc, int fr, int fq) const {
        const int e = u.pn >> 3, p = u.pn & 7;
        const int row0 = u.pm * BM + wr * 64 + fr, c0 = p * 128 + wc * 32 + 8 * fq;
        const float* bg = b_up + (size_t)e * 2048 + c0; const float* bl = bg + 1024;
        f32x4 bgv[2], blv[2];
#pragma unroll
        for (int n = 0; n < 2; ++n) { bgv[n] = *(const f32x4*)(bg + 4 * n); blv[n] = *(const f32x4*)(bl + 4 * n); }
#pragma unroll
        for (int ai = 0; ai < 2; ++ai)
#pragma unroll
            for (int m = 0; m < 4; ++m) { bf16_t* rowp = ACT + (size_t)(row0 + ai * HALF + m * 16) * 1024 + c0;
                f32x4 a[2];
#pragma unroll
                for (int n = 0; n < 2; ++n) { const f32x4 g = acc[ai][0][m][n] + bgv[n], l = acc[ai][1][m][n] + blv[n];
#pragma unroll
                    for (int j = 0; j < 4; ++j) { const float gg = fminf(g[j], 7.0f), ll = fminf(fmaxf(l[j], -7.0f), 7.0f); a[n][j] = (ll + 1.0f) * gg * fast_sigmoid(1.702f * gg); } }
                u32x4 w; w.x = cvt_pk_bf16(a[0][0], a[0][1]); w.y = cvt_pk_bf16(a[0][2], a[0][3]); w.z = cvt_pk_bf16(a[1][0], a[1][1]); w.w = cvt_pk_bf16(a[1][2], a[1][3]);
                *(u32x4*)rowp = w; }
    }
};
struct EpiDown {
    static constexpr bool PERM = true, AFTER_DRAIN = false;
    bf16_t* YR; const float* b_down; const float* row_gate; const LAS int* tbl;
    __device__ __forceinline__ void operator()(const f32x4 (&acc)[2][2][4][2], const Unit& u, int wr, int wc, int fr, int fq) const {
        const int e = u.pn >> 2, p = u.pn & 3;
        const int row0 = u.pm * BM + wr * 64 + fr, c0 = p * BM + wc * 32 + 8 * fq;
        f32x4 bv[2][2];
#pragma unroll
        for (int bj = 0; bj < 2; ++bj)
#pragma unroll
            for (int n = 0; n < 2; ++n) bv[bj][n] = *(const f32x4*)(b_down + (size_t)e * 1024 + c0 + bj * HALF + 4 * n);
#pragma unroll
        for (int ai = 0; ai < 2; ++ai)
#pragma unroll
            for (int m = 0; m < 4; ++m) { const int r = row0 + ai * HALF + m * 16; const int pos = r - tbl[32 + e] * 256;
                const float gt = pos < tbl[e] ? __hip_atomic_load(row_gate + (size_t)e * 16384 + pos, __ATOMIC_RELAXED, __HIP_MEMORY_SCOPE_AGENT) : 0.0f;
                bf16_t* rowp = YR + (size_t)r * 1024 + c0;
#pragma unroll
                for (int bj = 0; bj < 2; ++bj) { const f32x4 v0 = (acc[ai][bj][m][0] + bv[bj][0]) * gt, v1 = (acc[ai][bj][m][1] + bv[bj][1]) * gt;
                    u32x4 w; w.x = cvt_pk_bf16(v0[0], v0[1]); w.y = cvt_pk_bf16(v0[2], v0[3]); w.z = cvt_pk_bf16(v1[0], v1[1]); w.w = cvt_pk_bf16(v1[2], v1[3]);
                    *(u32x4*)(rowp + bj * HALF) = w; } }
    }
};
}

__device__ __forceinline__ void p0_transpose_item(const float* W, int N, bf16* WT, int Kd, size_t dst_row0, LAS float* scr, int k0, int n0, int lane) {
#pragma unroll 8
    for (int i = 0; i < 32; ++i) { const int kk = 2 * i + (lane >> 5); scr[kk * 33 + (lane & 31)] = W[(size_t)(k0 + kk) * N + n0 + (lane & 31)]; }
    LDS_WAIT(); asm volatile("" ::: "memory");
    const int c = lane & 7;
#pragma unroll
    for (int j = 0; j < 4; ++j) { const int n = (lane >> 3) + 8 * j; const LAS float* s = scr + (8 * c) * 33 + n;
        v4u o; o.x = pk2(s[0 * 33], s[1 * 33]); o.y = pk2(s[2 * 33], s[3 * 33]); o.z = pk2(s[4 * 33], s[5 * 33]); o.w = pk2(s[6 * 33], s[7 * 33]);
        *(GAS v4u*)(WT + (dst_row0 + n) * (size_t)Kd + k0 + 8 * c) = o; }
    LDS_WAIT(); asm volatile("" ::: "memory");
}
__device__ __forceinline__ void p0_prologue(Frame& F, const Args& args) {
    const float* c_in = IN_F(1); const int* pos = IN_I(2); const float* ada_w = IN_F(3); const float* ada_b = IN_F(4);
    for (int task = F.vcu; task < 96; task += F.G) {
        LAS float* sc = (LAS float*)F.lds;
        LAS float* red = (LAS float*)(F.lds + 16384);
        for (int i = F.tid; i < 4096; i += 512) { const float v = c_in[i]; sc[i] = v / (1.0f + expf(-v)); }
        __syncthreads();
        const int colq = F.lane & 15, kq = F.lane >> 4, col = task * 64 + colq * 4;
        float acc[4][4];
#pragma unroll
        for (int b = 0; b < 4; ++b)
#pragma unroll
            for (int j = 0; j < 4; ++j) acc[b][j] = 0.f;
#pragma unroll 4
        for (int s = 0; s < 32; ++s) { const int k = F.wave * 128 + s * 4 + kq; const f32x4 wv = *(const f32x4*)(ada_w + (size_t)k * 6144 + col);
#pragma unroll
            for (int b = 0; b < 4; ++b) { const float sv = sc[b * 1024 + k];
#pragma unroll
                for (int j = 0; j < 4; ++j) acc[b][j] += sv * wv[j]; } }
#pragma unroll
        for (int b = 0; b < 4; ++b)
#pragma unroll
            for (int j = 0; j < 4; ++j) { float v = acc[b][j]; v += __shfl_xor(v, 16); v += __shfl_xor(v, 32); if (kq == 0) red[(F.wave * 4 + b) * 64 + colq * 4 + j] = v; }
        __syncthreads();
        if (F.tid < 256) { const int b = F.tid >> 6, cc = F.tid & 63; float s = ada_b[task * 64 + cc];
#pragma unroll
            for (int w = 0; w < 8; ++w) s += red[(w * 4 + b) * 64 + cc];
            WSP(float, WS_MOD)[b * 6144 + task * 64 + cc] = s; }
        __syncthreads();
    }
    const int gt = F.vcu * 512 + F.tid, NGT = F.G * 512;
    for (int idx = gt; idx < NTOK * 16; idx += NGT) { const int m = idx >> 4, i = idx & 15;
        double freq = 1.0; for (int q = 0; q < i; ++q) freq *= 0.44036660267178046;
        const double ang = (double)pos[m] * freq; const double nr = __builtin_rint(ang * 0.15915494309189535);
        const float r = (float)__builtin_fma(-nr, 6.283185307179586, ang);
        float sn, cs; sincosf(r, &sn, &cs);
        WSP(float, WS_TRIG)[m * 32 + i] = cs; WSP(float, WS_TRIG)[m * 32 + 16 + i] = sn; }
    { const float* wr = IN_F(20); for (int idx = gt; idx < 32 * 1024; idx += NGT) { const int e = idx >> 10, k = idx & 1023; const float w = wr[k * 32 + e];
        const unsigned hi = f2bf(w); const float rem = w - __builtin_bit_cast(float, hi << 16); WSP(bf16, WS_WRH)[idx] = (bf16)hi; WSP(bf16, WS_WRL)[idx] = (bf16)f2bf(rem); } }
    LAS float* scr = (LAS float*)(F.lds + 32768 + F.wave * 8704);
    const int gw = F.vcu * NWAVES + F.wave, NGW = F.G * NWAVES;
    constexpr int I_IN = 16 * 224, I_RG = 128, I_B = 1024, I_O = 512, I_UP = 32 * 1024, I_DN = 32 * 512;
    constexpr int NITEMS = I_IN + I_RG + I_B + I_O + I_UP + I_DN;
    for (int it = gw; it < NITEMS; it += NGW) {
        int r = it;
        if (r < I_IN) { const int kb = r / 224, nb = r % 224; p0_transpose_item(IN_F(7), DIN, WSP(bf16, WS_WIN), 1024, (size_t)nb * 32, scr, kb * 64, nb * 32, F.lane); continue; } r -= I_IN;
        if (r < I_RG) { const int mat = r >> 6, blk = (r >> 3) & 7, kb = (r >> 2) & 1, nb = r & 3;
            p0_transpose_item(IN_F(mat ? 12 : 10) + (size_t)blk * 16384, 128, WSP(bf16, WS_WRG) + (size_t)(mat * 8 + blk) * 16384, 128, (size_t)nb * 32, scr, kb * 64, nb * 32, F.lane); continue; } r -= I_RG;
        if (r < I_B) { const int g = r >> 9, q = r & 511, kb = q >> 5, nb = q & 31;
            p0_transpose_item(IN_F(18) + (size_t)g * 1048576, 1024, WSP(bf16, WS_WB) + (size_t)g * 1048576, 1024, (size_t)nb * 32, scr, kb * 64, nb * 32, F.lane); continue; } r -= I_B;
        if (r < I_O) { const int kb = r >> 5, nb = r & 31; p0_transpose_item(IN_F(19), 1024, WSP(bf16, WS_WO), 1024, (size_t)nb * 32, scr, kb * 64, nb * 32, F.lane); continue; } r -= I_O;
        if (r < I_UP) { const int e = r >> 10, q = r & 1023, kb = q >> 6, nb = q & 63, n0 = nb * 32;
            const int bj = n0 >> 10, p = (n0 & 1023) >> 7, oo = n0 & 127;
            p0_transpose_item(IN_F(22) + (size_t)e * 2097152, 2048, WSP(bf16, WS_WUP) + (size_t)e * 2097152, 1024, (size_t)(p * 256 + bj * 128 + oo), scr, kb * 64, n0, F.lane); continue; } r -= I_UP;
        { const int e = r >> 9, q = r & 511, kb = q >> 5, nb = q & 31;
            p0_transpose_item(IN_F(24) + (size_t)e * 1048576, 1024, WSP(bf16, WS_WDN) + (size_t)e * 1048576, 1024, (size_t)nb * 32, scr, kb * 64, nb * 32, F.lane); }
    }
}

__device__ __forceinline__ void p1_hrows(Frame& F, const Args& args) {
    const float* x = IN_F(0); const float* g1n = IN_F(5); const float* mod = WSP(float, WS_MOD); bf16* H = WSP(bf16, WS_HB);
    const int gw = F.vcu * NWAVES + F.wave, NGW = F.G * NWAVES;
    for (int m = gw; m < NTOK; m += NGW) {
        const int b = m >> 12;
        const f32x4* xr = (const f32x4*)(x + (size_t)m * DM) + F.lane;
        f32x4 v[4]; float s = 0.f;
#pragma unroll
        for (int j = 0; j < 4; ++j) { v[j] = xr[64 * j]; s += (v[j].x * v[j].x + v[j].y * v[j].y) + (v[j].z * v[j].z + v[j].w * v[j].w); }
        const float rstd = 1.0f / sqrtf(wave_sum(s) * (1.f / DM) + EPS);
        unsigned long long* o8 = (unsigned long long*)(H + (size_t)m * DM) + F.lane;
#pragma unroll
        for (int j = 0; j < 4; ++j) { const int col = 4 * F.lane + 256 * j;
            const f32x4 g = *(const f32x4*)(g1n + col), sh = *(const f32x4*)(mod + b * 6144 + col), sc = *(const f32x4*)(mod + b * 6144 + 1024 + col);
            const f32x4 h = v[j] * rstd * g * (sc + 1.0f) + sh;
            o8[64 * j] = (unsigned long long)pk2(h.x, h.y) | ((unsigned long long)pk2(h.z, h.w) << 32); }
    }
}

__device__ __forceinline__ void p3_knorm_unit(Frame& F, const Args& args, int unit) {
    const int h = unit & 7, j = (unit >> 3) & 15, b = unit >> 7;
    bf16* KR = WSP(bf16, WS_E) + 3 * E_STRIDE; const float* trig = WSP(float, WS_TRIG); const float* kg = IN_F(16);
    const int rsub = F.lane >> 4, c16 = F.lane & 15;
    float gk[8];
#pragma unroll
    for (int i = 0; i < 8; ++i) gk[i] = kg[c16 * 8 + i];
    float km[8];
#pragma unroll
    for (int i = 0; i < 8; ++i) km[i] = 0.f;
    for (int it = 0; it < 8; ++it) {
        const int m = b * SEQ + j * 256 + F.wave * 32 + it * 4 + rsub;
        bf16* p = KR + (size_t)m * DM + h * HD + c16 * 8;
        const v4u raw = *(const v4u*)p;
        float v[8] = {bflo(raw.x), bfhi(raw.x), bflo(raw.y), bfhi(raw.y), bflo(raw.z), bfhi(raw.z), bflo(raw.w), bfhi(raw.w)};
        float ss = 0.f;
#pragma unroll
        for (int i = 0; i < 8; ++i) ss += v[i] * v[i];
        ss += __shfl_xor(ss, 1); ss += __shfl_xor(ss, 2); ss += __shfl_xor(ss, 4); ss += __shfl_xor(ss, 8);
        const float rstd = 1.0f / sqrtf(ss * (1.f / HD) + EPS);
#pragma unroll
        for (int i = 0; i < 8; ++i) v[i] = v[i] * rstd * gk[i];
        const int fi = (c16 & 1) * 8;
#pragma unroll
        for (int i = 0; i < 8; ++i) { const float other = __shfl_xor(v[i], 2);
            if (c16 < 4) { const float cs = trig[(size_t)m * 32 + fi + i], sn = trig[(size_t)m * 32 + 16 + fi + i];
                v[i] = (c16 < 2) ? (v[i] * cs - other * sn) : (v[i] * cs + other * sn); } }
#pragma unroll
        for (int i = 0; i < 8; ++i) km[i] += v[i];
        v4u o; o.x = pk2(v[0], v[1]); o.y = pk2(v[2], v[3]); o.z = pk2(v[4], v[5]); o.w = pk2(v[6], v[7]);
        *(v4u*)p = o;
    }
    LAS float* red = (LAS float*)(F.lds + XTRA_OFF);
#pragma unroll
    for (int i = 0; i < 8; ++i) { float v = km[i]; v += __shfl_xor(v, 16); v += __shfl_xor(v, 32); if (rsub == 0) red[F.wave * 128 + c16 * 8 + i] = v; }
    __syncthreads();
    if (F.tid < 128) { float s = 0.f;
#pragma unroll
        for (int w = 0; w < 8; ++w) s += red[w * 128 + F.tid];
        WSP(float, WS_KMEAN)[((size_t)(b * NH + h) * 16 + j) * HD + F.tid] = s * (1.f / 256.f); }
    __syncthreads();
}

__device__ __forceinline__ void p3_rnn_local_unit(Frame& F, const Args& args, int unit) {
    const int n = unit & 7, c = (unit >> 3) & 15, b = unit >> 7;
    const int t0 = c * 256, m0 = b * SEQ + t0, ch0 = n * 128;
    const bf16* XR = WSP(bf16, WS_E);
    LAS unsigned char* At = F.lds;
    {
        const int cg = F.tid & 15, rs = F.tid >> 4; const int chb = ch0 + cg * 8;
        const float* cw = IN_F(8); const float* cb = IN_F(9);
        float w0[8], w1[8], w2[8], w3[8], bb[8];
#pragma unroll
        for (int i = 0; i < 8; ++i) { w0[i] = cw[chb + i]; w1[i] = cw[1024 + chb + i]; w2[i] = cw[2048 + chb + i]; w3[i] = cw[3072 + chb + i]; bb[i] = cb[chb + i]; }
        float p1[8], p2[8], p3[8];
        const int tr0 = t0 + rs * 8;
#define LDROW(dst, tt) do { if ((tt) >= 0) { const v4u r_ = *(const v4u*)(XR + (size_t)(b * SEQ + (tt)) * DM + chb); \
            dst[0] = bflo(r_.x); dst[1] = bfhi(r_.x); dst[2] = bflo(r_.y); dst[3] = bfhi(r_.y); dst[4] = bflo(r_.z); dst[5] = bfhi(r_.z); dst[6] = bflo(r_.w); dst[7] = bfhi(r_.w); } \
            else { _Pragma("unroll") for (int i_ = 0; i_ < 8; ++i_) dst[i_] = 0.f; } } while (0)
        LDROW(p3, tr0 - 3); LDROW(p2, tr0 - 2); LDROW(p1, tr0 - 1);
#pragma unroll
        for (int r = 0; r < 8; ++r) { float cur[8]; LDROW(cur, tr0 + r);
            float xc[8];
#pragma unroll
            for (int i = 0; i < 8; ++i) xc[i] = bb[i] + w0[i] * cur[i] + w1[i] * p1[i] + w2[i] * p2[i] + w3[i] * p3[i];
            const int row = rs * 8 + r;
            v4u o; o.x = pk2(xc[0], xc[1]); o.y = pk2(xc[2], xc[3]); o.z = pk2(xc[4], xc[5]); o.w = pk2(xc[6], xc[7]);
            *(LAS v4u*)(At + row * 256 + ((cg ^ (row & 15)) << 4)) = o;
#pragma unroll
            for (int i = 0; i < 8; ++i) { p3[i] = p2[i]; p2[i] = p1[i]; p1[i] = cur[i]; } }
#undef LDROW
    }
    __syncthreads();
    const int fr = F.lane & 15, fq = F.lane >> 4;
    const int vloc = F.wave * 16 + fr, ch = ch0 + vloc;
    const bf16* WA = WSP(bf16, WS_WRG) + (size_t)n * 16384 + (size_t)vloc * 128 + fq * 8;
    const bf16* WX = WA + 8 * 16384;
    bf16x8 Ba[4], Bx[4];
#pragma unroll
    for (int s = 0; s < 4; ++s) { Ba[s] = *(const bf16x8*)(WA + 32 * s); Bx[s] = *(const bf16x8*)(WX + 32 * s); }
    const float ba = IN_F(11)[ch], bx = IN_F(13)[ch];
    const float sp8 = 8.0f * log1pf(expf(-IN_F(14)[ch]));
    float cP = 1.f, cH = 0.f;
    bf16* HL = WSP(bf16, WS_HL); bf16* PP = WSP(bf16, WS_PP);
    LAS unsigned short* stg = (LAS unsigned short*)(F.lds + 65536);
    for (int rt = 0; rt < 16; ++rt) {
        f32x4 accr = {0.f, 0.f, 0.f, 0.f}, accx = {0.f, 0.f, 0.f, 0.f};
        const int arow = rt * 16 + fr;
#pragma unroll
        for (int s = 0; s < 4; ++s) { const bf16x8 a = *(const LAS bf16x8*)(At + arow * 256 + (((fq + 4 * s) ^ (arow & 15)) << 4));
            accr = __builtin_amdgcn_mfma_f32_16x16x32_bf16(a, Ba[s], accr, 0, 0, 0);
            accx = __builtin_amdgcn_mfma_f32_16x16x32_bf16(a, Bx[s], accx, 0, 0, 0); }
        float pj[4], hj[4];
#pragma unroll
        for (int j = 0; j < 4; ++j) { const int row = rt * 16 + 4 * fq + j;
            const float xcv = bf2f(*(const LAS unsigned short*)(At + row * 256 + ((((vloc >> 3)) ^ (row & 15)) << 4) + (vloc & 7) * 2));
            const float r = fast_sigmoid(accr[j] + ba), ig = fast_sigmoid(accx[j] + bx);
            const float la = -sp8 * r, a = __builtin_amdgcn_exp2f(la * 1.4426950408889634f);
            float mult = sqrtf(-expm1f(2.0f * la)); if (t0 + row == 0) mult = 1.0f;
            const float u = mult * ig * xcv;
            pj[j] = (j ? pj[j - 1] : 1.0f) * a; hj[j] = (j ? hj[j - 1] * a : 0.0f) + u; }
        const float tp = pj[3], th = hj[3];
        const float pa = __shfl(tp, F.lane - 16), ha = __shfl(th, F.lane - 16);
        const float pb = __shfl(tp, F.lane - 32), hb = __shfl(th, F.lane - 32);
        const float pc = __shfl(tp, F.lane - 48), hc = __shfl(th, F.lane - 48);
        float Pq, Hq;
        if (fq == 0) { Pq = 1.f; Hq = 0.f; } else if (fq == 1) { Pq = pa; Hq = ha; } else if (fq == 2) { Pq = pb * pa; Hq = pa * hb + ha; } else { Pq = pc * pb * pa; Hq = pa * (pb * hc + hb) + ha; }
        const float hstart = Hq + Pq * cH, pstart = Pq * cP;
        LAS unsigned short* sb = stg + (rt & 1) * 4096;
        float hl3 = 0.f, pp3 = 0.f;
#pragma unroll
        for (int j = 0; j < 4; ++j) { const float hv = hj[j] + pj[j] * hstart, pv = pj[j] * pstart; const int rl = 4 * fq + j;
            sb[rl * 128 + vloc] = (unsigned short)f2bf(hv); sb[2048 + rl * 128 + vloc] = (unsigned short)f2bf(pv); if (j == 3) { hl3 = hv; pp3 = pv; } }
        cH = __shfl(hl3, fr + 48); cP = __shfl(pp3, fr + 48);
        __syncthreads();
        { const int arr = F.tid >> 8, rr = (F.tid >> 4) & 15, c16 = F.tid & 15;
            const v4u val = *(const LAS v4u*)(sb + arr * 2048 + rr * 128 + c16 * 8);
            bf16* dst = (arr ? PP : HL) + (size_t)(m0 + rt * 16 + rr) * DM + ch0 + c16 * 8;
            *(v4u*)dst = val; }
    }
    if (fq == 0) { WSP(float, WS_AGGP)[(size_t)(b * 16 + c) * 1024 + ch] = cP; WSP(float, WS_AGGH)[(size_t)(b * 16 + c) * 1024 + ch] = cH; }
    __syncthreads();
}

__device__ __forceinline__ void p4_rnn_final_unit(Frame& F, const Args& args, int unit) {
    const int n = unit & 7, c = (unit >> 3) & 15, b = unit >> 7;
    const int m0 = b * SEQ + c * 256, ch0 = n * 128;
    LAS float* car = (LAS float*)(F.lds + XTRA_OFF);
    if (F.tid < 128) { const int ch = ch0 + F.tid; float h = 0.f;
        for (int cc = 0; cc < c; ++cc) { const float p = WSP(float, WS_AGGP)[(size_t)(b * 16 + cc) * 1024 + ch], hh = WSP(float, WS_AGGH)[(size_t)(b * 16 + cc) * 1024 + ch]; h = p * h + hh; }
        car[F.tid] = h; }
    __syncthreads();
    const bf16* HL = WSP(bf16, WS_HL); const bf16* PP = WSP(bf16, WS_PP); const bf16* GG = WSP(bf16, WS_E) + E_STRIDE; bf16* Y = WSP(bf16, WS_YRNN);
    const int c16 = F.tid & 15, r0 = F.tid >> 4;
    float cv[8];
#pragma unroll
    for (int i = 0; i < 8; ++i) cv[i] = car[c16 * 8 + i];
#pragma unroll 2
    for (int it = 0; it < 8; ++it) { const size_t o = (size_t)(m0 + it * 32 + r0) * DM + ch0 + c16 * 8;
        const v4u hl = *(const v4u*)(HL + o), pp = *(const v4u*)(PP + o), gg = *(const v4u*)(GG + o);
        v4u y;
        y.x = pk2((bflo(hl.x) + bflo(pp.x) * cv[0]) * bflo(gg.x), (bfhi(hl.x) + bfhi(pp.x) * cv[1]) * bfhi(gg.x));
        y.y = pk2((bflo(hl.y) + bflo(pp.y) * cv[2]) * bflo(gg.y), (bfhi(hl.y) + bfhi(pp.y) * cv[3]) * bfhi(gg.y));
        y.z = pk2((bflo(hl.z) + bflo(pp.z) * cv[4]) * bflo(gg.z), (bfhi(hl.z) + bfhi(pp.z) * cv[5]) * bfhi(gg.z));
        y.w = pk2((bflo(hl.w) + bflo(pp.w) * cv[6]) * bflo(gg.w), (bfhi(hl.w) + bfhi(pp.w) * cv[7]) * bfhi(gg.w));
        *(v4u*)(Y + o) = y; }
    __syncthreads();
}

namespace att {
constexpr int KVBLK = 64, SHM_K = KVBLK * HD * 2, SHM_V = SHM_K;
constexpr float C2 = 0.08838834764831845f * 1.4426950408889634f;
#define KSWZ(row, colB) ((row) * 256 + ((colB) ^ (((row) & 7) << 4)))
__device__ __forceinline__ int v_st(int k, int c) { const int kk = (k & ~0xC) | ((k & 4) << 1) | ((k & 8) >> 1); return ((kk >> 3) * 4 + (c >> 5)) * 512 + ((kk & 7) * 32 + (c & 31)) * 2; }
__device__ __forceinline__ int v_rd_base(int lane) { return ((lane & 3) << 3) | (((lane >> 2) & 3) << 6) | (((lane >> 4) & 1) << 5) | (((lane >> 5) & 1) << 8); }
constexpr int v_rd_off(int d0, int ks, int half) { return d0 * 512 + ks * 4096 + half * 2048; }
__device__ __forceinline__ int crow(int r, int hi) { return (r & 3) + 8 * (r >> 2) + 4 * hi; }

template <int KB>
__device__ __forceinline__ void qkt(f32x16& p0, f32x16& p1, const char* K_lds, int r32, int hi, const char* qfrag, bool act) {
    if (!act) { const float NEG = -__builtin_inff();
#pragma unroll
        for (int r = 0; r < 16; ++r) { p0[r] = NEG; p1[r] = NEG; } return; }
    p0 = f32x16{}; p1 = f32x16{};
    const char* kb[4];
#pragma unroll
    for (int dd = 0; dd < 4; ++dd) kb[dd] = K_lds + KB * SHM_K + KSWZ(r32, (dd * 16 + hi * 8) * 2);
#pragma unroll
    for (int d0 = 0; d0 < 8; ++d0) { const char* a = kb[d0 & 3] + (d0 >> 2) * 128;
        bf16x8 b0 = *reinterpret_cast<const bf16x8*>(a);
        bf16x8 b1 = *reinterpret_cast<const bf16x8*>(a + 32 * 256);
        const bf16x8 q = *reinterpret_cast<const bf16x8*>(qfrag + d0 * 1024);
        p0 = __builtin_amdgcn_mfma_f32_32x32x16_bf16(b0, q, p0, 0, 0, 0);
        p1 = __builtin_amdgcn_mfma_f32_32x32x16_bf16(b1, q, p1, 0, 0, 0); }
}
template <int VB>
__device__ __forceinline__ void pv_tile(f32x16* o, int vb0, bf16x8 pa0, bf16x8 pa1, bf16x8 pa2, bf16x8 pa3, bool act) {
    if (!act) return;
#define TRRD(dst, off) asm volatile("ds_read_b64_tr_b16 %0, %1 offset:%2" : "=&v"(dst) : "v"(vb0), "i"(off) : "memory")
#define PV_D0(d0) do { s16x4 l0, l1, l2, l3, h0, h1, h2, h3; constexpr int b_ = VB * SHM_V + v_rd_off(d0, 0, 0); \
        TRRD(l0, b_); TRRD(h0, b_ + 2048); TRRD(l1, b_ + 4096); TRRD(h1, b_ + 6144); TRRD(l2, b_ + 8192); TRRD(h2, b_ + 10240); TRRD(l3, b_ + 12288); TRRD(h3, b_ + 14336); \
        asm volatile("s_waitcnt lgkmcnt(0)" ::: "memory"); SBAR(); \
        o[d0] = __builtin_amdgcn_mfma_f32_32x32x16_bf16(pa0, (bf16x8){l0[0], l0[1], l0[2], l0[3], h0[0], h0[1], h0[2], h0[3]}, o[d0], 0, 0, 0);   \
        o[d0] = __builtin_amdgcn_mfma_f32_32x32x16_bf16(pa1, (bf16x8){l1[0], l1[1], l1[2], l1[3], h1[0], h1[1], h1[2], h1[3]}, o[d0], 0, 0, 0);   \
        o[d0] = __builtin_amdgcn_mfma_f32_32x32x16_bf16(pa2, (bf16x8){l2[0], l2[1], l2[2], l2[3], h2[0], h2[1], h2[2], h2[3]}, o[d0], 0, 0, 0);   \
        o[d0] = __builtin_amdgcn_mfma_f32_32x32x16_bf16(pa3, (bf16x8){l3[0], l3[1], l3[2], l3[3], h3[0], h3[1], h3[2], h3[3]}, o[d0], 0, 0, 0); } while (0)
    PV_D0(0); PV_D0(1); PV_D0(2); PV_D0(3);
#undef PV_D0
#undef TRRD
}
__device__ __forceinline__ void sm_a(f32x16& p0) {
#pragma unroll
    for (int r = 0; r < 16; ++r) p0[r] = __builtin_amdgcn_exp2f(p0[r]);
}
__device__ __forceinline__ void sm_b(f32x16& p0, f32x16& p1, float& l_reg, bf16x8& pa0, bf16x8& pa1, bf16x8& pa2, bf16x8& pa3) {
#pragma unroll
    for (int r = 0; r < 16; ++r) p1[r] = __builtin_amdgcn_exp2f(p1[r]);
    float ps = 0;
#pragma unroll
    for (int r = 0; r < 16; ++r) ps += p0[r];
#pragma unroll
    for (int r = 0; r < 16; ++r) ps += p1[r];
    l_reg += ps;
#define PK4(P, B_, OUT) do { unsigned a0 = cvtpk(P[B_+0], P[B_+1]), a1 = cvtpk(P[B_+2], P[B_+3]); \
        unsigned b0 = cvtpk(P[B_+4], P[B_+5]), b1 = cvtpk(P[B_+6], P[B_+7]); \
        auto r0 = __builtin_amdgcn_permlane32_swap(a0, b0, false, false); auto r1 = __builtin_amdgcn_permlane32_swap(a1, b1, false, false); \
        v4u w = {r0[0], r1[0], r0[1], r1[1]}; OUT = *reinterpret_cast<bf16x8*>(&w); } while (0)
    PK4(p0, 0, pa0); PK4(p0, 8, pa1); PK4(p1, 0, pa2); PK4(p1, 8, pa3);
#undef PK4
}

__device__ __forceinline__ void attn_unit(Frame& F, const Args& args, int b, int h, int iq) {
    int tid = F.tid; asm volatile("" : "+v"(tid));
    const int wid = F.wave, lane = tid & 63, r32 = lane & 31, hi = lane >> 5;
    char* lds = F.ldsg;
    char* V_lds = lds; char* K_lds = lds + 2 * SHM_V;
    float* kml = (float*)(lds + XTRA_OFF);
    char* qfrag = lds + 65536 + wid * 8192 + lane * 16;
    const bf16* QR = WSP(bf16, WS_E) + 2 * E_STRIDE; const bf16* KN = WSP(bf16, WS_E) + 3 * E_STRIDE; const bf16* VV = WSP(bf16, WS_E) + 4 * E_STRIDE;
    bf16* YA = WSP(bf16, WS_YATT);
    const size_t mb = (size_t)b * SEQ;
    const int q0 = iq * 256, NT = 4 * (iq + 1);
    const bf16* Kh = KN + mb * DM + h * HD; const bf16* Vh = VV + mb * DM + h * HD;
    { const float* kmg = WSP(float, WS_KMEAN) + (size_t)(b * NH + h) * 16 * HD; for (int idx = tid; idx < iq * HD; idx += 512) kml[idx] = kmg[idx]; }
    const int sr = tid >> 4, sc = (tid & 15) * 8, vst0 = v_st(sr, sc), vst1 = v_st(32 + sr, sc), kws = KSWZ(sr, sc * 2);
    const int vb0 = (int)(uintptr_t)V_lds + v_rd_base(lane);
    bf16x8 st_v0, st_v1, st_k0, st_k1;
    const unsigned goff = (unsigned)(sr * DM + sc) * 2u;
#define ROWP(p, k0, rr) ((const char*)((p) + (size_t)((k0) + (rr)) * DM) + goff)
#define SLOAD(k0) do { st_v0 = *(const bf16x8*)ROWP(Vh, k0, 0); st_v1 = *(const bf16x8*)ROWP(Vh, k0, 32); st_k0 = *(const bf16x8*)ROWP(Kh, k0, 0); st_k1 = *(const bf16x8*)ROWP(Kh, k0, 32); } while (0)
#define SWRITE(bf) do { *(bf16x8*)(V_lds + (bf) * SHM_V + vst0) = st_v0; *(bf16x8*)(V_lds + (bf) * SHM_V + vst1) = st_v1; \
                        *(bf16x8*)(K_lds + (bf) * SHM_K + kws) = st_k0; *(bf16x8*)(K_lds + (bf) * SHM_K + kws + 32 * 256) = st_k1; } while (0)
    SLOAD(0);
    const size_t mq = mb + q0 + wid * 32 + r32;
    unsigned selmask;
    {
        bf16x8 qr[8];
        const bf16* qp = QR + mq * DM + h * HD + hi * 8;
        v4u raw[8];
#pragma unroll
        for (int d0 = 0; d0 < 8; ++d0) raw[d0] = *(const v4u*)(qp + d0 * 16);
        float ss = 0.f;
#pragma unroll
        for (int d0 = 0; d0 < 8; ++d0) { const float a0 = bflo(raw[d0].x), a1 = bfhi(raw[d0].x), a2 = bflo(raw[d0].y), a3 = bfhi(raw[d0].y), a4 = bflo(raw[d0].z), a5 = bfhi(raw[d0].z), a6 = bflo(raw[d0].w), a7 = bfhi(raw[d0].w);
            ss += (a0 * a0 + a1 * a1) + (a2 * a2 + a3 * a3) + (a4 * a4 + a5 * a5) + (a6 * a6 + a7 * a7); }
        ss += __shfl_xor(ss, 32);
        const float rs = C2 / sqrtf(ss * (1.f / HD) + EPS);
        const float* qg = IN_F(15) + hi * 8;
#define UNPK(f, W_) do { const v4u t_ = (W_); f[0] = bflo(t_.x); f[1] = bfhi(t_.x); f[2] = bflo(t_.y); f[3] = bfhi(t_.y); f[4] = bflo(t_.z); f[5] = bfhi(t_.z); f[6] = bflo(t_.w); f[7] = bfhi(t_.w); } while (0)
#define PACK(f) ({ v4u w_; w_.x = cvtpk(f[0], f[1]); w_.y = cvtpk(f[2], f[3]); w_.z = cvtpk(f[4], f[5]); w_.w = cvtpk(f[6], f[7]); *reinterpret_cast<bf16x8*>(&w_); })
        { float f0[8], f1[8]; UNPK(f0, raw[0]); UNPK(f1, raw[1]);
          const float* tg = WSP(float, WS_TRIG) + mq * 32 + hi * 8;
#pragma unroll
          for (int j = 0; j < 8; ++j) { const float x1 = f0[j] * rs * qg[j], x2 = f1[j] * rs * qg[16 + j], cs = tg[j], sn = tg[16 + j]; f0[j] = x1 * cs - x2 * sn; f1[j] = x2 * cs + x1 * sn; }
          qr[0] = PACK(f0); qr[1] = PACK(f1); }
#pragma unroll
        for (int d0 = 2; d0 < 8; ++d0) { float f[8]; UNPK(f, raw[d0]);
#pragma unroll
            for (int j = 0; j < 8; ++j) f[j] *= rs * qg[d0 * 16 + j];
            qr[d0] = PACK(f); }
        __syncthreads();
        float v1 = -__builtin_inff(), v2 = v1, v3 = v1; int i1 = 0, i2 = 0, i3 = 0;
#pragma unroll 1
        for (int jb = 0; jb < iq; ++jb) { const float* km = kml + jb * HD + hi * 8; float g = 0.f;
#pragma unroll
            for (int d0 = 0; d0 < 8; ++d0) { float f[8]; UNPK(f, *reinterpret_cast<const v4u*>(&qr[d0]));
                const f32x4 k0 = *(const f32x4*)(km + d0 * 16), k1 = *(const f32x4*)(km + d0 * 16 + 4);
                g += (f[0] * k0[0] + f[1] * k0[1]) + (f[2] * k0[2] + f[3] * k0[3]) + (f[4] * k1[0] + f[5] * k1[1]) + (f[6] * k1[2] + f[7] * k1[3]); }
            g += __shfl_xor(g, 32);
            if (g > v1) { v3 = v2; i3 = i2; v2 = v1; i2 = i1; v1 = g; i1 = jb; }
            else if (g > v2) { v3 = v2; i3 = i2; v2 = g; i2 = jb; }
            else if (g > v3) { v3 = g; i3 = jb; } }
#undef UNPK
#undef PACK
        selmask = 0u; if (iq >= 1) selmask |= 1u << i1; if (iq >= 2) selmask |= 1u << i2; if (iq >= 3) selmask |= 1u << i3;
#pragma unroll
        for (int d0 = 0; d0 < 8; ++d0) *reinterpret_cast<bf16x8*>(qfrag + d0 * 1024) = qr[d0];
    }
    float l_reg = 0.f; f32x16 o[4] = {};
    const int wrow0 = wid * 32;
#define ACT(t) (((t) >> 2) < iq ? (__ballot((selmask >> ((t) >> 2)) & 1u) != 0ull) : ((((t) - 4 * iq) * 64) <= wrow0 + 31))
#define MASKT(P0_, P1_, t) do { const int blk_ = (t) >> 2; const float NEG_ = -__builtin_inff(); \
        if (blk_ < iq) { if (!((selmask >> blk_) & 1u)) { _Pragma("unroll") for (int r = 0; r < 16; ++r) { P0_[r] = NEG_; P1_[r] = NEG_; } } } \
        else { const int kb_ = ((t) - 4 * iq) * 64; if (kb_ + 63 > wrow0) { int dq_ = wrow0 + r32 - kb_ - 4 * hi; asm volatile("" : "+v"(dq_)); \
            _Pragma("unroll") for (int r = 0; r < 16; ++r) { const int c_ = (r & 3) + 8 * (r >> 2); if (c_ > dq_) P0_[r] = NEG_; if (c_ + 32 > dq_) P1_[r] = NEG_; } } } } while (0)
    f32x16 pA0, pA1, pB0, pB1; bf16x8 pa0, pa1, pa2, pa3;
    VM_WAIT(); SWRITE(0); SBAR();
    SLOAD(64);
    __syncthreads();
    SBAR(); qkt<0>(pA0, pA1, K_lds, r32, hi, qfrag, ACT(0));
    MASKT(pA0, pA1, 0); sm_a(pA0);
    VM_WAIT(); SWRITE(1);
    __syncthreads();
#define HALF_STEP(PX0, PX1, PY0, PY1, t, KB, VB, SB) do { \
        SBAR(); qkt<KB>(PX0, PX1, K_lds, r32, hi, qfrag, ACT(t)); \
        sm_b(PY0, PY1, l_reg, pa0, pa1, pa2, pa3); SBAR(); \
        if ((t) + 1 < NT) { SLOAD(((t) + 1) * 64); SBAR(); } \
        pv_tile<VB>(o, vb0, pa0, pa1, pa2, pa3, ACT((t) - 1)); MASKT(PX0, PX1, (t)); sm_a(PX0); \
        __syncthreads(); \
        if ((t) + 1 < NT) { VM_WAIT(); SWRITE(SB); } \
        __syncthreads(); } while (0)
    for (int t = 1; t + 1 < NT; t += 2) {
        HALF_STEP(pB0, pB1, pA0, pA1, t, 1, 0, 0);
        HALF_STEP(pA0, pA1, pB0, pB1, t + 1, 0, 1, 1);
    }
    SBAR(); qkt<1>(pB0, pB1, K_lds, r32, hi, qfrag, ACT(NT - 1)); SBAR();
    sm_b(pA0, pA1, l_reg, pa0, pa1, pa2, pa3); SBAR();
    pv_tile<0>(o, vb0, pa0, pa1, pa2, pa3, ACT(NT - 2));
    MASKT(pB0, pB1, NT - 1); sm_a(pB0);
    sm_b(pB0, pB1, l_reg, pa0, pa1, pa2, pa3); SBAR();
    pv_tile<1>(o, vb0, pa0, pa1, pa2, pa3, ACT(NT - 1));
    l_reg += __shfl_xor(l_reg, 32);
    float* li_l = (float*)(lds + XTRA_OFF + 8192) + wid * 32;
    if (hi == 0) li_l[r32] = l_reg;
    asm volatile("s_waitcnt lgkmcnt(0)" ::: "memory");
    float rli[16];
#pragma unroll
    for (int r = 0; r < 16; ++r) rli[r] = __builtin_amdgcn_rcpf(li_l[crow(r, hi)]);
    bf16* Ow = YA + (mb + q0 + wid * 32) * DM + h * HD;
#pragma unroll
    for (int r = 0; r < 16; ++r) { const int orow = crow(r, hi);
#pragma unroll
        for (int d0 = 0; d0 < 4; ++d0) { const float v = o[d0][r] * rli[r]; const float vn = __shfl_xor(v, 1);
            if ((r32 & 1) == 0) *(unsigned*)(Ow + (size_t)orow * DM + d0 * 32 + r32) = cvtpk(v, vn); } }
    __syncthreads();
#undef ROWP
#undef SLOAD
#undef SWRITE
#undef ACT
#undef MASKT
#undef HALF_STEP
}
#undef KSWZ
}

__device__ __forceinline__ void p7_router(Frame& F, const Args& args) {
    LAS float* ssq = (LAS float*)F.lds;
    LAS float* lg = (LAS float*)(F.lds + 1024);
    LAS int* hist = (LAS int*)(F.lds + 20480);
    LAS int* sel = (LAS int*)(F.lds + 21504);
    const float* g2n = IN_F(6); const float* mod = WSP(float, WS_MOD); const float* brt = IN_F(21);
    const bf16* WRH = WSP(bf16, WS_WRH); const bf16* WRL = WSP(bf16, WS_WRL);
    bf16* H2 = WSP(bf16, WS_HB);
    unsigned* CNT = (unsigned*)(F.ws + WS_CTL) + CW_CNT;
    const int rg = F.wave & 3, kh = F.wave >> 2, row = F.lane & 15, q = F.lane >> 4;
    for (int vw = F.vcu; vw < 256; vw += F.G) {
        const int rl = rg * 16 + row, m = vw * 64 + rl, b = m >> 12;
        const float* xp = F.out + (size_t)m * DM + 512 * kh + 8 * q;
        float ss = 0.f;
#pragma unroll 4
        for (int s = 0; s < 16; ++s) { const f32x4 x0 = *(const f32x4*)(xp + 32 * s), x1 = *(const f32x4*)(xp + 32 * s + 4); const f32x4 a = x0 * x0 + x1 * x1; ss += (a.x + a.y) + (a.z + a.w); }
        ss += __shfl_xor(ss, 16); ss += __shfl_xor(ss, 32);
        if (q == 0) ssq[kh * 64 + rl] = ss;
        if (F.tid < 32) hist[F.tid] = 0;
        __syncthreads();
        const float rstd = 1.0f / sqrtf((ssq[rl] + ssq[64 + rl]) * (1.f / DM) + EPS);
        f32x4 acc0 = {0.f, 0.f, 0.f, 0.f}, acc1 = {0.f, 0.f, 0.f, 0.f};
        const float* mp = mod + b * 6144;
        bf16* hp = H2 + (size_t)m * DM + 512 * kh + 8 * q;
        const bf16* wh = WRH + (size_t)row * 1024 + 512 * kh + 8 * q; const bf16* wl = WRL + (size_t)row * 1024 + 512 * kh + 8 * q;
#pragma unroll 2
        for (int s = 0; s < 16; ++s) { const int col = 512 * kh + 32 * s + 8 * q;
            const f32x4 xq[2] = {*(const f32x4*)(xp + 32 * s), *(const f32x4*)(xp + 32 * s + 4)};
            float h[8];
#pragma unroll
            for (int hf = 0; hf < 2; ++hf) { const f32x4 g = *(const f32x4*)(g2n + col + 4 * hf), sh = *(const f32x4*)(mp + 3072 + col + 4 * hf), sc = *(const f32x4*)(mp + 4096 + col + 4 * hf);
                const f32x4 t = xq[hf] * rstd * g * (sc + 1.0f) + sh; h[4 * hf] = t.x; h[4 * hf + 1] = t.y; h[4 * hf + 2] = t.z; h[4 * hf + 3] = t.w; }
            v4u hi; hi.x = cvtpk(h[0], h[1]); hi.y = cvtpk(h[2], h[3]); hi.z = cvtpk(h[4], h[5]); hi.w = cvtpk(h[6], h[7]);
            *(v4u*)(hp + 32 * s) = hi;
            v4u lo; lo.x = cvtpk(h[0] - bflo(hi.x), h[1] - bfhi(hi.x)); lo.y = cvtpk(h[2] - bflo(hi.y), h[3] - bfhi(hi.y)); lo.z = cvtpk(h[4] - bflo(hi.z), h[5] - bfhi(hi.z)); lo.w = cvtpk(h[6] - bflo(hi.w), h[7] - bfhi(hi.w));
            const bf16x8 ah = *reinterpret_cast<bf16x8*>(&hi), al = *reinterpret_cast<bf16x8*>(&lo);
            const bf16x8 bh0 = *(const bf16x8*)(wh + 32 * s), bl0 = *(const bf16x8*)(wl + 32 * s), bh1 = *(const bf16x8*)(wh + 16384 + 32 * s), bl1 = *(const bf16x8*)(wl + 16384 + 32 * s);
            acc0 = __builtin_amdgcn_mfma_f32_16x16x32_bf16(ah, bh0, acc0, 0, 0, 0); acc0 = __builtin_amdgcn_mfma_f32_16x16x32_bf16(ah, bl0, acc0, 0, 0, 0); acc0 = __builtin_amdgcn_mfma_f32_16x16x32_bf16(al, bh0, acc0, 0, 0, 0);
            acc1 = __builtin_amdgcn_mfma_f32_16x16x32_bf16(ah, bh1, acc1, 0, 0, 0); acc1 = __builtin_amdgcn_mfma_f32_16x16x32_bf16(ah, bl1, acc1, 0, 0, 0); acc1 = __builtin_amdgcn_mfma_f32_16x16x32_bf16(al, bh1, acc1, 0, 0, 0); }
#pragma unroll
        for (int r = 0; r < 4; ++r) { lg[(kh * 64 + rg * 16 + 4 * q + r) * 33 + row] = acc0[r]; lg[(kh * 64 + rg * 16 + 4 * q + r) * 33 + 16 + row] = acc1[r]; }
        __syncthreads();
        { const int rowl = F.tid >> 3, eq = F.tid & 7; float v[4];
#pragma unroll
          for (int j = 0; j < 4; ++j) v[j] = lg[rowl * 33 + 4 * eq + j] + lg[(64 + rowl) * 33 + 4 * eq + j] + brt[4 * eq + j];
          float tv[4]; int te[4];
#pragma unroll
          for (int k = 0; k < 4; ++k) { float gm = fmaxf(fmaxf(v[0], v[1]), fmaxf(v[2], v[3]));
              gm = fmaxf(gm, __shfl_xor(gm, 1)); gm = fmaxf(gm, __shfl_xor(gm, 2)); gm = fmaxf(gm, __shfl_xor(gm, 4));
              int ci = v[0] == gm ? 4 * eq : v[1] == gm ? 4 * eq + 1 : v[2] == gm ? 4 * eq + 2 : v[3] == gm ? 4 * eq + 3 : 99;
              ci = min(ci, __shfl_xor(ci, 1)); ci = min(ci, __shfl_xor(ci, 2)); ci = min(ci, __shfl_xor(ci, 4));
              te[k] = ci; tv[k] = gm;
#pragma unroll
              for (int j = 0; j < 4; ++j) if (ci == 4 * eq + j) v[j] = -__builtin_inff(); }
          if (eq == 0) { const float w1 = __expf(tv[1] - tv[0]), w2 = __expf(tv[2] - tv[0]), w3 = __expf(tv[3] - tv[0]); const float inv = 1.0f / (1.0f + w1 + w2 + w3);
              const float gk[4] = {inv, w1 * inv, w2 * inv, w3 * inv};
#pragma unroll
              for (int k = 0; k < 4; ++k) { const int lr = atomicAdd((int*)&hist[te[k]], 1); sel[rowl * 4 + k] = te[k]; sel[256 + rowl * 4 + k] = lr; sel[512 + rowl * 4 + k] = __float_as_int(gk[k]); } } }
        __syncthreads();
        if (F.tid < 32) { const int hc = hist[F.tid]; hist[32 + F.tid] = hc ? (int)__hip_atomic_fetch_add(CNT + F.tid, (unsigned)hc, RLX_AGENT) : 0; }
        __syncthreads();
        if (F.tid < 256) { const int e = sel[F.tid], pos = hist[32 + e] + sel[256 + F.tid], mm = vw * 64 + (F.tid >> 2);
            WSP(int, WS_ROWTOK)[(size_t)e * ECAP + pos] = mm; WSP(int, WS_ROWGATE)[(size_t)e * ECAP + pos] = sel[512 + F.tid];
            WSP(int, WS_TOKE)[mm * 4 + (F.tid & 3)] = e; WSP(int, WS_TOKPOS)[mm * 4 + (F.tid & 3)] = pos; }
        __syncthreads();
    }
}

constexpr int MOE_TBL_OFF = XTRA_OFF, MOE_LIST_OFF = XTRA_OFF + 2048;
__device__ __forceinline__ int moe_tables(Frame& F) {
    LAS int* tbl = (LAS int*)(F.lds + MOE_TBL_OFF);
    const unsigned* CNT = (const unsigned*)(F.ws + WS_CTL) + CW_CNT;
    if (F.tid < 32) tbl[F.tid] = (int)__hip_atomic_load(CNT + F.tid, RLX_AGENT);
    __syncthreads();
    if (F.tid == 0) { int run = 0; for (int e = 0; e < 32; ++e) { tbl[32 + e] = run; const int nb = (tbl[e] + 255) >> 8; for (int bb = 0; bb < nb; ++bb) tbl[80 + run + bb] = e; run += nb; } tbl[64] = run; }
    __syncthreads();
    int nblk = tbl[64]; if (nblk > MAXBLK) nblk = MAXBLK; if (nblk < 1) nblk = 1;
    return __builtin_amdgcn_readfirstlane(nblk);
}

__device__ __forceinline__ void p11_combine(Frame& F, const Args& args) {
    (void)moe_tables(F);
    const LAS int* tbl = (const LAS int*)(F.lds + MOE_TBL_OFF);
    const float* mod = WSP(float, WS_MOD); const bf16* YR = WSP(bf16, WS_YR);
    const int gw = F.vcu * NWAVES + F.wave, NGW = F.G * NWAVES;
    for (int m = gw; m < NTOK; m += NGW) {
        const int b = m >> 12;
        int dk = 0; if (F.lane < 4) { const int e = __hip_atomic_load(WSP(int, WS_TOKE) + m * 4 + F.lane, RLX_AGENT); dk = tbl[32 + e] * 256 + __hip_atomic_load(WSP(int, WS_TOKPOS) + m * 4 + F.lane, RLX_AGENT); }
        const int d0 = __shfl(dk, 0), d1 = __shfl(dk, 1), d2 = __shfl(dk, 2), d3 = __shfl(dk, 3);
        f32x4* xr = (f32x4*)(F.out + (size_t)m * DM) + F.lane;
#pragma unroll
        for (int j = 0; j < 4; ++j) { const int col = 4 * F.lane + 256 * j;
            const v2u y0 = *(const v2u*)(YR + (size_t)d0 * DM + col), y1 = *(const v2u*)(YR + (size_t)d1 * DM + col), y2 = *(const v2u*)(YR + (size_t)d2 * DM + col), y3 = *(const v2u*)(YR + (size_t)d3 * DM + col);
            f32x4 s;
            s.x = (bflo(y0.x) + bflo(y1.x)) + (bflo(y2.x) + bflo(y3.x)); s.y = (bfhi(y0.x) + bfhi(y1.x)) + (bfhi(y2.x) + bfhi(y3.x));
            s.z = (bflo(y0.y) + bflo(y1.y)) + (bflo(y2.y) + bflo(y3.y)); s.w = (bfhi(y0.y) + bfhi(y1.y)) + (bfhi(y2.y) + bfhi(y3.y));
            const f32x4 g2 = *(const f32x4*)(mod + b * 6144 + 5120 + col);
            xr[64 * j] = xr[64 * j] + g2 * s; }
    }
}

#ifndef MK_N_LAUNCHES
#define MK_N_LAUNCHES 1
#endif
constexpr int PER_PHASE = 12;
constexpr int N_LAUNCHES = MK_N_LAUNCHES;

__global__ void __launch_bounds__(NWAVES * 64, 2) hybrid_fwd(Args args) {
    extern __shared__ __attribute__((aligned(16))) unsigned char lds[];
    Frame F;
    F.lds = (LAS unsigned char*)lds; F.ldsg = (char*)lds;
    F.MISC = (volatile LAS unsigned*)(F.lds + MISC_OFF);
    F.tid = threadIdx.x; F.lane = F.tid & 63; F.wave = __builtin_amdgcn_readfirstlane(F.tid >> 6);
    F.G = gridDim.x; { const int bx = blockIdx.x; F.vcu = (F.G % 8 == 0) ? (bx % 8) * (F.G / 8) + bx / 8 : bx; }
    F.ws = args.ws; F.out = args.out;
    gu32* ctl = (gu32*)(args.ws + WS_CTL);
    for (int u = F.tid; u < (LDS_BYTES - LDSCTL_OFF) / 4; u += NWAVES * 64) ((LAS unsigned*)(F.lds + LDSCTL_OFF))[u] = 0u;
    __syncthreads();
    XcdBarrier bar; bar.bar = (unsigned*)(ctl + CW_BAR); bar.x = 0; bar.st = nullptr;
    if (N_LAUNCHES == 1) bar = xcd_barrier_post((unsigned*)(ctl + CW_BAR), F.MISC + 8);
    const int lo = args.ph_lo, hi = args.ph_hi;
#ifndef PHASE_MASK
#define PHASE_MASK 0xFFF
#endif
#define IN(k) (((PHASE_MASK >> (k)) & 1) && lo <= (k) && (k) < hi)
#define NEXTP(k) ((k) == 7 ? 9 : (k) + 1)
#define SEAM(k) do { if (IN(k) && IN(NEXTP(k))) xcd_barrier(bar); } while (0)

#ifndef DUP_MASK
#define DUP_MASK 0
#endif
#define PHASE(k, ...) do { if (IN(k)) { __VA_ARGS__ if ((DUP_MASK >> (k)) & 1) { xcd_barrier(bar); __VA_ARGS__ } } SEAM(k); } while (0)
    PHASE(0, { p0_prologue(F, args); });
    PHASE(1, { p1_hrows(F, args); });
    PHASE(2, {
        pg8::Gemm g{WSP(bf16, WS_HB), WSP(bf16, WS_WIN), NTOK, DIN, DM}; pg8::TileOrder S; S.init(NTOK / 256, DIN / 256, F.G, (int)blockIdx.x, nullptr);
        pg8::EpiWin E{WSP(bf16, WS_E), IN_F(17)};
        pg8::gemm_phase<pg8::EpiWin, pg8::TileOrder, true, true>(F.lds + RING_OFF, g, S, E);
    });
    int p3rep = 0;
    PHASE(3, {
        for (int u = F.vcu; u < 512; u += F.G) p3_rnn_local_unit(F, args, u);
        if (p3rep++ == 0) { for (int u = F.vcu; u < 512; u += F.G) p3_knorm_unit(F, args, u); }
    });
    PHASE(4, {
        for (int it = F.vcu; it < 256; it += F.G) { const int bh = it >> 3, s = it & 7;
            for (int pass = 0; pass < 2; ++pass) att::attn_unit(F, args, bh >> 3, bh & 7, pass ? s : 15 - s); }
        for (int u = F.vcu; u < 512; u += F.G) p4_rnn_final_unit(F, args, u);
    });
    PHASE(5, {
        { pg8::Gemm g{WSP(bf16, WS_YRNN), WSP(bf16, WS_WB), NTOK, DM, DM}; pg8::TileOrder S; S.init(NTOK / 256, DM / 256, F.G, (int)blockIdx.x, nullptr);
          pg8::EpiBranch<0> E{WSP(bf16, WS_E) + 5 * E_STRIDE, WSP(float, WS_T0), nullptr};
          pg8::gemm_phase<pg8::EpiBranch<0>, pg8::TileOrder, false, true>(F.lds + RING_OFF, g, S, E); }
        { pg8::Gemm g{WSP(bf16, WS_YATT), WSP(bf16, WS_WB) + 1048576, NTOK, DM, DM}; pg8::TileOrder S; S.init(NTOK / 256, DM / 256, F.G, (int)blockIdx.x, nullptr);
          pg8::EpiBranch<1> E{WSP(bf16, WS_E) + 6 * E_STRIDE, WSP(float, WS_T0), WSP(bf16, WS_HB)};
          pg8::gemm_phase<pg8::EpiBranch<1>, pg8::TileOrder, false, true>(F.lds + RING_OFF, g, S, E); }
    });
    PHASE(6, {
        pg8::Gemm g{WSP(bf16, WS_HB), WSP(bf16, WS_WO), NTOK, DM, DM}; pg8::TileOrder S; S.init(NTOK / 256, DM / 256, F.G, (int)blockIdx.x, nullptr);
        pg8::EpiWout E{IN_F(0), F.out, WSP(float, WS_MOD)};
        pg8::gemm_phase<pg8::EpiWout, pg8::TileOrder, false, true>(F.lds + RING_OFF, g, S, E);
    });
    PHASE(7, { p7_router(F, args); });
    PHASE(9, {
        const int nblk = moe_tables(F);
        const LAS int* tbl = (const LAS int*)(F.lds + MOE_TBL_OFF); LAS int* lists = (LAS int*)(F.lds + MOE_LIST_OFF);
        pg8::Gemm g{WSP(bf16, WS_HB), WSP(bf16, WS_WUP), RMAX, 2048 * NEXP, DM}; pg8::TileOrder S; S.init(nblk, 8, F.G, (int)blockIdx.x, tbl + 80);
        { pg8::Unit u; for (int i = 0; i < 9 && S.next(i, u); ++i) { if (F.tid < 256) { const int e = u.pn >> 3, pos = (u.pm - tbl[32 + e]) * 256 + F.tid;
              lists[i * 256 + F.tid] = pos < tbl[e] ? __hip_atomic_load(WSP(int, WS_ROWTOK) + (size_t)e * ECAP + pos, RLX_AGENT) : 0; } } }
        __syncthreads();
        pg8::EpiUp E{WSP(bf16, WS_ACT), IN_F(23)};
        pg8::gemm_phase<pg8::EpiUp, pg8::TileOrder, true, true, true>(F.lds + RING_OFF, g, S, E, lists);
    });
    PHASE(10, {
        const int nblk = moe_tables(F);
        const LAS int* tbl = (const LAS int*)(F.lds + MOE_TBL_OFF);
        pg8::Gemm g{WSP(bf16, WS_ACT), WSP(bf16, WS_WDN), RMAX, 1024 * NEXP, DM}; pg8::TileOrder S; S.init(nblk, 4, F.G, (int)blockIdx.x, tbl + 80);
        pg8::EpiDown E{WSP(bf16, WS_YR), IN_F(25), WSP(float, WS_ROWGATE), tbl};
        pg8::gemm_phase<pg8::EpiDown, pg8::TileOrder, true, true>(F.lds + RING_OFF, g, S, E);
    });
    PHASE(11, { p11_combine(F, args); });
#undef PHASE
#undef IN
#undef SEAM
}

extern "C" void kernel_launch(void* const* d_in, const int* in_sizes, int n_in, void* d_out, int out_size, void* d_ws, size_t ws_size, hipStream_t stream) {
    static int grid = 0;
    if (grid == 0) {
        if (n_in != 26 || in_sizes[0] != NTOK * DM || out_size != NTOK * DM || ws_size < WS_END) {
            fprintf(stderr, "kernel_launch: shape/workspace mismatch (n_in %d, in0 %d, out %d, ws %zu; need ws >= %zu); nothing launched\n", n_in, n_in > 0 ? in_sizes[0] : -1, out_size, ws_size, (size_t)WS_END); grid = -1; return; }
        int dev = 0, cus = 0, per_cu = 0;
        if (hipGetDevice(&dev) != hipSuccess || hipDeviceGetAttribute(&cus, hipDeviceAttributeMultiprocessorCount, dev) != hipSuccess) { fprintf(stderr, "kernel_launch: device query failed\n"); grid = -1; return; }
        if (hipFuncSetAttribute((const void*)hybrid_fwd, hipFuncAttributeMaxDynamicSharedMemorySize, LDS_BYTES) != hipSuccess) { fprintf(stderr, "kernel_launch: hipFuncSetAttribute failed\n"); grid = -1; return; }
        if (hipOccupancyMaxActiveBlocksPerMultiprocessor(&per_cu, (const void*)hybrid_fwd, NWAVES * 64, LDS_BYTES) != hipSuccess || per_cu < 1) { fprintf(stderr, "kernel_launch: occupancy query says %d blocks/CU\n", per_cu); per_cu = 1; }
        (void)hipGetLastError();
        grid = cus;
        if (grid > 256) grid = 256;
    }
    if (grid < 0) return;
    (void)hipMemsetAsync((char*)d_ws + WS_CTL, 0, CTL_ZERO_BYTES, stream);
    Args a{};
    for (int i = 0; i < 26; ++i) a.in[i] = d_in[i];
    a.out = (float*)d_out; a.ws = (unsigned char*)d_ws;
    for (int li = 0; li < N_LAUNCHES; ++li) {
        a.ph_lo = (N_LAUNCHES == 1) ? 0 : li; a.ph_hi = (N_LAUNCHES == 1) ? PER_PHASE : li + 1;
        hipLaunchKernelGGL(hybrid_fwd, dim3(grid), dim3(NWAVES * 64), LDS_BYTES, stream, a);
        const hipError_t le = hipPeekAtLastError();
        if (le != hipSuccess) { fprintf(stderr, "kernel_launch: launch %d failed: %s\n", li, hipGetErrorName(le)); break; }
    }
}
```

```cpp
#include <hip/hip_runtime.h>
#include <hip/hip_bf16.h>
#include <cstdio>
#include <cstdint>
#include <cmath>
namespace pg8 {
#define PG8_LAS __attribute__((address_space(3)))
typedef unsigned short bf16_t;
typedef short bf16x8 __attribute__((ext_vector_type(8)));
typedef float f32x4 __attribute__((ext_vector_type(4)));
typedef unsigned u32x4 __attribute__((ext_vector_type(4)));
constexpr int BM = 256, BK = 64, HALF = 128, HTB = HALF * BK * 2  , STAGE_BYTES = 8 * HTB, NXCD = 8, WGM = 8;

__host__ __device__ __forceinline__ int lds_byte(int r, int c) { const int st = (r >> 4) * 2 + (c >> 5), rr = r & 15, cc = c & 31, ob = rr * 64 + cc * 2; return st * 1024 + (ob ^ (((ob >> 9) & 1) << 5)); }
__host__ __device__ __forceinline__ void stage_rc(int b, int& R, int& C) { const int st = b / 1024, sb = b % 1024, swz = sb ^ (((sb >> 9) & 1) << 5); R = (st >> 1) * 16 + swz / 64; C = (st & 1) * 32 + (swz % 64) / 2; }
__host__ __device__ __forceinline__ int perm32(int rho) { const int n = rho >> 4, i = rho & 15; return 8 * (i >> 2) + 4 * n + (i & 3); }

struct Unit { int pm, pn; };
struct Gemm { const bf16_t* A; const bf16_t* Bt; int M, N, K; };

struct StaticOrder {
    int nM, nN, nwg, G, c;
    __host__ __device__ void init(int M, int N, int G_, int c_) { nM = M / BM; nN = N / BM; nwg = nM * nN; G = G_; c = c_; }
    __host__ __device__ bool next(int i, Unit& u) const {
        const long L = (long)i * G + c; if (L >= nwg) return false;
        int wgid = (int)L; { const int q = nwg / NXCD, r = nwg % NXCD, xcd = wgid % NXCD, off = wgid / NXCD; wgid = (xcd < r ? xcd * (q + 1) : r * (q + 1) + (xcd - r) * q) + off; }
        const int nig = WGM * nN, gid = wgid / nig, fm = gid * WGM, gsz = (nM - fm) < WGM ? (nM - fm) : WGM;
        u.pm = fm + ((wgid % nig) % gsz); u.pn = (wgid % nig) / gsz; return true;
    }
    __device__ __forceinline__ void a_ready(const Unit&) const {}
    __device__ __forceinline__ void done(const Unit&) const {}
};

__device__ __forceinline__ unsigned cvt_pk_bf16(float lo, float hi) { unsigned r; asm volatile("v_cvt_pk_bf16_f32 %0, %1, %2" : "=v"(r) : "v"(lo), "v"(hi)); return r; }
template <class Epi, class Sched, bool ALIGN_EPI = false, bool SP2 = false, bool GATHER = false>
__device__ __forceinline__ void gemm_phase(PG8_LAS unsigned char* lds, const Gemm g, const Sched& S, const Epi& E, const PG8_LAS int* rowlists = nullptr) {
    static_assert(!GATHER || SP2, "GATHER is implemented for the SP2 loop");
    const int tid = threadIdx.x, wid = __builtin_amdgcn_readfirstlane(tid >> 6), lane = tid & 63, wr = wid >> 2, wc = wid & 3, fr = lane & 15, fq = lane >> 4;
    const int K = g.K, nt = K / BK;
    unsigned voffA[2], voffB[2]; int gR[2], gC[2];
#pragma unroll
    for (int i = 0; i < 2; ++i) { int R, C; stage_rc(tid * 16 + i * 8192, R, C); const int Rb = Epi::PERM ? ((R & ~31) + perm32(R & 31)) : R; gR[i] = R; gC[i] = C;
        voffA[i] = (unsigned)(R * K + C) * 2u; voffB[i] = (unsigned)(Rb * K + C) * 2u; }
    unsigned vC0[2], vC1[2], vN0[2], vN1[2];
#define PG8_ROWOFFS(d0, d1, ui_) do { _Pragma("unroll") for (int i_ = 0; i_ < 2; ++i_) { \
        d0[i_] = (unsigned)(rowlists[(ui_) * 256 + gR[i_]] * K + gC[i_]) * 2u; d1[i_] = (unsigned)(rowlists[(ui_) * 256 + HALF + gR[i_]] * K + gC[i_]) * 2u; } } while (0)
    const size_t kstep = (size_t)(BK * 2);
    const size_t hstep = (size_t)HALF * K * 2;
    const size_t tstep = 2 * hstep;
    const unsigned ldsw = (unsigned)wid * 1024u;
    const int aoff = lds_byte(wr * 64 + fr, fq * 8), boff = lds_byte(wc * 32 + fr, fq * 8);
#define PG8_SA(b, h) (((b) * 2 + (h)) * HTB)
#define PG8_SB(b, h) ((4 + (b) * 2 + (h)) * HTB)
#define PG8_STAGE(bufoff, gbase, voff) do { _Pragma("unroll") for (int _i = 0; _i < 2; ++_i) \
        __builtin_amdgcn_global_load_lds((const unsigned*)((const char*)(gbase) + (voff)[_i]), (PG8_LAS unsigned*)(lds + (bufoff) + ldsw + _i * 8192), 16, 0, 0); } while (0)
#define PG8_LDA(dst, b, h) do { _Pragma("unroll") for (int m = 0; m < 4; ++m) _Pragma("unroll") for (int k = 0; k < 2; ++k) dst[m][k] = *(const PG8_LAS bf16x8*)(lds + PG8_SA(b, h) + aoff + m * 2048 + k * 1024); } while (0)
#define PG8_LDB(dst, b, h) do { _Pragma("unroll") for (int n = 0; n < 2; ++n) _Pragma("unroll") for (int k = 0; k < 2; ++k) dst[n][k] = *(const PG8_LAS bf16x8*)(lds + PG8_SB(b, h) + boff + n * 2048 + k * 1024); } while (0)
#define PG8_MMA(ai, bj, At, Bt) do { __builtin_amdgcn_s_setprio(1); _Pragma("unroll") for (int m = 0; m < 4; ++m) _Pragma("unroll") for (int n = 0; n < 2; ++n) _Pragma("unroll") for (int k = 0; k < 2; ++k) \
        acc[ai][bj][m][n] = __builtin_amdgcn_mfma_f32_16x16x32_bf16(Bt[n][k], At[m][k], acc[ai][bj][m][n], 0, 0, 0); __builtin_amdgcn_s_setprio(0); } while (0)
#define PG8_WAIT_V(n) asm volatile("s_waitcnt vmcnt(" #n ")" ::: "memory")
#define PG8_WAIT_L(n) asm volatile("s_waitcnt lgkmcnt(" #n ")" ::: "memory")
#define PG8_BAR __builtin_amdgcn_s_barrier()
#define PG8_SCHED __builtin_amdgcn_sched_barrier(0)
    Unit cur, nxt; int ui = 0;
    if (!S.next(0, cur)) return;
    f32x4 acc[2][2][4][2];
#pragma unroll
    for (int a = 0; a < 2; ++a)
#pragma unroll
        for (int b = 0; b < 2; ++b)
#pragma unroll
            for (int m = 0; m < 4; ++m)
#pragma unroll
                for (int n = 0; n < 2; ++n) acc[a][b][m][n] = (f32x4){0.f, 0.f, 0.f, 0.f};
    bf16x8 At[4][2], B0[2][2], B1[2][2];
    const char* cA = GATHER ? (const char*)g.A : (const char*)g.A + (size_t)cur.pm * tstep; const char* cB = (const char*)g.Bt + (size_t)cur.pn * tstep;
    if constexpr (GATHER) { PG8_ROWOFFS(vC0, vC1, 0); vN0[0] = vC0[0]; vN0[1] = vC0[1]; vN1[0] = vC1[0]; vN1[1] = vC1[1]; }
#define PG8_STAGE_A(bufoff, kptr, half, v0, v1) do { if constexpr (GATHER) { if ((half) == 0) PG8_STAGE(bufoff, kptr, v0); else PG8_STAGE(bufoff, kptr, v1); } \
        else { PG8_STAGE(bufoff, (kptr) + (half) * hstep, voffA); } } while (0)
    S.a_ready(cur);
    if constexpr (SP2) {
        PG8_STAGE(PG8_SB(0, 0), cB, voffB); PG8_STAGE(PG8_SB(0, 1), cB + hstep, voffB); PG8_STAGE_A(PG8_SA(0, 0), cA, 0, vC0, vC1); PG8_STAGE_A(PG8_SA(0, 1), cA, 1, vC0, vC1);
        if (wr == 1) PG8_BAR;
        PG8_WAIT_V(2); PG8_BAR;
        PG8_STAGE(PG8_SB(1, 0), cB + kstep, voffB); PG8_STAGE_A(PG8_SA(1, 0), cA + kstep, 0, vC0, vC1); PG8_STAGE(PG8_SB(1, 1), cB + hstep + kstep, voffB);
        PG8_WAIT_V(6); PG8_BAR;
    } else {
        PG8_STAGE(PG8_SB(0, 0), cB, voffB); PG8_STAGE(PG8_SA(0, 0), cA, voffA); PG8_STAGE(PG8_SB(0, 1), cB + hstep, voffB); PG8_STAGE(PG8_SA(0, 1), cA + hstep, voffA);
        if (wr == 1) PG8_BAR;
        PG8_WAIT_V(4); PG8_BAR;
        PG8_STAGE(PG8_SB(1, 0), cB + kstep, voffB); PG8_STAGE(PG8_SA(1, 0), cA + kstep, voffA); PG8_STAGE(PG8_SB(1, 1), cB + hstep + kstep, voffB);
        PG8_WAIT_V(6); PG8_BAR;
    }
    for (;;) {
        const bool has_next = S.next(ui + 1, nxt);
        const char* nA = GATHER ? cA : (has_next ? (const char*)g.A + (size_t)nxt.pm * tstep : cA);
        if constexpr (GATHER) { if (has_next) { PG8_ROWOFFS(vN0, vN1, ui + 1); } else { vN0[0] = vC0[0]; vN0[1] = vC0[1]; vN1[0] = vC1[0]; vN1[1] = vC1[1]; } } const char* nB = has_next ? (const char*)g.Bt + (size_t)nxt.pn * tstep : cB;
        for (int t = 0; t < nt; t += 2) {
            const bool last = (t == nt - 2);
            if constexpr (Epi::MIDK) { if (t == (nt >> 1)) E.mid(acc, cur, wr, wc, fr, fq); }
            const char* a1 = cA + (size_t)(t + 1) * kstep;
            const char* a2 = last ? nA : cA + (size_t)(t + 2) * kstep; const char* b2 = last ? nB : cB + (size_t)(t + 2) * kstep;
            const char* a3 = a2 + kstep; const char* b3 = b2 + kstep;
            if (last && has_next) S.a_ready(nxt);
            unsigned vS0[2], vS1[2];
            if constexpr (GATHER) { vS0[0] = last ? vN0[0] : vC0[0]; vS0[1] = last ? vN0[1] : vC0[1]; vS1[0] = last ? vN1[0] : vC1[0]; vS1[1] = last ? vN1[1] : vC1[1]; }
            if constexpr (SP2) {
            PG8_LDB(B0, 0, 0); PG8_LDB(B1, 0, 1); PG8_SCHED; PG8_LDA(At, 0, 0); PG8_STAGE_A(PG8_SA(1, 1), a1, 1, vC0, vC1);
            PG8_WAIT_V(8); PG8_WAIT_L(0); PG8_BAR; PG8_MMA(0, 0, At, B0); PG8_MMA(0, 1, At, B1); PG8_BAR; PG8_SCHED;
            PG8_LDA(At, 0, 1); PG8_STAGE(PG8_SB(0, 0), b2, voffB); PG8_STAGE(PG8_SB(0, 1), b2 + hstep, voffB); PG8_STAGE_A(PG8_SA(0, 0), a2, 0, vS0, vS1);
            PG8_WAIT_V(8); PG8_WAIT_L(0); PG8_BAR; PG8_MMA(1, 0, At, B0); PG8_MMA(1, 1, At, B1); PG8_BAR; PG8_SCHED;
            PG8_LDB(B0, 1, 0); PG8_LDB(B1, 1, 1); PG8_SCHED; PG8_LDA(At, 1, 0); PG8_STAGE_A(PG8_SA(0, 1), a2, 1, vS0, vS1);
            PG8_WAIT_V(8); PG8_WAIT_L(0); PG8_BAR; PG8_MMA(0, 0, At, B0); PG8_MMA(0, 1, At, B1); PG8_BAR; PG8_SCHED;
            PG8_LDA(At, 1, 1); PG8_STAGE(PG8_SB(1, 0), b3, voffB); PG8_STAGE(PG8_SB(1, 1), b3 + hstep, voffB); PG8_STAGE_A(PG8_SA(1, 0), a3, 0, vS0, vS1);
            PG8_WAIT_V(8); PG8_WAIT_L(0); PG8_BAR; PG8_MMA(1, 0, At, B0); PG8_MMA(1, 1, At, B1); PG8_BAR; PG8_SCHED;
            } else {
            PG8_LDB(B0, 0, 0); PG8_SCHED; PG8_LDA(At, 0, 0); PG8_STAGE(PG8_SA(1, 1), a1 + hstep, voffA);
            PG8_WAIT_L(8); PG8_BAR; PG8_WAIT_L(0); PG8_MMA(0, 0, At, B0); PG8_BAR; PG8_SCHED;
            PG8_LDB(B1, 0, 1); PG8_STAGE(PG8_SB(0, 0), b2, voffB);
            PG8_BAR; PG8_WAIT_L(0); PG8_MMA(0, 1, At, B1); PG8_BAR;
            PG8_LDA(At, 0, 1); PG8_STAGE(PG8_SA(0, 0), a2, voffA);
            PG8_BAR; PG8_WAIT_L(0); PG8_MMA(1, 0, At, B0); PG8_BAR; PG8_SCHED;
            PG8_STAGE(PG8_SB(0, 1), b2 + hstep, voffB);
            PG8_WAIT_V(6); PG8_BAR; PG8_MMA(1, 1, At, B1); PG8_BAR;
            PG8_LDB(B0, 1, 0); PG8_SCHED; PG8_LDA(At, 1, 0); PG8_STAGE(PG8_SA(0, 1), a2 + hstep, voffA);
            PG8_WAIT_L(8); PG8_BAR; PG8_WAIT_L(0); PG8_MMA(0, 0, At, B0); PG8_BAR; PG8_SCHED;
            PG8_LDB(B1, 1, 1); PG8_STAGE(PG8_SB(1, 0), b3, voffB);
            PG8_BAR; PG8_WAIT_L(0); PG8_MMA(0, 1, At, B1); PG8_BAR;
            PG8_LDA(At, 1, 1); PG8_STAGE(PG8_SA(1, 0), a3, voffA);
            PG8_BAR; PG8_WAIT_L(0); PG8_MMA(1, 0, At, B0); PG8_BAR; PG8_SCHED;
            PG8_STAGE(PG8_SB(1, 1), b3 + hstep, voffB);
            PG8_WAIT_V(6); PG8_BAR; PG8_MMA(1, 1, At, B1); PG8_BAR;
            }
        }
        if constexpr (ALIGN_EPI) { if (wr == 0) PG8_BAR; }
        if constexpr (!Epi::AFTER_DRAIN) { E(acc, cur, wr, wc, fr, fq); S.done(cur); }
        if (!has_next) break;
#pragma unroll
        for (int a = 0; a < 2; ++a)
#pragma unroll
            for (int b = 0; b < 2; ++b)
#pragma unroll
                for (int m = 0; m < 4; ++m)
#pragma unroll
                    for (int n = 0; n < 2; ++n) acc[a][b][m][n] = (f32x4){0.f, 0.f, 0.f, 0.f};
        cur = nxt; cA = nA; cB = nB; ++ui;
        if constexpr (GATHER) { vC0[0] = vN0[0]; vC0[1] = vN0[1]; vC1[0] = vN1[0]; vC1[1] = vN1[1]; }
        if constexpr (ALIGN_EPI) { if (wr == 1) PG8_BAR; }
    }
    PG8_WAIT_V(0);
    if constexpr (!ALIGN_EPI) { if (wr == 0) PG8_BAR; }
    PG8_BAR;
    if constexpr (Epi::AFTER_DRAIN) { E.fused(acc, cur, wr, wc, fr, fq, lds, wid, lane); S.done(cur); }
#undef PG8_SA
#undef PG8_STAGE_A
#undef PG8_ROWOFFS
#undef PG8_SB
#undef PG8_STAGE
#undef PG8_LDA
#undef PG8_LDB
#undef PG8_MMA
#undef PG8_WAIT_V
#undef PG8_WAIT_L
#undef PG8_BAR
#undef PG8_SCHED
}
}

constexpr int NB = 4, SEQ = 4096, DM = 1024, NTOK = NB * SEQ, DIN = 7168, NH = 8, HD = 128;
constexpr int NEXP = 32, TOPK = 4, MAXBLK = 288, RMAX = MAXBLK * 256;
constexpr float EPS = 1e-6f;
constexpr int NWAVES = 8;

constexpr size_t MiB = 1u << 20, KiB = 1u << 10;
constexpr size_t WS_CTL = 0, CTL_ZERO_BYTES = 1 * MiB;
constexpr size_t WS_MOD = 1 * MiB;
constexpr size_t WS_KMEAN = 1 * MiB + 128 * KiB;
constexpr size_t WS_AGGP = 1 * MiB + 384 * KiB;
constexpr size_t WS_AGGH = 1 * MiB + 640 * KiB;
constexpr size_t WS_WRH = 2 * MiB, WS_WRL = 2 * MiB + 64 * KiB;
constexpr size_t WS_TOKE = 3 * MiB, WS_TOKPOS = 3 * MiB + 256 * KiB;
constexpr int ECAP = 16384;
constexpr size_t WS_ROWTOK = 28 * MiB, WS_ROWGATE = 30 * MiB;
constexpr int CW_CNT = 8192;
constexpr size_t WS_TRIG = 4 * MiB;
constexpr size_t WS_WRG = 6 * MiB;
constexpr size_t WS_WIN = 8 * MiB;
constexpr size_t WS_WB = 22 * MiB;
constexpr size_t WS_WO = 26 * MiB;
constexpr size_t WS_WUP = 32 * MiB;
constexpr size_t WS_WDN = 160 * MiB;
constexpr size_t WS_HB = 224 * MiB;
constexpr size_t WS_E = 256 * MiB;
constexpr size_t E_STRIDE = (size_t)NTOK * DM;
constexpr size_t WS_HL = 480 * MiB, WS_PP = 512 * MiB, WS_YCAT = 544 * MiB;
constexpr int CW_MODCNT = 8256;
constexpr size_t WS_ACT = 400 * MiB, WS_YR = 544 * MiB;
constexpr size_t WS_END = 688 * MiB;
constexpr int CW_BAR = 4096;

constexpr int RING_OFF = 0, RING_BYTES = 131072;
constexpr int LDSCTL_OFF = RING_BYTES, MISC_OFF = LDSCTL_OFF + 320;
constexpr int XTRA_OFF = LDSCTL_OFF + 1024;
constexpr int LDS_BYTES = 147456;

#define GAS __attribute__((address_space(1)))
#define LAS __attribute__((address_space(3)))
typedef unsigned short bf16;
typedef unsigned v4u __attribute__((ext_vector_type(4)));
typedef unsigned v2u __attribute__((ext_vector_type(2)));
typedef float f32x4 __attribute__((ext_vector_type(4)));
typedef float f32x2 __attribute__((ext_vector_type(2)));
typedef float f32x16 __attribute__((ext_vector_type(16)));
typedef short bf16x8 __attribute__((ext_vector_type(8)));
typedef short s16x4 __attribute__((ext_vector_type(4)));
typedef GAS unsigned gu32;
#define RLX_AGENT __ATOMIC_RELAXED, __HIP_MEMORY_SCOPE_AGENT
#define LDS_WAIT() asm volatile("s_waitcnt lgkmcnt(0)" ::: "memory")
#define VM_WAIT() asm volatile("s_waitcnt vmcnt(0)" ::: "memory")
#define SBAR() __builtin_amdgcn_sched_barrier(0)
__device__ __forceinline__ unsigned f2bf(float f) { unsigned u = __builtin_bit_cast(unsigned, f); return (u + 0x7fffu + ((u >> 16) & 1u)) >> 16; }
__device__ __forceinline__ unsigned pk2(float lo, float hi) { return f2bf(lo) | (f2bf(hi) << 16); }
__device__ __forceinline__ float bf2f(unsigned short h) { return __builtin_bit_cast(float, (unsigned)h << 16); }
__device__ __forceinline__ float bflo(unsigned w) { return __builtin_bit_cast(float, w << 16); }
__device__ __forceinline__ float bfhi(unsigned w) { return __builtin_bit_cast(float, w & 0xffff0000u); }
__device__ __forceinline__ unsigned cvtpk(float lo, float hi) { unsigned r; asm volatile("v_cvt_pk_bf16_f32 %0, %1, %2" : "=v"(r) : "v"(lo), "v"(hi)); return r; }
__device__ __forceinline__ float fast_sigmoid(float x) { return __builtin_amdgcn_rcpf(1.0f + __builtin_amdgcn_exp2f(-1.4426950408889634f * x)); }
__device__ __forceinline__ float gelu_tanh(float x) { const float z = 1.5957691216057308f * (x + 0.044715f * x * x * x); return x * fast_sigmoid(z); }
__device__ __forceinline__ float wave_sum(float v) {
#pragma unroll
    for (int o = 1; o < 64; o <<= 1) v += __shfl_xor(v, o);
    return v;
}
__device__ __forceinline__ float wave_max(float v) {
#pragma unroll
    for (int o = 1; o < 64; o <<= 1) v = fmaxf(v, __shfl_xor(v, o));
    return v;
}

#define XB_TMO      128
#define XB_XCNT(j)  (256  + 64 * (j))
#define XB_XSUB(j)  (1280 + 64 * (j))
#define XB_XGEN(j)  (2304 + 64 * (j))
#define XB_TOP      3328
#define XB_TOPGEN   3392
#define XCD_BAR_WORDS 3456
#define XB_SPIN_CAP (1u << 20)
__device__ __forceinline__ unsigned xb_ld(unsigned* p)              { return __hip_atomic_load(p, __ATOMIC_RELAXED, __HIP_MEMORY_SCOPE_AGENT); }
__device__ __forceinline__ unsigned xb_add(unsigned* p, unsigned v) { return __hip_atomic_fetch_add(p, v, __ATOMIC_RELAXED, __HIP_MEMORY_SCOPE_AGENT); }
__device__ __forceinline__ unsigned xb_xcc_id() { return (unsigned)__builtin_amdgcn_s_getreg((3 << 11) | 20) & 0xFu; }
#define XB_SPIN(cond, bar) do { unsigned _sp = 0; while (cond) { __builtin_amdgcn_s_sleep(1); \
    if ((++_sp & 255u) == 0u) { if (xb_ld(&(bar)[XB_TMO])) break; if (_sp > XB_SPIN_CAP) { atomicAdd(&(bar)[XB_TMO], 1u); break; } } } } while (0)
struct XcdBarrier { unsigned* bar; unsigned x; volatile LAS unsigned* st; };
__device__ __forceinline__ XcdBarrier xcd_barrier_post(unsigned* bar, volatile LAS unsigned* st) {
    XcdBarrier b; b.bar = bar; b.x = xb_xcc_id(); b.st = st;
    if (threadIdx.x == 0) (void)xb_add(&bar[XB_XCNT(b.x)], 1u);
    return b;
}
__device__ __forceinline__ void xcd_barrier_complete(unsigned* bar, unsigned x, unsigned& nloc, unsigned& nx) {
    const unsigned G = gridDim.x * gridDim.y * gridDim.z;
    unsigned sum, cnt, mine, sp = 0u;
    for (;;) {
        sum = 0u; cnt = 0u; mine = 0u;
#pragma unroll
        for (unsigned j = 0; j < 16; ++j) { const unsigned c = xb_ld(&bar[XB_XCNT(j)]); sum += c; cnt += (c > 0u) ? 1u : 0u; mine = (j == x) ? c : mine; }
        if (sum == G) break;
        __builtin_amdgcn_s_sleep(1);
        if ((++sp & 255u) == 0u) { if (xb_ld(&bar[XB_TMO])) break; if (sp > XB_SPIN_CAP) { atomicAdd(&bar[XB_TMO], 1u); break; } }
    }
    nloc = mine > 0u ? mine : 1u; nx = cnt > 0u ? cnt : 1u;
}
__device__ __forceinline__ void xcd_barrier(const XcdBarrier& b) {
    asm volatile("s_waitcnt vmcnt(0)" ::: "memory");
    __syncthreads();
    if (threadIdx.x == 0) {
        unsigned* bar = b.bar;
        __builtin_amdgcn_s_waitcnt(0);
        unsigned nloc = b.st[0], nx = b.st[1];
        if (nloc == 0u) { xcd_barrier_complete(bar, b.x, nloc, nx); b.st[0] = nloc; b.st[1] = nx; }
        const unsigned old = xb_add(&bar[XB_XSUB(b.x)], 1u);
        const unsigned gen = old / nloc;
        if (old + 1u == (gen + 1u) * nloc) {
            __builtin_amdgcn_fence(__ATOMIC_RELEASE, "agent");
            asm volatile("s_waitcnt vmcnt(0)" ::: "memory");
            const unsigned og = xb_add(&bar[XB_TOP], 1u);
            const unsigned tg = og / nx;
            if (og + 1u == (tg + 1u) * nx) xb_add(&bar[XB_TOPGEN], 1u);
            else XB_SPIN(xb_ld(&bar[XB_TOPGEN]) == tg, bar);
            __builtin_amdgcn_fence(__ATOMIC_ACQUIRE, "agent");
            xb_add(&bar[XB_XGEN(b.x)], 1u);
            asm volatile("s_waitcnt vmcnt(0)" ::: "memory");
        } else {
            XB_SPIN(xb_ld(&bar[XB_XGEN(b.x)]) == gen, bar);
            __builtin_amdgcn_fence(__ATOMIC_ACQUIRE, "agent");
            asm volatile("s_waitcnt vmcnt(0)" ::: "memory");
        }
    }
    __syncthreads();
}

struct Args { const void* in[26]; float* out; unsigned char* ws; int ph_lo, ph_hi; };
struct Frame {
    LAS unsigned char* lds; char* ldsg;
    volatile LAS unsigned* MISC;
    int tid, lane, wave, vcu, G;
    unsigned char* ws; float* out;
};
#define IN_F(k) ((const float*)args.in[k])
#define IN_I(k) ((const int*)args.in[k])
#define WSP(T, off) ((T*)(F.ws + (off)))

namespace pg8 {
struct TileOrder {
    int nM, nN, nwg, G, c; const LAS int* blk_exp;
    __device__ void init(int nM_, int nN_, int G_, int c_, const LAS int* be) { nM = nM_; nN = nN_; nwg = nM * nN; G = G_; c = c_; blk_exp = be; }
    __device__ bool next(int i, Unit& u) const {
        const long L = (long)i * G + c; if (L >= nwg) return false;
        int wgid = (int)L; { const int q = nwg / NXCD, r = nwg % NXCD, xcd = wgid % NXCD, off = wgid / NXCD; wgid = (xcd < r ? xcd * (q + 1) : r * (q + 1) + (xcd - r) * q) + off; }
        const int nig = WGM * nN, gid = wgid / nig, fm = gid * WGM, gsz = (nM - fm) < WGM ? (nM - fm) : WGM;
        u.pm = fm + ((wgid % nig) % gsz); u.pn = (wgid % nig) / gsz;
        if (blk_exp) { const int e = __builtin_amdgcn_readfirstlane(blk_exp[u.pm]); u.pn += e * nN; }
        return true;
    }
    __device__ __forceinline__ void a_ready(const Unit&) const {}
    __device__ __forceinline__ void done(const Unit&) const {}
};

struct EpiWin {
    static constexpr bool PERM = true, AFTER_DRAIN = false, MIDK = false;
    bf16_t* E; const float* b_gate;
    __device__ __forceinline__ void operator()(const f32x4 (&acc)[2][2][4][2], const Unit& u, int wr, int wc, int fr, int fq) const {
        const int t = u.pn >> 2, colt = (u.pn & 3) * BM;
        bf16_t* base = E + (size_t)t * ((size_t)16384 * 1024);
        const int row0 = u.pm * BM + wr * 64 + fr, col0 = colt + wc * 32 + 8 * fq;
        f32x4 bv[2][2];
#pragma unroll
        for (int bj = 0; bj < 2; ++bj)
#pragma unroll
            for (int n = 0; n < 2; ++n) bv[bj][n] = (t >= 5) ? *(const f32x4*)(b_gate + (t - 5) * 1024 + col0 + bj * HALF + 4 * n) : (f32x4){0.f, 0.f, 0.f, 0.f};
#pragma unroll
        for (int ai = 0; ai < 2; ++ai)
#pragma unroll
            for (int m = 0; m < 4; ++m) { bf16_t* rowp = base + (size_t)(row0 + ai * HALF + m * 16) * 1024 + col0;
#pragma unroll
                for (int bj = 0; bj < 2; ++bj) { f32x4 v0 = acc[ai][bj][m][0] + bv[bj][0], v1 = acc[ai][bj][m][1] + bv[bj][1];
                    if (t == 1) {
#pragma unroll
                        for (int j = 0; j < 4; ++j) { v0[j] = gelu_tanh(v0[j]); v1[j] = gelu_tanh(v1[j]); } }
                    else if (t >= 5) {
#pragma unroll
                        for (int j = 0; j < 4; ++j) { v0[j] = fast_sigmoid(v0[j]); v1[j] = fast_sigmoid(v1[j]); } }
                    u32x4 w; w.x = cvt_pk_bf16(v0[0], v0[1]); w.y = cvt_pk_bf16(v0[2], v0[3]); w.z = cvt_pk_bf16(v1[0], v1[1]); w.w = cvt_pk_bf16(v1[2], v1[3]);
                    *(u32x4*)(rowp + bj * HALF) = w; } }
    }
};
struct EpiBranch {
    static constexpr bool PERM = true, AFTER_DRAIN = false, MIDK = true;
    const bf16_t* SG0; const bf16_t* SG1; bf16_t* MIX;
    __device__ __forceinline__ void mid(f32x4 (&acc)[2][2][4][2], const Unit& u, int wr, int wc, int fr, int fq) const {
        int row0 = u.pm * BM + wr * 64 + fr; const int col0 = u.pn * BM + wc * 32 + 8 * fq;
        asm volatile("" : "+v"(row0));
#pragma unroll
        for (int ai = 0; ai < 2; ++ai)
#pragma unroll
            for (int m = 0; m < 4; ++m) { const size_t ro = (size_t)(row0 + ai * HALF + m * 16) * 1024 + col0;
#pragma unroll
                for (int bj = 0; bj < 2; ++bj) { const size_t o = ro + bj * HALF;
                    const u32x4 a = *(const u32x4*)(SG0 + o), b = *(const u32x4*)(SG1 + o);
                    const float r0 = bflo(a.x) * __builtin_amdgcn_rcpf(fmaxf(bflo(b.x), 1e-18f)), r1 = bfhi(a.x) * __builtin_amdgcn_rcpf(fmaxf(bfhi(b.x), 1e-18f));
                    const float r2 = bflo(a.y) * __builtin_amdgcn_rcpf(fmaxf(bflo(b.y), 1e-18f)), r3 = bfhi(a.y) * __builtin_amdgcn_rcpf(fmaxf(bfhi(b.y), 1e-18f));
                    const float r4 = bflo(a.z) * __builtin_amdgcn_rcpf(fmaxf(bflo(b.z), 1e-18f)), r5 = bfhi(a.z) * __builtin_amdgcn_rcpf(fmaxf(bfhi(b.z), 1e-18f));
                    const float r6 = bflo(a.w) * __builtin_amdgcn_rcpf(fmaxf(bflo(b.w), 1e-18f)), r7 = bfhi(a.w) * __builtin_amdgcn_rcpf(fmaxf(bfhi(b.w), 1e-18f));
                    acc[ai][bj][m][0] *= (f32x4){r0, r1, r2, r3}; acc[ai][bj][m][1] *= (f32x4){r4, r5, r6, r7}; }
                asm volatile("" ::: "memory"); }
    }
    __device__ __forceinline__ void operator()(const f32x4 (&acc)[2][2][4][2], const Unit& u, int wr, int wc, int fr, int fq) const {
        int row0 = u.pm * BM + wr * 64 + fr; const int col0 = u.pn * BM + wc * 32 + 8 * fq;
        asm volatile("" : "+v"(row0));
#pragma unroll
        for (int ai = 0; ai < 2; ++ai)
#pragma unroll
            for (int m = 0; m < 4; ++m) { const size_t ro = (size_t)(row0 + ai * HALF + m * 16) * 1024 + col0;
#pragma unroll
                for (int bj = 0; bj < 2; ++bj) { const size_t o = ro + bj * HALF;
                    const u32x4 b = *(const u32x4*)(SG1 + o);
                    const f32x4 g0 = {fmaxf(bflo(b.x), 1e-18f), fmaxf(bfhi(b.x), 1e-18f), fmaxf(bflo(b.y), 1e-18f), fmaxf(bfhi(b.y), 1e-18f)}, g1 = {fmaxf(bflo(b.z), 1e-18f), fmaxf(bfhi(b.z), 1e-18f), fmaxf(bflo(b.w), 1e-18f), fmaxf(bfhi(b.w), 1e-18f)};
                    const f32x4 v0 = acc[ai][bj][m][0] * g0, v1 = acc[ai][bj][m][1] * g1;
                    u32x4 w; w.x = cvt_pk_bf16(v0[0], v0[1]); w.y = cvt_pk_bf16(v0[2], v0[3]); w.z = cvt_pk_bf16(v1[0], v1[1]); w.w = cvt_pk_bf16(v1[2], v1[3]);
                    *(u32x4*)(MIX + o) = w; } }
    }
};
struct EpiWout {
    static constexpr bool PERM = false, AFTER_DRAIN = false, MIDK = false;
    const float* x; float* out; const float* mod;
    __device__ __forceinline__ void operator()(const f32x4 (&acc)[2][2][4][2], const Unit& u, int wr, int wc, int fr, int fq) const {
        const int row0 = u.pm * BM + wr * 64 + fr, col0 = u.pn * BM + wc * 32 + 4 * fq;
        const float* g1p = mod + (size_t)(u.pm >> 4) * 6144 + 2048;
        f32x4 gv[2][2];
#pragma unroll
        for (int bj = 0; bj < 2; ++bj)
#pragma unroll
            for (int n = 0; n < 2; ++n) gv[bj][n] = *(const f32x4*)(g1p + col0 + bj * HALF + n * 16);
#pragma unroll
        for (int ai = 0; ai < 2; ++ai)
#pragma unroll
            for (int m = 0; m < 4; ++m) { const size_t ro = (size_t)(row0 + ai * HALF + m * 16) * 1024 + col0;
#pragma unroll
                for (int bj = 0; bj < 2; ++bj)
#pragma unroll
                    for (int n = 0; n < 2; ++n) { const size_t o = ro + bj * HALF + n * 16; *(f32x4*)(out + o) = *(const f32x4*)(x + o) + gv[bj][n] * acc[ai][bj][m][n]; } }
    }
};
struct EpiUp {
    static constexpr bool PERM = true, AFTER_DRAIN = false, MIDK = false;
    bf16_t* ACT; const float* b_up;
    __device__ __forceinline__ void operator()(const f32x4 (&acc)[2][2][4][2], const Unit& u, int wr, int wc, int fr, int fq) const {
        const int e = u.pn >> 3, p = u.pn & 7;
        const int row0 = u.pm * BM + wr * 64 + fr, c0 = p * 128 + wc * 32 + 8 * fq;
        const float* bg = b_up + (size_t)e * 2048 + c0; const float* bl = bg + 1024;
        f32x4 bgv[2], blv[2];
#pragma unroll
        for (int n = 0; n < 2; ++n) { bgv[n] = *(const f32x4*)(bg + 4 * n); blv[n] = *(const f32x4*)(bl + 4 * n); }
#pragma unroll
        for (int ai = 0; ai < 2; ++ai)
#pragma unroll
            for (int m = 0; m < 4; ++m) { bf16_t* rowp = ACT + (size_t)(row0 + ai * HALF + m * 16) * 1024 + c0;
                f32x4 a[2];
#pragma unroll
                for (int n = 0; n < 2; ++n) { const f32x4 g = acc[ai][0][m][n] + bgv[n], l = acc[ai][1][m][n] + blv[n];
#pragma unroll
                    for (int j = 0; j < 4; ++j) { const float gg = fminf(g[j], 7.0f), ll = fminf(fmaxf(l[j], -7.0f), 7.0f); a[n][j] = (ll + 1.0f) * gg * fast_sigmoid(1.702f * gg); } }
                u32x4 w; w.x = cvt_pk_bf16(a[0][0], a[0][1]); w.y = cvt_pk_bf16(a[0][2], a[0][3]); w.z = cvt_pk_bf16(a[1][0], a[1][1]); w.w = cvt_pk_bf16(a[1][2], a[1][3]);
                *(u32x4*)rowp = w; }
    }
};
struct EpiDown {
    static constexpr bool PERM = true, AFTER_DRAIN = false, MIDK = false;
    bf16_t* YR; const float* b_down; const float* row_gate; const LAS int* tbl;
    __device__ __forceinline__ void operator()(const f32x4 (&acc)[2][2][4][2], const Unit& u, int wr, int wc, int fr, int fq) const {
        const int e = u.pn >> 2, p = u.pn & 3;
        const int row0 = u.pm * BM + wr * 64 + fr, c0 = p * BM + wc * 32 + 8 * fq;
        f32x4 bv[2][2];
#pragma unroll
        for (int bj = 0; bj < 2; ++bj)
#pragma unroll
            for (int n = 0; n < 2; ++n) bv[bj][n] = *(const f32x4*)(b_down + (size_t)e * 1024 + c0 + bj * HALF + 4 * n);
#pragma unroll
        for (int ai = 0; ai < 2; ++ai)
#pragma unroll
            for (int m = 0; m < 4; ++m) { const int r = row0 + ai * HALF + m * 16; const int pos = r - tbl[32 + e] * 256;
                const float gt = pos < tbl[e] ? __hip_atomic_load(row_gate + (size_t)e * 16384 + pos, __ATOMIC_RELAXED, __HIP_MEMORY_SCOPE_AGENT) : 0.0f;
                bf16_t* rowp = YR + (size_t)r * 1024 + c0;
#pragma unroll
                for (int bj = 0; bj < 2; ++bj) { const f32x4 v0 = (acc[ai][bj][m][0] + bv[bj][0]) * gt, v1 = (acc[ai][bj][m][1] + bv[bj][1]) * gt;
                    u32x4 w; w.x = cvt_pk_bf16(v0[0], v0[1]); w.y = cvt_pk_bf16(v0[2], v0[3]); w.z = cvt_pk_bf16(v1[0], v1[1]); w.w = cvt_pk_bf16(v1[2], v1[3]);
                    *(u32x4*)(rowp + bj * HALF) = w; } }
    }
};
}

__device__ __forceinline__ void p0_transpose_item(const float* W, int N, bf16* WT, int Kd, size_t dst_row0, LAS float* scr, int k0, int n0, int lane) {
#pragma unroll 8
    for (int i = 0; i < 32; ++i) { const int kk = 2 * i + (lane >> 5); scr[kk * 33 + (lane & 31)] = W[(size_t)(k0 + kk) * N + n0 + (lane & 31)]; }
    LDS_WAIT(); asm volatile("" ::: "memory");
    const int c = lane & 7;
#pragma unroll
    for (int j = 0; j < 4; ++j) { const int n = (lane >> 3) + 8 * j; const LAS float* s = scr + (8 * c) * 33 + n;
        v4u o; o.x = pk2(s[0 * 33], s[1 * 33]); o.y = pk2(s[2 * 33], s[3 * 33]); o.z = pk2(s[4 * 33], s[5 * 33]); o.w = pk2(s[6 * 33], s[7 * 33]);
        *(GAS v4u*)(WT + (dst_row0 + n) * (size_t)Kd + k0 + 8 * c) = o; }
    LDS_WAIT(); asm volatile("" ::: "memory");
}
__device__ __forceinline__ void p0_prologue(Frame& F, const Args& args) {
    const float* c_in = IN_F(1); const int* pos = IN_I(2); const float* ada_w = IN_F(3); const float* ada_b = IN_F(4);
    for (int task = F.vcu; task < 96; task += F.G) {
        LAS float* sc = (LAS float*)F.lds;
        LAS float* red = (LAS float*)(F.lds + 16384);
        for (int i = F.tid; i < 4096; i += 512) { const float v = c_in[i]; sc[i] = v / (1.0f + expf(-v)); }
        __syncthreads();
        const int colq = F.lane & 15, kq = F.lane >> 4, col = task * 64 + colq * 4;
        float acc[4][4];
#pragma unroll
        for (int b = 0; b < 4; ++b)
#pragma unroll
            for (int j = 0; j < 4; ++j) acc[b][j] = 0.f;
#pragma unroll 4
        for (int s = 0; s < 32; ++s) { const int k = F.wave * 128 + s * 4 + kq; const f32x4 wv = *(const f32x4*)(ada_w + (size_t)k * 6144 + col);
#pragma unroll
            for (int b = 0; b < 4; ++b) { const float sv = sc[b * 1024 + k];
#pragma unroll
                for (int j = 0; j < 4; ++j) acc[b][j] += sv * wv[j]; } }
#pragma unroll
        for (int b = 0; b < 4; ++b)
#pragma unroll
            for (int j = 0; j < 4; ++j) { float v = acc[b][j]; v += __shfl_xor(v, 16); v += __shfl_xor(v, 32); if (kq == 0) red[(F.wave * 4 + b) * 64 + colq * 4 + j] = v; }
        __syncthreads();
        if (F.tid < 256) { const int b = F.tid >> 6, cc = F.tid & 63; float s = ada_b[task * 64 + cc];
#pragma unroll
            for (int w = 0; w < 8; ++w) s += red[(w * 4 + b) * 64 + cc];
            WSP(float, WS_MOD)[b * 6144 + task * 64 + cc] = s; }
        VM_WAIT(); __syncthreads();
        if (F.tid == 0) { __builtin_amdgcn_fence(__ATOMIC_RELEASE, "agent"); VM_WAIT(); __hip_atomic_fetch_add((unsigned*)(F.ws + WS_CTL) + CW_MODCNT, 1u, RLX_AGENT); }
    }
    const int gt = F.vcu * 512 + F.tid, NGT = F.G * 512;
    for (int idx = gt; idx < NTOK * 16; idx += NGT) { const int m = idx >> 4, i = idx & 15;
        double freq = 1.0; for (int q = 0; q < i; ++q) freq *= 0.44036660267178046;
        const double ang = (double)pos[m] * freq; const double nr = __builtin_rint(ang * 0.15915494309189535);
        const float r = (float)__builtin_fma(-nr, 6.283185307179586, ang);
        float sn, cs; sincosf(r, &sn, &cs);
        WSP(float, WS_TRIG)[m * 32 + i] = cs; WSP(float, WS_TRIG)[m * 32 + 16 + i] = sn; }
    { const float* wr = IN_F(20); for (int idx = gt; idx < 32 * 1024; idx += NGT) { const int e = idx >> 10, k = idx & 1023; const float w = wr[k * 32 + e];
        const unsigned hi = f2bf(w); const float rem = w - __builtin_bit_cast(float, hi << 16); WSP(bf16, WS_WRH)[idx] = (bf16)hi; WSP(bf16, WS_WRL)[idx] = (bf16)f2bf(rem); } }
    LAS float* scr = (LAS float*)(F.lds + 32768 + F.wave * 8704);
    const int gw = F.vcu * NWAVES + F.wave, NGW = F.G * NWAVES;
    constexpr int I_IN = 16 * 224, I_RG = 128, I_B = 1024, I_O = 512, I_UP = 32 * 1024, I_DN = 32 * 512;
    constexpr int NITEMS = I_IN + I_RG + I_B + I_O + I_UP + I_DN;
    for (int it = gw; it < NITEMS; it += NGW) {
        int r = it;
        if (r < I_IN) { const int kb = r / 224, nb = r % 224; p0_transpose_item(IN_F(7), DIN, WSP(bf16, WS_WIN), 1024, (size_t)nb * 32, scr, kb * 64, nb * 32, F.lane); continue; } r -= I_IN;
        if (r < I_RG) { const int mat = r >> 6, blk = (r >> 3) & 7, kb = (r >> 2) & 1, nb = r & 3;
            p0_transpose_item(IN_F(mat ? 12 : 10) + (size_t)blk * 16384, 128, WSP(bf16, WS_WRG) + (size_t)(mat * 8 + blk) * 16384, 128, (size_t)nb * 32, scr, kb * 64, nb * 32, F.lane); continue; } r -= I_RG;
        if (r < I_B) { const int g = r >> 9, q = r & 511, kb = q >> 5, nb = q & 31;
            p0_transpose_item(IN_F(18) + (size_t)g * 1048576, 1024, WSP(bf16, WS_WB) + (size_t)g * 1024, 2048, (size_t)nb * 32, scr, kb * 64, nb * 32, F.lane); continue; } r -= I_B;
        if (r < I_O) { const int kb = r >> 5, nb = r & 31; p0_transpose_item(IN_F(19), 1024, WSP(bf16, WS_WO), 1024, (size_t)nb * 32, scr, kb * 64, nb * 32, F.lane); continue; } r -= I_O;
        if (r < I_UP) { const int e = r >> 10, q = r & 1023, kb = q >> 6, nb = q & 63, n0 = nb * 32;
            const int bj = n0 >> 10, p = (n0 & 1023) >> 7, oo = n0 & 127;
            p0_transpose_item(IN_F(22) + (size_t)e * 2097152, 2048, WSP(bf16, WS_WUP) + (size_t)e * 2097152, 1024, (size_t)(p * 256 + bj * 128 + oo), scr, kb * 64, n0, F.lane); continue; } r -= I_UP;
        { const int e = r >> 9, q = r & 511, kb = q >> 5, nb = q & 31;
            p0_transpose_item(IN_F(24) + (size_t)e * 1048576, 1024, WSP(bf16, WS_WDN) + (size_t)e * 1048576, 1024, (size_t)nb * 32, scr, kb * 64, nb * 32, F.lane); }
    }
}

__device__ __forceinline__ void p1_hrows(Frame& F, const Args& args) {
    if (F.tid == 0) { unsigned* mc = (unsigned*)(F.ws + WS_CTL) + CW_MODCNT; unsigned sp = 0; while (__hip_atomic_load(mc, RLX_AGENT) < 96u && ++sp < (1u << 22)) __builtin_amdgcn_s_sleep(2);
        __builtin_amdgcn_fence(__ATOMIC_ACQUIRE, "agent"); VM_WAIT(); }
    __syncthreads();
    const float* x = IN_F(0); const float* g1n = IN_F(5); const float* mod = WSP(float, WS_MOD); bf16* H = WSP(bf16, WS_HB);
    const int gw = F.vcu * NWAVES + F.wave, NGW = F.G * NWAVES;
    for (int m = gw; m < NTOK; m += NGW) {
        const int b = m >> 12;
        const f32x4* xr = (const f32x4*)(x + (size_t)m * DM) + F.lane;
        f32x4 v[4]; float s = 0.f;
#pragma unroll
        for (int j = 0; j < 4; ++j) { v[j] = xr[64 * j]; s += (v[j].x * v[j].x + v[j].y * v[j].y) + (v[j].z * v[j].z + v[j].w * v[j].w); }
        const float rstd = 1.0f / sqrtf(wave_sum(s) * (1.f / DM) + EPS);
        unsigned long long* o8 = (unsigned long long*)(H + (size_t)m * DM) + F.lane;
#pragma unroll
        for (int j = 0; j < 4; ++j) { const int col = 4 * F.lane + 256 * j;
            const f32x4 g = *(const f32x4*)(g1n + col), sh = *(const f32x4*)(mod + b * 6144 + col), sc = *(const f32x4*)(mod + b * 6144 + 1024 + col);
            const f32x4 h = v[j] * rstd * g * (sc + 1.0f) + sh;
            o8[64 * j] = (unsigned long long)pk2(h.x, h.y) | ((unsigned long long)pk2(h.z, h.w) << 32); }
    }
}

__device__ __forceinline__ void p3_knorm_unit(Frame& F, const Args& args, int unit) {
    const int h = unit & 7, j = (unit >> 3) & 15, b = unit >> 7;
    bf16* KR = WSP(bf16, WS_E) + 3 * E_STRIDE; const float* trig = WSP(float, WS_TRIG); const float* kg = IN_F(16);
    const int rsub = F.lane >> 4, c16 = F.lane & 15;
    float gk[8];
#pragma unroll
    for (int i = 0; i < 8; ++i) gk[i] = kg[c16 * 8 + i];
    float km[8];
#pragma unroll
    for (int i = 0; i < 8; ++i) km[i] = 0.f;
    for (int it = 0; it < 8; ++it) {
        const int m = b * SEQ + j * 256 + F.wave * 32 + it * 4 + rsub;
        bf16* p = KR + (size_t)m * DM + h * HD + c16 * 8;
        const v4u raw = *(const v4u*)p;
        float v[8] = {bflo(raw.x), bfhi(raw.x), bflo(raw.y), bfhi(raw.y), bflo(raw.z), bfhi(raw.z), bflo(raw.w), bfhi(raw.w)};
        float ss = 0.f;
#pragma unroll
        for (int i = 0; i < 8; ++i) ss += v[i] * v[i];
        ss += __shfl_xor(ss, 1); ss += __shfl_xor(ss, 2); ss += __shfl_xor(ss, 4); ss += __shfl_xor(ss, 8);
        const float rstd = 1.0f / sqrtf(ss * (1.f / HD) + EPS);
#pragma unroll
        for (int i = 0; i < 8; ++i) v[i] = v[i] * rstd * gk[i];
        const int fi = (c16 & 1) * 8;
#pragma unroll
        for (int i = 0; i < 8; ++i) { const float other = __shfl_xor(v[i], 2);
            if (c16 < 4) { const float cs = trig[(size_t)m * 32 + fi + i], sn = trig[(size_t)m * 32 + 16 + fi + i];
                v[i] = (c16 < 2) ? (v[i] * cs - other * sn) : (v[i] * cs + other * sn); } }
#pragma unroll
        for (int i = 0; i < 8; ++i) km[i] += v[i];
        v4u o; o.x = pk2(v[0], v[1]); o.y = pk2(v[2], v[3]); o.z = pk2(v[4], v[5]); o.w = pk2(v[6], v[7]);
        *(v4u*)p = o;
    }
    LAS float* red = (LAS float*)(F.lds + XTRA_OFF);
#pragma unroll
    for (int i = 0; i < 8; ++i) { float v = km[i]; v += __shfl_xor(v, 16); v += __shfl_xor(v, 32); if (rsub == 0) red[F.wave * 128 + c16 * 8 + i] = v; }
    __syncthreads();
    if (F.tid < 128) { float s = 0.f;
#pragma unroll
        for (int w = 0; w < 8; ++w) s += red[w * 128 + F.tid];
        WSP(float, WS_KMEAN)[((size_t)(b * NH + h) * 16 + j) * HD + F.tid] = s * (1.f / 256.f); }
    __syncthreads();
}

__device__ __forceinline__ void p3_rnn_local_unit(Frame& F, const Args& args, int unit) {
    const int n = unit & 7, c = (unit >> 3) & 15, b = unit >> 7;
    const int t0 = c * 256, m0 = b * SEQ + t0, ch0 = n * 128;
    const bf16* XR = WSP(bf16, WS_E);
    LAS unsigned char* At = F.lds;
    {
        const int cg = F.tid & 15, rs = F.tid >> 4; const int chb = ch0 + cg * 8;
        const float* cw = IN_F(8); const float* cb = IN_F(9);
        float w0[8], w1[8], w2[8], w3[8], bb[8];
#pragma unroll
        for (int i = 0; i < 8; ++i) { w0[i] = cw[chb + i]; w1[i] = cw[1024 + chb + i]; w2[i] = cw[2048 + chb + i]; w3[i] = cw[3072 + chb + i]; bb[i] = cb[chb + i]; }
        float p1[8], p2[8], p3[8];
        const int tr0 = t0 + rs * 8;
#define LDROW(dst, tt) do { if ((tt) >= 0) { const v4u r_ = *(const v4u*)(XR + (size_t)(b * SEQ + (tt)) * DM + chb); \
            dst[0] = bflo(r_.x); dst[1] = bfhi(r_.x); dst[2] = bflo(r_.y); dst[3] = bfhi(r_.y); dst[4] = bflo(r_.z); dst[5] = bfhi(r_.z); dst[6] = bflo(r_.w); dst[7] = bfhi(r_.w); } \
            else { _Pragma("unroll") for (int i_ = 0; i_ < 8; ++i_) dst[i_] = 0.f; } } while (0)
        LDROW(p3, tr0 - 3); LDROW(p2, tr0 - 2); LDROW(p1, tr0 - 1);
#pragma unroll
        for (int r = 0; r < 8; ++r) { float cur[8]; LDROW(cur, tr0 + r);
            float xc[8];
#pragma unroll
            for (int i = 0; i < 8; ++i) xc[i] = bb[i] + w0[i] * cur[i] + w1[i] * p1[i] + w2[i] * p2[i] + w3[i] * p3[i];
            const int row = rs * 8 + r;
            v4u o; o.x = pk2(xc[0], xc[1]); o.y = pk2(xc[2], xc[3]); o.z = pk2(xc[4], xc[5]); o.w = pk2(xc[6], xc[7]);
            *(LAS v4u*)(At + row * 256 + ((cg ^ (row & 15)) << 4)) = o;
#pragma unroll
            for (int i = 0; i < 8; ++i) { p3[i] = p2[i]; p2[i] = p1[i]; p1[i] = cur[i]; } }
#undef LDROW
    }
    __syncthreads();
    const int fr = F.lane & 15, fq = F.lane >> 4;
    const int vloc = F.wave * 16 + fr, ch = ch0 + vloc;
    const bf16* WA = WSP(bf16, WS_WRG) + (size_t)n * 16384 + (size_t)vloc * 128 + fq * 8;
    const bf16* WX = WA + 8 * 16384;
    bf16x8 Ba[4], Bx[4];
#pragma unroll
    for (int s = 0; s < 4; ++s) { Ba[s] = *(const bf16x8*)(WA + 32 * s); Bx[s] = *(const bf16x8*)(WX + 32 * s); }
    const float ba = IN_F(11)[ch], bx = IN_F(13)[ch];
    const float sp8 = 8.0f * log1pf(expf(-IN_F(14)[ch]));
    float cP = 1.f, cH = 0.f;
    bf16* HL = WSP(bf16, WS_HL); bf16* PP = WSP(bf16, WS_PP);
    LAS unsigned short* stg = (LAS unsigned short*)(F.lds + 65536);
    for (int rq = 0; rq < 4; ++rq) {
        LAS unsigned short* sb = stg + (rq & 1) * 16384;
#pragma unroll
        for (int ri = 0; ri < 4; ++ri) { const int rt = rq * 4 + ri;
            f32x4 accr = {0.f, 0.f, 0.f, 0.f}, accx = {0.f, 0.f, 0.f, 0.f};
            const int arow = rt * 16 + fr;
#pragma unroll
            for (int s = 0; s < 4; ++s) { const bf16x8 a = *(const LAS bf16x8*)(At + arow * 256 + (((fq + 4 * s) ^ (arow & 15)) << 4));
                accr = __builtin_amdgcn_mfma_f32_16x16x32_bf16(a, Ba[s], accr, 0, 0, 0);
                accx = __builtin_amdgcn_mfma_f32_16x16x32_bf16(a, Bx[s], accx, 0, 0, 0); }
            float pj[4], hj[4];
#pragma unroll
            for (int j = 0; j < 4; ++j) { const int row = rt * 16 + 4 * fq + j;
                const float xcv = bf2f(*(const LAS unsigned short*)(At + row * 256 + ((((vloc >> 3)) ^ (row & 15)) << 4) + (vloc & 7) * 2));
                const float r = fast_sigmoid(accr[j] + ba), ig = fast_sigmoid(accx[j] + bx);
                const float a = __builtin_amdgcn_exp2f(-sp8 * r * 1.4426950408889634f);
                float mult = __builtin_amdgcn_sqrtf(fmaxf(fmaf(-a, a, 1.0f), 0.0f)); if (t0 + row == 0) mult = 1.0f;
                const float u = mult * ig * xcv;
                pj[j] = (j ? pj[j - 1] : 1.0f) * a; hj[j] = (j ? hj[j - 1] * a : 0.0f) + u; }
            const float tp = pj[3], th = hj[3];
            const float pa = __shfl(tp, F.lane - 16), ha = __shfl(th, F.lane - 16);
            const float pb = __shfl(tp, F.lane - 32), hb = __shfl(th, F.lane - 32);
            const float pc = __shfl(tp, F.lane - 48), hc = __shfl(th, F.lane - 48);
            float Pq, Hq;
            if (fq == 0) { Pq = 1.f; Hq = 0.f; } else if (fq == 1) { Pq = pa; Hq = ha; } else if (fq == 2) { Pq = pb * pa; Hq = pa * hb + ha; } else { Pq = pc * pb * pa; Hq = pa * (pb * hc + hb) + ha; }
            const float hstart = Hq + Pq * cH, pstart = Pq * cP;
            float hl3 = 0.f, pp3 = 0.f;
#pragma unroll
            for (int j = 0; j < 4; ++j) { const float hv = hj[j] + pj[j] * hstart, pv = pj[j] * pstart; const int rl = ri * 16 + 4 * fq + j;
                sb[rl * 128 + vloc] = (unsigned short)f2bf(hv); sb[8192 + rl * 128 + vloc] = (unsigned short)f2bf(pv); if (j == 3) { hl3 = hv; pp3 = pv; } }
            cH = __shfl(hl3, fr + 48); cP = __shfl(pp3, fr + 48);
        }
        __syncthreads();
#pragma unroll
        for (int q4 = 0; q4 < 4; ++q4) { const int idx = q4 * 512 + F.tid, arr = idx >> 10, rr = (idx >> 4) & 63, c16 = idx & 15;
            const v4u val = *(const LAS v4u*)(sb + arr * 8192 + rr * 128 + c16 * 8);
            bf16* dst = (arr ? PP : HL) + (size_t)(m0 + rq * 64 + rr) * DM + ch0 + c16 * 8;
            *(v4u*)dst = val; }
    }
    if (fq == 0) { WSP(float, WS_AGGP)[(size_t)(b * 16 + c) * 1024 + ch] = cP; WSP(float, WS_AGGH)[(size_t)(b * 16 + c) * 1024 + ch] = cH; }
    __syncthreads();
}

__device__ __forceinline__ void p4_rnn_final_unit(Frame& F, const Args& args, int unit) {
    const int n = unit & 7, c = (unit >> 3) & 15, b = unit >> 7;
    const int m0 = b * SEQ + c * 256, ch0 = n * 128;
    LAS float* car = (LAS float*)(F.lds + XTRA_OFF);
    if (F.tid < 128) { const int ch = ch0 + F.tid; float h = 0.f;
        for (int cc = 0; cc < c; ++cc) { const float p = WSP(float, WS_AGGP)[(size_t)(b * 16 + cc) * 1024 + ch], hh = WSP(float, WS_AGGH)[(size_t)(b * 16 + cc) * 1024 + ch]; h = p * h + hh; }
        car[F.tid] = h; }
    __syncthreads();
    const bf16* HL = WSP(bf16, WS_HL); const bf16* PP = WSP(bf16, WS_PP); const bf16* GG = WSP(bf16, WS_E) + E_STRIDE; bf16* Y = WSP(bf16, WS_YCAT);
    const int c16 = F.tid & 15, r0 = F.tid >> 4;
    float cv[8];
#pragma unroll
    for (int i = 0; i < 8; ++i) cv[i] = car[c16 * 8 + i];
#pragma unroll 2
    for (int it = 0; it < 8; ++it) { const size_t o = (size_t)(m0 + it * 32 + r0) * DM + ch0 + c16 * 8, oy = (size_t)(m0 + it * 32 + r0) * 2048 + ch0 + c16 * 8;
        const v4u hl = *(const v4u*)(HL + o), pp = *(const v4u*)(PP + o), gg = *(const v4u*)(GG + o);
        v4u y;
        y.x = pk2((bflo(hl.x) + bflo(pp.x) * cv[0]) * bflo(gg.x), (bfhi(hl.x) + bfhi(pp.x) * cv[1]) * bfhi(gg.x));
        y.y = pk2((bflo(hl.y) + bflo(pp.y) * cv[2]) * bflo(gg.y), (bfhi(hl.y) + bfhi(pp.y) * cv[3]) * bfhi(gg.y));
        y.z = pk2((bflo(hl.z) + bflo(pp.z) * cv[4]) * bflo(gg.z), (bfhi(hl.z) + bfhi(pp.z) * cv[5]) * bfhi(gg.z));
        y.w = pk2((bflo(hl.w) + bflo(pp.w) * cv[6]) * bflo(gg.w), (bfhi(hl.w) + bfhi(pp.w) * cv[7]) * bfhi(gg.w));
        *(v4u*)(Y + oy) = y; }
    __syncthreads();
}

namespace att {
constexpr int KVBLK = 64, SHM_K = KVBLK * HD * 2, SHM_V = SHM_K;
constexpr float C2 = 0.08838834764831845f * 1.4426950408889634f;
#define KSWZ(row, colB) ((row) * 256 + ((colB) ^ (((row) & 7) << 4)))
__device__ __forceinline__ int v_st(int k, int c) { const int kk = (k & ~0xC) | ((k & 4) << 1) | ((k & 8) >> 1); return ((kk >> 3) * 4 + (c >> 5)) * 512 + ((kk & 7) * 32 + (c & 31)) * 2; }
__device__ __forceinline__ int v_rd_base(int lane) { return ((lane & 3) << 3) | (((lane >> 2) & 3) << 6) | (((lane >> 4) & 1) << 5) | (((lane >> 5) & 1) << 8); }
constexpr int v_rd_off(int d0, int ks, int half) { return d0 * 512 + ks * 4096 + half * 2048; }
__device__ __forceinline__ int crow(int r, int hi) { return (r & 3) + 8 * (r >> 2) + 4 * hi; }

template <int KB>
__device__ __forceinline__ void qkt(f32x16& p0, f32x16& p1, const char* K_lds, int r32, int hi, const char* qfrag, bool act) {
    if (!act) { const float NEG = -__builtin_inff();
#pragma unroll
        for (int r = 0; r < 16; ++r) { p0[r] = NEG; p1[r] = NEG; } return; }
    p0 = f32x16{}; p1 = f32x16{};
    const char* kb[4];
#pragma unroll
    for (int dd = 0; dd < 4; ++dd) kb[dd] = K_lds + KB * SHM_K + KSWZ(r32, (dd * 16 + hi * 8) * 2);
#pragma unroll
    for (int d0 = 0; d0 < 8; ++d0) { const char* a = kb[d0 & 3] + (d0 >> 2) * 128;
        bf16x8 b0 = *reinterpret_cast<const bf16x8*>(a);
        bf16x8 b1 = *reinterpret_cast<const bf16x8*>(a + 32 * 256);
        const bf16x8 q = *reinterpret_cast<const bf16x8*>(qfrag + d0 * 1024);
        p0 = __builtin_amdgcn_mfma_f32_32x32x16_bf16(b0, q, p0, 0, 0, 0);
        p1 = __builtin_amdgcn_mfma_f32_32x32x16_bf16(b1, q, p1, 0, 0, 0); }
}
template <int VB>
__device__ __forceinline__ void pv_tile(f32x16* o, int vb0, bf16x8 pa0, bf16x8 pa1, bf16x8 pa2, bf16x8 pa3, bool act) {
    if (!act) return;
#define TRRD(dst, off) asm volatile("ds_read_b64_tr_b16 %0, %1 offset:%2" : "=&v"(dst) : "v"(vb0), "i"(off) : "memory")
#define PV_D0(d0) do { s16x4 l0, l1, l2, l3, h0, h1, h2, h3; constexpr int b_ = VB * SHM_V + v_rd_off(d0, 0, 0); \
        TRRD(l0, b_); TRRD(h0, b_ + 2048); TRRD(l1, b_ + 4096); TRRD(h1, b_ + 6144); TRRD(l2, b_ + 8192); TRRD(h2, b_ + 10240); TRRD(l3, b_ + 12288); TRRD(h3, b_ + 14336); \
        asm volatile("s_waitcnt lgkmcnt(0)" ::: "memory"); SBAR(); \
        o[d0] = __builtin_amdgcn_mfma_f32_32x32x16_bf16(pa0, (bf16x8){l0[0], l0[1], l0[2], l0[3], h0[0], h0[1], h0[2], h0[3]}, o[d0], 0, 0, 0);   \
        o[d0] = __builtin_amdgcn_mfma_f32_32x32x16_bf16(pa1, (bf16x8){l1[0], l1[1], l1[2], l1[3], h1[0], h1[1], h1[2], h1[3]}, o[d0], 0, 0, 0);   \
        o[d0] = __builtin_amdgcn_mfma_f32_32x32x16_bf16(pa2, (bf16x8){l2[0], l2[1], l2[2], l2[3], h2[0], h2[1], h2[2], h2[3]}, o[d0], 0, 0, 0);   \
        o[d0] = __builtin_amdgcn_mfma_f32_32x32x16_bf16(pa3, (bf16x8){l3[0], l3[1], l3[2], l3[3], h3[0], h3[1], h3[2], h3[3]}, o[d0], 0, 0, 0); } while (0)
    PV_D0(0); PV_D0(1); PV_D0(2); PV_D0(3);
#undef PV_D0
#undef TRRD
}
__device__ __forceinline__ void sm_a(f32x16& p0) {
#pragma unroll
    for (int r = 0; r < 16; ++r) p0[r] = __builtin_amdgcn_exp2f(p0[r]);
}
__device__ __forceinline__ void sm_b(f32x16& p0, f32x16& p1, float& l_reg, bf16x8& pa0, bf16x8& pa1, bf16x8& pa2, bf16x8& pa3) {
#pragma unroll
    for (int r = 0; r < 16; ++r) p1[r] = __builtin_amdgcn_exp2f(p1[r]);
    float ps = 0;
#pragma unroll
    for (int r = 0; r < 16; ++r) ps += p0[r];
#pragma unroll
    for (int r = 0; r < 16; ++r) ps += p1[r];
    l_reg += ps;
#define PK4(P, B_, OUT) do { unsigned a0 = cvtpk(P[B_+0], P[B_+1]), a1 = cvtpk(P[B_+2], P[B_+3]); \
        unsigned b0 = cvtpk(P[B_+4], P[B_+5]), b1 = cvtpk(P[B_+6], P[B_+7]); \
        auto r0 = __builtin_amdgcn_permlane32_swap(a0, b0, false, false); auto r1 = __builtin_amdgcn_permlane32_swap(a1, b1, false, false); \
        v4u w = {r0[0], r1[0], r0[1], r1[1]}; OUT = *reinterpret_cast<bf16x8*>(&w); } while (0)
    PK4(p0, 0, pa0); PK4(p0, 8, pa1); PK4(p1, 0, pa2); PK4(p1, 8, pa3);
#undef PK4
}

__device__ __forceinline__ void attn_unit(Frame& F, const Args& args, int b, int h, int iq) {
    int tid = F.tid; asm volatile("" : "+v"(tid));
    const int wid = F.wave, lane = tid & 63, r32 = lane & 31, hi = lane >> 5;
    char* lds = F.ldsg;
    char* V_lds = lds; char* K_lds = lds + 2 * SHM_V;
    float* kml = (float*)(lds + XTRA_OFF);
    char* qfrag = lds + 65536 + wid * 8192 + lane * 16;
    const bf16* QR = WSP(bf16, WS_E) + 2 * E_STRIDE; const bf16* KN = WSP(bf16, WS_E) + 3 * E_STRIDE; const bf16* VV = WSP(bf16, WS_E) + 4 * E_STRIDE;
    bf16* YA = WSP(bf16, WS_YCAT) + 1024;
    const size_t mb = (size_t)b * SEQ;
    const int q0 = iq * 256, NT = 4 * (iq + 1);
    const bf16* Kh = KN + mb * DM + h * HD; const bf16* Vh = VV + mb * DM + h * HD;
    { const float* kmg = WSP(float, WS_KMEAN) + (size_t)(b * NH + h) * 16 * HD; for (int idx = tid; idx < iq * HD; idx += 512) kml[idx] = kmg[idx]; }
    const int sr = tid >> 4, sc = (tid & 15) * 8, vst0 = v_st(sr, sc), vst1 = v_st(32 + sr, sc), kws = KSWZ(sr, sc * 2);
    const int vb0 = (int)(uintptr_t)V_lds + v_rd_base(lane);
    bf16x8 st_v0, st_v1, st_k0, st_k1;
    const unsigned goff = (unsigned)(sr * DM + sc) * 2u;
#define ROWP(p, k0, rr) ((const char*)((p) + (size_t)((k0) + (rr)) * DM) + goff)
#define SLOAD(k0) do { st_v0 = *(const bf16x8*)ROWP(Vh, k0, 0); st_v1 = *(const bf16x8*)ROWP(Vh, k0, 32); st_k0 = *(const bf16x8*)ROWP(Kh, k0, 0); st_k1 = *(const bf16x8*)ROWP(Kh, k0, 32); } while (0)
#define SWRITE(bf) do { *(bf16x8*)(V_lds + (bf) * SHM_V + vst0) = st_v0; *(bf16x8*)(V_lds + (bf) * SHM_V + vst1) = st_v1; \
                        *(bf16x8*)(K_lds + (bf) * SHM_K + kws) = st_k0; *(bf16x8*)(K_lds + (bf) * SHM_K + kws + 32 * 256) = st_k1; } while (0)
    SLOAD(0);
    const size_t mq = mb + q0 + wid * 32 + r32;
    unsigned selmask;
    {
        bf16x8 qr[8];
        const bf16* qp = QR + mq * DM + h * HD + hi * 8;
        v4u raw[8];
#pragma unroll
        for (int d0 = 0; d0 < 8; ++d0) raw[d0] = *(const v4u*)(qp + d0 * 16);
        float ss = 0.f;
#pragma unroll
        for (int d0 = 0; d0 < 8; ++d0) { const float a0 = bflo(raw[d0].x), a1 = bfhi(raw[d0].x), a2 = bflo(raw[d0].y), a3 = bfhi(raw[d0].y), a4 = bflo(raw[d0].z), a5 = bfhi(raw[d0].z), a6 = bflo(raw[d0].w), a7 = bfhi(raw[d0].w);
            ss += (a0 * a0 + a1 * a1) + (a2 * a2 + a3 * a3) + (a4 * a4 + a5 * a5) + (a6 * a6 + a7 * a7); }
        ss += __shfl_xor(ss, 32);
        const float rs = C2 / sqrtf(ss * (1.f / HD) + EPS);
        const float* qg = IN_F(15) + hi * 8;
#define UNPK(f, W_) do { const v4u t_ = (W_); f[0] = bflo(t_.x); f[1] = bfhi(t_.x); f[2] = bflo(t_.y); f[3] = bfhi(t_.y); f[4] = bflo(t_.z); f[5] = bfhi(t_.z); f[6] = bflo(t_.w); f[7] = bfhi(t_.w); } while (0)
#define PACK(f) ({ v4u w_; w_.x = cvtpk(f[0], f[1]); w_.y = cvtpk(f[2], f[3]); w_.z = cvtpk(f[4], f[5]); w_.w = cvtpk(f[6], f[7]); *reinterpret_cast<bf16x8*>(&w_); })
        { float f0[8], f1[8]; UNPK(f0, raw[0]); UNPK(f1, raw[1]);
          const float* tg = WSP(float, WS_TRIG) + mq * 32 + hi * 8;
#pragma unroll
          for (int j = 0; j < 8; ++j) { const float x1 = f0[j] * rs * qg[j], x2 = f1[j] * rs * qg[16 + j], cs = tg[j], sn = tg[16 + j]; f0[j] = x1 * cs - x2 * sn; f1[j] = x2 * cs + x1 * sn; }
          qr[0] = PACK(f0); qr[1] = PACK(f1); }
#pragma unroll
        for (int d0 = 2; d0 < 8; ++d0) { float f[8]; UNPK(f, raw[d0]);
#pragma unroll
            for (int j = 0; j < 8; ++j) f[j] *= rs * qg[d0 * 16 + j];
            qr[d0] = PACK(f); }
        __syncthreads();
        float v1 = -__builtin_inff(), v2 = v1, v3 = v1; int i1 = 0, i2 = 0, i3 = 0;
#pragma unroll 1
        for (int jb = 0; jb < iq; ++jb) { const float* km = kml + jb * HD + hi * 8; float g = 0.f;
#pragma unroll
            for (int d0 = 0; d0 < 8; ++d0) { float f[8]; UNPK(f, *reinterpret_cast<const v4u*>(&qr[d0]));
                const f32x4 k0 = *(const f32x4*)(km + d0 * 16), k1 = *(const f32x4*)(km + d0 * 16 + 4);
                g += (f[0] * k0[0] + f[1] * k0[1]) + (f[2] * k0[2] + f[3] * k0[3]) + (f[4] * k1[0] + f[5] * k1[1]) + (f[6] * k1[2] + f[7] * k1[3]); }
            g += __shfl_xor(g, 32);
            if (g > v1) { v3 = v2; i3 = i2; v2 = v1; i2 = i1; v1 = g; i1 = jb; }
            else if (g > v2) { v3 = v2; i3 = i2; v2 = g; i2 = jb; }
            else if (g > v3) { v3 = g; i3 = jb; } }
#undef UNPK
#undef PACK
        selmask = 0u; if (iq >= 1) selmask |= 1u << i1; if (iq >= 2) selmask |= 1u << i2; if (iq >= 3) selmask |= 1u << i3;
#pragma unroll
        for (int d0 = 0; d0 < 8; ++d0) *reinterpret_cast<bf16x8*>(qfrag + d0 * 1024) = qr[d0];
    }
    float l_reg = 0.f; f32x16 o[4] = {};
    const int wrow0 = wid * 32;
#define ACT(t) (((t) >> 2) < iq ? (__ballot((selmask >> ((t) >> 2)) & 1u) != 0ull) : ((((t) - 4 * iq) * 64) <= wrow0 + 31))
#define MASKT(P0_, P1_, t) do { const int blk_ = (t) >> 2; const float NEG_ = -__builtin_inff(); \
        if (blk_ < iq) { if (!((selmask >> blk_) & 1u)) { _Pragma("unroll") for (int r = 0; r < 16; ++r) { P0_[r] = NEG_; P1_[r] = NEG_; } } } \
        else { const int kb_ = ((t) - 4 * iq) * 64; if (kb_ + 63 > wrow0) { int dq_ = wrow0 + r32 - kb_ - 4 * hi; asm volatile("" : "+v"(dq_)); \
            _Pragma("unroll") for (int r = 0; r < 16; ++r) { const int c_ = (r & 3) + 8 * (r >> 2); if (c_ > dq_) P0_[r] = NEG_; if (c_ + 32 > dq_) P1_[r] = NEG_; } } } } while (0)
    f32x16 pA0, pA1, pB0, pB1; bf16x8 pa0, pa1, pa2, pa3;
    VM_WAIT(); SWRITE(0); SBAR();
    SLOAD(64);
    __syncthreads();
    SBAR(); qkt<0>(pA0, pA1, K_lds, r32, hi, qfrag, ACT(0));
    MASKT(pA0, pA1, 0); sm_a(pA0);
    VM_WAIT(); SWRITE(1);
    __syncthreads();
#define HALF_STEP(PX0, PX1, PY0, PY1, t, KB, VB, SB) do { \
        SBAR(); qkt<KB>(PX0, PX1, K_lds, r32, hi, qfrag, ACT(t)); \
        sm_b(PY0, PY1, l_reg, pa0, pa1, pa2, pa3); SBAR(); \
        if ((t) + 1 < NT) { SLOAD(((t) + 1) * 64); SBAR(); } \
        pv_tile<VB>(o, vb0, pa0, pa1, pa2, pa3, ACT((t) - 1)); MASKT(PX0, PX1, (t)); sm_a(PX0); \
        __syncthreads(); \
        if ((t) + 1 < NT) { VM_WAIT(); SWRITE(SB); } \
        __syncthreads(); } while (0)
    for (int t = 1; t + 1 < NT; t += 2) {
        HALF_STEP(pB0, pB1, pA0, pA1, t, 1, 0, 0);
        HALF_STEP(pA0, pA1, pB0, pB1, t + 1, 0, 1, 1);
    }
    SBAR(); qkt<1>(pB0, pB1, K_lds, r32, hi, qfrag, ACT(NT - 1)); SBAR();
    sm_b(pA0, pA1, l_reg, pa0, pa1, pa2, pa3); SBAR();
    pv_tile<0>(o, vb0, pa0, pa1, pa2, pa3, ACT(NT - 2));
    MASKT(pB0, pB1, NT - 1); sm_a(pB0);
    sm_b(pB0, pB1, l_reg, pa0, pa1, pa2, pa3); SBAR();
    pv_tile<1>(o, vb0, pa0, pa1, pa2, pa3, ACT(NT - 1));
    l_reg += __shfl_xor(l_reg, 32);
    float* li_l = (float*)(lds + XTRA_OFF + 8192) + wid * 32;
    if (hi == 0) li_l[r32] = l_reg;
    asm volatile("s_waitcnt lgkmcnt(0)" ::: "memory");
    float rli[16];
#pragma unroll
    for (int r = 0; r < 16; ++r) rli[r] = __builtin_amdgcn_rcpf(li_l[crow(r, hi)]);
    bf16* Ow = YA + (mb + q0 + wid * 32) * 2048 + h * HD;
#pragma unroll
    for (int r = 0; r < 16; ++r) { const int orow = crow(r, hi);
#pragma unroll
        for (int d0 = 0; d0 < 4; ++d0) { const float v = o[d0][r] * rli[r]; const float vn = __shfl_xor(v, 1);
            if ((r32 & 1) == 0) *(unsigned*)(Ow + (size_t)orow * 2048 + d0 * 32 + r32) = cvtpk(v, vn); } }
    __syncthreads();
#undef ROWP
#undef SLOAD
#undef SWRITE
#undef ACT
#undef MASKT
#undef HALF_STEP
}
#undef KSWZ
}

__device__ __forceinline__ void p7_router(Frame& F, const Args& args) {
    LAS float* ssq = (LAS float*)F.lds;
    LAS float* lg = (LAS float*)(F.lds + 1024);
    LAS int* hist = (LAS int*)(F.lds + 20480);
    LAS int* sel = (LAS int*)(F.lds + 21504);
    const float* g2n = IN_F(6); const float* mod = WSP(float, WS_MOD); const float* brt = IN_F(21);
    const bf16* WRH = WSP(bf16, WS_WRH); const bf16* WRL = WSP(bf16, WS_WRL);
    bf16* H2 = WSP(bf16, WS_HB);
    unsigned* CNT = (unsigned*)(F.ws + WS_CTL) + CW_CNT;
    const int rg = F.wave & 3, kh = F.wave >> 2, row = F.lane & 15, q = F.lane >> 4;
    for (int vw = F.vcu; vw < 256; vw += F.G) {
        const int rl = rg * 16 + row, m = vw * 64 + rl, b = m >> 12;
        const float* xp = F.out + (size_t)m * DM + 512 * kh + 8 * q;
        float ss = 0.f;
#pragma unroll 4
        for (int s = 0; s < 16; ++s) { const f32x4 x0 = *(const f32x4*)(xp + 32 * s), x1 = *(const f32x4*)(xp + 32 * s + 4); const f32x4 a = x0 * x0 + x1 * x1; ss += (a.x + a.y) + (a.z + a.w); }
        ss += __shfl_xor(ss, 16); ss += __shfl_xor(ss, 32);
        if (q == 0) ssq[kh * 64 + rl] = ss;
        if (F.tid < 32) hist[F.tid] = 0;
        __syncthreads();
        const float rstd = 1.0f / sqrtf((ssq[rl] + ssq[64 + rl]) * (1.f / DM) + EPS);
        f32x4 acc0 = {0.f, 0.f, 0.f, 0.f}, acc1 = {0.f, 0.f, 0.f, 0.f};
        const float* mp = mod + b * 6144;
        bf16* hp = H2 + (size_t)m * DM + 512 * kh + 8 * q;
        const bf16* wh = WRH + (size_t)row * 1024 + 512 * kh + 8 * q; const bf16* wl = WRL + (size_t)row * 1024 + 512 * kh + 8 * q;
#pragma unroll 2
        for (int s = 0; s < 16; ++s) { const int col = 512 * kh + 32 * s + 8 * q;
            const f32x4 xq[2] = {*(const f32x4*)(xp + 32 * s), *(const f32x4*)(xp + 32 * s + 4)};
            float h[8];
#pragma unroll
            for (int hf = 0; hf < 2; ++hf) { const f32x4 g = *(const f32x4*)(g2n + col + 4 * hf), sh = *(const f32x4*)(mp + 3072 + col + 4 * hf), sc = *(const f32x4*)(mp + 4096 + col + 4 * hf);
                const f32x4 t = xq[hf] * rstd * g * (sc + 1.0f) + sh; h[4 * hf] = t.x; h[4 * hf + 1] = t.y; h[4 * hf + 2] = t.z; h[4 * hf + 3] = t.w; }
            v4u hi; hi.x = cvtpk(h[0], h[1]); hi.y = cvtpk(h[2], h[3]); hi.z = cvtpk(h[4], h[5]); hi.w = cvtpk(h[6], h[7]);
            *(v4u*)(hp + 32 * s) = hi;
            v4u lo; lo.x = cvtpk(h[0] - bflo(hi.x), h[1] - bfhi(hi.x)); lo.y = cvtpk(h[2] - bflo(hi.y), h[3] - bfhi(hi.y)); lo.z = cvtpk(h[4] - bflo(hi.z), h[5] - bfhi(hi.z)); lo.w = cvtpk(h[6] - bflo(hi.w), h[7] - bfhi(hi.w));
            const bf16x8 ah = *reinterpret_cast<bf16x8*>(&hi), al = *reinterpret_cast<bf16x8*>(&lo);
            const bf16x8 bh0 = *(const bf16x8*)(wh + 32 * s), bl0 = *(const bf16x8*)(wl + 32 * s), bh1 = *(const bf16x8*)(wh + 16384 + 32 * s), bl1 = *(const bf16x8*)(wl + 16384 + 32 * s);
            acc0 = __builtin_amdgcn_mfma_f32_16x16x32_bf16(ah, bh0, acc0, 0, 0, 0); acc0 = __builtin_amdgcn_mfma_f32_16x16x32_bf16(ah, bl0, acc0, 0, 0, 0); acc0 = __builtin_amdgcn_mfma_f32_16x16x32_bf16(al, bh0, acc0, 0, 0, 0);
            acc1 = __builtin_amdgcn_mfma_f32_16x16x32_bf16(ah, bh1, acc1, 0, 0, 0); acc1 = __builtin_amdgcn_mfma_f32_16x16x32_bf16(ah, bl1, acc1, 0, 0, 0); acc1 = __builtin_amdgcn_mfma_f32_16x16x32_bf16(al, bh1, acc1, 0, 0, 0); }
#pragma unroll
        for (int r = 0; r < 4; ++r) { lg[(kh * 64 + rg * 16 + 4 * q + r) * 33 + row] = acc0[r]; lg[(kh * 64 + rg * 16 + 4 * q + r) * 33 + 16 + row] = acc1[r]; }
        __syncthreads();
        { const int rowl = F.tid >> 3, eq = F.tid & 7; float v[4];
#pragma unroll
          for (int j = 0; j < 4; ++j) v[j] = lg[rowl * 33 + 4 * eq + j] + lg[(64 + rowl) * 33 + 4 * eq + j] + brt[4 * eq + j];
          float tv[4]; int te[4];
#pragma unroll
          for (int k = 0; k < 4; ++k) { float gm = fmaxf(fmaxf(v[0], v[1]), fmaxf(v[2], v[3]));
              gm = fmaxf(gm, __shfl_xor(gm, 1)); gm = fmaxf(gm, __shfl_xor(gm, 2)); gm = fmaxf(gm, __shfl_xor(gm, 4));
              int ci = v[0] == gm ? 4 * eq : v[1] == gm ? 4 * eq + 1 : v[2] == gm ? 4 * eq + 2 : v[3] == gm ? 4 * eq + 3 : 99;
              ci = min(ci, __shfl_xor(ci, 1)); ci = min(ci, __shfl_xor(ci, 2)); ci = min(ci, __shfl_xor(ci, 4));
              te[k] = ci; tv[k] = gm;
#pragma unroll
              for (int j = 0; j < 4; ++j) if (ci == 4 * eq + j) v[j] = -__builtin_inff(); }
          if (eq == 0) { const float w1 = __expf(tv[1] - tv[0]), w2 = __expf(tv[2] - tv[0]), w3 = __expf(tv[3] - tv[0]); const float inv = 1.0f / (1.0f + w1 + w2 + w3);
              const float gk[4] = {inv, w1 * inv, w2 * inv, w3 * inv};
#pragma unroll
              for (int k = 0; k < 4; ++k) { const int lr = atomicAdd((int*)&hist[te[k]], 1); sel[rowl * 4 + k] = te[k]; sel[256 + rowl * 4 + k] = lr; sel[512 + rowl * 4 + k] = __float_as_int(gk[k]); } } }
        __syncthreads();
        if (F.tid < 32) { const int hc = hist[F.tid]; hist[32 + F.tid] = hc ? (int)__hip_atomic_fetch_add(CNT + F.tid, (unsigned)hc, RLX_AGENT) : 0; }
        __syncthreads();
        if (F.tid < 256) { const int e = sel[F.tid], pos = hist[32 + e] + sel[256 + F.tid], mm = vw * 64 + (F.tid >> 2);
            WSP(int, WS_ROWTOK)[(size_t)e * ECAP + pos] = mm; WSP(int, WS_ROWGATE)[(size_t)e * ECAP + pos] = sel[512 + F.tid];
            WSP(int, WS_TOKE)[mm * 4 + (F.tid & 3)] = e; WSP(int, WS_TOKPOS)[mm * 4 + (F.tid & 3)] = pos; }
        __syncthreads();
    }
}

constexpr int MOE_TBL_OFF = XTRA_OFF, MOE_LIST_OFF = XTRA_OFF + 2048;
__device__ __forceinline__ int moe_tables(Frame& F) {
    LAS int* tbl = (LAS int*)(F.lds + MOE_TBL_OFF);
    const unsigned* CNT = (const unsigned*)(F.ws + WS_CTL) + CW_CNT;
    if (F.tid < 32) tbl[F.tid] = (int)__hip_atomic_load(CNT + F.tid, RLX_AGENT);
    __syncthreads();
    if (F.tid == 0) { int run = 0; for (int e = 0; e < 32; ++e) { tbl[32 + e] = run; const int nb = (tbl[e] + 255) >> 8; for (int bb = 0; bb < nb; ++bb) tbl[80 + run + bb] = e; run += nb; } tbl[64] = run; }
    __syncthreads();
    int nblk = tbl[64]; if (nblk > MAXBLK) nblk = MAXBLK; if (nblk < 1) nblk = 1;
    return __builtin_amdgcn_readfirstlane(nblk);
}

__device__ __forceinline__ void p11_combine(Frame& F, const Args& args) {
    (void)moe_tables(F);
    const LAS int* tbl = (const LAS int*)(F.lds + MOE_TBL_OFF);
    const float* mod = WSP(float, WS_MOD); const bf16* YR = WSP(bf16, WS_YR);
    const int gw = F.vcu * NWAVES + F.wave, NGW = F.G * NWAVES;
    for (int m = gw; m < NTOK; m += NGW) {
        const int b = m >> 12;
        int dk = 0; if (F.lane < 4) { const int e = __hip_atomic_load(WSP(int, WS_TOKE) + m * 4 + F.lane, RLX_AGENT); dk = tbl[32 + e] * 256 + __hip_atomic_load(WSP(int, WS_TOKPOS) + m * 4 + F.lane, RLX_AGENT); }
        const int d0 = __shfl(dk, 0), d1 = __shfl(dk, 1), d2 = __shfl(dk, 2), d3 = __shfl(dk, 3);
        f32x4* xr = (f32x4*)(F.out + (size_t)m * DM) + F.lane;
#pragma unroll
        for (int j = 0; j < 4; ++j) { const int col = 4 * F.lane + 256 * j;
            const v2u y0 = *(const v2u*)(YR + (size_t)d0 * DM + col), y1 = *(const v2u*)(YR + (size_t)d1 * DM + col), y2 = *(const v2u*)(YR + (size_t)d2 * DM + col), y3 = *(const v2u*)(YR + (size_t)d3 * DM + col);
            f32x4 s;
            s.x = (bflo(y0.x) + bflo(y1.x)) + (bflo(y2.x) + bflo(y3.x)); s.y = (bfhi(y0.x) + bfhi(y1.x)) + (bfhi(y2.x) + bfhi(y3.x));
            s.z = (bflo(y0.y) + bflo(y1.y)) + (bflo(y2.y) + bflo(y3.y)); s.w = (bfhi(y0.y) + bfhi(y1.y)) + (bfhi(y2.y) + bfhi(y3.y));
            const f32x4 g2 = *(const f32x4*)(mod + b * 6144 + 5120 + col);
            xr[64 * j] = xr[64 * j] + g2 * s; }
    }
}

#ifndef MK_N_LAUNCHES
#define MK_N_LAUNCHES 1
#endif
constexpr int PER_PHASE = 12;
constexpr int N_LAUNCHES = MK_N_LAUNCHES;

__global__ void __launch_bounds__(NWAVES * 64, 2) hybrid_fwd(Args args) {
    extern __shared__ __attribute__((aligned(16))) unsigned char lds[];
    Frame F;
    F.lds = (LAS unsigned char*)lds; F.ldsg = (char*)lds;
    F.MISC = (volatile LAS unsigned*)(F.lds + MISC_OFF);
    F.tid = threadIdx.x; F.lane = F.tid & 63; F.wave = __builtin_amdgcn_readfirstlane(F.tid >> 6);
    F.G = gridDim.x; { const int bx = blockIdx.x; F.vcu = (F.G % 8 == 0) ? (bx % 8) * (F.G / 8) + bx / 8 : bx; }
    F.ws = args.ws; F.out = args.out;
    gu32* ctl = (gu32*)(args.ws + WS_CTL);
    for (int u = F.tid; u < (LDS_BYTES - LDSCTL_OFF) / 4; u += NWAVES * 64) ((LAS unsigned*)(F.lds + LDSCTL_OFF))[u] = 0u;
    __syncthreads();
    XcdBarrier bar; bar.bar = (unsigned*)(ctl + CW_BAR); bar.x = 0; bar.st = nullptr;
    if (N_LAUNCHES == 1) bar = xcd_barrier_post((unsigned*)(ctl + CW_BAR), F.MISC + 8);
    const int lo = args.ph_lo, hi = args.ph_hi;
#ifndef PHASE_MASK
#define PHASE_MASK 0xFFF
#endif
#define IN(k) (((PHASE_MASK >> (k)) & 1) && lo <= (k) && (k) < hi)
#define NEXTP(k) ((k) == 7 ? 9 : (k) == 0 ? 2 : (k) + 1)
#define SEAM(k) do { if (IN(k) && IN(NEXTP(k))) xcd_barrier(bar); } while (0)

#ifndef DUP_MASK
#define DUP_MASK 0
#endif
#define PHASE(k, ...) do { if (IN(k)) { __VA_ARGS__ if ((DUP_MASK >> (k)) & 1) { xcd_barrier(bar); __VA_ARGS__ } } SEAM(k); } while (0)
    PHASE(0, { p0_prologue(F, args); p1_hrows(F, args); });
    PHASE(2, {
        pg8::Gemm g{WSP(bf16, WS_HB), WSP(bf16, WS_WIN), NTOK, DIN, DM}; pg8::TileOrder S; S.init(NTOK / 256, DIN / 256, F.G, (int)blockIdx.x, nullptr);
        pg8::EpiWin E{WSP(bf16, WS_E), IN_F(17)};
        pg8::gemm_phase<pg8::EpiWin, pg8::TileOrder, true, true>(F.lds + RING_OFF, g, S, E);
    });
    int p3rep = 0;
    PHASE(3, {
        for (int u = F.vcu; u < 512; u += F.G) p3_rnn_local_unit(F, args, u);
        if (p3rep++ == 0) { for (int u = F.vcu; u < 512; u += F.G) p3_knorm_unit(F, args, u); }
    });
    PHASE(4, {
        for (int it = F.vcu; it < 256; it += F.G) { const int bh = it >> 3, s = it & 7;
            for (int pass = 0; pass < 2; ++pass) att::attn_unit(F, args, bh >> 3, bh & 7, pass ? s : 15 - s); }
        for (int u = F.vcu; u < 512; u += F.G) p4_rnn_final_unit(F, args, u);
    });
    PHASE(5, {
        pg8::Gemm g{WSP(bf16, WS_YCAT), WSP(bf16, WS_WB), NTOK, DM, 2 * DM}; pg8::TileOrder S; S.init(NTOK / 256, DM / 256, F.G, (int)blockIdx.x, nullptr);
        pg8::EpiBranch E{WSP(bf16, WS_E) + 5 * E_STRIDE, WSP(bf16, WS_E) + 6 * E_STRIDE, WSP(bf16, WS_HB)};
        pg8::gemm_phase<pg8::EpiBranch, pg8::TileOrder, false, true>(F.lds + RING_OFF, g, S, E);
    });
    PHASE(6, {
        pg8::Gemm g{WSP(bf16, WS_HB), WSP(bf16, WS_WO), NTOK, DM, DM}; pg8::TileOrder S; S.init(NTOK / 256, DM / 256, F.G, (int)blockIdx.x, nullptr);
        pg8::EpiWout E{IN_F(0), F.out, WSP(float, WS_MOD)};
        pg8::gemm_phase<pg8::EpiWout, pg8::TileOrder, false, true>(F.lds + RING_OFF, g, S, E);
    });
    PHASE(7, { p7_router(F, args); });
    PHASE(9, {
        const int nblk = moe_tables(F);
        const LAS int* tbl = (const LAS int*)(F.lds + MOE_TBL_OFF); LAS int* lists = (LAS int*)(F.lds + MOE_LIST_OFF);
        pg8::Gemm g{WSP(bf16, WS_HB), WSP(bf16, WS_WUP), RMAX, 2048 * NEXP, DM}; pg8::TileOrder S; S.init(nblk, 8, F.G, (int)blockIdx.x, tbl + 80);
        { pg8::Unit u; for (int i = 0; i < 9 && S.next(i, u); ++i) { if (F.tid < 256) { const int e = u.pn >> 3, pos = (u.pm - tbl[32 + e]) * 256 + F.tid;
              lists[i * 256 + F.tid] = pos < tbl[e] ? __hip_atomic_load(WSP(int, WS_ROWTOK) + (size_t)e * ECAP + pos, RLX_AGENT) : 0; } } }
        __syncthreads();
        pg8::EpiUp E{WSP(bf16, WS_ACT), IN_F(23)};
        pg8::gemm_phase<pg8::EpiUp, pg8::TileOrder, true, true, true>(F.lds + RING_OFF, g, S, E, lists);
    });
    PHASE(10, {
        const int nblk = moe_tables(F);
        const LAS int* tbl = (const LAS int*)(F.lds + MOE_TBL_OFF);
        pg8::Gemm g{WSP(bf16, WS_ACT), WSP(bf16, WS_WDN), RMAX, 1024 * NEXP, DM}; pg8::TileOrder S; S.init(nblk, 4, F.G, (int)blockIdx.x, tbl + 80);
        pg8::EpiDown E{WSP(bf16, WS_YR), IN_F(25), WSP(float, WS_ROWGATE), tbl};
        pg8::gemm_phase<pg8::EpiDown, pg8::TileOrder, true, true>(F.lds + RING_OFF, g, S, E);
    });
    PHASE(11, { p11_combine(F, args); });
#undef PHASE
#undef IN
#undef SEAM
}

extern "C" void kernel_launch(void* const* d_in, const int* in_sizes, int n_in, void* d_out, int out_size, void* d_ws, size_t ws_size, hipStream_t stream) {
    static int grid = 0;
    if (grid == 0) {
        if (n_in != 26 || in_sizes[0] != NTOK * DM || out_size != NTOK * DM || ws_size < WS_END) {
            fprintf(stderr, "kernel_launch: shape/workspace mismatch (n_in %d, in0 %d, out %d, ws %zu; need ws >= %zu); nothing launched\n", n_in, n_in > 0 ? in_sizes[0] : -1, out_size, ws_size, (size_t)WS_END); grid = -1; return; }
        int dev = 0, cus = 0, per_cu = 0;
        if (hipGetDevice(&dev) != hipSuccess || hipDeviceGetAttribute(&cus, hipDeviceAttributeMultiprocessorCount, dev) != hipSuccess) { fprintf(stderr, "kernel_launch: device query failed\n"); grid = -1; return; }
        if (hipFuncSetAttribute((const void*)hybrid_fwd, hipFuncAttributeMaxDynamicSharedMemorySize, LDS_BYTES) != hipSuccess) { fprintf(stderr, "kernel_launch: hipFuncSetAttribute failed\n"); grid = -1; return; }
        if (hipOccupancyMaxActiveBlocksPerMultiprocessor(&per_cu, (const void*)hybrid_fwd, NWAVES * 64, LDS_BYTES) != hipSuccess || per_cu < 1) { fprintf(stderr, "kernel_launch: occupancy query says %d blocks/CU\n", per_cu); per_cu = 1; }
        (void)hipGetLastError();
        grid = cus;
        if (grid > 256) grid = 256;
    }
    if (grid < 0) return;
    (void)hipMemsetAsync((char*)d_ws + WS_CTL, 0, CTL_ZERO_BYTES, stream);
    Args a{};
    for (int i = 0; i < 26; ++i) a.in[i] = d_in[i];
    a.out = (float*)d_out; a.ws = (unsigned char*)d_ws;
    for (int li = 0; li < N_LAUNCHES; ++li) {
        a.ph_lo = (N_LAUNCHES == 1) ? 0 : li; a.ph_hi = (N_LAUNCHES == 1) ? PER_PHASE : li + 1;
        hipLaunchKernelGGL(hybrid_fwd, dim3(grid), dim3(NWAVES * 64), LDS_BYTES, stream, a);
        const hipError_t le = hipPeekAtLastError();
        if (le != hipSuccess) { fprintf(stderr, "kernel_launch: launch %d failed: %s\n", li, hipGetErrorName(le)); break; }
    }
}
```

```cpp
#include <hip/hip_runtime.h>
#include <hip/hip_bf16.h>
#include <cstdio>
#include <cstdint>
#include <cmath>
namespace pg8 {
#define PG8_LAS __attribute__((address_space(3)))
typedef unsigned short bf16_t;
typedef short bf16x8 __attribute__((ext_vector_type(8)));
typedef float f32x4 __attribute__((ext_vector_type(4)));
typedef unsigned u32x4 __attribute__((ext_vector_type(4)));
constexpr int BM = 256, BK = 64, HALF = 128, HTB = HALF * BK * 2  , STAGE_BYTES = 8 * HTB, NXCD = 8, WGM = 8;

__host__ __device__ __forceinline__ int lds_byte(int r, int c) { const int st = (r >> 4) * 2 + (c >> 5), rr = r & 15, cc = c & 31, ob = rr * 64 + cc * 2; return st * 1024 + (ob ^ (((ob >> 9) & 1) << 5)); }
__host__ __device__ __forceinline__ void stage_rc(int b, int& R, int& C) { const int st = b / 1024, sb = b % 1024, swz = sb ^ (((sb >> 9) & 1) << 5); R = (st >> 1) * 16 + swz / 64; C = (st & 1) * 32 + (swz % 64) / 2; }
__host__ __device__ __forceinline__ int perm32(int rho) { const int n = rho >> 4, i = rho & 15; return 8 * (i >> 2) + 4 * n + (i & 3); }

struct Unit { int pm, pn; };
struct Gemm { const bf16_t* A; const bf16_t* Bt; int M, N, K; };

struct StaticOrder {
    int nM, nN, nwg, G, c;
    __host__ __device__ void init(int M, int N, int G_, int c_) { nM = M / BM; nN = N / BM; nwg = nM * nN; G = G_; c = c_; }
    __host__ __device__ bool next(int i, Unit& u) const {
        const long L = (long)i * G + c; if (L >= nwg) return false;
        int wgid = (int)L; { const int q = nwg / NXCD, r = nwg % NXCD, xcd = wgid % NXCD, off = wgid / NXCD; wgid = (xcd < r ? xcd * (q + 1) : r * (q + 1) + (xcd - r) * q) + off; }
        const int nig = WGM * nN, gid = wgid / nig, fm = gid * WGM, gsz = (nM - fm) < WGM ? (nM - fm) : WGM;
        u.pm = fm + ((wgid % nig) % gsz); u.pn = (wgid % nig) / gsz; return true;
    }
    __device__ __forceinline__ void a_ready(const Unit&) const {}
    __device__ __forceinline__ void done(const Unit&) const {}
};

__device__ __forceinline__ unsigned cvt_pk_bf16(float lo, float hi) { unsigned r; asm volatile("v_cvt_pk_bf16_f32 %0, %1, %2" : "=v"(r) : "v"(lo), "v"(hi)); return r; }
template <class Epi, class Sched, bool ALIGN_EPI = false, bool SP2 = false, bool GATHER = false>
__device__ __forceinline__ void gemm_phase(PG8_LAS unsigned char* lds, const Gemm g, const Sched& S, const Epi& E, const PG8_LAS int* rowlists = nullptr) {
    static_assert(!GATHER || SP2, "GATHER is implemented for the SP2 loop");
    const int tid = threadIdx.x, wid = __builtin_amdgcn_readfirstlane(tid >> 6), lane = tid & 63, wr = wid >> 2, wc = wid & 3, fr = lane & 15, fq = lane >> 4;
    const int K = g.K, nt = K / BK;
    unsigned voffA[2], voffB[2]; int gR[2], gC[2];
#pragma unroll
    for (int i = 0; i < 2; ++i) { int R, C; stage_rc(tid * 16 + i * 8192, R, C); const int Rb = Epi::PERM ? ((R & ~31) + perm32(R & 31)) : R; gR[i] = R; gC[i] = C;
        voffA[i] = (unsigned)(R * K + C) * 2u; voffB[i] = (unsigned)(Rb * K + C) * 2u; }
    unsigned vC0[2], vC1[2], vN0[2], vN1[2];
#define PG8_ROWOFFS(d0, d1, ui_) do { _Pragma("unroll") for (int i_ = 0; i_ < 2; ++i_) { \
        d0[i_] = (unsigned)(rowlists[(ui_) * 256 + gR[i_]] * K + gC[i_]) * 2u; d1[i_] = (unsigned)(rowlists[(ui_) * 256 + HALF + gR[i_]] * K + gC[i_]) * 2u; } } while (0)
    const size_t kstep = (size_t)(BK * 2);
    const size_t hstep = (size_t)HALF * K * 2;
    const size_t tstep = 2 * hstep;
    const unsigned ldsw = (unsigned)wid * 1024u;
    const int aoff = lds_byte(wr * 64 + fr, fq * 8), boff = lds_byte(wc * 32 + fr, fq * 8);
#define PG8_SA(b, h) (((b) * 2 + (h)) * HTB)
#define PG8_SB(b, h) ((4 + (b) * 2 + (h)) * HTB)
#define PG8_STAGE(bufoff, gbase, voff) do { _Pragma("unroll") for (int _i = 0; _i < 2; ++_i) \
        __builtin_amdgcn_global_load_lds((const unsigned*)((const char*)(gbase) + (voff)[_i]), (PG8_LAS unsigned*)(lds + (bufoff) + ldsw + _i * 8192), 16, 0, 0); } while (0)
#define PG8_LDA(dst, b, h) do { _Pragma("unroll") for (int m = 0; m < 4; ++m) _Pragma("unroll") for (int k = 0; k < 2; ++k) dst[m][k] = *(const PG8_LAS bf16x8*)(lds + PG8_SA(b, h) + aoff + m * 2048 + k * 1024); } while (0)
#define PG8_LDB(dst, b, h) do { _Pragma("unroll") for (int n = 0; n < 2; ++n) _Pragma("unroll") for (int k = 0; k < 2; ++k) dst[n][k] = *(const PG8_LAS bf16x8*)(lds + PG8_SB(b, h) + boff + n * 2048 + k * 1024); } while (0)
#define PG8_MMA(ai, bj, At, Bt) do { __builtin_amdgcn_s_setprio(1); _Pragma("unroll") for (int m = 0; m < 4; ++m) _Pragma("unroll") for (int n = 0; n < 2; ++n) _Pragma("unroll") for (int k = 0; k < 2; ++k) \
        acc[ai][bj][m][n] = __builtin_amdgcn_mfma_f32_16x16x32_bf16(Bt[n][k], At[m][k], acc[ai][bj][m][n], 0, 0, 0); __builtin_amdgcn_s_setprio(0); } while (0)
#define PG8_WAIT_V(n) asm volatile("s_waitcnt vmcnt(" #n ")" ::: "memory")
#define PG8_WAIT_L(n) asm volatile("s_waitcnt lgkmcnt(" #n ")" ::: "memory")
#define PG8_BAR __builtin_amdgcn_s_barrier()
#define PG8_SCHED __builtin_amdgcn_sched_barrier(0)
    Unit cur, nxt; int ui = 0;
    if (!S.next(0, cur)) return;
    f32x4 acc[2][2][4][2];
#pragma unroll
    for (int a = 0; a < 2; ++a)
#pragma unroll
        for (int b = 0; b < 2; ++b)
#pragma unroll
            for (int m = 0; m < 4; ++m)
#pragma unroll
                for (int n = 0; n < 2; ++n) acc[a][b][m][n] = (f32x4){0.f, 0.f, 0.f, 0.f};
    bf16x8 At[4][2], B0[2][2], B1[2][2];
    const char* cA = GATHER ? (const char*)g.A : (const char*)g.A + (size_t)cur.pm * tstep; const char* cB = (const char*)g.Bt + (size_t)cur.pn * tstep;
    if constexpr (GATHER) { PG8_ROWOFFS(vC0, vC1, 0); vN0[0] = vC0[0]; vN0[1] = vC0[1]; vN1[0] = vC1[0]; vN1[1] = vC1[1]; }
#define PG8_STAGE_A(bufoff, kptr, half, v0, v1) do { if constexpr (GATHER) { if ((half) == 0) PG8_STAGE(bufoff, kptr, v0); else PG8_STAGE(bufoff, kptr, v1); } \
        else { PG8_STAGE(bufoff, (kptr) + (half) * hstep, voffA); } } while (0)
    S.a_ready(cur);
    if constexpr (SP2) {
        PG8_STAGE(PG8_SB(0, 0), cB, voffB); PG8_STAGE(PG8_SB(0, 1), cB + hstep, voffB); PG8_STAGE_A(PG8_SA(0, 0), cA, 0, vC0, vC1); PG8_STAGE_A(PG8_SA(0, 1), cA, 1, vC0, vC1);
        if (wr == 1) PG8_BAR;
        PG8_WAIT_V(2); PG8_BAR;
        PG8_STAGE(PG8_SB(1, 0), cB + kstep, voffB); PG8_STAGE_A(PG8_SA(1, 0), cA + kstep, 0, vC0, vC1); PG8_STAGE(PG8_SB(1, 1), cB + hstep + kstep, voffB);
        PG8_WAIT_V(6); PG8_BAR;
    } else {
        PG8_STAGE(PG8_SB(0, 0), cB, voffB); PG8_STAGE(PG8_SA(0, 0), cA, voffA); PG8_STAGE(PG8_SB(0, 1), cB + hstep, voffB); PG8_STAGE(PG8_SA(0, 1), cA + hstep, voffA);
        if (wr == 1) PG8_BAR;
        PG8_WAIT_V(4); PG8_BAR;
        PG8_STAGE(PG8_SB(1, 0), cB + kstep, voffB); PG8_STAGE(PG8_SA(1, 0), cA + kstep, voffA); PG8_STAGE(PG8_SB(1, 1), cB + hstep + kstep, voffB);
        PG8_WAIT_V(6); PG8_BAR;
    }
    for (;;) {
        const bool has_next = S.next(ui + 1, nxt);
        const char* nA = GATHER ? cA : (has_next ? (const char*)g.A + (size_t)nxt.pm * tstep : cA);
        if constexpr (GATHER) { if (has_next) { PG8_ROWOFFS(vN0, vN1, ui + 1); } else { vN0[0] = vC0[0]; vN0[1] = vC0[1]; vN1[0] = vC1[0]; vN1[1] = vC1[1]; } } const char* nB = has_next ? (const char*)g.Bt + (size_t)nxt.pn * tstep : cB;
        for (int t = 0; t < nt; t += 2) {
            const bool last = (t == nt - 2);
            if constexpr (Epi::MIDK) { if (t == (nt >> 1)) E.mid(acc, cur, wr, wc, fr, fq); }
            const char* a1 = cA + (size_t)(t + 1) * kstep;
            const char* a2 = last ? nA : cA + (size_t)(t + 2) * kstep; const char* b2 = last ? nB : cB + (size_t)(t + 2) * kstep;
            const char* a3 = a2 + kstep; const char* b3 = b2 + kstep;
            if (last && has_next) S.a_ready(nxt);
            unsigned vS0[2], vS1[2];
            if constexpr (GATHER) { vS0[0] = last ? vN0[0] : vC0[0]; vS0[1] = last ? vN0[1] : vC0[1]; vS1[0] = last ? vN1[0] : vC1[0]; vS1[1] = last ? vN1[1] : vC1[1]; }
            if constexpr (SP2) {
            PG8_LDB(B0, 0, 0); PG8_LDB(B1, 0, 1); PG8_SCHED; PG8_LDA(At, 0, 0); PG8_STAGE_A(PG8_SA(1, 1), a1, 1, vC0, vC1);
            PG8_WAIT_V(8); PG8_WAIT_L(0); PG8_BAR; PG8_MMA(0, 0, At, B0); PG8_MMA(0, 1, At, B1); PG8_BAR; PG8_SCHED;
            PG8_LDA(At, 0, 1); PG8_STAGE(PG8_SB(0, 0), b2, voffB); PG8_STAGE(PG8_SB(0, 1), b2 + hstep, voffB); PG8_STAGE_A(PG8_SA(0, 0), a2, 0, vS0, vS1);
            PG8_WAIT_V(8); PG8_WAIT_L(0); PG8_BAR; PG8_MMA(1, 0, At, B0); PG8_MMA(1, 1, At, B1); PG8_BAR; PG8_SCHED;
            PG8_LDB(B0, 1, 0); PG8_LDB(B1, 1, 1); PG8_SCHED; PG8_LDA(At, 1, 0); PG8_STAGE_A(PG8_SA(0, 1), a2, 1, vS0, vS1);
            PG8_WAIT_V(8); PG8_WAIT_L(0); PG8_BAR; PG8_MMA(0, 0, At, B0); PG8_MMA(0, 1, At, B1); PG8_BAR; PG8_SCHED;
            PG8_LDA(At, 1, 1); PG8_STAGE(PG8_SB(1, 0), b3, voffB); PG8_STAGE(PG8_SB(1, 1), b3 + hstep, voffB); PG8_STAGE_A(PG8_SA(1, 0), a3, 0, vS0, vS1);
            PG8_WAIT_V(8); PG8_WAIT_L(0); PG8_BAR; PG8_MMA(1, 0, At, B0); PG8_MMA(1, 1, At, B1); PG8_BAR; PG8_SCHED;
            } else {
            PG8_LDB(B0, 0, 0); PG8_SCHED; PG8_LDA(At, 0, 0); PG8_STAGE(PG8_SA(1, 1), a1 + hstep, voffA);
            PG8_WAIT_L(8); PG8_BAR; PG8_WAIT_L(0); PG8_MMA(0, 0, At, B0); PG8_BAR; PG8_SCHED;
            PG8_LDB(B1, 0, 1); PG8_STAGE(PG8_SB(0, 0), b2, voffB);
            PG8_BAR; PG8_WAIT_L(0); PG8_MMA(0, 1, At, B1); PG8_BAR;
            PG8_LDA(At, 0, 1); PG8_STAGE(PG8_SA(0, 0), a2, voffA);
            PG8_BAR; PG8_WAIT_L(0); PG8_MMA(1, 0, At, B0); PG8_BAR; PG8_SCHED;
            PG8_STAGE(PG8_SB(0, 1), b2 + hstep, voffB);
            PG8_WAIT_V(6); PG8_BAR; PG8_MMA(1, 1, At, B1); PG8_BAR;
            PG8_LDB(B0, 1, 0); PG8_SCHED; PG8_LDA(At, 1, 0); PG8_STAGE(PG8_SA(0, 1), a2 + hstep, voffA);
            PG8_WAIT_L(8); PG8_BAR; PG8_WAIT_L(0); PG8_MMA(0, 0, At, B0); PG8_BAR; PG8_SCHED;
            PG8_LDB(B1, 1, 1); PG8_STAGE(PG8_SB(1, 0), b3, voffB);
            PG8_BAR; PG8_WAIT_L(0); PG8_MMA(0, 1, At, B1); PG8_BAR;
            PG8_LDA(At, 1, 1); PG8_STAGE(PG8_SA(1, 0), a3, voffA);
            PG8_BAR; PG8_WAIT_L(0); PG8_MMA(1, 0, At, B0); PG8_BAR; PG8_SCHED;
            PG8_STAGE(PG8_SB(1, 1), b3 + hstep, voffB);
            PG8_WAIT_V(6); PG8_BAR; PG8_MMA(1, 1, At, B1); PG8_BAR;
            }
        }
        if constexpr (ALIGN_EPI) { if (wr == 0) PG8_BAR; }
        if constexpr (!Epi::AFTER_DRAIN) { E(acc, cur, wr, wc, fr, fq); S.done(cur); }
        if (!has_next) break;
#pragma unroll
        for (int a = 0; a < 2; ++a)
#pragma unroll
            for (int b = 0; b < 2; ++b)
#pragma unroll
                for (int m = 0; m < 4; ++m)
#pragma unroll
                    for (int n = 0; n < 2; ++n) acc[a][b][m][n] = (f32x4){0.f, 0.f, 0.f, 0.f};
        cur = nxt; cA = nA; cB = nB; ++ui;
        if constexpr (GATHER) { vC0[0] = vN0[0]; vC0[1] = vN0[1]; vC1[0] = vN1[0]; vC1[1] = vN1[1]; }
        if constexpr (ALIGN_EPI) { if (wr == 1) PG8_BAR; }
    }
    PG8_WAIT_V(0);
    if constexpr (!ALIGN_EPI) { if (wr == 0) PG8_BAR; }
    PG8_BAR;
    if constexpr (Epi::AFTER_DRAIN) { E.fused(acc, cur, wr, wc, fr, fq, lds, wid, lane); S.done(cur); }
#undef PG8_SA
#undef PG8_STAGE_A
#undef PG8_ROWOFFS
#undef PG8_SB
#undef PG8_STAGE
#undef PG8_LDA
#undef PG8_LDB
#undef PG8_MMA
#undef PG8_WAIT_V
#undef PG8_WAIT_L
#undef PG8_BAR
#undef PG8_SCHED
}
}

constexpr int NB = 4, SEQ = 4096, DM = 1024, NTOK = NB * SEQ, DIN = 7168, NH = 8, HD = 128;
constexpr int NEXP = 32, TOPK = 4, MAXBLK = 288, RMAX = MAXBLK * 256;
constexpr float EPS = 1e-6f;
constexpr int NWAVES = 8;

constexpr size_t MiB = 1u << 20, KiB = 1u << 10;
constexpr size_t WS_CTL = 0, CTL_ZERO_BYTES = 1 * MiB;
constexpr size_t WS_MOD = 1 * MiB;
constexpr size_t WS_KMEAN = 1 * MiB + 128 * KiB;
constexpr size_t WS_AGGP = 1 * MiB + 384 * KiB;
constexpr size_t WS_AGGH = 1 * MiB + 640 * KiB;
constexpr size_t WS_WRH = 2 * MiB, WS_WRL = 2 * MiB + 64 * KiB;
constexpr size_t WS_TOKE = 3 * MiB, WS_TOKPOS = 3 * MiB + 256 * KiB;
constexpr int ECAP = 16384;
constexpr size_t WS_ROWTOK = 28 * MiB, WS_ROWGATE = 30 * MiB;
constexpr int CW_CNT = 8192;
constexpr size_t WS_TRIG = 4 * MiB;
constexpr size_t WS_WRG = 6 * MiB;
constexpr size_t WS_WIN = 8 * MiB;
constexpr size_t WS_WB = 22 * MiB;
constexpr size_t WS_WO = 26 * MiB;
constexpr size_t WS_WUP = 32 * MiB;
constexpr size_t WS_WDN = 160 * MiB;
constexpr size_t WS_HB = 224 * MiB;
constexpr size_t WS_E = 256 * MiB;
constexpr size_t E_STRIDE = (size_t)NTOK * DM;
constexpr size_t WS_HL = 480 * MiB, WS_PP = 512 * MiB, WS_YCAT = 544 * MiB;
constexpr int CW_MODCNT = 8256;
constexpr size_t WS_ACT = 400 * MiB, WS_YR = 544 * MiB;
constexpr size_t WS_END = 688 * MiB;
constexpr int CW_BAR = 4096;

constexpr int RING_OFF = 0, RING_BYTES = 131072;
constexpr int LDSCTL_OFF = RING_BYTES, MISC_OFF = LDSCTL_OFF + 320;
constexpr int XTRA_OFF = LDSCTL_OFF + 1024;
constexpr int LDS_BYTES = 147456;

#define GAS __attribute__((address_space(1)))
#define LAS __attribute__((address_space(3)))
typedef unsigned short bf16;
typedef unsigned v4u __attribute__((ext_vector_type(4)));
typedef unsigned v2u __attribute__((ext_vector_type(2)));
typedef float f32x4 __attribute__((ext_vector_type(4)));
typedef float f32x2 __attribute__((ext_vector_type(2)));
typedef float f32x16 __attribute__((ext_vector_type(16)));
typedef short bf16x8 __attribute__((ext_vector_type(8)));
typedef short s16x4 __attribute__((ext_vector_type(4)));
typedef GAS unsigned gu32;
#define RLX_AGENT __ATOMIC_RELAXED, __HIP_MEMORY_SCOPE_AGENT
#define LDS_WAIT() asm volatile("s_waitcnt lgkmcnt(0)" ::: "memory")
#define VM_WAIT() asm volatile("s_waitcnt vmcnt(0)" ::: "memory")
#define SBAR() __builtin_amdgcn_sched_barrier(0)
__device__ __forceinline__ unsigned f2bf(float f) { unsigned u = __builtin_bit_cast(unsigned, f); return (u + 0x7fffu + ((u >> 16) & 1u)) >> 16; }
__device__ __forceinline__ unsigned pk2(float lo, float hi) { return f2bf(lo) | (f2bf(hi) << 16); }
__device__ __forceinline__ float bf2f(unsigned short h) { return __builtin_bit_cast(float, (unsigned)h << 16); }
__device__ __forceinline__ float bflo(unsigned w) { return __builtin_bit_cast(float, w << 16); }
__device__ __forceinline__ float bfhi(unsigned w) { return __builtin_bit_cast(float, w & 0xffff0000u); }
__device__ __forceinline__ unsigned cvtpk(float lo, float hi) { unsigned r; asm volatile("v_cvt_pk_bf16_f32 %0, %1, %2" : "=v"(r) : "v"(lo), "v"(hi)); return r; }
__device__ __forceinline__ float fast_sigmoid(float x) { return __builtin_amdgcn_rcpf(1.0f + __builtin_amdgcn_exp2f(-1.4426950408889634f * x)); }
__device__ __forceinline__ float gelu_tanh(float x) { const float z = 1.5957691216057308f * (x + 0.044715f * x * x * x); return x * fast_sigmoid(z); }
__device__ __forceinline__ float wave_sum(float v) {
#pragma unroll
    for (int o = 1; o < 64; o <<= 1) v += __shfl_xor(v, o);
    return v;
}
__device__ __forceinline__ float wave_max(float v) {
#pragma unroll
    for (int o = 1; o < 64; o <<= 1) v = fmaxf(v, __shfl_xor(v, o));
    return v;
}

#define XB_TMO      128
#define XB_XCNT(j)  (256  + 64 * (j))
#define XB_XSUB(j)  (1280 + 64 * (j))
#define XB_XGEN(j)  (2304 + 64 * (j))
#define XB_TOP      3328
#define XB_TOPGEN   3392
#define XCD_BAR_WORDS 3456
#define XB_SPIN_CAP (1u << 20)
__device__ __forceinline__ unsigned xb_ld(unsigned* p)              { return __hip_atomic_load(p, __ATOMIC_RELAXED, __HIP_MEMORY_SCOPE_AGENT); }
__device__ __forceinline__ unsigned xb_add(unsigned* p, unsigned v) { return __hip_atomic_fetch_add(p, v, __ATOMIC_RELAXED, __HIP_MEMORY_SCOPE_AGENT); }
__device__ __forceinline__ unsigned xb_xcc_id() { return (unsigned)__builtin_amdgcn_s_getreg((3 << 11) | 20) & 0xFu; }
#define XB_SPIN(cond, bar) do { unsigned _sp = 0; while (cond) { __builtin_amdgcn_s_sleep(1); \
    if ((++_sp & 255u) == 0u) { if (xb_ld(&(bar)[XB_TMO])) break; if (_sp > XB_SPIN_CAP) { atomicAdd(&(bar)[XB_TMO], 1u); break; } } } } while (0)
struct XcdBarrier { unsigned* bar; unsigned x; volatile LAS unsigned* st; };
__device__ __forceinline__ XcdBarrier xcd_barrier_post(unsigned* bar, volatile LAS unsigned* st) {
    XcdBarrier b; b.bar = bar; b.x = xb_xcc_id(); b.st = st;
    if (threadIdx.x == 0) (void)xb_add(&bar[XB_XCNT(b.x)], 1u);
    return b;
}
__device__ __forceinline__ void xcd_barrier_complete(unsigned* bar, unsigned x, unsigned& nloc, unsigned& nx) {
    const unsigned G = gridDim.x * gridDim.y * gridDim.z;
    unsigned sum, cnt, mine, sp = 0u;
    for (;;) {
        sum = 0u; cnt = 0u; mine = 0u;
#pragma unroll
        for (unsigned j = 0; j < 16; ++j) { const unsigned c = xb_ld(&bar[XB_XCNT(j)]); sum += c; cnt += (c > 0u) ? 1u : 0u; mine = (j == x) ? c : mine; }
        if (sum == G) break;
        __builtin_amdgcn_s_sleep(1);
        if ((++sp & 255u) == 0u) { if (xb_ld(&bar[XB_TMO])) break; if (sp > XB_SPIN_CAP) { atomicAdd(&bar[XB_TMO], 1u); break; } }
    }
    nloc = mine > 0u ? mine : 1u; nx = cnt > 0u ? cnt : 1u;
}
__device__ __forceinline__ void xcd_barrier(const XcdBarrier& b) {
    asm volatile("s_waitcnt vmcnt(0)" ::: "memory");
    __syncthreads();
    if (threadIdx.x == 0) {
        unsigned* bar = b.bar;
        __builtin_amdgcn_s_waitcnt(0);
        unsigned nloc = b.st[0], nx = b.st[1];
        if (nloc == 0u) { xcd_barrier_complete(bar, b.x, nloc, nx); b.st[0] = nloc; b.st[1] = nx; }
        const unsigned old = xb_add(&bar[XB_XSUB(b.x)], 1u);
        const unsigned gen = old / nloc;
        if (old + 1u == (gen + 1u) * nloc) {
            __builtin_amdgcn_fence(__ATOMIC_RELEASE, "agent");
            asm volatile("s_waitcnt vmcnt(0)" ::: "memory");
            const unsigned og = xb_add(&bar[XB_TOP], 1u);
            const unsigned tg = og / nx;
            if (og + 1u == (tg + 1u) * nx) xb_add(&bar[XB_TOPGEN], 1u);
            else XB_SPIN(xb_ld(&bar[XB_TOPGEN]) == tg, bar);
            __builtin_amdgcn_fence(__ATOMIC_ACQUIRE, "agent");
            xb_add(&bar[XB_XGEN(b.x)], 1u);
            asm volatile("s_waitcnt vmcnt(0)" ::: "memory");
        } else {
            XB_SPIN(xb_ld(&bar[XB_XGEN(b.x)]) == gen, bar);
            __builtin_amdgcn_fence(__ATOMIC_ACQUIRE, "agent");
            asm volatile("s_waitcnt vmcnt(0)" ::: "memory");
        }
    }
    __syncthreads();
}

struct Args { const void* in[26]; float* out; unsigned char* ws; int ph_lo, ph_hi; };
struct Frame {
    LAS unsigned char* lds; char* ldsg;
    volatile LAS unsigned* MISC;
    int tid, lane, wave, vcu, G;
    unsigned char* ws; float* out;
};
#define IN_F(k) ((const float*)args.in[k])
#define IN_I(k) ((const int*)args.in[k])
#define WSP(T, off) ((T*)(F.ws + (off)))

namespace pg8 {
struct TileOrder {
    int nM, nN, nwg, G, c; const LAS int* blk_exp;
    __device__ void init(int nM_, int nN_, int G_, int c_, const LAS int* be) { nM = nM_; nN = nN_; nwg = nM * nN; G = G_; c = c_; blk_exp = be; }
    __device__ bool next(int i, Unit& u) const {
        const long L = (long)i * G + c; if (L >= nwg) return false;
        int wgid = (int)L; { const int q = nwg / NXCD, r = nwg % NXCD, xcd = wgid % NXCD, off = wgid / NXCD; wgid = (xcd < r ? xcd * (q + 1) : r * (q + 1) + (xcd - r) * q) + off; }
        const int nig = WGM * nN, gid = wgid / nig, fm = gid * WGM, gsz = (nM - fm) < WGM ? (nM - fm) : WGM;
        u.pm = fm + ((wgid % nig) % gsz); u.pn = (wgid % nig) / gsz;
        if (blk_exp) { const int e = __builtin_amdgcn_readfirstlane(blk_exp[u.pm]); u.pn += e * nN; }
        return true;
    }
    __device__ __forceinline__ void a_ready(const Unit&) const {}
    __device__ __forceinline__ void done(const Unit&) const {}
};

struct EpiWin {
    static constexpr bool PERM = true, AFTER_DRAIN = false, MIDK = false;
    bf16_t* E; const float* b_gate;
    __device__ __forceinline__ void operator()(const f32x4 (&acc)[2][2][4][2], const Unit& u, int wr, int wc, int fr, int fq) const {
        const int t = u.pn >> 2, colt = (u.pn & 3) * BM;
        bf16_t* base = E + (size_t)t * ((size_t)16384 * 1024);
        const int row0 = u.pm * BM + wr * 64 + fr, col0 = colt + wc * 32 + 8 * fq;
        f32x4 bv[2][2];
#pragma unroll
        for (int bj = 0; bj < 2; ++bj)
#pragma unroll
            for (int n = 0; n < 2; ++n) bv[bj][n] = (t >= 5) ? *(const f32x4*)(b_gate + (t - 5) * 1024 + col0 + bj * HALF + 4 * n) : (f32x4){0.f, 0.f, 0.f, 0.f};
#pragma unroll
        for (int ai = 0; ai < 2; ++ai)
#pragma unroll
            for (int m = 0; m < 4; ++m) { bf16_t* rowp = base + (size_t)(row0 + ai * HALF + m * 16) * 1024 + col0;
#pragma unroll
                for (int bj = 0; bj < 2; ++bj) { f32x4 v0 = acc[ai][bj][m][0] + bv[bj][0], v1 = acc[ai][bj][m][1] + bv[bj][1];
                    if (t == 1) {
#pragma unroll
                        for (int j = 0; j < 4; ++j) { v0[j] = gelu_tanh(v0[j]); v1[j] = gelu_tanh(v1[j]); } }
                    else if (t >= 5) {
#pragma unroll
                        for (int j = 0; j < 4; ++j) { v0[j] = fast_sigmoid(v0[j]); v1[j] = fast_sigmoid(v1[j]); } }
                    u32x4 w; w.x = cvt_pk_bf16(v0[0], v0[1]); w.y = cvt_pk_bf16(v0[2], v0[3]); w.z = cvt_pk_bf16(v1[0], v1[1]); w.w = cvt_pk_bf16(v1[2], v1[3]);
                    *(u32x4*)(rowp + bj * HALF) = w; } }
    }
};
struct EpiBranch {
    static constexpr bool PERM = true, AFTER_DRAIN = false, MIDK = true;
    const bf16_t* SG0; const bf16_t* SG1; bf16_t* MIX;
    __device__ __forceinline__ void mid(f32x4 (&acc)[2][2][4][2], const Unit& u, int wr, int wc, int fr, int fq) const {
        int row0 = u.pm * BM + wr * 64 + fr; const int col0 = u.pn * BM + wc * 32 + 8 * fq;
        asm volatile("" : "+v"(row0));
#pragma unroll
        for (int ai = 0; ai < 2; ++ai)
#pragma unroll
            for (int m = 0; m < 4; ++m) { const size_t ro = (size_t)(row0 + ai * HALF + m * 16) * 1024 + col0;
#pragma unroll
                for (int bj = 0; bj < 2; ++bj) { const size_t o = ro + bj * HALF;
                    const u32x4 a = *(const u32x4*)(SG0 + o), b = *(const u32x4*)(SG1 + o);
                    const float r0 = bflo(a.x) * __builtin_amdgcn_rcpf(fmaxf(bflo(b.x), 1e-18f)), r1 = bfhi(a.x) * __builtin_amdgcn_rcpf(fmaxf(bfhi(b.x), 1e-18f));
                    const float r2 = bflo(a.y) * __builtin_amdgcn_rcpf(fmaxf(bflo(b.y), 1e-18f)), r3 = bfhi(a.y) * __builtin_amdgcn_rcpf(fmaxf(bfhi(b.y), 1e-18f));
                    const float r4 = bflo(a.z) * __builtin_amdgcn_rcpf(fmaxf(bflo(b.z), 1e-18f)), r5 = bfhi(a.z) * __builtin_amdgcn_rcpf(fmaxf(bfhi(b.z), 1e-18f));
                    const float r6 = bflo(a.w) * __builtin_amdgcn_rcpf(fmaxf(bflo(b.w), 1e-18f)), r7 = bfhi(a.w) * __builtin_amdgcn_rcpf(fmaxf(bfhi(b.w), 1e-18f));
                    acc[ai][bj][m][0] *= (f32x4){r0, r1, r2, r3}; acc[ai][bj][m][1] *= (f32x4){r4, r5, r6, r7}; }
                asm volatile("" ::: "memory"); }
    }
    __device__ __forceinline__ void operator()(const f32x4 (&acc)[2][2][4][2], const Unit& u, int wr, int wc, int fr, int fq) const {
        int row0 = u.pm * BM + wr * 64 + fr; const int col0 = u.pn * BM + wc * 32 + 8 * fq;
        asm volatile("" : "+v"(row0));
#pragma unroll
        for (int ai = 0; ai < 2; ++ai)
#pragma unroll
            for (int m = 0; m < 4; ++m) { const size_t ro = (size_t)(row0 + ai * HALF + m * 16) * 1024 + col0;
#pragma unroll
                for (int bj = 0; bj < 2; ++bj) { const size_t o = ro + bj * HALF;
                    const u32x4 b = *(const u32x4*)(SG1 + o);
                    const f32x4 g0 = {fmaxf(bflo(b.x), 1e-18f), fmaxf(bfhi(b.x), 1e-18f), fmaxf(bflo(b.y), 1e-18f), fmaxf(bfhi(b.y), 1e-18f)}, g1 = {fmaxf(bflo(b.z), 1e-18f), fmaxf(bfhi(b.z), 1e-18f), fmaxf(bflo(b.w), 1e-18f), fmaxf(bfhi(b.w), 1e-18f)};
                    const f32x4 v0 = acc[ai][bj][m][0] * g0, v1 = acc[ai][bj][m][1] * g1;
                    u32x4 w; w.x = cvt_pk_bf16(v0[0], v0[1]); w.y = cvt_pk_bf16(v0[2], v0[3]); w.z = cvt_pk_bf16(v1[0], v1[1]); w.w = cvt_pk_bf16(v1[2], v1[3]);
                    *(u32x4*)(MIX + o) = w; } }
    }
};
struct EpiWout {
    static constexpr bool PERM = false, AFTER_DRAIN = false, MIDK = false;
    const float* x; float* out; const float* mod;
    __device__ __forceinline__ void operator()(const f32x4 (&acc)[2][2][4][2], const Unit& u, int wr, int wc, int fr, int fq) const {
        const int row0 = u.pm * BM + wr * 64 + fr, col0 = u.pn * BM + wc * 32 + 4 * fq;
        const float* g1p = mod + (size_t)(u.pm >> 4) * 6144 + 2048;
        f32x4 gv[2][2];
#pragma unroll
        for (int bj = 0; bj < 2; ++bj)
#pragma unroll
            for (int n = 0; n < 2; ++n) gv[bj][n] = *(const f32x4*)(g1p + col0 + bj * HALF + n * 16);
#pragma unroll
        for (int ai = 0; ai < 2; ++ai)
#pragma unroll
            for (int m = 0; m < 4; ++m) { const size_t ro = (size_t)(row0 + ai * HALF + m * 16) * 1024 + col0;
#pragma unroll
                for (int bj = 0; bj < 2; ++bj)
#pragma unroll
                    for (int n = 0; n < 2; ++n) { const size_t o = ro + bj * HALF + n * 16; *(f32x4*)(out + o) = *(const f32x4*)(x + o) + gv[bj][n] * acc[ai][bj][m][n]; } }
    }
};
struct EpiUp {
    static constexpr bool PERM = true, AFTER_DRAIN = false, MIDK = false;
    bf16_t* ACT; const float* b_up;
    __device__ __forceinline__ void operator()(const f32x4 (&acc)[2][2][4][2], const Unit& u, int wr, int wc, int fr, int fq) const {
        const int e = u.pn >> 3, p = u.pn & 7;
        const int row0 = u.pm * BM + wr * 64 + fr, c0 = p * 128 + wc * 32 + 8 * fq;
        const float* bg = b_up + (size_t)e * 2048 + c0; const float* bl = bg + 1024;
        f32x4 bgv[2], blv[2];
#pragma unroll
        for (int n = 0; n < 2; ++n) { bgv[n] = *(const f32x4*)(bg + 4 * n); blv[n] = *(const f32x4*)(bl + 4 * n); }
#pragma unroll
        for (int ai = 0; ai < 2; ++ai)
#pragma unroll
            for (int m = 0; m < 4; ++m) { bf16_t* rowp = ACT + (size_t)(row0 + ai * HALF + m * 16) * 1024 + c0;
                f32x4 a[2];
#pragma unroll
                for (int n = 0; n < 2; ++n) { const f32x4 g = acc[ai][0][m][n] + bgv[n], l = acc[ai][1][m][n] + blv[n];
#pragma unroll
                    for (int j = 0; j < 4; ++j) { const float gg = fminf(g[j], 7.0f), ll = fminf(fmaxf(l[j], -7.0f), 7.0f); a[n][j] = (ll + 1.0f) * gg * fast_sigmoid(1.702f * gg); } }
                u32x4 w; w.x = cvt_pk_bf16(a[0][0], a[0][1]); w.y = cvt_pk_bf16(a[0][2], a[0][3]); w.z = cvt_pk_bf16(a[1][0], a[1][1]); w.w = cvt_pk_bf16(a[1][2], a[1][3]);
                *(u32x4*)rowp = w; }
    }
};
struct EpiDown {
    static constexpr bool PERM = true, AFTER_DRAIN = false, MIDK = false;
    bf16_t* YR; const float* b_down; const float* row_gate; const LAS int* tbl;
    __device__ __forceinline__ void operator()(const f32x4 (&acc)[2][2][4][2], const Unit& u, int wr, int wc, int fr, int fq) const {
        const int e = u.pn >> 2, p = u.pn & 3;
        const int row0 = u.pm * BM + wr * 64 + fr, c0 = p * BM + wc * 32 + 8 * fq;
        f32x4 bv[2][2];
#pragma unroll
        for (int bj = 0; bj < 2; ++bj)
#pragma unroll
            for (int n = 0; n < 2; ++n) bv[bj][n] = *(const f32x4*)(b_down + (size_t)e * 1024 + c0 + bj * HALF + 4 * n);
#pragma unroll
        for (int ai = 0; ai < 2; ++ai)
#pragma unroll
            for (int m = 0; m < 4; ++m) { const int r = row0 + ai * HALF + m * 16; const int pos = r - tbl[32 + e] * 256;
                const float gt = pos < tbl[e] ? __hip_atomic_load(row_gate + (size_t)e * 16384 + pos, __ATOMIC_RELAXED, __HIP_MEMORY_SCOPE_AGENT) : 0.0f;
                bf16_t* rowp = YR + (size_t)r * 1024 + c0;
#pragma unroll
                for (int bj = 0; bj < 2; ++bj) { const f32x4 v0 = (acc[ai][bj][m][0] + bv[bj][0]) * gt, v1 = (acc[ai][bj][m][1] + bv[bj][1]) * gt;
                    u32x4 w; w.x = cvt_pk_bf16(v0[0], v0[1]); w.y = cvt_pk_bf16(v0[2], v0[3]); w.z = cvt_pk_bf16(v1[0], v1[1]); w.w = cvt_pk_bf16(v1[2], v1[3]);
                    *(u32x4*)(rowp + bj * HALF) = w; } }
    }
};
}

__device__ __forceinline__ void p0_transpose_item(const float* W, int N, bf16* WT, int Kd, size_t dst_row0, LAS float* scr, int k0, int n0, int lane) {
#pragma unroll 8
    for (int i = 0; i < 32; ++i) { const int kk = 2 * i + (lane >> 5); scr[kk * 33 + (lane & 31)] = W[(size_t)(k0 + kk) * N + n0 + (lane & 31)]; }
    LDS_WAIT(); asm volatile("" ::: "memory");
    const int c = lane & 7;
#pragma unroll
    for (int j = 0; j < 4; ++j) { const int n = (lane >> 3) + 8 * j; const LAS float* s = scr + (8 * c) * 33 + n;
        v4u o; o.x = pk2(s[0 * 33], s[1 * 33]); o.y = pk2(s[2 * 33], s[3 * 33]); o.z = pk2(s[4 * 33], s[5 * 33]); o.w = pk2(s[6 * 33], s[7 * 33]);
        *(GAS v4u*)(WT + (dst_row0 + n) * (size_t)Kd + k0 + 8 * c) = o; }
    LDS_WAIT(); asm volatile("" ::: "memory");
}
__device__ __forceinline__ void p0_prologue(Frame& F, const Args& args) {
    const float* c_in = IN_F(1); const int* pos = IN_I(2); const float* ada_w = IN_F(3); const float* ada_b = IN_F(4);
    for (int task = F.vcu; task < 96; task += F.G) {
        LAS float* sc = (LAS float*)F.lds;
        LAS float* red = (LAS float*)(F.lds + 16384);
        for (int i = F.tid; i < 4096; i += 512) { const float v = c_in[i]; sc[i] = v / (1.0f + expf(-v)); }
        __syncthreads();
        const int colq = F.lane & 15, kq = F.lane >> 4, col = task * 64 + colq * 4;
        float acc[4][4];
#pragma unroll
        for (int b = 0; b < 4; ++b)
#pragma unroll
            for (int j = 0; j < 4; ++j) acc[b][j] = 0.f;
#pragma unroll 4
        for (int s = 0; s < 32; ++s) { const int k = F.wave * 128 + s * 4 + kq; const f32x4 wv = *(const f32x4*)(ada_w + (size_t)k * 6144 + col);
#pragma unroll
            for (int b = 0; b < 4; ++b) { const float sv = sc[b * 1024 + k];
#pragma unroll
                for (int j = 0; j < 4; ++j) acc[b][j] += sv * wv[j]; } }
#pragma unroll
        for (int b = 0; b < 4; ++b)
#pragma unroll
            for (int j = 0; j < 4; ++j) { float v = acc[b][j]; v += __shfl_xor(v, 16); v += __shfl_xor(v, 32); if (kq == 0) red[(F.wave * 4 + b) * 64 + colq * 4 + j] = v; }
        __syncthreads();
        if (F.tid < 256) { const int b = F.tid >> 6, cc = F.tid & 63; float s = ada_b[task * 64 + cc];
#pragma unroll
            for (int w = 0; w < 8; ++w) s += red[(w * 4 + b) * 64 + cc];
            WSP(float, WS_MOD)[b * 6144 + task * 64 + cc] = s; }
        VM_WAIT(); __syncthreads();
        if (F.tid == 0) { __builtin_amdgcn_fence(__ATOMIC_RELEASE, "agent"); VM_WAIT(); __hip_atomic_fetch_add((unsigned*)(F.ws + WS_CTL) + CW_MODCNT, 1u, RLX_AGENT); }
    }
    const int gt = F.vcu * 512 + F.tid, NGT = F.G * 512;
    for (int idx = gt; idx < NTOK * 16; idx += NGT) { const int m = idx >> 4, i = idx & 15;
        double freq = 1.0; for (int q = 0; q < i; ++q) freq *= 0.44036660267178046;
        const double ang = (double)pos[m] * freq; const double nr = __builtin_rint(ang * 0.15915494309189535);
        const float r = (float)__builtin_fma(-nr, 6.283185307179586, ang);
        float sn, cs; sincosf(r, &sn, &cs);
        WSP(float, WS_TRIG)[m * 32 + i] = cs; WSP(float, WS_TRIG)[m * 32 + 16 + i] = sn; }
    { const float* wr = IN_F(20); for (int idx = gt; idx < 32 * 1024; idx += NGT) { const int e = idx >> 10, k = idx & 1023; const float w = wr[k * 32 + e];
        const unsigned hi = f2bf(w); const float rem = w - __builtin_bit_cast(float, hi << 16); WSP(bf16, WS_WRH)[idx] = (bf16)hi; WSP(bf16, WS_WRL)[idx] = (bf16)f2bf(rem); } }
    LAS float* scr = (LAS float*)(F.lds + 32768 + F.wave * 8704);
    const int gw = F.vcu * NWAVES + F.wave, NGW = F.G * NWAVES;
    constexpr int I_IN = 16 * 224, I_RG = 128, I_B = 1024, I_O = 512;
    constexpr int NITEMS = I_IN + I_RG + I_B + I_O;
    for (int it = gw; it < NITEMS; it += NGW) {
        int r = it;
        if (r < I_IN) { const int kb = r / 224, nb = r % 224; p0_transpose_item(IN_F(7), DIN, WSP(bf16, WS_WIN), 1024, (size_t)nb * 32, scr, kb * 64, nb * 32, F.lane); continue; } r -= I_IN;
        if (r < I_RG) { const int mat = r >> 6, blk = (r >> 3) & 7, kb = (r >> 2) & 1, nb = r & 3;
            p0_transpose_item(IN_F(mat ? 12 : 10) + (size_t)blk * 16384, 128, WSP(bf16, WS_WRG) + (size_t)(mat * 8 + blk) * 16384, 128, (size_t)nb * 32, scr, kb * 64, nb * 32, F.lane); continue; } r -= I_RG;
        if (r < I_B) { const int g = r >> 9, q = r & 511, kb = q >> 5, nb = q & 31;
            p0_transpose_item(IN_F(18) + (size_t)g * 1048576, 1024, WSP(bf16, WS_WB) + (size_t)g * 1024, 2048, (size_t)nb * 32, scr, kb * 64, nb * 32, F.lane); continue; } r -= I_B;
        { const int kb = r >> 5, nb = r & 31; p0_transpose_item(IN_F(19), 1024, WSP(bf16, WS_WO), 1024, (size_t)nb * 32, scr, kb * 64, nb * 32, F.lane); }
    }
}
__device__ __forceinline__ void p8_moe_weights(Frame& F, const Args& args) {
    LAS float* scr = (LAS float*)(F.lds + 32768 + F.wave * 8704);
    const int gw = F.vcu * NWAVES + F.wave, NGW = F.G * NWAVES;
    constexpr int I_UP = 32 * 1024, I_DN = 32 * 512;
    for (int it = gw; it < I_UP + I_DN; it += NGW) {
        int r = it;
        if (r < I_UP) { const int e = r >> 10, q = r & 1023, kb = q >> 6, nb = q & 63, n0 = nb * 32;
            const int bj = n0 >> 10, p = (n0 & 1023) >> 7, oo = n0 & 127;
            p0_transpose_item(IN_F(22) + (size_t)e * 2097152, 2048, WSP(bf16, WS_WUP) + (size_t)e * 2097152, 1024, (size_t)(p * 256 + bj * 128 + oo), scr, kb * 64, n0, F.lane); continue; } r -= I_UP;
        { const int e = r >> 9, q = r & 511, kb = q >> 5, nb = q & 31;
            p0_transpose_item(IN_F(24) + (size_t)e * 1048576, 1024, WSP(bf16, WS_WDN) + (size_t)e * 1048576, 1024, (size_t)nb * 32, scr, kb * 64, nb * 32, F.lane); }
    }
}

__device__ __forceinline__ void p1_hrows(Frame& F, const Args& args) {
    if (F.tid == 0) { unsigned* mc = (unsigned*)(F.ws + WS_CTL) + CW_MODCNT; unsigned sp = 0; while (__hip_atomic_load(mc, RLX_AGENT) < 96u && ++sp < (1u << 22)) __builtin_amdgcn_s_sleep(2);
        __builtin_amdgcn_fence(__ATOMIC_ACQUIRE, "agent"); VM_WAIT(); }
    __syncthreads();
    const float* x = IN_F(0); const float* g1n = IN_F(5); const float* mod = WSP(float, WS_MOD); bf16* H = WSP(bf16, WS_HB);
    const int gw = F.vcu * NWAVES + F.wave, NGW = F.G * NWAVES;
    for (int m = gw; m < NTOK; m += NGW) {
        const int b = m >> 12;
        const f32x4* xr = (const f32x4*)(x + (size_t)m * DM) + F.lane;
        f32x4 v[4]; float s = 0.f;
#pragma unroll
        for (int j = 0; j < 4; ++j) { v[j] = xr[64 * j]; s += (v[j].x * v[j].x + v[j].y * v[j].y) + (v[j].z * v[j].z + v[j].w * v[j].w); }
        const float rstd = 1.0f / sqrtf(wave_sum(s) * (1.f / DM) + EPS);
        unsigned long long* o8 = (unsigned long long*)(H + (size_t)m * DM) + F.lane;
#pragma unroll
        for (int j = 0; j < 4; ++j) { const int col = 4 * F.lane + 256 * j;
            const f32x4 g = *(const f32x4*)(g1n + col), sh = *(const f32x4*)(mod + b * 6144 + col), sc = *(const f32x4*)(mod + b * 6144 + 1024 + col);
            const f32x4 h = v[j] * rstd * g * (sc + 1.0f) + sh;
            o8[64 * j] = (unsigned long long)pk2(h.x, h.y) | ((unsigned long long)pk2(h.z, h.w) << 32); }
    }
}

__device__ __forceinline__ void p3_knorm_unit(Frame& F, const Args& args, int unit) {
    const int h = unit & 7, j = (unit >> 3) & 15, b = unit >> 7;
    bf16* KR = WSP(bf16, WS_E) + 3 * E_STRIDE; const float* trig = WSP(float, WS_TRIG); const float* kg = IN_F(16);
    const int rsub = F.lane >> 4, c16 = F.lane & 15;
    float gk[8];
#pragma unroll
    for (int i = 0; i < 8; ++i) gk[i] = kg[c16 * 8 + i];
    float km[8];
#pragma unroll
    for (int i = 0; i < 8; ++i) km[i] = 0.f;
    for (int it = 0; it < 8; ++it) {
        const int m = b * SEQ + j * 256 + F.wave * 32 + it * 4 + rsub;
        bf16* p = KR + (size_t)m * DM + h * HD + c16 * 8;
        const v4u raw = *(const v4u*)p;
        float v[8] = {bflo(raw.x), bfhi(raw.x), bflo(raw.y), bfhi(raw.y), bflo(raw.z), bfhi(raw.z), bflo(raw.w), bfhi(raw.w)};
        float ss = 0.f;
#pragma unroll
        for (int i = 0; i < 8; ++i) ss += v[i] * v[i];
        ss += __shfl_xor(ss, 1); ss += __shfl_xor(ss, 2); ss += __shfl_xor(ss, 4); ss += __shfl_xor(ss, 8);
        const float rstd = 1.0f / sqrtf(ss * (1.f / HD) + EPS);
#pragma unroll
        for (int i = 0; i < 8; ++i) v[i] = v[i] * rstd * gk[i];
        const int fi = (c16 & 1) * 8;
#pragma unroll
        for (int i = 0; i < 8; ++i) { const float other = __shfl_xor(v[i], 2);
            if (c16 < 4) { const float cs = trig[(size_t)m * 32 + fi + i], sn = trig[(size_t)m * 32 + 16 + fi + i];
                v[i] = (c16 < 2) ? (v[i] * cs - other * sn) : (v[i] * cs + other * sn); } }
#pragma unroll
        for (int i = 0; i < 8; ++i) km[i] += v[i];
        v4u o; o.x = pk2(v[0], v[1]); o.y = pk2(v[2], v[3]); o.z = pk2(v[4], v[5]); o.w = pk2(v[6], v[7]);
        *(v4u*)p = o;
    }
    LAS float* red = (LAS float*)(F.lds + XTRA_OFF);
#pragma unroll
    for (int i = 0; i < 8; ++i) { float v = km[i]; v += __shfl_xor(v, 16); v += __shfl_xor(v, 32); if (rsub == 0) red[F.wave * 128 + c16 * 8 + i] = v; }
    __syncthreads();
    if (F.tid < 128) { float s = 0.f;
#pragma unroll
        for (int w = 0; w < 8; ++w) s += red[w * 128 + F.tid];
        WSP(float, WS_KMEAN)[((size_t)(b * NH + h) * 16 + j) * HD + F.tid] = s * (1.f / 256.f); }
    __syncthreads();
}

__device__ __forceinline__ void p3_rnn_local_unit(Frame& F, const Args& args, int unit) {
    const int n = unit & 7, c = (unit >> 3) & 15, b = unit >> 7;
    const int t0 = c * 256, m0 = b * SEQ + t0, ch0 = n * 128;
    const bf16* XR = WSP(bf16, WS_E);
    LAS unsigned char* At = F.lds;
    {
        const int cg = F.tid & 15, rs = F.tid >> 4; const int chb = ch0 + cg * 8;
        const float* cw = IN_F(8); const float* cb = IN_F(9);
        float w0[8], w1[8], w2[8], w3[8], bb[8];
#pragma unroll
        for (int i = 0; i < 8; ++i) { w0[i] = cw[chb + i]; w1[i] = cw[1024 + chb + i]; w2[i] = cw[2048 + chb + i]; w3[i] = cw[3072 + chb + i]; bb[i] = cb[chb + i]; }
        float p1[8], p2[8], p3[8];
        const int tr0 = t0 + rs * 8;
#define LDROW(dst, tt) do { if ((tt) >= 0) { const v4u r_ = *(const v4u*)(XR + (size_t)(b * SEQ + (tt)) * DM + chb); \
            dst[0] = bflo(r_.x); dst[1] = bfhi(r_.x); dst[2] = bflo(r_.y); dst[3] = bfhi(r_.y); dst[4] = bflo(r_.z); dst[5] = bfhi(r_.z); dst[6] = bflo(r_.w); dst[7] = bfhi(r_.w); } \
            else { _Pragma("unroll") for (int i_ = 0; i_ < 8; ++i_) dst[i_] = 0.f; } } while (0)
        LDROW(p3, tr0 - 3); LDROW(p2, tr0 - 2); LDROW(p1, tr0 - 1);
#pragma unroll
        for (int r = 0; r < 8; ++r) { float cur[8]; LDROW(cur, tr0 + r);
            float xc[8];
#pragma unroll
            for (int i = 0; i < 8; ++i) xc[i] = bb[i] + w0[i] * cur[i] + w1[i] * p1[i] + w2[i] * p2[i] + w3[i] * p3[i];
            const int row = rs * 8 + r;
            v4u o; o.x = pk2(xc[0], xc[1]); o.y = pk2(xc[2], xc[3]); o.z = pk2(xc[4], xc[5]); o.w = pk2(xc[6], xc[7]);
            *(LAS v4u*)(At + row * 256 + ((cg ^ (row & 15)) << 4)) = o;
#pragma unroll
            for (int i = 0; i < 8; ++i) { p3[i] = p2[i]; p2[i] = p1[i]; p1[i] = cur[i]; } }
#undef LDROW
    }
    __syncthreads();
    const int fr = F.lane & 15, fq = F.lane >> 4;
    const int vloc = F.wave * 16 + fr, ch = ch0 + vloc;
    const bf16* WA = WSP(bf16, WS_WRG) + (size_t)n * 16384 + (size_t)vloc * 128 + fq * 8;
    const bf16* WX = WA + 8 * 16384;
    bf16x8 Ba[4], Bx[4];
#pragma unroll
    for (int s = 0; s < 4; ++s) { Ba[s] = *(const bf16x8*)(WA + 32 * s); Bx[s] = *(const bf16x8*)(WX + 32 * s); }
    const float ba = IN_F(11)[ch], bx = IN_F(13)[ch];
    const float sp8 = 8.0f * log1pf(expf(-IN_F(14)[ch]));
    float cP = 1.f, cH = 0.f;
    bf16* HL = WSP(bf16, WS_HL); bf16* PP = WSP(bf16, WS_PP);
    LAS unsigned short* stg = (LAS unsigned short*)(F.lds + 65536);
    for (int rq = 0; rq < 4; ++rq) {
        LAS unsigned short* sb = stg + (rq & 1) * 16384;
#pragma unroll
        for (int ri = 0; ri < 4; ++ri) { const int rt = rq * 4 + ri;
            f32x4 accr = {0.f, 0.f, 0.f, 0.f}, accx = {0.f, 0.f, 0.f, 0.f};
            const int arow = rt * 16 + fr;
#pragma unroll
            for (int s = 0; s < 4; ++s) { const bf16x8 a = *(const LAS bf16x8*)(At + arow * 256 + (((fq + 4 * s) ^ (arow & 15)) << 4));
                accr = __builtin_amdgcn_mfma_f32_16x16x32_bf16(a, Ba[s], accr, 0, 0, 0);
                accx = __builtin_amdgcn_mfma_f32_16x16x32_bf16(a, Bx[s], accx, 0, 0, 0); }
            float pj[4], hj[4];
#pragma unroll
            for (int j = 0; j < 4; ++j) { const int row = rt * 16 + 4 * fq + j;
                const float xcv = bf2f(*(const LAS unsigned short*)(At + row * 256 + ((((vloc >> 3)) ^ (row & 15)) << 4) + (vloc & 7) * 2));
                const float r = fast_sigmoid(accr[j] + ba), ig = fast_sigmoid(accx[j] + bx);
                const float a = __builtin_amdgcn_exp2f(-sp8 * r * 1.4426950408889634f);
                float mult = __builtin_amdgcn_sqrtf(fmaxf(fmaf(-a, a, 1.0f), 0.0f)); if (t0 + row == 0) mult = 1.0f;
                const float u = mult * ig * xcv;
                pj[j] = (j ? pj[j - 1] : 1.0f) * a; hj[j] = (j ? hj[j - 1] * a : 0.0f) + u; }
            const float tp = pj[3], th = hj[3];
            const float pa = __shfl(tp, F.lane - 16), ha = __shfl(th, F.lane - 16);
            const float pb = __shfl(tp, F.lane - 32), hb = __shfl(th, F.lane - 32);
            const float pc = __shfl(tp, F.lane - 48), hc = __shfl(th, F.lane - 48);
            float Pq, Hq;
            if (fq == 0) { Pq = 1.f; Hq = 0.f; } else if (fq == 1) { Pq = pa; Hq = ha; } else if (fq == 2) { Pq = pb * pa; Hq = pa * hb + ha; } else { Pq = pc * pb * pa; Hq = pa * (pb * hc + hb) + ha; }
            const float hstart = Hq + Pq * cH, pstart = Pq * cP;
            float hl3 = 0.f, pp3 = 0.f;
#pragma unroll
            for (int j = 0; j < 4; ++j) { const float hv = hj[j] + pj[j] * hstart, pv = pj[j] * pstart; const int rl = ri * 16 + 4 * fq + j;
                sb[rl * 128 + vloc] = (unsigned short)f2bf(hv); sb[8192 + rl * 128 + vloc] = (unsigned short)f2bf(pv); if (j == 3) { hl3 = hv; pp3 = pv; } }
            cH = __shfl(hl3, fr + 48); cP = __shfl(pp3, fr + 48);
        }
        __syncthreads();
#pragma unroll
        for (int q4 = 0; q4 < 4; ++q4) { const int idx = q4 * 512 + F.tid, arr = idx >> 10, rr = (idx >> 4) & 63, c16 = idx & 15;
            const v4u val = *(const LAS v4u*)(sb + arr * 8192 + rr * 128 + c16 * 8);
            bf16* dst = (arr ? PP : HL) + (size_t)(m0 + rq * 64 + rr) * DM + ch0 + c16 * 8;
            *(v4u*)dst = val; }
    }
    if (fq == 0) { WSP(float, WS_AGGP)[(size_t)(b * 16 + c) * 1024 + ch] = cP; WSP(float, WS_AGGH)[(size_t)(b * 16 + c) * 1024 + ch] = cH; }
    __syncthreads();
}

__device__ __forceinline__ void p4_rnn_final_unit(Frame& F, const Args& args, int unit) {
    const int n = unit & 7, c = (unit >> 3) & 15, b = unit >> 7;
    const int m0 = b * SEQ + c * 256, ch0 = n * 128;
    LAS float* car = (LAS float*)(F.lds + XTRA_OFF);
    if (F.tid < 128) { const int ch = ch0 + F.tid; float h = 0.f;
        for (int cc = 0; cc < c; ++cc) { const float p = WSP(float, WS_AGGP)[(size_t)(b * 16 + cc) * 1024 + ch], hh = WSP(float, WS_AGGH)[(size_t)(b * 16 + cc) * 1024 + ch]; h = p * h + hh; }
        car[F.tid] = h; }
    __syncthreads();
    const bf16* HL = WSP(bf16, WS_HL); const bf16* PP = WSP(bf16, WS_PP); const bf16* GG = WSP(bf16, WS_E) + E_STRIDE; bf16* Y = WSP(bf16, WS_YCAT);
    const int c16 = F.tid & 15, r0 = F.tid >> 4;
    float cv[8];
#pragma unroll
    for (int i = 0; i < 8; ++i) cv[i] = car[c16 * 8 + i];
#pragma unroll 2
    for (int it = 0; it < 8; ++it) { const size_t o = (size_t)(m0 + it * 32 + r0) * DM + ch0 + c16 * 8, oy = (size_t)(m0 + it * 32 + r0) * 2048 + ch0 + c16 * 8;
        const v4u hl = *(const v4u*)(HL + o), pp = *(const v4u*)(PP + o), gg = *(const v4u*)(GG + o);
        v4u y;
        y.x = pk2((bflo(hl.x) + bflo(pp.x) * cv[0]) * bflo(gg.x), (bfhi(hl.x) + bfhi(pp.x) * cv[1]) * bfhi(gg.x));
        y.y = pk2((bflo(hl.y) + bflo(pp.y) * cv[2]) * bflo(gg.y), (bfhi(hl.y) + bfhi(pp.y) * cv[3]) * bfhi(gg.y));
        y.z = pk2((bflo(hl.z) + bflo(pp.z) * cv[4]) * bflo(gg.z), (bfhi(hl.z) + bfhi(pp.z) * cv[5]) * bfhi(gg.z));
        y.w = pk2((bflo(hl.w) + bflo(pp.w) * cv[6]) * bflo(gg.w), (bfhi(hl.w) + bfhi(pp.w) * cv[7]) * bfhi(gg.w));
        *(v4u*)(Y + oy) = y; }
    __syncthreads();
}

namespace att {
constexpr int KVBLK = 64, SHM_K = KVBLK * HD * 2, SHM_V = SHM_K;
constexpr float C2 = 0.08838834764831845f * 1.4426950408889634f;
#define KSWZ(row, colB) ((row) * 256 + ((colB) ^ (((row) & 7) << 4)))
__device__ __forceinline__ int v_st(int k, int c) { const int kk = (k & ~0xC) | ((k & 4) << 1) | ((k & 8) >> 1); return ((kk >> 3) * 4 + (c >> 5)) * 512 + ((kk & 7) * 32 + (c & 31)) * 2; }
__device__ __forceinline__ int v_rd_base(int lane) { return ((lane & 3) << 3) | (((lane >> 2) & 3) << 6) | (((lane >> 4) & 1) << 5) | (((lane >> 5) & 1) << 8); }
constexpr int v_rd_off(int d0, int ks, int half) { return d0 * 512 + ks * 4096 + half * 2048; }
__device__ __forceinline__ int crow(int r, int hi) { return (r & 3) + 8 * (r >> 2) + 4 * hi; }

template <int KB>
__device__ __forceinline__ void qkt(f32x16& p0, f32x16& p1, const char* K_lds, int r32, int hi, const char* qfrag, bool act) {
    if (!act) { const float NEG = -__builtin_inff();
#pragma unroll
        for (int r = 0; r < 16; ++r) { p0[r] = NEG; p1[r] = NEG; } return; }
    p0 = f32x16{}; p1 = f32x16{};
    const char* kb[4];
#pragma unroll
    for (int dd = 0; dd < 4; ++dd) kb[dd] = K_lds + KB * SHM_K + KSWZ(r32, (dd * 16 + hi * 8) * 2);
#pragma unroll
    for (int d0 = 0; d0 < 8; ++d0) { const char* a = kb[d0 & 3] + (d0 >> 2) * 128;
        bf16x8 b0 = *reinterpret_cast<const bf16x8*>(a);
        bf16x8 b1 = *reinterpret_cast<const bf16x8*>(a + 32 * 256);
        const bf16x8 q = *reinterpret_cast<const bf16x8*>(qfrag + d0 * 1024);
        p0 = __builtin_amdgcn_mfma_f32_32x32x16_bf16(b0, q, p0, 0, 0, 0);
        p1 = __builtin_amdgcn_mfma_f32_32x32x16_bf16(b1, q, p1, 0, 0, 0); }
}
template <int VB>
__device__ __forceinline__ void pv_tile(f32x16* o, int vb0, bf16x8 pa0, bf16x8 pa1, bf16x8 pa2, bf16x8 pa3, bool act) {
    if (!act) return;
#define TRRD(dst, off) asm volatile("ds_read_b64_tr_b16 %0, %1 offset:%2" : "=&v"(dst) : "v"(vb0), "i"(off) : "memory")
#define PV_D0(d0) do { s16x4 l0, l1, l2, l3, h0, h1, h2, h3; constexpr int b_ = VB * SHM_V + v_rd_off(d0, 0, 0); \
        TRRD(l0, b_); TRRD(h0, b_ + 2048); TRRD(l1, b_ + 4096); TRRD(h1, b_ + 6144); TRRD(l2, b_ + 8192); TRRD(h2, b_ + 10240); TRRD(l3, b_ + 12288); TRRD(h3, b_ + 14336); \
        asm volatile("s_waitcnt lgkmcnt(0)" ::: "memory"); SBAR(); \
        o[d0] = __builtin_amdgcn_mfma_f32_32x32x16_bf16(pa0, (bf16x8){l0[0], l0[1], l0[2], l0[3], h0[0], h0[1], h0[2], h0[3]}, o[d0], 0, 0, 0);   \
        o[d0] = __builtin_amdgcn_mfma_f32_32x32x16_bf16(pa1, (bf16x8){l1[0], l1[1], l1[2], l1[3], h1[0], h1[1], h1[2], h1[3]}, o[d0], 0, 0, 0);   \
        o[d0] = __builtin_amdgcn_mfma_f32_32x32x16_bf16(pa2, (bf16x8){l2[0], l2[1], l2[2], l2[3], h2[0], h2[1], h2[2], h2[3]}, o[d0], 0, 0, 0);   \
        o[d0] = __builtin_amdgcn_mfma_f32_32x32x16_bf16(pa3, (bf16x8){l3[0], l3[1], l3[2], l3[3], h3[0], h3[1], h3[2], h3[3]}, o[d0], 0, 0, 0); } while (0)
    PV_D0(0); PV_D0(1); PV_D0(2); PV_D0(3);
#undef PV_D0
#undef TRRD
}
__device__ __forceinline__ void sm_a(f32x16& p0) {
#pragma unroll
    for (int r = 0; r < 16; ++r) p0[r] = __builtin_amdgcn_exp2f(p0[r]);
}
__device__ __forceinline__ void sm_b(f32x16& p0, f32x16& p1, float& l_reg, bf16x8& pa0, bf16x8& pa1, bf16x8& pa2, bf16x8& pa3) {
#pragma unroll
    for (int r = 0; r < 16; ++r) p1[r] = __builtin_amdgcn_exp2f(p1[r]);
    float ps = 0;
#pragma unroll
    for (int r = 0; r < 16; ++r) ps += p0[r];
#pragma unroll
    for (int r = 0; r < 16; ++r) ps += p1[r];
    l_reg += ps;
#define PK4(P, B_, OUT) do { unsigned a0 = cvtpk(P[B_+0], P[B_+1]), a1 = cvtpk(P[B_+2], P[B_+3]); \
        unsigned b0 = cvtpk(P[B_+4], P[B_+5]), b1 = cvtpk(P[B_+6], P[B_+7]); \
        auto r0 = __builtin_amdgcn_permlane32_swap(a0, b0, false, false); auto r1 = __builtin_amdgcn_permlane32_swap(a1, b1, false, false); \
        v4u w = {r0[0], r1[0], r0[1], r1[1]}; OUT = *reinterpret_cast<bf16x8*>(&w); } while (0)
    PK4(p0, 0, pa0); PK4(p0, 8, pa1); PK4(p1, 0, pa2); PK4(p1, 8, pa3);
#undef PK4
}

__device__ __forceinline__ void attn_unit(Frame& F, const Args& args, int b, int h, int iq) {
    int tid = F.tid; asm volatile("" : "+v"(tid));
    const int wid = F.wave, lane = tid & 63, r32 = lane & 31, hi = lane >> 5;
    char* lds = F.ldsg;
    char* V_lds = lds; char* K_lds = lds + 2 * SHM_V;
    float* kml = (float*)(lds + XTRA_OFF);
    char* qfrag = lds + 65536 + wid * 8192 + lane * 16;
    const bf16* QR = WSP(bf16, WS_E) + 2 * E_STRIDE; const bf16* KN = WSP(bf16, WS_E) + 3 * E_STRIDE; const bf16* VV = WSP(bf16, WS_E) + 4 * E_STRIDE;
    bf16* YA = WSP(bf16, WS_YCAT) + 1024;
    const size_t mb = (size_t)b * SEQ;
    const int q0 = iq * 256, NT = 4 * (iq + 1);
    const bf16* Kh = KN + mb * DM + h * HD; const bf16* Vh = VV + mb * DM + h * HD;
    { const float* kmg = WSP(float, WS_KMEAN) + (size_t)(b * NH + h) * 16 * HD; for (int idx = tid; idx < iq * HD; idx += 512) kml[idx] = kmg[idx]; }
    const int sr = tid >> 4, sc = (tid & 15) * 8, vst0 = v_st(sr, sc), vst1 = v_st(32 + sr, sc), kws = KSWZ(sr, sc * 2);
    const int vb0 = (int)(uintptr_t)V_lds + v_rd_base(lane);
    bf16x8 st_v0, st_v1, st_k0, st_k1;
    const unsigned goff = (unsigned)(sr * DM + sc) * 2u;
#define ROWP(p, k0, rr) ((const char*)((p) + (size_t)((k0) + (rr)) * DM) + goff)
#define SLOAD(k0) do { st_v0 = *(const bf16x8*)ROWP(Vh, k0, 0); st_v1 = *(const bf16x8*)ROWP(Vh, k0, 32); st_k0 = *(const bf16x8*)ROWP(Kh, k0, 0); st_k1 = *(const bf16x8*)ROWP(Kh, k0, 32); } while (0)
#define SWRITE(bf) do { *(bf16x8*)(V_lds + (bf) * SHM_V + vst0) = st_v0; *(bf16x8*)(V_lds + (bf) * SHM_V + vst1) = st_v1; \
                        *(bf16x8*)(K_lds + (bf) * SHM_K + kws) = st_k0; *(bf16x8*)(K_lds + (bf) * SHM_K + kws + 32 * 256) = st_k1; } while (0)
    SLOAD(0);
    const size_t mq = mb + q0 + wid * 32 + r32;
    unsigned selmask;
    {
        bf16x8 qr[8];
        const bf16* qp = QR + mq * DM + h * HD + hi * 8;
        v4u raw[8];
#pragma unroll
        for (int d0 = 0; d0 < 8; ++d0) raw[d0] = *(const v4u*)(qp + d0 * 16);
        float ss = 0.f;
#pragma unroll
        for (int d0 = 0; d0 < 8; ++d0) { const float a0 = bflo(raw[d0].x), a1 = bfhi(raw[d0].x), a2 = bflo(raw[d0].y), a3 = bfhi(raw[d0].y), a4 = bflo(raw[d0].z), a5 = bfhi(raw[d0].z), a6 = bflo(raw[d0].w), a7 = bfhi(raw[d0].w);
            ss += (a0 * a0 + a1 * a1) + (a2 * a2 + a3 * a3) + (a4 * a4 + a5 * a5) + (a6 * a6 + a7 * a7); }
        ss += __shfl_xor(ss, 32);
        const float rs = C2 / sqrtf(ss * (1.f / HD) + EPS);
        const float* qg = IN_F(15) + hi * 8;
#define UNPK(f, W_) do { const v4u t_ = (W_); f[0] = bflo(t_.x); f[1] = bfhi(t_.x); f[2] = bflo(t_.y); f[3] = bfhi(t_.y); f[4] = bflo(t_.z); f[5] = bfhi(t_.z); f[6] = bflo(t_.w); f[7] = bfhi(t_.w); } while (0)
#define PACK(f) ({ v4u w_; w_.x = cvtpk(f[0], f[1]); w_.y = cvtpk(f[2], f[3]); w_.z = cvtpk(f[4], f[5]); w_.w = cvtpk(f[6], f[7]); *reinterpret_cast<bf16x8*>(&w_); })
        { float f0[8], f1[8]; UNPK(f0, raw[0]); UNPK(f1, raw[1]);
          const float* tg = WSP(float, WS_TRIG) + mq * 32 + hi * 8;
#pragma unroll
          for (int j = 0; j < 8; ++j) { const float x1 = f0[j] * rs * qg[j], x2 = f1[j] * rs * qg[16 + j], cs = tg[j], sn = tg[16 + j]; f0[j] = x1 * cs - x2 * sn; f1[j] = x2 * cs + x1 * sn; }
          qr[0] = PACK(f0); qr[1] = PACK(f1); }
#pragma unroll
        for (int d0 = 2; d0 < 8; ++d0) { float f[8]; UNPK(f, raw[d0]);
#pragma unroll
            for (int j = 0; j < 8; ++j) f[j] *= rs * qg[d0 * 16 + j];
            qr[d0] = PACK(f); }
        __syncthreads();
        float v1 = -__builtin_inff(), v2 = v1, v3 = v1; int i1 = 0, i2 = 0, i3 = 0;
#pragma unroll 1
        for (int jb = 0; jb < iq; ++jb) { const float* km = kml + jb * HD + hi * 8; float g = 0.f;
#pragma unroll
            for (int d0 = 0; d0 < 8; ++d0) { float f[8]; UNPK(f, *reinterpret_cast<const v4u*>(&qr[d0]));
                const f32x4 k0 = *(const f32x4*)(km + d0 * 16), k1 = *(const f32x4*)(km + d0 * 16 + 4);
                g += (f[0] * k0[0] + f[1] * k0[1]) + (f[2] * k0[2] + f[3] * k0[3]) + (f[4] * k1[0] + f[5] * k1[1]) + (f[6] * k1[2] + f[7] * k1[3]); }
            g += __shfl_xor(g, 32);
            if (g > v1) { v3 = v2; i3 = i2; v2 = v1; i2 = i1; v1 = g; i1 = jb; }
            else if (g > v2) { v3 = v2; i3 = i2; v2 = g; i2 = jb; }
            else if (g > v3) { v3 = g; i3 = jb; } }
#undef UNPK
#undef PACK
        selmask = 0u; if (iq >= 1) selmask |= 1u << i1; if (iq >= 2) selmask |= 1u << i2; if (iq >= 3) selmask |= 1u << i3;
#pragma unroll
        for (int d0 = 0; d0 < 8; ++d0) *reinterpret_cast<bf16x8*>(qfrag + d0 * 1024) = qr[d0];
    }
    float l_reg = 0.f; f32x16 o[4] = {};
    const int wrow0 = wid * 32;
#define ACT(t) (((t) >> 2) < iq ? (__ballot((selmask >> ((t) >> 2)) & 1u) != 0ull) : ((((t) - 4 * iq) * 64) <= wrow0 + 31))
#define MASKT(P0_, P1_, t) do { const int blk_ = (t) >> 2; const float NEG_ = -__builtin_inff(); \
        if (blk_ < iq) { if (!((selmask >> blk_) & 1u)) { _Pragma("unroll") for (int r = 0; r < 16; ++r) { P0_[r] = NEG_; P1_[r] = NEG_; } } } \
        else { const int kb_ = ((t) - 4 * iq) * 64; if (kb_ + 63 > wrow0) { int dq_ = wrow0 + r32 - kb_ - 4 * hi; asm volatile("" : "+v"(dq_)); \
            _Pragma("unroll") for (int r = 0; r < 16; ++r) { const int c_ = (r & 3) + 8 * (r >> 2); if (c_ > dq_) P0_[r] = NEG_; if (c_ + 32 > dq_) P1_[r] = NEG_; } } } } while (0)
    f32x16 pA0, pA1, pB0, pB1; bf16x8 pa0, pa1, pa2, pa3;
    VM_WAIT(); SWRITE(0); SBAR();
    SLOAD(64);
    __syncthreads();
    SBAR(); qkt<0>(pA0, pA1, K_lds, r32, hi, qfrag, ACT(0));
    MASKT(pA0, pA1, 0); sm_a(pA0);
    VM_WAIT(); SWRITE(1);
    __syncthreads();
#define HALF_STEP(PX0, PX1, PY0, PY1, t, KB, VB, SB) do { \
        SBAR(); qkt<KB>(PX0, PX1, K_lds, r32, hi, qfrag, ACT(t)); \
        sm_b(PY0, PY1, l_reg, pa0, pa1, pa2, pa3); SBAR(); \
        if ((t) + 1 < NT) { SLOAD(((t) + 1) * 64); SBAR(); } \
        pv_tile<VB>(o, vb0, pa0, pa1, pa2, pa3, ACT((t) - 1)); MASKT(PX0, PX1, (t)); sm_a(PX0); \
        __syncthreads(); \
        if ((t) + 1 < NT) { VM_WAIT(); SWRITE(SB); } \
        __syncthreads(); } while (0)
    for (int t = 1; t + 1 < NT; t += 2) {
        HALF_STEP(pB0, pB1, pA0, pA1, t, 1, 0, 0);
        HALF_STEP(pA0, pA1, pB0, pB1, t + 1, 0, 1, 1);
    }
    SBAR(); qkt<1>(pB0, pB1, K_lds, r32, hi, qfrag, ACT(NT - 1)); SBAR();
    sm_b(pA0, pA1, l_reg, pa0, pa1, pa2, pa3); SBAR();
    pv_tile<0>(o, vb0, pa0, pa1, pa2, pa3, ACT(NT - 2));
    MASKT(pB0, pB1, NT - 1); sm_a(pB0);
    sm_b(pB0, pB1, l_reg, pa0, pa1, pa2, pa3); SBAR();
    pv_tile<1>(o, vb0, pa0, pa1, pa2, pa3, ACT(NT - 1));
    l_reg += __shfl_xor(l_reg, 32);
    float* li_l = (float*)(lds + XTRA_OFF + 8192) + wid * 32;
    if (hi == 0) li_l[r32] = l_reg;
    asm volatile("s_waitcnt lgkmcnt(0)" ::: "memory");
    float rli[16];
#pragma unroll
    for (int r = 0; r < 16; ++r) rli[r] = __builtin_amdgcn_rcpf(li_l[crow(r, hi)]);
    bf16* Ow = YA + (mb + q0 + wid * 32) * 2048 + h * HD;
#pragma unroll
    for (int r = 0; r < 16; ++r) { const int orow = crow(r, hi);
#pragma unroll
        for (int d0 = 0; d0 < 4; ++d0) { const float v = o[d0][r] * rli[r]; const float vn = __shfl_xor(v, 1);
            if ((r32 & 1) == 0) *(unsigned*)(Ow + (size_t)orow * 2048 + d0 * 32 + r32) = cvtpk(v, vn); } }
    __syncthreads();
#undef ROWP
#undef SLOAD
#undef SWRITE
#undef ACT
#undef MASKT
#undef HALF_STEP
}
#undef KSWZ
}

__device__ __forceinline__ void p7_router(Frame& F, const Args& args) {
    LAS float* ssq = (LAS float*)F.lds;
    LAS float* par = (LAS float*)(F.lds + 2048);
    LAS float* lg = (LAS float*)(F.lds + 10240);
    LAS int* hist = (LAS int*)(F.lds + 77824 + 2048);
    LAS int* sel = (LAS int*)(F.lds + 77824 + 4096);
    const float* g2n = IN_F(6); const float* mod = WSP(float, WS_MOD); const float* brt = IN_F(21);
    bf16* H2 = WSP(bf16, WS_HB);
    unsigned* CNT = (unsigned*)(F.ws + WS_CTL) + CW_CNT;
    const int row = F.lane & 15, q = F.lane >> 4, kw = F.wave * 128;
    bf16x8 Bh[4][2], Bl[4][2];
    { const bf16* wh = WSP(bf16, WS_WRH) + (size_t)row * 1024 + kw + 8 * q; const bf16* wl = WSP(bf16, WS_WRL) + (size_t)row * 1024 + kw + 8 * q;
#pragma unroll
      for (int s = 0; s < 4; ++s) { Bh[s][0] = *(const bf16x8*)(wh + 32 * s); Bh[s][1] = *(const bf16x8*)(wh + 16384 + 32 * s); Bl[s][0] = *(const bf16x8*)(wl + 32 * s); Bl[s][1] = *(const bf16x8*)(wl + 16384 + 32 * s); } }
    for (int vw = F.vcu; vw < 256; vw += F.G) {
        const int m0 = vw * 64, b = m0 >> 12;
        for (int i = F.tid; i < 1024; i += 512) { par[i] = g2n[i] * (1.0f + mod[b * 6144 + 4096 + i]); par[1024 + i] = mod[b * 6144 + 3072 + i]; }
        if (F.tid < 32) hist[F.tid] = 0;
#pragma unroll
        for (int rt = 0; rt < 4; ++rt) { const float* xp = F.out + (size_t)(m0 + rt * 16 + row) * DM + kw + 8 * q; float ss = 0.f;
#pragma unroll
            for (int s = 0; s < 4; ++s) { const f32x4 x0 = *(const f32x4*)(xp + 32 * s), x1 = *(const f32x4*)(xp + 32 * s + 4); const f32x4 a = x0 * x0 + x1 * x1; ss += (a.x + a.y) + (a.z + a.w); }
            ss += __shfl_xor(ss, 16); ss += __shfl_xor(ss, 32);
            if (q == 0) ssq[F.wave * 64 + rt * 16 + row] = ss; }
        __syncthreads();
#pragma unroll
        for (int rt = 0; rt < 4; ++rt) { const int rl = rt * 16 + row; float tot = 0.f;
#pragma unroll
            for (int w = 0; w < 8; ++w) tot += ssq[w * 64 + rl];
            const float rstd = 1.0f / sqrtf(tot * (1.f / DM) + EPS);
            f32x4 acc0 = {0.f, 0.f, 0.f, 0.f}, acc1 = {0.f, 0.f, 0.f, 0.f};
            bf16* hp = H2 + (size_t)(m0 + rl) * DM + kw + 8 * q; const float* xp = F.out + (size_t)(m0 + rl) * DM + kw + 8 * q;
            f32x4 xq[4][2];
#pragma unroll
            for (int s = 0; s < 4; ++s) { xq[s][0] = *(const f32x4*)(xp + 32 * s); xq[s][1] = *(const f32x4*)(xp + 32 * s + 4); }
#pragma unroll
            for (int s = 0; s < 4; ++s) { const int col = kw + 32 * s + 8 * q; float h[8];
#pragma unroll
                for (int hf = 0; hf < 2; ++hf) { const f32x4 sc = *(const LAS f32x4*)(par + col + 4 * hf), sh = *(const LAS f32x4*)(par + 1024 + col + 4 * hf);
                    const f32x4 t = xq[s][hf] * rstd * sc + sh; h[4 * hf] = t.x; h[4 * hf + 1] = t.y; h[4 * hf + 2] = t.z; h[4 * hf + 3] = t.w; }
                v4u hi; hi.x = cvtpk(h[0], h[1]); hi.y = cvtpk(h[2], h[3]); hi.z = cvtpk(h[4], h[5]); hi.w = cvtpk(h[6], h[7]);
                *(v4u*)(hp + 32 * s) = hi;
                v4u lo; lo.x = cvtpk(h[0] - bflo(hi.x), h[1] - bfhi(hi.x)); lo.y = cvtpk(h[2] - bflo(hi.y), h[3] - bfhi(hi.y)); lo.z = cvtpk(h[4] - bflo(hi.z), h[5] - bfhi(hi.z)); lo.w = cvtpk(h[6] - bflo(hi.w), h[7] - bfhi(hi.w));
                const bf16x8 ah = *reinterpret_cast<bf16x8*>(&hi), al = *reinterpret_cast<bf16x8*>(&lo);
                acc0 = __builtin_amdgcn_mfma_f32_16x16x32_bf16(ah, Bh[s][0], acc0, 0, 0, 0); acc0 = __builtin_amdgcn_mfma_f32_16x16x32_bf16(ah, Bl[s][0], acc0, 0, 0, 0); acc0 = __builtin_amdgcn_mfma_f32_16x16x32_bf16(al, Bh[s][0], acc0, 0, 0, 0);
                acc1 = __builtin_amdgcn_mfma_f32_16x16x32_bf16(ah, Bh[s][1], acc1, 0, 0, 0); acc1 = __builtin_amdgcn_mfma_f32_16x16x32_bf16(ah, Bl[s][1], acc1, 0, 0, 0); acc1 = __builtin_amdgcn_mfma_f32_16x16x32_bf16(al, Bh[s][1], acc1, 0, 0, 0); }
#pragma unroll
            for (int r = 0; r < 4; ++r) { lg[(F.wave * 64 + rt * 16 + 4 * q + r) * 33 + row] = acc0[r]; lg[(F.wave * 64 + rt * 16 + 4 * q + r) * 33 + 16 + row] = acc1[r]; } }
        __syncthreads();
        { const int rowl = F.tid >> 3, eq = F.tid & 7; float v[4];
#pragma unroll
          for (int j = 0; j < 4; ++j) { float a = brt[4 * eq + j];
#pragma unroll
              for (int w = 0; w < 8; ++w) a += lg[(w * 64 + rowl) * 33 + 4 * eq + j];
              v[j] = a; }
          float tv[4]; int te[4];
#pragma unroll
          for (int k = 0; k < 4; ++k) { float gm = fmaxf(fmaxf(v[0], v[1]), fmaxf(v[2], v[3]));
              gm = fmaxf(gm, __shfl_xor(gm, 1)); gm = fmaxf(gm, __shfl_xor(gm, 2)); gm = fmaxf(gm, __shfl_xor(gm, 4));
              int ci = v[0] == gm ? 4 * eq : v[1] == gm ? 4 * eq + 1 : v[2] == gm ? 4 * eq + 2 : v[3] == gm ? 4 * eq + 3 : 99;
              ci = min(ci, __shfl_xor(ci, 1)); ci = min(ci, __shfl_xor(ci, 2)); ci = min(ci, __shfl_xor(ci, 4));
              te[k] = ci; tv[k] = gm;
#pragma unroll
              for (int j = 0; j < 4; ++j) if (ci == 4 * eq + j) v[j] = -__builtin_inff(); }
          if (eq == 0) { const float w1 = __expf(tv[1] - tv[0]), w2 = __expf(tv[2] - tv[0]), w3 = __expf(tv[3] - tv[0]); const float inv = 1.0f / (1.0f + w1 + w2 + w3);
              const float gk[4] = {inv, w1 * inv, w2 * inv, w3 * inv};
#pragma unroll
              for (int k = 0; k < 4; ++k) { const int lr = atomicAdd((int*)&hist[te[k]], 1); sel[rowl * 4 + k] = te[k]; sel[256 + rowl * 4 + k] = lr; sel[512 + rowl * 4 + k] = __float_as_int(gk[k]); } } }
        __syncthreads();
        if (F.tid < 32) { const int hc = hist[F.tid]; hist[32 + F.tid] = hc ? (int)__hip_atomic_fetch_add(CNT + F.tid, (unsigned)hc, RLX_AGENT) : 0; }
        __syncthreads();
        if (F.tid < 256) { const int e = sel[F.tid], pos = hist[32 + e] + sel[256 + F.tid], mm = m0 + (F.tid >> 2);
            WSP(int, WS_ROWTOK)[(size_t)e * ECAP + pos] = mm; WSP(int, WS_ROWGATE)[(size_t)e * ECAP + pos] = sel[512 + F.tid];
            WSP(int, WS_TOKE)[mm * 4 + (F.tid & 3)] = e; WSP(int, WS_TOKPOS)[mm * 4 + (F.tid & 3)] = pos; }
        __syncthreads();
    }
}

constexpr int MOE_TBL_OFF = XTRA_OFF, MOE_LIST_OFF = XTRA_OFF + 2048;
__device__ __forceinline__ int moe_tables(Frame& F) {
    LAS int* tbl = (LAS int*)(F.lds + MOE_TBL_OFF);
    const unsigned* CNT = (const unsigned*)(F.ws + WS_CTL) + CW_CNT;
    if (F.tid < 32) tbl[F.tid] = (int)__hip_atomic_load(CNT + F.tid, RLX_AGENT);
    __syncthreads();
    if (F.tid == 0) { int run = 0; for (int e = 0; e < 32; ++e) { tbl[32 + e] = run; const int nb = (tbl[e] + 255) >> 8; for (int bb = 0; bb < nb; ++bb) tbl[80 + run + bb] = e; run += nb; } tbl[64] = run; }
    __syncthreads();
    int nblk = tbl[64]; if (nblk > MAXBLK) nblk = MAXBLK; if (nblk < 1) nblk = 1;
    return __builtin_amdgcn_readfirstlane(nblk);
}

__device__ __forceinline__ void p11_combine(Frame& F, const Args& args) {
    (void)moe_tables(F);
    const LAS int* tbl = (const LAS int*)(F.lds + MOE_TBL_OFF);
    const float* mod = WSP(float, WS_MOD); const bf16* YR = WSP(bf16, WS_YR);
    const int gw = F.vcu * NWAVES + F.wave, NGW = F.G * NWAVES;
    for (int m = gw; m < NTOK; m += NGW) {
        const int b = m >> 12;
        int dk = 0; if (F.lane < 4) { const int e = __hip_atomic_load(WSP(int, WS_TOKE) + m * 4 + F.lane, RLX_AGENT); dk = tbl[32 + e] * 256 + __hip_atomic_load(WSP(int, WS_TOKPOS) + m * 4 + F.lane, RLX_AGENT); }
        const int d0 = __shfl(dk, 0), d1 = __shfl(dk, 1), d2 = __shfl(dk, 2), d3 = __shfl(dk, 3);
        f32x4* xr = (f32x4*)(F.out + (size_t)m * DM) + F.lane;
#pragma unroll
        for (int j = 0; j < 4; ++j) { const int col = 4 * F.lane + 256 * j;
            const v2u y0 = *(const v2u*)(YR + (size_t)d0 * DM + col), y1 = *(const v2u*)(YR + (size_t)d1 * DM + col), y2 = *(const v2u*)(YR + (size_t)d2 * DM + col), y3 = *(const v2u*)(YR + (size_t)d3 * DM + col);
            f32x4 s;
            s.x = (bflo(y0.x) + bflo(y1.x)) + (bflo(y2.x) + bflo(y3.x)); s.y = (bfhi(y0.x) + bfhi(y1.x)) + (bfhi(y2.x) + bfhi(y3.x));
            s.z = (bflo(y0.y) + bflo(y1.y)) + (bflo(y2.y) + bflo(y3.y)); s.w = (bfhi(y0.y) + bfhi(y1.y)) + (bfhi(y2.y) + bfhi(y3.y));
            const f32x4 g2 = *(const f32x4*)(mod + b * 6144 + 5120 + col);
            xr[64 * j] = xr[64 * j] + g2 * s; }
    }
}

#ifndef MK_N_LAUNCHES
#define MK_N_LAUNCHES 1
#endif
constexpr int PER_PHASE = 12;
constexpr int N_LAUNCHES = MK_N_LAUNCHES;

__global__ void __launch_bounds__(NWAVES * 64, 2) hybrid_fwd(Args args) {
    extern __shared__ __attribute__((aligned(16))) unsigned char lds[];
    Frame F;
    F.lds = (LAS unsigned char*)lds; F.ldsg = (char*)lds;
    F.MISC = (volatile LAS unsigned*)(F.lds + MISC_OFF);
    F.tid = threadIdx.x; F.lane = F.tid & 63; F.wave = __builtin_amdgcn_readfirstlane(F.tid >> 6);
    F.G = gridDim.x; { const int bx = blockIdx.x; F.vcu = (F.G % 8 == 0) ? (bx % 8) * (F.G / 8) + bx / 8 : bx; }
    F.ws = args.ws; F.out = args.out;
    gu32* ctl = (gu32*)(args.ws + WS_CTL);
    for (int u = F.tid; u < (LDS_BYTES - LDSCTL_OFF) / 4; u += NWAVES * 64) ((LAS unsigned*)(F.lds + LDSCTL_OFF))[u] = 0u;
    __syncthreads();
    XcdBarrier bar; bar.bar = (unsigned*)(ctl + CW_BAR); bar.x = 0; bar.st = nullptr;
    if (N_LAUNCHES == 1) bar = xcd_barrier_post((unsigned*)(ctl + CW_BAR), F.MISC + 8);
    const int lo = args.ph_lo, hi = args.ph_hi;
#ifndef PHASE_MASK
#define PHASE_MASK 0xFFF
#endif
#define IN(k) (((PHASE_MASK >> (k)) & 1) && lo <= (k) && (k) < hi)
#define NEXTP(k) ((k) == 0 ? 2 : (k) + 1)
#define SEAM(k) do { if (IN(k) && IN(NEXTP(k))) xcd_barrier(bar); } while (0)

#ifndef DUP_MASK
#define DUP_MASK 0
#endif
#define PHASE(k, ...) do { if (IN(k)) { __VA_ARGS__ if ((DUP_MASK >> (k)) & 1) { xcd_barrier(bar); __VA_ARGS__ } } SEAM(k); } while (0)
    PHASE(0, { p0_prologue(F, args); p1_hrows(F, args); });
    PHASE(2, {
        pg8::Gemm g{WSP(bf16, WS_HB), WSP(bf16, WS_WIN), NTOK, DIN, DM}; pg8::TileOrder S; S.init(NTOK / 256, DIN / 256, F.G, (int)blockIdx.x, nullptr);
        pg8::EpiWin E{WSP(bf16, WS_E), IN_F(17)};
        pg8::gemm_phase<pg8::EpiWin, pg8::TileOrder, true, true>(F.lds + RING_OFF, g, S, E);
    });
    int p3rep = 0;
    PHASE(3, {
        for (int u = F.vcu; u < 512; u += F.G) p3_rnn_local_unit(F, args, u);
        if (p3rep++ == 0) { for (int u = F.vcu; u < 512; u += F.G) p3_knorm_unit(F, args, u); }
    });
    PHASE(4, {
        for (int it = F.vcu; it < 256; it += F.G) { const int bh = it >> 3, s = it & 7;
            for (int pass = 0; pass < 2; ++pass) att::attn_unit(F, args, bh >> 3, bh & 7, pass ? s : 15 - s); }
        for (int u = F.vcu; u < 512; u += F.G) p4_rnn_final_unit(F, args, u);
    });
    PHASE(5, {
        pg8::Gemm g{WSP(bf16, WS_YCAT), WSP(bf16, WS_WB), NTOK, DM, 2 * DM}; pg8::TileOrder S; S.init(NTOK / 256, DM / 256, F.G, (int)blockIdx.x, nullptr);
        pg8::EpiBranch E{WSP(bf16, WS_E) + 5 * E_STRIDE, WSP(bf16, WS_E) + 6 * E_STRIDE, WSP(bf16, WS_HB)};
        pg8::gemm_phase<pg8::EpiBranch, pg8::TileOrder, false, true>(F.lds + RING_OFF, g, S, E);
    });
    PHASE(6, {
        pg8::Gemm g{WSP(bf16, WS_HB), WSP(bf16, WS_WO), NTOK, DM, DM}; pg8::TileOrder S; S.init(NTOK / 256, DM / 256, F.G, (int)blockIdx.x, nullptr);
        pg8::EpiWout E{IN_F(0), F.out, WSP(float, WS_MOD)};
        pg8::gemm_phase<pg8::EpiWout, pg8::TileOrder, false, true>(F.lds + RING_OFF, g, S, E);
    });
    PHASE(7, { p7_router(F, args); });
    PHASE(8, { p8_moe_weights(F, args); });
    PHASE(9, {
        const int nblk = moe_tables(F);
        const LAS int* tbl = (const LAS int*)(F.lds + MOE_TBL_OFF); LAS int* lists = (LAS int*)(F.lds + MOE_LIST_OFF);
        pg8::Gemm g{WSP(bf16, WS_HB), WSP(bf16, WS_WUP), RMAX, 2048 * NEXP, DM}; pg8::TileOrder S; S.init(nblk, 8, F.G, (int)blockIdx.x, tbl + 80);
        { pg8::Unit u; for (int i = 0; i < 9 && S.next(i, u); ++i) { if (F.tid < 256) { const int e = u.pn >> 3, pos = (u.pm - tbl[32 + e]) * 256 + F.tid;
              lists[i * 256 + F.tid] = pos < tbl[e] ? __hip_atomic_load(WSP(int, WS_ROWTOK) + (size_t)e * ECAP + pos, RLX_AGENT) : 0; } } }
        __syncthreads();
        pg8::EpiUp E{WSP(bf16, WS_ACT), IN_F(23)};
        pg8::gemm_phase<pg8::EpiUp, pg8::TileOrder, true, true, true>(F.lds + RING_OFF, g, S, E, lists);
    });
    PHASE(10, {
        const int nblk = moe_tables(F);
        const LAS int* tbl = (const LAS int*)(F.lds + MOE_TBL_OFF);
        pg8::Gemm g{WSP(bf16, WS_ACT), WSP(bf16, WS_WDN), RMAX, 1024 * NEXP, DM}; pg8::TileOrder S; S.init(nblk, 4, F.G, (int)blockIdx.x, tbl + 80);
        pg8::EpiDown E{WSP(bf16, WS_YR), IN_F(25), WSP(float, WS_ROWGATE), tbl};
        pg8::gemm_phase<pg8::EpiDown, pg8::TileOrder, true, true>(F.lds + RING_OFF, g, S, E);
    });
    PHASE(11, { p11_combine(F, args); });
#undef PHASE
#undef IN
#undef SEAM
}

extern "C" void kernel_launch(void* const* d_in, const int* in_sizes, int n_in, void* d_out, int out_size, void* d_ws, size_t ws_size, hipStream_t stream) {
    static int grid = 0;
    if (grid == 0) {
        if (n_in != 26 || in_sizes[0] != NTOK * DM || out_size != NTOK * DM || ws_size < WS_END) {
            fprintf(stderr, "kernel_launch: shape/workspace mismatch (n_in %d, in0 %d, out %d, ws %zu; need ws >= %zu); nothing launched\n", n_in, n_in > 0 ? in_sizes[0] : -1, out_size, ws_size, (size_t)WS_END); grid = -1; return; }
        int dev = 0, cus = 0, per_cu = 0;
        if (hipGetDevice(&dev) != hipSuccess || hipDeviceGetAttribute(&cus, hipDeviceAttributeMultiprocessorCount, dev) != hipSuccess) { fprintf(stderr, "kernel_launch: device query failed\n"); grid = -1; return; }
        if (hipFuncSetAttribute((const void*)hybrid_fwd, hipFuncAttributeMaxDynamicSharedMemorySize, LDS_BYTES) != hipSuccess) { fprintf(stderr, "kernel_launch: hipFuncSetAttribute failed\n"); grid = -1; return; }
        if (hipOccupancyMaxActiveBlocksPerMultiprocessor(&per_cu, (const void*)hybrid_fwd, NWAVES * 64, LDS_BYTES) != hipSuccess || per_cu < 1) { fprintf(stderr, "kernel_launch: occupancy query says %d blocks/CU\n", per_cu); per_cu = 1; }
        (void)hipGetLastError();
        grid = cus;
        if (grid > 256) grid = 256;
    }
    if (grid < 0) return;
    (void)hipMemsetAsync((char*)d_ws + WS_CTL, 0, CTL_ZERO_BYTES, stream);
    Args a{};
    for (int i = 0; i < 26; ++i) a.in[i] = d_in[i];
    a.out = (float*)d_out; a.ws = (unsigned char*)d_ws;
    for (int li = 0; li < N_LAUNCHES; ++li) {
        a.ph_lo = (N_LAUNCHES == 1) ? 0 : li; a.ph_hi = (N_LAUNCHES == 1) ? PER_PHASE : li + 1;
        hipLaunchKernelGGL(hybrid_fwd, dim3(grid), dim3(NWAVES * 64), LDS_BYTES, stream, a);
        const hipError_t le = hipPeekAtLastError();
        if (le != hipSuccess) { fprintf(stderr, "kernel_launch: launch %d failed: %s\n", li, hipGetErrorName(le)); break; }
    }
}
```

```cpp
#include <hip/hip_runtime.h>
#include <hip/hip_bf16.h>
#include <cstdio>
#include <cstdint>
#include <cmath>
namespace pg8 {
#define PG8_LAS __attribute__((address_space(3)))
typedef unsigned short bf16_t;
typedef short bf16x8 __attribute__((ext_vector_type(8)));
typedef float f32x4 __attribute__((ext_vector_type(4)));
typedef unsigned u32x4 __attribute__((ext_vector_type(4)));
constexpr int BM = 256, BK = 64, HALF = 128, HTB = HALF * BK * 2  , STAGE_BYTES = 8 * HTB, NXCD = 8, WGM = 8;

__host__ __device__ __forceinline__ int lds_byte(int r, int c) { const int st = (r >> 4) * 2 + (c >> 5), rr = r & 15, cc = c & 31, ob = rr * 64 + cc * 2; return st * 1024 + (ob ^ (((ob >> 9) & 1) << 5)); }
__host__ __device__ __forceinline__ void stage_rc(int b, int& R, int& C) { const int st = b / 1024, sb = b % 1024, swz = sb ^ (((sb >> 9) & 1) << 5); R = (st >> 1) * 16 + swz / 64; C = (st & 1) * 32 + (swz % 64) / 2; }
__host__ __device__ __forceinline__ int perm32(int rho) { const int n = rho >> 4, i = rho & 15; return 8 * (i >> 2) + 4 * n + (i & 3); }

struct Unit { int pm, pn; };
struct Gemm { const bf16_t* A; const bf16_t* Bt; int M, N, K; };

struct StaticOrder {
    int nM, nN, nwg, G, c;
    __host__ __device__ void init(int M, int N, int G_, int c_) { nM = M / BM; nN = N / BM; nwg = nM * nN; G = G_; c = c_; }
    __host__ __device__ bool next(int i, Unit& u) const {
        const long L = (long)i * G + c; if (L >= nwg) return false;
        int wgid = (int)L; { const int q = nwg / NXCD, r = nwg % NXCD, xcd = wgid % NXCD, off = wgid / NXCD; wgid = (xcd < r ? xcd * (q + 1) : r * (q + 1) + (xcd - r) * q) + off; }
        const int nig = WGM * nN, gid = wgid / nig, fm = gid * WGM, gsz = (nM - fm) < WGM ? (nM - fm) : WGM;
        u.pm = fm + ((wgid % nig) % gsz); u.pn = (wgid % nig) / gsz; return true;
    }
    __device__ __forceinline__ void a_ready(const Unit&) const {}
    __device__ __forceinline__ void done(const Unit&) const {}
};

__device__ __forceinline__ unsigned cvt_pk_bf16(float lo, float hi) { unsigned r; asm volatile("v_cvt_pk_bf16_f32 %0, %1, %2" : "=v"(r) : "v"(lo), "v"(hi)); return r; }
typedef int v4i_t __attribute__((ext_vector_type(4)));
typedef int v8i_t __attribute__((ext_vector_type(8)));
template <class Epi, class Sched, bool ALIGN_EPI = false, bool SP2 = false, bool GATHER = false, bool FP8 = false>
__device__ __forceinline__ void gemm_phase(PG8_LAS unsigned char* lds, const Gemm g, const Sched& S, const Epi& E, const PG8_LAS int* rowlists = nullptr) {
    static_assert(!GATHER || SP2, "GATHER is implemented for the SP2 loop");
    const int tid = threadIdx.x, wid = __builtin_amdgcn_readfirstlane(tid >> 6), lane = tid & 63, wr = wid >> 2, wc = wid & 3, fr = lane & 15, fq = lane >> 4;
    const int K = g.K, nt = K / BK;
    unsigned voffA, voffB; int gR, gC;
    { int R, C; stage_rc(tid * 16, R, C); const int Rb = Epi::PERM ? ((R & ~31) + perm32(R & 31)) : R; gR = R; gC = C;
      voffA = (unsigned)(R * K + C) * 2u; voffB = (unsigned)(Rb * K + C) * 2u; }
    const size_t row64 = (size_t)64 * K * 2;
    const size_t kstep = (size_t)(BK * 2);
    const size_t hstep = (size_t)HALF * K * 2;
    const size_t tstep = 2 * hstep;
    const unsigned ldsw = (unsigned)wid * 1024u;
    const int aoff = lds_byte(wr * 64 + fr, fq * 8), boff = lds_byte(wc * 32 + fr, fq * 8);
#define PG8_SA(b, h) (((b) * 2 + (h)) * HTB)
#define PG8_SB(b, h) ((4 + (b) * 2 + (h)) * HTB)
#define PG8_STAGE2(bufoff, gbase, v0_, v1_) do { unsigned vo0_ = (v0_), vo1_ = (v1_); asm volatile("" : "+v"(vo0_), "+v"(vo1_));     \
        __builtin_amdgcn_global_load_lds((const unsigned*)((const char*)(gbase) + vo0_), (PG8_LAS unsigned*)(lds + (bufoff) + ldsw), 16, 0, 0); \
        __builtin_amdgcn_global_load_lds((const unsigned*)((const char*)(gbase) + vo1_), (PG8_LAS unsigned*)(lds + (bufoff) + ldsw + 8192), 16, 0, 0); } while (0)
#define PG8_STAGE(bufoff, gbase, voff) do { unsigned vo_ = (voff); asm volatile("" : "+v"(vo_)); \
        __builtin_amdgcn_global_load_lds((const unsigned*)((const char*)(gbase) + vo_), (PG8_LAS unsigned*)(lds + (bufoff) + ldsw), 16, 0, 0); \
        __builtin_amdgcn_global_load_lds((const unsigned*)((const char*)(gbase) + row64 + vo_), (PG8_LAS unsigned*)(lds + (bufoff) + ldsw + 8192), 16, 0, 0); } while (0)
#define PG8_LDA(dst, b, h) do { _Pragma("unroll") for (int m = 0; m < 4; ++m) _Pragma("unroll") for (int k = 0; k < 2; ++k) dst[m][k] = *(const PG8_LAS bf16x8*)(lds + PG8_SA(b, h) + aoff + m * 2048 + k * 1024); } while (0)
#define PG8_LDB(dst, b, h) do { _Pragma("unroll") for (int n = 0; n < 2; ++n) _Pragma("unroll") for (int k = 0; k < 2; ++k) dst[n][k] = *(const PG8_LAS bf16x8*)(lds + PG8_SB(b, h) + boff + n * 2048 + k * 1024); } while (0)
#define PG8_CAT8(x, y) __builtin_shufflevector(__builtin_bit_cast(v4i_t, (x)), __builtin_bit_cast(v4i_t, (y)), 0, 1, 2, 3, 4, 5, 6, 7)
#define PG8_MMA(ai, bj, At, Bt) do { __builtin_amdgcn_s_setprio(1); _Pragma("unroll") for (int m = 0; m < 4; ++m) _Pragma("unroll") for (int n = 0; n < 2; ++n) { \
        if constexpr (FP8) { const v8i_t a8_ = PG8_CAT8(Bt[n][0], Bt[n][1]), b8_ = PG8_CAT8(At[m][0], At[m][1]);     \
            asm volatile("v_mfma_scale_f32_16x16x128_f8f6f4 %0, %1, %2, %0, %3, %4 op_sel_hi:[0,0,0]" : "+v"(acc[ai][bj][m][n]) : "v"(a8_), "v"(b8_), "v"(mxsa_), "v"(mxsb_)); } \
        else { _Pragma("unroll") for (int k = 0; k < 2; ++k) acc[ai][bj][m][n] = __builtin_amdgcn_mfma_f32_16x16x32_bf16(Bt[n][k], At[m][k], acc[ai][bj][m][n], 0, 0, 0); } } \
        __builtin_amdgcn_s_setprio(0); } while (0)
#define PG8_WAIT_V(n) asm volatile("s_waitcnt vmcnt(" #n ")" ::: "memory")
#define PG8_WAIT_L(n) asm volatile("s_waitcnt lgkmcnt(" #n ")" ::: "memory")
#define PG8_BAR __builtin_amdgcn_s_barrier()
#define PG8_SCHED __builtin_amdgcn_sched_barrier(0)
    Unit cur, nxt; int ui = 0;
    if (!S.next(0, cur)) return;
    int mxsa_ = 121, mxsb_ = 127; asm volatile("" : "+v"(mxsa_), "+v"(mxsb_));
    f32x4 acc[2][2][4][2];
#pragma unroll
    for (int a = 0; a < 2; ++a)
#pragma unroll
        for (int b = 0; b < 2; ++b)
#pragma unroll
            for (int m = 0; m < 4; ++m)
#pragma unroll
                for (int n = 0; n < 2; ++n) acc[a][b][m][n] = (f32x4){0.f, 0.f, 0.f, 0.f};
    bf16x8 At[4][2], B0[2][2], B1[2][2];
    const char* cA = GATHER ? (const char*)g.A : (const char*)g.A + (size_t)cur.pm * tstep; const char* cB = (const char*)g.Bt + (size_t)cur.pn * tstep;
#define PG8_STAGE_A(bufoff, kptr, half, unx) do { if constexpr (GATHER) { const PG8_LAS int* rl_ = rowlists + (ui + (unx)) * 256 + (half) * HALF + gR; \
        PG8_STAGE2(bufoff, kptr, (unsigned)(rl_[0] * K + gC) * 2u, (unsigned)(rl_[64] * K + gC) * 2u); } \
        else { PG8_STAGE(bufoff, (kptr) + (half) * hstep, voffA); } } while (0)
    S.a_ready(cur);
    if constexpr (SP2) {
        PG8_STAGE(PG8_SB(0, 0), cB, voffB); PG8_STAGE(PG8_SB(0, 1), cB + hstep, voffB); PG8_STAGE_A(PG8_SA(0, 0), cA, 0, 0); PG8_STAGE_A(PG8_SA(0, 1), cA, 1, 0);
        if (wr == 1) PG8_BAR;
        PG8_WAIT_V(2); PG8_BAR;
        PG8_STAGE(PG8_SB(1, 0), cB + kstep, voffB); PG8_STAGE_A(PG8_SA(1, 0), cA + kstep, 0, 0); PG8_STAGE(PG8_SB(1, 1), cB + hstep + kstep, voffB);
        PG8_WAIT_V(6); PG8_BAR;
    } else {
        PG8_STAGE(PG8_SB(0, 0), cB, voffB); PG8_STAGE(PG8_SA(0, 0), cA, voffA); PG8_STAGE(PG8_SB(0, 1), cB + hstep, voffB); PG8_STAGE(PG8_SA(0, 1), cA + hstep, voffA);
        if (wr == 1) PG8_BAR;
        PG8_WAIT_V(4); PG8_BAR;
        PG8_STAGE(PG8_SB(1, 0), cB + kstep, voffB); PG8_STAGE(PG8_SA(1, 0), cA + kstep, voffA); PG8_STAGE(PG8_SB(1, 1), cB + hstep + kstep, voffB);
        PG8_WAIT_V(6); PG8_BAR;
    }
    for (;;) {
        const bool has_next = S.next(ui + 1, nxt);
        const char* nA = GATHER ? cA : (has_next ? (const char*)g.A + (size_t)nxt.pm * tstep : cA);
        const char* nB = has_next ? (const char*)g.Bt + (size_t)nxt.pn * tstep : cB;
#pragma unroll 1
        for (int t = 0; t < nt; t += 2) {
            const bool last = (t == nt - 2);
            if constexpr (Epi::MIDK) { if (t == (nt >> 1)) { if constexpr (FP8) asm volatile("s_nop 15\n\ts_nop 7" ::: "memory"); E.mid(acc, cur, wr, wc, fr, fq); } }
            const char* a1 = cA + (size_t)(t + 1) * kstep;
            const char* a2 = last ? nA : cA + (size_t)(t + 2) * kstep; const char* b2 = last ? nB : cB + (size_t)(t + 2) * kstep;
            const char* a3 = a2 + kstep; const char* b3 = b2 + kstep;
            if (last && has_next) S.a_ready(nxt);
            const int unx = (GATHER && last && has_next) ? 1 : 0;
            if constexpr (SP2) {
            PG8_LDB(B0, 0, 0); PG8_LDB(B1, 0, 1); PG8_SCHED; PG8_LDA(At, 0, 0); PG8_STAGE_A(PG8_SA(1, 1), a1, 1, 0);
            PG8_WAIT_V(8); PG8_WAIT_L(0); PG8_BAR; PG8_MMA(0, 0, At, B0); PG8_MMA(0, 1, At, B1); PG8_BAR; PG8_SCHED;
            PG8_LDA(At, 0, 1); PG8_STAGE(PG8_SB(0, 0), b2, voffB); PG8_STAGE(PG8_SB(0, 1), b2 + hstep, voffB); PG8_STAGE_A(PG8_SA(0, 0), a2, 0, unx);
            PG8_WAIT_V(8); PG8_WAIT_L(0); PG8_BAR; PG8_MMA(1, 0, At, B0); PG8_MMA(1, 1, At, B1); PG8_BAR; PG8_SCHED;
            PG8_LDB(B0, 1, 0); PG8_LDB(B1, 1, 1); PG8_SCHED; PG8_LDA(At, 1, 0); PG8_STAGE_A(PG8_SA(0, 1), a2, 1, unx);
            PG8_WAIT_V(8); PG8_WAIT_L(0); PG8_BAR; PG8_MMA(0, 0, At, B0); PG8_MMA(0, 1, At, B1); PG8_BAR; PG8_SCHED;
            PG8_LDA(At, 1, 1); PG8_STAGE(PG8_SB(1, 0), b3, voffB); PG8_STAGE(PG8_SB(1, 1), b3 + hstep, voffB); PG8_STAGE_A(PG8_SA(1, 0), a3, 0, unx);
            PG8_WAIT_V(8); PG8_WAIT_L(0); PG8_BAR; PG8_MMA(1, 0, At, B0); PG8_MMA(1, 1, At, B1); PG8_BAR; PG8_SCHED;
            } else {
            PG8_LDB(B0, 0, 0); PG8_SCHED; PG8_LDA(At, 0, 0); PG8_STAGE(PG8_SA(1, 1), a1 + hstep, voffA);
            PG8_WAIT_L(8); PG8_BAR; PG8_WAIT_L(0); PG8_MMA(0, 0, At, B0); PG8_BAR; PG8_SCHED;
            PG8_LDB(B1, 0, 1); PG8_STAGE(PG8_SB(0, 0), b2, voffB);
            PG8_BAR; PG8_WAIT_L(0); PG8_MMA(0, 1, At, B1); PG8_BAR;
            PG8_LDA(At, 0, 1); PG8_STAGE(PG8_SA(0, 0), a2, voffA);
            PG8_BAR; PG8_WAIT_L(0); PG8_MMA(1, 0, At, B0); PG8_BAR; PG8_SCHED;
            PG8_STAGE(PG8_SB(0, 1), b2 + hstep, voffB);
            PG8_WAIT_V(6); PG8_BAR; PG8_MMA(1, 1, At, B1); PG8_BAR;
            PG8_LDB(B0, 1, 0); PG8_SCHED; PG8_LDA(At, 1, 0); PG8_STAGE(PG8_SA(0, 1), a2 + hstep, voffA);
            PG8_WAIT_L(8); PG8_BAR; PG8_WAIT_L(0); PG8_MMA(0, 0, At, B0); PG8_BAR; PG8_SCHED;
            PG8_LDB(B1, 1, 1); PG8_STAGE(PG8_SB(1, 0), b3, voffB);
            PG8_BAR; PG8_WAIT_L(0); PG8_MMA(0, 1, At, B1); PG8_BAR;
            PG8_LDA(At, 1, 1); PG8_STAGE(PG8_SA(1, 0), a3, voffA);
            PG8_BAR; PG8_WAIT_L(0); PG8_MMA(1, 0, At, B0); PG8_BAR; PG8_SCHED;
            PG8_STAGE(PG8_SB(1, 1), b3 + hstep, voffB);
            PG8_WAIT_V(6); PG8_BAR; PG8_MMA(1, 1, At, B1); PG8_BAR;
            }
        }
        if constexpr (ALIGN_EPI) { if (wr == 0) PG8_BAR; }
        if constexpr (FP8) asm volatile("s_nop 15\n\ts_nop 7" ::: "memory");
        if constexpr (!Epi::AFTER_DRAIN) { E(acc, cur, wr, wc, fr, fq); S.done(cur); }
        if (!has_next) break;
#pragma unroll
        for (int a = 0; a < 2; ++a)
#pragma unroll
            for (int b = 0; b < 2; ++b)
#pragma unroll
                for (int m = 0; m < 4; ++m)
#pragma unroll
                    for (int n = 0; n < 2; ++n) acc[a][b][m][n] = (f32x4){0.f, 0.f, 0.f, 0.f};
        cur = nxt; cA = nA; cB = nB; ++ui;
        if constexpr (ALIGN_EPI) { if (wr == 1) PG8_BAR; }
    }
    PG8_WAIT_V(0);
    if constexpr (!ALIGN_EPI) { if (wr == 0) PG8_BAR; }
    PG8_BAR;
    if constexpr (Epi::AFTER_DRAIN) { E.fused(acc, cur, wr, wc, fr, fq, lds, wid, lane); S.done(cur); }
#undef PG8_SA
#undef PG8_STAGE_A
#undef PG8_SB
#undef PG8_STAGE
#undef PG8_STAGE2
#undef PG8_LDA
#undef PG8_LDB
#undef PG8_MMA
#undef PG8_CAT8
#undef PG8_WAIT_V
#undef PG8_WAIT_L
#undef PG8_BAR
#undef PG8_SCHED
}
}

constexpr int NB = 4, SEQ = 4096, DM = 1024, NTOK = NB * SEQ, DIN = 7168, NH = 8, HD = 128;
constexpr int NEXP = 32, TOPK = 4, MAXBLK = 288, RMAX = MAXBLK * 256;
constexpr float EPS = 1e-6f;
constexpr int NWAVES = 8;

constexpr size_t MiB = 1u << 20, KiB = 1u << 10;
constexpr size_t WS_CTL = 0, CTL_ZERO_BYTES = 1 * MiB;
constexpr size_t WS_MOD = 1 * MiB;
constexpr size_t WS_KMEAN = 1 * MiB + 128 * KiB;
constexpr size_t WS_AGGP = 1 * MiB + 384 * KiB;
constexpr size_t WS_AGGH = 1 * MiB + 640 * KiB;
constexpr size_t WS_WRH = 2 * MiB, WS_WRL = 2 * MiB + 64 * KiB;
constexpr size_t WS_TOKE = 3 * MiB, WS_TOKPOS = 3 * MiB + 256 * KiB;
constexpr int ECAP = 16384;
constexpr size_t WS_ROWTOK = 28 * MiB, WS_ROWGATE = 30 * MiB;
constexpr int CW_CNT = 8192;
constexpr size_t WS_TRIG = 4 * MiB;
constexpr size_t WS_WRG = 6 * MiB;
constexpr size_t WS_WIN = 8 * MiB;
constexpr size_t WS_WB = 22 * MiB;
constexpr size_t WS_WO = 26 * MiB;
constexpr size_t WS_WUP = 32 * MiB;
constexpr size_t WS_WDN = 96 * MiB;
constexpr size_t WS_HB = 224 * MiB;
constexpr size_t WS_E = 256 * MiB;
constexpr size_t E_STRIDE = (size_t)NTOK * DM;
constexpr size_t WS_HL = 480 * MiB, WS_PP = 512 * MiB, WS_YCAT = 544 * MiB;
constexpr int CW_MODCNT = 8256;
constexpr size_t WS_ACT = 400 * MiB, WS_YR = 544 * MiB;
constexpr size_t WS_END = 688 * MiB;
constexpr int CW_BAR = 4096;

constexpr int RING_OFF = 0, RING_BYTES = 131072;
constexpr int LDSCTL_OFF = RING_BYTES, MISC_OFF = LDSCTL_OFF + 320;
constexpr int XTRA_OFF = LDSCTL_OFF + 1024;
constexpr int LDS_BYTES = 147456;

#define GAS __attribute__((address_space(1)))
#define LAS __attribute__((address_space(3)))
typedef unsigned short bf16;
typedef unsigned v4u __attribute__((ext_vector_type(4)));
typedef unsigned v2u __attribute__((ext_vector_type(2)));
typedef float f32x4 __attribute__((ext_vector_type(4)));
typedef float f32x2 __attribute__((ext_vector_type(2)));
typedef float f32x16 __attribute__((ext_vector_type(16)));
typedef short bf16x8 __attribute__((ext_vector_type(8)));
typedef short s16x4 __attribute__((ext_vector_type(4)));
typedef GAS unsigned gu32;
#define RLX_AGENT __ATOMIC_RELAXED, __HIP_MEMORY_SCOPE_AGENT
#define LDS_WAIT() asm volatile("s_waitcnt lgkmcnt(0)" ::: "memory")
#define VM_WAIT() asm volatile("s_waitcnt vmcnt(0)" ::: "memory")
#define SBAR() __builtin_amdgcn_sched_barrier(0)
__device__ __forceinline__ unsigned f2bf(float f) { unsigned u = __builtin_bit_cast(unsigned, f); return (u + 0x7fffu + ((u >> 16) & 1u)) >> 16; }
__device__ __forceinline__ unsigned pk2(float lo, float hi) { return f2bf(lo) | (f2bf(hi) << 16); }
__device__ __forceinline__ float bf2f(unsigned short h) { return __builtin_bit_cast(float, (unsigned)h << 16); }
__device__ __forceinline__ float bflo(unsigned w) { return __builtin_bit_cast(float, w << 16); }
__device__ __forceinline__ float bfhi(unsigned w) { return __builtin_bit_cast(float, w & 0xffff0000u); }
__device__ __forceinline__ unsigned cvtpk(float lo, float hi) { unsigned r; asm volatile("v_cvt_pk_bf16_f32 %0, %1, %2" : "=v"(r) : "v"(lo), "v"(hi)); return r; }
__device__ __forceinline__ float fast_sigmoid(float x) { return __builtin_amdgcn_rcpf(1.0f + __builtin_amdgcn_exp2f(-1.4426950408889634f * x)); }
__device__ __forceinline__ float gelu_tanh(float x) { const float z = 1.5957691216057308f * (x + 0.044715f * x * x * x); return x * fast_sigmoid(z); }
__device__ __forceinline__ float wave_sum(float v) {
#pragma unroll
    for (int o = 1; o < 64; o <<= 1) v += __shfl_xor(v, o);
    return v;
}
__device__ __forceinline__ float wave_max(float v) {
#pragma unroll
    for (int o = 1; o < 64; o <<= 1) v = fmaxf(v, __shfl_xor(v, o));
    return v;
}

#define XB_TMO      128
#define XB_XCNT(j)  (256  + 64 * (j))
#define XB_XSUB(j)  (1280 + 64 * (j))
#define XB_XGEN(j)  (2304 + 64 * (j))
#define XB_TOP      3328
#define XB_TOPGEN   3392
#define XCD_BAR_WORDS 3456
#define XB_SPIN_CAP (1u << 20)
__device__ __forceinline__ unsigned xb_ld(unsigned* p)              { return __hip_atomic_load(p, __ATOMIC_RELAXED, __HIP_MEMORY_SCOPE_AGENT); }
__device__ __forceinline__ unsigned xb_add(unsigned* p, unsigned v) { return __hip_atomic_fetch_add(p, v, __ATOMIC_RELAXED, __HIP_MEMORY_SCOPE_AGENT); }
__device__ __forceinline__ unsigned xb_xcc_id() { return (unsigned)__builtin_amdgcn_s_getreg((3 << 11) | 20) & 0xFu; }
#define XB_SPIN(cond, bar) do { unsigned _sp = 0; while (cond) { __builtin_amdgcn_s_sleep(1); \
    if ((++_sp & 255u) == 0u) { if (xb_ld(&(bar)[XB_TMO])) break; if (_sp > XB_SPIN_CAP) { atomicAdd(&(bar)[XB_TMO], 1u); break; } } } } while (0)
struct XcdBarrier { unsigned* bar; unsigned x; volatile LAS unsigned* st; };
__device__ __forceinline__ XcdBarrier xcd_barrier_post(unsigned* bar, volatile LAS unsigned* st) {
    XcdBarrier b; b.bar = bar; b.x = xb_xcc_id(); b.st = st;
    if (threadIdx.x == 0) (void)xb_add(&bar[XB_XCNT(b.x)], 1u);
    return b;
}
__device__ __forceinline__ void xcd_barrier_complete(unsigned* bar, unsigned x, unsigned& nloc, unsigned& nx) {
    const unsigned G = gridDim.x * gridDim.y * gridDim.z;
    unsigned sum, cnt, mine, sp = 0u;
    for (;;) {
        sum = 0u; cnt = 0u; mine = 0u;
#pragma unroll
        for (unsigned j = 0; j < 16; ++j) { const unsigned c = xb_ld(&bar[XB_XCNT(j)]); sum += c; cnt += (c > 0u) ? 1u : 0u; mine = (j == x) ? c : mine; }
        if (sum == G) break;
        __builtin_amdgcn_s_sleep(1);
        if ((++sp & 255u) == 0u) { if (xb_ld(&bar[XB_TMO])) break; if (sp > XB_SPIN_CAP) { atomicAdd(&bar[XB_TMO], 1u); break; } }
    }
    nloc = mine > 0u ? mine : 1u; nx = cnt > 0u ? cnt : 1u;
}
__device__ __forceinline__ void xcd_barrier(const XcdBarrier& b) {
    asm volatile("s_waitcnt vmcnt(0)" ::: "memory");
    __syncthreads();
    if (threadIdx.x == 0) {
        unsigned* bar = b.bar;
        __builtin_amdgcn_s_waitcnt(0);
        unsigned nloc = b.st[0], nx = b.st[1];
        if (nloc == 0u) { xcd_barrier_complete(bar, b.x, nloc, nx); b.st[0] = nloc; b.st[1] = nx; }
        const unsigned old = xb_add(&bar[XB_XSUB(b.x)], 1u);
        const unsigned gen = old / nloc;
        if (old + 1u == (gen + 1u) * nloc) {
            __builtin_amdgcn_fence(__ATOMIC_RELEASE, "agent");
            asm volatile("s_waitcnt vmcnt(0)" ::: "memory");
            const unsigned og = xb_add(&bar[XB_TOP], 1u);
            const unsigned tg = og / nx;
            if (og + 1u == (tg + 1u) * nx) xb_add(&bar[XB_TOPGEN], 1u);
            else XB_SPIN(xb_ld(&bar[XB_TOPGEN]) == tg, bar);
            __builtin_amdgcn_fence(__ATOMIC_ACQUIRE, "agent");
            xb_add(&bar[XB_XGEN(b.x)], 1u);
            asm volatile("s_waitcnt vmcnt(0)" ::: "memory");
        } else {
            XB_SPIN(xb_ld(&bar[XB_XGEN(b.x)]) == gen, bar);
            __builtin_amdgcn_fence(__ATOMIC_ACQUIRE, "agent");
            asm volatile("s_waitcnt vmcnt(0)" ::: "memory");
        }
    }
    __syncthreads();
}

struct Args { const void* in[26]; float* out; unsigned char* ws; int ph_lo, ph_hi; };
struct Frame {
    LAS unsigned char* lds; char* ldsg;
    volatile LAS unsigned* MISC;
    int tid, lane, wave, vcu, G;
    unsigned char* ws; float* out;
};
#define IN_F(k) ((const float*)args.in[k])
#define IN_I(k) ((const int*)args.in[k])
#define WSP(T, off) ((T*)(F.ws + (off)))

namespace pg8 {
struct TileOrder {
    int nM, nN, nwg, G, c; const LAS int* blk_exp;
    __device__ void init(int nM_, int nN_, int G_, int c_, const LAS int* be) { nM = nM_; nN = nN_; nwg = nM * nN; G = G_; c = c_; blk_exp = be; }
    __device__ bool next(int i, Unit& u) const {
        const long L = (long)i * G + c; if (L >= nwg) return false;
        int wgid = (int)L; { const int q = nwg / NXCD, r = nwg % NXCD, xcd = wgid % NXCD, off = wgid / NXCD; wgid = (xcd < r ? xcd * (q + 1) : r * (q + 1) + (xcd - r) * q) + off; }
        const int nig = WGM * nN, gid = wgid / nig, fm = gid * WGM, gsz = (nM - fm) < WGM ? (nM - fm) : WGM;
        u.pm = fm + ((wgid % nig) % gsz); u.pn = (wgid % nig) / gsz;
        if (blk_exp) { const int e = __builtin_amdgcn_readfirstlane(blk_exp[u.pm]); u.pn += e * nN; }
        return true;
    }
    __device__ __forceinline__ void a_ready(const Unit&) const {}
    __device__ __forceinline__ void done(const Unit&) const {}
};

struct EpiWin {
    static constexpr bool PERM = true, AFTER_DRAIN = false, MIDK = false;
    bf16_t* E; const float* b_gate;
    __device__ __forceinline__ void operator()(const f32x4 (&acc)[2][2][4][2], const Unit& u, int wr, int wc, int fr, int fq) const {
        const int t = u.pn >> 2, colt = (u.pn & 3) * BM;
        bf16_t* base = E + (size_t)t * ((size_t)16384 * 1024);
        int row0 = u.pm * BM + wr * 64 + fr; const int col0 = colt + wc * 32 + 8 * fq;
        asm volatile("" : "+v"(row0));
        f32x4 bv[2][2];
#pragma unroll
        for (int bj = 0; bj < 2; ++bj)
#pragma unroll
            for (int n = 0; n < 2; ++n) bv[bj][n] = (t >= 5) ? *(const f32x4*)(b_gate + (t - 5) * 1024 + col0 + bj * HALF + 4 * n) : (f32x4){0.f, 0.f, 0.f, 0.f};
#pragma unroll
        for (int ai = 0; ai < 2; ++ai)
#pragma unroll
            for (int m = 0; m < 4; ++m) { bf16_t* rowp = base + (size_t)(row0 + ai * HALF + m * 16) * 1024 + col0;
#pragma unroll
                for (int bj = 0; bj < 2; ++bj) { f32x4 v0 = acc[ai][bj][m][0] + bv[bj][0], v1 = acc[ai][bj][m][1] + bv[bj][1];
                    if (t == 1) {
#pragma unroll
                        for (int j = 0; j < 4; ++j) { v0[j] = gelu_tanh(v0[j]); v1[j] = gelu_tanh(v1[j]); } }
                    else if (t >= 5) {
#pragma unroll
                        for (int j = 0; j < 4; ++j) { v0[j] = fast_sigmoid(v0[j]); v1[j] = fast_sigmoid(v1[j]); } }
                    u32x4 w; w.x = cvt_pk_bf16(v0[0], v0[1]); w.y = cvt_pk_bf16(v0[2], v0[3]); w.z = cvt_pk_bf16(v1[0], v1[1]); w.w = cvt_pk_bf16(v1[2], v1[3]);
                    *(u32x4*)(rowp + bj * HALF) = w; } }
    }
};
struct EpiBranch {
    static constexpr bool PERM = true, AFTER_DRAIN = false, MIDK = true;
    const bf16_t* SG0; const bf16_t* SG1; bf16_t* MIX;
    __device__ __forceinline__ void mid(f32x4 (&acc)[2][2][4][2], const Unit& u, int wr, int wc, int fr, int fq) const {
        int row0 = u.pm * BM + wr * 64 + fr; const int col0 = u.pn * BM + wc * 32 + 8 * fq;
        asm volatile("" : "+v"(row0));
#pragma unroll
        for (int ai = 0; ai < 2; ++ai)
#pragma unroll
            for (int m = 0; m < 4; ++m) { const size_t ro = (size_t)(row0 + ai * HALF + m * 16) * 1024 + col0;
#pragma unroll
                for (int bj = 0; bj < 2; ++bj) { const size_t o = ro + bj * HALF;
                    const u32x4 a = *(const u32x4*)(SG0 + o), b = *(const u32x4*)(SG1 + o);
                    const float r0 = bflo(a.x) * __builtin_amdgcn_rcpf(fmaxf(bflo(b.x), 1e-18f)), r1 = bfhi(a.x) * __builtin_amdgcn_rcpf(fmaxf(bfhi(b.x), 1e-18f));
                    const float r2 = bflo(a.y) * __builtin_amdgcn_rcpf(fmaxf(bflo(b.y), 1e-18f)), r3 = bfhi(a.y) * __builtin_amdgcn_rcpf(fmaxf(bfhi(b.y), 1e-18f));
                    const float r4 = bflo(a.z) * __builtin_amdgcn_rcpf(fmaxf(bflo(b.z), 1e-18f)), r5 = bfhi(a.z) * __builtin_amdgcn_rcpf(fmaxf(bfhi(b.z), 1e-18f));
                    const float r6 = bflo(a.w) * __builtin_amdgcn_rcpf(fmaxf(bflo(b.w), 1e-18f)), r7 = bfhi(a.w) * __builtin_amdgcn_rcpf(fmaxf(bfhi(b.w), 1e-18f));
                    acc[ai][bj][m][0] *= (f32x4){r0, r1, r2, r3}; acc[ai][bj][m][1] *= (f32x4){r4, r5, r6, r7}; }
                asm volatile("" ::: "memory"); }
    }
    __device__ __forceinline__ void operator()(const f32x4 (&acc)[2][2][4][2], const Unit& u, int wr, int wc, int fr, int fq) const {
        int row0 = u.pm * BM + wr * 64 + fr; const int col0 = u.pn * BM + wc * 32 + 8 * fq;
        asm volatile("" : "+v"(row0));
#pragma unroll
        for (int ai = 0; ai < 2; ++ai)
#pragma unroll
            for (int m = 0; m < 4; ++m) { const size_t ro = (size_t)(row0 + ai * HALF + m * 16) * 1024 + col0;
#pragma unroll
                for (int bj = 0; bj < 2; ++bj) { const size_t o = ro + bj * HALF;
                    const u32x4 b = *(const u32x4*)(SG1 + o);
                    const f32x4 g0 = {fmaxf(bflo(b.x), 1e-18f), fmaxf(bfhi(b.x), 1e-18f), fmaxf(bflo(b.y), 1e-18f), fmaxf(bfhi(b.y), 1e-18f)}, g1 = {fmaxf(bflo(b.z), 1e-18f), fmaxf(bfhi(b.z), 1e-18f), fmaxf(bflo(b.w), 1e-18f), fmaxf(bfhi(b.w), 1e-18f)};
                    const f32x4 v0 = acc[ai][bj][m][0] * g0, v1 = acc[ai][bj][m][1] * g1;
                    u32x4 w; w.x = cvt_pk_bf16(v0[0], v0[1]); w.y = cvt_pk_bf16(v0[2], v0[3]); w.z = cvt_pk_bf16(v1[0], v1[1]); w.w = cvt_pk_bf16(v1[2], v1[3]);
                    *(u32x4*)(MIX + o) = w; } }
    }
};
struct EpiWout {
    static constexpr bool PERM = false, AFTER_DRAIN = false, MIDK = false;
    const float* x; float* out; const float* mod;
    __device__ __forceinline__ void operator()(const f32x4 (&acc)[2][2][4][2], const Unit& u, int wr, int wc, int fr, int fq) const {
        int row0 = u.pm * BM + wr * 64 + fr; const int col0 = u.pn * BM + wc * 32 + 4 * fq;
        asm volatile("" : "+v"(row0));
        const float* g1p = mod + (size_t)(u.pm >> 4) * 6144 + 2048;
        f32x4 gv[2][2];
#pragma unroll
        for (int bj = 0; bj < 2; ++bj)
#pragma unroll
            for (int n = 0; n < 2; ++n) gv[bj][n] = *(const f32x4*)(g1p + col0 + bj * HALF + n * 16);
#pragma unroll
        for (int ai = 0; ai < 2; ++ai)
#pragma unroll
            for (int m = 0; m < 4; ++m) { const size_t ro = (size_t)(row0 + ai * HALF + m * 16) * 1024 + col0;
#pragma unroll
                for (int bj = 0; bj < 2; ++bj)
#pragma unroll
                    for (int n = 0; n < 2; ++n) { const size_t o = ro + bj * HALF + n * 16; *(f32x4*)(out + o) = *(const f32x4*)(x + o) + gv[bj][n] * acc[ai][bj][m][n]; } }
    }
};
__device__ __forceinline__ unsigned pk_fp8x4(float a, float b, float c, float d) { int p = __builtin_amdgcn_cvt_pk_fp8_f32(a, b, 0, false); p = __builtin_amdgcn_cvt_pk_fp8_f32(c, d, p, true); return (unsigned)p; }
struct EpiUp {
    static constexpr bool PERM = true, AFTER_DRAIN = false, MIDK = false;
    unsigned char* ACT; const float* b_up;
    __device__ __forceinline__ void operator()(const f32x4 (&acc)[2][2][4][2], const Unit& u, int wr, int wc, int fr, int fq) const {
        const int e = u.pn >> 3, p = u.pn & 7;
        int row0 = u.pm * BM + wr * 64 + fr; const int c0 = p * 128 + wc * 32 + 8 * fq;
        asm volatile("" : "+v"(row0));
        const float* bg = b_up + (size_t)e * 2048 + c0; const float* bl = bg + 1024;
        f32x4 bgv[2], blv[2];
#pragma unroll
        for (int n = 0; n < 2; ++n) { bgv[n] = *(const f32x4*)(bg + 4 * n); blv[n] = *(const f32x4*)(bl + 4 * n); }
#pragma unroll
        for (int ai = 0; ai < 2; ++ai)
#pragma unroll
            for (int m = 0; m < 4; ++m) { unsigned char* rowp = ACT + (size_t)(row0 + ai * HALF + m * 16) * 1024 + c0;
                f32x4 a[2];
#pragma unroll
                for (int n = 0; n < 2; ++n) { const f32x4 g = acc[ai][0][m][n] + bgv[n], l = acc[ai][1][m][n] + blv[n];
#pragma unroll
                    for (int j = 0; j < 4; ++j) { const float gg = fminf(g[j], 7.0f), ll = fminf(fmaxf(l[j], -7.0f), 7.0f); a[n][j] = (ll + 1.0f) * gg * fast_sigmoid(1.702f * gg); } }
                typedef unsigned u32x2_t __attribute__((ext_vector_type(2)));
                u32x2_t w; w.x = pk_fp8x4(a[0][0], a[0][1], a[0][2], a[0][3]); w.y = pk_fp8x4(a[1][0], a[1][1], a[1][2], a[1][3]);
                *(u32x2_t*)rowp = w; }
    }
};
struct EpiDown {
    static constexpr bool PERM = true, AFTER_DRAIN = false, MIDK = false;
    bf16_t* YR; const float* b_down; const float* row_gate; const LAS int* tbl;
    __device__ __forceinline__ void operator()(const f32x4 (&acc)[2][2][4][2], const Unit& u, int wr, int wc, int fr, int fq) const {
        const int e = u.pn >> 2, p = u.pn & 3;
        int row0 = u.pm * BM + wr * 64 + fr; const int c0 = p * BM + wc * 32 + 8 * fq;
        asm volatile("" : "+v"(row0));
        f32x4 bv[2][2];
#pragma unroll
        for (int bj = 0; bj < 2; ++bj)
#pragma unroll
            for (int n = 0; n < 2; ++n) bv[bj][n] = *(const f32x4*)(b_down + (size_t)e * 1024 + c0 + bj * HALF + 4 * n);
#pragma unroll
        for (int ai = 0; ai < 2; ++ai)
#pragma unroll
            for (int m = 0; m < 4; ++m) { const int r = row0 + ai * HALF + m * 16; const int pos = r - tbl[32 + e] * 256;
                const float gt = pos < tbl[e] ? __hip_atomic_load(row_gate + (size_t)e * 16384 + pos, __ATOMIC_RELAXED, __HIP_MEMORY_SCOPE_AGENT) : 0.0f;
                bf16_t* rowp = YR + (size_t)r * 1024 + c0;
#pragma unroll
                for (int bj = 0; bj < 2; ++bj) { const f32x4 v0 = (acc[ai][bj][m][0] + bv[bj][0]) * gt, v1 = (acc[ai][bj][m][1] + bv[bj][1]) * gt;
                    u32x4 w; w.x = cvt_pk_bf16(v0[0], v0[1]); w.y = cvt_pk_bf16(v0[2], v0[3]); w.z = cvt_pk_bf16(v1[0], v1[1]); w.w = cvt_pk_bf16(v1[2], v1[3]);
                    *(u32x4*)(rowp + bj * HALF) = w; } }
    }
};
}

__device__ __forceinline__ void p0_transpose_item(const float* W, int N, bf16* WT, int Kd, size_t dst_row0, LAS float* scr, int k0, int n0, int lane) {
#pragma unroll 8
    for (int i = 0; i < 32; ++i) { const int kk = 2 * i + (lane >> 5); scr[kk * 33 + (lane & 31)] = W[(size_t)(k0 + kk) * N + n0 + (lane & 31)]; }
    LDS_WAIT(); asm volatile("" ::: "memory");
    const int c = lane & 7;
#pragma unroll
    for (int j = 0; j < 4; ++j) { const int n = (lane >> 3) + 8 * j; const LAS float* s = scr + (8 * c) * 33 + n;
        v4u o; o.x = pk2(s[0 * 33], s[1 * 33]); o.y = pk2(s[2 * 33], s[3 * 33]); o.z = pk2(s[4 * 33], s[5 * 33]); o.w = pk2(s[6 * 33], s[7 * 33]);
        *(GAS v4u*)(WT + (dst_row0 + n) * (size_t)Kd + k0 + 8 * c) = o; }
    LDS_WAIT(); asm volatile("" ::: "memory");
}
__device__ __forceinline__ void p0_prologue(Frame& F, const Args& args) {
    const float* c_in = IN_F(1); const int* pos = IN_I(2); const float* ada_w = IN_F(3); const float* ada_b = IN_F(4);
    for (int task = F.vcu; task < 96; task += F.G) {
        LAS float* sc = (LAS float*)F.lds;
        LAS float* red = (LAS float*)(F.lds + 16384);
        for (int i = F.tid; i < 4096; i += 512) { const float v = c_in[i]; sc[i] = v / (1.0f + expf(-v)); }
        __syncthreads();
        const int colq = F.lane & 15, kq = F.lane >> 4, col = task * 64 + colq * 4;
        float acc[4][4];
#pragma unroll
        for (int b = 0; b < 4; ++b)
#pragma unroll
            for (int j = 0; j < 4; ++j) acc[b][j] = 0.f;
#pragma unroll 4
        for (int s = 0; s < 32; ++s) { const int k = F.wave * 128 + s * 4 + kq; const f32x4 wv = *(const f32x4*)(ada_w + (size_t)k * 6144 + col);
#pragma unroll
            for (int b = 0; b < 4; ++b) { const float sv = sc[b * 1024 + k];
#pragma unroll
                for (int j = 0; j < 4; ++j) acc[b][j] += sv * wv[j]; } }
#pragma unroll
        for (int b = 0; b < 4; ++b)
#pragma unroll
            for (int j = 0; j < 4; ++j) { float v = acc[b][j]; v += __shfl_xor(v, 16); v += __shfl_xor(v, 32); if (kq == 0) red[(F.wave * 4 + b) * 64 + colq * 4 + j] = v; }
        __syncthreads();
        if (F.tid < 256) { const int b = F.tid >> 6, cc = F.tid & 63; float s = ada_b[task * 64 + cc];
#pragma unroll
            for (int w = 0; w < 8; ++w) s += red[(w * 4 + b) * 64 + cc];
            WSP(float, WS_MOD)[b * 6144 + task * 64 + cc] = s; }
        VM_WAIT(); __syncthreads();
        if (F.tid == 0) { __builtin_amdgcn_fence(__ATOMIC_RELEASE, "agent"); VM_WAIT(); __hip_atomic_fetch_add((unsigned*)(F.ws + WS_CTL) + CW_MODCNT, 1u, RLX_AGENT); }
    }
    const int gt = F.vcu * 512 + F.tid, NGT = F.G * 512;
    for (int idx = gt; idx < NTOK * 16; idx += NGT) { const int m = idx >> 4, i = idx & 15;
        double freq = 1.0; for (int q = 0; q < i; ++q) freq *= 0.44036660267178046;
        const double ang = (double)pos[m] * freq; const double nr = __builtin_rint(ang * 0.15915494309189535);
        const float r = (float)__builtin_fma(-nr, 6.283185307179586, ang);
        float sn, cs; sincosf(r, &sn, &cs);
        WSP(float, WS_TRIG)[m * 32 + i] = cs; WSP(float, WS_TRIG)[m * 32 + 16 + i] = sn; }
    { const float* wr = IN_F(20); for (int idx = gt; idx < 32 * 1024; idx += NGT) { const int e = idx >> 10, k = idx & 1023; const float w = wr[k * 32 + e];
        const unsigned hi = f2bf(w); const float rem = w - __builtin_bit_cast(float, hi << 16); WSP(bf16, WS_WRH)[idx] = (bf16)hi; WSP(bf16, WS_WRL)[idx] = (bf16)f2bf(rem); } }
    LAS float* scr = (LAS float*)(F.lds + 32768 + F.wave * 8704);
    const int gw = F.vcu * NWAVES + F.wave, NGW = F.G * NWAVES;
    constexpr int I_IN = 16 * 224, I_RG = 128, I_B = 1024, I_O = 512;
    constexpr int NITEMS = I_IN + I_RG + I_B + I_O;
    for (int it = gw; it < NITEMS; it += NGW) {
        int r = it;
        if (r < I_IN) { const int kb = r / 224, nb = r % 224; p0_transpose_item(IN_F(7), DIN, WSP(bf16, WS_WIN), 1024, (size_t)nb * 32, scr, kb * 64, nb * 32, F.lane); continue; } r -= I_IN;
        if (r < I_RG) { const int mat = r >> 6, blk = (r >> 3) & 7, kb = (r >> 2) & 1, nb = r & 3;
            p0_transpose_item(IN_F(mat ? 12 : 10) + (size_t)blk * 16384, 128, WSP(bf16, WS_WRG) + (size_t)(mat * 8 + blk) * 16384, 128, (size_t)nb * 32, scr, kb * 64, nb * 32, F.lane); continue; } r -= I_RG;
        if (r < I_B) { const int g = r >> 9, q = r & 511, kb = q >> 5, nb = q & 31;
            p0_transpose_item(IN_F(18) + (size_t)g * 1048576, 1024, WSP(bf16, WS_WB) + (size_t)g * 1024, 2048, (size_t)nb * 32, scr, kb * 64, nb * 32, F.lane); continue; } r -= I_B;
        { const int kb = r >> 5, nb = r & 31; p0_transpose_item(IN_F(19), 1024, WSP(bf16, WS_WO), 1024, (size_t)nb * 32, scr, kb * 64, nb * 32, F.lane); }
    }
}
__device__ __forceinline__ void p8_transpose_item_fp8(const float* W, int N, unsigned char* WT, int Kd, size_t dst_row0, LAS float* scr, int k0, int n0, int lane) {
#pragma unroll 8
    for (int i = 0; i < 32; ++i) { const int kk = 2 * i + (lane >> 5); scr[kk * 33 + (lane & 31)] = W[(size_t)(k0 + kk) * N + n0 + (lane & 31)] * 64.0f; }
    LDS_WAIT(); asm volatile("" ::: "memory");
    const int c = lane & 7;
#pragma unroll
    for (int j = 0; j < 4; ++j) { const int n = (lane >> 3) + 8 * j; const LAS float* s = scr + (8 * c) * 33 + n;
        v2u o; o.x = pg8::pk_fp8x4(s[0 * 33], s[1 * 33], s[2 * 33], s[3 * 33]); o.y = pg8::pk_fp8x4(s[4 * 33], s[5 * 33], s[6 * 33], s[7 * 33]);
        *(GAS v2u*)(WT + (dst_row0 + n) * (size_t)Kd + k0 + 8 * c) = o; }
    LDS_WAIT(); asm volatile("" ::: "memory");
}
__device__ __forceinline__ void p8_moe_weights(Frame& F, const Args& args) {
    LAS float* scr = (LAS float*)(F.lds + 32768 + F.wave * 8704);
    const int gw = F.vcu * NWAVES + F.wave, NGW = F.G * NWAVES;
    constexpr int I_UP = 32 * 1024, I_DN = 32 * 512;
    for (int it = gw; it < I_UP + I_DN; it += NGW) {
        int r = it;
        if (r < I_UP) { const int e = r >> 10, q = r & 1023, kb = q >> 6, nb = q & 63, n0 = nb * 32;
            const int bj = n0 >> 10, p = (n0 & 1023) >> 7, oo = n0 & 127;
            p8_transpose_item_fp8(IN_F(22) + (size_t)e * 2097152, 2048, WSP(unsigned char, WS_WUP) + (size_t)e * 2097152, 1024, (size_t)(p * 256 + bj * 128 + oo), scr, kb * 64, n0, F.lane); continue; } r -= I_UP;
        { const int e = r >> 9, q = r & 511, kb = q >> 5, nb = q & 31;
            p8_transpose_item_fp8(IN_F(24) + (size_t)e * 1048576, 1024, WSP(unsigned char, WS_WDN) + (size_t)e * 1048576, 1024, (size_t)nb * 32, scr, kb * 64, nb * 32, F.lane); }
    }
}

__device__ __forceinline__ void p1_hrows(Frame& F, const Args& args) {
    if (F.tid == 0) { unsigned* mc = (unsigned*)(F.ws + WS_CTL) + CW_MODCNT; unsigned sp = 0; while (__hip_atomic_load(mc, RLX_AGENT) < 96u && ++sp < (1u << 22)) __builtin_amdgcn_s_sleep(2);
        __builtin_amdgcn_fence(__ATOMIC_ACQUIRE, "agent"); VM_WAIT(); }
    __syncthreads();
    const float* x = IN_F(0); const float* g1n = IN_F(5); const float* mod = WSP(float, WS_MOD); bf16* H = WSP(bf16, WS_HB);
    const int gw = F.vcu * NWAVES + F.wave, NGW = F.G * NWAVES;
    for (int m = gw; m < NTOK; m += NGW) {
        const int b = m >> 12;
        const f32x4* xr = (const f32x4*)(x + (size_t)m * DM) + F.lane;
        f32x4 v[4]; float s = 0.f;
#pragma unroll
        for (int j = 0; j < 4; ++j) { v[j] = xr[64 * j]; s += (v[j].x * v[j].x + v[j].y * v[j].y) + (v[j].z * v[j].z + v[j].w * v[j].w); }
        const float rstd = 1.0f / sqrtf(wave_sum(s) * (1.f / DM) + EPS);
        unsigned long long* o8 = (unsigned long long*)(H + (size_t)m * DM) + F.lane;
#pragma unroll
        for (int j = 0; j < 4; ++j) { const int col = 4 * F.lane + 256 * j;
            const f32x4 g = *(const f32x4*)(g1n + col), sh = *(const f32x4*)(mod + b * 6144 + col), sc = *(const f32x4*)(mod + b * 6144 + 1024 + col);
            const f32x4 h = v[j] * rstd * g * (sc + 1.0f) + sh;
            o8[64 * j] = (unsigned long long)pk2(h.x, h.y) | ((unsigned long long)pk2(h.z, h.w) << 32); }
    }
}

__device__ __forceinline__ void p3_knorm_unit(Frame& F, const Args& args, int unit) {
    const int h = unit & 7, j = (unit >> 3) & 15, b = unit >> 7;
    bf16* KR = WSP(bf16, WS_E) + 3 * E_STRIDE; const float* trig = WSP(float, WS_TRIG); const float* kg = IN_F(16);
    const int rsub = F.lane >> 4, c16 = F.lane & 15;
    float gk[8];
#pragma unroll
    for (int i = 0; i < 8; ++i) gk[i] = kg[c16 * 8 + i];
    float km[8];
#pragma unroll
    for (int i = 0; i < 8; ++i) km[i] = 0.f;
    const int fi = (c16 & 1) * 8;
#pragma unroll 1
    for (int bt = 0; bt < 2; ++bt) {
        v4u raw[4]; f32x4 tcs[4][4];
#pragma unroll
        for (int i4 = 0; i4 < 4; ++i4) { const int m = b * SEQ + j * 256 + F.wave * 32 + (bt * 4 + i4) * 4 + rsub;
            raw[i4] = *(const v4u*)(KR + (size_t)m * DM + h * HD + c16 * 8);
            const float* tp = trig + (size_t)m * 32 + fi;
            tcs[i4][0] = *(const f32x4*)tp; tcs[i4][1] = *(const f32x4*)(tp + 4); tcs[i4][2] = *(const f32x4*)(tp + 16); tcs[i4][3] = *(const f32x4*)(tp + 20); }
#pragma unroll
        for (int i4 = 0; i4 < 4; ++i4) { const int m = b * SEQ + j * 256 + F.wave * 32 + (bt * 4 + i4) * 4 + rsub;
            float v[8] = {bflo(raw[i4].x), bfhi(raw[i4].x), bflo(raw[i4].y), bfhi(raw[i4].y), bflo(raw[i4].z), bfhi(raw[i4].z), bflo(raw[i4].w), bfhi(raw[i4].w)};
            float ss = 0.f;
#pragma unroll
            for (int i = 0; i < 8; ++i) ss += v[i] * v[i];
            ss += __shfl_xor(ss, 1); ss += __shfl_xor(ss, 2); ss += __shfl_xor(ss, 4); ss += __shfl_xor(ss, 8);
            const float rstd = 1.0f / sqrtf(ss * (1.f / HD) + EPS);
#pragma unroll
            for (int i = 0; i < 8; ++i) v[i] = v[i] * rstd * gk[i];
#pragma unroll
            for (int i = 0; i < 8; ++i) { const float other = __shfl_xor(v[i], 2); const float cs = tcs[i4][i >> 2][i & 3], sn = tcs[i4][2 + (i >> 2)][i & 3];
                if (c16 < 4) v[i] = (c16 < 2) ? (v[i] * cs - other * sn) : (v[i] * cs + other * sn); }
#pragma unroll
            for (int i = 0; i < 8; ++i) km[i] += v[i];
            v4u o; o.x = cvtpk(v[0], v[1]); o.y = cvtpk(v[2], v[3]); o.z = cvtpk(v[4], v[5]); o.w = cvtpk(v[6], v[7]);
            *(v4u*)(KR + (size_t)m * DM + h * HD + c16 * 8) = o; }
    }
    LAS float* red = (LAS float*)(F.lds + XTRA_OFF);
#pragma unroll
    for (int i = 0; i < 8; ++i) { float v = km[i]; v += __shfl_xor(v, 16); v += __shfl_xor(v, 32); if (rsub == 0) red[F.wave * 128 + c16 * 8 + i] = v; }
    __syncthreads();
    if (F.tid < 128) { float s = 0.f;
#pragma unroll
        for (int w = 0; w < 8; ++w) s += red[w * 128 + F.tid];
        WSP(float, WS_KMEAN)[((size_t)(b * NH + h) * 16 + j) * HD + F.tid] = s * (1.f / 256.f); }
    __syncthreads();
}

__device__ __forceinline__ void p3_rnn_local_unit(Frame& F, const Args& args, int unit) {
    const int n = unit & 7, c = (unit >> 3) & 15, b = unit >> 7;
    const int t0 = c * 256, m0 = b * SEQ + t0, ch0 = n * 128;
    const bf16* XR = WSP(bf16, WS_E);
    LAS unsigned char* At = F.lds;
    {
        const int cg = F.tid & 15, rs = F.tid >> 4; const int chb = ch0 + cg * 8;
        const float* cw = IN_F(8); const float* cb = IN_F(9);
        float w0[8], w1[8], w2[8], w3[8], bb[8];
#pragma unroll
        for (int i = 0; i < 8; ++i) { w0[i] = cw[chb + i]; w1[i] = cw[1024 + chb + i]; w2[i] = cw[2048 + chb + i]; w3[i] = cw[3072 + chb + i]; bb[i] = cb[chb + i]; }
        const int tr0 = t0 + rs * 8;
        v4u rw[11];
#pragma unroll
        for (int r = 0; r < 11; ++r) { const int tt = tr0 - 3 + r; rw[r] = *(const v4u*)(XR + (size_t)(b * SEQ + (tt < 0 ? 0 : tt)) * DM + chb); if (tt < 0) rw[r] = (v4u){0u, 0u, 0u, 0u}; }
#define UNP(dst, w_) do { dst[0] = bflo(w_.x); dst[1] = bfhi(w_.x); dst[2] = bflo(w_.y); dst[3] = bfhi(w_.y); dst[4] = bflo(w_.z); dst[5] = bfhi(w_.z); dst[6] = bflo(w_.w); dst[7] = bfhi(w_.w); } while (0)
        float p1[8], p2[8], p3[8];
        UNP(p3, rw[0]); UNP(p2, rw[1]); UNP(p1, rw[2]);
#pragma unroll
        for (int r = 0; r < 8; ++r) { float cur[8]; UNP(cur, rw[3 + r]);
            float xc[8];
#pragma unroll
            for (int i = 0; i < 8; ++i) xc[i] = bb[i] + w0[i] * cur[i] + w1[i] * p1[i] + w2[i] * p2[i] + w3[i] * p3[i];
            const int row = rs * 8 + r;
            v4u o; o.x = cvtpk(xc[0], xc[1]); o.y = cvtpk(xc[2], xc[3]); o.z = cvtpk(xc[4], xc[5]); o.w = cvtpk(xc[6], xc[7]);
            *(LAS v4u*)(At + row * 256 + ((cg ^ (row & 15)) << 4)) = o;
#pragma unroll
            for (int i = 0; i < 8; ++i) { p3[i] = p2[i]; p2[i] = p1[i]; p1[i] = cur[i]; } }
#undef UNP
    }
    __syncthreads();
    const int fr = F.lane & 15, fq = F.lane >> 4;
    const int vloc = F.wave * 16 + fr, ch = ch0 + vloc;
    const bf16* WA = WSP(bf16, WS_WRG) + (size_t)n * 16384 + (size_t)vloc * 128 + fq * 8;
    const bf16* WX = WA + 8 * 16384;
    bf16x8 Ba[4], Bx[4];
#pragma unroll
    for (int s = 0; s < 4; ++s) { Ba[s] = *(const bf16x8*)(WA + 32 * s); Bx[s] = *(const bf16x8*)(WX + 32 * s); }
    const float ba = IN_F(11)[ch], bx = IN_F(13)[ch];
    const float sp8 = 8.0f * log1pf(expf(-IN_F(14)[ch]));
    float cP = 1.f, cH = 0.f;
    bf16* HL = WSP(bf16, WS_HL); bf16* PP = WSP(bf16, WS_PP);
    LAS unsigned short* stg = (LAS unsigned short*)(F.lds + 65536);
    for (int rq = 0; rq < 4; ++rq) {
        LAS unsigned short* sb = stg + (rq & 1) * 16384;
#pragma unroll
        for (int ri = 0; ri < 4; ++ri) { const int rt = rq * 4 + ri;
            f32x4 accr = {0.f, 0.f, 0.f, 0.f}, accx = {0.f, 0.f, 0.f, 0.f};
            const int arow = rt * 16 + fr;
#pragma unroll
            for (int s = 0; s < 4; ++s) { const bf16x8 a = *(const LAS bf16x8*)(At + arow * 256 + (((fq + 4 * s) ^ (arow & 15)) << 4));
                accr = __builtin_amdgcn_mfma_f32_16x16x32_bf16(a, Ba[s], accr, 0, 0, 0);
                accx = __builtin_amdgcn_mfma_f32_16x16x32_bf16(a, Bx[s], accx, 0, 0, 0); }
            float pj[4], hj[4];
#pragma unroll
            for (int j = 0; j < 4; ++j) { const int row = rt * 16 + 4 * fq + j;
                const float xcv = bf2f(*(const LAS unsigned short*)(At + row * 256 + ((((vloc >> 3)) ^ (row & 15)) << 4) + (vloc & 7) * 2));
                const float r = fast_sigmoid(accr[j] + ba), ig = fast_sigmoid(accx[j] + bx);
                const float a = __builtin_amdgcn_exp2f(-sp8 * r * 1.4426950408889634f);
                float mult = __builtin_amdgcn_sqrtf(fmaxf(fmaf(-a, a, 1.0f), 0.0f)); if (t0 + row == 0) mult = 1.0f;
                const float u = mult * ig * xcv;
                pj[j] = (j ? pj[j - 1] : 1.0f) * a; hj[j] = (j ? hj[j - 1] * a : 0.0f) + u; }
            const float tp = pj[3], th = hj[3];
            const float pa = __shfl(tp, F.lane - 16), ha = __shfl(th, F.lane - 16);
            const float pb = __shfl(tp, F.lane - 32), hb = __shfl(th, F.lane - 32);
            const float pc = __shfl(tp, F.lane - 48), hc = __shfl(th, F.lane - 48);
            float Pq, Hq;
            if (fq == 0) { Pq = 1.f; Hq = 0.f; } else if (fq == 1) { Pq = pa; Hq = ha; } else if (fq == 2) { Pq = pb * pa; Hq = pa * hb + ha; } else { Pq = pc * pb * pa; Hq = pa * (pb * hc + hb) + ha; }
            const float hstart = Hq + Pq * cH, pstart = Pq * cP;
            float hl3 = 0.f, pp3 = 0.f;
#pragma unroll
            for (int j = 0; j < 4; ++j) { const float hv = hj[j] + pj[j] * hstart, pv = pj[j] * pstart; const int rl = ri * 16 + 4 * fq + j;
                const unsigned pk = cvtpk(hv, pv); sb[rl * 128 + vloc] = (unsigned short)pk; sb[8192 + rl * 128 + vloc] = (unsigned short)(pk >> 16); if (j == 3) { hl3 = hv; pp3 = pv; } }
            cH = __shfl(hl3, fr + 48); cP = __shfl(pp3, fr + 48);
        }
        __syncthreads();
#pragma unroll
        for (int q4 = 0; q4 < 4; ++q4) { const int idx = q4 * 512 + F.tid, arr = idx >> 10, rr = (idx >> 4) & 63, c16 = idx & 15;
            const v4u val = *(const LAS v4u*)(sb + arr * 8192 + rr * 128 + c16 * 8);
            bf16* dst = (arr ? PP : HL) + (size_t)(m0 + rq * 64 + rr) * DM + ch0 + c16 * 8;
            *(v4u*)dst = val; }
    }
    if (fq == 0) { WSP(float, WS_AGGP)[(size_t)(b * 16 + c) * 1024 + ch] = cP; WSP(float, WS_AGGH)[(size_t)(b * 16 + c) * 1024 + ch] = cH; }
    __syncthreads();
}

__device__ __forceinline__ void p4_rnn_final_unit(Frame& F, const Args& args, int unit) {
    const int n = unit & 7, c = (unit >> 3) & 15, b = unit >> 7;
    const int m0 = b * SEQ + c * 256, ch0 = n * 128;
    LAS float* car = (LAS float*)(F.lds + XTRA_OFF);
    if (F.tid < 128) { const int ch = ch0 + F.tid; float h = 0.f;
        for (int cc = 0; cc < c; ++cc) { const float p = WSP(float, WS_AGGP)[(size_t)(b * 16 + cc) * 1024 + ch], hh = WSP(float, WS_AGGH)[(size_t)(b * 16 + cc) * 1024 + ch]; h = p * h + hh; }
        car[F.tid] = h; }
    __syncthreads();
    const bf16* HL = WSP(bf16, WS_HL); const bf16* PP = WSP(bf16, WS_PP); const bf16* GG = WSP(bf16, WS_E) + E_STRIDE; bf16* Y = WSP(bf16, WS_YCAT);
    const int c16 = F.tid & 15, r0 = F.tid >> 4;
    float cv[8];
#pragma unroll
    for (int i = 0; i < 8; ++i) cv[i] = car[c16 * 8 + i];
#pragma unroll 2
    for (int it = 0; it < 8; ++it) { const size_t o = (size_t)(m0 + it * 32 + r0) * DM + ch0 + c16 * 8, oy = (size_t)(m0 + it * 32 + r0) * 2048 + ch0 + c16 * 8;
        const v4u hl = *(const v4u*)(HL + o), pp = *(const v4u*)(PP + o), gg = *(const v4u*)(GG + o);
        v4u y;
        y.x = pk2((bflo(hl.x) + bflo(pp.x) * cv[0]) * bflo(gg.x), (bfhi(hl.x) + bfhi(pp.x) * cv[1]) * bfhi(gg.x));
        y.y = pk2((bflo(hl.y) + bflo(pp.y) * cv[2]) * bflo(gg.y), (bfhi(hl.y) + bfhi(pp.y) * cv[3]) * bfhi(gg.y));
        y.z = pk2((bflo(hl.z) + bflo(pp.z) * cv[4]) * bflo(gg.z), (bfhi(hl.z) + bfhi(pp.z) * cv[5]) * bfhi(gg.z));
        y.w = pk2((bflo(hl.w) + bflo(pp.w) * cv[6]) * bflo(gg.w), (bfhi(hl.w) + bfhi(pp.w) * cv[7]) * bfhi(gg.w));
        *(v4u*)(Y + oy) = y; }
    __syncthreads();
}

namespace att {
constexpr int KVBLK = 64, SHM_K = KVBLK * HD * 2, SHM_V = SHM_K;
constexpr float C2 = 0.08838834764831845f * 1.4426950408889634f;
#define KSWZ(row, colB) ((row) * 256 + ((colB) ^ (((row) & 7) << 4)))
__device__ __forceinline__ int v_st(int k, int c) { const int kk = (k & ~0xC) | ((k & 4) << 1) | ((k & 8) >> 1); return ((kk >> 3) * 4 + (c >> 5)) * 512 + ((kk & 7) * 32 + (c & 31)) * 2; }
__device__ __forceinline__ int v_rd_base(int lane) { return ((lane & 3) << 3) | (((lane >> 2) & 3) << 6) | (((lane >> 4) & 1) << 5) | (((lane >> 5) & 1) << 8); }
constexpr int v_rd_off(int d0, int ks, int half) { return d0 * 512 + ks * 4096 + half * 2048; }
__device__ __forceinline__ int crow(int r, int hi) { return (r & 3) + 8 * (r >> 2) + 4 * hi; }

template <int KB>
__device__ __forceinline__ void qkt(f32x16& p0, f32x16& p1, const char* K_lds, int r32, int hi, const char* qfrag, bool act) {
    if (!act) { const float NEG = -__builtin_inff();
#pragma unroll
        for (int r = 0; r < 16; ++r) { p0[r] = NEG; p1[r] = NEG; } return; }
    p0 = f32x16{}; p1 = f32x16{};
    const char* kb[4];
#pragma unroll
    for (int dd = 0; dd < 4; ++dd) kb[dd] = K_lds + KB * SHM_K + KSWZ(r32, (dd * 16 + hi * 8) * 2);
#pragma unroll
    for (int d0 = 0; d0 < 8; ++d0) { const char* a = kb[d0 & 3] + (d0 >> 2) * 128;
        bf16x8 b0 = *reinterpret_cast<const bf16x8*>(a);
        bf16x8 b1 = *reinterpret_cast<const bf16x8*>(a + 32 * 256);
        const bf16x8 q = *reinterpret_cast<const bf16x8*>(qfrag + d0 * 1024);
        p0 = __builtin_amdgcn_mfma_f32_32x32x16_bf16(b0, q, p0, 0, 0, 0);
        p1 = __builtin_amdgcn_mfma_f32_32x32x16_bf16(b1, q, p1, 0, 0, 0); }
}
template <int VB>
__device__ __forceinline__ void pv_tile(f32x16* o, int vb0, bf16x8 pa0, bf16x8 pa1, bf16x8 pa2, bf16x8 pa3, bool act) {
    if (!act) return;
#define TRRD(dst, off) asm volatile("ds_read_b64_tr_b16 %0, %1 offset:%2" : "=&v"(dst) : "v"(vb0), "i"(off) : "memory")
#define PV_D0(d0) do { s16x4 l0, l1, l2, l3, h0, h1, h2, h3; constexpr int b_ = VB * SHM_V + v_rd_off(d0, 0, 0); \
        TRRD(l0, b_); TRRD(h0, b_ + 2048); TRRD(l1, b_ + 4096); TRRD(h1, b_ + 6144); TRRD(l2, b_ + 8192); TRRD(h2, b_ + 10240); TRRD(l3, b_ + 12288); TRRD(h3, b_ + 14336); \
        asm volatile("s_waitcnt lgkmcnt(0)" ::: "memory"); SBAR(); \
        o[d0] = __builtin_amdgcn_mfma_f32_32x32x16_bf16(pa0, (bf16x8){l0[0], l0[1], l0[2], l0[3], h0[0], h0[1], h0[2], h0[3]}, o[d0], 0, 0, 0);   \
        o[d0] = __builtin_amdgcn_mfma_f32_32x32x16_bf16(pa1, (bf16x8){l1[0], l1[1], l1[2], l1[3], h1[0], h1[1], h1[2], h1[3]}, o[d0], 0, 0, 0);   \
        o[d0] = __builtin_amdgcn_mfma_f32_32x32x16_bf16(pa2, (bf16x8){l2[0], l2[1], l2[2], l2[3], h2[0], h2[1], h2[2], h2[3]}, o[d0], 0, 0, 0);   \
        o[d0] = __builtin_amdgcn_mfma_f32_32x32x16_bf16(pa3, (bf16x8){l3[0], l3[1], l3[2], l3[3], h3[0], h3[1], h3[2], h3[3]}, o[d0], 0, 0, 0); } while (0)
    PV_D0(0); PV_D0(1); PV_D0(2); PV_D0(3);
#undef PV_D0
#undef TRRD
}
__device__ __forceinline__ void sm_a(f32x16& p0) {
#pragma unroll
    for (int r = 0; r < 16; ++r) p0[r] = __builtin_amdgcn_exp2f(p0[r]);
}
__device__ __forceinline__ void sm_b(f32x16& p0, f32x16& p1, float& l_reg, bf16x8& pa0, bf16x8& pa1, bf16x8& pa2, bf16x8& pa3) {
#pragma unroll
    for (int r = 0; r < 16; ++r) p1[r] = __builtin_amdgcn_exp2f(p1[r]);
    float ps = 0;
#pragma unroll
    for (int r = 0; r < 16; ++r) ps += p0[r];
#pragma unroll
    for (int r = 0; r < 16; ++r) ps += p1[r];
    l_reg += ps;
#define PK4(P, B_, OUT) do { unsigned a0 = cvtpk(P[B_+0], P[B_+1]), a1 = cvtpk(P[B_+2], P[B_+3]); \
        unsigned b0 = cvtpk(P[B_+4], P[B_+5]), b1 = cvtpk(P[B_+6], P[B_+7]); \
        auto r0 = __builtin_amdgcn_permlane32_swap(a0, b0, false, false); auto r1 = __builtin_amdgcn_permlane32_swap(a1, b1, false, false); \
        v4u w = {r0[0], r1[0], r0[1], r1[1]}; OUT = *reinterpret_cast<bf16x8*>(&w); } while (0)
    PK4(p0, 0, pa0); PK4(p0, 8, pa1); PK4(p1, 0, pa2); PK4(p1, 8, pa3);
#undef PK4
}

__device__ __forceinline__ void attn_unit(Frame& F, const Args& args, int b, int h, int iq) {
    int tid = F.tid; asm volatile("" : "+v"(tid));
    const int wid = F.wave, lane = tid & 63, r32 = lane & 31, hi = lane >> 5;
    char* lds = F.ldsg;
    char* V_lds = lds; char* K_lds = lds + 2 * SHM_V;
    float* kml = (float*)(lds + XTRA_OFF);
    char* qfrag = lds + 65536 + wid * 8192 + lane * 16;
    const bf16* QR = WSP(bf16, WS_E) + 2 * E_STRIDE; const bf16* KN = WSP(bf16, WS_E) + 3 * E_STRIDE; const bf16* VV = WSP(bf16, WS_E) + 4 * E_STRIDE;
    bf16* YA = WSP(bf16, WS_YCAT) + 1024;
    const size_t mb = (size_t)b * SEQ;
    const int q0 = iq * 256, NT = 4 * (iq + 1);
    const bf16* Kh = KN + mb * DM + h * HD; const bf16* Vh = VV + mb * DM + h * HD;
    { const float* kmg = WSP(float, WS_KMEAN) + (size_t)(b * NH + h) * 16 * HD; for (int idx = tid; idx < iq * HD; idx += 512) kml[idx] = kmg[idx]; }
    const int sr = tid >> 4, sc = (tid & 15) * 8, vst0 = v_st(sr, sc), vst1 = v_st(32 + sr, sc), kws = KSWZ(sr, sc * 2);
    const int vb0 = (int)(uintptr_t)V_lds + v_rd_base(lane);
    bf16x8 st_v0, st_v1, st_k0, st_k1;
    const unsigned goff = (unsigned)(sr * DM + sc) * 2u;
#define ROWP(p, k0, rr) ((const char*)((p) + (size_t)((k0) + (rr)) * DM) + goff)
#define SLOAD(k0) do { st_v0 = *(const bf16x8*)ROWP(Vh, k0, 0); st_v1 = *(const bf16x8*)ROWP(Vh, k0, 32); st_k0 = *(const bf16x8*)ROWP(Kh, k0, 0); st_k1 = *(const bf16x8*)ROWP(Kh, k0, 32); } while (0)
#define SWRITE(bf) do { *(bf16x8*)(V_lds + (bf) * SHM_V + vst0) = st_v0; *(bf16x8*)(V_lds + (bf) * SHM_V + vst1) = st_v1; \
                        *(bf16x8*)(K_lds + (bf) * SHM_K + kws) = st_k0; *(bf16x8*)(K_lds + (bf) * SHM_K + kws + 32 * 256) = st_k1; } while (0)
    SLOAD(0);
    const size_t mq = mb + q0 + wid * 32 + r32;
    unsigned selmask;
    {
        bf16x8 qr[8];
        const bf16* qp = QR + mq * DM + h * HD + hi * 8;
        v4u raw[8];
#pragma unroll
        for (int d0 = 0; d0 < 8; ++d0) raw[d0] = *(const v4u*)(qp + d0 * 16);
        float ss = 0.f;
#pragma unroll
        for (int d0 = 0; d0 < 8; ++d0) { const float a0 = bflo(raw[d0].x), a1 = bfhi(raw[d0].x), a2 = bflo(raw[d0].y), a3 = bfhi(raw[d0].y), a4 = bflo(raw[d0].z), a5 = bfhi(raw[d0].z), a6 = bflo(raw[d0].w), a7 = bfhi(raw[d0].w);
            ss += (a0 * a0 + a1 * a1) + (a2 * a2 + a3 * a3) + (a4 * a4 + a5 * a5) + (a6 * a6 + a7 * a7); }
        ss += __shfl_xor(ss, 32);
        const float rs = C2 / sqrtf(ss * (1.f / HD) + EPS);
        const float* qg = IN_F(15) + hi * 8;
#define UNPK(f, W_) do { const v4u t_ = (W_); f[0] = bflo(t_.x); f[1] = bfhi(t_.x); f[2] = bflo(t_.y); f[3] = bfhi(t_.y); f[4] = bflo(t_.z); f[5] = bfhi(t_.z); f[6] = bflo(t_.w); f[7] = bfhi(t_.w); } while (0)
#define PACK(f) ({ v4u w_; w_.x = cvtpk(f[0], f[1]); w_.y = cvtpk(f[2], f[3]); w_.z = cvtpk(f[4], f[5]); w_.w = cvtpk(f[6], f[7]); *reinterpret_cast<bf16x8*>(&w_); })
        { float f0[8], f1[8]; UNPK(f0, raw[0]); UNPK(f1, raw[1]);
          const float* tg = WSP(float, WS_TRIG) + mq * 32 + hi * 8;
#pragma unroll
          for (int j = 0; j < 8; ++j) { const float x1 = f0[j] * rs * qg[j], x2 = f1[j] * rs * qg[16 + j], cs = tg[j], sn = tg[16 + j]; f0[j] = x1 * cs - x2 * sn; f1[j] = x2 * cs + x1 * sn; }
          qr[0] = PACK(f0); qr[1] = PACK(f1); }
#pragma unroll
        for (int d0 = 2; d0 < 8; ++d0) { float f[8]; UNPK(f, raw[d0]);
#pragma unroll
            for (int j = 0; j < 8; ++j) f[j] *= rs * qg[d0 * 16 + j];
            qr[d0] = PACK(f); }
        __syncthreads();
        float v1 = -__builtin_inff(), v2 = v1, v3 = v1; int i1 = 0, i2 = 0, i3 = 0;
#pragma unroll 1
        for (int jb = 0; jb < iq; ++jb) { const float* km = kml + jb * HD + hi * 8; float g = 0.f;
#pragma unroll
            for (int d0 = 0; d0 < 8; ++d0) { float f[8]; UNPK(f, *reinterpret_cast<const v4u*>(&qr[d0]));
                const f32x4 k0 = *(const f32x4*)(km + d0 * 16), k1 = *(const f32x4*)(km + d0 * 16 + 4);
                g += (f[0] * k0[0] + f[1] * k0[1]) + (f[2] * k0[2] + f[3] * k0[3]) + (f[4] * k1[0] + f[5] * k1[1]) + (f[6] * k1[2] + f[7] * k1[3]); }
            g += __shfl_xor(g, 32);
            if (g > v1) { v3 = v2; i3 = i2; v2 = v1; i2 = i1; v1 = g; i1 = jb; }
            else if (g > v2) { v3 = v2; i3 = i2; v2 = g; i2 = jb; }
            else if (g > v3) { v3 = g; i3 = jb; } }
#undef UNPK
#undef PACK
        selmask = 0u; if (iq >= 1) selmask |= 1u << i1; if (iq >= 2) selmask |= 1u << i2; if (iq >= 3) selmask |= 1u << i3;
#pragma unroll
        for (int d0 = 0; d0 < 8; ++d0) *reinterpret_cast<bf16x8*>(qfrag + d0 * 1024) = qr[d0];
    }
    float l_reg = 0.f; f32x16 o[4] = {};
    const int wrow0 = wid * 32;
#define ACT(t) (((t) >> 2) < iq ? (__ballot((selmask >> ((t) >> 2)) & 1u) != 0ull) : ((((t) - 4 * iq) * 64) <= wrow0 + 31))
#define MASKT(P0_, P1_, t) do { const int blk_ = (t) >> 2; const float NEG_ = -__builtin_inff(); \
        if (blk_ < iq) { if (!((selmask >> blk_) & 1u)) { _Pragma("unroll") for (int r = 0; r < 16; ++r) { P0_[r] = NEG_; P1_[r] = NEG_; } } } \
        else { const int kb_ = ((t) - 4 * iq) * 64; if (kb_ + 63 > wrow0) { int dq_ = wrow0 + r32 - kb_ - 4 * hi; asm volatile("" : "+v"(dq_)); \
            _Pragma("unroll") for (int r = 0; r < 16; ++r) { const int c_ = (r & 3) + 8 * (r >> 2); if (c_ > dq_) P0_[r] = NEG_; if (c_ + 32 > dq_) P1_[r] = NEG_; } } } } while (0)
    f32x16 pA0, pA1, pB0, pB1; bf16x8 pa0, pa1, pa2, pa3;
    VM_WAIT(); SWRITE(0); SBAR();
    SLOAD(64);
    __syncthreads();
    SBAR(); qkt<0>(pA0, pA1, K_lds, r32, hi, qfrag, ACT(0));
    MASKT(pA0, pA1, 0); sm_a(pA0);
    VM_WAIT(); SWRITE(1);
    __syncthreads();
#define HALF_STEP(PX0, PX1, PY0, PY1, t, KB, VB, SB) do { \
        SBAR(); qkt<KB>(PX0, PX1, K_lds, r32, hi, qfrag, ACT(t)); \
        sm_b(PY0, PY1, l_reg, pa0, pa1, pa2, pa3); SBAR(); \
        if ((t) + 1 < NT) { SLOAD(((t) + 1) * 64); SBAR(); } \
        pv_tile<VB>(o, vb0, pa0, pa1, pa2, pa3, ACT((t) - 1)); MASKT(PX0, PX1, (t)); sm_a(PX0); \
        __syncthreads(); \
        if ((t) + 1 < NT) { VM_WAIT(); SWRITE(SB); } \
        __syncthreads(); } while (0)
    for (int t = 1; t + 1 < NT; t += 2) {
        HALF_STEP(pB0, pB1, pA0, pA1, t, 1, 0, 0);
        HALF_STEP(pA0, pA1, pB0, pB1, t + 1, 0, 1, 1);
    }
    SBAR(); qkt<1>(pB0, pB1, K_lds, r32, hi, qfrag, ACT(NT - 1)); SBAR();
    sm_b(pA0, pA1, l_reg, pa0, pa1, pa2, pa3); SBAR();
    pv_tile<0>(o, vb0, pa0, pa1, pa2, pa3, ACT(NT - 2));
    MASKT(pB0, pB1, NT - 1); sm_a(pB0);
    sm_b(pB0, pB1, l_reg, pa0, pa1, pa2, pa3); SBAR();
    pv_tile<1>(o, vb0, pa0, pa1, pa2, pa3, ACT(NT - 1));
    l_reg += __shfl_xor(l_reg, 32);
    float* li_l = (float*)(lds + XTRA_OFF + 8192) + wid * 32;
    if (hi == 0) li_l[r32] = l_reg;
    asm volatile("s_waitcnt lgkmcnt(0)" ::: "memory");
    float rli[16];
#pragma unroll
    for (int r = 0; r < 16; ++r) rli[r] = __builtin_amdgcn_rcpf(li_l[crow(r, hi)]);
    bf16* Ow = YA + (mb + q0 + wid * 32) * 2048 + h * HD;
#pragma unroll
    for (int r = 0; r < 16; ++r) { const int orow = crow(r, hi);
#pragma unroll
        for (int d0 = 0; d0 < 4; ++d0) { const float v = o[d0][r] * rli[r]; const float vn = __shfl_xor(v, 1);
            if ((r32 & 1) == 0) *(unsigned*)(Ow + (size_t)orow * 2048 + d0 * 32 + r32) = cvtpk(v, vn); } }
    __syncthreads();
#undef ROWP
#undef SLOAD
#undef SWRITE
#undef ACT
#undef MASKT
#undef HALF_STEP
}
#undef KSWZ
}

__device__ __forceinline__ void p7_router(Frame& F, const Args& args) {
    LAS float* ssq = (LAS float*)F.lds;
    LAS float* par = (LAS float*)(F.lds + 2048);
    LAS float* lg = (LAS float*)(F.lds + 10240);
    LAS int* hist = (LAS int*)(F.lds + 77824 + 2048);
    LAS int* sel = (LAS int*)(F.lds + 77824 + 4096);
    const float* g2n = IN_F(6); const float* mod = WSP(float, WS_MOD); const float* brt = IN_F(21);
    unsigned char* H2 = WSP(unsigned char, WS_HB);
    unsigned* CNT = (unsigned*)(F.ws + WS_CTL) + CW_CNT;
    const int row = F.lane & 15, q = F.lane >> 4, kw = F.wave * 128;
    bf16x8 Bh[4][2], Bl[4][2];
    { const bf16* wh = WSP(bf16, WS_WRH) + (size_t)row * 1024 + kw + 8 * q; const bf16* wl = WSP(bf16, WS_WRL) + (size_t)row * 1024 + kw + 8 * q;
#pragma unroll
      for (int s = 0; s < 4; ++s) { Bh[s][0] = *(const bf16x8*)(wh + 32 * s); Bh[s][1] = *(const bf16x8*)(wh + 16384 + 32 * s); Bl[s][0] = *(const bf16x8*)(wl + 32 * s); Bl[s][1] = *(const bf16x8*)(wl + 16384 + 32 * s); } }
    for (int vw = F.vcu; vw < 256; vw += F.G) {
        const int m0 = vw * 64, b = m0 >> 12;
        for (int i = F.tid; i < 1024; i += 512) { par[i] = g2n[i] * (1.0f + mod[b * 6144 + 4096 + i]); par[1024 + i] = mod[b * 6144 + 3072 + i]; }
        if (F.tid < 32) hist[F.tid] = 0;
#pragma unroll
        for (int rt = 0; rt < 4; ++rt) { const float* xp = F.out + (size_t)(m0 + rt * 16 + row) * DM + kw + 8 * q; float ss = 0.f;
#pragma unroll
            for (int s = 0; s < 4; ++s) { const f32x4 x0 = *(const f32x4*)(xp + 32 * s), x1 = *(const f32x4*)(xp + 32 * s + 4); const f32x4 a = x0 * x0 + x1 * x1; ss += (a.x + a.y) + (a.z + a.w); }
            ss += __shfl_xor(ss, 16); ss += __shfl_xor(ss, 32);
            if (q == 0) ssq[F.wave * 64 + rt * 16 + row] = ss; }
        __syncthreads();
#pragma unroll
        for (int rt = 0; rt < 4; ++rt) { const int rl = rt * 16 + row; float tot = 0.f;
#pragma unroll
            for (int w = 0; w < 8; ++w) tot += ssq[w * 64 + rl];
            const float rstd = 1.0f / sqrtf(tot * (1.f / DM) + EPS);
            f32x4 acc0 = {0.f, 0.f, 0.f, 0.f}, acc1 = {0.f, 0.f, 0.f, 0.f};
            unsigned char* hp = H2 + (size_t)(m0 + rl) * DM + kw + 8 * q; const float* xp = F.out + (size_t)(m0 + rl) * DM + kw + 8 * q;
            f32x4 xq[4][2];
#pragma unroll
            for (int s = 0; s < 4; ++s) { xq[s][0] = *(const f32x4*)(xp + 32 * s); xq[s][1] = *(const f32x4*)(xp + 32 * s + 4); }
#pragma unroll
            for (int s = 0; s < 4; ++s) { const int col = kw + 32 * s + 8 * q; float h[8];
#pragma unroll
                for (int hf = 0; hf < 2; ++hf) { const f32x4 sc = *(const LAS f32x4*)(par + col + 4 * hf), sh = *(const LAS f32x4*)(par + 1024 + col + 4 * hf);
                    const f32x4 t = xq[s][hf] * rstd * sc + sh; h[4 * hf] = t.x; h[4 * hf + 1] = t.y; h[4 * hf + 2] = t.z; h[4 * hf + 3] = t.w; }
                v4u hi; hi.x = cvtpk(h[0], h[1]); hi.y = cvtpk(h[2], h[3]); hi.z = cvtpk(h[4], h[5]); hi.w = cvtpk(h[6], h[7]);
                { v2u h8; h8.x = pg8::pk_fp8x4(h[0], h[1], h[2], h[3]); h8.y = pg8::pk_fp8x4(h[4], h[5], h[6], h[7]); *(v2u*)(hp + 32 * s) = h8; }
                v4u lo; lo.x = cvtpk(h[0] - bflo(hi.x), h[1] - bfhi(hi.x)); lo.y = cvtpk(h[2] - bflo(hi.y), h[3] - bfhi(hi.y)); lo.z = cvtpk(h[4] - bflo(hi.z), h[5] - bfhi(hi.z)); lo.w = cvtpk(h[6] - bflo(hi.w), h[7] - bfhi(hi.w));
                const bf16x8 ah = *reinterpret_cast<bf16x8*>(&hi), al = *reinterpret_cast<bf16x8*>(&lo);
                acc0 = __builtin_amdgcn_mfma_f32_16x16x32_bf16(ah, Bh[s][0], acc0, 0, 0, 0); acc0 = __builtin_amdgcn_mfma_f32_16x16x32_bf16(ah, Bl[s][0], acc0, 0, 0, 0); acc0 = __builtin_amdgcn_mfma_f32_16x16x32_bf16(al, Bh[s][0], acc0, 0, 0, 0);
                acc1 = __builtin_amdgcn_mfma_f32_16x16x32_bf16(ah, Bh[s][1], acc1, 0, 0, 0); acc1 = __builtin_amdgcn_mfma_f32_16x16x32_bf16(ah, Bl[s][1], acc1, 0, 0, 0); acc1 = __builtin_amdgcn_mfma_f32_16x16x32_bf16(al, Bh[s][1], acc1, 0, 0, 0); }
#pragma unroll
            for (int r = 0; r < 4; ++r) { lg[(F.wave * 64 + rt * 16 + 4 * q + r) * 33 + row] = acc0[r]; lg[(F.wave * 64 + rt * 16 + 4 * q + r) * 33 + 16 + row] = acc1[r]; } }
        __syncthreads();
        { const int rowl = F.tid >> 3, eq = F.tid & 7; float v[4];
#pragma unroll
          for (int j = 0; j < 4; ++j) { float a = brt[4 * eq + j];
#pragma unroll
              for (int w = 0; w < 8; ++w) a += lg[(w * 64 + rowl) * 33 + 4 * eq + j];
              v[j] = a; }
          float tv[4]; int te[4];
#pragma unroll
          for (int k = 0; k < 4; ++k) { float gm = fmaxf(fmaxf(v[0], v[1]), fmaxf(v[2], v[3]));
              gm = fmaxf(gm, __shfl_xor(gm, 1)); gm = fmaxf(gm, __shfl_xor(gm, 2)); gm = fmaxf(gm, __shfl_xor(gm, 4));
              int ci = v[0] == gm ? 4 * eq : v[1] == gm ? 4 * eq + 1 : v[2] == gm ? 4 * eq + 2 : v[3] == gm ? 4 * eq + 3 : 99;
              ci = min(ci, __shfl_xor(ci, 1)); ci = min(ci, __shfl_xor(ci, 2)); ci = min(ci, __shfl_xor(ci, 4));
              te[k] = ci; tv[k] = gm;
#pragma unroll
              for (int j = 0; j < 4; ++j) if (ci == 4 * eq + j) v[j] = -__builtin_inff(); }
          if (eq == 0) { const float w1 = __expf(tv[1] - tv[0]), w2 = __expf(tv[2] - tv[0]), w3 = __expf(tv[3] - tv[0]); const float inv = 1.0f / (1.0f + w1 + w2 + w3);
              const float gk[4] = {inv, w1 * inv, w2 * inv, w3 * inv};
#pragma unroll
              for (int k = 0; k < 4; ++k) { const int lr = atomicAdd((int*)&hist[te[k]], 1); sel[rowl * 4 + k] = te[k]; sel[256 + rowl * 4 + k] = lr; sel[512 + rowl * 4 + k] = __float_as_int(gk[k]); } } }
        __syncthreads();
        if (F.tid < 32) { const int hc = hist[F.tid]; hist[32 + F.tid] = hc ? (int)__hip_atomic_fetch_add(CNT + F.tid, (unsigned)hc, RLX_AGENT) : 0; }
        __syncthreads();
        if (F.tid < 256) { const int e = sel[F.tid], pos = hist[32 + e] + sel[256 + F.tid], mm = m0 + (F.tid >> 2);
            WSP(int, WS_ROWTOK)[(size_t)e * ECAP + pos] = mm; WSP(int, WS_ROWGATE)[(size_t)e * ECAP + pos] = sel[512 + F.tid];
            WSP(int, WS_TOKE)[mm * 4 + (F.tid & 3)] = e; WSP(int, WS_TOKPOS)[mm * 4 + (F.tid & 3)] = pos; }
        __syncthreads();
    }
}

constexpr int MOE_TBL_OFF = XTRA_OFF, MOE_LIST_OFF = XTRA_OFF + 2048;
__device__ __forceinline__ int moe_tables(Frame& F) {
    LAS int* tbl = (LAS int*)(F.lds + MOE_TBL_OFF);
    const unsigned* CNT = (const unsigned*)(F.ws + WS_CTL) + CW_CNT;
    if (F.tid < 32) tbl[F.tid] = (int)__hip_atomic_load(CNT + F.tid, RLX_AGENT);
    __syncthreads();
    if (F.tid == 0) { int run = 0;
#pragma unroll 1
        for (int e = 0; e < 32; ++e) { tbl[32 + e] = run; const int nb = (tbl[e] + 255) >> 8;
#pragma unroll 1
            for (int bb = 0; bb < nb; ++bb) tbl[80 + run + bb] = e;
            run += nb; }
        tbl[64] = run; }
    __syncthreads();
    int nblk = tbl[64]; if (nblk > MAXBLK) nblk = MAXBLK; if (nblk < 1) nblk = 1;
    return __builtin_amdgcn_readfirstlane(nblk);
}

__device__ __forceinline__ void p11_combine(Frame& F, const Args& args) {
    (void)moe_tables(F);
    const LAS int* tbl = (const LAS int*)(F.lds + MOE_TBL_OFF);
    const float* mod = WSP(float, WS_MOD); const bf16* YR = WSP(bf16, WS_YR);
    const int gw = F.vcu * NWAVES + F.wave, NGW = F.G * NWAVES;
    for (int m = gw; m < NTOK; m += NGW) {
        const int b = m >> 12;
        int dk = 0; if (F.lane < 4) { const int e = __hip_atomic_load(WSP(int, WS_TOKE) + m * 4 + F.lane, RLX_AGENT); dk = tbl[32 + e] * 256 + __hip_atomic_load(WSP(int, WS_TOKPOS) + m * 4 + F.lane, RLX_AGENT); }
        const int d0 = __shfl(dk, 0), d1 = __shfl(dk, 1), d2 = __shfl(dk, 2), d3 = __shfl(dk, 3);
        f32x4* xr = (f32x4*)(F.out + (size_t)m * DM) + F.lane;
#pragma unroll
        for (int j = 0; j < 4; ++j) { const int col = 4 * F.lane + 256 * j;
            const v2u y0 = *(const v2u*)(YR + (size_t)d0 * DM + col), y1 = *(const v2u*)(YR + (size_t)d1 * DM + col), y2 = *(const v2u*)(YR + (size_t)d2 * DM + col), y3 = *(const v2u*)(YR + (size_t)d3 * DM + col);
            f32x4 s;
            s.x = (bflo(y0.x) + bflo(y1.x)) + (bflo(y2.x) + bflo(y3.x)); s.y = (bfhi(y0.x) + bfhi(y1.x)) + (bfhi(y2.x) + bfhi(y3.x));
            s.z = (bflo(y0.y) + bflo(y1.y)) + (bflo(y2.y) + bflo(y3.y)); s.w = (bfhi(y0.y) + bfhi(y1.y)) + (bfhi(y2.y) + bfhi(y3.y));
            const f32x4 g2 = *(const f32x4*)(mod + b * 6144 + 5120 + col);
            xr[64 * j] = xr[64 * j] + g2 * s; }
    }
}

#ifndef MK_N_LAUNCHES
#define MK_N_LAUNCHES 1
#endif
constexpr int PER_PHASE = 12;
constexpr int N_LAUNCHES = MK_N_LAUNCHES;

__global__ void __launch_bounds__(NWAVES * 64, 2) hybrid_fwd(Args args) {
    extern __shared__ __attribute__((aligned(16))) unsigned char lds[];
    Frame F;
    F.lds = (LAS unsigned char*)lds; F.ldsg = (char*)lds;
    F.MISC = (volatile LAS unsigned*)(F.lds + MISC_OFF);
    F.tid = threadIdx.x; F.lane = F.tid & 63; F.wave = __builtin_amdgcn_readfirstlane(F.tid >> 6);
    F.G = gridDim.x; { const int bx = blockIdx.x; F.vcu = (F.G % 8 == 0) ? (bx % 8) * (F.G / 8) + bx / 8 : bx; }
    F.ws = args.ws; F.out = args.out;
    gu32* ctl = (gu32*)(args.ws + WS_CTL);
    for (int u = F.tid; u < (LDS_BYTES - LDSCTL_OFF) / 4; u += NWAVES * 64) ((LAS unsigned*)(F.lds + LDSCTL_OFF))[u] = 0u;
    __syncthreads();
    XcdBarrier bar; bar.bar = (unsigned*)(ctl + CW_BAR); bar.x = 0; bar.st = nullptr;
    if (N_LAUNCHES == 1) bar = xcd_barrier_post((unsigned*)(ctl + CW_BAR), F.MISC + 8);
    const int lo = args.ph_lo, hi = args.ph_hi;
#ifndef PHASE_MASK
#define PHASE_MASK 0xFFF
#endif
#define IN(k) (((PHASE_MASK >> (k)) & 1) && lo <= (k) && (k) < hi)
#define NEXTP(k) ((k) == 0 ? 2 : (k) + 1)
#define SEAM(k) do { if (IN(k) && IN(NEXTP(k))) xcd_barrier(bar); } while (0)

#ifndef DUP_MASK
#define DUP_MASK 0
#endif
#define PHASE(k, ...) do { if (IN(k)) { __VA_ARGS__ if ((DUP_MASK >> (k)) & 1) { xcd_barrier(bar); __VA_ARGS__ } } SEAM(k); } while (0)
    PHASE(0, { p0_prologue(F, args); p1_hrows(F, args); });
    PHASE(2, {
        pg8::Gemm g{WSP(bf16, WS_HB), WSP(bf16, WS_WIN), NTOK, DIN, DM}; pg8::TileOrder S; S.init(NTOK / 256, DIN / 256, F.G, (int)blockIdx.x, nullptr);
        pg8::EpiWin E{WSP(bf16, WS_E), IN_F(17)};
        pg8::gemm_phase<pg8::EpiWin, pg8::TileOrder, true, true>(F.lds + RING_OFF, g, S, E);
    });
    int p3rep = 0;
    PHASE(3, {
        for (int u = F.vcu; u < 512; u += F.G) p3_rnn_local_unit(F, args, u);
        if (p3rep++ == 0) { for (int u = F.vcu; u < 512; u += F.G) p3_knorm_unit(F, args, u); }
    });
    PHASE(4, {
        for (int it = F.vcu; it < 256; it += F.G) { const int bh = it >> 3, s = it & 7;
            for (int pass = 0; pass < 2; ++pass) att::attn_unit(F, args, bh >> 3, bh & 7, pass ? s : 15 - s); }
        for (int u = F.vcu; u < 512; u += F.G) p4_rnn_final_unit(F, args, u);
    });
    PHASE(5, {
        pg8::Gemm g{WSP(bf16, WS_YCAT), WSP(bf16, WS_WB), NTOK, DM, 2 * DM}; pg8::TileOrder S; S.init(NTOK / 256, DM / 256, F.G, (int)blockIdx.x, nullptr);
        pg8::EpiBranch E{WSP(bf16, WS_E) + 5 * E_STRIDE, WSP(bf16, WS_E) + 6 * E_STRIDE, WSP(bf16, WS_HB)};
        pg8::gemm_phase<pg8::EpiBranch, pg8::TileOrder, false, true>(F.lds + RING_OFF, g, S, E);
    });
    PHASE(6, {
        pg8::Gemm g{WSP(bf16, WS_HB), WSP(bf16, WS_WO), NTOK, DM, DM}; pg8::TileOrder S; S.init(NTOK / 256, DM / 256, F.G, (int)blockIdx.x, nullptr);
        pg8::EpiWout E{IN_F(0), F.out, WSP(float, WS_MOD)};
        pg8::gemm_phase<pg8::EpiWout, pg8::TileOrder, false, true>(F.lds + RING_OFF, g, S, E);
    });
    PHASE(7, { p7_router(F, args); });
    PHASE(8, { p8_moe_weights(F, args); });
    PHASE(9, {
        const int nblk = moe_tables(F);
        const LAS int* tbl = (const LAS int*)(F.lds + MOE_TBL_OFF); LAS int* lists = (LAS int*)(F.lds + MOE_LIST_OFF);
        pg8::Gemm g{WSP(bf16, WS_HB), WSP(bf16, WS_WUP), RMAX, 2048 * NEXP, DM / 2}; pg8::TileOrder S; S.init(nblk, 8, F.G, (int)blockIdx.x, tbl + 80);
        { pg8::Unit u; for (int i = 0; i < 9 && S.next(i, u); ++i) { if (F.tid < 256) { const int e = u.pn >> 3, pos = (u.pm - tbl[32 + e]) * 256 + F.tid;
              lists[i * 256 + F.tid] = pos < tbl[e] ? __hip_atomic_load(WSP(int, WS_ROWTOK) + (size_t)e * ECAP + pos, RLX_AGENT) : 0; } } }
        __syncthreads();
        pg8::EpiUp E{WSP(unsigned char, WS_ACT), IN_F(23)};
        pg8::gemm_phase<pg8::EpiUp, pg8::TileOrder, true, true, true, true>(F.lds + RING_OFF, g, S, E, lists);
    });
    PHASE(10, {
        const int nblk = moe_tables(F);
        const LAS int* tbl = (const LAS int*)(F.lds + MOE_TBL_OFF);
        pg8::Gemm g{WSP(bf16, WS_ACT), WSP(bf16, WS_WDN), RMAX, 1024 * NEXP, DM / 2}; pg8::TileOrder S; S.init(nblk, 4, F.G, (int)blockIdx.x, tbl + 80);
        pg8::EpiDown E{WSP(bf16, WS_YR), IN_F(25), WSP(float, WS_ROWGATE), tbl};
        pg8::gemm_phase<pg8::EpiDown, pg8::TileOrder, true, true, false, true>(F.lds + RING_OFF, g, S, E);
    });
    PHASE(11, { p11_combine(F, args); });
#undef PHASE
#undef IN
#undef SEAM
}

extern "C" void kernel_launch(void* const* d_in, const int* in_sizes, int n_in, void* d_out, int out_size, void* d_ws, size_t ws_size, hipStream_t stream) {
    static int grid = 0;
    if (grid == 0) {
        if (n_in != 26 || in_sizes[0] != NTOK * DM || out_size != NTOK * DM || ws_size < WS_END) {
            fprintf(stderr, "kernel_launch: shape/workspace mismatch (n_in %d, in0 %d, out %d, ws %zu; need ws >= %zu); nothing launched\n", n_in, n_in > 0 ? in_sizes[0] : -1, out_size, ws_size, (size_t)WS_END); grid = -1; return; }
        int dev = 0, cus = 0, per_cu = 0;
        if (hipGetDevice(&dev) != hipSuccess || hipDeviceGetAttribute(&cus, hipDeviceAttributeMultiprocessorCount, dev) != hipSuccess) { fprintf(stderr, "kernel_launch: device query failed\n"); grid = -1; return; }
        if (hipFuncSetAttribute((const void*)hybrid_fwd, hipFuncAttributeMaxDynamicSharedMemorySize, LDS_BYTES) != hipSuccess) { fprintf(stderr, "kernel_launch: hipFuncSetAttribute failed\n"); grid = -1; return; }
        if (hipOccupancyMaxActiveBlocksPerMultiprocessor(&per_cu, (const void*)hybrid_fwd, NWAVES * 64, LDS_BYTES) != hipSuccess || per_cu < 1) { fprintf(stderr, "kernel_launch: occupancy query says %d blocks/CU\n", per_cu); per_cu = 1; }
        (void)hipGetLastError();
        grid = cus;
        if (grid > 256) grid = 256;
    }
    if (grid < 0) return;
    (void)hipMemsetAsync((char*)d_ws + WS_CTL, 0, CTL_ZERO_BYTES, stream);
    Args a{};
    for (int i = 0; i < 26; ++i) a.in[i] = d_in[i];
    a.out = (float*)d_out; a.ws = (unsigned char*)d_ws;
    for (int li = 0; li < N_LAUNCHES; ++li) {
        a.ph_lo = (N_LAUNCHES == 1) ? 0 : li; a.ph_hi = (N_LAUNCHES == 1) ? PER_PHASE : li + 1;
        hipLaunchKernelGGL(hybrid_fwd, dim3(grid), dim3(NWAVES * 64), LDS_BYTES, stream, a);
        const hipError_t le = hipPeekAtLastError();
        if (le != hipSuccess) { fprintf(stderr, "kernel_launch: launch %d failed: %s\n", li, hipGetErrorName(le)); break; }
    }
}
```

```cpp
#include <hip/hip_runtime.h>
#include <hip/hip_bf16.h>
#include <cstdio>
#include <cstdint>
#include <cmath>
namespace pg8 {
#define PG8_LAS __attribute__((address_space(3)))
typedef unsigned short bf16_t;
typedef short bf16x8 __attribute__((ext_vector_type(8)));
typedef float f32x4 __attribute__((ext_vector_type(4)));
typedef unsigned u32x4 __attribute__((ext_vector_type(4)));
constexpr int BM = 256, BK = 64, HALF = 128, HTB = HALF * BK * 2  , STAGE_BYTES = 8 * HTB, NXCD = 8, WGM = 8;

__host__ __device__ __forceinline__ int lds_byte(int r, int c) { const int st = (r >> 4) * 2 + (c >> 5), rr = r & 15, cc = c & 31, ob = rr * 64 + cc * 2; return st * 1024 + (ob ^ (((ob >> 9) & 1) << 5)); }
__host__ __device__ __forceinline__ void stage_rc(int b, int& R, int& C) { const int st = b / 1024, sb = b % 1024, swz = sb ^ (((sb >> 9) & 1) << 5); R = (st >> 1) * 16 + swz / 64; C = (st & 1) * 32 + (swz % 64) / 2; }
__host__ __device__ __forceinline__ int perm32(int rho) { const int n = rho >> 4, i = rho & 15; return 8 * (i >> 2) + 4 * n + (i & 3); }

struct Unit { int pm, pn; };
struct Gemm { const bf16_t* A; const bf16_t* Bt; int M, N, K; };

struct StaticOrder {
    int nM, nN, nwg, G, c;
    __host__ __device__ void init(int M, int N, int G_, int c_) { nM = M / BM; nN = N / BM; nwg = nM * nN; G = G_; c = c_; }
    __host__ __device__ bool next(int i, Unit& u) const {
        const long L = (long)i * G + c; if (L >= nwg) return false;
        int wgid = (int)L; { const int q = nwg / NXCD, r = nwg % NXCD, xcd = wgid % NXCD, off = wgid / NXCD; wgid = (xcd < r ? xcd * (q + 1) : r * (q + 1) + (xcd - r) * q) + off; }
        const int nig = WGM * nN, gid = wgid / nig, fm = gid * WGM, gsz = (nM - fm) < WGM ? (nM - fm) : WGM;
        u.pm = fm + ((wgid % nig) % gsz); u.pn = (wgid % nig) / gsz; return true;
    }
    __device__ __forceinline__ void a_ready(const Unit&) const {}
    __device__ __forceinline__ void done(const Unit&) const {}
};

__device__ __forceinline__ unsigned cvt_pk_bf16(float lo, float hi) { unsigned r; asm volatile("v_cvt_pk_bf16_f32 %0, %1, %2" : "=v"(r) : "v"(lo), "v"(hi)); return r; }
typedef int v4i_t __attribute__((ext_vector_type(4)));
typedef int v8i_t __attribute__((ext_vector_type(8)));
template <class Epi, class Sched, bool ALIGN_EPI = false, bool SP2 = false, bool GATHER = false, bool FP8 = false>
__device__ __forceinline__ void gemm_phase(PG8_LAS unsigned char* lds, const Gemm g, const Sched& S, const Epi& E, const PG8_LAS int* rowlists = nullptr) {
    static_assert(!GATHER || SP2, "GATHER is implemented for the SP2 loop");
    const int tid = threadIdx.x, wid = __builtin_amdgcn_readfirstlane(tid >> 6), lane = tid & 63, wr = wid >> 2, wc = wid & 3, fr = lane & 15, fq = lane >> 4;
    const int K = g.K, nt = K / BK;
    unsigned voffA, voffB; int gR, gC;
    { int R, C; stage_rc(tid * 16, R, C); const int Rb = Epi::PERM ? ((R & ~31) + perm32(R & 31)) : R; gR = R; gC = C;
      voffA = (unsigned)(R * K + C) * 2u; voffB = (unsigned)(Rb * K + C) * 2u; }
    const size_t row64 = (size_t)64 * K * 2;
    const size_t kstep = (size_t)(BK * 2);
    const size_t hstep = (size_t)HALF * K * 2;
    const size_t tstep = 2 * hstep;
    const unsigned ldsw = (unsigned)wid * 1024u;
    const int aoff = lds_byte(wr * 64 + fr, fq * 8), boff = lds_byte(wc * 32 + fr, fq * 8);
#define PG8_SA(b, h) (((b) * 2 + (h)) * HTB)
#define PG8_SB(b, h) ((4 + (b) * 2 + (h)) * HTB)
#define PG8_STAGE2(bufoff, gbase, v0_, v1_) do { unsigned vo0_ = (v0_), vo1_ = (v1_); asm volatile("" : "+v"(vo0_), "+v"(vo1_));     \
        __builtin_amdgcn_global_load_lds((const unsigned*)((const char*)(gbase) + vo0_), (PG8_LAS unsigned*)(lds + (bufoff) + ldsw), 16, 0, 0); \
        __builtin_amdgcn_global_load_lds((const unsigned*)((const char*)(gbase) + vo1_), (PG8_LAS unsigned*)(lds + (bufoff) + ldsw + 8192), 16, 0, 0); } while (0)
#define PG8_STAGE(bufoff, gbase, voff) do { unsigned vo_ = (voff); asm volatile("" : "+v"(vo_)); \
        __builtin_amdgcn_global_load_lds((const unsigned*)((const char*)(gbase) + vo_), (PG8_LAS unsigned*)(lds + (bufoff) + ldsw), 16, 0, 0); \
        __builtin_amdgcn_global_load_lds((const unsigned*)((const char*)(gbase) + row64 + vo_), (PG8_LAS unsigned*)(lds + (bufoff) + ldsw + 8192), 16, 0, 0); } while (0)
#define PG8_LDA(dst, b, h) do { _Pragma("unroll") for (int m = 0; m < 4; ++m) _Pragma("unroll") for (int k = 0; k < 2; ++k) dst[m][k] = *(const PG8_LAS bf16x8*)(lds + PG8_SA(b, h) + aoff + m * 2048 + k * 1024); } while (0)
#define PG8_LDB(dst, b, h) do { _Pragma("unroll") for (int n = 0; n < 2; ++n) _Pragma("unroll") for (int k = 0; k < 2; ++k) dst[n][k] = *(const PG8_LAS bf16x8*)(lds + PG8_SB(b, h) + boff + n * 2048 + k * 1024); } while (0)
#define PG8_CAT8(x, y) __builtin_shufflevector(__builtin_bit_cast(v4i_t, (x)), __builtin_bit_cast(v4i_t, (y)), 0, 1, 2, 3, 4, 5, 6, 7)
#define PG8_MMA(ai, bj, At, Bt) do { __builtin_amdgcn_s_setprio(1); _Pragma("unroll") for (int m = 0; m < 4; ++m) _Pragma("unroll") for (int n = 0; n < 2; ++n) { \
        if constexpr (FP8) { const v8i_t a8_ = PG8_CAT8(Bt[n][0], Bt[n][1]), b8_ = PG8_CAT8(At[m][0], At[m][1]);     \
            asm volatile("v_mfma_scale_f32_16x16x128_f8f6f4 %0, %1, %2, %0, %3, %4 op_sel_hi:[0,0,0]" : "+v"(acc[ai][bj][m][n]) : "v"(a8_), "v"(b8_), "v"(mxsa_), "v"(mxsb_)); } \
        else { _Pragma("unroll") for (int k = 0; k < 2; ++k) acc[ai][bj][m][n] = __builtin_amdgcn_mfma_f32_16x16x32_bf16(Bt[n][k], At[m][k], acc[ai][bj][m][n], 0, 0, 0); } } \
        __builtin_amdgcn_s_setprio(0); } while (0)
#define PG8_WAIT_V(n) asm volatile("s_waitcnt vmcnt(" #n ")" ::: "memory")
#define PG8_WAIT_L(n) asm volatile("s_waitcnt lgkmcnt(" #n ")" ::: "memory")
#define PG8_BAR __builtin_amdgcn_s_barrier()
#define PG8_SCHED __builtin_amdgcn_sched_barrier(0)
    Unit cur, nxt; int ui = 0;
    if (!S.next(0, cur)) return;
    int mxsa_ = 121, mxsb_ = 127; asm volatile("" : "+v"(mxsa_), "+v"(mxsb_));
    f32x4 acc[2][2][4][2];
#pragma unroll
    for (int a = 0; a < 2; ++a)
#pragma unroll
        for (int b = 0; b < 2; ++b)
#pragma unroll
            for (int m = 0; m < 4; ++m)
#pragma unroll
                for (int n = 0; n < 2; ++n) acc[a][b][m][n] = (f32x4){0.f, 0.f, 0.f, 0.f};
    bf16x8 At[4][2], B0[2][2], B1[2][2];
    const char* cA = GATHER ? (const char*)g.A : (const char*)g.A + (size_t)cur.pm * tstep; const char* cB = (const char*)g.Bt + (size_t)cur.pn * tstep;
#define PG8_STAGE_A(bufoff, kptr, half, unx) do { if constexpr (GATHER) { const PG8_LAS int* rl_ = rowlists + (ui + (unx)) * 256 + (half) * HALF + gR; \
        PG8_STAGE2(bufoff, kptr, (unsigned)(rl_[0] * K + gC) * 2u, (unsigned)(rl_[64] * K + gC) * 2u); } \
        else { PG8_STAGE(bufoff, (kptr) + (half) * hstep, voffA); } } while (0)
    S.a_ready(cur);
    if constexpr (SP2) {
        PG8_STAGE(PG8_SB(0, 0), cB, voffB); PG8_STAGE(PG8_SB(0, 1), cB + hstep, voffB); PG8_STAGE_A(PG8_SA(0, 0), cA, 0, 0); PG8_STAGE_A(PG8_SA(0, 1), cA, 1, 0);
        if (wr == 1) PG8_BAR;
        PG8_WAIT_V(2); PG8_BAR;
        PG8_STAGE(PG8_SB(1, 0), cB + kstep, voffB); PG8_STAGE_A(PG8_SA(1, 0), cA + kstep, 0, 0); PG8_STAGE(PG8_SB(1, 1), cB + hstep + kstep, voffB);
        PG8_WAIT_V(6); PG8_BAR;
    } else {
        PG8_STAGE(PG8_SB(0, 0), cB, voffB); PG8_STAGE(PG8_SA(0, 0), cA, voffA); PG8_STAGE(PG8_SB(0, 1), cB + hstep, voffB); PG8_STAGE(PG8_SA(0, 1), cA + hstep, voffA);
        if (wr == 1) PG8_BAR;
        PG8_WAIT_V(4); PG8_BAR;
        PG8_STAGE(PG8_SB(1, 0), cB + kstep, voffB); PG8_STAGE(PG8_SA(1, 0), cA + kstep, voffA); PG8_STAGE(PG8_SB(1, 1), cB + hstep + kstep, voffB);
        PG8_WAIT_V(6); PG8_BAR;
    }
    for (;;) {
        const bool has_next = S.next(ui + 1, nxt);
        const char* nA = GATHER ? cA : (has_next ? (const char*)g.A + (size_t)nxt.pm * tstep : cA);
        const char* nB = has_next ? (const char*)g.Bt + (size_t)nxt.pn * tstep : cB;
#pragma unroll 1
        for (int t = 0; t < nt; t += 2) {
            const bool last = (t == nt - 2);
            if constexpr (Epi::MIDK) { if (t == (nt >> 1)) { if constexpr (FP8) asm volatile("s_nop 15\n\ts_nop 7" ::: "memory"); E.mid(acc, cur, wr, wc, fr, fq); } }
            const char* a1 = cA + (size_t)(t + 1) * kstep;
            const char* a2 = last ? nA : cA + (size_t)(t + 2) * kstep; const char* b2 = last ? nB : cB + (size_t)(t + 2) * kstep;
            const char* a3 = a2 + kstep; const char* b3 = b2 + kstep;
            if (last && has_next) S.a_ready(nxt);
            const int unx = (GATHER && last && has_next) ? 1 : 0;
            if constexpr (SP2) {
            PG8_LDB(B0, 0, 0); PG8_LDB(B1, 0, 1); PG8_SCHED; PG8_LDA(At, 0, 0); PG8_STAGE_A(PG8_SA(1, 1), a1, 1, 0);
            PG8_WAIT_V(8); PG8_WAIT_L(0); PG8_BAR; PG8_MMA(0, 0, At, B0); PG8_MMA(0, 1, At, B1); PG8_BAR; PG8_SCHED;
            PG8_LDA(At, 0, 1); PG8_STAGE(PG8_SB(0, 0), b2, voffB); PG8_STAGE(PG8_SB(0, 1), b2 + hstep, voffB); PG8_STAGE_A(PG8_SA(0, 0), a2, 0, unx);
            PG8_WAIT_V(8); PG8_WAIT_L(0); PG8_BAR; PG8_MMA(1, 0, At, B0); PG8_MMA(1, 1, At, B1); PG8_BAR; PG8_SCHED;
            PG8_LDB(B0, 1, 0); PG8_LDB(B1, 1, 1); PG8_SCHED; PG8_LDA(At, 1, 0); PG8_STAGE_A(PG8_SA(0, 1), a2, 1, unx);
            PG8_WAIT_V(8); PG8_WAIT_L(0); PG8_BAR; PG8_MMA(0, 0, At, B0); PG8_MMA(0, 1, At, B1); PG8_BAR; PG8_SCHED;
            PG8_LDA(At, 1, 1); PG8_STAGE(PG8_SB(1, 0), b3, voffB); PG8_STAGE(PG8_SB(1, 1), b3 + hstep, voffB); PG8_STAGE_A(PG8_SA(1, 0), a3, 0, unx);
            PG8_WAIT_V(8); PG8_WAIT_L(0); PG8_BAR; PG8_MMA(1, 0, At, B0); PG8_MMA(1, 1, At, B1); PG8_BAR; PG8_SCHED;
            } else {
            PG8_LDB(B0, 0, 0); PG8_SCHED; PG8_LDA(At, 0, 0); PG8_STAGE(PG8_SA(1, 1), a1 + hstep, voffA);
            PG8_WAIT_L(8); PG8_BAR; PG8_WAIT_L(0); PG8_MMA(0, 0, At, B0); PG8_BAR; PG8_SCHED;
            PG8_LDB(B1, 0, 1); PG8_STAGE(PG8_SB(0, 0), b2, voffB);
            PG8_BAR; PG8_WAIT_L(0); PG8_MMA(0, 1, At, B1); PG8_BAR;
            PG8_LDA(At, 0, 1); PG8_STAGE(PG8_SA(0, 0), a2, voffA);
            PG8_BAR; PG8_WAIT_L(0); PG8_MMA(1, 0, At, B0); PG8_BAR; PG8_SCHED;
            PG8_STAGE(PG8_SB(0, 1), b2 + hstep, voffB);
            PG8_WAIT_V(6); PG8_BAR; PG8_MMA(1, 1, At, B1); PG8_BAR;
            PG8_LDB(B0, 1, 0); PG8_SCHED; PG8_LDA(At, 1, 0); PG8_STAGE(PG8_SA(0, 1), a2 + hstep, voffA);
            PG8_WAIT_L(8); PG8_BAR; PG8_WAIT_L(0); PG8_MMA(0, 0, At, B0); PG8_BAR; PG8_SCHED;
            PG8_LDB(B1, 1, 1); PG8_STAGE(PG8_SB(1, 0), b3, voffB);
            PG8_BAR; PG8_WAIT_L(0); PG8_MMA(0, 1, At, B1); PG8_BAR;
            PG8_LDA(At, 1, 1); PG8_STAGE(PG8_SA(1, 0), a3, voffA);
            PG8_BAR; PG8_WAIT_L(0); PG8_MMA(1, 0, At, B0); PG8_BAR; PG8_SCHED;
            PG8_STAGE(PG8_SB(1, 1), b3 + hstep, voffB);
            PG8_WAIT_V(6); PG8_BAR; PG8_MMA(1, 1, At, B1); PG8_BAR;
            }
        }
        if constexpr (ALIGN_EPI) { if (wr == 0) PG8_BAR; }
        if constexpr (FP8) asm volatile("s_nop 15\n\ts_nop 7" ::: "memory");
        if constexpr (!Epi::AFTER_DRAIN) { E(acc, cur, wr, wc, fr, fq); S.done(cur); }
        if (!has_next) break;
#pragma unroll
        for (int a = 0; a < 2; ++a)
#pragma unroll
            for (int b = 0; b < 2; ++b)
#pragma unroll
                for (int m = 0; m < 4; ++m)
#pragma unroll
                    for (int n = 0; n < 2; ++n) acc[a][b][m][n] = (f32x4){0.f, 0.f, 0.f, 0.f};
        cur = nxt; cA = nA; cB = nB; ++ui;
        if constexpr (ALIGN_EPI) { if (wr == 1) PG8_BAR; }
    }
    PG8_WAIT_V(0);
    if constexpr (!ALIGN_EPI) { if (wr == 0) PG8_BAR; }
    PG8_BAR;
    if constexpr (Epi::AFTER_DRAIN) { E.fused(acc, cur, wr, wc, fr, fq, lds, wid, lane); S.done(cur); }
#undef PG8_SA
#undef PG8_STAGE_A
#undef PG8_SB
#undef PG8_STAGE
#undef PG8_STAGE2
#undef PG8_LDA
#undef PG8_LDB
#undef PG8_MMA
#undef PG8_CAT8
#undef PG8_WAIT_V
#undef PG8_WAIT_L
#undef PG8_BAR
#undef PG8_SCHED
}
}

constexpr int NB = 4, SEQ = 4096, DM = 1024, NTOK = NB * SEQ, DIN = 7168, NH = 8, HD = 128;
constexpr int NEXP = 32, TOPK = 4, MAXBLK = 288, RMAX = MAXBLK * 256;
constexpr float EPS = 1e-6f;
constexpr int NWAVES = 8;

constexpr size_t MiB = 1u << 20, KiB = 1u << 10;
constexpr size_t WS_CTL = 0, CTL_ZERO_BYTES = 1 * MiB;
constexpr size_t WS_MOD = 1 * MiB;
constexpr size_t WS_KMEAN = 1 * MiB + 128 * KiB;
constexpr size_t WS_AGGP = 1 * MiB + 384 * KiB;
constexpr size_t WS_AGGH = 1 * MiB + 640 * KiB;
constexpr size_t WS_WRH = 2 * MiB, WS_WRL = 2 * MiB + 64 * KiB;
constexpr size_t WS_TOKE = 3 * MiB, WS_TOKPOS = 3 * MiB + 256 * KiB;
constexpr int ECAP = 16384;
constexpr size_t WS_ROWTOK = 28 * MiB, WS_ROWGATE = 30 * MiB;
constexpr int CW_CNT = 8192;
constexpr size_t WS_TRIG = 4 * MiB;
constexpr size_t WS_WRG = 6 * MiB;
constexpr size_t WS_WIN = 8 * MiB;
constexpr size_t WS_WIN8 = 16 * MiB;
constexpr size_t WS_H8 = 544 * MiB;
constexpr size_t WS_WB = 22 * MiB;
constexpr size_t WS_WO = 26 * MiB;
constexpr size_t WS_WUP = 32 * MiB;
constexpr size_t WS_WDN = 96 * MiB;
constexpr size_t WS_HB = 224 * MiB;
constexpr size_t WS_E = 256 * MiB;
constexpr size_t E_STRIDE = (size_t)NTOK * DM;
constexpr size_t WS_HL = 480 * MiB, WS_PP = 512 * MiB, WS_YCAT = 544 * MiB;
constexpr int CW_MODCNT = 8256;
constexpr size_t WS_ACT = 400 * MiB, WS_YR = 544 * MiB;
constexpr size_t WS_END = 688 * MiB;
constexpr int CW_BAR = 4096;

constexpr int RING_OFF = 0, RING_BYTES = 131072;
constexpr int LDSCTL_OFF = RING_BYTES, MISC_OFF = LDSCTL_OFF + 320;
constexpr int XTRA_OFF = LDSCTL_OFF + 1024;
constexpr int LDS_BYTES = 147456;

#define GAS __attribute__((address_space(1)))
#define LAS __attribute__((address_space(3)))
typedef unsigned short bf16;
typedef unsigned v4u __attribute__((ext_vector_type(4)));
typedef unsigned v2u __attribute__((ext_vector_type(2)));
typedef float f32x4 __attribute__((ext_vector_type(4)));
typedef float f32x2 __attribute__((ext_vector_type(2)));
typedef float f32x16 __attribute__((ext_vector_type(16)));
typedef short bf16x8 __attribute__((ext_vector_type(8)));
typedef short s16x4 __attribute__((ext_vector_type(4)));
typedef GAS unsigned gu32;
#define RLX_AGENT __ATOMIC_RELAXED, __HIP_MEMORY_SCOPE_AGENT
#define LDS_WAIT() asm volatile("s_waitcnt lgkmcnt(0)" ::: "memory")
#define VM_WAIT() asm volatile("s_waitcnt vmcnt(0)" ::: "memory")
#define SBAR() __builtin_amdgcn_sched_barrier(0)
__device__ __forceinline__ unsigned f2bf(float f) { unsigned u = __builtin_bit_cast(unsigned, f); return (u + 0x7fffu + ((u >> 16) & 1u)) >> 16; }
__device__ __forceinline__ unsigned pk2(float lo, float hi) { return f2bf(lo) | (f2bf(hi) << 16); }
__device__ __forceinline__ float bf2f(unsigned short h) { return __builtin_bit_cast(float, (unsigned)h << 16); }
__device__ __forceinline__ float bflo(unsigned w) { return __builtin_bit_cast(float, w << 16); }
__device__ __forceinline__ float bfhi(unsigned w) { return __builtin_bit_cast(float, w & 0xffff0000u); }
__device__ __forceinline__ unsigned cvtpk(float lo, float hi) { unsigned r; asm volatile("v_cvt_pk_bf16_f32 %0, %1, %2" : "=v"(r) : "v"(lo), "v"(hi)); return r; }
__device__ __forceinline__ float fast_sigmoid(float x) { return __builtin_amdgcn_rcpf(1.0f + __builtin_amdgcn_exp2f(-1.4426950408889634f * x)); }
__device__ __forceinline__ float gelu_tanh(float x) { const float z = 1.5957691216057308f * (x + 0.044715f * x * x * x); return x * fast_sigmoid(z); }
__device__ __forceinline__ float wave_sum(float v) {
#pragma unroll
    for (int o = 1; o < 64; o <<= 1) v += __shfl_xor(v, o);
    return v;
}
__device__ __forceinline__ float wave_max(float v) {
#pragma unroll
    for (int o = 1; o < 64; o <<= 1) v = fmaxf(v, __shfl_xor(v, o));
    return v;
}

#define XB_TMO      128
#define XB_XCNT(j)  (256  + 64 * (j))
#define XB_XSUB(j)  (1280 + 64 * (j))
#define XB_XGEN(j)  (2304 + 64 * (j))
#define XB_TOP      3328
#define XB_TOPGEN   3392
#define XCD_BAR_WORDS 3456
#define XB_SPIN_CAP (1u << 20)
__device__ __forceinline__ unsigned xb_ld(unsigned* p)              { return __hip_atomic_load(p, __ATOMIC_RELAXED, __HIP_MEMORY_SCOPE_AGENT); }
__device__ __forceinline__ unsigned xb_add(unsigned* p, unsigned v) { return __hip_atomic_fetch_add(p, v, __ATOMIC_RELAXED, __HIP_MEMORY_SCOPE_AGENT); }
__device__ __forceinline__ unsigned xb_xcc_id() { return (unsigned)__builtin_amdgcn_s_getreg((3 << 11) | 20) & 0xFu; }
#define XB_SPIN(cond, bar) do { unsigned _sp = 0; while (cond) { __builtin_amdgcn_s_sleep(1); \
    if ((++_sp & 255u) == 0u) { if (xb_ld(&(bar)[XB_TMO])) break; if (_sp > XB_SPIN_CAP) { atomicAdd(&(bar)[XB_TMO], 1u); break; } } } } while (0)
struct XcdBarrier { unsigned* bar; unsigned x; volatile LAS unsigned* st; };
__device__ __forceinline__ XcdBarrier xcd_barrier_post(unsigned* bar, volatile LAS unsigned* st) {
    XcdBarrier b; b.bar = bar; b.x = xb_xcc_id(); b.st = st;
    if (threadIdx.x == 0) (void)xb_add(&bar[XB_XCNT(b.x)], 1u);
    return b;
}
__device__ __forceinline__ void xcd_barrier_complete(unsigned* bar, unsigned x, unsigned& nloc, unsigned& nx) {
    const unsigned G = gridDim.x * gridDim.y * gridDim.z;
    unsigned sum, cnt, mine, sp = 0u;
    for (;;) {
        sum = 0u; cnt = 0u; mine = 0u;
#pragma unroll
        for (unsigned j = 0; j < 16; ++j) { const unsigned c = xb_ld(&bar[XB_XCNT(j)]); sum += c; cnt += (c > 0u) ? 1u : 0u; mine = (j == x) ? c : mine; }
        if (sum == G) break;
        __builtin_amdgcn_s_sleep(1);
        if ((++sp & 255u) == 0u) { if (xb_ld(&bar[XB_TMO])) break; if (sp > XB_SPIN_CAP) { atomicAdd(&bar[XB_TMO], 1u); break; } }
    }
    nloc = mine > 0u ? mine : 1u; nx = cnt > 0u ? cnt : 1u;
}
__device__ __forceinline__ void xcd_barrier(const XcdBarrier& b) {
    asm volatile("s_waitcnt vmcnt(0)" ::: "memory");
    __syncthreads();
    if (threadIdx.x == 0) {
        unsigned* bar = b.bar;
        __builtin_amdgcn_s_waitcnt(0);
        unsigned nloc = b.st[0], nx = b.st[1];
        if (nloc == 0u) { xcd_barrier_complete(bar, b.x, nloc, nx); b.st[0] = nloc; b.st[1] = nx; }
        const unsigned old = xb_add(&bar[XB_XSUB(b.x)], 1u);
        const unsigned gen = old / nloc;
        if (old + 1u == (gen + 1u) * nloc) {
            __builtin_amdgcn_fence(__ATOMIC_RELEASE, "agent");
            asm volatile("s_waitcnt vmcnt(0)" ::: "memory");
            const unsigned og = xb_add(&bar[XB_TOP], 1u);
            const unsigned tg = og / nx;
            if (og + 1u == (tg + 1u) * nx) xb_add(&bar[XB_TOPGEN], 1u);
            else XB_SPIN(xb_ld(&bar[XB_TOPGEN]) == tg, bar);
            __builtin_amdgcn_fence(__ATOMIC_ACQUIRE, "agent");
            xb_add(&bar[XB_XGEN(b.x)], 1u);
            asm volatile("s_waitcnt vmcnt(0)" ::: "memory");
        } else {
            XB_SPIN(xb_ld(&bar[XB_XGEN(b.x)]) == gen, bar);
            __builtin_amdgcn_fence(__ATOMIC_ACQUIRE, "agent");
            asm volatile("s_waitcnt vmcnt(0)" ::: "memory");
        }
    }
    __syncthreads();
}

struct Args { const void* in[26]; float* out; unsigned char* ws; int ph_lo, ph_hi; };
struct Frame {
    LAS unsigned char* lds; char* ldsg;
    volatile LAS unsigned* MISC;
    int tid, lane, wave, vcu, G;
    unsigned char* ws; float* out;
};
#define IN_F(k) ((const float*)args.in[k])
#define IN_I(k) ((const int*)args.in[k])
#define WSP(T, off) ((T*)(F.ws + (off)))

namespace pg8 {
struct TileOrder {
    int nM, nN, nwg, G, c; const LAS int* blk_exp;
    __device__ void init(int nM_, int nN_, int G_, int c_, const LAS int* be) { nM = nM_; nN = nN_; nwg = nM * nN; G = G_; c = c_; blk_exp = be; }
    __device__ bool next(int i, Unit& u) const {
        const long L = (long)i * G + c; if (L >= nwg) return false;
        int wgid = (int)L; { const int q = nwg / NXCD, r = nwg % NXCD, xcd = wgid % NXCD, off = wgid / NXCD; wgid = (xcd < r ? xcd * (q + 1) : r * (q + 1) + (xcd - r) * q) + off; }
        const int nig = WGM * nN, gid = wgid / nig, fm = gid * WGM, gsz = (nM - fm) < WGM ? (nM - fm) : WGM;
        u.pm = fm + ((wgid % nig) % gsz); u.pn = (wgid % nig) / gsz;
        if (blk_exp) { const int e = __builtin_amdgcn_readfirstlane(blk_exp[u.pm]); u.pn += e * nN; }
        return true;
    }
    __device__ __forceinline__ void a_ready(const Unit&) const {}
    __device__ __forceinline__ void done(const Unit&) const {}
};

struct EpiWin {
    static constexpr bool PERM = true, AFTER_DRAIN = false, MIDK = false;
    bf16_t* E; const float* b_gate; int mode;
    __device__ __forceinline__ void operator()(const f32x4 (&acc)[2][2][4][2], const Unit& u, int wr, int wc, int fr, int fq) const {
        const int opn = mode == 0 ? (u.pn < 8 ? u.pn : u.pn + 8) : (u.pn < 8 ? u.pn + 8 : u.pn + 12);
        const int t = opn >> 2, colt = (opn & 3) * BM;
        bf16_t* base = E + (size_t)t * ((size_t)16384 * 1024);
        int row0 = u.pm * BM + wr * 64 + fr; const int col0 = colt + wc * 32 + 8 * fq;
        asm volatile("" : "+v"(row0));
        f32x4 bv[2][2];
#pragma unroll
        for (int bj = 0; bj < 2; ++bj)
#pragma unroll
            for (int n = 0; n < 2; ++n) bv[bj][n] = (t >= 5) ? *(const f32x4*)(b_gate + (t - 5) * 1024 + col0 + bj * HALF + 4 * n) : (f32x4){0.f, 0.f, 0.f, 0.f};
#pragma unroll
        for (int ai = 0; ai < 2; ++ai)
#pragma unroll
            for (int m = 0; m < 4; ++m) { bf16_t* rowp = base + (size_t)(row0 + ai * HALF + m * 16) * 1024 + col0;
#pragma unroll
                for (int bj = 0; bj < 2; ++bj) { f32x4 v0 = acc[ai][bj][m][0] + bv[bj][0], v1 = acc[ai][bj][m][1] + bv[bj][1];
                    if (t == 1) {
#pragma unroll
                        for (int j = 0; j < 4; ++j) { v0[j] = gelu_tanh(v0[j]); v1[j] = gelu_tanh(v1[j]); } }
                    else if (t >= 5) {
#pragma unroll
                        for (int j = 0; j < 4; ++j) { v0[j] = fast_sigmoid(v0[j]); v1[j] = fast_sigmoid(v1[j]); } }
                    u32x4 w; w.x = cvt_pk_bf16(v0[0], v0[1]); w.y = cvt_pk_bf16(v0[2], v0[3]); w.z = cvt_pk_bf16(v1[0], v1[1]); w.w = cvt_pk_bf16(v1[2], v1[3]);
                    *(u32x4*)(rowp + bj * HALF) = w; } }
    }
};
struct EpiBranch {
    static constexpr bool PERM = true, AFTER_DRAIN = false, MIDK = true;
    const bf16_t* SG0; const bf16_t* SG1; bf16_t* MIX;
    __device__ __forceinline__ void mid(f32x4 (&acc)[2][2][4][2], const Unit& u, int wr, int wc, int fr, int fq) const {
        int row0 = u.pm * BM + wr * 64 + fr; const int col0 = u.pn * BM + wc * 32 + 8 * fq;
        asm volatile("" : "+v"(row0));
#pragma unroll
        for (int ai = 0; ai < 2; ++ai)
#pragma unroll
            for (int m = 0; m < 4; ++m) { const size_t ro = (size_t)(row0 + ai * HALF + m * 16) * 1024 + col0;
#pragma unroll
                for (int bj = 0; bj < 2; ++bj) { const size_t o = ro + bj * HALF;
                    const u32x4 a = *(const u32x4*)(SG0 + o), b = *(const u32x4*)(SG1 + o);
                    const float r0 = bflo(a.x) * __builtin_amdgcn_rcpf(fmaxf(bflo(b.x), 1e-18f)), r1 = bfhi(a.x) * __builtin_amdgcn_rcpf(fmaxf(bfhi(b.x), 1e-18f));
                    const float r2 = bflo(a.y) * __builtin_amdgcn_rcpf(fmaxf(bflo(b.y), 1e-18f)), r3 = bfhi(a.y) * __builtin_amdgcn_rcpf(fmaxf(bfhi(b.y), 1e-18f));
                    const float r4 = bflo(a.z) * __builtin_amdgcn_rcpf(fmaxf(bflo(b.z), 1e-18f)), r5 = bfhi(a.z) * __builtin_amdgcn_rcpf(fmaxf(bfhi(b.z), 1e-18f));
                    const float r6 = bflo(a.w) * __builtin_amdgcn_rcpf(fmaxf(bflo(b.w), 1e-18f)), r7 = bfhi(a.w) * __builtin_amdgcn_rcpf(fmaxf(bfhi(b.w), 1e-18f));
                    acc[ai][bj][m][0] *= (f32x4){r0, r1, r2, r3}; acc[ai][bj][m][1] *= (f32x4){r4, r5, r6, r7}; }
                asm volatile("" ::: "memory"); }
    }
    __device__ __forceinline__ void operator()(const f32x4 (&acc)[2][2][4][2], const Unit& u, int wr, int wc, int fr, int fq) const {
        int row0 = u.pm * BM + wr * 64 + fr; const int col0 = u.pn * BM + wc * 32 + 8 * fq;
        asm volatile("" : "+v"(row0));
#pragma unroll
        for (int ai = 0; ai < 2; ++ai)
#pragma unroll
            for (int m = 0; m < 4; ++m) { const size_t ro = (size_t)(row0 + ai * HALF + m * 16) * 1024 + col0;
#pragma unroll
                for (int bj = 0; bj < 2; ++bj) { const size_t o = ro + bj * HALF;
                    const u32x4 b = *(const u32x4*)(SG1 + o);
                    const f32x4 g0 = {fmaxf(bflo(b.x), 1e-18f), fmaxf(bfhi(b.x), 1e-18f), fmaxf(bflo(b.y), 1e-18f), fmaxf(bfhi(b.y), 1e-18f)}, g1 = {fmaxf(bflo(b.z), 1e-18f), fmaxf(bfhi(b.z), 1e-18f), fmaxf(bflo(b.w), 1e-18f), fmaxf(bfhi(b.w), 1e-18f)};
                    const f32x4 v0 = acc[ai][bj][m][0] * g0, v1 = acc[ai][bj][m][1] * g1;
                    u32x4 w; w.x = cvt_pk_bf16(v0[0], v0[1]); w.y = cvt_pk_bf16(v0[2], v0[3]); w.z = cvt_pk_bf16(v1[0], v1[1]); w.w = cvt_pk_bf16(v1[2], v1[3]);
                    *(u32x4*)(MIX + o) = w; } }
    }
};
struct EpiWout {
    static constexpr bool PERM = false, AFTER_DRAIN = false, MIDK = false;
    const float* x; float* out; const float* mod;
    __device__ __forceinline__ void operator()(const f32x4 (&acc)[2][2][4][2], const Unit& u, int wr, int wc, int fr, int fq) const {
        int row0 = u.pm * BM + wr * 64 + fr; const int col0 = u.pn * BM + wc * 32 + 4 * fq;
        asm volatile("" : "+v"(row0));
        const float* g1p = mod + (size_t)(u.pm >> 4) * 6144 + 2048;
        f32x4 gv[2][2];
#pragma unroll
        for (int bj = 0; bj < 2; ++bj)
#pragma unroll
            for (int n = 0; n < 2; ++n) gv[bj][n] = *(const f32x4*)(g1p + col0 + bj * HALF + n * 16);
#pragma unroll
        for (int ai = 0; ai < 2; ++ai)
#pragma unroll
            for (int m = 0; m < 4; ++m) { const size_t ro = (size_t)(row0 + ai * HALF + m * 16) * 1024 + col0;
#pragma unroll
                for (int bj = 0; bj < 2; ++bj)
#pragma unroll
                    for (int n = 0; n < 2; ++n) { const size_t o = ro + bj * HALF + n * 16; *(f32x4*)(out + o) = *(const f32x4*)(x + o) + gv[bj][n] * acc[ai][bj][m][n]; } }
    }
};
__device__ __forceinline__ unsigned pk_fp8x4(float a, float b, float c, float d) { int p = __builtin_amdgcn_cvt_pk_fp8_f32(a, b, 0, false); p = __builtin_amdgcn_cvt_pk_fp8_f32(c, d, p, true); return (unsigned)p; }
struct EpiUp {
    static constexpr bool PERM = true, AFTER_DRAIN = false, MIDK = false;
    unsigned char* ACT; const float* b_up;
    __device__ __forceinline__ void operator()(const f32x4 (&acc)[2][2][4][2], const Unit& u, int wr, int wc, int fr, int fq) const {
        const int e = u.pn >> 3, p = u.pn & 7;
        int row0 = u.pm * BM + wr * 64 + fr; const int c0 = p * 128 + wc * 32 + 8 * fq;
        asm volatile("" : "+v"(row0));
        const float* bg = b_up + (size_t)e * 2048 + c0; const float* bl = bg + 1024;
        f32x4 bgv[2], blv[2];
#pragma unroll
        for (int n = 0; n < 2; ++n) { bgv[n] = *(const f32x4*)(bg + 4 * n); blv[n] = *(const f32x4*)(bl + 4 * n); }
#pragma unroll
        for (int ai = 0; ai < 2; ++ai)
#pragma unroll
            for (int m = 0; m < 4; ++m) { unsigned char* rowp = ACT + (size_t)(row0 + ai * HALF + m * 16) * 1024 + c0;
                f32x4 a[2];
#pragma unroll
                for (int n = 0; n < 2; ++n) { const f32x4 g = acc[ai][0][m][n] + bgv[n], l = acc[ai][1][m][n] + blv[n];
#pragma unroll
                    for (int j = 0; j < 4; ++j) { const float gg = fminf(g[j], 7.0f), ll = fminf(fmaxf(l[j], -7.0f), 7.0f); a[n][j] = (ll + 1.0f) * gg * fast_sigmoid(1.702f * gg); } }
                typedef unsigned u32x2_t __attribute__((ext_vector_type(2)));
                u32x2_t w; w.x = pk_fp8x4(a[0][0], a[0][1], a[0][2], a[0][3]); w.y = pk_fp8x4(a[1][0], a[1][1], a[1][2], a[1][3]);
                *(u32x2_t*)rowp = w; }
    }
};
struct EpiDown {
    static constexpr bool PERM = true, AFTER_DRAIN = false, MIDK = false;
    bf16_t* YR; const float* b_down; const float* row_gate; const LAS int* tbl;
    __device__ __forceinline__ void operator()(const f32x4 (&acc)[2][2][4][2], const Unit& u, int wr, int wc, int fr, int fq) const {
        const int e = u.pn >> 2, p = u.pn & 3;
        int row0 = u.pm * BM + wr * 64 + fr; const int c0 = p * BM + wc * 32 + 8 * fq;
        asm volatile("" : "+v"(row0));
        f32x4 bv[2][2];
#pragma unroll
        for (int bj = 0; bj < 2; ++bj)
#pragma unroll
            for (int n = 0; n < 2; ++n) bv[bj][n] = *(const f32x4*)(b_down + (size_t)e * 1024 + c0 + bj * HALF + 4 * n);
#pragma unroll
        for (int ai = 0; ai < 2; ++ai)
#pragma unroll
            for (int m = 0; m < 4; ++m) { const int r = row0 + ai * HALF + m * 16; const int pos = r - tbl[32 + e] * 256;
                const float gt = pos < tbl[e] ? __hip_atomic_load(row_gate + (size_t)e * 16384 + pos, __ATOMIC_RELAXED, __HIP_MEMORY_SCOPE_AGENT) : 0.0f;
                bf16_t* rowp = YR + (size_t)r * 1024 + c0;
#pragma unroll
                for (int bj = 0; bj < 2; ++bj) { const f32x4 v0 = (acc[ai][bj][m][0] + bv[bj][0]) * gt, v1 = (acc[ai][bj][m][1] + bv[bj][1]) * gt;
                    u32x4 w; w.x = cvt_pk_bf16(v0[0], v0[1]); w.y = cvt_pk_bf16(v0[2], v0[3]); w.z = cvt_pk_bf16(v1[0], v1[1]); w.w = cvt_pk_bf16(v1[2], v1[3]);
                    *(u32x4*)(rowp + bj * HALF) = w; } }
    }
};
}

__device__ __forceinline__ void p0_transpose_item(const float* W, int N, bf16* WT, int Kd, size_t dst_row0, LAS float* scr, int k0, int n0, int lane) {
#pragma unroll 8
    for (int i = 0; i < 32; ++i) { const int kk = 2 * i + (lane >> 5); scr[kk * 33 + (lane & 31)] = W[(size_t)(k0 + kk) * N + n0 + (lane & 31)]; }
    LDS_WAIT(); asm volatile("" ::: "memory");
    const int c = lane & 7;
#pragma unroll
    for (int j = 0; j < 4; ++j) { const int n = (lane >> 3) + 8 * j; const LAS float* s = scr + (8 * c) * 33 + n;
        v4u o; o.x = pk2(s[0 * 33], s[1 * 33]); o.y = pk2(s[2 * 33], s[3 * 33]); o.z = pk2(s[4 * 33], s[5 * 33]); o.w = pk2(s[6 * 33], s[7 * 33]);
        *(GAS v4u*)(WT + (dst_row0 + n) * (size_t)Kd + k0 + 8 * c) = o; }
    LDS_WAIT(); asm volatile("" ::: "memory");
}
__device__ __forceinline__ void p8_transpose_item_fp8(const float* W, int N, unsigned char* WT, int Kd, size_t dst_row0, LAS float* scr, int k0, int n0, int lane) {
#pragma unroll 8
    for (int i = 0; i < 32; ++i) { const int kk = 2 * i + (lane >> 5); scr[kk * 33 + (lane & 31)] = W[(size_t)(k0 + kk) * N + n0 + (lane & 31)] * 64.0f; }
    LDS_WAIT(); asm volatile("" ::: "memory");
    const int c = lane & 7;
#pragma unroll
    for (int j = 0; j < 4; ++j) { const int n = (lane >> 3) + 8 * j; const LAS float* s = scr + (8 * c) * 33 + n;
        v2u o; o.x = pg8::pk_fp8x4(s[0 * 33], s[1 * 33], s[2 * 33], s[3 * 33]); o.y = pg8::pk_fp8x4(s[4 * 33], s[5 * 33], s[6 * 33], s[7 * 33]);
        *(GAS v2u*)(WT + (dst_row0 + n) * (size_t)Kd + k0 + 8 * c) = o; }
    LDS_WAIT(); asm volatile("" ::: "memory");
}
__device__ __forceinline__ void p0_prologue(Frame& F, const Args& args) {
    const float* c_in = IN_F(1); const int* pos = IN_I(2); const float* ada_w = IN_F(3); const float* ada_b = IN_F(4);
    for (int task = F.vcu; task < 96; task += F.G) {
        LAS float* sc = (LAS float*)F.lds;
        LAS float* red = (LAS float*)(F.lds + 16384);
        for (int i = F.tid; i < 4096; i += 512) { const float v = c_in[i]; sc[i] = v / (1.0f + expf(-v)); }
        __syncthreads();
        const int colq = F.lane & 15, kq = F.lane >> 4, col = task * 64 + colq * 4;
        float acc[4][4];
#pragma unroll
        for (int b = 0; b < 4; ++b)
#pragma unroll
            for (int j = 0; j < 4; ++j) acc[b][j] = 0.f;
#pragma unroll 4
        for (int s = 0; s < 32; ++s) { const int k = F.wave * 128 + s * 4 + kq; const f32x4 wv = *(const f32x4*)(ada_w + (size_t)k * 6144 + col);
#pragma unroll
            for (int b = 0; b < 4; ++b) { const float sv = sc[b * 1024 + k];
#pragma unroll
                for (int j = 0; j < 4; ++j) acc[b][j] += sv * wv[j]; } }
#pragma unroll
        for (int b = 0; b < 4; ++b)
#pragma unroll
            for (int j = 0; j < 4; ++j) { float v = acc[b][j]; v += __shfl_xor(v, 16); v += __shfl_xor(v, 32); if (kq == 0) red[(F.wave * 4 + b) * 64 + colq * 4 + j] = v; }
        __syncthreads();
        if (F.tid < 256) { const int b = F.tid >> 6, cc = F.tid & 63; float s = ada_b[task * 64 + cc];
#pragma unroll
            for (int w = 0; w < 8; ++w) s += red[(w * 4 + b) * 64 + cc];
            WSP(float, WS_MOD)[b * 6144 + task * 64 + cc] = s; }
        VM_WAIT(); __syncthreads();
        if (F.tid == 0) { __builtin_amdgcn_fence(__ATOMIC_RELEASE, "agent"); VM_WAIT(); __hip_atomic_fetch_add((unsigned*)(F.ws + WS_CTL) + CW_MODCNT, 1u, RLX_AGENT); }
    }
    const int gt = F.vcu * 512 + F.tid, NGT = F.G * 512;
    for (int idx = gt; idx < NTOK * 16; idx += NGT) { const int m = idx >> 4, i = idx & 15;
        double freq = 1.0; for (int q = 0; q < i; ++q) freq *= 0.44036660267178046;
        const double ang = (double)pos[m] * freq; const double nr = __builtin_rint(ang * 0.15915494309189535);
        const float r = (float)__builtin_fma(-nr, 6.283185307179586, ang);
        float sn, cs; sincosf(r, &sn, &cs);
        WSP(float, WS_TRIG)[m * 32 + i] = cs; WSP(float, WS_TRIG)[m * 32 + 16 + i] = sn; }
    { const float* wr = IN_F(20); for (int idx = gt; idx < 32 * 1024; idx += NGT) { const int e = idx >> 10, k = idx & 1023; const float w = wr[k * 32 + e];
        const unsigned hi = f2bf(w); const float rem = w - __builtin_bit_cast(float, hi << 16); WSP(bf16, WS_WRH)[idx] = (bf16)hi; WSP(bf16, WS_WRL)[idx] = (bf16)f2bf(rem); } }
    LAS float* scr = (LAS float*)(F.lds + 32768 + F.wave * 8704);
    const int gw = F.vcu * NWAVES + F.wave, NGW = F.G * NWAVES;
    constexpr int I_IN = 16 * 224, I_RG = 128, I_B = 1024, I_O = 512;
    constexpr int NITEMS = I_IN + I_RG + I_B + I_O;
    for (int it = gw; it < NITEMS; it += NGW) {
        int r = it;
        if (r < I_IN) { const int kb = r / 224, nb = r % 224, n0 = nb * 32;
            if (n0 < 2048 || (n0 >= 4096 && n0 < 5120)) p0_transpose_item(IN_F(7), DIN, WSP(bf16, WS_WIN), 1024, (size_t)(n0 < 2048 ? n0 : n0 - 2048), scr, kb * 64, n0, F.lane);
            else p8_transpose_item_fp8(IN_F(7), DIN, WSP(unsigned char, WS_WIN8), 1024, (size_t)(n0 < 4096 ? n0 - 2048 : n0 - 3072), scr, kb * 64, n0, F.lane);
            continue; } r -= I_IN;
        if (r < I_RG) { const int mat = r >> 6, blk = (r >> 3) & 7, kb = (r >> 2) & 1, nb = r & 3;
            p0_transpose_item(IN_F(mat ? 12 : 10) + (size_t)blk * 16384, 128, WSP(bf16, WS_WRG) + (size_t)(mat * 8 + blk) * 16384, 128, (size_t)nb * 32, scr, kb * 64, nb * 32, F.lane); continue; } r -= I_RG;
        if (r < I_B) { const int g = r >> 9, q = r & 511, kb = q >> 5, nb = q & 31;
            p0_transpose_item(IN_F(18) + (size_t)g * 1048576, 1024, WSP(bf16, WS_WB) + (size_t)g * 1024, 2048, (size_t)nb * 32, scr, kb * 64, nb * 32, F.lane); continue; } r -= I_B;
        { const int kb = r >> 5, nb = r & 31; p0_transpose_item(IN_F(19), 1024, WSP(bf16, WS_WO), 1024, (size_t)nb * 32, scr, kb * 64, nb * 32, F.lane); }
    }
}
__device__ __forceinline__ void p8_moe_weights(Frame& F, const Args& args) {
    LAS float* scr = (LAS float*)(F.lds + 32768 + F.wave * 8704);
    const int gw = F.vcu * NWAVES + F.wave, NGW = F.G * NWAVES;
    constexpr int I_UP = 32 * 1024, I_DN = 32 * 512;
    for (int it = gw; it < I_UP + I_DN; it += NGW) {
        int r = it;
        if (r < I_UP) { const int e = r >> 10, q = r & 1023, kb = q >> 6, nb = q & 63, n0 = nb * 32;
            const int bj = n0 >> 10, p = (n0 & 1023) >> 7, oo = n0 & 127;
            p8_transpose_item_fp8(IN_F(22) + (size_t)e * 2097152, 2048, WSP(unsigned char, WS_WUP) + (size_t)e * 2097152, 1024, (size_t)(p * 256 + bj * 128 + oo), scr, kb * 64, n0, F.lane); continue; } r -= I_UP;
        { const int e = r >> 9, q = r & 511, kb = q >> 5, nb = q & 31;
            p8_transpose_item_fp8(IN_F(24) + (size_t)e * 1048576, 1024, WSP(unsigned char, WS_WDN) + (size_t)e * 1048576, 1024, (size_t)nb * 32, scr, kb * 64, nb * 32, F.lane); }
    }
}

__device__ __forceinline__ void p1_hrows(Frame& F, const Args& args) {
    if (F.tid == 0) { unsigned* mc = (unsigned*)(F.ws + WS_CTL) + CW_MODCNT; unsigned sp = 0; while (__hip_atomic_load(mc, RLX_AGENT) < 96u && ++sp < (1u << 22)) __builtin_amdgcn_s_sleep(2);
        __builtin_amdgcn_fence(__ATOMIC_ACQUIRE, "agent"); VM_WAIT(); }
    __syncthreads();
    const float* x = IN_F(0); const float* g1n = IN_F(5); const float* mod = WSP(float, WS_MOD); bf16* H = WSP(bf16, WS_HB); unsigned char* H8 = WSP(unsigned char, WS_H8);
    const int gw = F.vcu * NWAVES + F.wave, NGW = F.G * NWAVES;
    for (int m0 = gw; m0 < NTOK; m0 += 2 * NGW) {
        const int m1 = m0 + NGW;
        const bool has1 = m1 < NTOK;
        f32x4 v0[4], v1[4]; float s0 = 0.f, s1 = 0.f;
        const f32x4* x0 = (const f32x4*)(x + (size_t)m0 * DM) + F.lane; const f32x4* x1 = (const f32x4*)(x + (size_t)(has1 ? m1 : m0) * DM) + F.lane;
#pragma unroll
        for (int j = 0; j < 4; ++j) { v0[j] = x0[64 * j]; v1[j] = x1[64 * j]; }
#pragma unroll
        for (int j = 0; j < 4; ++j) { s0 += (v0[j].x * v0[j].x + v0[j].y * v0[j].y) + (v0[j].z * v0[j].z + v0[j].w * v0[j].w); s1 += (v1[j].x * v1[j].x + v1[j].y * v1[j].y) + (v1[j].z * v1[j].z + v1[j].w * v1[j].w); }
#pragma unroll
        for (int o = 1; o < 64; o <<= 1) { s0 += __shfl_xor(s0, o); s1 += __shfl_xor(s1, o); }
        const float r0 = 1.0f / sqrtf(s0 * (1.f / DM) + EPS), r1 = 1.0f / sqrtf(s1 * (1.f / DM) + EPS);
        const int b0 = m0 >> 12, b1 = (has1 ? m1 : m0) >> 12;
        unsigned long long* o0 = (unsigned long long*)(H + (size_t)m0 * DM) + F.lane; unsigned long long* o1 = (unsigned long long*)(H + (size_t)(has1 ? m1 : m0) * DM) + F.lane;
#pragma unroll
        for (int j = 0; j < 4; ++j) { const int col = 4 * F.lane + 256 * j;
            const f32x4 g = *(const f32x4*)(g1n + col);
            const f32x4 sh0 = *(const f32x4*)(mod + b0 * 6144 + col), sc0 = *(const f32x4*)(mod + b0 * 6144 + 1024 + col);
            const f32x4 sh1 = *(const f32x4*)(mod + b1 * 6144 + col), sc1 = *(const f32x4*)(mod + b1 * 6144 + 1024 + col);
            const f32x4 h0 = v0[j] * r0 * g * (sc0 + 1.0f) + sh0, h1 = v1[j] * r1 * g * (sc1 + 1.0f) + sh1;
            o0[64 * j] = (unsigned long long)cvtpk(h0.x, h0.y) | ((unsigned long long)cvtpk(h0.z, h0.w) << 32);
            ((unsigned*)(H8 + (size_t)m0 * DM))[F.lane + 64 * j] = pg8::pk_fp8x4(h0.x, h0.y, h0.z, h0.w);
            if (has1) { o1[64 * j] = (unsigned long long)cvtpk(h1.x, h1.y) | ((unsigned long long)cvtpk(h1.z, h1.w) << 32);
                ((unsigned*)(H8 + (size_t)m1 * DM))[F.lane + 64 * j] = pg8::pk_fp8x4(h1.x, h1.y, h1.z, h1.w); } }
    }
}

__device__ __forceinline__ void p3_knorm_unit(Frame& F, const Args& args, int unit) {
    const int h = unit & 7, j = (unit >> 3) & 15, b = unit >> 7;
    bf16* KR = WSP(bf16, WS_E) + 3 * E_STRIDE; const float* trig = WSP(float, WS_TRIG); const float* kg = IN_F(16);
    const int rsub = F.lane >> 4, c16 = F.lane & 15;
    float gk[8];
#pragma unroll
    for (int i = 0; i < 8; ++i) gk[i] = kg[c16 * 8 + i];
    float km[8];
#pragma unroll
    for (int i = 0; i < 8; ++i) km[i] = 0.f;
    const int fi = (c16 & 1) * 8;
#pragma unroll 1
    for (int bt = 0; bt < 2; ++bt) {
        v4u raw[4]; f32x4 tcs[4][4];
#pragma unroll
        for (int i4 = 0; i4 < 4; ++i4) { const int m = b * SEQ + j * 256 + F.wave * 32 + (bt * 4 + i4) * 4 + rsub;
            raw[i4] = *(const v4u*)(KR + (size_t)m * DM + h * HD + c16 * 8);
            const float* tp = trig + (size_t)m * 32 + fi;
            tcs[i4][0] = *(const f32x4*)tp; tcs[i4][1] = *(const f32x4*)(tp + 4); tcs[i4][2] = *(const f32x4*)(tp + 16); tcs[i4][3] = *(const f32x4*)(tp + 20); }
#pragma unroll
        for (int i4 = 0; i4 < 4; ++i4) { const int m = b * SEQ + j * 256 + F.wave * 32 + (bt * 4 + i4) * 4 + rsub;
            float v[8] = {bflo(raw[i4].x), bfhi(raw[i4].x), bflo(raw[i4].y), bfhi(raw[i4].y), bflo(raw[i4].z), bfhi(raw[i4].z), bflo(raw[i4].w), bfhi(raw[i4].w)};
            float ss = 0.f;
#pragma unroll
            for (int i = 0; i < 8; ++i) ss += v[i] * v[i];
            ss += __shfl_xor(ss, 1); ss += __shfl_xor(ss, 2); ss += __shfl_xor(ss, 4); ss += __shfl_xor(ss, 8);
            const float rstd = 1.0f / sqrtf(ss * (1.f / HD) + EPS);
#pragma unroll
            for (int i = 0; i < 8; ++i) v[i] = v[i] * rstd * gk[i];
#pragma unroll
            for (int i = 0; i < 8; ++i) { const float other = __shfl_xor(v[i], 2); const float cs = tcs[i4][i >> 2][i & 3], sn = tcs[i4][2 + (i >> 2)][i & 3];
                if (c16 < 4) v[i] = (c16 < 2) ? (v[i] * cs - other * sn) : (v[i] * cs + other * sn); }
#pragma unroll
            for (int i = 0; i < 8; ++i) km[i] += v[i];
            v4u o; o.x = cvtpk(v[0], v[1]); o.y = cvtpk(v[2], v[3]); o.z = cvtpk(v[4], v[5]); o.w = cvtpk(v[6], v[7]);
            *(v4u*)(KR + (size_t)m * DM + h * HD + c16 * 8) = o; }
    }
    LAS float* red = (LAS float*)(F.lds + XTRA_OFF);
#pragma unroll
    for (int i = 0; i < 8; ++i) { float v = km[i]; v += __shfl_xor(v, 16); v += __shfl_xor(v, 32); if (rsub == 0) red[F.wave * 128 + c16 * 8 + i] = v; }
    __syncthreads();
    if (F.tid < 128) { float s = 0.f;
#pragma unroll
        for (int w = 0; w < 8; ++w) s += red[w * 128 + F.tid];
        WSP(float, WS_KMEAN)[((size_t)(b * NH + h) * 16 + j) * HD + F.tid] = s * (1.f / 256.f); }
    __syncthreads();
}

__device__ __forceinline__ void p3_rnn_local_unit(Frame& F, const Args& args, int unit) {
    const int n = unit & 7, c = (unit >> 3) & 15, b = unit >> 7;
    const int t0 = c * 256, m0 = b * SEQ + t0, ch0 = n * 128;
    const bf16* XR = WSP(bf16, WS_E);
    LAS unsigned char* At = F.lds;
    {
        const int cg = F.tid & 15, rs = F.tid >> 4; const int chb = ch0 + cg * 8;
        const float* cw = IN_F(8); const float* cb = IN_F(9);
        float w0[8], w1[8], w2[8], w3[8], bb[8];
#pragma unroll
        for (int i = 0; i < 8; ++i) { w0[i] = cw[chb + i]; w1[i] = cw[1024 + chb + i]; w2[i] = cw[2048 + chb + i]; w3[i] = cw[3072 + chb + i]; bb[i] = cb[chb + i]; }
        const int tr0 = t0 + rs * 8;
        v4u rw[11];
#pragma unroll
        for (int r = 0; r < 11; ++r) { const int tt = tr0 - 3 + r; rw[r] = *(const v4u*)(XR + (size_t)(b * SEQ + (tt < 0 ? 0 : tt)) * DM + chb); if (tt < 0) rw[r] = (v4u){0u, 0u, 0u, 0u}; }
#define UNP(dst, w_) do { dst[0] = bflo(w_.x); dst[1] = bfhi(w_.x); dst[2] = bflo(w_.y); dst[3] = bfhi(w_.y); dst[4] = bflo(w_.z); dst[5] = bfhi(w_.z); dst[6] = bflo(w_.w); dst[7] = bfhi(w_.w); } while (0)
        float p1[8], p2[8], p3[8];
        UNP(p3, rw[0]); UNP(p2, rw[1]); UNP(p1, rw[2]);
#pragma unroll
        for (int r = 0; r < 8; ++r) { float cur[8]; UNP(cur, rw[3 + r]);
            float xc[8];
#pragma unroll
            for (int i = 0; i < 8; ++i) xc[i] = bb[i] + w0[i] * cur[i] + w1[i] * p1[i] + w2[i] * p2[i] + w3[i] * p3[i];
            const int row = rs * 8 + r;
            v4u o; o.x = cvtpk(xc[0], xc[1]); o.y = cvtpk(xc[2], xc[3]); o.z = cvtpk(xc[4], xc[5]); o.w = cvtpk(xc[6], xc[7]);
            *(LAS v4u*)(At + row * 256 + ((cg ^ (row & 15)) << 4)) = o;
#pragma unroll
            for (int i = 0; i < 8; ++i) { p3[i] = p2[i]; p2[i] = p1[i]; p1[i] = cur[i]; } }
#undef UNP
    }
    __syncthreads();
    const int fr = F.lane & 15, fq = F.lane >> 4;
    const int vloc = F.wave * 16 + fr, ch = ch0 + vloc;
    const bf16* WA = WSP(bf16, WS_WRG) + (size_t)n * 16384 + (size_t)vloc * 128 + fq * 8;
    const bf16* WX = WA + 8 * 16384;
    bf16x8 Ba[4], Bx[4];
#pragma unroll
    for (int s = 0; s < 4; ++s) { Ba[s] = *(const bf16x8*)(WA + 32 * s); Bx[s] = *(const bf16x8*)(WX + 32 * s); }
    const float ba = IN_F(11)[ch], bx = IN_F(13)[ch];
    const float sp8 = 8.0f * log1pf(expf(-IN_F(14)[ch]));
    float cP = 1.f, cH = 0.f;
    bf16* HL = WSP(bf16, WS_HL); bf16* PP = WSP(bf16, WS_PP);
    LAS unsigned short* stg = (LAS unsigned short*)(F.lds + 65536);
    for (int rq = 0; rq < 4; ++rq) {
        LAS unsigned short* sb = stg + (rq & 1) * 16384;
#pragma unroll
        for (int ri = 0; ri < 4; ++ri) { const int rt = rq * 4 + ri;
            f32x4 accr = {0.f, 0.f, 0.f, 0.f}, accx = {0.f, 0.f, 0.f, 0.f};
            const int arow = rt * 16 + fr;
#pragma unroll
            for (int s = 0; s < 4; ++s) { const bf16x8 a = *(const LAS bf16x8*)(At + arow * 256 + (((fq + 4 * s) ^ (arow & 15)) << 4));
                accr = __builtin_amdgcn_mfma_f32_16x16x32_bf16(a, Ba[s], accr, 0, 0, 0);
                accx = __builtin_amdgcn_mfma_f32_16x16x32_bf16(a, Bx[s], accx, 0, 0, 0); }
            float pj[4], hj[4];
#pragma unroll
            for (int j = 0; j < 4; ++j) { const int row = rt * 16 + 4 * fq + j;
                const float xcv = bf2f(*(const LAS unsigned short*)(At + row * 256 + ((((vloc >> 3)) ^ (row & 15)) << 4) + (vloc & 7) * 2));
                const float r = fast_sigmoid(accr[j] + ba), ig = fast_sigmoid(accx[j] + bx);
                const float a = __builtin_amdgcn_exp2f(-sp8 * r * 1.4426950408889634f);
                float mult = __builtin_amdgcn_sqrtf(fmaxf(fmaf(-a, a, 1.0f), 0.0f)); if (t0 + row == 0) mult = 1.0f;
                const float u = mult * ig * xcv;
                pj[j] = (j ? pj[j - 1] : 1.0f) * a; hj[j] = (j ? hj[j - 1] * a : 0.0f) + u; }
            const float tp = pj[3], th = hj[3];
            const float pa = __shfl(tp, F.lane - 16), ha = __shfl(th, F.lane - 16);
            const float pb = __shfl(tp, F.lane - 32), hb = __shfl(th, F.lane - 32);
            const float pc = __shfl(tp, F.lane - 48), hc = __shfl(th, F.lane - 48);
            float Pq, Hq;
            if (fq == 0) { Pq = 1.f; Hq = 0.f; } else if (fq == 1) { Pq = pa; Hq = ha; } else if (fq == 2) { Pq = pb * pa; Hq = pa * hb + ha; } else { Pq = pc * pb * pa; Hq = pa * (pb * hc + hb) + ha; }
            const float hstart = Hq + Pq * cH, pstart = Pq * cP;
            float hl3 = 0.f, pp3 = 0.f;
#pragma unroll
            for (int j = 0; j < 4; ++j) { const float hv = hj[j] + pj[j] * hstart, pv = pj[j] * pstart; const int rl = ri * 16 + 4 * fq + j;
                const unsigned pk = cvtpk(hv, pv); sb[rl * 128 + vloc] = (unsigned short)pk; sb[8192 + rl * 128 + vloc] = (unsigned short)(pk >> 16); if (j == 3) { hl3 = hv; pp3 = pv; } }
            cH = __shfl(hl3, fr + 48); cP = __shfl(pp3, fr + 48);
        }
        __syncthreads();
#pragma unroll
        for (int q4 = 0; q4 < 4; ++q4) { const int idx = q4 * 512 + F.tid, arr = idx >> 10, rr = (idx >> 4) & 63, c16 = idx & 15;
            const v4u val = *(const LAS v4u*)(sb + arr * 8192 + rr * 128 + c16 * 8);
            bf16* dst = (arr ? PP : HL) + (size_t)(m0 + rq * 64 + rr) * DM + ch0 + c16 * 8;
            *(v4u*)dst = val; }
    }
    if (fq == 0) { WSP(float, WS_AGGP)[(size_t)(b * 16 + c) * 1024 + ch] = cP; WSP(float, WS_AGGH)[(size_t)(b * 16 + c) * 1024 + ch] = cH; }
    __syncthreads();
}

__device__ __forceinline__ void p4_rnn_final_unit(Frame& F, const Args& args, int unit) {
    const int n = unit & 7, c = (unit >> 3) & 15, b = unit >> 7;
    const int m0 = b * SEQ + c * 256, ch0 = n * 128;
    LAS float* car = (LAS float*)(F.lds + XTRA_OFF);
    if (F.tid < 128) { const int ch = ch0 + F.tid; float h = 0.f;
        for (int cc = 0; cc < c; ++cc) { const float p = WSP(float, WS_AGGP)[(size_t)(b * 16 + cc) * 1024 + ch], hh = WSP(float, WS_AGGH)[(size_t)(b * 16 + cc) * 1024 + ch]; h = p * h + hh; }
        car[F.tid] = h; }
    __syncthreads();
    const bf16* HL = WSP(bf16, WS_HL); const bf16* PP = WSP(bf16, WS_PP); const bf16* GG = WSP(bf16, WS_E) + E_STRIDE; bf16* Y = WSP(bf16, WS_YCAT);
    const int c16 = F.tid & 15, r0 = F.tid >> 4;
    float cv[8];
#pragma unroll
    for (int i = 0; i < 8; ++i) cv[i] = car[c16 * 8 + i];
#pragma unroll 2
    for (int it = 0; it < 8; ++it) { const size_t o = (size_t)(m0 + it * 32 + r0) * DM + ch0 + c16 * 8, oy = (size_t)(m0 + it * 32 + r0) * 2048 + ch0 + c16 * 8;
        const v4u hl = *(const v4u*)(HL + o), pp = *(const v4u*)(PP + o), gg = *(const v4u*)(GG + o);
        v4u y;
        y.x = pk2((bflo(hl.x) + bflo(pp.x) * cv[0]) * bflo(gg.x), (bfhi(hl.x) + bfhi(pp.x) * cv[1]) * bfhi(gg.x));
        y.y = pk2((bflo(hl.y) + bflo(pp.y) * cv[2]) * bflo(gg.y), (bfhi(hl.y) + bfhi(pp.y) * cv[3]) * bfhi(gg.y));
        y.z = pk2((bflo(hl.z) + bflo(pp.z) * cv[4]) * bflo(gg.z), (bfhi(hl.z) + bfhi(pp.z) * cv[5]) * bfhi(gg.z));
        y.w = pk2((bflo(hl.w) + bflo(pp.w) * cv[6]) * bflo(gg.w), (bfhi(hl.w) + bfhi(pp.w) * cv[7]) * bfhi(gg.w));
        *(v4u*)(Y + oy) = y; }
    __syncthreads();
}

namespace att {
constexpr int KVBLK = 64, SHM_K = KVBLK * HD * 2, SHM_V = SHM_K;
constexpr float C2 = 0.08838834764831845f * 1.4426950408889634f;
#define KSWZ(row, colB) ((row) * 256 + ((colB) ^ (((row) & 7) << 4)))
__device__ __forceinline__ int v_st(int k, int c) { const int kk = (k & ~0xC) | ((k & 4) << 1) | ((k & 8) >> 1); return ((kk >> 3) * 4 + (c >> 5)) * 512 + ((kk & 7) * 32 + (c & 31)) * 2; }
__device__ __forceinline__ int v_rd_base(int lane) { return ((lane & 3) << 3) | (((lane >> 2) & 3) << 6) | (((lane >> 4) & 1) << 5) | (((lane >> 5) & 1) << 8); }
constexpr int v_rd_off(int d0, int ks, int half) { return d0 * 512 + ks * 4096 + half * 2048; }
__device__ __forceinline__ int crow(int r, int hi) { return (r & 3) + 8 * (r >> 2) + 4 * hi; }

template <int KB>
__device__ __forceinline__ void qkt(f32x16& p0, f32x16& p1, const char* K_lds, int r32, int hi, const char* qfrag, bool act) {
    if (!act) { const float NEG = -__builtin_inff();
#pragma unroll
        for (int r = 0; r < 16; ++r) { p0[r] = NEG; p1[r] = NEG; } return; }
    p0 = f32x16{}; p1 = f32x16{};
    const char* kb[4];
#pragma unroll
    for (int dd = 0; dd < 4; ++dd) kb[dd] = K_lds + KB * SHM_K + KSWZ(r32, (dd * 16 + hi * 8) * 2);
#pragma unroll
    for (int d0 = 0; d0 < 8; ++d0) { const char* a = kb[d0 & 3] + (d0 >> 2) * 128;
        bf16x8 b0 = *reinterpret_cast<const bf16x8*>(a);
        bf16x8 b1 = *reinterpret_cast<const bf16x8*>(a + 32 * 256);
        const bf16x8 q = *reinterpret_cast<const bf16x8*>(qfrag + d0 * 1024);
        p0 = __builtin_amdgcn_mfma_f32_32x32x16_bf16(b0, q, p0, 0, 0, 0);
        p1 = __builtin_amdgcn_mfma_f32_32x32x16_bf16(b1, q, p1, 0, 0, 0); }
}
template <int VB>
__device__ __forceinline__ void pv_tile(f32x16* o, int vb0, bf16x8 pa0, bf16x8 pa1, bf16x8 pa2, bf16x8 pa3, bool act) {
    if (!act) return;
#define TRRD(dst, off) asm volatile("ds_read_b64_tr_b16 %0, %1 offset:%2" : "=&v"(dst) : "v"(vb0), "i"(off) : "memory")
#define PV_D0(d0) do { s16x4 l0, l1, l2, l3, h0, h1, h2, h3; constexpr int b_ = VB * SHM_V + v_rd_off(d0, 0, 0); \
        TRRD(l0, b_); TRRD(h0, b_ + 2048); TRRD(l1, b_ + 4096); TRRD(h1, b_ + 6144); TRRD(l2, b_ + 8192); TRRD(h2, b_ + 10240); TRRD(l3, b_ + 12288); TRRD(h3, b_ + 14336); \
        asm volatile("s_waitcnt lgkmcnt(0)" ::: "memory"); SBAR(); \
        o[d0] = __builtin_amdgcn_mfma_f32_32x32x16_bf16(pa0, (bf16x8){l0[0], l0[1], l0[2], l0[3], h0[0], h0[1], h0[2], h0[3]}, o[d0], 0, 0, 0);   \
        o[d0] = __builtin_amdgcn_mfma_f32_32x32x16_bf16(pa1, (bf16x8){l1[0], l1[1], l1[2], l1[3], h1[0], h1[1], h1[2], h1[3]}, o[d0], 0, 0, 0);   \
        o[d0] = __builtin_amdgcn_mfma_f32_32x32x16_bf16(pa2, (bf16x8){l2[0], l2[1], l2[2], l2[3], h2[0], h2[1], h2[2], h2[3]}, o[d0], 0, 0, 0);   \
        o[d0] = __builtin_amdgcn_mfma_f32_32x32x16_bf16(pa3, (bf16x8){l3[0], l3[1], l3[2], l3[3], h3[0], h3[1], h3[2], h3[3]}, o[d0], 0, 0, 0); } while (0)
    PV_D0(0); PV_D0(1); PV_D0(2); PV_D0(3);
#undef PV_D0
#undef TRRD
}
__device__ __forceinline__ void sm_a(f32x16& p0) {
#pragma unroll
    for (int r = 0; r < 16; ++r) p0[r] = __builtin_amdgcn_exp2f(p0[r]);
}
__device__ __forceinline__ void sm_b(f32x16& p0, f32x16& p1, float& l_reg, bf16x8& pa0, bf16x8& pa1, bf16x8& pa2, bf16x8& pa3) {
#pragma unroll
    for (int r = 0; r < 16; ++r) p1[r] = __builtin_amdgcn_exp2f(p1[r]);
    float ps = 0;
#pragma unroll
    for (int r = 0; r < 16; ++r) ps += p0[r];
#pragma unroll
    for (int r = 0; r < 16; ++r) ps += p1[r];
    l_reg += ps;
#define PK4(P, B_, OUT) do { unsigned a0 = cvtpk(P[B_+0], P[B_+1]), a1 = cvtpk(P[B_+2], P[B_+3]); \
        unsigned b0 = cvtpk(P[B_+4], P[B_+5]), b1 = cvtpk(P[B_+6], P[B_+7]); \
        auto r0 = __builtin_amdgcn_permlane32_swap(a0, b0, false, false); auto r1 = __builtin_amdgcn_permlane32_swap(a1, b1, false, false); \
        v4u w = {r0[0], r1[0], r0[1], r1[1]}; OUT = *reinterpret_cast<bf16x8*>(&w); } while (0)
    PK4(p0, 0, pa0); PK4(p0, 8, pa1); PK4(p1, 0, pa2); PK4(p1, 8, pa3);
#undef PK4
}

__device__ __forceinline__ void attn_unit(Frame& F, const Args& args, int b, int h, int iq) {
    int tid = F.tid; asm volatile("" : "+v"(tid));
    const int wid = F.wave, lane = tid & 63, r32 = lane & 31, hi = lane >> 5;
    char* lds = F.ldsg;
    char* V_lds = lds; char* K_lds = lds + 2 * SHM_V;
    float* kml = (float*)(lds + XTRA_OFF);
    char* qfrag = lds + 65536 + wid * 8192 + lane * 16;
    const bf16* QR = WSP(bf16, WS_E) + 2 * E_STRIDE; const bf16* KN = WSP(bf16, WS_E) + 3 * E_STRIDE; const bf16* VV = WSP(bf16, WS_E) + 4 * E_STRIDE;
    bf16* YA = WSP(bf16, WS_YCAT) + 1024;
    const size_t mb = (size_t)b * SEQ;
    const int q0 = iq * 256, NT = 4 * (iq + 1);
    const bf16* Kh = KN + mb * DM + h * HD; const bf16* Vh = VV + mb * DM + h * HD;
    { const float* kmg = WSP(float, WS_KMEAN) + (size_t)(b * NH + h) * 16 * HD; for (int idx = tid; idx < iq * HD; idx += 512) kml[idx] = kmg[idx]; }
    const int sr = tid >> 4, sc = (tid & 15) * 8, vst0 = v_st(sr, sc), vst1 = v_st(32 + sr, sc), kws = KSWZ(sr, sc * 2);
    const int vb0 = (int)(uintptr_t)V_lds + v_rd_base(lane);
    bf16x8 st_v0, st_v1, st_k0, st_k1;
    const unsigned goff = (unsigned)(sr * DM + sc) * 2u;
#define ROWP(p, k0, rr) ((const char*)((p) + (size_t)((k0) + (rr)) * DM) + goff)
#define SLOAD(k0) do { st_v0 = *(const bf16x8*)ROWP(Vh, k0, 0); st_v1 = *(const bf16x8*)ROWP(Vh, k0, 32); st_k0 = *(const bf16x8*)ROWP(Kh, k0, 0); st_k1 = *(const bf16x8*)ROWP(Kh, k0, 32); } while (0)
#define SWRITE(bf) do { *(bf16x8*)(V_lds + (bf) * SHM_V + vst0) = st_v0; *(bf16x8*)(V_lds + (bf) * SHM_V + vst1) = st_v1; \
                        *(bf16x8*)(K_lds + (bf) * SHM_K + kws) = st_k0; *(bf16x8*)(K_lds + (bf) * SHM_K + kws + 32 * 256) = st_k1; } while (0)
    SLOAD(0);
    const size_t mq = mb + q0 + wid * 32 + r32;
    unsigned selmask;
    {
        bf16x8 qr[8];
        const bf16* qp = QR + mq * DM + h * HD + hi * 8;
        v4u raw[8];
#pragma unroll
        for (int d0 = 0; d0 < 8; ++d0) raw[d0] = *(const v4u*)(qp + d0 * 16);
        float ss = 0.f;
#pragma unroll
        for (int d0 = 0; d0 < 8; ++d0) { const float a0 = bflo(raw[d0].x), a1 = bfhi(raw[d0].x), a2 = bflo(raw[d0].y), a3 = bfhi(raw[d0].y), a4 = bflo(raw[d0].z), a5 = bfhi(raw[d0].z), a6 = bflo(raw[d0].w), a7 = bfhi(raw[d0].w);
            ss += (a0 * a0 + a1 * a1) + (a2 * a2 + a3 * a3) + (a4 * a4 + a5 * a5) + (a6 * a6 + a7 * a7); }
        ss += __shfl_xor(ss, 32);
        const float rs = C2 / sqrtf(ss * (1.f / HD) + EPS);
        const float* qg = IN_F(15) + hi * 8;
#define UNPK(f, W_) do { const v4u t_ = (W_); f[0] = bflo(t_.x); f[1] = bfhi(t_.x); f[2] = bflo(t_.y); f[3] = bfhi(t_.y); f[4] = bflo(t_.z); f[5] = bfhi(t_.z); f[6] = bflo(t_.w); f[7] = bfhi(t_.w); } while (0)
#define PACK(f) ({ v4u w_; w_.x = cvtpk(f[0], f[1]); w_.y = cvtpk(f[2], f[3]); w_.z = cvtpk(f[4], f[5]); w_.w = cvtpk(f[6], f[7]); *reinterpret_cast<bf16x8*>(&w_); })
        { float f0[8], f1[8]; UNPK(f0, raw[0]); UNPK(f1, raw[1]);
          const float* tg = WSP(float, WS_TRIG) + mq * 32 + hi * 8;
#pragma unroll
          for (int j = 0; j < 8; ++j) { const float x1 = f0[j] * rs * qg[j], x2 = f1[j] * rs * qg[16 + j], cs = tg[j], sn = tg[16 + j]; f0[j] = x1 * cs - x2 * sn; f1[j] = x2 * cs + x1 * sn; }
          qr[0] = PACK(f0); qr[1] = PACK(f1); }
#pragma unroll
        for (int d0 = 2; d0 < 8; ++d0) { float f[8]; UNPK(f, raw[d0]);
#pragma unroll
            for (int j = 0; j < 8; ++j) f[j] *= rs * qg[d0 * 16 + j];
            qr[d0] = PACK(f); }
        __syncthreads();
        float v1 = -__builtin_inff(), v2 = v1, v3 = v1; int i1 = 0, i2 = 0, i3 = 0;
#pragma unroll 1
        for (int jb = 0; jb < iq; ++jb) { const float* km = kml + jb * HD + hi * 8; float g = 0.f;
#pragma unroll
            for (int d0 = 0; d0 < 8; ++d0) { float f[8]; UNPK(f, *reinterpret_cast<const v4u*>(&qr[d0]));
                const f32x4 k0 = *(const f32x4*)(km + d0 * 16), k1 = *(const f32x4*)(km + d0 * 16 + 4);
                g += (f[0] * k0[0] + f[1] * k0[1]) + (f[2] * k0[2] + f[3] * k0[3]) + (f[4] * k1[0] + f[5] * k1[1]) + (f[6] * k1[2] + f[7] * k1[3]); }
            g += __shfl_xor(g, 32);
            if (g > v1) { v3 = v2; i3 = i2; v2 = v1; i2 = i1; v1 = g; i1 = jb; }
            else if (g > v2) { v3 = v2; i3 = i2; v2 = g; i2 = jb; }
            else if (g > v3) { v3 = g; i3 = jb; } }
#undef UNPK
#undef PACK
        selmask = 0u; if (iq >= 1) selmask |= 1u << i1; if (iq >= 2) selmask |= 1u << i2; if (iq >= 3) selmask |= 1u << i3;
#pragma unroll
        for (int d0 = 0; d0 < 8; ++d0) *reinterpret_cast<bf16x8*>(qfrag + d0 * 1024) = qr[d0];
    }
    float l_reg = 0.f; f32x16 o[4] = {};
    const int wrow0 = wid * 32;
#define ACT(t) (((t) >> 2) < iq ? (__ballot((selmask >> ((t) >> 2)) & 1u) != 0ull) : ((((t) - 4 * iq) * 64) <= wrow0 + 31))
#define MASKT(P0_, P1_, t) do { const int blk_ = (t) >> 2; const float NEG_ = -__builtin_inff(); \
        if (blk_ < iq) { if (!((selmask >> blk_) & 1u)) { _Pragma("unroll") for (int r = 0; r < 16; ++r) { P0_[r] = NEG_; P1_[r] = NEG_; } } } \
        else { const int kb_ = ((t) - 4 * iq) * 64; if (kb_ + 63 > wrow0) { int dq_ = wrow0 + r32 - kb_ - 4 * hi; asm volatile("" : "+v"(dq_)); \
            _Pragma("unroll") for (int r = 0; r < 16; ++r) { const int c_ = (r & 3) + 8 * (r >> 2); if (c_ > dq_) P0_[r] = NEG_; if (c_ + 32 > dq_) P1_[r] = NEG_; } } } } while (0)
    f32x16 pA0, pA1, pB0, pB1; bf16x8 pa0, pa1, pa2, pa3;
    VM_WAIT(); SWRITE(0); SBAR();
    SLOAD(64);
    __syncthreads();
    SBAR(); qkt<0>(pA0, pA1, K_lds, r32, hi, qfrag, ACT(0));
    MASKT(pA0, pA1, 0); sm_a(pA0);
    VM_WAIT(); SWRITE(1);
    __syncthreads();
#define HALF_STEP(PX0, PX1, PY0, PY1, t, KB, VB, SB) do { \
        SBAR(); qkt<KB>(PX0, PX1, K_lds, r32, hi, qfrag, ACT(t)); \
        sm_b(PY0, PY1, l_reg, pa0, pa1, pa2, pa3); SBAR(); \
        if ((t) + 1 < NT) { SLOAD(((t) + 1) * 64); SBAR(); } \
        pv_tile<VB>(o, vb0, pa0, pa1, pa2, pa3, ACT((t) - 1)); MASKT(PX0, PX1, (t)); sm_a(PX0); \
        __syncthreads(); \
        if ((t) + 1 < NT) { VM_WAIT(); SWRITE(SB); } \
        __syncthreads(); } while (0)
    for (int t = 1; t + 1 < NT; t += 2) {
        HALF_STEP(pB0, pB1, pA0, pA1, t, 1, 0, 0);
        HALF_STEP(pA0, pA1, pB0, pB1, t + 1, 0, 1, 1);
    }
    SBAR(); qkt<1>(pB0, pB1, K_lds, r32, hi, qfrag, ACT(NT - 1)); SBAR();
    sm_b(pA0, pA1, l_reg, pa0, pa1, pa2, pa3); SBAR();
    pv_tile<0>(o, vb0, pa0, pa1, pa2, pa3, ACT(NT - 2));
    MASKT(pB0, pB1, NT - 1); sm_a(pB0);
    sm_b(pB0, pB1, l_reg, pa0, pa1, pa2, pa3); SBAR();
    pv_tile<1>(o, vb0, pa0, pa1, pa2, pa3, ACT(NT - 1));
    l_reg += __shfl_xor(l_reg, 32);
    float* li_l = (float*)(lds + XTRA_OFF + 8192) + wid * 32;
    if (hi == 0) li_l[r32] = l_reg;
    asm volatile("s_waitcnt lgkmcnt(0)" ::: "memory");
    float rli[16];
#pragma unroll
    for (int r = 0; r < 16; ++r) rli[r] = __builtin_amdgcn_rcpf(li_l[crow(r, hi)]);
    bf16* Ow = YA + (mb + q0 + wid * 32) * 2048 + h * HD;
#pragma unroll
    for (int r = 0; r < 16; ++r) { const int orow = crow(r, hi);
#pragma unroll
        for (int d0 = 0; d0 < 4; ++d0) { const float v = o[d0][r] * rli[r]; const float vn = __shfl_xor(v, 1);
            if ((r32 & 1) == 0) *(unsigned*)(Ow + (size_t)orow * 2048 + d0 * 32 + r32) = cvtpk(v, vn); } }
    __syncthreads();
#undef ROWP
#undef SLOAD
#undef SWRITE
#undef ACT
#undef MASKT
#undef HALF_STEP
}
#undef KSWZ
}

__device__ __forceinline__ void p7_router(Frame& F, const Args& args) {
    LAS float* ssq = (LAS float*)F.lds;
    LAS float* par = (LAS float*)(F.lds + 2048);
    LAS float* lg = (LAS float*)(F.lds + 10240);
    LAS int* hist = (LAS int*)(F.lds + 77824 + 2048);
    LAS int* sel = (LAS int*)(F.lds + 77824 + 4096);
    const float* g2n = IN_F(6); const float* mod = WSP(float, WS_MOD); const float* brt = IN_F(21);
    unsigned char* H2 = WSP(unsigned char, WS_HB);
    unsigned* CNT = (unsigned*)(F.ws + WS_CTL) + CW_CNT;
    const int row = F.lane & 15, q = F.lane >> 4, kw = F.wave * 128;
    bf16x8 Bh[4][2], Bl[4][2];
    { const bf16* wh = WSP(bf16, WS_WRH) + (size_t)row * 1024 + kw + 8 * q; const bf16* wl = WSP(bf16, WS_WRL) + (size_t)row * 1024 + kw + 8 * q;
#pragma unroll
      for (int s = 0; s < 4; ++s) { Bh[s][0] = *(const bf16x8*)(wh + 32 * s); Bh[s][1] = *(const bf16x8*)(wh + 16384 + 32 * s); Bl[s][0] = *(const bf16x8*)(wl + 32 * s); Bl[s][1] = *(const bf16x8*)(wl + 16384 + 32 * s); } }
    for (int vw = F.vcu; vw < 256; vw += F.G) {
        const int m0 = vw * 64, b = m0 >> 12;
        for (int i = F.tid; i < 1024; i += 512) { par[i] = g2n[i] * (1.0f + mod[b * 6144 + 4096 + i]); par[1024 + i] = mod[b * 6144 + 3072 + i]; }
        if (F.tid < 32) hist[F.tid] = 0;
#pragma unroll
        for (int rt = 0; rt < 4; ++rt) { const float* xp = F.out + (size_t)(m0 + rt * 16 + row) * DM + kw + 8 * q; float ss = 0.f;
#pragma unroll
            for (int s = 0; s < 4; ++s) { const f32x4 x0 = *(const f32x4*)(xp + 32 * s), x1 = *(const f32x4*)(xp + 32 * s + 4); const f32x4 a = x0 * x0 + x1 * x1; ss += (a.x + a.y) + (a.z + a.w); }
            ss += __shfl_xor(ss, 16); ss += __shfl_xor(ss, 32);
            if (q == 0) ssq[F.wave * 64 + rt * 16 + row] = ss; }
        __syncthreads();
#pragma unroll
        for (int rt = 0; rt < 4; ++rt) { const int rl = rt * 16 + row; float tot = 0.f;
#pragma unroll
            for (int w = 0; w < 8; ++w) tot += ssq[w * 64 + rl];
            const float rstd = 1.0f / sqrtf(tot * (1.f / DM) + EPS);
            f32x4 acc0 = {0.f, 0.f, 0.f, 0.f}, acc1 = {0.f, 0.f, 0.f, 0.f};
            unsigned char* hp = H2 + (size_t)(m0 + rl) * DM + kw + 8 * q; const float* xp = F.out + (size_t)(m0 + rl) * DM + kw + 8 * q;
            f32x4 xq[4][2];
#pragma unroll
            for (int s = 0; s < 4; ++s) { xq[s][0] = *(const f32x4*)(xp + 32 * s); xq[s][1] = *(const f32x4*)(xp + 32 * s + 4); }
#pragma unroll
            for (int s = 0; s < 4; ++s) { const int col = kw + 32 * s + 8 * q; float h[8];
#pragma unroll
                for (int hf = 0; hf < 2; ++hf) { const f32x4 sc = *(const LAS f32x4*)(par + col + 4 * hf), sh = *(const LAS f32x4*)(par + 1024 + col + 4 * hf);
                    const f32x4 t = xq[s][hf] * rstd * sc + sh; h[4 * hf] = t.x; h[4 * hf + 1] = t.y; h[4 * hf + 2] = t.z; h[4 * hf + 3] = t.w; }
                v4u hi; hi.x = cvtpk(h[0], h[1]); hi.y = cvtpk(h[2], h[3]); hi.z = cvtpk(h[4], h[5]); hi.w = cvtpk(h[6], h[7]);
                { v2u h8; h8.x = pg8::pk_fp8x4(h[0], h[1], h[2], h[3]); h8.y = pg8::pk_fp8x4(h[4], h[5], h[6], h[7]); *(v2u*)(hp + 32 * s) = h8; }
                v4u lo; lo.x = cvtpk(h[0] - bflo(hi.x), h[1] - bfhi(hi.x)); lo.y = cvtpk(h[2] - bflo(hi.y), h[3] - bfhi(hi.y)); lo.z = cvtpk(h[4] - bflo(hi.z), h[5] - bfhi(hi.z)); lo.w = cvtpk(h[6] - bflo(hi.w), h[7] - bfhi(hi.w));
                const bf16x8 ah = *reinterpret_cast<bf16x8*>(&hi), al = *reinterpret_cast<bf16x8*>(&lo);
                acc0 = __builtin_amdgcn_mfma_f32_16x16x32_bf16(ah, Bh[s][0], acc0, 0, 0, 0); acc0 = __builtin_amdgcn_mfma_f32_16x16x32_bf16(ah, Bl[s][0], acc0, 0, 0, 0); acc0 = __builtin_amdgcn_mfma_f32_16x16x32_bf16(al, Bh[s][0], acc0, 0, 0, 0);
                acc1 = __builtin_amdgcn_mfma_f32_16x16x32_bf16(ah, Bh[s][1], acc1, 0, 0, 0); acc1 = __builtin_amdgcn_mfma_f32_16x16x32_bf16(ah, Bl[s][1], acc1, 0, 0, 0); acc1 = __builtin_amdgcn_mfma_f32_16x16x32_bf16(al, Bh[s][1], acc1, 0, 0, 0); }
#pragma unroll
            for (int r = 0; r < 4; ++r) { lg[(F.wave * 64 + rt * 16 + 4 * q + r) * 33 + row] = acc0[r]; lg[(F.wave * 64 + rt * 16 + 4 * q + r) * 33 + 16 + row] = acc1[r]; } }
        __syncthreads();
        { const int rowl = F.tid >> 3, eq = F.tid & 7; float v[4];
#pragma unroll
          for (int j = 0; j < 4; ++j) { float a = brt[4 * eq + j];
#pragma unroll
              for (int w = 0; w < 8; ++w) a += lg[(w * 64 + rowl) * 33 + 4 * eq + j];
              v[j] = a; }
          float tv[4]; int te[4];
#pragma unroll
          for (int k = 0; k < 4; ++k) { float gm = fmaxf(fmaxf(v[0], v[1]), fmaxf(v[2], v[3]));
              gm = fmaxf(gm, __shfl_xor(gm, 1)); gm = fmaxf(gm, __shfl_xor(gm, 2)); gm = fmaxf(gm, __shfl_xor(gm, 4));
              int ci = v[0] == gm ? 4 * eq : v[1] == gm ? 4 * eq + 1 : v[2] == gm ? 4 * eq + 2 : v[3] == gm ? 4 * eq + 3 : 99;
              ci = min(ci, __shfl_xor(ci, 1)); ci = min(ci, __shfl_xor(ci, 2)); ci = min(ci, __shfl_xor(ci, 4));
              te[k] = ci; tv[k] = gm;
#pragma unroll
              for (int j = 0; j < 4; ++j) if (ci == 4 * eq + j) v[j] = -__builtin_inff(); }
          if (eq == 0) { const float w1 = __expf(tv[1] - tv[0]), w2 = __expf(tv[2] - tv[0]), w3 = __expf(tv[3] - tv[0]); const float inv = 1.0f / (1.0f + w1 + w2 + w3);
              const float gk[4] = {inv, w1 * inv, w2 * inv, w3 * inv};
#pragma unroll
              for (int k = 0; k < 4; ++k) { const int lr = atomicAdd((int*)&hist[te[k]], 1); sel[rowl * 4 + k] = te[k]; sel[256 + rowl * 4 + k] = lr; sel[512 + rowl * 4 + k] = __float_as_int(gk[k]); } } }
        __syncthreads();
        if (F.tid < 32) { const int hc = hist[F.tid]; hist[32 + F.tid] = hc ? (int)__hip_atomic_fetch_add(CNT + F.tid, (unsigned)hc, RLX_AGENT) : 0; }
        __syncthreads();
        if (F.tid < 256) { const int e = sel[F.tid], pos = hist[32 + e] + sel[256 + F.tid], mm = m0 + (F.tid >> 2);
            WSP(int, WS_ROWTOK)[(size_t)e * ECAP + pos] = mm; WSP(int, WS_ROWGATE)[(size_t)e * ECAP + pos] = sel[512 + F.tid];
            WSP(int, WS_TOKE)[mm * 4 + (F.tid & 3)] = e; WSP(int, WS_TOKPOS)[mm * 4 + (F.tid & 3)] = pos; }
        __syncthreads();
    }
}

constexpr int MOE_TBL_OFF = XTRA_OFF, MOE_LIST_OFF = XTRA_OFF + 2048;
__device__ __forceinline__ int moe_tables(Frame& F) {
    LAS int* tbl = (LAS int*)(F.lds + MOE_TBL_OFF);
    const unsigned* CNT = (const unsigned*)(F.ws + WS_CTL) + CW_CNT;
    if (F.tid < 32) tbl[F.tid] = (int)__hip_atomic_load(CNT + F.tid, RLX_AGENT);
    __syncthreads();
    if (F.tid == 0) { int run = 0;
#pragma unroll 1
        for (int e = 0; e < 32; ++e) { tbl[32 + e] = run; const int nb = (tbl[e] + 255) >> 8;
#pragma unroll 1
            for (int bb = 0; bb < nb; ++bb) tbl[80 + run + bb] = e;
            run += nb; }
        tbl[64] = run; }
    __syncthreads();
    int nblk = tbl[64]; if (nblk > MAXBLK) nblk = MAXBLK; if (nblk < 1) nblk = 1;
    return __builtin_amdgcn_readfirstlane(nblk);
}

__device__ __forceinline__ void p11_combine(Frame& F, const Args& args) {
    (void)moe_tables(F);
    const LAS int* tbl = (const LAS int*)(F.lds + MOE_TBL_OFF);
    const float* mod = WSP(float, WS_MOD); const bf16* YR = WSP(bf16, WS_YR);
    const int gw = F.vcu * NWAVES + F.wave, NGW = F.G * NWAVES;
    for (int m = gw; m < NTOK; m += NGW) {
        const int b = m >> 12;
        int dk = 0; if (F.lane < 4) { const int e = __hip_atomic_load(WSP(int, WS_TOKE) + m * 4 + F.lane, RLX_AGENT); dk = tbl[32 + e] * 256 + __hip_atomic_load(WSP(int, WS_TOKPOS) + m * 4 + F.lane, RLX_AGENT); }
        const int d0 = __shfl(dk, 0), d1 = __shfl(dk, 1), d2 = __shfl(dk, 2), d3 = __shfl(dk, 3);
        f32x4* xr = (f32x4*)(F.out + (size_t)m * DM) + F.lane;
#pragma unroll
        for (int j = 0; j < 4; ++j) { const int col = 4 * F.lane + 256 * j;
            const v2u y0 = *(const v2u*)(YR + (size_t)d0 * DM + col), y1 = *(const v2u*)(YR + (size_t)d1 * DM + col), y2 = *(const v2u*)(YR + (size_t)d2 * DM + col), y3 = *(const v2u*)(YR + (size_t)d3 * DM + col);
            f32x4 s;
            s.x = (bflo(y0.x) + bflo(y1.x)) + (bflo(y2.x) + bflo(y3.x)); s.y = (bfhi(y0.x) + bfhi(y1.x)) + (bfhi(y2.x) + bfhi(y3.x));
            s.z = (bflo(y0.y) + bflo(y1.y)) + (bflo(y2.y) + bflo(y3.y)); s.w = (bfhi(y0.y) + bfhi(y1.y)) + (bfhi(y2.y) + bfhi(y3.y));
            const f32x4 g2 = *(const f32x4*)(mod + b * 6144 + 5120 + col);
            xr[64 * j] = xr[64 * j] + g2 * s; }
    }
}

#ifndef MK_N_LAUNCHES
#define MK_N_LAUNCHES 1
#endif
constexpr int PER_PHASE = 12;
constexpr int N_LAUNCHES = MK_N_LAUNCHES;

__global__ void __launch_bounds__(NWAVES * 64, 2) hybrid_fwd(Args args) {
    extern __shared__ __attribute__((aligned(16))) unsigned char lds[];
    Frame F;
    F.lds = (LAS unsigned char*)lds; F.ldsg = (char*)lds;
    F.MISC = (volatile LAS unsigned*)(F.lds + MISC_OFF);
    F.tid = threadIdx.x; F.lane = F.tid & 63; F.wave = __builtin_amdgcn_readfirstlane(F.tid >> 6);
    F.G = gridDim.x; { const int bx = blockIdx.x; F.vcu = (F.G % 8 == 0) ? (bx % 8) * (F.G / 8) + bx / 8 : bx; }
    F.ws = args.ws; F.out = args.out;
    gu32* ctl = (gu32*)(args.ws + WS_CTL);
    for (int u = F.tid; u < (LDS_BYTES - LDSCTL_OFF) / 4; u += NWAVES * 64) ((LAS unsigned*)(F.lds + LDSCTL_OFF))[u] = 0u;
    __syncthreads();
    XcdBarrier bar; bar.bar = (unsigned*)(ctl + CW_BAR); bar.x = 0; bar.st = nullptr;
    if (N_LAUNCHES == 1) bar = xcd_barrier_post((unsigned*)(ctl + CW_BAR), F.MISC + 8);
    const int lo = args.ph_lo, hi = args.ph_hi;
#ifndef PHASE_MASK
#define PHASE_MASK 0xFFF
#endif
#define IN(k) (((PHASE_MASK >> (k)) & 1) && lo <= (k) && (k) < hi)
#define NEXTP(k) ((k) == 0 ? 2 : (k) == 7 ? 9 : (k) + 1)
#define SEAM(k) do { if (IN(k) && IN(NEXTP(k))) xcd_barrier(bar); } while (0)

#ifndef DUP_MASK
#define DUP_MASK 0
#endif
#define PHASE(k, ...) do { if (IN(k)) { __VA_ARGS__ if ((DUP_MASK >> (k)) & 1) { xcd_barrier(bar); __VA_ARGS__ } } SEAM(k); } while (0)
    PHASE(0, { p0_prologue(F, args); p1_hrows(F, args); });
    PHASE(2, {
        { pg8::Gemm g{WSP(bf16, WS_HB), WSP(bf16, WS_WIN), NTOK, 3072, DM}; pg8::TileOrder S; S.init(NTOK / 256, 12, F.G, (int)blockIdx.x, nullptr);
          pg8::EpiWin E{WSP(bf16, WS_E), IN_F(17), 0};
          pg8::gemm_phase<pg8::EpiWin, pg8::TileOrder, true, true>(F.lds + RING_OFF, g, S, E); }
        { pg8::Gemm g{WSP(bf16, WS_H8), WSP(bf16, WS_WIN8), NTOK, 4096, DM / 2}; pg8::TileOrder S; S.init(NTOK / 256, 16, F.G, (int)blockIdx.x, nullptr);
          pg8::EpiWin E{WSP(bf16, WS_E), IN_F(17), 1};
          pg8::gemm_phase<pg8::EpiWin, pg8::TileOrder, true, true, false, true>(F.lds + RING_OFF, g, S, E); }
    });
    int p3rep = 0;
    PHASE(3, {
        for (int u = F.vcu; u < 512; u += F.G) p3_rnn_local_unit(F, args, u);
        if (p3rep++ == 0) { for (int u = F.vcu; u < 512; u += F.G) p3_knorm_unit(F, args, u); }
    });
    PHASE(4, {
        for (int it = F.vcu; it < 256; it += F.G) { const int bh = it >> 3, s = it & 7;
            for (int pass = 0; pass < 2; ++pass) att::attn_unit(F, args, bh >> 3, bh & 7, pass ? s : 15 - s); }
        for (int u = F.vcu; u < 512; u += F.G) p4_rnn_final_unit(F, args, u);
    });
    PHASE(5, {
        pg8::Gemm g{WSP(bf16, WS_YCAT), WSP(bf16, WS_WB), NTOK, DM, 2 * DM}; pg8::TileOrder S; S.init(NTOK / 256, DM / 256, F.G, (int)blockIdx.x, nullptr);
        pg8::EpiBranch E{WSP(bf16, WS_E) + 5 * E_STRIDE, WSP(bf16, WS_E) + 6 * E_STRIDE, WSP(bf16, WS_HB)};
        pg8::gemm_phase<pg8::EpiBranch, pg8::TileOrder, false, true>(F.lds + RING_OFF, g, S, E);
    });
    PHASE(6, {
        pg8::Gemm g{WSP(bf16, WS_HB), WSP(bf16, WS_WO), NTOK, DM, DM}; pg8::TileOrder S; S.init(NTOK / 256, DM / 256, F.G, (int)blockIdx.x, nullptr);
        pg8::EpiWout E{IN_F(0), F.out, WSP(float, WS_MOD)};
        pg8::gemm_phase<pg8::EpiWout, pg8::TileOrder, false, true>(F.lds + RING_OFF, g, S, E);
    });
    PHASE(7, { p7_router(F, args); p8_moe_weights(F, args); });
    PHASE(9, {
        const int nblk = moe_tables(F);
        const LAS int* tbl = (const LAS int*)(F.lds + MOE_TBL_OFF); LAS int* lists = (LAS int*)(F.lds + MOE_LIST_OFF);
        pg8::Gemm g{WSP(bf16, WS_HB), WSP(bf16, WS_WUP), RMAX, 2048 * NEXP, DM / 2}; pg8::TileOrder S; S.init(nblk, 8, F.G, (int)blockIdx.x, tbl + 80);
        { pg8::Unit u; for (int i = 0; i < 9 && S.next(i, u); ++i) { if (F.tid < 256) { const int e = u.pn >> 3, pos = (u.pm - tbl[32 + e]) * 256 + F.tid;
              lists[i * 256 + F.tid] = pos < tbl[e] ? __hip_atomic_load(WSP(int, WS_ROWTOK) + (size_t)e * ECAP + pos, RLX_AGENT) : 0; } } }
        __syncthreads();
        pg8::EpiUp E{WSP(unsigned char, WS_ACT), IN_F(23)};
        pg8::gemm_phase<pg8::EpiUp, pg8::TileOrder, true, true, true, true>(F.lds + RING_OFF, g, S, E, lists);
    });
    PHASE(10, {
        const int nblk = moe_tables(F);
        const LAS int* tbl = (const LAS int*)(F.lds + MOE_TBL_OFF);
        pg8::Gemm g{WSP(bf16, WS_ACT), WSP(bf16, WS_WDN), RMAX, 1024 * NEXP, DM / 2}; pg8::TileOrder S; S.init(nblk, 4, F.G, (int)blockIdx.x, tbl + 80);
        pg8::EpiDown E{WSP(bf16, WS_YR), IN_F(25), WSP(float, WS_ROWGATE), tbl};
        pg8::gemm_phase<pg8::EpiDown, pg8::TileOrder, true, true, false, true>(F.lds + RING_OFF, g, S, E);
    });
    PHASE(11, { p11_combine(F, args); });
#undef PHASE
#undef IN
#undef SEAM
}

extern "C" void kernel_launch(void* const* d_in, const int* in_sizes, int n_in, void* d_out, int out_size, void* d_ws, size_t ws_size, hipStream_t stream) {
    static int grid = 0;
    if (grid == 0) {
        if (n_in != 26 || in_sizes[0] != NTOK * DM || out_size != NTOK * DM || ws_size < WS_END) {
            fprintf(stderr, "kernel_launch: shape/workspace mismatch (n_in %d, in0 %d, out %d, ws %zu; need ws >= %zu); nothing launched\n", n_in, n_in > 0 ? in_sizes[0] : -1, out_size, ws_size, (size_t)WS_END); grid = -1; return; }
        int dev = 0, cus = 0, per_cu = 0;
        if (hipGetDevice(&dev) != hipSuccess || hipDeviceGetAttribute(&cus, hipDeviceAttributeMultiprocessorCount, dev) != hipSuccess) { fprintf(stderr, "kernel_launch: device query failed\n"); grid = -1; return; }
        if (hipFuncSetAttribute((const void*)hybrid_fwd, hipFuncAttributeMaxDynamicSharedMemorySize, LDS_BYTES) != hipSuccess) { fprintf(stderr, "kernel_launch: hipFuncSetAttribute failed\n"); grid = -1; return; }
        if (hipOccupancyMaxActiveBlocksPerMultiprocessor(&per_cu, (const void*)hybrid_fwd, NWAVES * 64, LDS_BYTES) != hipSuccess || per_cu < 1) { fprintf(stderr, "kernel_launch: occupancy query says %d blocks/CU\n", per_cu); per_cu = 1; }
        (void)hipGetLastError();
        grid = cus;
        if (grid > 256) grid = 256;
    }
    if (grid < 0) return;
    (void)hipMemsetAsync((char*)d_ws + WS_CTL, 0, CTL_ZERO_BYTES, stream);
    Args a{};
    for (int i = 0; i < 26; ++i) a.in[i] = d_in[i];
    a.out = (float*)d_out; a.ws = (unsigned char*)d_ws;
    for (int li = 0; li < N_LAUNCHES; ++li) {
        a.ph_lo = (N_LAUNCHES == 1) ? 0 : li; a.ph_hi = (N_LAUNCHES == 1) ? PER_PHASE : li + 1;
        hipLaunchKernelGGL(hybrid_fwd, dim3(grid), dim3(NWAVES * 64), LDS_BYTES, stream, a);
        const hipError_t le = hipPeekAtLastError();
        if (le != hipSuccess) { fprintf(stderr, "kernel_launch: launch %d failed: %s\n", li, hipGetErrorName(le)); break; }
    }
}
```

```cpp
#include <hip/hip_runtime.h>
#include <hip/hip_bf16.h>
#include <cstdio>
#include <cstdint>
#include <cmath>
namespace pg8 {
#define PG8_LAS __attribute__((address_space(3)))
typedef unsigned short bf16_t;
typedef short bf16x8 __attribute__((ext_vector_type(8)));
typedef float f32x4 __attribute__((ext_vector_type(4)));
typedef unsigned u32x4 __attribute__((ext_vector_type(4)));
constexpr int BM = 256, BK = 64, HALF = 128, HTB = HALF * BK * 2  , STAGE_BYTES = 8 * HTB, NXCD = 8, WGM = 8;

__host__ __device__ __forceinline__ int lds_byte(int r, int c) { const int st = (r >> 4) * 2 + (c >> 5), rr = r & 15, cc = c & 31, ob = rr * 64 + cc * 2; return st * 1024 + (ob ^ (((ob >> 9) & 1) << 5)); }
__host__ __device__ __forceinline__ void stage_rc(int b, int& R, int& C) { const int st = b / 1024, sb = b % 1024, swz = sb ^ (((sb >> 9) & 1) << 5); R = (st >> 1) * 16 + swz / 64; C = (st & 1) * 32 + (swz % 64) / 2; }
__host__ __device__ __forceinline__ int perm32(int rho) { const int n = rho >> 4, i = rho & 15; return 8 * (i >> 2) + 4 * n + (i & 3); }

struct Unit { int pm, pn, kind; };
struct Gemm { const bf16_t* A; const bf16_t* Bt; int M, N, K; };

struct StaticOrder {
    int nM, nN, nwg, G, c;
    __host__ __device__ void init(int M, int N, int G_, int c_) { nM = M / BM; nN = N / BM; nwg = nM * nN; G = G_; c = c_; }
    __host__ __device__ bool next(int i, Unit& u) const {
        const long L = (long)i * G + c; if (L >= nwg) return false;
        int wgid = (int)L; { const int q = nwg / NXCD, r = nwg % NXCD, xcd = wgid % NXCD, off = wgid / NXCD; wgid = (xcd < r ? xcd * (q + 1) : r * (q + 1) + (xcd - r) * q) + off; }
        const int nig = WGM * nN, gid = wgid / nig, fm = gid * WGM, gsz = (nM - fm) < WGM ? (nM - fm) : WGM;
        u.pm = fm + ((wgid % nig) % gsz); u.pn = (wgid % nig) / gsz; return true;
    }
    __device__ __forceinline__ void a_ready(const Unit&) const {}
    __device__ __forceinline__ void done(const Unit&) const {}
};

__device__ __forceinline__ unsigned cvt_pk_bf16(float lo, float hi) { unsigned r; asm volatile("v_cvt_pk_bf16_f32 %0, %1, %2" : "=v"(r) : "v"(lo), "v"(hi)); return r; }
typedef int v4i_t __attribute__((ext_vector_type(4)));
typedef int v8i_t __attribute__((ext_vector_type(8)));
template <class Epi, class Sched, bool ALIGN_EPI = false, bool SP2 = false, bool GATHER = false, bool FP8 = false>
__device__ __forceinline__ void gemm_phase(PG8_LAS unsigned char* lds, const Gemm g, const Sched& S, const Epi& E, const PG8_LAS int* rowlists = nullptr) {
    static_assert(!GATHER || SP2, "GATHER is implemented for the SP2 loop");
    const int tid = threadIdx.x, wid = __builtin_amdgcn_readfirstlane(tid >> 6), lane = tid & 63, wr = wid >> 2, wc = wid & 3, fr = lane & 15, fq = lane >> 4;
    const int K = g.K, nt = K / BK;
    unsigned voffA, voffB; int gR, gC;
    { int R, C; stage_rc(tid * 16, R, C); const int Rb = Epi::PERM ? ((R & ~31) + perm32(R & 31)) : R; gR = R; gC = C;
      voffA = (unsigned)(R * K + C) * 2u; voffB = (unsigned)(Rb * K + C) * 2u; }
    const size_t row64 = (size_t)64 * K * 2;
    const size_t kstep = (size_t)(BK * 2);
    const size_t hstep = (size_t)HALF * K * 2;
    const size_t tstep = 2 * hstep;
    const unsigned ldsw = (unsigned)wid * 1024u;
    const int aoff = lds_byte(wr * 64 + fr, fq * 8), boff = lds_byte(wc * 32 + fr, fq * 8);
#define PG8_SA(b, h) (((b) * 2 + (h)) * HTB)
#define PG8_SB(b, h) ((4 + (b) * 2 + (h)) * HTB)
#define PG8_STAGE2(bufoff, gbase, v0_, v1_) do { unsigned vo0_ = (v0_), vo1_ = (v1_); asm volatile("" : "+v"(vo0_), "+v"(vo1_));     \
        __builtin_amdgcn_global_load_lds((const unsigned*)((const char*)(gbase) + vo0_), (PG8_LAS unsigned*)(lds + (bufoff) + ldsw), 16, 0, 0); \
        __builtin_amdgcn_global_load_lds((const unsigned*)((const char*)(gbase) + vo1_), (PG8_LAS unsigned*)(lds + (bufoff) + ldsw + 8192), 16, 0, 0); } while (0)
#define PG8_STAGE(bufoff, gbase, voff) do { unsigned vo_ = (voff); asm volatile("" : "+v"(vo_)); \
        __builtin_amdgcn_global_load_lds((const unsigned*)((const char*)(gbase) + vo_), (PG8_LAS unsigned*)(lds + (bufoff) + ldsw), 16, 0, 0); \
        __builtin_amdgcn_global_load_lds((const unsigned*)((const char*)(gbase) + row64 + vo_), (PG8_LAS unsigned*)(lds + (bufoff) + ldsw + 8192), 16, 0, 0); } while (0)
#define PG8_LDA(dst, b, h) do { _Pragma("unroll") for (int m = 0; m < 4; ++m) _Pragma("unroll") for (int k = 0; k < 2; ++k) dst[m][k] = *(const PG8_LAS bf16x8*)(lds + PG8_SA(b, h) + aoff + m * 2048 + k * 1024); } while (0)
#define PG8_LDB(dst, b, h) do { _Pragma("unroll") for (int n = 0; n < 2; ++n) _Pragma("unroll") for (int k = 0; k < 2; ++k) dst[n][k] = *(const PG8_LAS bf16x8*)(lds + PG8_SB(b, h) + boff + n * 2048 + k * 1024); } while (0)
#define PG8_CAT8(x, y) __builtin_shufflevector(__builtin_bit_cast(v4i_t, (x)), __builtin_bit_cast(v4i_t, (y)), 0, 1, 2, 3, 4, 5, 6, 7)
#define PG8_MMA(ai, bj, At, Bt) do { __builtin_amdgcn_s_setprio(1); _Pragma("unroll") for (int m = 0; m < 4; ++m) _Pragma("unroll") for (int n = 0; n < 2; ++n) { \
        if constexpr (FP8) { const v8i_t a8_ = PG8_CAT8(Bt[n][0], Bt[n][1]), b8_ = PG8_CAT8(At[m][0], At[m][1]);     \
            asm volatile("v_mfma_scale_f32_16x16x128_f8f6f4 %0, %1, %2, %0, %3, %4 op_sel_hi:[0,0,0]" : "+v"(acc[ai][bj][m][n]) : "v"(a8_), "v"(b8_), "v"(mxsa_), "v"(mxsb_)); } \
        else { _Pragma("unroll") for (int k = 0; k < 2; ++k) acc[ai][bj][m][n] = __builtin_amdgcn_mfma_f32_16x16x32_bf16(Bt[n][k], At[m][k], acc[ai][bj][m][n], 0, 0, 0); } } \
        __builtin_amdgcn_s_setprio(0); } while (0)
#define PG8_WAIT_V(n) asm volatile("s_waitcnt vmcnt(" #n ")" ::: "memory")
#define PG8_WAIT_VN(n) asm volatile("s_waitcnt vmcnt(%0)" :: "i"(n) : "memory")
#define PG8_WAIT_L(n) asm volatile("s_waitcnt lgkmcnt(" #n ")" ::: "memory")
#define PG8_BAR __builtin_amdgcn_s_barrier()
#define PG8_SCHED __builtin_amdgcn_sched_barrier(0)
    Unit cur, nxt; int ui = 0;
    if (!S.next(0, cur)) return;
    int mxsa_ = 121, mxsb_ = 127; asm volatile("" : "+v"(mxsa_), "+v"(mxsb_));
    f32x4 acc[2][2][4][2];
#pragma unroll
    for (int a = 0; a < 2; ++a)
#pragma unroll
        for (int b = 0; b < 2; ++b)
#pragma unroll
            for (int m = 0; m < 4; ++m)
#pragma unroll
                for (int n = 0; n < 2; ++n) acc[a][b][m][n] = (f32x4){0.f, 0.f, 0.f, 0.f};
    bf16x8 At[4][2], B0[2][2], B1[2][2];
    const char* cA = GATHER ? (const char*)S.a_base(cur) : (const char*)g.A + (size_t)cur.pm * tstep; const char* cB = (const char*)g.Bt + (size_t)cur.pn * tstep;
#define PG8_STAGE_A(bufoff, kptr, half, unx) do { if constexpr (GATHER) { const PG8_LAS int* rl_ = rowlists + (ui + (unx)) * 256 + (half) * HALF + gR; \
        PG8_STAGE2(bufoff, kptr, (unsigned)(rl_[0] * K + gC) * 2u, (unsigned)(rl_[64] * K + gC) * 2u); } \
        else { PG8_STAGE(bufoff, (kptr) + (half) * hstep, voffA); } } while (0)
    S.a_ready(cur);
    if constexpr (SP2) {
        PG8_STAGE(PG8_SB(0, 0), cB, voffB); PG8_STAGE(PG8_SB(0, 1), cB + hstep, voffB); PG8_STAGE_A(PG8_SA(0, 0), cA, 0, 0); PG8_STAGE_A(PG8_SA(0, 1), cA, 1, 0);
        if (wr == 1) PG8_BAR;
        PG8_WAIT_V(2); PG8_BAR;
        PG8_STAGE(PG8_SB(1, 0), cB + kstep, voffB); PG8_STAGE_A(PG8_SA(1, 0), cA + kstep, 0, 0); PG8_STAGE(PG8_SB(1, 1), cB + hstep + kstep, voffB);
        PG8_WAIT_V(6); PG8_BAR;
    } else {
        PG8_STAGE(PG8_SB(0, 0), cB, voffB); PG8_STAGE(PG8_SA(0, 0), cA, voffA); PG8_STAGE(PG8_SB(0, 1), cB + hstep, voffB); PG8_STAGE(PG8_SA(0, 1), cA + hstep, voffA);
        if (wr == 1) PG8_BAR;
        PG8_WAIT_V(4); PG8_BAR;
        PG8_STAGE(PG8_SB(1, 0), cB + kstep, voffB); PG8_STAGE(PG8_SA(1, 0), cA + kstep, voffA); PG8_STAGE(PG8_SB(1, 1), cB + hstep + kstep, voffB);
        PG8_WAIT_V(6); PG8_BAR;
    }
    for (;;) {
        const bool has_next = S.next(ui + 1, nxt);
        const char* nA = GATHER ? (has_next ? (const char*)S.a_base(nxt) : cA) : (has_next ? (const char*)g.A + (size_t)nxt.pm * tstep : cA);
        const char* nB = has_next ? (const char*)g.Bt + (size_t)nxt.pn * tstep : cB;
#pragma unroll 1
        for (int t = 0; t < nt; t += 2) {
            const bool last = (t == nt - 2);
            if constexpr (Epi::MIDK) { if (t == (nt >> 1)) { if constexpr (FP8) asm volatile("s_nop 15\n\ts_nop 7" ::: "memory"); E.mid(acc, cur, wr, wc, fr, fq); } }
            const char* a1 = cA + (size_t)(t + 1) * kstep;
            const char* a2 = last ? nA : cA + (size_t)(t + 2) * kstep; const char* b2 = last ? nB : cB + (size_t)(t + 2) * kstep;
            const char* a3 = a2 + kstep; const char* b3 = b2 + kstep;
            if (last && has_next) S.a_ready(nxt);
            const int unx = (GATHER && last && has_next) ? 1 : 0;
            if constexpr (SP2) {
            PG8_LDB(B0, 0, 0); PG8_LDB(B1, 0, 1); PG8_SCHED; PG8_LDA(At, 0, 0); PG8_STAGE_A(PG8_SA(1, 1), a1, 1, 0);
            PG8_WAIT_V(8); PG8_WAIT_L(0); PG8_BAR; PG8_MMA(0, 0, At, B0); PG8_MMA(0, 1, At, B1); PG8_BAR; PG8_SCHED;
            PG8_LDA(At, 0, 1); PG8_STAGE(PG8_SB(0, 0), b2, voffB); PG8_STAGE(PG8_SB(0, 1), b2 + hstep, voffB); PG8_STAGE_A(PG8_SA(0, 0), a2, 0, unx);
            PG8_WAIT_V(8); PG8_WAIT_L(0); PG8_BAR; PG8_MMA(1, 0, At, B0); PG8_MMA(1, 1, At, B1); PG8_BAR; PG8_SCHED;
            PG8_LDB(B0, 1, 0); PG8_LDB(B1, 1, 1); PG8_SCHED; PG8_LDA(At, 1, 0); PG8_STAGE_A(PG8_SA(0, 1), a2, 1, unx);
            PG8_WAIT_V(8); PG8_WAIT_L(0); PG8_BAR; PG8_MMA(0, 0, At, B0); PG8_MMA(0, 1, At, B1); PG8_BAR; PG8_SCHED;
            PG8_LDA(At, 1, 1); PG8_STAGE(PG8_SB(1, 0), b3, voffB); PG8_STAGE(PG8_SB(1, 1), b3 + hstep, voffB); PG8_STAGE_A(PG8_SA(1, 0), a3, 0, unx);
            PG8_WAIT_V(8); PG8_WAIT_L(0); PG8_BAR; PG8_MMA(1, 0, At, B0); PG8_MMA(1, 1, At, B1); PG8_BAR; PG8_SCHED;
            } else {
            PG8_LDB(B0, 0, 0); PG8_SCHED; PG8_LDA(At, 0, 0); PG8_STAGE(PG8_SA(1, 1), a1 + hstep, voffA);
            PG8_WAIT_L(8); PG8_BAR; PG8_WAIT_L(0); PG8_MMA(0, 0, At, B0); PG8_BAR; PG8_SCHED;
            PG8_LDB(B1, 0, 1); PG8_STAGE(PG8_SB(0, 0), b2, voffB);
            PG8_BAR; PG8_WAIT_L(0); PG8_MMA(0, 1, At, B1); PG8_BAR;
            PG8_LDA(At, 0, 1); PG8_STAGE(PG8_SA(0, 0), a2, voffA);
            PG8_BAR; PG8_WAIT_L(0); PG8_MMA(1, 0, At, B0); PG8_BAR; PG8_SCHED;
            PG8_STAGE(PG8_SB(0, 1), b2 + hstep, voffB);
            PG8_WAIT_V(6); PG8_BAR; PG8_MMA(1, 1, At, B1); PG8_BAR;
            PG8_LDB(B0, 1, 0); PG8_SCHED; PG8_LDA(At, 1, 0); PG8_STAGE(PG8_SA(0, 1), a2 + hstep, voffA);
            PG8_WAIT_L(8); PG8_BAR; PG8_WAIT_L(0); PG8_MMA(0, 0, At, B0); PG8_BAR; PG8_SCHED;
            PG8_LDB(B1, 1, 1); PG8_STAGE(PG8_SB(1, 0), b3, voffB);
            PG8_BAR; PG8_WAIT_L(0); PG8_MMA(0, 1, At, B1); PG8_BAR;
            PG8_LDA(At, 1, 1); PG8_STAGE(PG8_SA(1, 0), a3, voffA);
            PG8_BAR; PG8_WAIT_L(0); PG8_MMA(1, 0, At, B0); PG8_BAR; PG8_SCHED;
            PG8_STAGE(PG8_SB(1, 1), b3 + hstep, voffB);
            PG8_WAIT_V(6); PG8_BAR; PG8_MMA(1, 1, At, B1); PG8_BAR;
            }
        }
        if constexpr (ALIGN_EPI) { if (wr == 0) PG8_BAR; }
        if constexpr (FP8) asm volatile("s_nop 15\n\ts_nop 7" ::: "memory");
        if constexpr (!Epi::AFTER_DRAIN) { E(acc, cur, wr, wc, fr, fq); S.done(cur); }
        if (!has_next) break;
#pragma unroll
        for (int a = 0; a < 2; ++a)
#pragma unroll
            for (int b = 0; b < 2; ++b)
#pragma unroll
                for (int m = 0; m < 4; ++m)
#pragma unroll
                    for (int n = 0; n < 2; ++n) acc[a][b][m][n] = (f32x4){0.f, 0.f, 0.f, 0.f};
        cur = nxt; cA = nA; cB = nB; ++ui;
        if constexpr (ALIGN_EPI) { if (wr == 1) PG8_BAR; }
    }
    PG8_WAIT_V(0);
    if constexpr (!ALIGN_EPI) { if (wr == 0) PG8_BAR; }
    PG8_BAR;
    if constexpr (Epi::AFTER_DRAIN) { E.fused(acc, cur, wr, wc, fr, fq, lds, wid, lane); S.done(cur); }
#undef PG8_SA
#undef PG8_STAGE_A
#undef PG8_SB
#undef PG8_STAGE
#undef PG8_STAGE2
#undef PG8_LDA
#undef PG8_LDB
#undef PG8_MMA
#undef PG8_CAT8
#undef PG8_WAIT_V
#undef PG8_WAIT_VN
#undef PG8_WAIT_L
#undef PG8_BAR
#undef PG8_SCHED
}
}

constexpr int NB = 4, SEQ = 4096, DM = 1024, NTOK = NB * SEQ, DIN = 7168, NH = 8, HD = 128;
constexpr int NEXP = 32, TOPK = 4, MAXBLK = 288, RMAX = MAXBLK * 256;
constexpr float EPS = 1e-6f;
constexpr int NWAVES = 8;

constexpr size_t MiB = 1u << 20, KiB = 1u << 10;
constexpr size_t WS_CTL = 0, CTL_ZERO_BYTES = 1 * MiB;
constexpr size_t WS_MOD = 1 * MiB;
constexpr size_t WS_KMEAN = 1 * MiB + 128 * KiB;
constexpr size_t WS_AGGP = 1 * MiB + 384 * KiB;
constexpr size_t WS_AGGH = 1 * MiB + 640 * KiB;
constexpr size_t WS_WRH = 2 * MiB, WS_WRL = 2 * MiB + 64 * KiB;
constexpr size_t WS_TOKE = 3 * MiB, WS_TOKPOS = 3 * MiB + 256 * KiB;
constexpr int ECAP = 16384;
constexpr size_t WS_ROWTOK = 28 * MiB, WS_ROWGATE = 30 * MiB;
constexpr int CW_UPDONE = 16384;
constexpr int CW_CNT = 8192;
constexpr size_t WS_TRIG = 4 * MiB;
constexpr size_t WS_WRG = 6 * MiB;
constexpr size_t WS_WIN = 8 * MiB;
constexpr size_t WS_WIN8 = 16 * MiB;
constexpr size_t WS_H8 = 544 * MiB;
constexpr size_t WS_WB = 22 * MiB;
constexpr size_t WS_WO = 26 * MiB;
constexpr size_t WS_WUP = 32 * MiB;
constexpr size_t WS_WDN = 96 * MiB;
constexpr size_t WS_HB = 224 * MiB;
constexpr size_t WS_E = 256 * MiB;
constexpr size_t E_STRIDE = (size_t)NTOK * DM;
constexpr size_t WS_HL = 480 * MiB, WS_PP = 512 * MiB, WS_YCAT = 544 * MiB;
constexpr int CW_MODCNT = 8256;
constexpr size_t WS_ACT = 400 * MiB, WS_YR = 544 * MiB;
constexpr size_t WS_END = 688 * MiB;
constexpr int CW_BAR = 4096;

constexpr int RING_OFF = 0, RING_BYTES = 131072;
constexpr int LDSCTL_OFF = RING_BYTES, MISC_OFF = LDSCTL_OFF + 320;
constexpr int XTRA_OFF = LDSCTL_OFF + 1024;
constexpr int LDS_BYTES = 155648;

#define GAS __attribute__((address_space(1)))
#define LAS __attribute__((address_space(3)))
typedef unsigned short bf16;
typedef unsigned v4u __attribute__((ext_vector_type(4)));
typedef unsigned v2u __attribute__((ext_vector_type(2)));
typedef float f32x4 __attribute__((ext_vector_type(4)));
typedef float f32x2 __attribute__((ext_vector_type(2)));
typedef float f32x16 __attribute__((ext_vector_type(16)));
typedef short bf16x8 __attribute__((ext_vector_type(8)));
typedef short s16x4 __attribute__((ext_vector_type(4)));
typedef GAS unsigned gu32;
#define RLX_AGENT __ATOMIC_RELAXED, __HIP_MEMORY_SCOPE_AGENT
#define LDS_WAIT() asm volatile("s_waitcnt lgkmcnt(0)" ::: "memory")
#define VM_WAIT() asm volatile("s_waitcnt vmcnt(0)" ::: "memory")
#define SBAR() __builtin_amdgcn_sched_barrier(0)
__device__ __forceinline__ unsigned f2bf(float f) { unsigned u = __builtin_bit_cast(unsigned, f); return (u + 0x7fffu + ((u >> 16) & 1u)) >> 16; }
__device__ __forceinline__ unsigned pk2(float lo, float hi) { return f2bf(lo) | (f2bf(hi) << 16); }
__device__ __forceinline__ float bf2f(unsigned short h) { return __builtin_bit_cast(float, (unsigned)h << 16); }
__device__ __forceinline__ float bflo(unsigned w) { return __builtin_bit_cast(float, w << 16); }
__device__ __forceinline__ float bfhi(unsigned w) { return __builtin_bit_cast(float, w & 0xffff0000u); }
__device__ __forceinline__ unsigned cvtpk(float lo, float hi) { unsigned r; asm volatile("v_cvt_pk_bf16_f32 %0, %1, %2" : "=v"(r) : "v"(lo), "v"(hi)); return r; }
__device__ __forceinline__ float fast_sigmoid(float x) { return __builtin_amdgcn_rcpf(1.0f + __builtin_amdgcn_exp2f(-1.4426950408889634f * x)); }
__device__ __forceinline__ float gelu_tanh(float x) { const float z = 1.5957691216057308f * (x + 0.044715f * x * x * x); return x * fast_sigmoid(z); }
__device__ __forceinline__ f32x2 sigmoid_pk(f32x2 x) { const f32x2 z = x * (-1.4426950408889634f); f32x2 e; e.x = __builtin_amdgcn_exp2f(z.x); e.y = __builtin_amdgcn_exp2f(z.y);
    const f32x2 d = e + 1.0f; f32x2 r; r.x = __builtin_amdgcn_rcpf(d.x); r.y = __builtin_amdgcn_rcpf(d.y); return r; }
__device__ __forceinline__ f32x2 gelu_tanh_pk(f32x2 x) {
    const f32x2 u = x * x, w = u * (-0.044715f * 1.5957691216057308f * 1.4426950408889634f) + (-1.5957691216057308f * 1.4426950408889634f), z = x * w;
    f32x2 e; e.x = __builtin_amdgcn_exp2f(z.x); e.y = __builtin_amdgcn_exp2f(z.y);
    const f32x2 d = e + 1.0f; f32x2 r; r.x = __builtin_amdgcn_rcpf(d.x); r.y = __builtin_amdgcn_rcpf(d.y); return x * r; }
__device__ __forceinline__ float wave_sum(float v) {
#pragma unroll
    for (int o = 1; o < 64; o <<= 1) v += __shfl_xor(v, o);
    return v;
}
__device__ __forceinline__ float wave_max(float v) {
#pragma unroll
    for (int o = 1; o < 64; o <<= 1) v = fmaxf(v, __shfl_xor(v, o));
    return v;
}

#define XB_TMO      128
#define XB_XCNT(j)  (256  + 64 * (j))
#define XB_XSUB(j)  (1280 + 64 * (j))
#define XB_XGEN(j)  (2304 + 64 * (j))
#define XB_TOP      3328
#define XB_TOPGEN   3392
#define XCD_BAR_WORDS 3456
#define XB_SPIN_CAP (1u << 20)
__device__ __forceinline__ unsigned xb_ld(unsigned* p)              { return __hip_atomic_load(p, __ATOMIC_RELAXED, __HIP_MEMORY_SCOPE_AGENT); }
__device__ __forceinline__ unsigned xb_add(unsigned* p, unsigned v) { return __hip_atomic_fetch_add(p, v, __ATOMIC_RELAXED, __HIP_MEMORY_SCOPE_AGENT); }
__device__ __forceinline__ unsigned xb_xcc_id() { return (unsigned)__builtin_amdgcn_s_getreg((3 << 11) | 20) & 0xFu; }
#define XB_SPIN(cond, bar) do { unsigned _sp = 0; while (cond) { __builtin_amdgcn_s_sleep(1); \
    if ((++_sp & 255u) == 0u) { if (xb_ld(&(bar)[XB_TMO])) break; if (_sp > XB_SPIN_CAP) { atomicAdd(&(bar)[XB_TMO], 1u); break; } } } } while (0)
struct XcdBarrier { unsigned* bar; unsigned x; volatile LAS unsigned* st; };
__device__ __forceinline__ XcdBarrier xcd_barrier_post(unsigned* bar, volatile LAS unsigned* st) {
    XcdBarrier b; b.bar = bar; b.x = xb_xcc_id(); b.st = st;
    if (threadIdx.x == 0) (void)xb_add(&bar[XB_XCNT(b.x)], 1u);
    return b;
}
__device__ __forceinline__ void xcd_barrier_complete(unsigned* bar, unsigned x, unsigned& nloc, unsigned& nx) {
    const unsigned G = gridDim.x * gridDim.y * gridDim.z;
    unsigned sum, cnt, mine, sp = 0u;
    for (;;) {
        sum = 0u; cnt = 0u; mine = 0u;
#pragma unroll
        for (unsigned j = 0; j < 16; ++j) { const unsigned c = xb_ld(&bar[XB_XCNT(j)]); sum += c; cnt += (c > 0u) ? 1u : 0u; mine = (j == x) ? c : mine; }
        if (sum == G) break;
        __builtin_amdgcn_s_sleep(1);
        if ((++sp & 255u) == 0u) { if (xb_ld(&bar[XB_TMO])) break; if (sp > XB_SPIN_CAP) { atomicAdd(&bar[XB_TMO], 1u); break; } }
    }
    nloc = mine > 0u ? mine : 1u; nx = cnt > 0u ? cnt : 1u;
}
__device__ __forceinline__ void xcd_barrier(const XcdBarrier& b) {
    asm volatile("s_waitcnt vmcnt(0)" ::: "memory");
    __syncthreads();
    if (threadIdx.x == 0) {
        unsigned* bar = b.bar;
        __builtin_amdgcn_s_waitcnt(0);
        unsigned nloc = b.st[0], nx = b.st[1];
        if (nloc == 0u) { xcd_barrier_complete(bar, b.x, nloc, nx); b.st[0] = nloc; b.st[1] = nx; }
        const unsigned old = xb_add(&bar[XB_XSUB(b.x)], 1u);
        const unsigned gen = old / nloc;
        if (old + 1u == (gen + 1u) * nloc) {
            __builtin_amdgcn_fence(__ATOMIC_RELEASE, "agent");
            asm volatile("s_waitcnt vmcnt(0)" ::: "memory");
            const unsigned og = xb_add(&bar[XB_TOP], 1u);
            const unsigned tg = og / nx;
            if (og + 1u == (tg + 1u) * nx) xb_add(&bar[XB_TOPGEN], 1u);
            else XB_SPIN(xb_ld(&bar[XB_TOPGEN]) == tg, bar);
            __builtin_amdgcn_fence(__ATOMIC_ACQUIRE, "agent");
            xb_add(&bar[XB_XGEN(b.x)], 1u);
            asm volatile("s_waitcnt vmcnt(0)" ::: "memory");
        } else {
            XB_SPIN(xb_ld(&bar[XB_XGEN(b.x)]) == gen, bar);
            __builtin_amdgcn_fence(__ATOMIC_ACQUIRE, "agent");
            asm volatile("s_waitcnt vmcnt(0)" ::: "memory");
        }
    }
    __syncthreads();
}

struct Args { const void* in[26]; float* out; unsigned char* ws; int ph_lo, ph_hi; };
struct Frame {
    LAS unsigned char* lds; char* ldsg;
    volatile LAS unsigned* MISC;
    int tid, lane, wave, vcu, G;
    unsigned char* ws; float* out;
};
#define IN_F(k) ((const float*)args.in[k])
#define IN_I(k) ((const int*)args.in[k])
#define WSP(T, off) ((T*)(F.ws + (off)))

namespace pg8 {
struct TileOrder {
    int nM, nN, nwg, G, c; const LAS int* blk_exp; const void* abase;
    __device__ void init(int nM_, int nN_, int G_, int c_, const LAS int* be, const void* ab = nullptr) { nM = nM_; nN = nN_; nwg = nM * nN; G = G_; c = c_; blk_exp = be; abase = ab; }
    __device__ __forceinline__ const void* a_base(const Unit&) const { return abase; }
    __device__ bool next(int i, Unit& u) const {
        const long L = (long)i * G + c; if (L >= nwg) return false;
        int wgid = (int)L; { const int q = nwg / NXCD, r = nwg % NXCD, xcd = wgid % NXCD, off = wgid / NXCD; wgid = (xcd < r ? xcd * (q + 1) : r * (q + 1) + (xcd - r) * q) + off; }
        const int nig = WGM * nN, gid = wgid / nig, fm = gid * WGM, gsz = (nM - fm) < WGM ? (nM - fm) : WGM;
        u.pm = fm + ((wgid % nig) % gsz); u.pn = (wgid % nig) / gsz; u.kind = 0;
        if (blk_exp) { const int e = __builtin_amdgcn_readfirstlane(blk_exp[u.pm]); u.pn += e * nN; }
        return true;
    }
    __device__ __forceinline__ void a_ready(const Unit&) const {}
    __device__ __forceinline__ void done(const Unit&) const {}
};

struct EpiWin {
    static constexpr bool PERM = true, AFTER_DRAIN = false, MIDK = false; static constexpr int NSTORES = 16;
    bf16_t* E; const float* b_gate; int mode;
    __device__ __forceinline__ void operator()(const f32x4 (&acc)[2][2][4][2], const Unit& u, int wr, int wc, int fr, int fq) const {
        const int opn = mode == 0 ? (u.pn < 8 ? u.pn : u.pn + 8) : (u.pn < 8 ? u.pn + 8 : u.pn + 12);
        const int t = opn >> 2, colt = (opn & 3) * BM;
        bf16_t* base = E + (size_t)t * ((size_t)16384 * 1024);
        int row0 = u.pm * BM + wr * 64 + fr; const int col0 = colt + wc * 32 + 8 * fq;
        asm volatile("" : "+v"(row0));
        f32x4 bv[2][2];
#pragma unroll
        for (int bj = 0; bj < 2; ++bj)
#pragma unroll
            for (int n = 0; n < 2; ++n) bv[bj][n] = (t >= 5) ? *(const f32x4*)(b_gate + (t - 5) * 1024 + col0 + bj * HALF + 4 * n) : (f32x4){0.f, 0.f, 0.f, 0.f};
#pragma unroll
        for (int ai = 0; ai < 2; ++ai)
#pragma unroll
            for (int m = 0; m < 4; ++m) { bf16_t* rowp = base + (size_t)(row0 + ai * HALF + m * 16) * 1024 + col0;
#pragma unroll
                for (int bj = 0; bj < 2; ++bj) { f32x4 v0 = acc[ai][bj][m][0] + bv[bj][0], v1 = acc[ai][bj][m][1] + bv[bj][1];
                    if (t == 1) { const f32x2 a = gelu_tanh_pk((f32x2){v0[0], v0[1]}), b = gelu_tanh_pk((f32x2){v0[2], v0[3]}), c = gelu_tanh_pk((f32x2){v1[0], v1[1]}), d = gelu_tanh_pk((f32x2){v1[2], v1[3]});
                        v0 = (f32x4){a.x, a.y, b.x, b.y}; v1 = (f32x4){c.x, c.y, d.x, d.y}; }
                    else if (t >= 5) { const f32x2 a = sigmoid_pk((f32x2){v0[0], v0[1]}), b = sigmoid_pk((f32x2){v0[2], v0[3]}), c = sigmoid_pk((f32x2){v1[0], v1[1]}), d = sigmoid_pk((f32x2){v1[2], v1[3]});
                        v0 = (f32x4){a.x, a.y, b.x, b.y}; v1 = (f32x4){c.x, c.y, d.x, d.y}; }
                    u32x4 w; w.x = cvt_pk_bf16(v0[0], v0[1]); w.y = cvt_pk_bf16(v0[2], v0[3]); w.z = cvt_pk_bf16(v1[0], v1[1]); w.w = cvt_pk_bf16(v1[2], v1[3]);
                    *(u32x4*)(rowp + bj * HALF) = w; } }
    }
};
struct EpiBranch {
    static constexpr bool PERM = true, AFTER_DRAIN = false, MIDK = true; static constexpr int NSTORES = 16;
    const bf16_t* SG0; const bf16_t* SG1; bf16_t* MIX;
    __device__ __forceinline__ void mid(f32x4 (&acc)[2][2][4][2], const Unit& u, int wr, int wc, int fr, int fq) const {
        int row0 = u.pm * BM + wr * 64 + fr; const int col0 = u.pn * BM + wc * 32 + 8 * fq;
        asm volatile("" : "+v"(row0));
#pragma unroll
        for (int ai = 0; ai < 2; ++ai)
#pragma unroll
            for (int m = 0; m < 4; ++m) { const size_t ro = (size_t)(row0 + ai * HALF + m * 16) * 1024 + col0;
#pragma unroll
                for (int bj = 0; bj < 2; ++bj) { const size_t o = ro + bj * HALF;
                    const u32x4 a = *(const u32x4*)(SG0 + o), b = *(const u32x4*)(SG1 + o);
                    const float r0 = bflo(a.x) * __builtin_amdgcn_rcpf(fmaxf(bflo(b.x), 1e-18f)), r1 = bfhi(a.x) * __builtin_amdgcn_rcpf(fmaxf(bfhi(b.x), 1e-18f));
                    const float r2 = bflo(a.y) * __builtin_amdgcn_rcpf(fmaxf(bflo(b.y), 1e-18f)), r3 = bfhi(a.y) * __builtin_amdgcn_rcpf(fmaxf(bfhi(b.y), 1e-18f));
                    const float r4 = bflo(a.z) * __builtin_amdgcn_rcpf(fmaxf(bflo(b.z), 1e-18f)), r5 = bfhi(a.z) * __builtin_amdgcn_rcpf(fmaxf(bfhi(b.z), 1e-18f));
                    const float r6 = bflo(a.w) * __builtin_amdgcn_rcpf(fmaxf(bflo(b.w), 1e-18f)), r7 = bfhi(a.w) * __builtin_amdgcn_rcpf(fmaxf(bfhi(b.w), 1e-18f));
                    acc[ai][bj][m][0] *= (f32x4){r0, r1, r2, r3}; acc[ai][bj][m][1] *= (f32x4){r4, r5, r6, r7}; }
                asm volatile("" ::: "memory"); }
    }
    __device__ __forceinline__ void operator()(const f32x4 (&acc)[2][2][4][2], const Unit& u, int wr, int wc, int fr, int fq) const {
        int row0 = u.pm * BM + wr * 64 + fr; const int col0 = u.pn * BM + wc * 32 + 8 * fq;
        asm volatile("" : "+v"(row0));
#pragma unroll
        for (int ai = 0; ai < 2; ++ai)
#pragma unroll
            for (int m = 0; m < 4; ++m) { const size_t ro = (size_t)(row0 + ai * HALF + m * 16) * 1024 + col0;
#pragma unroll
                for (int bj = 0; bj < 2; ++bj) { const size_t o = ro + bj * HALF;
                    const u32x4 b = *(const u32x4*)(SG1 + o);
                    const f32x4 g0 = {fmaxf(bflo(b.x), 1e-18f), fmaxf(bfhi(b.x), 1e-18f), fmaxf(bflo(b.y), 1e-18f), fmaxf(bfhi(b.y), 1e-18f)}, g1 = {fmaxf(bflo(b.z), 1e-18f), fmaxf(bfhi(b.z), 1e-18f), fmaxf(bflo(b.w), 1e-18f), fmaxf(bfhi(b.w), 1e-18f)};
                    const f32x4 v0 = acc[ai][bj][m][0] * g0, v1 = acc[ai][bj][m][1] * g1;
                    u32x4 w; w.x = cvt_pk_bf16(v0[0], v0[1]); w.y = cvt_pk_bf16(v0[2], v0[3]); w.z = cvt_pk_bf16(v1[0], v1[1]); w.w = cvt_pk_bf16(v1[2], v1[3]);
                    *(u32x4*)(MIX + o) = w; } }
    }
};
struct EpiWout {
    static constexpr bool PERM = false, AFTER_DRAIN = false, MIDK = false; static constexpr int NSTORES = 32;
    const float* x; float* out; const float* mod;
    __device__ __forceinline__ void operator()(const f32x4 (&acc)[2][2][4][2], const Unit& u, int wr, int wc, int fr, int fq) const {
        int row0 = u.pm * BM + wr * 64 + fr; const int col0 = u.pn * BM + wc * 32 + 4 * fq;
        asm volatile("" : "+v"(row0));
        const float* g1p = mod + (size_t)(u.pm >> 4) * 6144 + 2048;
        f32x4 gv[2][2];
#pragma unroll
        for (int bj = 0; bj < 2; ++bj)
#pragma unroll
            for (int n = 0; n < 2; ++n) gv[bj][n] = *(const f32x4*)(g1p + col0 + bj * HALF + n * 16);
#pragma unroll
        for (int ai = 0; ai < 2; ++ai)
#pragma unroll
            for (int m = 0; m < 4; ++m) { const size_t ro = (size_t)(row0 + ai * HALF + m * 16) * 1024 + col0;
#pragma unroll
                for (int bj = 0; bj < 2; ++bj)
#pragma unroll
                    for (int n = 0; n < 2; ++n) { const size_t o = ro + bj * HALF + n * 16; *(f32x4*)(out + o) = *(const f32x4*)(x + o) + gv[bj][n] * acc[ai][bj][m][n]; } }
    }
};
__device__ __forceinline__ unsigned pk_fp8x4(float a, float b, float c, float d) { int p = __builtin_amdgcn_cvt_pk_fp8_f32(a, b, 0, false); p = __builtin_amdgcn_cvt_pk_fp8_f32(c, d, p, true); return (unsigned)p; }
struct EpiUp {
    static constexpr bool PERM = true, AFTER_DRAIN = false, MIDK = false; static constexpr int NSTORES = 8;
    unsigned char* ACT; const float* b_up;
    __device__ __forceinline__ void operator()(const f32x4 (&acc)[2][2][4][2], const Unit& u, int wr, int wc, int fr, int fq) const {
        const int e = u.pn >> 3, p = u.pn & 7;
        int row0 = u.pm * BM + wr * 64 + fr; const int c0 = p * 128 + wc * 32 + 8 * fq;
        asm volatile("" : "+v"(row0));
        const float* bg = b_up + (size_t)e * 2048 + c0; const float* bl = bg + 1024;
        f32x4 bgv[2], blv[2];
#pragma unroll
        for (int n = 0; n < 2; ++n) { bgv[n] = *(const f32x4*)(bg + 4 * n); blv[n] = *(const f32x4*)(bl + 4 * n) + 1.0f; }
#pragma unroll
        for (int ai = 0; ai < 2; ++ai)
#pragma unroll
            for (int m = 0; m < 4; ++m) { unsigned char* rowp = ACT + (size_t)(row0 + ai * HALF + m * 16) * 1024 + c0;
                f32x4 a[2];
#pragma unroll
                for (int n = 0; n < 2; ++n) {
#pragma unroll
                    for (int j = 0; j < 4; j += 2) { f32x2 g = (f32x2){acc[ai][0][m][n][j], acc[ai][0][m][n][j + 1]} + (f32x2){bgv[n][j], bgv[n][j + 1]};
                        f32x2 l = (f32x2){acc[ai][1][m][n][j], acc[ai][1][m][n][j + 1]} + (f32x2){blv[n][j], blv[n][j + 1]};
                        g.x = fminf(g.x, 7.0f); g.y = fminf(g.y, 7.0f); l.x = __builtin_amdgcn_fmed3f(l.x, -6.0f, 8.0f); l.y = __builtin_amdgcn_fmed3f(l.y, -6.0f, 8.0f);
                        const f32x2 z = g * (-1.702f * 1.4426950408889634f); f32x2 e; e.x = __builtin_amdgcn_exp2f(z.x); e.y = __builtin_amdgcn_exp2f(z.y);
                        const f32x2 d = e + 1.0f; f32x2 r; r.x = __builtin_amdgcn_rcpf(d.x); r.y = __builtin_amdgcn_rcpf(d.y);
                        const f32x2 o = (l * g) * r; a[n][j] = o.x; a[n][j + 1] = o.y; } }
                typedef unsigned u32x2_t __attribute__((ext_vector_type(2)));
                u32x2_t w; w.x = pk_fp8x4(a[0][0], a[0][1], a[0][2], a[0][3]); w.y = pk_fp8x4(a[1][0], a[1][1], a[1][2], a[1][3]);
                *(u32x2_t*)rowp = w; }
    }
};
struct EpiDown {
    static constexpr bool PERM = true, AFTER_DRAIN = false, MIDK = false; static constexpr int NSTORES = 16;
    bf16_t* YR; const float* b_down; const float* row_gate; const LAS int* tbl;
    __device__ __forceinline__ void operator()(const f32x4 (&acc)[2][2][4][2], const Unit& u, int wr, int wc, int fr, int fq) const {
        const int e = u.pn >> 2, p = u.pn & 3;
        int row0 = u.pm * BM + wr * 64 + fr; const int c0 = p * BM + wc * 32 + 8 * fq;
        asm volatile("" : "+v"(row0));
        const int pos0 = row0 - tbl[32 + e] * 256, cnt = tbl[e];
        const float* gp = row_gate + (size_t)e * 16384 + pos0;
        float gt[2][4];
#pragma unroll
        for (int ai = 0; ai < 2; ++ai)
#pragma unroll
            for (int m = 0; m < 4; ++m) { const int o = ai * HALF + m * 16; gt[ai][m] = (pos0 + o < cnt) ? gp[o] : 0.0f; }
        f32x4 bv[2][2];
#pragma unroll
        for (int bj = 0; bj < 2; ++bj)
#pragma unroll
            for (int n = 0; n < 2; ++n) bv[bj][n] = *(const f32x4*)(b_down + (size_t)e * 1024 + c0 + bj * HALF + 4 * n);
#pragma unroll
        for (int ai = 0; ai < 2; ++ai)
#pragma unroll
            for (int m = 0; m < 4; ++m) { const int r = row0 + ai * HALF + m * 16; const float g = gt[ai][m];
                bf16_t* rowp = YR + (size_t)r * 1024 + c0;
#pragma unroll
                for (int bj = 0; bj < 2; ++bj) { const f32x4 v0 = (acc[ai][bj][m][0] + bv[bj][0]) * g, v1 = (acc[ai][bj][m][1] + bv[bj][1]) * g;
                    u32x4 w; w.x = cvt_pk_bf16(v0[0], v0[1]); w.y = cvt_pk_bf16(v0[2], v0[3]); w.z = cvt_pk_bf16(v1[0], v1[1]); w.w = cvt_pk_bf16(v1[2], v1[3]);
                    *(u32x4*)(rowp + bj * HALF) = w; } }
    }
};
}

__device__ __forceinline__ void p0_transpose_item(const float* W, int N, bf16* WT, int Kd, size_t dst_row0, LAS float* scr, int k0, int n0, int lane) {
#pragma unroll 8
    for (int i = 0; i < 32; ++i) { const int kk = 2 * i + (lane >> 5); scr[kk * 33 + (lane & 31)] = W[(size_t)(k0 + kk) * N + n0 + (lane & 31)]; }
    LDS_WAIT(); asm volatile("" ::: "memory");
    const int c = lane & 7;
#pragma unroll
    for (int j = 0; j < 4; ++j) { const int n = (lane >> 3) + 8 * j; const LAS float* s = scr + (8 * c) * 33 + n;
        v4u o; o.x = pk2(s[0 * 33], s[1 * 33]); o.y = pk2(s[2 * 33], s[3 * 33]); o.z = pk2(s[4 * 33], s[5 * 33]); o.w = pk2(s[6 * 33], s[7 * 33]);
        *(GAS v4u*)(WT + (dst_row0 + n) * (size_t)Kd + k0 + 8 * c) = o; }
    LDS_WAIT(); asm volatile("" ::: "memory");
}
__device__ __forceinline__ void p8_transpose_item_fp8(const float* W, int N, unsigned char* WT, int Kd, size_t dst_row0, LAS float* scr, int k0, int n0, int lane) {
#pragma unroll 8
    for (int i = 0; i < 32; ++i) { const int kk = 2 * i + (lane >> 5); scr[kk * 33 + (lane & 31)] = W[(size_t)(k0 + kk) * N + n0 + (lane & 31)] * 64.0f; }
    LDS_WAIT(); asm volatile("" ::: "memory");
    const int c = lane & 7;
#pragma unroll
    for (int j = 0; j < 4; ++j) { const int n = (lane >> 3) + 8 * j; const LAS float* s = scr + (8 * c) * 33 + n;
        v2u o; o.x = pg8::pk_fp8x4(s[0 * 33], s[1 * 33], s[2 * 33], s[3 * 33]); o.y = pg8::pk_fp8x4(s[4 * 33], s[5 * 33], s[6 * 33], s[7 * 33]);
        *(GAS v2u*)(WT + (dst_row0 + n) * (size_t)Kd + k0 + 8 * c) = o; }
    LDS_WAIT(); asm volatile("" ::: "memory");
}
__device__ __forceinline__ void p0_prologue(Frame& F, const Args& args) {
    const float* c_in = IN_F(1); const int* pos = IN_I(2); const float* ada_w = IN_F(3); const float* ada_b = IN_F(4);
    for (int task = F.vcu; task < 96; task += F.G) {
        LAS float* sc = (LAS float*)F.lds;
        LAS float* red = (LAS float*)(F.lds + 16384);
        for (int i = F.tid; i < 4096; i += 512) { const float v = c_in[i]; sc[i] = v / (1.0f + expf(-v)); }
        __syncthreads();
        const int colq = F.lane & 15, kq = F.lane >> 4, col = task * 64 + colq * 4;
        float acc[4][4];
#pragma unroll
        for (int b = 0; b < 4; ++b)
#pragma unroll
            for (int j = 0; j < 4; ++j) acc[b][j] = 0.f;
#pragma unroll 4
        for (int s = 0; s < 32; ++s) { const int k = F.wave * 128 + s * 4 + kq; const f32x4 wv = *(const f32x4*)(ada_w + (size_t)k * 6144 + col);
#pragma unroll
            for (int b = 0; b < 4; ++b) { const float sv = sc[b * 1024 + k];
#pragma unroll
                for (int j = 0; j < 4; ++j) acc[b][j] += sv * wv[j]; } }
#pragma unroll
        for (int b = 0; b < 4; ++b)
#pragma unroll
            for (int j = 0; j < 4; ++j) { float v = acc[b][j]; v += __shfl_xor(v, 16); v += __shfl_xor(v, 32); if (kq == 0) red[(F.wave * 4 + b) * 64 + colq * 4 + j] = v; }
        __syncthreads();
        if (F.tid < 256) { const int b = F.tid >> 6, cc = F.tid & 63; float s = ada_b[task * 64 + cc];
#pragma unroll
            for (int w = 0; w < 8; ++w) s += red[(w * 4 + b) * 64 + cc];
            WSP(float, WS_MOD)[b * 6144 + task * 64 + cc] = s; }
        VM_WAIT(); __syncthreads();
        if (F.tid == 0) { __builtin_amdgcn_fence(__ATOMIC_RELEASE, "agent"); VM_WAIT(); __hip_atomic_fetch_add((unsigned*)(F.ws + WS_CTL) + CW_MODCNT, 1u, RLX_AGENT); }
    }
    const int gt = F.vcu * 512 + F.tid, NGT = F.G * 512;
    for (int idx = gt; idx < NTOK * 16; idx += NGT) { const int m = idx >> 4, i = idx & 15;
        double freq = 1.0; for (int q = 0; q < i; ++q) freq *= 0.44036660267178046;
        const double ang = (double)pos[m] * freq; const double nr = __builtin_rint(ang * 0.15915494309189535);
        const float r = (float)__builtin_fma(-nr, 6.283185307179586, ang);
        float sn, cs; sincosf(r, &sn, &cs);
        WSP(float, WS_TRIG)[m * 32 + i] = cs; WSP(float, WS_TRIG)[m * 32 + 16 + i] = sn; }
    { const float* wr = IN_F(20); for (int idx = gt; idx < 32 * 1024; idx += NGT) { const int e = idx >> 10, k = idx & 1023; const float w = wr[k * 32 + e];
        const unsigned hi = f2bf(w); const float rem = w - __builtin_bit_cast(float, hi << 16); WSP(bf16, WS_WRH)[idx] = (bf16)hi; WSP(bf16, WS_WRL)[idx] = (bf16)f2bf(rem); } }
    LAS float* scr = (LAS float*)(F.lds + 32768 + F.wave * 8704);
    const int gw = F.vcu * NWAVES + F.wave, NGW = F.G * NWAVES;
    constexpr int I_IN = 16 * 224, I_RG = 128, I_B = 1024, I_O = 512;
    constexpr int NITEMS = I_IN + I_RG + I_B + I_O;
    for (int it = gw; it < NITEMS; it += NGW) {
        int r = it;
        if (r < I_IN) { const int kb = r / 224, nb = r % 224, n0 = nb * 32;
            if (n0 < 2048 || (n0 >= 4096 && n0 < 5120)) p0_transpose_item(IN_F(7), DIN, WSP(bf16, WS_WIN), 1024, (size_t)(n0 < 2048 ? n0 : n0 - 2048), scr, kb * 64, n0, F.lane);
            else p8_transpose_item_fp8(IN_F(7), DIN, WSP(unsigned char, WS_WIN8), 1024, (size_t)(n0 < 4096 ? n0 - 2048 : n0 - 3072), scr, kb * 64, n0, F.lane);
            continue; } r -= I_IN;
        if (r < I_RG) { const int mat = r >> 6, blk = (r >> 3) & 7, kb = (r >> 2) & 1, nb = r & 3;
            p0_transpose_item(IN_F(mat ? 12 : 10) + (size_t)blk * 16384, 128, WSP(bf16, WS_WRG) + (size_t)(mat * 8 + blk) * 16384, 128, (size_t)nb * 32, scr, kb * 64, nb * 32, F.lane); continue; } r -= I_RG;
        if (r < I_B) { const int g = r >> 9, q = r & 511, kb = q >> 5, nb = q & 31;
            p0_transpose_item(IN_F(18) + (size_t)g * 1048576, 1024, WSP(bf16, WS_WB) + (size_t)g * 1024, 2048, (size_t)nb * 32, scr, kb * 64, nb * 32, F.lane); continue; } r -= I_B;
        { const int kb = r >> 5, nb = r & 31; p0_transpose_item(IN_F(19), 1024, WSP(bf16, WS_WO), 1024, (size_t)nb * 32, scr, kb * 64, nb * 32, F.lane); }
    }
}
__device__ __forceinline__ void p8_moe_weights(Frame& F, const Args& args) {
    LAS float* scr = (LAS float*)(F.lds + 32768 + F.wave * 8704);
    const int gw = F.vcu * NWAVES + F.wave, NGW = F.G * NWAVES;
    constexpr int I_UP = 32 * 1024, I_DN = 32 * 512;
    for (int it = gw; it < I_UP + I_DN; it += NGW) {
        int r = it;
        if (r < I_UP) { const int e = r >> 10, q = r & 1023, kb = q >> 6, nb = q & 63, n0 = nb * 32;
            const int bj = n0 >> 10, p = (n0 & 1023) >> 7, oo = n0 & 127;
            p8_transpose_item_fp8(IN_F(22) + (size_t)e * 2097152, 2048, WSP(unsigned char, WS_WUP) + (size_t)e * 2097152, 1024, (size_t)(p * 256 + bj * 128 + oo), scr, kb * 64, n0, F.lane); continue; } r -= I_UP;
        { const int e = r >> 9, q = r & 511, kb = q >> 5, nb = q & 31;
            p8_transpose_item_fp8(IN_F(24) + (size_t)e * 1048576, 1024, WSP(unsigned char, WS_WDN) + (size_t)e * 1048576, 1024, (size_t)nb * 32, scr, kb * 64, nb * 32, F.lane); }
    }
}

__device__ __forceinline__ void p1_hrows(Frame& F, const Args& args) {
    if (F.tid == 0) { unsigned* mc = (unsigned*)(F.ws + WS_CTL) + CW_MODCNT; unsigned sp = 0; while (__hip_atomic_load(mc, RLX_AGENT) < 96u && ++sp < (1u << 22)) __builtin_amdgcn_s_sleep(2);
        __builtin_amdgcn_fence(__ATOMIC_ACQUIRE, "agent"); VM_WAIT(); }
    __syncthreads();
    const float* x = IN_F(0); const float* g1n = IN_F(5); const float* mod = WSP(float, WS_MOD); bf16* H = WSP(bf16, WS_HB); unsigned char* H8 = WSP(unsigned char, WS_H8);
    const int gw = F.vcu * NWAVES + F.wave, NGW = F.G * NWAVES;
    for (int m0 = gw; m0 < NTOK; m0 += 2 * NGW) {
        const int m1 = m0 + NGW;
        const bool has1 = m1 < NTOK;
        f32x4 v0[4], v1[4]; float s0 = 0.f, s1 = 0.f;
        const f32x4* x0 = (const f32x4*)(x + (size_t)m0 * DM) + F.lane; const f32x4* x1 = (const f32x4*)(x + (size_t)(has1 ? m1 : m0) * DM) + F.lane;
#pragma unroll
        for (int j = 0; j < 4; ++j) { v0[j] = x0[64 * j]; v1[j] = x1[64 * j]; }
#pragma unroll
        for (int j = 0; j < 4; ++j) { s0 += (v0[j].x * v0[j].x + v0[j].y * v0[j].y) + (v0[j].z * v0[j].z + v0[j].w * v0[j].w); s1 += (v1[j].x * v1[j].x + v1[j].y * v1[j].y) + (v1[j].z * v1[j].z + v1[j].w * v1[j].w); }
#pragma unroll
        for (int o = 1; o < 64; o <<= 1) { s0 += __shfl_xor(s0, o); s1 += __shfl_xor(s1, o); }
        const float r0 = 1.0f / sqrtf(s0 * (1.f / DM) + EPS), r1 = 1.0f / sqrtf(s1 * (1.f / DM) + EPS);
        const int b0 = m0 >> 12, b1 = (has1 ? m1 : m0) >> 12;
        unsigned long long* o0 = (unsigned long long*)(H + (size_t)m0 * DM) + F.lane; unsigned long long* o1 = (unsigned long long*)(H + (size_t)(has1 ? m1 : m0) * DM) + F.lane;
#pragma unroll
        for (int j = 0; j < 4; ++j) { const int col = 4 * F.lane + 256 * j;
            const f32x4 g = *(const f32x4*)(g1n + col);
            const f32x4 sh0 = *(const f32x4*)(mod + b0 * 6144 + col), sc0 = *(const f32x4*)(mod + b0 * 6144 + 1024 + col);
            const f32x4 sh1 = *(const f32x4*)(mod + b1 * 6144 + col), sc1 = *(const f32x4*)(mod + b1 * 6144 + 1024 + col);
            const f32x4 h0 = v0[j] * r0 * g * (sc0 + 1.0f) + sh0, h1 = v1[j] * r1 * g * (sc1 + 1.0f) + sh1;
            o0[64 * j] = (unsigned long long)cvtpk(h0.x, h0.y) | ((unsigned long long)cvtpk(h0.z, h0.w) << 32);
            ((unsigned*)(H8 + (size_t)m0 * DM))[F.lane + 64 * j] = pg8::pk_fp8x4(h0.x, h0.y, h0.z, h0.w);
            if (has1) { o1[64 * j] = (unsigned long long)cvtpk(h1.x, h1.y) | ((unsigned long long)cvtpk(h1.z, h1.w) << 32);
                ((unsigned*)(H8 + (size_t)m1 * DM))[F.lane + 64 * j] = pg8::pk_fp8x4(h1.x, h1.y, h1.z, h1.w); } }
    }
}

__device__ __forceinline__ void p3_knorm_unit(Frame& F, const Args& args, int unit) {
    const int h = unit & 7, j = (unit >> 3) & 15, b = unit >> 7;
    bf16* KR = WSP(bf16, WS_E) + 3 * E_STRIDE; const float* trig = WSP(float, WS_TRIG); const float* kg = IN_F(16);
    const int rsub = F.lane >> 4, c16 = F.lane & 15;
    float gk[8];
#pragma unroll
    for (int i = 0; i < 8; ++i) gk[i] = kg[c16 * 8 + i];
    float km[8];
#pragma unroll
    for (int i = 0; i < 8; ++i) km[i] = 0.f;
    const int fi = (c16 & 1) * 8;
#pragma unroll 1
    for (int bt = 0; bt < 2; ++bt) {
        v4u raw[4]; f32x4 tcs[4][4];
#pragma unroll
        for (int i4 = 0; i4 < 4; ++i4) { const int m = b * SEQ + j * 256 + F.wave * 32 + (bt * 4 + i4) * 4 + rsub;
            raw[i4] = *(const v4u*)(KR + (size_t)m * DM + h * HD + c16 * 8);
            const float* tp = trig + (size_t)m * 32 + fi;
            tcs[i4][0] = *(const f32x4*)tp; tcs[i4][1] = *(const f32x4*)(tp + 4); tcs[i4][2] = *(const f32x4*)(tp + 16); tcs[i4][3] = *(const f32x4*)(tp + 20); }
#pragma unroll
        for (int i4 = 0; i4 < 4; ++i4) { const int m = b * SEQ + j * 256 + F.wave * 32 + (bt * 4 + i4) * 4 + rsub;
            float v[8] = {bflo(raw[i4].x), bfhi(raw[i4].x), bflo(raw[i4].y), bfhi(raw[i4].y), bflo(raw[i4].z), bfhi(raw[i4].z), bflo(raw[i4].w), bfhi(raw[i4].w)};
            float ss = 0.f;
#pragma unroll
            for (int i = 0; i < 8; ++i) ss += v[i] * v[i];
            ss += __shfl_xor(ss, 1); ss += __shfl_xor(ss, 2); ss += __shfl_xor(ss, 4); ss += __shfl_xor(ss, 8);
            const float rstd = 1.0f / sqrtf(ss * (1.f / HD) + EPS);
#pragma unroll
            for (int i = 0; i < 8; ++i) v[i] = v[i] * rstd * gk[i];
#pragma unroll
            for (int i = 0; i < 8; ++i) { const float other = __shfl_xor(v[i], 2); const float cs = tcs[i4][i >> 2][i & 3], sn = tcs[i4][2 + (i >> 2)][i & 3];
                if (c16 < 4) v[i] = (c16 < 2) ? (v[i] * cs - other * sn) : (v[i] * cs + other * sn); }
#pragma unroll
            for (int i = 0; i < 8; ++i) km[i] += v[i];
            v4u o; o.x = cvtpk(v[0], v[1]); o.y = cvtpk(v[2], v[3]); o.z = cvtpk(v[4], v[5]); o.w = cvtpk(v[6], v[7]);
            *(v4u*)(KR + (size_t)m * DM + h * HD + c16 * 8) = o; }
    }
    LAS float* red = (LAS float*)(F.lds + XTRA_OFF);
#pragma unroll
    for (int i = 0; i < 8; ++i) { float v = km[i]; v += __shfl_xor(v, 16); v += __shfl_xor(v, 32); if (rsub == 0) red[F.wave * 128 + c16 * 8 + i] = v; }
    __syncthreads();
    if (F.tid < 128) { float s = 0.f;
#pragma unroll
        for (int w = 0; w < 8; ++w) s += red[w * 128 + F.tid];
        WSP(float, WS_KMEAN)[((size_t)(b * NH + h) * 16 + j) * HD + F.tid] = s * (1.f / 256.f); }
    __syncthreads();
}

__device__ __forceinline__ void p3_rnn_local_unit(Frame& F, const Args& args, int unit) {
    const int n = unit & 7, c = (unit >> 3) & 15, b = unit >> 7;
    const int t0 = c * 256, m0 = b * SEQ + t0, ch0 = n * 128;
    const bf16* XR = WSP(bf16, WS_E);
    LAS unsigned char* At = F.lds;
    {
        const int cg = F.tid & 15, rs = F.tid >> 4; const int chb = ch0 + cg * 8;
        const float* cw = IN_F(8); const float* cb = IN_F(9);
        float w0[8], w1[8], w2[8], w3[8], bb[8];
#pragma unroll
        for (int i = 0; i < 8; ++i) { w0[i] = cw[chb + i]; w1[i] = cw[1024 + chb + i]; w2[i] = cw[2048 + chb + i]; w3[i] = cw[3072 + chb + i]; bb[i] = cb[chb + i]; }
        const int tr0 = t0 + rs * 8;
        v4u rw[11];
#pragma unroll
        for (int r = 0; r < 11; ++r) { const int tt = tr0 - 3 + r; rw[r] = *(const v4u*)(XR + (size_t)(b * SEQ + (tt < 0 ? 0 : tt)) * DM + chb); if (tt < 0) rw[r] = (v4u){0u, 0u, 0u, 0u}; }
#define UNP(dst, w_) do { dst[0] = bflo(w_.x); dst[1] = bfhi(w_.x); dst[2] = bflo(w_.y); dst[3] = bfhi(w_.y); dst[4] = bflo(w_.z); dst[5] = bfhi(w_.z); dst[6] = bflo(w_.w); dst[7] = bfhi(w_.w); } while (0)
        float p1[8], p2[8], p3[8];
        UNP(p3, rw[0]); UNP(p2, rw[1]); UNP(p1, rw[2]);
#pragma unroll
        for (int r = 0; r < 8; ++r) { float cur[8]; UNP(cur, rw[3 + r]);
            float xc[8];
#pragma unroll
            for (int i = 0; i < 8; ++i) xc[i] = bb[i] + w0[i] * cur[i] + w1[i] * p1[i] + w2[i] * p2[i] + w3[i] * p3[i];
            const int row = rs * 8 + r;
            v4u o; o.x = cvtpk(xc[0], xc[1]); o.y = cvtpk(xc[2], xc[3]); o.z = cvtpk(xc[4], xc[5]); o.w = cvtpk(xc[6], xc[7]);
            *(LAS v4u*)(At + row * 256 + ((cg ^ (row & 15)) << 4)) = o;
#pragma unroll
            for (int i = 0; i < 8; ++i) { p3[i] = p2[i]; p2[i] = p1[i]; p1[i] = cur[i]; } }
#undef UNP
    }
    __syncthreads();
    const int fr = F.lane & 15, fq = F.lane >> 4;
    const int vloc = F.wave * 16 + fr, ch = ch0 + vloc;
    const bf16* WA = WSP(bf16, WS_WRG) + (size_t)n * 16384 + (size_t)vloc * 128 + fq * 8;
    const bf16* WX = WA + 8 * 16384;
    bf16x8 Ba[4], Bx[4];
#pragma unroll
    for (int s = 0; s < 4; ++s) { Ba[s] = *(const bf16x8*)(WA + 32 * s); Bx[s] = *(const bf16x8*)(WX + 32 * s); }
    const float ba = IN_F(11)[ch], bx = IN_F(13)[ch];
    const float sp8 = 8.0f * log1pf(expf(-IN_F(14)[ch]));
    float cP = 1.f, cH = 0.f;
    bf16* HL = WSP(bf16, WS_HL); bf16* PP = WSP(bf16, WS_PP);
    LAS unsigned short* stg = (LAS unsigned short*)(F.lds + 65536);
    for (int rq = 0; rq < 4; ++rq) {
        LAS unsigned short* sb = stg + (rq & 1) * 16384;
#pragma unroll
        for (int ri = 0; ri < 4; ++ri) { const int rt = rq * 4 + ri;
            f32x4 accr = {0.f, 0.f, 0.f, 0.f}, accx = {0.f, 0.f, 0.f, 0.f};
            const int arow = rt * 16 + fr;
#pragma unroll
            for (int s = 0; s < 4; ++s) { const bf16x8 a = *(const LAS bf16x8*)(At + arow * 256 + (((fq + 4 * s) ^ (arow & 15)) << 4));
                accr = __builtin_amdgcn_mfma_f32_16x16x32_bf16(a, Ba[s], accr, 0, 0, 0);
                accx = __builtin_amdgcn_mfma_f32_16x16x32_bf16(a, Bx[s], accx, 0, 0, 0); }
            float pj[4], hj[4];
#pragma unroll
            for (int j = 0; j < 4; ++j) { const int row = rt * 16 + 4 * fq + j;
                const float xcv = bf2f(*(const LAS unsigned short*)(At + row * 256 + ((((vloc >> 3)) ^ (row & 15)) << 4) + (vloc & 7) * 2));
                const float r = fast_sigmoid(accr[j] + ba), ig = fast_sigmoid(accx[j] + bx);
                const float a = __builtin_amdgcn_exp2f(-sp8 * r * 1.4426950408889634f);
                float mult = __builtin_amdgcn_sqrtf(fmaxf(fmaf(-a, a, 1.0f), 0.0f)); if (t0 + row == 0) mult = 1.0f;
                const float u = mult * ig * xcv;
                pj[j] = (j ? pj[j - 1] : 1.0f) * a; hj[j] = (j ? hj[j - 1] * a : 0.0f) + u; }
            const float tp = pj[3], th = hj[3];
            const float pa = __shfl(tp, F.lane - 16), ha = __shfl(th, F.lane - 16);
            const float pb = __shfl(tp, F.lane - 32), hb = __shfl(th, F.lane - 32);
            const float pc = __shfl(tp, F.lane - 48), hc = __shfl(th, F.lane - 48);
            float Pq, Hq;
            if (fq == 0) { Pq = 1.f; Hq = 0.f; } else if (fq == 1) { Pq = pa; Hq = ha; } else if (fq == 2) { Pq = pb * pa; Hq = pa * hb + ha; } else { Pq = pc * pb * pa; Hq = pa * (pb * hc + hb) + ha; }
            const float hstart = Hq + Pq * cH, pstart = Pq * cP;
            float hl3 = 0.f, pp3 = 0.f;
#pragma unroll
            for (int j = 0; j < 4; ++j) { const float hv = hj[j] + pj[j] * hstart, pv = pj[j] * pstart; const int rl = ri * 16 + 4 * fq + j;
                const unsigned pk = cvtpk(hv, pv); sb[rl * 128 + vloc] = (unsigned short)pk; sb[8192 + rl * 128 + vloc] = (unsigned short)(pk >> 16); if (j == 3) { hl3 = hv; pp3 = pv; } }
            cH = __shfl(hl3, fr + 48); cP = __shfl(pp3, fr + 48);
        }
        __syncthreads();
#pragma unroll
        for (int q4 = 0; q4 < 4; ++q4) { const int idx = q4 * 512 + F.tid, arr = idx >> 10, rr = (idx >> 4) & 63, c16 = idx & 15;
            const v4u val = *(const LAS v4u*)(sb + arr * 8192 + rr * 128 + c16 * 8);
            bf16* dst = (arr ? PP : HL) + (size_t)(m0 + rq * 64 + rr) * DM + ch0 + c16 * 8;
            *(v4u*)dst = val; }
    }
    if (fq == 0) { WSP(float, WS_AGGP)[(size_t)(b * 16 + c) * 1024 + ch] = cP; WSP(float, WS_AGGH)[(size_t)(b * 16 + c) * 1024 + ch] = cH; }
    __syncthreads();
}

__device__ __forceinline__ void p4_rnn_final_unit(Frame& F, const Args& args, int unit) {
    const int n = unit & 7, c = (unit >> 3) & 15, b = unit >> 7;
    const int m0 = b * SEQ + c * 256, ch0 = n * 128;
    LAS float* car = (LAS float*)(F.lds + XTRA_OFF);
    if (F.tid < 128) { const int ch = ch0 + F.tid; float h = 0.f;
        for (int cc = 0; cc < c; ++cc) { const float p = WSP(float, WS_AGGP)[(size_t)(b * 16 + cc) * 1024 + ch], hh = WSP(float, WS_AGGH)[(size_t)(b * 16 + cc) * 1024 + ch]; h = p * h + hh; }
        car[F.tid] = h; }
    __syncthreads();
    const bf16* HL = WSP(bf16, WS_HL); const bf16* PP = WSP(bf16, WS_PP); const bf16* GG = WSP(bf16, WS_E) + E_STRIDE; bf16* Y = WSP(bf16, WS_YCAT);
    const int c16 = F.tid & 15, r0 = F.tid >> 4;
    float cv[8];
#pragma unroll
    for (int i = 0; i < 8; ++i) cv[i] = car[c16 * 8 + i];
#pragma unroll 2
    for (int it = 0; it < 8; ++it) { const size_t o = (size_t)(m0 + it * 32 + r0) * DM + ch0 + c16 * 8, oy = (size_t)(m0 + it * 32 + r0) * 2048 + ch0 + c16 * 8;
        const v4u hl = *(const v4u*)(HL + o), pp = *(const v4u*)(PP + o), gg = *(const v4u*)(GG + o);
        v4u y;
        y.x = pk2((bflo(hl.x) + bflo(pp.x) * cv[0]) * bflo(gg.x), (bfhi(hl.x) + bfhi(pp.x) * cv[1]) * bfhi(gg.x));
        y.y = pk2((bflo(hl.y) + bflo(pp.y) * cv[2]) * bflo(gg.y), (bfhi(hl.y) + bfhi(pp.y) * cv[3]) * bfhi(gg.y));
        y.z = pk2((bflo(hl.z) + bflo(pp.z) * cv[4]) * bflo(gg.z), (bfhi(hl.z) + bfhi(pp.z) * cv[5]) * bfhi(gg.z));
        y.w = pk2((bflo(hl.w) + bflo(pp.w) * cv[6]) * bflo(gg.w), (bfhi(hl.w) + bfhi(pp.w) * cv[7]) * bfhi(gg.w));
        *(v4u*)(Y + oy) = y; }
    __syncthreads();
}

namespace att {
constexpr int KVBLK = 64, SHM_K = KVBLK * HD * 2, SHM_V = SHM_K;
constexpr float C2 = 0.08838834764831845f * 1.4426950408889634f;
#define KSWZ(row, colB) ((row) * 256 + ((colB) ^ (((row) & 7) << 4)))
__device__ __forceinline__ int v_st(int k, int c) { const int kk = (k & ~0xC) | ((k & 4) << 1) | ((k & 8) >> 1); return ((kk >> 3) * 4 + (c >> 5)) * 512 + ((kk & 7) * 32 + (c & 31)) * 2; }
__device__ __forceinline__ int v_rd_base(int lane) { return ((lane & 3) << 3) | (((lane >> 2) & 3) << 6) | (((lane >> 4) & 1) << 5) | (((lane >> 5) & 1) << 8); }
constexpr int v_rd_off(int d0, int ks, int half) { return d0 * 512 + ks * 4096 + half * 2048; }
__device__ __forceinline__ int crow(int r, int hi) { return (r & 3) + 8 * (r >> 2) + 4 * hi; }

template <int KB>
__device__ __forceinline__ void qkt(f32x16& p0, f32x16& p1, const char* K_lds, int r32, int hi, const char* qfrag, bool act) {
    if (!act) { const float NEG = -__builtin_inff();
#pragma unroll
        for (int r = 0; r < 16; ++r) { p0[r] = NEG; p1[r] = NEG; } return; }
    p0 = f32x16{}; p1 = f32x16{};
    const char* kb[4];
#pragma unroll
    for (int dd = 0; dd < 4; ++dd) kb[dd] = K_lds + KB * SHM_K + KSWZ(r32, (dd * 16 + hi * 8) * 2);
#pragma unroll
    for (int d0 = 0; d0 < 8; ++d0) { const char* a = kb[d0 & 3] + (d0 >> 2) * 128;
        bf16x8 b0 = *reinterpret_cast<const bf16x8*>(a);
        bf16x8 b1 = *reinterpret_cast<const bf16x8*>(a + 32 * 256);
        const bf16x8 q = *reinterpret_cast<const bf16x8*>(qfrag + d0 * 1024);
        p0 = __builtin_amdgcn_mfma_f32_32x32x16_bf16(b0, q, p0, 0, 0, 0);
        p1 = __builtin_amdgcn_mfma_f32_32x32x16_bf16(b1, q, p1, 0, 0, 0); }
}
template <int VB>
__device__ __forceinline__ void pv_tile(f32x16* o, int vb0, bf16x8 pa0, bf16x8 pa1, bf16x8 pa2, bf16x8 pa3, bool act) {
    if (!act) return;
#define TRRD(dst, off) asm volatile("ds_read_b64_tr_b16 %0, %1 offset:%2" : "=&v"(dst) : "v"(vb0), "i"(off) : "memory")
#define PV_D0(d0) do { s16x4 l0, l1, l2, l3, h0, h1, h2, h3; constexpr int b_ = VB * SHM_V + v_rd_off(d0, 0, 0); \
        TRRD(l0, b_); TRRD(h0, b_ + 2048); TRRD(l1, b_ + 4096); TRRD(h1, b_ + 6144); TRRD(l2, b_ + 8192); TRRD(h2, b_ + 10240); TRRD(l3, b_ + 12288); TRRD(h3, b_ + 14336); \
        asm volatile("s_waitcnt lgkmcnt(0)" ::: "memory"); SBAR(); \
        o[d0] = __builtin_amdgcn_mfma_f32_32x32x16_bf16(pa0, (bf16x8){l0[0], l0[1], l0[2], l0[3], h0[0], h0[1], h0[2], h0[3]}, o[d0], 0, 0, 0);   \
        o[d0] = __builtin_amdgcn_mfma_f32_32x32x16_bf16(pa1, (bf16x8){l1[0], l1[1], l1[2], l1[3], h1[0], h1[1], h1[2], h1[3]}, o[d0], 0, 0, 0);   \
        o[d0] = __builtin_amdgcn_mfma_f32_32x32x16_bf16(pa2, (bf16x8){l2[0], l2[1], l2[2], l2[3], h2[0], h2[1], h2[2], h2[3]}, o[d0], 0, 0, 0);   \
        o[d0] = __builtin_amdgcn_mfma_f32_32x32x16_bf16(pa3, (bf16x8){l3[0], l3[1], l3[2], l3[3], h3[0], h3[1], h3[2], h3[3]}, o[d0], 0, 0, 0); } while (0)
    PV_D0(0); PV_D0(1); PV_D0(2); PV_D0(3);
#undef PV_D0
#undef TRRD
}
__device__ __forceinline__ void sm_a(f32x16& p0) {
#pragma unroll
    for (int r = 0; r < 16; ++r) p0[r] = __builtin_amdgcn_exp2f(p0[r]);
}
__device__ __forceinline__ void sm_b(f32x16& p0, f32x16& p1, float& l_reg, bf16x8& pa0, bf16x8& pa1, bf16x8& pa2, bf16x8& pa3) {
#pragma unroll
    for (int r = 0; r < 16; ++r) p1[r] = __builtin_amdgcn_exp2f(p1[r]);
    float ps = 0;
#pragma unroll
    for (int r = 0; r < 16; ++r) ps += p0[r];
#pragma unroll
    for (int r = 0; r < 16; ++r) ps += p1[r];
    l_reg += ps;
#define PK4(P, B_, OUT) do { unsigned a0 = cvtpk(P[B_+0], P[B_+1]), a1 = cvtpk(P[B_+2], P[B_+3]); \
        unsigned b0 = cvtpk(P[B_+4], P[B_+5]), b1 = cvtpk(P[B_+6], P[B_+7]); \
        auto r0 = __builtin_amdgcn_permlane32_swap(a0, b0, false, false); auto r1 = __builtin_amdgcn_permlane32_swap(a1, b1, false, false); \
        v4u w = {r0[0], r1[0], r0[1], r1[1]}; OUT = *reinterpret_cast<bf16x8*>(&w); } while (0)
    PK4(p0, 0, pa0); PK4(p0, 8, pa1); PK4(p1, 0, pa2); PK4(p1, 8, pa3);
#undef PK4
}

__device__ __forceinline__ void attn_unit(Frame& F, const Args& args, int b, int h, int iq) {
    int tid = F.tid; asm volatile("" : "+v"(tid));
    const int wid = F.wave, lane = tid & 63, r32 = lane & 31, hi = lane >> 5;
    char* lds = F.ldsg;
    char* V_lds = lds; char* K_lds = lds + 2 * SHM_V;
    float* kml = (float*)(lds + XTRA_OFF);
    char* qfrag = lds + 65536 + wid * 8192 + lane * 16;
    const bf16* QR = WSP(bf16, WS_E) + 2 * E_STRIDE; const bf16* KN = WSP(bf16, WS_E) + 3 * E_STRIDE; const bf16* VV = WSP(bf16, WS_E) + 4 * E_STRIDE;
    bf16* YA = WSP(bf16, WS_YCAT) + 1024;
    const size_t mb = (size_t)b * SEQ;
    const int q0 = iq * 256, NT = 4 * (iq + 1);
    const bf16* Kh = KN + mb * DM + h * HD; const bf16* Vh = VV + mb * DM + h * HD;
    { const float* kmg = WSP(float, WS_KMEAN) + (size_t)(b * NH + h) * 16 * HD; for (int idx = tid; idx < iq * HD; idx += 512) kml[idx] = kmg[idx]; }
    const int sr = tid >> 4, sc = (tid & 15) * 8, vst0 = v_st(sr, sc), vst1 = v_st(32 + sr, sc), kws = KSWZ(sr, sc * 2);
    const int vb0 = (int)(uintptr_t)V_lds + v_rd_base(lane);
    bf16x8 st_v0, st_v1, st_k0, st_k1;
    const unsigned goff = (unsigned)(sr * DM + sc) * 2u;
#define ROWP(p, k0, rr) ((const char*)((p) + (size_t)((k0) + (rr)) * DM) + goff)
#define SLOAD(k0) do { st_v0 = *(const bf16x8*)ROWP(Vh, k0, 0); st_v1 = *(const bf16x8*)ROWP(Vh, k0, 32); st_k0 = *(const bf16x8*)ROWP(Kh, k0, 0); st_k1 = *(const bf16x8*)ROWP(Kh, k0, 32); } while (0)
#define SWRITE(bf) do { *(bf16x8*)(V_lds + (bf) * SHM_V + vst0) = st_v0; *(bf16x8*)(V_lds + (bf) * SHM_V + vst1) = st_v1; \
                        *(bf16x8*)(K_lds + (bf) * SHM_K + kws) = st_k0; *(bf16x8*)(K_lds + (bf) * SHM_K + kws + 32 * 256) = st_k1; } while (0)
    SLOAD(0);
    const size_t mq = mb + q0 + wid * 32 + r32;
    unsigned selmask;
    {
        bf16x8 qr[8];
        const bf16* qp = QR + mq * DM + h * HD + hi * 8;
        v4u raw[8];
#pragma unroll
        for (int d0 = 0; d0 < 8; ++d0) raw[d0] = *(const v4u*)(qp + d0 * 16);
        float ss = 0.f;
#pragma unroll
        for (int d0 = 0; d0 < 8; ++d0) { const float a0 = bflo(raw[d0].x), a1 = bfhi(raw[d0].x), a2 = bflo(raw[d0].y), a3 = bfhi(raw[d0].y), a4 = bflo(raw[d0].z), a5 = bfhi(raw[d0].z), a6 = bflo(raw[d0].w), a7 = bfhi(raw[d0].w);
            ss += (a0 * a0 + a1 * a1) + (a2 * a2 + a3 * a3) + (a4 * a4 + a5 * a5) + (a6 * a6 + a7 * a7); }
        ss += __shfl_xor(ss, 32);
        const float rs = C2 / sqrtf(ss * (1.f / HD) + EPS);
        const float* qg = IN_F(15) + hi * 8;
#define UNPK(f, W_) do { const v4u t_ = (W_); f[0] = bflo(t_.x); f[1] = bfhi(t_.x); f[2] = bflo(t_.y); f[3] = bfhi(t_.y); f[4] = bflo(t_.z); f[5] = bfhi(t_.z); f[6] = bflo(t_.w); f[7] = bfhi(t_.w); } while (0)
#define PACK(f) ({ v4u w_; w_.x = cvtpk(f[0], f[1]); w_.y = cvtpk(f[2], f[3]); w_.z = cvtpk(f[4], f[5]); w_.w = cvtpk(f[6], f[7]); *reinterpret_cast<bf16x8*>(&w_); })
        { float f0[8], f1[8]; UNPK(f0, raw[0]); UNPK(f1, raw[1]);
          const float* tg = WSP(float, WS_TRIG) + mq * 32 + hi * 8;
#pragma unroll
          for (int j = 0; j < 8; ++j) { const float x1 = f0[j] * rs * qg[j], x2 = f1[j] * rs * qg[16 + j], cs = tg[j], sn = tg[16 + j]; f0[j] = x1 * cs - x2 * sn; f1[j] = x2 * cs + x1 * sn; }
          qr[0] = PACK(f0); qr[1] = PACK(f1); }
#pragma unroll
        for (int d0 = 2; d0 < 8; ++d0) { float f[8]; UNPK(f, raw[d0]);
#pragma unroll
            for (int j = 0; j < 8; ++j) f[j] *= rs * qg[d0 * 16 + j];
            qr[d0] = PACK(f); }
        __syncthreads();
        float v1 = -__builtin_inff(), v2 = v1, v3 = v1; int i1 = 0, i2 = 0, i3 = 0;
#pragma unroll 1
        for (int jb = 0; jb < iq; ++jb) { const float* km = kml + jb * HD + hi * 8; float g = 0.f;
#pragma unroll
            for (int d0 = 0; d0 < 8; ++d0) { float f[8]; UNPK(f, *reinterpret_cast<const v4u*>(&qr[d0]));
                const f32x4 k0 = *(const f32x4*)(km + d0 * 16), k1 = *(const f32x4*)(km + d0 * 16 + 4);
                g += (f[0] * k0[0] + f[1] * k0[1]) + (f[2] * k0[2] + f[3] * k0[3]) + (f[4] * k1[0] + f[5] * k1[1]) + (f[6] * k1[2] + f[7] * k1[3]); }
            g += __shfl_xor(g, 32);
            if (g > v1) { v3 = v2; i3 = i2; v2 = v1; i2 = i1; v1 = g; i1 = jb; }
            else if (g > v2) { v3 = v2; i3 = i2; v2 = g; i2 = jb; }
            else if (g > v3) { v3 = g; i3 = jb; } }
#undef UNPK
#undef PACK
        selmask = 0u; if (iq >= 1) selmask |= 1u << i1; if (iq >= 2) selmask |= 1u << i2; if (iq >= 3) selmask |= 1u << i3;
#pragma unroll
        for (int d0 = 0; d0 < 8; ++d0) *reinterpret_cast<bf16x8*>(qfrag + d0 * 1024) = qr[d0];
    }
    float l_reg = 0.f; f32x16 o[4] = {};
    const int wrow0 = wid * 32;
#define ACT(t) (((t) >> 2) < iq ? (__ballot((selmask >> ((t) >> 2)) & 1u) != 0ull) : ((((t) - 4 * iq) * 64) <= wrow0 + 31))
#define MASKT(P0_, P1_, t) do { const int blk_ = (t) >> 2; const float NEG_ = -__builtin_inff(); \
        if (blk_ < iq) { if (!((selmask >> blk_) & 1u)) { _Pragma("unroll") for (int r = 0; r < 16; ++r) { P0_[r] = NEG_; P1_[r] = NEG_; } } } \
        else { const int kb_ = ((t) - 4 * iq) * 64; if (kb_ + 63 > wrow0) { int dq_ = wrow0 + r32 - kb_ - 4 * hi; asm volatile("" : "+v"(dq_)); \
            _Pragma("unroll") for (int r = 0; r < 16; ++r) { const int c_ = (r & 3) + 8 * (r >> 2); if (c_ > dq_) P0_[r] = NEG_; if (c_ + 32 > dq_) P1_[r] = NEG_; } } } } while (0)
    f32x16 pA0, pA1, pB0, pB1; bf16x8 pa0, pa1, pa2, pa3;
    VM_WAIT(); SWRITE(0); SBAR();
    SLOAD(64);
    __syncthreads();
    SBAR(); qkt<0>(pA0, pA1, K_lds, r32, hi, qfrag, ACT(0));
    MASKT(pA0, pA1, 0); sm_a(pA0);
    VM_WAIT(); SWRITE(1);
    __syncthreads();
#define HALF_STEP(PX0, PX1, PY0, PY1, t, KB, VB, SB) do { \
        SBAR(); qkt<KB>(PX0, PX1, K_lds, r32, hi, qfrag, ACT(t)); \
        sm_b(PY0, PY1, l_reg, pa0, pa1, pa2, pa3); SBAR(); \
        if ((t) + 1 < NT) { SLOAD(((t) + 1) * 64); SBAR(); } \
        pv_tile<VB>(o, vb0, pa0, pa1, pa2, pa3, ACT((t) - 1)); MASKT(PX0, PX1, (t)); sm_a(PX0); \
        __syncthreads(); \
        if ((t) + 1 < NT) { VM_WAIT(); SWRITE(SB); } \
        __syncthreads(); } while (0)
    for (int t = 1; t + 1 < NT; t += 2) {
        HALF_STEP(pB0, pB1, pA0, pA1, t, 1, 0, 0);
        HALF_STEP(pA0, pA1, pB0, pB1, t + 1, 0, 1, 1);
    }
    SBAR(); qkt<1>(pB0, pB1, K_lds, r32, hi, qfrag, ACT(NT - 1)); SBAR();
    sm_b(pA0, pA1, l_reg, pa0, pa1, pa2, pa3); SBAR();
    pv_tile<0>(o, vb0, pa0, pa1, pa2, pa3, ACT(NT - 2));
    MASKT(pB0, pB1, NT - 1); sm_a(pB0);
    sm_b(pB0, pB1, l_reg, pa0, pa1, pa2, pa3); SBAR();
    pv_tile<1>(o, vb0, pa0, pa1, pa2, pa3, ACT(NT - 1));
    l_reg += __shfl_xor(l_reg, 32);
    float* li_l = (float*)(lds + XTRA_OFF + 8192) + wid * 32;
    if (hi == 0) li_l[r32] = l_reg;
    asm volatile("s_waitcnt lgkmcnt(0)" ::: "memory");
    float rli[16];
#pragma unroll
    for (int r = 0; r < 16; ++r) rli[r] = __builtin_amdgcn_rcpf(li_l[crow(r, hi)]);
    bf16* Ow = YA + (mb + q0 + wid * 32) * 2048 + h * HD;
#pragma unroll
    for (int r = 0; r < 16; ++r) { const int orow = crow(r, hi);
#pragma unroll
        for (int d0 = 0; d0 < 4; ++d0) { const float v = o[d0][r] * rli[r]; const float vn = __shfl_xor(v, 1);
            if ((r32 & 1) == 0) *(unsigned*)(Ow + (size_t)orow * 2048 + d0 * 32 + r32) = cvtpk(v, vn); } }
    __syncthreads();
#undef ROWP
#undef SLOAD
#undef SWRITE
#undef ACT
#undef MASKT
#undef HALF_STEP
}
#undef KSWZ
}

__device__ __forceinline__ void p7_router(Frame& F, const Args& args) {
    LAS float* ssq = (LAS float*)F.lds;
    LAS float* par = (LAS float*)(F.lds + 2048);
    LAS float* lg = (LAS float*)(F.lds + 10240);
    LAS int* hist = (LAS int*)(F.lds + 77824 + 2048);
    LAS int* sel = (LAS int*)(F.lds + 77824 + 4096);
    const float* g2n = IN_F(6); const float* mod = WSP(float, WS_MOD); const float* brt = IN_F(21);
    unsigned char* H2 = WSP(unsigned char, WS_HB);
    unsigned* CNT = (unsigned*)(F.ws + WS_CTL) + CW_CNT;
    const int row = F.lane & 15, q = F.lane >> 4, kw = F.wave * 128;
    bf16x8 Bh[4][2], Bl[4][2];
    { const bf16* wh = WSP(bf16, WS_WRH) + (size_t)row * 1024 + kw + 8 * q; const bf16* wl = WSP(bf16, WS_WRL) + (size_t)row * 1024 + kw + 8 * q;
#pragma unroll
      for (int s = 0; s < 4; ++s) { Bh[s][0] = *(const bf16x8*)(wh + 32 * s); Bh[s][1] = *(const bf16x8*)(wh + 16384 + 32 * s); Bl[s][0] = *(const bf16x8*)(wl + 32 * s); Bl[s][1] = *(const bf16x8*)(wl + 16384 + 32 * s); } }
    for (int vw = F.vcu; vw < 256; vw += F.G) {
        const int m0 = vw * 64, b = m0 >> 12;
        for (int i = F.tid; i < 1024; i += 512) { par[i] = g2n[i] * (1.0f + mod[b * 6144 + 4096 + i]); par[1024 + i] = mod[b * 6144 + 3072 + i]; }
        if (F.tid < 32) hist[F.tid] = 0;
#pragma unroll
        for (int rt = 0; rt < 4; ++rt) { const float* xp = F.out + (size_t)(m0 + rt * 16 + row) * DM + kw + 8 * q; float ss = 0.f;
#pragma unroll
            for (int s = 0; s < 4; ++s) { const f32x4 x0 = *(const f32x4*)(xp + 32 * s), x1 = *(const f32x4*)(xp + 32 * s + 4); const f32x4 a = x0 * x0 + x1 * x1; ss += (a.x + a.y) + (a.z + a.w); }
            ss += __shfl_xor(ss, 16); ss += __shfl_xor(ss, 32);
            if (q == 0) ssq[F.wave * 64 + rt * 16 + row] = ss; }
        __syncthreads();
#pragma unroll
        for (int rt = 0; rt < 4; ++rt) { const int rl = rt * 16 + row; float tot = 0.f;
#pragma unroll
            for (int w = 0; w < 8; ++w) tot += ssq[w * 64 + rl];
            const float rstd = 1.0f / sqrtf(tot * (1.f / DM) + EPS);
            f32x4 acc0 = {0.f, 0.f, 0.f, 0.f}, acc1 = {0.f, 0.f, 0.f, 0.f};
            unsigned char* hp = H2 + (size_t)(m0 + rl) * DM + kw + 8 * q; const float* xp = F.out + (size_t)(m0 + rl) * DM + kw + 8 * q;
            f32x4 xq[4][2];
#pragma unroll
            for (int s = 0; s < 4; ++s) { xq[s][0] = *(const f32x4*)(xp + 32 * s); xq[s][1] = *(const f32x4*)(xp + 32 * s + 4); }
#pragma unroll
            for (int s = 0; s < 4; ++s) { const int col = kw + 32 * s + 8 * q; float h[8];
#pragma unroll
                for (int hf = 0; hf < 2; ++hf) { const f32x4 sc = *(const LAS f32x4*)(par + col + 4 * hf), sh = *(const LAS f32x4*)(par + 1024 + col + 4 * hf);
                    const f32x4 t = xq[s][hf] * rstd * sc + sh; h[4 * hf] = t.x; h[4 * hf + 1] = t.y; h[4 * hf + 2] = t.z; h[4 * hf + 3] = t.w; }
                v4u hi; hi.x = cvtpk(h[0], h[1]); hi.y = cvtpk(h[2], h[3]); hi.z = cvtpk(h[4], h[5]); hi.w = cvtpk(h[6], h[7]);
                { v2u h8; h8.x = pg8::pk_fp8x4(h[0], h[1], h[2], h[3]); h8.y = pg8::pk_fp8x4(h[4], h[5], h[6], h[7]); *(v2u*)(hp + 32 * s) = h8; }
                v4u lo; lo.x = cvtpk(h[0] - bflo(hi.x), h[1] - bfhi(hi.x)); lo.y = cvtpk(h[2] - bflo(hi.y), h[3] - bfhi(hi.y)); lo.z = cvtpk(h[4] - bflo(hi.z), h[5] - bfhi(hi.z)); lo.w = cvtpk(h[6] - bflo(hi.w), h[7] - bfhi(hi.w));
                const bf16x8 ah = *reinterpret_cast<bf16x8*>(&hi), al = *reinterpret_cast<bf16x8*>(&lo);
                acc0 = __builtin_amdgcn_mfma_f32_16x16x32_bf16(ah, Bh[s][0], acc0, 0, 0, 0); acc0 = __builtin_amdgcn_mfma_f32_16x16x32_bf16(ah, Bl[s][0], acc0, 0, 0, 0); acc0 = __builtin_amdgcn_mfma_f32_16x16x32_bf16(al, Bh[s][0], acc0, 0, 0, 0);
                acc1 = __builtin_amdgcn_mfma_f32_16x16x32_bf16(ah, Bh[s][1], acc1, 0, 0, 0); acc1 = __builtin_amdgcn_mfma_f32_16x16x32_bf16(ah, Bl[s][1], acc1, 0, 0, 0); acc1 = __builtin_amdgcn_mfma_f32_16x16x32_bf16(al, Bh[s][1], acc1, 0, 0, 0); }
#pragma unroll
            for (int r = 0; r < 4; ++r) { lg[(F.wave * 64 + rt * 16 + 4 * q + r) * 33 + row] = acc0[r]; lg[(F.wave * 64 + rt * 16 + 4 * q + r) * 33 + 16 + row] = acc1[r]; } }
        __syncthreads();
        { const int rowl = F.tid >> 3, eq = F.tid & 7; float v[4];
#pragma unroll
          for (int j = 0; j < 4; ++j) { float a = brt[4 * eq + j];
#pragma unroll
              for (int w = 0; w < 8; ++w) a += lg[(w * 64 + rowl) * 33 + 4 * eq + j];
              v[j] = a; }
          float tv[4]; int te[4];
#pragma unroll
          for (int k = 0; k < 4; ++k) { float gm = fmaxf(fmaxf(v[0], v[1]), fmaxf(v[2], v[3]));
              gm = fmaxf(gm, __shfl_xor(gm, 1)); gm = fmaxf(gm, __shfl_xor(gm, 2)); gm = fmaxf(gm, __shfl_xor(gm, 4));
              int ci = v[0] == gm ? 4 * eq : v[1] == gm ? 4 * eq + 1 : v[2] == gm ? 4 * eq + 2 : v[3] == gm ? 4 * eq + 3 : 99;
              ci = min(ci, __shfl_xor(ci, 1)); ci = min(ci, __shfl_xor(ci, 2)); ci = min(ci, __shfl_xor(ci, 4));
              te[k] = ci; tv[k] = gm;
#pragma unroll
              for (int j = 0; j < 4; ++j) if (ci == 4 * eq + j) v[j] = -__builtin_inff(); }
          if (eq == 0) { const float w1 = __expf(tv[1] - tv[0]), w2 = __expf(tv[2] - tv[0]), w3 = __expf(tv[3] - tv[0]); const float inv = 1.0f / (1.0f + w1 + w2 + w3);
              const float gk[4] = {inv, w1 * inv, w2 * inv, w3 * inv};
#pragma unroll
              for (int k = 0; k < 4; ++k) { const int lr = atomicAdd((int*)&hist[te[k]], 1); sel[rowl * 4 + k] = te[k]; sel[256 + rowl * 4 + k] = lr; sel[512 + rowl * 4 + k] = __float_as_int(gk[k]); } } }
        __syncthreads();
        if (F.tid < 32) { const int hc = hist[F.tid]; hist[32 + F.tid] = hc ? (int)__hip_atomic_fetch_add(CNT + F.tid, (unsigned)hc, RLX_AGENT) : 0; }
        __syncthreads();
        if (F.tid < 256) { const int e = sel[F.tid], pos = hist[32 + e] + sel[256 + F.tid], mm = m0 + (F.tid >> 2);
            WSP(int, WS_ROWTOK)[(size_t)e * ECAP + pos] = mm; WSP(int, WS_ROWGATE)[(size_t)e * ECAP + pos] = sel[512 + F.tid];
            WSP(int, WS_TOKE)[mm * 4 + (F.tid & 3)] = e; WSP(int, WS_TOKPOS)[mm * 4 + (F.tid & 3)] = pos; }
        __syncthreads();
    }
}

constexpr int MOE_TBL_OFF = XTRA_OFF, MOE_LIST_OFF = XTRA_OFF + 2048;
__device__ __forceinline__ int moe_tables(Frame& F) {
    LAS int* tbl = (LAS int*)(F.lds + MOE_TBL_OFF);
    const unsigned* CNT = (const unsigned*)(F.ws + WS_CTL) + CW_CNT;
    if (F.tid < 32) tbl[F.tid] = (int)__hip_atomic_load(CNT + F.tid, RLX_AGENT);
    __syncthreads();
    if (F.tid == 0) { int run = 0;
#pragma unroll 1
        for (int e = 0; e < 32; ++e) { tbl[32 + e] = run; const int nb = (tbl[e] + 255) >> 8;
#pragma unroll 1
            for (int bb = 0; bb < nb; ++bb) tbl[80 + run + bb] = e;
            run += nb; }
        tbl[64] = run; }
    __syncthreads();
    int nblk = tbl[64]; if (nblk > MAXBLK) nblk = MAXBLK; if (nblk < 1) nblk = 1;
    return __builtin_amdgcn_readfirstlane(nblk);
}

__device__ __forceinline__ void p11_combine(Frame& F, const Args& args) {
    (void)moe_tables(F);
    const LAS int* tbl = (const LAS int*)(F.lds + MOE_TBL_OFF);
    const float* mod = WSP(float, WS_MOD); const bf16* YR = WSP(bf16, WS_YR);
    const int gw = F.vcu * NWAVES + F.wave, NGW = F.G * NWAVES;
    for (int m = gw; m < NTOK; m += NGW) {
        const int b = m >> 12;
        int dk = 0; if (F.lane < 4) { const int e = __hip_atomic_load(WSP(int, WS_TOKE) + m * 4 + F.lane, RLX_AGENT); dk = tbl[32 + e] * 256 + __hip_atomic_load(WSP(int, WS_TOKPOS) + m * 4 + F.lane, RLX_AGENT); }
        const int d0 = __shfl(dk, 0), d1 = __shfl(dk, 1), d2 = __shfl(dk, 2), d3 = __shfl(dk, 3);
        f32x4* xr = (f32x4*)(F.out + (size_t)m * DM) + F.lane;
#pragma unroll
        for (int j = 0; j < 4; ++j) { const int col = 4 * F.lane + 256 * j;
            const v2u y0 = *(const v2u*)(YR + (size_t)d0 * DM + col), y1 = *(const v2u*)(YR + (size_t)d1 * DM + col), y2 = *(const v2u*)(YR + (size_t)d2 * DM + col), y3 = *(const v2u*)(YR + (size_t)d3 * DM + col);
            f32x4 s;
            s.x = (bflo(y0.x) + bflo(y1.x)) + (bflo(y2.x) + bflo(y3.x)); s.y = (bfhi(y0.x) + bfhi(y1.x)) + (bfhi(y2.x) + bfhi(y3.x));
            s.z = (bflo(y0.y) + bflo(y1.y)) + (bflo(y2.y) + bflo(y3.y)); s.w = (bfhi(y0.y) + bfhi(y1.y)) + (bfhi(y2.y) + bfhi(y3.y));
            const f32x4 g2 = *(const f32x4*)(mod + b * 6144 + 5120 + col);
            xr[64 * j] = xr[64 * j] + g2 * s; }
    }
}

#ifndef MK_N_LAUNCHES
#define MK_N_LAUNCHES 1
#endif
constexpr int PER_PHASE = 12;
constexpr int N_LAUNCHES = MK_N_LAUNCHES;

__global__ void __launch_bounds__(NWAVES * 64, 2) hybrid_fwd(Args args) {
    extern __shared__ __attribute__((aligned(16))) unsigned char lds[];
    Frame F;
    F.lds = (LAS unsigned char*)lds; F.ldsg = (char*)lds;
    F.MISC = (volatile LAS unsigned*)(F.lds + MISC_OFF);
    F.tid = threadIdx.x; F.lane = F.tid & 63; F.wave = __builtin_amdgcn_readfirstlane(F.tid >> 6);
    F.G = gridDim.x; { const int bx = blockIdx.x; F.vcu = (F.G % 8 == 0) ? (bx % 8) * (F.G / 8) + bx / 8 : bx; }
    F.ws = args.ws; F.out = args.out;
    gu32* ctl = (gu32*)(args.ws + WS_CTL);
    for (int u = F.tid; u < (LDS_BYTES - LDSCTL_OFF) / 4; u += NWAVES * 64) ((LAS unsigned*)(F.lds + LDSCTL_OFF))[u] = 0u;
    __syncthreads();
    XcdBarrier bar; bar.bar = (unsigned*)(ctl + CW_BAR); bar.x = 0; bar.st = nullptr;
    if (N_LAUNCHES == 1) bar = xcd_barrier_post((unsigned*)(ctl + CW_BAR), F.MISC + 8);
    const int lo = args.ph_lo, hi = args.ph_hi;
#ifndef PHASE_MASK
#define PHASE_MASK 0xFFF
#endif
#define IN(k) (((PHASE_MASK >> (k)) & 1) && lo <= (k) && (k) < hi)
#define NEXTP(k) ((k) == 0 ? 2 : (k) == 7 ? 9 : (k) + 1)
#define SEAM(k) do { if (IN(k) && IN(NEXTP(k))) xcd_barrier(bar); } while (0)

#ifndef DUP_MASK
#define DUP_MASK 0
#endif
#define PHASE(k, ...) do { if (IN(k)) { __VA_ARGS__ if ((DUP_MASK >> (k)) & 1) { xcd_barrier(bar); __VA_ARGS__ } } SEAM(k); } while (0)
    PHASE(0, { p0_prologue(F, args); p1_hrows(F, args); });
    PHASE(2, {
        { pg8::Gemm g{WSP(bf16, WS_HB), WSP(bf16, WS_WIN), NTOK, 3072, DM}; pg8::TileOrder S; S.init(NTOK / 256, 12, F.G, (int)blockIdx.x, nullptr);
          pg8::EpiWin E{WSP(bf16, WS_E), IN_F(17), 0};
          pg8::gemm_phase<pg8::EpiWin, pg8::TileOrder, true, true>(F.lds + RING_OFF, g, S, E); }
        { pg8::Gemm g{WSP(bf16, WS_H8), WSP(bf16, WS_WIN8), NTOK, 4096, DM / 2}; pg8::TileOrder S; S.init(NTOK / 256, 16, F.G, (int)blockIdx.x, nullptr);
          pg8::EpiWin E{WSP(bf16, WS_E), IN_F(17), 1};
          pg8::gemm_phase<pg8::EpiWin, pg8::TileOrder, true, true, false, true>(F.lds + RING_OFF, g, S, E); }
    });
    int p3rep = 0;
    PHASE(3, {
        for (int u = F.vcu; u < 512; u += F.G) p3_rnn_local_unit(F, args, u);
        if (p3rep++ == 0) { for (int u = F.vcu; u < 512; u += F.G) p3_knorm_unit(F, args, u); }
    });
    PHASE(4, {
        for (int it = F.vcu; it < 256; it += F.G) { const int bh = it >> 3, s = it & 7;
            for (int pass = 0; pass < 2; ++pass) att::attn_unit(F, args, bh >> 3, bh & 7, pass ? s : 15 - s); }
        for (int u = F.vcu; u < 512; u += F.G) p4_rnn_final_unit(F, args, u);
    });
    PHASE(5, {
        pg8::Gemm g{WSP(bf16, WS_YCAT), WSP(bf16, WS_WB), NTOK, DM, 2 * DM}; pg8::TileOrder S; S.init(NTOK / 256, DM / 256, F.G, (int)blockIdx.x, nullptr);
        pg8::EpiBranch E{WSP(bf16, WS_E) + 5 * E_STRIDE, WSP(bf16, WS_E) + 6 * E_STRIDE, WSP(bf16, WS_HB)};
        pg8::gemm_phase<pg8::EpiBranch, pg8::TileOrder, false, true>(F.lds + RING_OFF, g, S, E);
    });
    PHASE(6, {
        pg8::Gemm g{WSP(bf16, WS_HB), WSP(bf16, WS_WO), NTOK, DM, DM}; pg8::TileOrder S; S.init(NTOK / 256, DM / 256, F.G, (int)blockIdx.x, nullptr);
        pg8::EpiWout E{IN_F(0), F.out, WSP(float, WS_MOD)};
        pg8::gemm_phase<pg8::EpiWout, pg8::TileOrder, false, true>(F.lds + RING_OFF, g, S, E);
    });
    PHASE(7, { p7_router(F, args); p8_moe_weights(F, args); });
    PHASE(9, {
        const int nblk = moe_tables(F);
        const LAS int* tbl = (const LAS int*)(F.lds + MOE_TBL_OFF); LAS int* lists = (LAS int*)(F.lds + MOE_LIST_OFF);
        pg8::Gemm g{WSP(bf16, WS_HB), WSP(bf16, WS_WUP), RMAX, 2048 * NEXP, DM / 2}; pg8::TileOrder S; S.init(nblk, 8, F.G, (int)blockIdx.x, tbl + 80, F.ws + WS_HB);
        { pg8::Unit u; for (int i = 0; i < 9 && S.next(i, u); ++i) { if (F.tid < 256) { const int e = u.pn >> 3, pos = (u.pm - tbl[32 + e]) * 256 + F.tid;
              lists[i * 256 + F.tid] = pos < tbl[e] ? __hip_atomic_load(WSP(int, WS_ROWTOK) + (size_t)e * ECAP + pos, RLX_AGENT) : 0; } } }
        __syncthreads();
        pg8::EpiUp E{WSP(unsigned char, WS_ACT), IN_F(23)};
        pg8::gemm_phase<pg8::EpiUp, pg8::TileOrder, true, true, true, true>(F.lds + RING_OFF, g, S, E, lists);
    });
    PHASE(10, {
        const int nblk = moe_tables(F);
        const LAS int* tbl = (const LAS int*)(F.lds + MOE_TBL_OFF);
        pg8::Gemm g{WSP(bf16, WS_ACT), WSP(bf16, WS_WDN), RMAX, 1024 * NEXP, DM / 2}; pg8::TileOrder S; S.init(nblk, 4, F.G, (int)blockIdx.x, tbl + 80);
        pg8::EpiDown E{WSP(bf16, WS_YR), IN_F(25), WSP(float, WS_ROWGATE), tbl};
        pg8::gemm_phase<pg8::EpiDown, pg8::TileOrder, true, true, false, true>(F.lds + RING_OFF, g, S, E);
    });
    PHASE(11, { p11_combine(F, args); });
#undef PHASE
#undef IN
#undef SEAM
}

extern "C" void kernel_launch(void* const* d_in, const int* in_sizes, int n_in, void* d_out, int out_size, void* d_ws, size_t ws_size, hipStream_t stream) {
    static int grid = 0;
    if (grid == 0) {
        if (n_in != 26 || in_sizes[0] != NTOK * DM || out_size != NTOK * DM || ws_size < WS_END) {
            fprintf(stderr, "kernel_launch: shape/workspace mismatch (n_in %d, in0 %d, out %d, ws %zu; need ws >= %zu); nothing launched\n", n_in, n_in > 0 ? in_sizes[0] : -1, out_size, ws_size, (size_t)WS_END); grid = -1; return; }
        int dev = 0, cus = 0, per_cu = 0;
        if (hipGetDevice(&dev) != hipSuccess || hipDeviceGetAttribute(&cus, hipDeviceAttributeMultiprocessorCount, dev) != hipSuccess) { fprintf(stderr, "kernel_launch: device query failed\n"); grid = -1; return; }
        if (hipFuncSetAttribute((const void*)hybrid_fwd, hipFuncAttributeMaxDynamicSharedMemorySize, LDS_BYTES) != hipSuccess) { fprintf(stderr, "kernel_launch: hipFuncSetAttribute failed\n"); grid = -1; return; }
        if (hipOccupancyMaxActiveBlocksPerMultiprocessor(&per_cu, (const void*)hybrid_fwd, NWAVES * 64, LDS_BYTES) != hipSuccess || per_cu < 1) { fprintf(stderr, "kernel_launch: occupancy query says %d blocks/CU\n", per_cu); per_cu = 1; }
        (void)hipGetLastError();
        grid = cus;
        if (grid > 256) grid = 256;
    }
    if (grid < 0) return;
    (void)hipMemsetAsync((char*)d_ws + WS_CTL, 0, CTL_ZERO_BYTES, stream);
    Args a{};
    for (int i = 0; i < 26; ++i) a.in[i] = d_in[i];
    a.out = (float*)d_out; a.ws = (unsigned char*)d_ws;
    for (int li = 0; li < N_LAUNCHES; ++li) {
        a.ph_lo = (N_LAUNCHES == 1) ? 0 : li; a.ph_hi = (N_LAUNCHES == 1) ? PER_PHASE : li + 1;
        hipLaunchKernelGGL(hybrid_fwd, dim3(grid), dim3(NWAVES * 64), LDS_BYTES, stream, a);
        const hipError_t le = hipPeekAtLastError();
        if (le != hipSuccess) { fprintf(stderr, "kernel_launch: launch %d failed: %s\n", li, hipGetErrorName(le)); break; }
    }
}
```

```cpp
#include <hip/hip_runtime.h>
#include <hip/hip_bf16.h>
#include <cstdio>
#include <cstdint>
#include <cmath>
namespace pg8 {
#define PG8_LAS __attribute__((address_space(3)))
typedef unsigned short bf16_t;
typedef short bf16x8 __attribute__((ext_vector_type(8)));
typedef float f32x4 __attribute__((ext_vector_type(4)));
typedef unsigned u32x4 __attribute__((ext_vector_type(4)));
constexpr int BM = 256, BK = 64, HALF = 128, HTB = HALF * BK * 2  , STAGE_BYTES = 8 * HTB, NXCD = 8, WGM = 8;

__host__ __device__ __forceinline__ int lds_byte(int r, int c) { const int st = (r >> 4) * 2 + (c >> 5), rr = r & 15, cc = c & 31, ob = rr * 64 + cc * 2; return st * 1024 + (ob ^ (((ob >> 9) & 1) << 5)); }
__host__ __device__ __forceinline__ void stage_rc(int b, int& R, int& C) { const int st = b / 1024, sb = b % 1024, swz = sb ^ (((sb >> 9) & 1) << 5); R = (st >> 1) * 16 + swz / 64; C = (st & 1) * 32 + (swz % 64) / 2; }
__host__ __device__ __forceinline__ int perm32(int rho) { const int n = rho >> 4, i = rho & 15; return 8 * (i >> 2) + 4 * n + (i & 3); }

struct Unit { int pm, pn, kind; };
struct Gemm { const bf16_t* A; const bf16_t* Bt; int M, N, K; };

struct StaticOrder {
    int nM, nN, nwg, G, c;
    __host__ __device__ void init(int M, int N, int G_, int c_) { nM = M / BM; nN = N / BM; nwg = nM * nN; G = G_; c = c_; }
    __host__ __device__ bool next(int i, Unit& u) const {
        const long L = (long)i * G + c; if (L >= nwg) return false;
        int wgid = (int)L; { const int q = nwg / NXCD, r = nwg % NXCD, xcd = wgid % NXCD, off = wgid / NXCD; wgid = (xcd < r ? xcd * (q + 1) : r * (q + 1) + (xcd - r) * q) + off; }
        const int nig = WGM * nN, gid = wgid / nig, fm = gid * WGM, gsz = (nM - fm) < WGM ? (nM - fm) : WGM;
        u.pm = fm + ((wgid % nig) % gsz); u.pn = (wgid % nig) / gsz; return true;
    }
    __device__ __forceinline__ void a_ready(const Unit&) const {}
    __device__ __forceinline__ void done(const Unit&) const {}
};

__device__ __forceinline__ unsigned cvt_pk_bf16(float lo, float hi) { unsigned r; asm volatile("v_cvt_pk_bf16_f32 %0, %1, %2" : "=v"(r) : "v"(lo), "v"(hi)); return r; }
typedef int v4i_t __attribute__((ext_vector_type(4)));
typedef int v8i_t __attribute__((ext_vector_type(8)));
template <class Epi, class Sched, bool ALIGN_EPI = false, bool SP2 = false, bool GATHER = false, bool FP8 = false>
__device__ __forceinline__ void gemm_phase(PG8_LAS unsigned char* lds, const Gemm g, const Sched& S, const Epi& E, const PG8_LAS int* rowlists = nullptr) {
    static_assert(!GATHER || SP2, "GATHER is implemented for the SP2 loop");
    const int tid = threadIdx.x, wid = __builtin_amdgcn_readfirstlane(tid >> 6), lane = tid & 63, wr = wid >> 2, wc = wid & 3, fr = lane & 15, fq = lane >> 4;
    const int K = g.K, nt = K / BK;
    unsigned voffA, voffB; int gR, gC;
    { int R, C; stage_rc(tid * 16, R, C); const int Rb = Epi::PERM ? ((R & ~31) + perm32(R & 31)) : R; gR = R; gC = C;
      voffA = (unsigned)(R * K + C) * 2u; voffB = (unsigned)(Rb * K + C) * 2u; }
    const size_t row64 = (size_t)64 * K * 2;
    const size_t kstep = (size_t)(BK * 2);
    const size_t hstep = (size_t)HALF * K * 2;
    const size_t tstep = 2 * hstep;
    const unsigned ldsw = (unsigned)wid * 1024u;
    const int aoff = lds_byte(wr * 64 + fr, fq * 8), boff = lds_byte(wc * 32 + fr, fq * 8);
#define PG8_SA(b, h) (((b) * 2 + (h)) * HTB)
#define PG8_SB(b, h) ((4 + (b) * 2 + (h)) * HTB)
#define PG8_STAGE2(bufoff, gbase, v0_, v1_) do { unsigned vo0_ = (v0_), vo1_ = (v1_); asm volatile("" : "+v"(vo0_), "+v"(vo1_));     \
        __builtin_amdgcn_global_load_lds((const unsigned*)((const char*)(gbase) + vo0_), (PG8_LAS unsigned*)(lds + (bufoff) + ldsw), 16, 0, 0); \
        __builtin_amdgcn_global_load_lds((const unsigned*)((const char*)(gbase) + vo1_), (PG8_LAS unsigned*)(lds + (bufoff) + ldsw + 8192), 16, 0, 0); } while (0)
#define PG8_STAGE(bufoff, gbase, voff) do { unsigned vo_ = (voff); asm volatile("" : "+v"(vo_)); \
        __builtin_amdgcn_global_load_lds((const unsigned*)((const char*)(gbase) + vo_), (PG8_LAS unsigned*)(lds + (bufoff) + ldsw), 16, 0, 0); \
        __builtin_amdgcn_global_load_lds((const unsigned*)((const char*)(gbase) + row64 + vo_), (PG8_LAS unsigned*)(lds + (bufoff) + ldsw + 8192), 16, 0, 0); } while (0)
#define PG8_LDA(dst, b, h) do { _Pragma("unroll") for (int m = 0; m < 4; ++m) _Pragma("unroll") for (int k = 0; k < 2; ++k) dst[m][k] = *(const PG8_LAS bf16x8*)(lds + PG8_SA(b, h) + aoff + m * 2048 + k * 1024); } while (0)
#define PG8_LDB(dst, b, h) do { _Pragma("unroll") for (int n = 0; n < 2; ++n) _Pragma("unroll") for (int k = 0; k < 2; ++k) dst[n][k] = *(const PG8_LAS bf16x8*)(lds + PG8_SB(b, h) + boff + n * 2048 + k * 1024); } while (0)
#define PG8_CAT8(x, y) __builtin_shufflevector(__builtin_bit_cast(v4i_t, (x)), __builtin_bit_cast(v4i_t, (y)), 0, 1, 2, 3, 4, 5, 6, 7)
#define PG8_MMA(ai, bj, At, Bt) do { __builtin_amdgcn_s_setprio(1); _Pragma("unroll") for (int m = 0; m < 4; ++m) _Pragma("unroll") for (int n = 0; n < 2; ++n) { \
        if constexpr (FP8) { const v8i_t a8_ = PG8_CAT8(Bt[n][0], Bt[n][1]), b8_ = PG8_CAT8(At[m][0], At[m][1]);     \
            asm volatile("v_mfma_scale_f32_16x16x128_f8f6f4 %0, %1, %2, %0, %3, %4 op_sel_hi:[0,0,0]" : "+v"(acc[ai][bj][m][n]) : "v"(a8_), "v"(b8_), "v"(mxsa_), "v"(mxsb_)); } \
        else { _Pragma("unroll") for (int k = 0; k < 2; ++k) acc[ai][bj][m][n] = __builtin_amdgcn_mfma_f32_16x16x32_bf16(Bt[n][k], At[m][k], acc[ai][bj][m][n], 0, 0, 0); } } \
        __builtin_amdgcn_s_setprio(0); } while (0)
#define PG8_WAIT_V(n) asm volatile("s_waitcnt vmcnt(" #n ")" ::: "memory")
#define PG8_WAIT_VN(n) asm volatile("s_waitcnt vmcnt(%0)" :: "i"(n) : "memory")
#define PG8_WAIT_L(n) asm volatile("s_waitcnt lgkmcnt(" #n ")" ::: "memory")
#define PG8_BAR __builtin_amdgcn_s_barrier()
#define PG8_SCHED __builtin_amdgcn_sched_barrier(0)
    Unit cur, nxt; int ui = 0;
    if (!S.next(0, cur)) return;
    int mxsa_ = 121, mxsb_ = 127; asm volatile("" : "+v"(mxsa_), "+v"(mxsb_));
    f32x4 acc[2][2][4][2];
#pragma unroll
    for (int a = 0; a < 2; ++a)
#pragma unroll
        for (int b = 0; b < 2; ++b)
#pragma unroll
            for (int m = 0; m < 4; ++m)
#pragma unroll
                for (int n = 0; n < 2; ++n) acc[a][b][m][n] = (f32x4){0.f, 0.f, 0.f, 0.f};
    bf16x8 At[4][2], B0[2][2], B1[2][2];
    const char* cA = GATHER ? (const char*)S.a_base(cur) : (const char*)g.A + (size_t)cur.pm * tstep; const char* cB = (const char*)g.Bt + (size_t)cur.pn * tstep;
#define PG8_STAGE_A(bufoff, kptr, half, unx) do { if constexpr (GATHER) { const PG8_LAS int* rl_ = rowlists + (ui + (unx)) * 256 + (half) * HALF + gR; \
        PG8_STAGE2(bufoff, kptr, (unsigned)(rl_[0] * K + gC) * 2u, (unsigned)(rl_[64] * K + gC) * 2u); } \
        else { PG8_STAGE(bufoff, (kptr) + (half) * hstep, voffA); } } while (0)
    S.a_ready(cur);
    if constexpr (SP2) {
        PG8_STAGE(PG8_SB(0, 0), cB, voffB); PG8_STAGE(PG8_SB(0, 1), cB + hstep, voffB); PG8_STAGE_A(PG8_SA(0, 0), cA, 0, 0); PG8_STAGE_A(PG8_SA(0, 1), cA, 1, 0);
        if (wr == 1) PG8_BAR;
        PG8_WAIT_V(2); PG8_BAR;
        PG8_STAGE(PG8_SB(1, 0), cB + kstep, voffB); PG8_STAGE_A(PG8_SA(1, 0), cA + kstep, 0, 0); PG8_STAGE(PG8_SB(1, 1), cB + hstep + kstep, voffB);
        PG8_WAIT_V(6); PG8_BAR;
    } else {
        PG8_STAGE(PG8_SB(0, 0), cB, voffB); PG8_STAGE(PG8_SA(0, 0), cA, voffA); PG8_STAGE(PG8_SB(0, 1), cB + hstep, voffB); PG8_STAGE(PG8_SA(0, 1), cA + hstep, voffA);
        if (wr == 1) PG8_BAR;
        PG8_WAIT_V(4); PG8_BAR;
        PG8_STAGE(PG8_SB(1, 0), cB + kstep, voffB); PG8_STAGE(PG8_SA(1, 0), cA + kstep, voffA); PG8_STAGE(PG8_SB(1, 1), cB + hstep + kstep, voffB);
        PG8_WAIT_V(6); PG8_BAR;
    }
    for (;;) {
        const bool has_next = S.next(ui + 1, nxt);
        const char* nA = GATHER ? (has_next ? (const char*)S.a_base(nxt) : cA) : (has_next ? (const char*)g.A + (size_t)nxt.pm * tstep : cA);
        const char* nB = has_next ? (const char*)g.Bt + (size_t)nxt.pn * tstep : cB;
#pragma unroll 1
        for (int t = 0; t < nt; t += 2) {
            const bool last = (t == nt - 2);
            if constexpr (Epi::MIDK) { if (t == (nt >> 1)) { if constexpr (FP8) asm volatile("s_nop 15\n\ts_nop 7" ::: "memory"); E.mid(acc, cur, wr, wc, fr, fq); } }
            const char* a1 = cA + (size_t)(t + 1) * kstep;
            const char* a2 = last ? nA : cA + (size_t)(t + 2) * kstep; const char* b2 = last ? nB : cB + (size_t)(t + 2) * kstep;
            const char* a3 = a2 + kstep; const char* b3 = b2 + kstep;
            if (last && has_next) S.a_ready(nxt);
            const int unx = (GATHER && last && has_next) ? 1 : 0;
            if constexpr (SP2) {
            PG8_LDB(B0, 0, 0); PG8_LDB(B1, 0, 1); PG8_SCHED; PG8_LDA(At, 0, 0); PG8_STAGE_A(PG8_SA(1, 1), a1, 1, 0);
            PG8_WAIT_V(8); PG8_WAIT_L(0); PG8_BAR; PG8_MMA(0, 0, At, B0); PG8_MMA(0, 1, At, B1); PG8_BAR; PG8_SCHED;
            PG8_LDA(At, 0, 1); PG8_STAGE(PG8_SB(0, 0), b2, voffB); PG8_STAGE(PG8_SB(0, 1), b2 + hstep, voffB); PG8_STAGE_A(PG8_SA(0, 0), a2, 0, unx);
            PG8_WAIT_V(8); PG8_WAIT_L(0); PG8_BAR; PG8_MMA(1, 0, At, B0); PG8_MMA(1, 1, At, B1); PG8_BAR; PG8_SCHED;
            PG8_LDB(B0, 1, 0); PG8_LDB(B1, 1, 1); PG8_SCHED; PG8_LDA(At, 1, 0); PG8_STAGE_A(PG8_SA(0, 1), a2, 1, unx);
            PG8_WAIT_V(8); PG8_WAIT_L(0); PG8_BAR; PG8_MMA(0, 0, At, B0); PG8_MMA(0, 1, At, B1); PG8_BAR; PG8_SCHED;
            PG8_LDA(At, 1, 1); PG8_STAGE(PG8_SB(1, 0), b3, voffB); PG8_STAGE(PG8_SB(1, 1), b3 + hstep, voffB); PG8_STAGE_A(PG8_SA(1, 0), a3, 0, unx);
            PG8_WAIT_V(8); PG8_WAIT_L(0); PG8_BAR; PG8_MMA(1, 0, At, B0); PG8_MMA(1, 1, At, B1); PG8_BAR; PG8_SCHED;
            } else {
            PG8_LDB(B0, 0, 0); PG8_SCHED; PG8_LDA(At, 0, 0); PG8_STAGE(PG8_SA(1, 1), a1 + hstep, voffA);
            PG8_WAIT_L(8); PG8_BAR; PG8_WAIT_L(0); PG8_MMA(0, 0, At, B0); PG8_BAR; PG8_SCHED;
            PG8_LDB(B1, 0, 1); PG8_STAGE(PG8_SB(0, 0), b2, voffB);
            PG8_BAR; PG8_WAIT_L(0); PG8_MMA(0, 1, At, B1); PG8_BAR;
            PG8_LDA(At, 0, 1); PG8_STAGE(PG8_SA(0, 0), a2, voffA);
            PG8_BAR; PG8_WAIT_L(0); PG8_MMA(1, 0, At, B0); PG8_BAR; PG8_SCHED;
            PG8_STAGE(PG8_SB(0, 1), b2 + hstep, voffB);
            PG8_WAIT_V(6); PG8_BAR; PG8_MMA(1, 1, At, B1); PG8_BAR;
            PG8_LDB(B0, 1, 0); PG8_SCHED; PG8_LDA(At, 1, 0); PG8_STAGE(PG8_SA(0, 1), a2 + hstep, voffA);
            PG8_WAIT_L(8); PG8_BAR; PG8_WAIT_L(0); PG8_MMA(0, 0, At, B0); PG8_BAR; PG8_SCHED;
            PG8_LDB(B1, 1, 1); PG8_STAGE(PG8_SB(1, 0), b3, voffB);
            PG8_BAR; PG8_WAIT_L(0); PG8_MMA(0, 1, At, B1); PG8_BAR;
            PG8_LDA(At, 1, 1); PG8_STAGE(PG8_SA(1, 0), a3, voffA);
            PG8_BAR; PG8_WAIT_L(0); PG8_MMA(1, 0, At, B0); PG8_BAR; PG8_SCHED;
            PG8_STAGE(PG8_SB(1, 1), b3 + hstep, voffB);
            PG8_WAIT_V(6); PG8_BAR; PG8_MMA(1, 1, At, B1); PG8_BAR;
            }
        }
        if constexpr (ALIGN_EPI) { if (wr == 0) PG8_BAR; }
        if constexpr (FP8) asm volatile("s_nop 15\n\ts_nop 7" ::: "memory");
        if constexpr (!Epi::AFTER_DRAIN) { E(acc, cur, wr, wc, fr, fq); S.done(cur); }
        if (!has_next) break;
#pragma unroll
        for (int a = 0; a < 2; ++a)
#pragma unroll
            for (int b = 0; b < 2; ++b)
#pragma unroll
                for (int m = 0; m < 4; ++m)
#pragma unroll
                    for (int n = 0; n < 2; ++n) acc[a][b][m][n] = (f32x4){0.f, 0.f, 0.f, 0.f};
        cur = nxt; cA = nA; cB = nB; ++ui;
        if constexpr (ALIGN_EPI) { if (wr == 1) PG8_BAR; }
    }
    PG8_WAIT_V(0);
    if constexpr (!ALIGN_EPI) { if (wr == 0) PG8_BAR; }
    PG8_BAR;
    if constexpr (Epi::AFTER_DRAIN) { E.fused(acc, cur, wr, wc, fr, fq, lds, wid, lane); S.done(cur); }
#undef PG8_SA
#undef PG8_STAGE_A
#undef PG8_SB
#undef PG8_STAGE
#undef PG8_STAGE2
#undef PG8_LDA
#undef PG8_LDB
#undef PG8_MMA
#undef PG8_CAT8
#undef PG8_WAIT_V
#undef PG8_WAIT_VN
#undef PG8_WAIT_L
#undef PG8_BAR
#undef PG8_SCHED
}
}

constexpr int NB = 4, SEQ = 4096, DM = 1024, NTOK = NB * SEQ, DIN = 7168, NH = 8, HD = 128;
constexpr int NEXP = 32, TOPK = 4, MAXBLK = 288, RMAX = MAXBLK * 256;
constexpr float EPS = 1e-6f;
constexpr int NWAVES = 8;

constexpr size_t MiB = 1u << 20, KiB = 1u << 10;
constexpr size_t WS_CTL = 0, CTL_ZERO_BYTES = 1 * MiB;
constexpr size_t WS_MOD = 1 * MiB;
constexpr size_t WS_KMEAN = 1 * MiB + 128 * KiB;
constexpr size_t WS_AGGP = 1 * MiB + 384 * KiB;
constexpr size_t WS_AGGH = 1 * MiB + 640 * KiB;
constexpr size_t WS_WRH = 2 * MiB, WS_WRL = 2 * MiB + 64 * KiB;
constexpr size_t WS_TOKE = 3 * MiB, WS_TOKPOS = 3 * MiB + 256 * KiB;
constexpr int ECAP = 16384;
constexpr size_t WS_ROWTOK = 28 * MiB, WS_ROWGATE = 30 * MiB;
constexpr int CW_UPDONE = 16384;
constexpr int CW_QUEUE = 12288;
constexpr int CW_CNT = 8192;
constexpr size_t WS_TRIG = 4 * MiB;
constexpr size_t WS_WRG = 6 * MiB;
constexpr size_t WS_WIN = 8 * MiB;
constexpr size_t WS_WIN8 = 16 * MiB;
constexpr size_t WS_H8 = 544 * MiB;
constexpr size_t WS_WB = 22 * MiB;
constexpr size_t WS_WO = 26 * MiB;
constexpr size_t WS_WUP = 32 * MiB;
constexpr size_t WS_WDN = 96 * MiB;
constexpr size_t WS_HB = 224 * MiB;
constexpr size_t WS_E = 256 * MiB;
constexpr size_t E_STRIDE = (size_t)NTOK * DM;
constexpr size_t WS_HL = 480 * MiB, WS_PP = 512 * MiB, WS_YCAT = 544 * MiB;
constexpr int CW_MODCNT = 8256;
constexpr size_t WS_ACT = 400 * MiB, WS_YR = 544 * MiB;
constexpr size_t WS_END = 688 * MiB;
constexpr int CW_BAR = 4096;

constexpr int RING_OFF = 0, RING_BYTES = 131072;
constexpr int LDSCTL_OFF = RING_BYTES, MISC_OFF = LDSCTL_OFF + 320;
constexpr int XTRA_OFF = LDSCTL_OFF + 1024;
constexpr int LDS_BYTES = 155648;

#define GAS __attribute__((address_space(1)))
#define LAS __attribute__((address_space(3)))
typedef unsigned short bf16;
typedef unsigned v4u __attribute__((ext_vector_type(4)));
typedef unsigned v2u __attribute__((ext_vector_type(2)));
typedef float f32x4 __attribute__((ext_vector_type(4)));
typedef float f32x2 __attribute__((ext_vector_type(2)));
typedef float f32x16 __attribute__((ext_vector_type(16)));
typedef short bf16x8 __attribute__((ext_vector_type(8)));
typedef short s16x4 __attribute__((ext_vector_type(4)));
typedef GAS unsigned gu32;
#define RLX_AGENT __ATOMIC_RELAXED, __HIP_MEMORY_SCOPE_AGENT
#define LDS_WAIT() asm volatile("s_waitcnt lgkmcnt(0)" ::: "memory")
#define VM_WAIT() asm volatile("s_waitcnt vmcnt(0)" ::: "memory")
#define SBAR() __builtin_amdgcn_sched_barrier(0)
__device__ __forceinline__ unsigned f2bf(float f) { unsigned u = __builtin_bit_cast(unsigned, f); return (u + 0x7fffu + ((u >> 16) & 1u)) >> 16; }
__device__ __forceinline__ unsigned pk2(float lo, float hi) { return f2bf(lo) | (f2bf(hi) << 16); }
__device__ __forceinline__ float bf2f(unsigned short h) { return __builtin_bit_cast(float, (unsigned)h << 16); }
__device__ __forceinline__ float bflo(unsigned w) { return __builtin_bit_cast(float, w << 16); }
__device__ __forceinline__ float bfhi(unsigned w) { return __builtin_bit_cast(float, w & 0xffff0000u); }
__device__ __forceinline__ unsigned cvtpk(float lo, float hi) { unsigned r; asm volatile("v_cvt_pk_bf16_f32 %0, %1, %2" : "=v"(r) : "v"(lo), "v"(hi)); return r; }
__device__ __forceinline__ float fast_sigmoid(float x) { return __builtin_amdgcn_rcpf(1.0f + __builtin_amdgcn_exp2f(-1.4426950408889634f * x)); }
__device__ __forceinline__ float gelu_tanh(float x) { const float z = 1.5957691216057308f * (x + 0.044715f * x * x * x); return x * fast_sigmoid(z); }
__device__ __forceinline__ f32x2 sigmoid_pk(f32x2 x) { const f32x2 z = x * (-1.4426950408889634f); f32x2 e; e.x = __builtin_amdgcn_exp2f(z.x); e.y = __builtin_amdgcn_exp2f(z.y);
    const f32x2 d = e + 1.0f; f32x2 r; r.x = __builtin_amdgcn_rcpf(d.x); r.y = __builtin_amdgcn_rcpf(d.y); return r; }
__device__ __forceinline__ f32x2 gelu_tanh_pk(f32x2 x) {
    const f32x2 u = x * x, w = u * (-0.044715f * 1.5957691216057308f * 1.4426950408889634f) + (-1.5957691216057308f * 1.4426950408889634f), z = x * w;
    f32x2 e; e.x = __builtin_amdgcn_exp2f(z.x); e.y = __builtin_amdgcn_exp2f(z.y);
    const f32x2 d = e + 1.0f; f32x2 r; r.x = __builtin_amdgcn_rcpf(d.x); r.y = __builtin_amdgcn_rcpf(d.y); return x * r; }
__device__ __forceinline__ float wave_sum(float v) {
#pragma unroll
    for (int o = 1; o < 64; o <<= 1) v += __shfl_xor(v, o);
    return v;
}
__device__ __forceinline__ float wave_max(float v) {
#pragma unroll
    for (int o = 1; o < 64; o <<= 1) v = fmaxf(v, __shfl_xor(v, o));
    return v;
}

#define XB_TMO      128
#define XB_XCNT(j)  (256  + 64 * (j))
#define XB_XSUB(j)  (1280 + 64 * (j))
#define XB_XGEN(j)  (2304 + 64 * (j))
#define XB_TOP      3328
#define XB_TOPGEN   3392
#define XCD_BAR_WORDS 3456
#define XB_SPIN_CAP (1u << 20)
__device__ __forceinline__ unsigned xb_ld(unsigned* p)              { return __hip_atomic_load(p, __ATOMIC_RELAXED, __HIP_MEMORY_SCOPE_AGENT); }
__device__ __forceinline__ unsigned xb_add(unsigned* p, unsigned v) { return __hip_atomic_fetch_add(p, v, __ATOMIC_RELAXED, __HIP_MEMORY_SCOPE_AGENT); }
__device__ __forceinline__ unsigned xb_xcc_id() { return (unsigned)__builtin_amdgcn_s_getreg((3 << 11) | 20) & 0xFu; }
#define XB_SPIN(cond, bar) do { unsigned _sp = 0; while (cond) { __builtin_amdgcn_s_sleep(1); \
    if ((++_sp & 255u) == 0u) { if (xb_ld(&(bar)[XB_TMO])) break; if (_sp > XB_SPIN_CAP) { atomicAdd(&(bar)[XB_TMO], 1u); break; } } } } while (0)
struct XcdBarrier { unsigned* bar; unsigned x; volatile LAS unsigned* st; };
__device__ __forceinline__ XcdBarrier xcd_barrier_post(unsigned* bar, volatile LAS unsigned* st) {
    XcdBarrier b; b.bar = bar; b.x = xb_xcc_id(); b.st = st;
    if (threadIdx.x == 0) (void)xb_add(&bar[XB_XCNT(b.x)], 1u);
    return b;
}
__device__ __forceinline__ void xcd_barrier_complete(unsigned* bar, unsigned x, unsigned& nloc, unsigned& nx) {
    const unsigned G = gridDim.x * gridDim.y * gridDim.z;
    unsigned sum, cnt, mine, sp = 0u;
    for (;;) {
        sum = 0u; cnt = 0u; mine = 0u;
#pragma unroll
        for (unsigned j = 0; j < 16; ++j) { const unsigned c = xb_ld(&bar[XB_XCNT(j)]); sum += c; cnt += (c > 0u) ? 1u : 0u; mine = (j == x) ? c : mine; }
        if (sum == G) break;
        __builtin_amdgcn_s_sleep(1);
        if ((++sp & 255u) == 0u) { if (xb_ld(&bar[XB_TMO])) break; if (sp > XB_SPIN_CAP) { atomicAdd(&bar[XB_TMO], 1u); break; } }
    }
    nloc = mine > 0u ? mine : 1u; nx = cnt > 0u ? cnt : 1u;
}
__device__ __forceinline__ void xcd_barrier(const XcdBarrier& b) {
    asm volatile("s_waitcnt vmcnt(0)" ::: "memory");
    __syncthreads();
    if (threadIdx.x == 0) {
        unsigned* bar = b.bar;
        __builtin_amdgcn_s_waitcnt(0);
        unsigned nloc = b.st[0], nx = b.st[1];
        if (nloc == 0u) { xcd_barrier_complete(bar, b.x, nloc, nx); b.st[0] = nloc; b.st[1] = nx; }
        const unsigned old = xb_add(&bar[XB_XSUB(b.x)], 1u);
        const unsigned gen = old / nloc;
        if (old + 1u == (gen + 1u) * nloc) {
            __builtin_amdgcn_fence(__ATOMIC_RELEASE, "agent");
            asm volatile("s_waitcnt vmcnt(0)" ::: "memory");
            const unsigned og = xb_add(&bar[XB_TOP], 1u);
            const unsigned tg = og / nx;
            if (og + 1u == (tg + 1u) * nx) xb_add(&bar[XB_TOPGEN], 1u);
            else XB_SPIN(xb_ld(&bar[XB_TOPGEN]) == tg, bar);
            __builtin_amdgcn_fence(__ATOMIC_ACQUIRE, "agent");
            xb_add(&bar[XB_XGEN(b.x)], 1u);
            asm volatile("s_waitcnt vmcnt(0)" ::: "memory");
        } else {
            XB_SPIN(xb_ld(&bar[XB_XGEN(b.x)]) == gen, bar);
            __builtin_amdgcn_fence(__ATOMIC_ACQUIRE, "agent");
            asm volatile("s_waitcnt vmcnt(0)" ::: "memory");
        }
    }
    __syncthreads();
}

struct Args { const void* in[26]; float* out; unsigned char* ws; int ph_lo, ph_hi; };
struct Frame {
    LAS unsigned char* lds; char* ldsg;
    volatile LAS unsigned* MISC;
    int tid, lane, wave, vcu, G;
    unsigned char* ws; float* out;
};
#define IN_F(k) ((const float*)args.in[k])
#define IN_I(k) ((const int*)args.in[k])
#define WSP(T, off) ((T*)(F.ws + (off)))

namespace pg8 {
struct TileOrder {
    int nM, nN, nwg, G, c; const LAS int* blk_exp; const void* abase;
    __device__ void init(int nM_, int nN_, int G_, int c_, const LAS int* be, const void* ab = nullptr) { nM = nM_; nN = nN_; nwg = nM * nN; G = G_; c = c_; blk_exp = be; abase = ab; }
    __device__ __forceinline__ const void* a_base(const Unit&) const { return abase; }
    __device__ bool next(int i, Unit& u) const {
        const long L = (long)i * G + c; if (L >= nwg) return false;
        int wgid = (int)L; { const int q = nwg / NXCD, r = nwg % NXCD, xcd = wgid % NXCD, off = wgid / NXCD; wgid = (xcd < r ? xcd * (q + 1) : r * (q + 1) + (xcd - r) * q) + off; }
        const int nig = WGM * nN, gid = wgid / nig, fm = gid * WGM, gsz = (nM - fm) < WGM ? (nM - fm) : WGM;
        u.pm = fm + ((wgid % nig) % gsz); u.pn = (wgid % nig) / gsz; u.kind = 0;
        if (blk_exp) { const int e = __builtin_amdgcn_readfirstlane(blk_exp[u.pm]); u.pn += e * nN; }
        return true;
    }
    __device__ __forceinline__ void a_ready(const Unit&) const {}
    __device__ __forceinline__ void done(const Unit&) const {}
};

struct EpiWin {
    static constexpr bool PERM = true, AFTER_DRAIN = false, MIDK = false; static constexpr int NSTORES = 16;
    bf16_t* E; const float* b_gate; int mode;
    __device__ __forceinline__ void operator()(const f32x4 (&acc)[2][2][4][2], const Unit& u, int wr, int wc, int fr, int fq) const {
        const int opn = mode == 0 ? (u.pn < 8 ? u.pn : u.pn + 8) : (u.pn < 8 ? u.pn + 8 : u.pn + 12);
        const int t = opn >> 2, colt = (opn & 3) * BM;
        bf16_t* base = E + (size_t)t * ((size_t)16384 * 1024);
        int row0 = u.pm * BM + wr * 64 + fr; const int col0 = colt + wc * 32 + 8 * fq;
        asm volatile("" : "+v"(row0));
        f32x4 bv[2][2];
#pragma unroll
        for (int bj = 0; bj < 2; ++bj)
#pragma unroll
            for (int n = 0; n < 2; ++n) bv[bj][n] = (t >= 5) ? *(const f32x4*)(b_gate + (t - 5) * 1024 + col0 + bj * HALF + 4 * n) : (f32x4){0.f, 0.f, 0.f, 0.f};
#pragma unroll
        for (int ai = 0; ai < 2; ++ai)
#pragma unroll
            for (int m = 0; m < 4; ++m) { bf16_t* rowp = base + (size_t)(row0 + ai * HALF + m * 16) * 1024 + col0;
#pragma unroll
                for (int bj = 0; bj < 2; ++bj) { f32x4 v0 = acc[ai][bj][m][0] + bv[bj][0], v1 = acc[ai][bj][m][1] + bv[bj][1];
                    if (t == 1) { const f32x2 a = gelu_tanh_pk((f32x2){v0[0], v0[1]}), b = gelu_tanh_pk((f32x2){v0[2], v0[3]}), c = gelu_tanh_pk((f32x2){v1[0], v1[1]}), d = gelu_tanh_pk((f32x2){v1[2], v1[3]});
                        v0 = (f32x4){a.x, a.y, b.x, b.y}; v1 = (f32x4){c.x, c.y, d.x, d.y}; }
                    else if (t >= 5) { const f32x2 a = sigmoid_pk((f32x2){v0[0], v0[1]}), b = sigmoid_pk((f32x2){v0[2], v0[3]}), c = sigmoid_pk((f32x2){v1[0], v1[1]}), d = sigmoid_pk((f32x2){v1[2], v1[3]});
                        v0 = (f32x4){a.x, a.y, b.x, b.y}; v1 = (f32x4){c.x, c.y, d.x, d.y}; }
                    u32x4 w; w.x = cvt_pk_bf16(v0[0], v0[1]); w.y = cvt_pk_bf16(v0[2], v0[3]); w.z = cvt_pk_bf16(v1[0], v1[1]); w.w = cvt_pk_bf16(v1[2], v1[3]);
                    *(u32x4*)(rowp + bj * HALF) = w; } }
    }
};
struct EpiBranch {
    static constexpr bool PERM = true, AFTER_DRAIN = false, MIDK = true; static constexpr int NSTORES = 16;
    const bf16_t* SG0; const bf16_t* SG1; bf16_t* MIX;
    __device__ __forceinline__ void mid(f32x4 (&acc)[2][2][4][2], const Unit& u, int wr, int wc, int fr, int fq) const {
        int row0 = u.pm * BM + wr * 64 + fr; const int col0 = u.pn * BM + wc * 32 + 8 * fq;
        asm volatile("" : "+v"(row0));
#pragma unroll
        for (int ai = 0; ai < 2; ++ai)
#pragma unroll
            for (int m = 0; m < 4; ++m) { const size_t ro = (size_t)(row0 + ai * HALF + m * 16) * 1024 + col0;
#pragma unroll
                for (int bj = 0; bj < 2; ++bj) { const size_t o = ro + bj * HALF;
                    const u32x4 a = *(const u32x4*)(SG0 + o), b = *(const u32x4*)(SG1 + o);
                    const float r0 = bflo(a.x) * __builtin_amdgcn_rcpf(fmaxf(bflo(b.x), 1e-18f)), r1 = bfhi(a.x) * __builtin_amdgcn_rcpf(fmaxf(bfhi(b.x), 1e-18f));
                    const float r2 = bflo(a.y) * __builtin_amdgcn_rcpf(fmaxf(bflo(b.y), 1e-18f)), r3 = bfhi(a.y) * __builtin_amdgcn_rcpf(fmaxf(bfhi(b.y), 1e-18f));
                    const float r4 = bflo(a.z) * __builtin_amdgcn_rcpf(fmaxf(bflo(b.z), 1e-18f)), r5 = bfhi(a.z) * __builtin_amdgcn_rcpf(fmaxf(bfhi(b.z), 1e-18f));
                    const float r6 = bflo(a.w) * __builtin_amdgcn_rcpf(fmaxf(bflo(b.w), 1e-18f)), r7 = bfhi(a.w) * __builtin_amdgcn_rcpf(fmaxf(bfhi(b.w), 1e-18f));
                    acc[ai][bj][m][0] *= (f32x4){r0, r1, r2, r3}; acc[ai][bj][m][1] *= (f32x4){r4, r5, r6, r7}; }
                asm volatile("" ::: "memory"); }
    }
    __device__ __forceinline__ void operator()(const f32x4 (&acc)[2][2][4][2], const Unit& u, int wr, int wc, int fr, int fq) const {
        int row0 = u.pm * BM + wr * 64 + fr; const int col0 = u.pn * BM + wc * 32 + 8 * fq;
        asm volatile("" : "+v"(row0));
#pragma unroll
        for (int ai = 0; ai < 2; ++ai)
#pragma unroll
            for (int m = 0; m < 4; ++m) { const size_t ro = (size_t)(row0 + ai * HALF + m * 16) * 1024 + col0;
#pragma unroll
                for (int bj = 0; bj < 2; ++bj) { const size_t o = ro + bj * HALF;
                    const u32x4 b = *(const u32x4*)(SG1 + o);
                    const f32x4 g0 = {fmaxf(bflo(b.x), 1e-18f), fmaxf(bfhi(b.x), 1e-18f), fmaxf(bflo(b.y), 1e-18f), fmaxf(bfhi(b.y), 1e-18f)}, g1 = {fmaxf(bflo(b.z), 1e-18f), fmaxf(bfhi(b.z), 1e-18f), fmaxf(bflo(b.w), 1e-18f), fmaxf(bfhi(b.w), 1e-18f)};
                    const f32x4 v0 = acc[ai][bj][m][0] * g0, v1 = acc[ai][bj][m][1] * g1;
                    u32x4 w; w.x = cvt_pk_bf16(v0[0], v0[1]); w.y = cvt_pk_bf16(v0[2], v0[3]); w.z = cvt_pk_bf16(v1[0], v1[1]); w.w = cvt_pk_bf16(v1[2], v1[3]);
                    *(u32x4*)(MIX + o) = w; } }
    }
};
struct EpiWout {
    static constexpr bool PERM = false, AFTER_DRAIN = false, MIDK = false; static constexpr int NSTORES = 32;
    const float* x; float* out; const float* mod;
    __device__ __forceinline__ void operator()(const f32x4 (&acc)[2][2][4][2], const Unit& u, int wr, int wc, int fr, int fq) const {
        int row0 = u.pm * BM + wr * 64 + fr; const int col0 = u.pn * BM + wc * 32 + 4 * fq;
        asm volatile("" : "+v"(row0));
        const float* g1p = mod + (size_t)(u.pm >> 4) * 6144 + 2048;
        f32x4 gv[2][2];
#pragma unroll
        for (int bj = 0; bj < 2; ++bj)
#pragma unroll
            for (int n = 0; n < 2; ++n) gv[bj][n] = *(const f32x4*)(g1p + col0 + bj * HALF + n * 16);
#pragma unroll
        for (int ai = 0; ai < 2; ++ai)
#pragma unroll
            for (int m = 0; m < 4; ++m) { const size_t ro = (size_t)(row0 + ai * HALF + m * 16) * 1024 + col0;
#pragma unroll
                for (int bj = 0; bj < 2; ++bj)
#pragma unroll
                    for (int n = 0; n < 2; ++n) { const size_t o = ro + bj * HALF + n * 16; *(f32x4*)(out + o) = *(const f32x4*)(x + o) + gv[bj][n] * acc[ai][bj][m][n]; } }
    }
};
__device__ __forceinline__ unsigned pk_fp8x4(float a, float b, float c, float d) { int p = __builtin_amdgcn_cvt_pk_fp8_f32(a, b, 0, false); p = __builtin_amdgcn_cvt_pk_fp8_f32(c, d, p, true); return (unsigned)p; }
struct EpiUp {
    static constexpr bool PERM = true, AFTER_DRAIN = false, MIDK = false; static constexpr int NSTORES = 8;
    unsigned char* ACT; const float* b_up;
    __device__ __forceinline__ void operator()(const f32x4 (&acc)[2][2][4][2], const Unit& u, int wr, int wc, int fr, int fq) const {
        const int e = u.pn >> 3, p = u.pn & 7;
        int row0 = u.pm * BM + wr * 64 + fr; const int c0 = p * 128 + wc * 32 + 8 * fq;
        asm volatile("" : "+v"(row0));
        const float* bg = b_up + (size_t)e * 2048 + c0; const float* bl = bg + 1024;
        f32x4 bgv[2], blv[2];
#pragma unroll
        for (int n = 0; n < 2; ++n) { bgv[n] = *(const f32x4*)(bg + 4 * n); blv[n] = *(const f32x4*)(bl + 4 * n) + 1.0f; }
#pragma unroll
        for (int ai = 0; ai < 2; ++ai)
#pragma unroll
            for (int m = 0; m < 4; ++m) { unsigned char* rowp = ACT + (size_t)(row0 + ai * HALF + m * 16) * 1024 + c0;
                f32x4 a[2];
#pragma unroll
                for (int n = 0; n < 2; ++n) {
#pragma unroll
                    for (int j = 0; j < 4; j += 2) { f32x2 g = (f32x2){acc[ai][0][m][n][j], acc[ai][0][m][n][j + 1]} + (f32x2){bgv[n][j], bgv[n][j + 1]};
                        f32x2 l = (f32x2){acc[ai][1][m][n][j], acc[ai][1][m][n][j + 1]} + (f32x2){blv[n][j], blv[n][j + 1]};
                        g.x = fminf(g.x, 7.0f); g.y = fminf(g.y, 7.0f); l.x = __builtin_amdgcn_fmed3f(l.x, -6.0f, 8.0f); l.y = __builtin_amdgcn_fmed3f(l.y, -6.0f, 8.0f);
                        const f32x2 z = g * (-1.702f * 1.4426950408889634f); f32x2 e; e.x = __builtin_amdgcn_exp2f(z.x); e.y = __builtin_amdgcn_exp2f(z.y);
                        const f32x2 d = e + 1.0f; f32x2 r; r.x = __builtin_amdgcn_rcpf(d.x); r.y = __builtin_amdgcn_rcpf(d.y);
                        const f32x2 o = (l * g) * r; a[n][j] = o.x; a[n][j + 1] = o.y; } }
                typedef unsigned u32x2_t __attribute__((ext_vector_type(2)));
                u32x2_t w; w.x = pk_fp8x4(a[0][0], a[0][1], a[0][2], a[0][3]); w.y = pk_fp8x4(a[1][0], a[1][1], a[1][2], a[1][3]);
                *(u32x2_t*)rowp = w; }
    }
};
struct EpiDown {
    static constexpr bool PERM = true, AFTER_DRAIN = false, MIDK = false; static constexpr int NSTORES = 16;
    bf16_t* YR; const float* b_down; const float* row_gate; const LAS int* tbl;
    __device__ __forceinline__ void operator()(const f32x4 (&acc)[2][2][4][2], const Unit& u, int wr, int wc, int fr, int fq) const {
        const int e = u.pn >> 2, p = u.pn & 3;
        int row0 = u.pm * BM + wr * 64 + fr; const int c0 = p * BM + wc * 32 + 8 * fq;
        asm volatile("" : "+v"(row0));
        const int pos0 = row0 - tbl[32 + e] * 256, cnt = tbl[e];
        const float* gp = row_gate + (size_t)e * 16384 + pos0;
        float gt[2][4];
#pragma unroll
        for (int ai = 0; ai < 2; ++ai)
#pragma unroll
            for (int m = 0; m < 4; ++m) { const int o = ai * HALF + m * 16; gt[ai][m] = (pos0 + o < cnt) ? gp[o] : 0.0f; }
        f32x4 bv[2][2];
#pragma unroll
        for (int bj = 0; bj < 2; ++bj)
#pragma unroll
            for (int n = 0; n < 2; ++n) bv[bj][n] = *(const f32x4*)(b_down + (size_t)e * 1024 + c0 + bj * HALF + 4 * n);
#pragma unroll
        for (int ai = 0; ai < 2; ++ai)
#pragma unroll
            for (int m = 0; m < 4; ++m) { const int r = row0 + ai * HALF + m * 16; const float g = gt[ai][m];
                bf16_t* rowp = YR + (size_t)r * 1024 + c0;
#pragma unroll
                for (int bj = 0; bj < 2; ++bj) { const f32x4 v0 = (acc[ai][bj][m][0] + bv[bj][0]) * g, v1 = (acc[ai][bj][m][1] + bv[bj][1]) * g;
                    u32x4 w; w.x = cvt_pk_bf16(v0[0], v0[1]); w.y = cvt_pk_bf16(v0[2], v0[3]); w.z = cvt_pk_bf16(v1[0], v1[1]); w.w = cvt_pk_bf16(v1[2], v1[3]);
                    *(u32x4*)(rowp + bj * HALF) = w; } }
    }
};
}

__device__ __forceinline__ void p0_transpose_item(const float* W, int N, bf16* WT, int Kd, size_t dst_row0, LAS float* scr, int k0, int n0, int lane) {
#pragma unroll 8
    for (int i = 0; i < 32; ++i) { const int kk = 2 * i + (lane >> 5); scr[kk * 33 + (lane & 31)] = W[(size_t)(k0 + kk) * N + n0 + (lane & 31)]; }
    LDS_WAIT(); asm volatile("" ::: "memory");
    const int c = lane & 7;
#pragma unroll
    for (int j = 0; j < 4; ++j) { const int n = (lane >> 3) + 8 * j; const LAS float* s = scr + (8 * c) * 33 + n;
        v4u o; o.x = pk2(s[0 * 33], s[1 * 33]); o.y = pk2(s[2 * 33], s[3 * 33]); o.z = pk2(s[4 * 33], s[5 * 33]); o.w = pk2(s[6 * 33], s[7 * 33]);
        *(GAS v4u*)(WT + (dst_row0 + n) * (size_t)Kd + k0 + 8 * c) = o; }
    LDS_WAIT(); asm volatile("" ::: "memory");
}
__device__ __forceinline__ void p8_transpose_item_fp8(const float* W, int N, unsigned char* WT, int Kd, size_t dst_row0, LAS float* scr, int k0, int n0, int lane) {
#pragma unroll 8
    for (int i = 0; i < 32; ++i) { const int kk = 2 * i + (lane >> 5); scr[kk * 33 + (lane & 31)] = W[(size_t)(k0 + kk) * N + n0 + (lane & 31)] * 64.0f; }
    LDS_WAIT(); asm volatile("" ::: "memory");
    const int c = lane & 7;
#pragma unroll
    for (int j = 0; j < 4; ++j) { const int n = (lane >> 3) + 8 * j; const LAS float* s = scr + (8 * c) * 33 + n;
        v2u o; o.x = pg8::pk_fp8x4(s[0 * 33], s[1 * 33], s[2 * 33], s[3 * 33]); o.y = pg8::pk_fp8x4(s[4 * 33], s[5 * 33], s[6 * 33], s[7 * 33]);
        *(GAS v2u*)(WT + (dst_row0 + n) * (size_t)Kd + k0 + 8 * c) = o; }
    LDS_WAIT(); asm volatile("" ::: "memory");
}
__device__ __forceinline__ void p0_prologue(Frame& F, const Args& args) {
    const float* c_in = IN_F(1); const int* pos = IN_I(2); const float* ada_w = IN_F(3); const float* ada_b = IN_F(4);
    for (int task = F.vcu; task < 96; task += F.G) {
        LAS float* sc = (LAS float*)F.lds;
        LAS float* red = (LAS float*)(F.lds + 16384);
        for (int i = F.tid; i < 4096; i += 512) { const float v = c_in[i]; sc[i] = v / (1.0f + expf(-v)); }
        __syncthreads();
        const int colq = F.lane & 15, kq = F.lane >> 4, col = task * 64 + colq * 4;
        float acc[4][4];
#pragma unroll
        for (int b = 0; b < 4; ++b)
#pragma unroll
            for (int j = 0; j < 4; ++j) acc[b][j] = 0.f;
#pragma unroll 4
        for (int s = 0; s < 32; ++s) { const int k = F.wave * 128 + s * 4 + kq; const f32x4 wv = *(const f32x4*)(ada_w + (size_t)k * 6144 + col);
#pragma unroll
            for (int b = 0; b < 4; ++b) { const float sv = sc[b * 1024 + k];
#pragma unroll
                for (int j = 0; j < 4; ++j) acc[b][j] += sv * wv[j]; } }
#pragma unroll
        for (int b = 0; b < 4; ++b)
#pragma unroll
            for (int j = 0; j < 4; ++j) { float v = acc[b][j]; v += __shfl_xor(v, 16); v += __shfl_xor(v, 32); if (kq == 0) red[(F.wave * 4 + b) * 64 + colq * 4 + j] = v; }
        __syncthreads();
        if (F.tid < 256) { const int b = F.tid >> 6, cc = F.tid & 63; float s = ada_b[task * 64 + cc];
#pragma unroll
            for (int w = 0; w < 8; ++w) s += red[(w * 4 + b) * 64 + cc];
            WSP(float, WS_MOD)[b * 6144 + task * 64 + cc] = s; }
        VM_WAIT(); __syncthreads();
        if (F.tid == 0) { __builtin_amdgcn_fence(__ATOMIC_RELEASE, "agent"); VM_WAIT(); __hip_atomic_fetch_add((unsigned*)(F.ws + WS_CTL) + CW_MODCNT, 1u, RLX_AGENT); }
    }
    const int gt = F.vcu * 512 + F.tid, NGT = F.G * 512;
    for (int idx = gt; idx < NTOK * 16; idx += NGT) { const int m = idx >> 4, i = idx & 15;
        double freq = 1.0; for (int q = 0; q < i; ++q) freq *= 0.44036660267178046;
        const double ang = (double)pos[m] * freq; const double nr = __builtin_rint(ang * 0.15915494309189535);
        const float r = (float)__builtin_fma(-nr, 6.283185307179586, ang);
        float sn, cs; sincosf(r, &sn, &cs);
        WSP(float, WS_TRIG)[m * 32 + i] = cs; WSP(float, WS_TRIG)[m * 32 + 16 + i] = sn; }
    { const float* wr = IN_F(20); for (int idx = gt; idx < 32 * 1024; idx += NGT) { const int e = idx >> 10, k = idx & 1023; const float w = wr[k * 32 + e];
        const unsigned hi = f2bf(w); const float rem = w - __builtin_bit_cast(float, hi << 16); WSP(bf16, WS_WRH)[idx] = (bf16)hi; WSP(bf16, WS_WRL)[idx] = (bf16)f2bf(rem); } }
    LAS float* scr = (LAS float*)(F.lds + 32768 + F.wave * 8704);
    const int gw = F.vcu * NWAVES + F.wave, NGW = F.G * NWAVES;
    constexpr int I_IN = 16 * 224, I_RG = 128, I_B = 1024, I_O = 512;
    constexpr int NITEMS = I_IN + I_RG + I_B + I_O;
    for (int it = gw; it < NITEMS; it += NGW) {
        int r = it;
        if (r < I_IN) { const int kb = r / 224, nb = r % 224, n0 = nb * 32;
            if (n0 < 2048 || (n0 >= 4096 && n0 < 5120)) p0_transpose_item(IN_F(7), DIN, WSP(bf16, WS_WIN), 1024, (size_t)(n0 < 2048 ? n0 : n0 - 2048), scr, kb * 64, n0, F.lane);
            else p8_transpose_item_fp8(IN_F(7), DIN, WSP(unsigned char, WS_WIN8), 1024, (size_t)(n0 < 4096 ? n0 - 2048 : n0 - 3072), scr, kb * 64, n0, F.lane);
            continue; } r -= I_IN;
        if (r < I_RG) { const int mat = r >> 6, blk = (r >> 3) & 7, kb = (r >> 2) & 1, nb = r & 3;
            p0_transpose_item(IN_F(mat ? 12 : 10) + (size_t)blk * 16384, 128, WSP(bf16, WS_WRG) + (size_t)(mat * 8 + blk) * 16384, 128, (size_t)nb * 32, scr, kb * 64, nb * 32, F.lane); continue; } r -= I_RG;
        if (r < I_B) { const int g = r >> 9, q = r & 511, kb = q >> 5, nb = q & 31;
            p0_transpose_item(IN_F(18) + (size_t)g * 1048576, 1024, WSP(bf16, WS_WB) + (size_t)g * 1024, 2048, (size_t)nb * 32, scr, kb * 64, nb * 32, F.lane); continue; } r -= I_B;
        { const int kb = r >> 5, nb = r & 31; p0_transpose_item(IN_F(19), 1024, WSP(bf16, WS_WO), 1024, (size_t)nb * 32, scr, kb * 64, nb * 32, F.lane); }
    }
}
struct WItem { const float* src; unsigned char* dst; int N; };
__device__ __forceinline__ WItem p8_item(const Args& args, unsigned char* ws, int it) {
    WItem w;
    if (it < 32 * 1024) { const int e = it >> 10, q = it & 1023, kb = q >> 6, nb = q & 63, n0 = nb * 32;
        const int bj = n0 >> 10, p = (n0 & 1023) >> 7, oo = n0 & 127;
        w.src = IN_F(22) + (size_t)e * 2097152 + (size_t)(kb * 64) * 2048 + n0; w.N = 2048;
        w.dst = ws + WS_WUP + (size_t)e * 2097152 + (size_t)(p * 256 + bj * 128 + oo) * 1024 + kb * 64; }
    else { const int r = it - 32 * 1024, e = r >> 9, q = r & 511, kb = q >> 5, nb = q & 31;
        w.src = IN_F(24) + (size_t)e * 1048576 + (size_t)(kb * 64) * 1024 + nb * 32; w.N = 1024;
        w.dst = ws + WS_WDN + (size_t)e * 1048576 + (size_t)(nb * 32) * 1024 + kb * 64; }
    return w;
}
__device__ __forceinline__ void p8_load(const WItem& w, f32x4 (&v)[8], int lane) {
#pragma unroll
    for (int i = 0; i < 8; ++i) v[i] = __builtin_nontemporal_load((const f32x4*)(w.src + (size_t)((lane >> 3) + 8 * i) * w.N + (lane & 7) * 4));
}
__device__ __forceinline__ void p8_store(const WItem& w, const f32x4 (&v)[8], LAS float* scr, int lane) {
#pragma unroll
    for (int i = 0; i < 8; ++i) { LAS float* d = scr + ((lane >> 3) + 8 * i) * 33 + (lane & 7) * 4; d[0] = v[i].x * 64.0f; d[1] = v[i].y * 64.0f; d[2] = v[i].z * 64.0f; d[3] = v[i].w * 64.0f; }
    LDS_WAIT(); asm volatile("" ::: "memory");
    const int c = lane & 7;
#pragma unroll
    for (int j = 0; j < 4; ++j) { const int n = (lane >> 3) + 8 * j; const LAS float* s = scr + (8 * c) * 33 + n;
        v2u o; o.x = pg8::pk_fp8x4(s[0 * 33], s[1 * 33], s[2 * 33], s[3 * 33]); o.y = pg8::pk_fp8x4(s[4 * 33], s[5 * 33], s[6 * 33], s[7 * 33]);
        __builtin_nontemporal_store(o, (v2u*)(w.dst + (size_t)n * 1024 + 8 * c)); }
    LDS_WAIT(); asm volatile("" ::: "memory");
}
constexpr int P8_ITEMS = 32 * 1024 + 32 * 512, P8_CHUNK = 128, P8_NCHUNK = P8_ITEMS / P8_CHUNK;
__device__ __forceinline__ void p8_chunk(Frame& F, const Args& args, int ch) {
    LAS float* scr = (LAS float*)(F.lds + 32768 + F.wave * 8704);
    const int it0 = ch * P8_CHUNK + F.wave * 16;
    f32x4 va[8], vb[8];
    WItem wa = p8_item(args, F.ws, it0), wb;
    p8_load(wa, va, F.lane);
#pragma unroll 1
    for (int j = 0; j < 16; j += 2) {
        wb = p8_item(args, F.ws, it0 + j + 1); p8_load(wb, vb, F.lane);
        p8_store(wa, va, scr, F.lane);
        if (j + 2 < 16) { wa = p8_item(args, F.ws, it0 + j + 2); p8_load(wa, va, F.lane); }
        p8_store(wb, vb, scr, F.lane);
    }
}
__device__ __forceinline__ void p8_moe_weights(Frame& F, const Args& args) {
    for (int ch = F.vcu; ch < P8_NCHUNK; ch += F.G) p8_chunk(F, args, ch);
}

__device__ __forceinline__ void p1_hrows(Frame& F, const Args& args) {
    if (F.tid == 0) { unsigned* mc = (unsigned*)(F.ws + WS_CTL) + CW_MODCNT; unsigned sp = 0; while (__hip_atomic_load(mc, RLX_AGENT) < 96u && ++sp < (1u << 22)) __builtin_amdgcn_s_sleep(2);
        __builtin_amdgcn_fence(__ATOMIC_ACQUIRE, "agent"); VM_WAIT(); }
    __syncthreads();
    const float* x = IN_F(0); const float* g1n = IN_F(5); const float* mod = WSP(float, WS_MOD); bf16* H = WSP(bf16, WS_HB); unsigned char* H8 = WSP(unsigned char, WS_H8);
    const int gw = F.vcu * NWAVES + F.wave, NGW = F.G * NWAVES;
    for (int m0 = gw; m0 < NTOK; m0 += 2 * NGW) {
        const int m1 = m0 + NGW;
        const bool has1 = m1 < NTOK;
        f32x4 v0[4], v1[4]; float s0 = 0.f, s1 = 0.f;
        const f32x4* x0 = (const f32x4*)(x + (size_t)m0 * DM) + F.lane; const f32x4* x1 = (const f32x4*)(x + (size_t)(has1 ? m1 : m0) * DM) + F.lane;
#pragma unroll
        for (int j = 0; j < 4; ++j) { v0[j] = x0[64 * j]; v1[j] = x1[64 * j]; }
#pragma unroll
        for (int j = 0; j < 4; ++j) { s0 += (v0[j].x * v0[j].x + v0[j].y * v0[j].y) + (v0[j].z * v0[j].z + v0[j].w * v0[j].w); s1 += (v1[j].x * v1[j].x + v1[j].y * v1[j].y) + (v1[j].z * v1[j].z + v1[j].w * v1[j].w); }
#pragma unroll
        for (int o = 1; o < 64; o <<= 1) { s0 += __shfl_xor(s0, o); s1 += __shfl_xor(s1, o); }
        const float r0 = 1.0f / sqrtf(s0 * (1.f / DM) + EPS), r1 = 1.0f / sqrtf(s1 * (1.f / DM) + EPS);
        const int b0 = m0 >> 12, b1 = (has1 ? m1 : m0) >> 12;
        unsigned long long* o0 = (unsigned long long*)(H + (size_t)m0 * DM) + F.lane; unsigned long long* o1 = (unsigned long long*)(H + (size_t)(has1 ? m1 : m0) * DM) + F.lane;
#pragma unroll
        for (int j = 0; j < 4; ++j) { const int col = 4 * F.lane + 256 * j;
            const f32x4 g = *(const f32x4*)(g1n + col);
            const f32x4 sh0 = *(const f32x4*)(mod + b0 * 6144 + col), sc0 = *(const f32x4*)(mod + b0 * 6144 + 1024 + col);
            const f32x4 sh1 = *(const f32x4*)(mod + b1 * 6144 + col), sc1 = *(const f32x4*)(mod + b1 * 6144 + 1024 + col);
            const f32x4 h0 = v0[j] * r0 * g * (sc0 + 1.0f) + sh0, h1 = v1[j] * r1 * g * (sc1 + 1.0f) + sh1;
            o0[64 * j] = (unsigned long long)cvtpk(h0.x, h0.y) | ((unsigned long long)cvtpk(h0.z, h0.w) << 32);
            ((unsigned*)(H8 + (size_t)m0 * DM))[F.lane + 64 * j] = pg8::pk_fp8x4(h0.x, h0.y, h0.z, h0.w);
            if (has1) { o1[64 * j] = (unsigned long long)cvtpk(h1.x, h1.y) | ((unsigned long long)cvtpk(h1.z, h1.w) << 32);
                ((unsigned*)(H8 + (size_t)m1 * DM))[F.lane + 64 * j] = pg8::pk_fp8x4(h1.x, h1.y, h1.z, h1.w); } }
    }
}

__device__ __forceinline__ void p3_knorm_unit(Frame& F, const Args& args, int unit) {
    const int h = unit & 7, j = (unit >> 3) & 15, b = unit >> 7;
    bf16* KR = WSP(bf16, WS_E) + 3 * E_STRIDE; const float* trig = WSP(float, WS_TRIG); const float* kg = IN_F(16);
    const int rsub = F.lane >> 4, c16 = F.lane & 15;
    float gk[8];
#pragma unroll
    for (int i = 0; i < 8; ++i) gk[i] = kg[c16 * 8 + i];
    float km[8];
#pragma unroll
    for (int i = 0; i < 8; ++i) km[i] = 0.f;
    const int fi = (c16 & 1) * 8;
#pragma unroll 1
    for (int bt = 0; bt < 2; ++bt) {
        v4u raw[4]; f32x4 tcs[4][4];
#pragma unroll
        for (int i4 = 0; i4 < 4; ++i4) { const int m = b * SEQ + j * 256 + F.wave * 32 + (bt * 4 + i4) * 4 + rsub;
            raw[i4] = *(const v4u*)(KR + (size_t)m * DM + h * HD + c16 * 8);
            const float* tp = trig + (size_t)m * 32 + fi;
            tcs[i4][0] = *(const f32x4*)tp; tcs[i4][1] = *(const f32x4*)(tp + 4); tcs[i4][2] = *(const f32x4*)(tp + 16); tcs[i4][3] = *(const f32x4*)(tp + 20); }
#pragma unroll
        for (int i4 = 0; i4 < 4; ++i4) { const int m = b * SEQ + j * 256 + F.wave * 32 + (bt * 4 + i4) * 4 + rsub;
            float v[8] = {bflo(raw[i4].x), bfhi(raw[i4].x), bflo(raw[i4].y), bfhi(raw[i4].y), bflo(raw[i4].z), bfhi(raw[i4].z), bflo(raw[i4].w), bfhi(raw[i4].w)};
            float ss = 0.f;
#pragma unroll
            for (int i = 0; i < 8; ++i) ss += v[i] * v[i];
            ss += __shfl_xor(ss, 1); ss += __shfl_xor(ss, 2); ss += __shfl_xor(ss, 4); ss += __shfl_xor(ss, 8);
            const float rstd = 1.0f / sqrtf(ss * (1.f / HD) + EPS);
#pragma unroll
            for (int i = 0; i < 8; ++i) v[i] = v[i] * rstd * gk[i];
#pragma unroll
            for (int i = 0; i < 8; ++i) { const float other = __shfl_xor(v[i], 2); const float cs = tcs[i4][i >> 2][i & 3], sn = tcs[i4][2 + (i >> 2)][i & 3];
                if (c16 < 4) v[i] = (c16 < 2) ? (v[i] * cs - other * sn) : (v[i] * cs + other * sn); }
#pragma unroll
            for (int i = 0; i < 8; ++i) km[i] += v[i];
            v4u o; o.x = cvtpk(v[0], v[1]); o.y = cvtpk(v[2], v[3]); o.z = cvtpk(v[4], v[5]); o.w = cvtpk(v[6], v[7]);
            *(v4u*)(KR + (size_t)m * DM + h * HD + c16 * 8) = o; }
    }
    LAS float* red = (LAS float*)(F.lds + XTRA_OFF);
#pragma unroll
    for (int i = 0; i < 8; ++i) { float v = km[i]; v += __shfl_xor(v, 16); v += __shfl_xor(v, 32); if (rsub == 0) red[F.wave * 128 + c16 * 8 + i] = v; }
    __syncthreads();
    if (F.tid < 128) { float s = 0.f;
#pragma unroll
        for (int w = 0; w < 8; ++w) s += red[w * 128 + F.tid];
        WSP(float, WS_KMEAN)[((size_t)(b * NH + h) * 16 + j) * HD + F.tid] = s * (1.f / 256.f); }
    __syncthreads();
}

__device__ __forceinline__ void p3_rnn_local_unit(Frame& F, const Args& args, int unit) {
    const int n = unit & 7, c = (unit >> 3) & 15, b = unit >> 7;
    const int t0 = c * 256, m0 = b * SEQ + t0, ch0 = n * 128;
    const bf16* XR = WSP(bf16, WS_E);
    LAS unsigned char* At = F.lds;
    {
        const int cg = F.tid & 15, rs = F.tid >> 4; const int chb = ch0 + cg * 8;
        const float* cw = IN_F(8); const float* cb = IN_F(9);
        float w0[8], w1[8], w2[8], w3[8], bb[8];
#pragma unroll
        for (int i = 0; i < 8; ++i) { w0[i] = cw[chb + i]; w1[i] = cw[1024 + chb + i]; w2[i] = cw[2048 + chb + i]; w3[i] = cw[3072 + chb + i]; bb[i] = cb[chb + i]; }
        const int tr0 = t0 + rs * 8;
        v4u rw[11];
#pragma unroll
        for (int r = 0; r < 11; ++r) { const int tt = tr0 - 3 + r; rw[r] = *(const v4u*)(XR + (size_t)(b * SEQ + (tt < 0 ? 0 : tt)) * DM + chb); if (tt < 0) rw[r] = (v4u){0u, 0u, 0u, 0u}; }
#define UNP(dst, w_) do { dst[0] = bflo(w_.x); dst[1] = bfhi(w_.x); dst[2] = bflo(w_.y); dst[3] = bfhi(w_.y); dst[4] = bflo(w_.z); dst[5] = bfhi(w_.z); dst[6] = bflo(w_.w); dst[7] = bfhi(w_.w); } while (0)
        float p1[8], p2[8], p3[8];
        UNP(p3, rw[0]); UNP(p2, rw[1]); UNP(p1, rw[2]);
#pragma unroll
        for (int r = 0; r < 8; ++r) { float cur[8]; UNP(cur, rw[3 + r]);
            float xc[8];
#pragma unroll
            for (int i = 0; i < 8; ++i) xc[i] = bb[i] + w0[i] * cur[i] + w1[i] * p1[i] + w2[i] * p2[i] + w3[i] * p3[i];
            const int row = rs * 8 + r;
            v4u o; o.x = cvtpk(xc[0], xc[1]); o.y = cvtpk(xc[2], xc[3]); o.z = cvtpk(xc[4], xc[5]); o.w = cvtpk(xc[6], xc[7]);
            *(LAS v4u*)(At + row * 256 + ((cg ^ (row & 15)) << 4)) = o;
#pragma unroll
            for (int i = 0; i < 8; ++i) { p3[i] = p2[i]; p2[i] = p1[i]; p1[i] = cur[i]; } }
#undef UNP
    }
    __syncthreads();
    const int fr = F.lane & 15, fq = F.lane >> 4;
    const int vloc = F.wave * 16 + fr, ch = ch0 + vloc;
    const bf16* WA = WSP(bf16, WS_WRG) + (size_t)n * 16384 + (size_t)vloc * 128 + fq * 8;
    const bf16* WX = WA + 8 * 16384;
    bf16x8 Ba[4], Bx[4];
#pragma unroll
    for (int s = 0; s < 4; ++s) { Ba[s] = *(const bf16x8*)(WA + 32 * s); Bx[s] = *(const bf16x8*)(WX + 32 * s); }
    const float ba = IN_F(11)[ch], bx = IN_F(13)[ch];
    const float sp8 = 8.0f * log1pf(expf(-IN_F(14)[ch]));
    float cP = 1.f, cH = 0.f;
    bf16* HL = WSP(bf16, WS_HL); bf16* PP = WSP(bf16, WS_PP);
    LAS unsigned short* stg = (LAS unsigned short*)(F.lds + 65536);
    for (int rq = 0; rq < 4; ++rq) {
        LAS unsigned short* sb = stg + (rq & 1) * 16384;
#pragma unroll
        for (int ri = 0; ri < 4; ++ri) { const int rt = rq * 4 + ri;
            f32x4 accr = {0.f, 0.f, 0.f, 0.f}, accx = {0.f, 0.f, 0.f, 0.f};
            const int arow = rt * 16 + fr;
#pragma unroll
            for (int s = 0; s < 4; ++s) { const bf16x8 a = *(const LAS bf16x8*)(At + arow * 256 + (((fq + 4 * s) ^ (arow & 15)) << 4));
                accr = __builtin_amdgcn_mfma_f32_16x16x32_bf16(a, Ba[s], accr, 0, 0, 0);
                accx = __builtin_amdgcn_mfma_f32_16x16x32_bf16(a, Bx[s], accx, 0, 0, 0); }
            float pj[4], hj[4];
#pragma unroll
            for (int j = 0; j < 4; ++j) { const int row = rt * 16 + 4 * fq + j;
                const float xcv = bf2f(*(const LAS unsigned short*)(At + row * 256 + ((((vloc >> 3)) ^ (row & 15)) << 4) + (vloc & 7) * 2));
                const float r = fast_sigmoid(accr[j] + ba), ig = fast_sigmoid(accx[j] + bx);
                const float a = __builtin_amdgcn_exp2f(-sp8 * r * 1.4426950408889634f);
                float mult = __builtin_amdgcn_sqrtf(fmaxf(fmaf(-a, a, 1.0f), 0.0f)); if (t0 + row == 0) mult = 1.0f;
                const float u = mult * ig * xcv;
                pj[j] = (j ? pj[j - 1] : 1.0f) * a; hj[j] = (j ? hj[j - 1] * a : 0.0f) + u; }
            const float tp = pj[3], th = hj[3];
            const float pa = __shfl(tp, F.lane - 16), ha = __shfl(th, F.lane - 16);
            const float pb = __shfl(tp, F.lane - 32), hb = __shfl(th, F.lane - 32);
            const float pc = __shfl(tp, F.lane - 48), hc = __shfl(th, F.lane - 48);
            float Pq, Hq;
            if (fq == 0) { Pq = 1.f; Hq = 0.f; } else if (fq == 1) { Pq = pa; Hq = ha; } else if (fq == 2) { Pq = pb * pa; Hq = pa * hb + ha; } else { Pq = pc * pb * pa; Hq = pa * (pb * hc + hb) + ha; }
            const float hstart = Hq + Pq * cH, pstart = Pq * cP;
            float hl3 = 0.f, pp3 = 0.f;
#pragma unroll
            for (int j = 0; j < 4; ++j) { const float hv = hj[j] + pj[j] * hstart, pv = pj[j] * pstart; const int rl = ri * 16 + 4 * fq + j;
                const unsigned pk = cvtpk(hv, pv); sb[rl * 128 + vloc] = (unsigned short)pk; sb[8192 + rl * 128 + vloc] = (unsigned short)(pk >> 16); if (j == 3) { hl3 = hv; pp3 = pv; } }
            cH = __shfl(hl3, fr + 48); cP = __shfl(pp3, fr + 48);
        }
        __syncthreads();
#pragma unroll
        for (int q4 = 0; q4 < 4; ++q4) { const int idx = q4 * 512 + F.tid, arr = idx >> 10, rr = (idx >> 4) & 63, c16 = idx & 15;
            const v4u val = *(const LAS v4u*)(sb + arr * 8192 + rr * 128 + c16 * 8);
            bf16* dst = (arr ? PP : HL) + (size_t)(m0 + rq * 64 + rr) * DM + ch0 + c16 * 8;
            *(v4u*)dst = val; }
    }
    if (fq == 0) { WSP(float, WS_AGGP)[(size_t)(b * 16 + c) * 1024 + ch] = cP; WSP(float, WS_AGGH)[(size_t)(b * 16 + c) * 1024 + ch] = cH; }
    __syncthreads();
}

__device__ __forceinline__ void p4_rnn_final_unit(Frame& F, const Args& args, int unit) {
    const int n = unit & 7, c = (unit >> 3) & 15, b = unit >> 7;
    const int m0 = b * SEQ + c * 256, ch0 = n * 128;
    LAS float* car = (LAS float*)(F.lds + XTRA_OFF);
    if (F.tid < 128) { const int ch = ch0 + F.tid; float h = 0.f;
        for (int cc = 0; cc < c; ++cc) { const float p = WSP(float, WS_AGGP)[(size_t)(b * 16 + cc) * 1024 + ch], hh = WSP(float, WS_AGGH)[(size_t)(b * 16 + cc) * 1024 + ch]; h = p * h + hh; }
        car[F.tid] = h; }
    __syncthreads();
    const bf16* HL = WSP(bf16, WS_HL); const bf16* PP = WSP(bf16, WS_PP); const bf16* GG = WSP(bf16, WS_E) + E_STRIDE; bf16* Y = WSP(bf16, WS_YCAT);
    const int c16 = F.tid & 15, r0 = F.tid >> 4;
    float cv[8];
#pragma unroll
    for (int i = 0; i < 8; ++i) cv[i] = car[c16 * 8 + i];
#pragma unroll 2
    for (int it = 0; it < 8; ++it) { const size_t o = (size_t)(m0 + it * 32 + r0) * DM + ch0 + c16 * 8, oy = (size_t)(m0 + it * 32 + r0) * 2048 + ch0 + c16 * 8;
        const v4u hl = *(const v4u*)(HL + o), pp = *(const v4u*)(PP + o), gg = *(const v4u*)(GG + o);
        v4u y;
        y.x = pk2((bflo(hl.x) + bflo(pp.x) * cv[0]) * bflo(gg.x), (bfhi(hl.x) + bfhi(pp.x) * cv[1]) * bfhi(gg.x));
        y.y = pk2((bflo(hl.y) + bflo(pp.y) * cv[2]) * bflo(gg.y), (bfhi(hl.y) + bfhi(pp.y) * cv[3]) * bfhi(gg.y));
        y.z = pk2((bflo(hl.z) + bflo(pp.z) * cv[4]) * bflo(gg.z), (bfhi(hl.z) + bfhi(pp.z) * cv[5]) * bfhi(gg.z));
        y.w = pk2((bflo(hl.w) + bflo(pp.w) * cv[6]) * bflo(gg.w), (bfhi(hl.w) + bfhi(pp.w) * cv[7]) * bfhi(gg.w));
        *(v4u*)(Y + oy) = y; }
    __syncthreads();
}

namespace att {
constexpr int KVBLK = 64, SHM_K = KVBLK * HD * 2, SHM_V = SHM_K;
constexpr float C2 = 0.08838834764831845f * 1.4426950408889634f;
#define KSWZ(row, colB) ((row) * 256 + ((colB) ^ (((row) & 7) << 4)))
__device__ __forceinline__ int v_st(int k, int c) { const int kk = (k & ~0xC) | ((k & 4) << 1) | ((k & 8) >> 1); return ((kk >> 3) * 4 + (c >> 5)) * 512 + ((kk & 7) * 32 + (c & 31)) * 2; }
__device__ __forceinline__ int v_rd_base(int lane) { return ((lane & 3) << 3) | (((lane >> 2) & 3) << 6) | (((lane >> 4) & 1) << 5) | (((lane >> 5) & 1) << 8); }
constexpr int v_rd_off(int d0, int ks, int half) { return d0 * 512 + ks * 4096 + half * 2048; }
__device__ __forceinline__ int crow(int r, int hi) { return (r & 3) + 8 * (r >> 2) + 4 * hi; }

template <int KB>
__device__ __forceinline__ void qkt(f32x16& p0, f32x16& p1, const char* K_lds, int r32, int hi, const char* qfrag, bool act) {
    if (!act) { const float NEG = -__builtin_inff();
#pragma unroll
        for (int r = 0; r < 16; ++r) { p0[r] = NEG; p1[r] = NEG; } return; }
    p0 = f32x16{}; p1 = f32x16{};
    const char* kb[4];
#pragma unroll
    for (int dd = 0; dd < 4; ++dd) kb[dd] = K_lds + KB * SHM_K + KSWZ(r32, (dd * 16 + hi * 8) * 2);
#pragma unroll
    for (int d0 = 0; d0 < 8; ++d0) { const char* a = kb[d0 & 3] + (d0 >> 2) * 128;
        bf16x8 b0 = *reinterpret_cast<const bf16x8*>(a);
        bf16x8 b1 = *reinterpret_cast<const bf16x8*>(a + 32 * 256);
        const bf16x8 q = *reinterpret_cast<const bf16x8*>(qfrag + d0 * 1024);
        p0 = __builtin_amdgcn_mfma_f32_32x32x16_bf16(b0, q, p0, 0, 0, 0);
        p1 = __builtin_amdgcn_mfma_f32_32x32x16_bf16(b1, q, p1, 0, 0, 0); }
}
template <int VB>
__device__ __forceinline__ void pv_tile(f32x16* o, int vb0, bf16x8 pa0, bf16x8 pa1, bf16x8 pa2, bf16x8 pa3, bool act) {
    if (!act) return;
#define TRRD(dst, off) asm volatile("ds_read_b64_tr_b16 %0, %1 offset:%2" : "=&v"(dst) : "v"(vb0), "i"(off) : "memory")
#define PV_D0(d0) do { s16x4 l0, l1, l2, l3, h0, h1, h2, h3; constexpr int b_ = VB * SHM_V + v_rd_off(d0, 0, 0); \
        TRRD(l0, b_); TRRD(h0, b_ + 2048); TRRD(l1, b_ + 4096); TRRD(h1, b_ + 6144); TRRD(l2, b_ + 8192); TRRD(h2, b_ + 10240); TRRD(l3, b_ + 12288); TRRD(h3, b_ + 14336); \
        asm volatile("s_waitcnt lgkmcnt(0)" ::: "memory"); SBAR(); \
        o[d0] = __builtin_amdgcn_mfma_f32_32x32x16_bf16(pa0, (bf16x8){l0[0], l0[1], l0[2], l0[3], h0[0], h0[1], h0[2], h0[3]}, o[d0], 0, 0, 0);   \
        o[d0] = __builtin_amdgcn_mfma_f32_32x32x16_bf16(pa1, (bf16x8){l1[0], l1[1], l1[2], l1[3], h1[0], h1[1], h1[2], h1[3]}, o[d0], 0, 0, 0);   \
        o[d0] = __builtin_amdgcn_mfma_f32_32x32x16_bf16(pa2, (bf16x8){l2[0], l2[1], l2[2], l2[3], h2[0], h2[1], h2[2], h2[3]}, o[d0], 0, 0, 0);   \
        o[d0] = __builtin_amdgcn_mfma_f32_32x32x16_bf16(pa3, (bf16x8){l3[0], l3[1], l3[2], l3[3], h3[0], h3[1], h3[2], h3[3]}, o[d0], 0, 0, 0); } while (0)
    PV_D0(0); PV_D0(1); PV_D0(2); PV_D0(3);
#undef PV_D0
#undef TRRD
}
__device__ __forceinline__ void sm_a(f32x16& p0) {
#pragma unroll
    for (int r = 0; r < 16; ++r) p0[r] = __builtin_amdgcn_exp2f(p0[r]);
}
__device__ __forceinline__ void sm_b(f32x16& p0, f32x16& p1, float& l_reg, bf16x8& pa0, bf16x8& pa1, bf16x8& pa2, bf16x8& pa3) {
#pragma unroll
    for (int r = 0; r < 16; ++r) p1[r] = __builtin_amdgcn_exp2f(p1[r]);
    float ps = 0;
#pragma unroll
    for (int r = 0; r < 16; ++r) ps += p0[r];
#pragma unroll
    for (int r = 0; r < 16; ++r) ps += p1[r];
    l_reg += ps;
#define PK4(P, B_, OUT) do { unsigned a0 = cvtpk(P[B_+0], P[B_+1]), a1 = cvtpk(P[B_+2], P[B_+3]); \
        unsigned b0 = cvtpk(P[B_+4], P[B_+5]), b1 = cvtpk(P[B_+6], P[B_+7]); \
        auto r0 = __builtin_amdgcn_permlane32_swap(a0, b0, false, false); auto r1 = __builtin_amdgcn_permlane32_swap(a1, b1, false, false); \
        v4u w = {r0[0], r1[0], r0[1], r1[1]}; OUT = *reinterpret_cast<bf16x8*>(&w); } while (0)
    PK4(p0, 0, pa0); PK4(p0, 8, pa1); PK4(p1, 0, pa2); PK4(p1, 8, pa3);
#undef PK4
}

__device__ __forceinline__ void attn_unit(Frame& F, const Args& args, int b, int h, int iq) {
    int tid = F.tid; asm volatile("" : "+v"(tid));
    const int wid = F.wave, lane = tid & 63, r32 = lane & 31, hi = lane >> 5;
    char* lds = F.ldsg;
    char* V_lds = lds; char* K_lds = lds + 2 * SHM_V;
    float* kml = (float*)(lds + XTRA_OFF);
    char* qfrag = lds + 65536 + wid * 8192 + lane * 16;
    const bf16* QR = WSP(bf16, WS_E) + 2 * E_STRIDE; const bf16* KN = WSP(bf16, WS_E) + 3 * E_STRIDE; const bf16* VV = WSP(bf16, WS_E) + 4 * E_STRIDE;
    bf16* YA = WSP(bf16, WS_YCAT) + 1024;
    const size_t mb = (size_t)b * SEQ;
    const int q0 = iq * 256, NT = 4 * (iq + 1);
    const bf16* Kh = KN + mb * DM + h * HD; const bf16* Vh = VV + mb * DM + h * HD;
    { const float* kmg = WSP(float, WS_KMEAN) + (size_t)(b * NH + h) * 16 * HD; for (int idx = tid; idx < iq * HD; idx += 512) kml[idx] = kmg[idx]; }
    const int sr = tid >> 4, sc = (tid & 15) * 8, vst0 = v_st(sr, sc), vst1 = v_st(32 + sr, sc), kws = KSWZ(sr, sc * 2);
    const int vb0 = (int)(uintptr_t)V_lds + v_rd_base(lane);
    bf16x8 st_v0, st_v1, st_k0, st_k1;
    const unsigned goff = (unsigned)(sr * DM + sc) * 2u;
#define ROWP(p, k0, rr) ((const char*)((p) + (size_t)((k0) + (rr)) * DM) + goff)
#define SLOAD(k0) do { st_v0 = *(const bf16x8*)ROWP(Vh, k0, 0); st_v1 = *(const bf16x8*)ROWP(Vh, k0, 32); st_k0 = *(const bf16x8*)ROWP(Kh, k0, 0); st_k1 = *(const bf16x8*)ROWP(Kh, k0, 32); } while (0)
#define SWRITE(bf) do { *(bf16x8*)(V_lds + (bf) * SHM_V + vst0) = st_v0; *(bf16x8*)(V_lds + (bf) * SHM_V + vst1) = st_v1; \
                        *(bf16x8*)(K_lds + (bf) * SHM_K + kws) = st_k0; *(bf16x8*)(K_lds + (bf) * SHM_K + kws + 32 * 256) = st_k1; } while (0)
    SLOAD(0);
    const size_t mq = mb + q0 + wid * 32 + r32;
    unsigned selmask;
    {
        bf16x8 qr[8];
        const bf16* qp = QR + mq * DM + h * HD + hi * 8;
        v4u raw[8];
#pragma unroll
        for (int d0 = 0; d0 < 8; ++d0) raw[d0] = *(const v4u*)(qp + d0 * 16);
        float ss = 0.f;
#pragma unroll
        for (int d0 = 0; d0 < 8; ++d0) { const float a0 = bflo(raw[d0].x), a1 = bfhi(raw[d0].x), a2 = bflo(raw[d0].y), a3 = bfhi(raw[d0].y), a4 = bflo(raw[d0].z), a5 = bfhi(raw[d0].z), a6 = bflo(raw[d0].w), a7 = bfhi(raw[d0].w);
            ss += (a0 * a0 + a1 * a1) + (a2 * a2 + a3 * a3) + (a4 * a4 + a5 * a5) + (a6 * a6 + a7 * a7); }
        ss += __shfl_xor(ss, 32);
        const float rs = C2 / sqrtf(ss * (1.f / HD) + EPS);
        const float* qg = IN_F(15) + hi * 8;
#define UNPK(f, W_) do { const v4u t_ = (W_); f[0] = bflo(t_.x); f[1] = bfhi(t_.x); f[2] = bflo(t_.y); f[3] = bfhi(t_.y); f[4] = bflo(t_.z); f[5] = bfhi(t_.z); f[6] = bflo(t_.w); f[7] = bfhi(t_.w); } while (0)
#define PACK(f) ({ v4u w_; w_.x = cvtpk(f[0], f[1]); w_.y = cvtpk(f[2], f[3]); w_.z = cvtpk(f[4], f[5]); w_.w = cvtpk(f[6], f[7]); *reinterpret_cast<bf16x8*>(&w_); })
        { float f0[8], f1[8]; UNPK(f0, raw[0]); UNPK(f1, raw[1]);
          const float* tg = WSP(float, WS_TRIG) + mq * 32 + hi * 8;
#pragma unroll
          for (int j = 0; j < 8; ++j) { const float x1 = f0[j] * rs * qg[j], x2 = f1[j] * rs * qg[16 + j], cs = tg[j], sn = tg[16 + j]; f0[j] = x1 * cs - x2 * sn; f1[j] = x2 * cs + x1 * sn; }
          qr[0] = PACK(f0); qr[1] = PACK(f1); }
#pragma unroll
        for (int d0 = 2; d0 < 8; ++d0) { float f[8]; UNPK(f, raw[d0]);
#pragma unroll
            for (int j = 0; j < 8; ++j) f[j] *= rs * qg[d0 * 16 + j];
            qr[d0] = PACK(f); }
        __syncthreads();
        float v1 = -__builtin_inff(), v2 = v1, v3 = v1; int i1 = 0, i2 = 0, i3 = 0;
#pragma unroll 1
        for (int jb = 0; jb < iq; ++jb) { const float* km = kml + jb * HD + hi * 8; float g = 0.f;
#pragma unroll
            for (int d0 = 0; d0 < 8; ++d0) { float f[8]; UNPK(f, *reinterpret_cast<const v4u*>(&qr[d0]));
                const f32x4 k0 = *(const f32x4*)(km + d0 * 16), k1 = *(const f32x4*)(km + d0 * 16 + 4);
                g += (f[0] * k0[0] + f[1] * k0[1]) + (f[2] * k0[2] + f[3] * k0[3]) + (f[4] * k1[0] + f[5] * k1[1]) + (f[6] * k1[2] + f[7] * k1[3]); }
            g += __shfl_xor(g, 32);
            if (g > v1) { v3 = v2; i3 = i2; v2 = v1; i2 = i1; v1 = g; i1 = jb; }
            else if (g > v2) { v3 = v2; i3 = i2; v2 = g; i2 = jb; }
            else if (g > v3) { v3 = g; i3 = jb; } }
#undef UNPK
#undef PACK
        selmask = 0u; if (iq >= 1) selmask |= 1u << i1; if (iq >= 2) selmask |= 1u << i2; if (iq >= 3) selmask |= 1u << i3;
#pragma unroll
        for (int d0 = 0; d0 < 8; ++d0) *reinterpret_cast<bf16x8*>(qfrag + d0 * 1024) = qr[d0];
    }
    float l_reg = 0.f; f32x16 o[4] = {};
    const int wrow0 = wid * 32;
#define ACT(t) (((t) >> 2) < iq ? (__ballot((selmask >> ((t) >> 2)) & 1u) != 0ull) : ((((t) - 4 * iq) * 64) <= wrow0 + 31))
#define MASKT(P0_, P1_, t) do { const int blk_ = (t) >> 2; const float NEG_ = -__builtin_inff(); \
        if (blk_ < iq) { if (!((selmask >> blk_) & 1u)) { _Pragma("unroll") for (int r = 0; r < 16; ++r) { P0_[r] = NEG_; P1_[r] = NEG_; } } } \
        else { const int kb_ = ((t) - 4 * iq) * 64; if (kb_ + 63 > wrow0) { int dq_ = wrow0 + r32 - kb_ - 4 * hi; asm volatile("" : "+v"(dq_)); \
            _Pragma("unroll") for (int r = 0; r < 16; ++r) { const int c_ = (r & 3) + 8 * (r >> 2); if (c_ > dq_) P0_[r] = NEG_; if (c_ + 32 > dq_) P1_[r] = NEG_; } } } } while (0)
    f32x16 pA0, pA1, pB0, pB1; bf16x8 pa0, pa1, pa2, pa3;
    VM_WAIT(); SWRITE(0); SBAR();
    SLOAD(64);
    __syncthreads();
    SBAR(); qkt<0>(pA0, pA1, K_lds, r32, hi, qfrag, ACT(0));
    MASKT(pA0, pA1, 0); sm_a(pA0);
    VM_WAIT(); SWRITE(1);
    __syncthreads();
#define HALF_STEP(PX0, PX1, PY0, PY1, t, KB, VB, SB) do { \
        SBAR(); qkt<KB>(PX0, PX1, K_lds, r32, hi, qfrag, ACT(t)); \
        sm_b(PY0, PY1, l_reg, pa0, pa1, pa2, pa3); SBAR(); \
        if ((t) + 1 < NT) { SLOAD(((t) + 1) * 64); SBAR(); } \
        pv_tile<VB>(o, vb0, pa0, pa1, pa2, pa3, ACT((t) - 1)); MASKT(PX0, PX1, (t)); sm_a(PX0); \
        __syncthreads(); \
        if ((t) + 1 < NT) { VM_WAIT(); SWRITE(SB); } \
        __syncthreads(); } while (0)
    for (int t = 1; t + 1 < NT; t += 2) {
        HALF_STEP(pB0, pB1, pA0, pA1, t, 1, 0, 0);
        HALF_STEP(pA0, pA1, pB0, pB1, t + 1, 0, 1, 1);
    }
    SBAR(); qkt<1>(pB0, pB1, K_lds, r32, hi, qfrag, ACT(NT - 1)); SBAR();
    sm_b(pA0, pA1, l_reg, pa0, pa1, pa2, pa3); SBAR();
    pv_tile<0>(o, vb0, pa0, pa1, pa2, pa3, ACT(NT - 2));
    MASKT(pB0, pB1, NT - 1); sm_a(pB0);
    sm_b(pB0, pB1, l_reg, pa0, pa1, pa2, pa3); SBAR();
    pv_tile<1>(o, vb0, pa0, pa1, pa2, pa3, ACT(NT - 1));
    l_reg += __shfl_xor(l_reg, 32);
    float* li_l = (float*)(lds + XTRA_OFF + 8192) + wid * 32;
    if (hi == 0) li_l[r32] = l_reg;
    asm volatile("s_waitcnt lgkmcnt(0)" ::: "memory");
    float rli[16];
#pragma unroll
    for (int r = 0; r < 16; ++r) rli[r] = __builtin_amdgcn_rcpf(li_l[crow(r, hi)]);
    bf16* Ow = YA + (mb + q0 + wid * 32) * 2048 + h * HD;
#pragma unroll
    for (int r = 0; r < 16; ++r) { const int orow = crow(r, hi);
#pragma unroll
        for (int d0 = 0; d0 < 4; ++d0) { const float v = o[d0][r] * rli[r]; const float vn = __shfl_xor(v, 1);
            if ((r32 & 1) == 0) *(unsigned*)(Ow + (size_t)orow * 2048 + d0 * 32 + r32) = cvtpk(v, vn); } }
    __syncthreads();
#undef ROWP
#undef SLOAD
#undef SWRITE
#undef ACT
#undef MASKT
#undef HALF_STEP
}
#undef KSWZ
}

__device__ __forceinline__ void p7_router(Frame& F, const Args& args) {
    LAS float* ssq = (LAS float*)F.lds;
    LAS float* par = (LAS float*)(F.lds + 2048);
    LAS float* lg = (LAS float*)(F.lds + 10240);
    LAS int* hist = (LAS int*)(F.lds + 77824 + 2048);
    LAS int* sel = (LAS int*)(F.lds + 77824 + 4096);
    const float* g2n = IN_F(6); const float* mod = WSP(float, WS_MOD); const float* brt = IN_F(21);
    unsigned char* H2 = WSP(unsigned char, WS_HB);
    unsigned* CNT = (unsigned*)(F.ws + WS_CTL) + CW_CNT;
    const int row = F.lane & 15, q = F.lane >> 4, kw = F.wave * 128;
    bf16x8 Bh[4][2], Bl[4][2];
    { const bf16* wh = WSP(bf16, WS_WRH) + (size_t)row * 1024 + kw + 8 * q; const bf16* wl = WSP(bf16, WS_WRL) + (size_t)row * 1024 + kw + 8 * q;
#pragma unroll
      for (int s = 0; s < 4; ++s) { Bh[s][0] = *(const bf16x8*)(wh + 32 * s); Bh[s][1] = *(const bf16x8*)(wh + 16384 + 32 * s); Bl[s][0] = *(const bf16x8*)(wl + 32 * s); Bl[s][1] = *(const bf16x8*)(wl + 16384 + 32 * s); } }
    for (int vw = F.vcu; vw < 256; vw += F.G) {
        const int m0 = vw * 64, b = m0 >> 12;
        for (int i = F.tid; i < 1024; i += 512) { par[i] = g2n[i] * (1.0f + mod[b * 6144 + 4096 + i]); par[1024 + i] = mod[b * 6144 + 3072 + i]; }
        if (F.tid < 32) hist[F.tid] = 0;
#pragma unroll
        for (int rt = 0; rt < 4; ++rt) { const float* xp = F.out + (size_t)(m0 + rt * 16 + row) * DM + kw + 8 * q; float ss = 0.f;
#pragma unroll
            for (int s = 0; s < 4; ++s) { const f32x4 x0 = *(const f32x4*)(xp + 32 * s), x1 = *(const f32x4*)(xp + 32 * s + 4); const f32x4 a = x0 * x0 + x1 * x1; ss += (a.x + a.y) + (a.z + a.w); }
            ss += __shfl_xor(ss, 16); ss += __shfl_xor(ss, 32);
            if (q == 0) ssq[F.wave * 64 + rt * 16 + row] = ss; }
        __syncthreads();
#pragma unroll
        for (int rt = 0; rt < 4; ++rt) { const int rl = rt * 16 + row; float tot = 0.f;
#pragma unroll
            for (int w = 0; w < 8; ++w) tot += ssq[w * 64 + rl];
            const float rstd = 1.0f / sqrtf(tot * (1.f / DM) + EPS);
            f32x4 acc0 = {0.f, 0.f, 0.f, 0.f}, acc1 = {0.f, 0.f, 0.f, 0.f};
            unsigned char* hp = H2 + (size_t)(m0 + rl) * DM + kw + 8 * q; const float* xp = F.out + (size_t)(m0 + rl) * DM + kw + 8 * q;
            f32x4 xq[4][2];
#pragma unroll
            for (int s = 0; s < 4; ++s) { xq[s][0] = *(const f32x4*)(xp + 32 * s); xq[s][1] = *(const f32x4*)(xp + 32 * s + 4); }
#pragma unroll
            for (int s = 0; s < 4; ++s) { const int col = kw + 32 * s + 8 * q; float h[8];
#pragma unroll
                for (int hf = 0; hf < 2; ++hf) { const f32x4 sc = *(const LAS f32x4*)(par + col + 4 * hf), sh = *(const LAS f32x4*)(par + 1024 + col + 4 * hf);
                    const f32x4 t = xq[s][hf] * rstd * sc + sh; h[4 * hf] = t.x; h[4 * hf + 1] = t.y; h[4 * hf + 2] = t.z; h[4 * hf + 3] = t.w; }
                v4u hi; hi.x = cvtpk(h[0], h[1]); hi.y = cvtpk(h[2], h[3]); hi.z = cvtpk(h[4], h[5]); hi.w = cvtpk(h[6], h[7]);
                { v2u h8; h8.x = pg8::pk_fp8x4(h[0], h[1], h[2], h[3]); h8.y = pg8::pk_fp8x4(h[4], h[5], h[6], h[7]); *(v2u*)(hp + 32 * s) = h8; }
                v4u lo; lo.x = cvtpk(h[0] - bflo(hi.x), h[1] - bfhi(hi.x)); lo.y = cvtpk(h[2] - bflo(hi.y), h[3] - bfhi(hi.y)); lo.z = cvtpk(h[4] - bflo(hi.z), h[5] - bfhi(hi.z)); lo.w = cvtpk(h[6] - bflo(hi.w), h[7] - bfhi(hi.w));
                const bf16x8 ah = *reinterpret_cast<bf16x8*>(&hi), al = *reinterpret_cast<bf16x8*>(&lo);
                acc0 = __builtin_amdgcn_mfma_f32_16x16x32_bf16(ah, Bh[s][0], acc0, 0, 0, 0); acc0 = __builtin_amdgcn_mfma_f32_16x16x32_bf16(ah, Bl[s][0], acc0, 0, 0, 0); acc0 = __builtin_amdgcn_mfma_f32_16x16x32_bf16(al, Bh[s][0], acc0, 0, 0, 0);
                acc1 = __builtin_amdgcn_mfma_f32_16x16x32_bf16(ah, Bh[s][1], acc1, 0, 0, 0); acc1 = __builtin_amdgcn_mfma_f32_16x16x32_bf16(ah, Bl[s][1], acc1, 0, 0, 0); acc1 = __builtin_amdgcn_mfma_f32_16x16x32_bf16(al, Bh[s][1], acc1, 0, 0, 0); }
#pragma unroll
            for (int r = 0; r < 4; ++r) { lg[(F.wave * 64 + rt * 16 + 4 * q + r) * 33 + row] = acc0[r]; lg[(F.wave * 64 + rt * 16 + 4 * q + r) * 33 + 16 + row] = acc1[r]; } }
        __syncthreads();
        { const int rowl = F.tid >> 3, eq = F.tid & 7; float v[4];
#pragma unroll
          for (int j = 0; j < 4; ++j) { float a = brt[4 * eq + j];
#pragma unroll
              for (int w = 0; w < 8; ++w) a += lg[(w * 64 + rowl) * 33 + 4 * eq + j];
              v[j] = a; }
          float tv[4]; int te[4];
#pragma unroll
          for (int k = 0; k < 4; ++k) { float gm = fmaxf(fmaxf(v[0], v[1]), fmaxf(v[2], v[3]));
              gm = fmaxf(gm, __shfl_xor(gm, 1)); gm = fmaxf(gm, __shfl_xor(gm, 2)); gm = fmaxf(gm, __shfl_xor(gm, 4));
              int ci = v[0] == gm ? 4 * eq : v[1] == gm ? 4 * eq + 1 : v[2] == gm ? 4 * eq + 2 : v[3] == gm ? 4 * eq + 3 : 99;
              ci = min(ci, __shfl_xor(ci, 1)); ci = min(ci, __shfl_xor(ci, 2)); ci = min(ci, __shfl_xor(ci, 4));
              te[k] = ci; tv[k] = gm;
#pragma unroll
              for (int j = 0; j < 4; ++j) if (ci == 4 * eq + j) v[j] = -__builtin_inff(); }
          if (eq == 0) { const float w1 = __expf(tv[1] - tv[0]), w2 = __expf(tv[2] - tv[0]), w3 = __expf(tv[3] - tv[0]); const float inv = 1.0f / (1.0f + w1 + w2 + w3);
              const float gk[4] = {inv, w1 * inv, w2 * inv, w3 * inv};
#pragma unroll
              for (int k = 0; k < 4; ++k) { const int lr = atomicAdd((int*)&hist[te[k]], 1); sel[rowl * 4 + k] = te[k]; sel[256 + rowl * 4 + k] = lr; sel[512 + rowl * 4 + k] = __float_as_int(gk[k]); } } }
        __syncthreads();
        if (F.tid < 32) { const int hc = hist[F.tid]; hist[32 + F.tid] = hc ? (int)__hip_atomic_fetch_add(CNT + F.tid, (unsigned)hc, RLX_AGENT) : 0; }
        __syncthreads();
        if (F.tid < 256) { const int e = sel[F.tid], pos = hist[32 + e] + sel[256 + F.tid], mm = m0 + (F.tid >> 2);
            WSP(int, WS_ROWTOK)[(size_t)e * ECAP + pos] = mm; WSP(int, WS_ROWGATE)[(size_t)e * ECAP + pos] = sel[512 + F.tid];
            WSP(int, WS_TOKE)[mm * 4 + (F.tid & 3)] = e; WSP(int, WS_TOKPOS)[mm * 4 + (F.tid & 3)] = pos; }
        __syncthreads();
    }
}

constexpr int MOE_TBL_OFF = XTRA_OFF, MOE_LIST_OFF = XTRA_OFF + 2048;
__device__ __forceinline__ int moe_tables(Frame& F) {
    LAS int* tbl = (LAS int*)(F.lds + MOE_TBL_OFF);
    const unsigned* CNT = (const unsigned*)(F.ws + WS_CTL) + CW_CNT;
    if (F.tid < 32) tbl[F.tid] = (int)__hip_atomic_load(CNT + F.tid, RLX_AGENT);
    __syncthreads();
    if (F.tid == 0) { int run = 0;
#pragma unroll 1
        for (int e = 0; e < 32; ++e) { tbl[32 + e] = run; const int nb = (tbl[e] + 255) >> 8;
#pragma unroll 1
            for (int bb = 0; bb < nb; ++bb) tbl[80 + run + bb] = e;
            run += nb; }
        tbl[64] = run; }
    __syncthreads();
    int nblk = tbl[64]; if (nblk > MAXBLK) nblk = MAXBLK; if (nblk < 1) nblk = 1;
    return __builtin_amdgcn_readfirstlane(nblk);
}

__device__ __forceinline__ void p11_combine(Frame& F, const Args& args) {
    (void)moe_tables(F);
    const LAS int* tbl = (const LAS int*)(F.lds + MOE_TBL_OFF);
    const float* mod = WSP(float, WS_MOD); const bf16* YR = WSP(bf16, WS_YR);
    const int gw = F.vcu * NWAVES + F.wave, NGW = F.G * NWAVES;
    for (int m = gw; m < NTOK; m += NGW) {
        const int b = m >> 12;
        int dk = 0; if (F.lane < 4) { const int e = __hip_atomic_load(WSP(int, WS_TOKE) + m * 4 + F.lane, RLX_AGENT); dk = tbl[32 + e] * 256 + __hip_atomic_load(WSP(int, WS_TOKPOS) + m * 4 + F.lane, RLX_AGENT); }
        const int d0 = __shfl(dk, 0), d1 = __shfl(dk, 1), d2 = __shfl(dk, 2), d3 = __shfl(dk, 3);
        f32x4* xr = (f32x4*)(F.out + (size_t)m * DM) + F.lane;
#pragma unroll
        for (int j = 0; j < 4; ++j) { const int col = 4 * F.lane + 256 * j;
            const v2u y0 = *(const v2u*)(YR + (size_t)d0 * DM + col), y1 = *(const v2u*)(YR + (size_t)d1 * DM + col), y2 = *(const v2u*)(YR + (size_t)d2 * DM + col), y3 = *(const v2u*)(YR + (size_t)d3 * DM + col);
            f32x4 s;
            s.x = (bflo(y0.x) + bflo(y1.x)) + (bflo(y2.x) + bflo(y3.x)); s.y = (bfhi(y0.x) + bfhi(y1.x)) + (bfhi(y2.x) + bfhi(y3.x));
            s.z = (bflo(y0.y) + bflo(y1.y)) + (bflo(y2.y) + bflo(y3.y)); s.w = (bfhi(y0.y) + bfhi(y1.y)) + (bfhi(y2.y) + bfhi(y3.y));
            const f32x4 g2 = *(const f32x4*)(mod + b * 6144 + 5120 + col);
            xr[64 * j] = xr[64 * j] + g2 * s; }
    }
}

#ifndef NSTREAM
#define NSTREAM 8
#endif
#define P4_PULL(ctr, dst) do { __syncthreads(); if (F.tid == 0) bc[0] = (int)__hip_atomic_fetch_add((ctr), 1u, RLX_AGENT); __syncthreads(); dst = bc[0]; } while (0)
__device__ __forceinline__ void p4_phase(Frame& F, const Args& args) {
    unsigned* Q = (unsigned*)(F.ws + WS_CTL) + CW_QUEUE;
    LAS int* bc = (LAS int*)(F.lds + XTRA_OFF + 12288);
    const bool xcd_ok = (F.G == 256);
    const int xg = xcd_ok ? (F.vcu >> 5) : (F.vcu & 7);
    const bool streamer = xcd_ok && (F.vcu & 31) < NSTREAM;
    if (streamer) { for (;;) { int ch; P4_PULL(Q + 64 * 9, ch); if (ch >= P8_NCHUNK) break; p8_chunk(F, args, ch); } }
#pragma unroll 1
    for (int dx = 0; dx < 8; ++dx) { const int x = (xg + dx) & 7;
        for (;;) { int a; P4_PULL(Q + 64 * x, a); if (a >= 64) break;
            const int bh = 4 * x + (a & 3); att::attn_unit(F, args, bh >> 3, bh & 7, 15 - (a >> 2)); } }
    for (;;) { int u; P4_PULL(Q + 64 * 8, u); if (u >= 512) break; p4_rnn_final_unit(F, args, u); }
    if (!streamer) { for (;;) { int ch; P4_PULL(Q + 64 * 9, ch); if (ch >= P8_NCHUNK) break; p8_chunk(F, args, ch); } }
}
#undef P4_PULL

#ifndef MK_N_LAUNCHES
#define MK_N_LAUNCHES 1
#endif
constexpr int PER_PHASE = 12;
constexpr int N_LAUNCHES = MK_N_LAUNCHES;

__global__ void __launch_bounds__(NWAVES * 64, 2) hybrid_fwd(Args args) {
    extern __shared__ __attribute__((aligned(16))) unsigned char lds[];
    Frame F;
    F.lds = (LAS unsigned char*)lds; F.ldsg = (char*)lds;
    F.MISC = (volatile LAS unsigned*)(F.lds + MISC_OFF);
    F.tid = threadIdx.x; F.lane = F.tid & 63; F.wave = __builtin_amdgcn_readfirstlane(F.tid >> 6);
    F.G = gridDim.x; { const int bx = blockIdx.x; F.vcu = (F.G % 8 == 0) ? (bx % 8) * (F.G / 8) + bx / 8 : bx; }
    F.ws = args.ws; F.out = args.out;
    gu32* ctl = (gu32*)(args.ws + WS_CTL);
    for (int u = F.tid; u < (LDS_BYTES - LDSCTL_OFF) / 4; u += NWAVES * 64) ((LAS unsigned*)(F.lds + LDSCTL_OFF))[u] = 0u;
    __syncthreads();
    XcdBarrier bar; bar.bar = (unsigned*)(ctl + CW_BAR); bar.x = 0; bar.st = nullptr;
    if (N_LAUNCHES == 1) bar = xcd_barrier_post((unsigned*)(ctl + CW_BAR), F.MISC + 8);
    const int lo = args.ph_lo, hi = args.ph_hi;
#ifndef PHASE_MASK
#define PHASE_MASK 0xFFF
#endif
#define IN(k) (((PHASE_MASK >> (k)) & 1) && lo <= (k) && (k) < hi)
#define NEXTP(k) ((k) == 0 ? 2 : (k) == 7 ? 9 : (k) + 1)
#define SEAM(k) do { if (IN(k) && IN(NEXTP(k))) xcd_barrier(bar); } while (0)

#ifndef DUP_MASK
#define DUP_MASK 0
#endif
#define PHASE(k, ...) do { if (IN(k)) { __VA_ARGS__ if ((DUP_MASK >> (k)) & 1) { xcd_barrier(bar); __VA_ARGS__ } } SEAM(k); } while (0)
    PHASE(0, { p0_prologue(F, args); p1_hrows(F, args); });
    PHASE(2, {
        { pg8::Gemm g{WSP(bf16, WS_HB), WSP(bf16, WS_WIN), NTOK, 3072, DM}; pg8::TileOrder S; S.init(NTOK / 256, 12, F.G, (int)blockIdx.x, nullptr);
          pg8::EpiWin E{WSP(bf16, WS_E), IN_F(17), 0};
          pg8::gemm_phase<pg8::EpiWin, pg8::TileOrder, true, true>(F.lds + RING_OFF, g, S, E); }
        { pg8::Gemm g{WSP(bf16, WS_H8), WSP(bf16, WS_WIN8), NTOK, 4096, DM / 2}; pg8::TileOrder S; S.init(NTOK / 256, 16, F.G, (int)blockIdx.x, nullptr);
          pg8::EpiWin E{WSP(bf16, WS_E), IN_F(17), 1};
          pg8::gemm_phase<pg8::EpiWin, pg8::TileOrder, true, true, false, true>(F.lds + RING_OFF, g, S, E); }
    });
    int p3rep = 0;
    PHASE(3, {
        for (int u = F.vcu; u < 512; u += F.G) p3_rnn_local_unit(F, args, u);
        if (p3rep++ == 0) { for (int u = F.vcu; u < 512; u += F.G) p3_knorm_unit(F, args, u); }
    });
    PHASE(4, { p4_phase(F, args); });
    PHASE(5, {
        pg8::Gemm g{WSP(bf16, WS_YCAT), WSP(bf16, WS_WB), NTOK, DM, 2 * DM}; pg8::TileOrder S; S.init(NTOK / 256, DM / 256, F.G, (int)blockIdx.x, nullptr);
        pg8::EpiBranch E{WSP(bf16, WS_E) + 5 * E_STRIDE, WSP(bf16, WS_E) + 6 * E_STRIDE, WSP(bf16, WS_HB)};
        pg8::gemm_phase<pg8::EpiBranch, pg8::TileOrder, false, true>(F.lds + RING_OFF, g, S, E);
    });
    PHASE(6, {
        pg8::Gemm g{WSP(bf16, WS_HB), WSP(bf16, WS_WO), NTOK, DM, DM}; pg8::TileOrder S; S.init(NTOK / 256, DM / 256, F.G, (int)blockIdx.x, nullptr);
        pg8::EpiWout E{IN_F(0), F.out, WSP(float, WS_MOD)};
        pg8::gemm_phase<pg8::EpiWout, pg8::TileOrder, false, true>(F.lds + RING_OFF, g, S, E);
    });
    PHASE(7, { p7_router(F, args); });
    PHASE(9, {
        const int nblk = moe_tables(F);
        const LAS int* tbl = (const LAS int*)(F.lds + MOE_TBL_OFF); LAS int* lists = (LAS int*)(F.lds + MOE_LIST_OFF);
        pg8::Gemm g{WSP(bf16, WS_HB), WSP(bf16, WS_WUP), RMAX, 2048 * NEXP, DM / 2}; pg8::TileOrder S; S.init(nblk, 8, F.G, (int)blockIdx.x, tbl + 80, F.ws + WS_HB);
        { pg8::Unit u; for (int i = 0; i < 9 && S.next(i, u); ++i) { if (F.tid < 256) { const int e = u.pn >> 3, pos = (u.pm - tbl[32 + e]) * 256 + F.tid;
              lists[i * 256 + F.tid] = pos < tbl[e] ? __hip_atomic_load(WSP(int, WS_ROWTOK) + (size_t)e * ECAP + pos, RLX_AGENT) : 0; } } }
        __syncthreads();
        pg8::EpiUp E{WSP(unsigned char, WS_ACT), IN_F(23)};
        pg8::gemm_phase<pg8::EpiUp, pg8::TileOrder, true, true, true, true>(F.lds + RING_OFF, g, S, E, lists);
    });
    PHASE(10, {
        const int nblk = moe_tables(F);
        const LAS int* tbl = (const LAS int*)(F.lds + MOE_TBL_OFF);
        pg8::Gemm g{WSP(bf16, WS_ACT), WSP(bf16, WS_WDN), RMAX, 1024 * NEXP, DM / 2}; pg8::TileOrder S; S.init(nblk, 4, F.G, (int)blockIdx.x, tbl + 80);
        pg8::EpiDown E{WSP(bf16, WS_YR), IN_F(25), WSP(float, WS_ROWGATE), tbl};
        pg8::gemm_phase<pg8::EpiDown, pg8::TileOrder, true, true, false, true>(F.lds + RING_OFF, g, S, E);
    });
    PHASE(11, { p11_combine(F, args); });
#undef PHASE
#undef IN
#undef SEAM
}

extern "C" void kernel_launch(void* const* d_in, const int* in_sizes, int n_in, void* d_out, int out_size, void* d_ws, size_t ws_size, hipStream_t stream) {
    static int grid = 0;
    if (grid == 0) {
        if (n_in != 26 || in_sizes[0] != NTOK * DM || out_size != NTOK * DM || ws_size < WS_END) {
            fprintf(stderr, "kernel_launch: shape/workspace mismatch (n_in %d, in0 %d, out %d, ws %zu; need ws >= %zu); nothing launched\n", n_in, n_in > 0 ? in_sizes[0] : -1, out_size, ws_size, (size_t)WS_END); grid = -1; return; }
        int dev = 0, cus = 0, per_cu = 0;
        if (hipGetDevice(&dev) != hipSuccess || hipDeviceGetAttribute(&cus, hipDeviceAttributeMultiprocessorCount, dev) != hipSuccess) { fprintf(stderr, "kernel_launch: device query failed\n"); grid = -1; return; }
        if (hipFuncSetAttribute((const void*)hybrid_fwd, hipFuncAttributeMaxDynamicSharedMemorySize, LDS_BYTES) != hipSuccess) { fprintf(stderr, "kernel_launch: hipFuncSetAttribute failed\n"); grid = -1; return; }
        if (hipOccupancyMaxActiveBlocksPerMultiprocessor(&per_cu, (const void*)hybrid_fwd, NWAVES * 64, LDS_BYTES) != hipSuccess || per_cu < 1) { fprintf(stderr, "kernel_launch: occupancy query says %d blocks/CU\n", per_cu); per_cu = 1; }
        (void)hipGetLastError();
        grid = cus;
        if (grid > 256) grid = 256;
    }
    if (grid < 0) return;
    (void)hipMemsetAsync((char*)d_ws + WS_CTL, 0, CTL_ZERO_BYTES, stream);
    Args a{};
    for (int i = 0; i < 26; ++i) a.in[i] = d_in[i];
    a.out = (float*)d_out; a.ws = (unsigned char*)d_ws;
    for (int li = 0; li < N_LAUNCHES; ++li) {
        a.ph_lo = (N_LAUNCHES == 1) ? 0 : li; a.ph_hi = (N_LAUNCHES == 1) ? PER_PHASE : li + 1;
        hipLaunchKernelGGL(hybrid_fwd, dim3(grid), dim3(NWAVES * 64), LDS_BYTES, stream, a);
        const hipError_t le = hipPeekAtLastError();
        if (le != hipSuccess) { fprintf(stderr, "kernel_launch: launch %d failed: %s\n", li, hipGetErrorName(le)); break; }
    }
}
```

```cpp
#include <hip/hip_runtime.h>
#include <hip/hip_bf16.h>
#include <cstdio>
#include <cstdint>
#include <cmath>
namespace pg8 {
#define PG8_LAS __attribute__((address_space(3)))
typedef unsigned short bf16_t;
typedef short bf16x8 __attribute__((ext_vector_type(8)));
typedef float f32x4 __attribute__((ext_vector_type(4)));
typedef unsigned u32x4 __attribute__((ext_vector_type(4)));
constexpr int BM = 256, BK = 64, HALF = 128, HTB = HALF * BK * 2  , STAGE_BYTES = 8 * HTB, NXCD = 8, WGM = 8;

__host__ __device__ __forceinline__ int lds_byte(int r, int c) { const int st = (r >> 4) * 2 + (c >> 5), rr = r & 15, cc = c & 31, ob = rr * 64 + cc * 2; return st * 1024 + (ob ^ (((ob >> 9) & 1) << 5)); }
__host__ __device__ __forceinline__ void stage_rc(int b, int& R, int& C) { const int st = b / 1024, sb = b % 1024, swz = sb ^ (((sb >> 9) & 1) << 5); R = (st >> 1) * 16 + swz / 64; C = (st & 1) * 32 + (swz % 64) / 2; }
__host__ __device__ __forceinline__ int perm32(int rho) { const int n = rho >> 4, i = rho & 15; return 8 * (i >> 2) + 4 * n + (i & 3); }

struct Unit { int pm, pn, kind; };
struct Gemm { const bf16_t* A; const bf16_t* Bt; int M, N, K; };

struct StaticOrder {
    int nM, nN, nwg, G, c;
    __host__ __device__ void init(int M, int N, int G_, int c_) { nM = M / BM; nN = N / BM; nwg = nM * nN; G = G_; c = c_; }
    __host__ __device__ bool next(int i, Unit& u) const {
        const long L = (long)i * G + c; if (L >= nwg) return false;
        int wgid = (int)L; { const int q = nwg / NXCD, r = nwg % NXCD, xcd = wgid % NXCD, off = wgid / NXCD; wgid = (xcd < r ? xcd * (q + 1) : r * (q + 1) + (xcd - r) * q) + off; }
        const int nig = WGM * nN, gid = wgid / nig, fm = gid * WGM, gsz = (nM - fm) < WGM ? (nM - fm) : WGM;
        u.pm = fm + ((wgid % nig) % gsz); u.pn = (wgid % nig) / gsz; return true;
    }
    __device__ __forceinline__ void a_ready(const Unit&) const {}
    __device__ __forceinline__ void done(const Unit&) const {}
};

__device__ __forceinline__ unsigned cvt_pk_bf16(float lo, float hi) { unsigned r; asm volatile("v_cvt_pk_bf16_f32 %0, %1, %2" : "=v"(r) : "v"(lo), "v"(hi)); return r; }
typedef int v4i_t __attribute__((ext_vector_type(4)));
typedef int v8i_t __attribute__((ext_vector_type(8)));
template <class Epi, class Sched, bool ALIGN_EPI = false, bool SP2 = false, bool GATHER = false, bool FP8 = false>
__device__ __forceinline__ void gemm_phase(PG8_LAS unsigned char* lds, const Gemm g, const Sched& S, const Epi& E, const PG8_LAS int* rowlists = nullptr) {
    static_assert(!GATHER || SP2, "GATHER is implemented for the SP2 loop");
    const int tid = threadIdx.x, wid = __builtin_amdgcn_readfirstlane(tid >> 6), lane = tid & 63, wr = wid >> 2, wc = wid & 3, fr = lane & 15, fq = lane >> 4;
    const int K = g.K, nt = K / BK;
    unsigned voffA, voffB; int gR, gC;
    { int R, C; stage_rc(tid * 16, R, C); const int Rb = Epi::PERM ? ((R & ~31) + perm32(R & 31)) : R; gR = R; gC = C;
      voffA = (unsigned)(R * K + C) * 2u; voffB = (unsigned)(Rb * K + C) * 2u; }
    const size_t row64 = (size_t)64 * K * 2;
    const size_t kstep = (size_t)(BK * 2);
    const size_t hstep = (size_t)HALF * K * 2;
    const size_t tstep = 2 * hstep;
    const unsigned ldsw = (unsigned)wid * 1024u;
    const int aoff = lds_byte(wr * 64 + fr, fq * 8), boff = lds_byte(wc * 32 + fr, fq * 8);
#define PG8_SA(b, h) (((b) * 2 + (h)) * HTB)
#define PG8_SB(b, h) ((4 + (b) * 2 + (h)) * HTB)
#define PG8_STAGE2(bufoff, gbase, v0_, v1_) do { unsigned vo0_ = (v0_), vo1_ = (v1_); asm volatile("" : "+v"(vo0_), "+v"(vo1_));     \
        __builtin_amdgcn_global_load_lds((const unsigned*)((const char*)(gbase) + vo0_), (PG8_LAS unsigned*)(lds + (bufoff) + ldsw), 16, 0, 0); \
        __builtin_amdgcn_global_load_lds((const unsigned*)((const char*)(gbase) + vo1_), (PG8_LAS unsigned*)(lds + (bufoff) + ldsw + 8192), 16, 0, 0); } while (0)
#define PG8_STAGE(bufoff, gbase, voff) do { unsigned vo_ = (voff); asm volatile("" : "+v"(vo_)); \
        __builtin_amdgcn_global_load_lds((const unsigned*)((const char*)(gbase) + vo_), (PG8_LAS unsigned*)(lds + (bufoff) + ldsw), 16, 0, 0); \
        __builtin_amdgcn_global_load_lds((const unsigned*)((const char*)(gbase) + row64 + vo_), (PG8_LAS unsigned*)(lds + (bufoff) + ldsw + 8192), 16, 0, 0); } while (0)
#define PG8_LDA(dst, b, h) do { _Pragma("unroll") for (int m = 0; m < 4; ++m) _Pragma("unroll") for (int k = 0; k < 2; ++k) dst[m][k] = *(const PG8_LAS bf16x8*)(lds + PG8_SA(b, h) + aoff + m * 2048 + k * 1024); } while (0)
#define PG8_LDB(dst, b, h) do { _Pragma("unroll") for (int n = 0; n < 2; ++n) _Pragma("unroll") for (int k = 0; k < 2; ++k) dst[n][k] = *(const PG8_LAS bf16x8*)(lds + PG8_SB(b, h) + boff + n * 2048 + k * 1024); } while (0)
#define PG8_CAT8(x, y) __builtin_shufflevector(__builtin_bit_cast(v4i_t, (x)), __builtin_bit_cast(v4i_t, (y)), 0, 1, 2, 3, 4, 5, 6, 7)
#define PG8_MMA(ai, bj, At, Bt) do { __builtin_amdgcn_s_setprio(1); _Pragma("unroll") for (int m = 0; m < 4; ++m) _Pragma("unroll") for (int n = 0; n < 2; ++n) { \
        if constexpr (FP8) { const v8i_t a8_ = PG8_CAT8(Bt[n][0], Bt[n][1]), b8_ = PG8_CAT8(At[m][0], At[m][1]);     \
            asm volatile("v_mfma_scale_f32_16x16x128_f8f6f4 %0, %1, %2, %0, %3, %4 op_sel_hi:[0,0,0]" : "+v"(acc[ai][bj][m][n]) : "v"(a8_), "v"(b8_), "v"(mxsa_), "v"(mxsb_)); } \
        else { _Pragma("unroll") for (int k = 0; k < 2; ++k) acc[ai][bj][m][n] = __builtin_amdgcn_mfma_f32_16x16x32_bf16(Bt[n][k], At[m][k], acc[ai][bj][m][n], 0, 0, 0); } } \
        __builtin_amdgcn_s_setprio(0); } while (0)
#define PG8_WAIT_V(n) asm volatile("s_waitcnt vmcnt(" #n ")" ::: "memory")
#define PG8_WAIT_VN(n) asm volatile("s_waitcnt vmcnt(%0)" :: "i"(n) : "memory")
#define PG8_WAIT_L(n) asm volatile("s_waitcnt lgkmcnt(" #n ")" ::: "memory")
#define PG8_BAR __builtin_amdgcn_s_barrier()
#define PG8_SCHED __builtin_amdgcn_sched_barrier(0)
    Unit cur, nxt; int ui = 0;
    if (!S.next(0, cur)) return;
    int mxsa_ = 121, mxsb_ = 127; asm volatile("" : "+v"(mxsa_), "+v"(mxsb_));
    f32x4 acc[2][2][4][2];
#pragma unroll
    for (int a = 0; a < 2; ++a)
#pragma unroll
        for (int b = 0; b < 2; ++b)
#pragma unroll
            for (int m = 0; m < 4; ++m)
#pragma unroll
                for (int n = 0; n < 2; ++n) acc[a][b][m][n] = (f32x4){0.f, 0.f, 0.f, 0.f};
    bf16x8 At[4][2], B0[2][2], B1[2][2];
    const char* cA = GATHER ? (const char*)S.a_base(cur) : (const char*)g.A + (size_t)cur.pm * tstep; const char* cB = (const char*)g.Bt + (size_t)cur.pn * tstep;
#define PG8_STAGE_A(bufoff, kptr, half, unx) do { if constexpr (GATHER) { const PG8_LAS int* rl_ = rowlists + (ui + (unx)) * 256 + (half) * HALF + gR; \
        PG8_STAGE2(bufoff, kptr, (unsigned)(rl_[0] * K + gC) * 2u, (unsigned)(rl_[64] * K + gC) * 2u); } \
        else { PG8_STAGE(bufoff, (kptr) + (half) * hstep, voffA); } } while (0)
    S.a_ready(cur);
    if constexpr (SP2) {
        PG8_STAGE(PG8_SB(0, 0), cB, voffB); PG8_STAGE(PG8_SB(0, 1), cB + hstep, voffB); PG8_STAGE_A(PG8_SA(0, 0), cA, 0, 0); PG8_STAGE_A(PG8_SA(0, 1), cA, 1, 0);
        if (wr == 1) PG8_BAR;
        PG8_WAIT_V(2); PG8_BAR;
        PG8_STAGE(PG8_SB(1, 0), cB + kstep, voffB); PG8_STAGE_A(PG8_SA(1, 0), cA + kstep, 0, 0); PG8_STAGE(PG8_SB(1, 1), cB + hstep + kstep, voffB);
        PG8_WAIT_V(6); PG8_BAR;
    } else {
        PG8_STAGE(PG8_SB(0, 0), cB, voffB); PG8_STAGE(PG8_SA(0, 0), cA, voffA); PG8_STAGE(PG8_SB(0, 1), cB + hstep, voffB); PG8_STAGE(PG8_SA(0, 1), cA + hstep, voffA);
        if (wr == 1) PG8_BAR;
        PG8_WAIT_V(4); PG8_BAR;
        PG8_STAGE(PG8_SB(1, 0), cB + kstep, voffB); PG8_STAGE(PG8_SA(1, 0), cA + kstep, voffA); PG8_STAGE(PG8_SB(1, 1), cB + hstep + kstep, voffB);
        PG8_WAIT_V(6); PG8_BAR;
    }
    for (;;) {
        const bool has_next = S.next(ui + 1, nxt);
        const char* nA = GATHER ? (has_next ? (const char*)S.a_base(nxt) : cA) : (has_next ? (const char*)g.A + (size_t)nxt.pm * tstep : cA);
        const char* nB = has_next ? (const char*)g.Bt + (size_t)nxt.pn * tstep : cB;
#pragma unroll 1
        for (int t = 0; t < nt; t += 2) {
            const bool last = (t == nt - 2);
            if constexpr (Epi::MIDK) { if (t == (nt >> 1)) { if constexpr (FP8) asm volatile("s_nop 15\n\ts_nop 7" ::: "memory"); E.mid(acc, cur, wr, wc, fr, fq); } }
            const char* a1 = cA + (size_t)(t + 1) * kstep;
            const char* a2 = last ? nA : cA + (size_t)(t + 2) * kstep; const char* b2 = last ? nB : cB + (size_t)(t + 2) * kstep;
            const char* a3 = a2 + kstep; const char* b3 = b2 + kstep;
            if (last && has_next) S.a_ready(nxt);
            const int unx = (GATHER && last && has_next) ? 1 : 0;
            if constexpr (SP2) {
            PG8_LDB(B0, 0, 0); PG8_LDB(B1, 0, 1); PG8_SCHED; PG8_LDA(At, 0, 0); PG8_STAGE_A(PG8_SA(1, 1), a1, 1, 0);
            PG8_WAIT_V(8); PG8_WAIT_L(0); PG8_BAR; PG8_MMA(0, 0, At, B0); PG8_MMA(0, 1, At, B1); PG8_BAR; PG8_SCHED;
            PG8_LDA(At, 0, 1); PG8_STAGE(PG8_SB(0, 0), b2, voffB); PG8_STAGE(PG8_SB(0, 1), b2 + hstep, voffB); PG8_STAGE_A(PG8_SA(0, 0), a2, 0, unx);
            PG8_WAIT_V(8); PG8_WAIT_L(0); PG8_BAR; PG8_MMA(1, 0, At, B0); PG8_MMA(1, 1, At, B1); PG8_BAR; PG8_SCHED;
            PG8_LDB(B0, 1, 0); PG8_LDB(B1, 1, 1); PG8_SCHED; PG8_LDA(At, 1, 0); PG8_STAGE_A(PG8_SA(0, 1), a2, 1, unx);
            PG8_WAIT_V(8); PG8_WAIT_L(0); PG8_BAR; PG8_MMA(0, 0, At, B0); PG8_MMA(0, 1, At, B1); PG8_BAR; PG8_SCHED;
            PG8_LDA(At, 1, 1); PG8_STAGE(PG8_SB(1, 0), b3, voffB); PG8_STAGE(PG8_SB(1, 1), b3 + hstep, voffB); PG8_STAGE_A(PG8_SA(1, 0), a3, 0, unx);
            PG8_WAIT_V(8); PG8_WAIT_L(0); PG8_BAR; PG8_MMA(1, 0, At, B0); PG8_MMA(1, 1, At, B1); PG8_BAR; PG8_SCHED;
            } else {
            PG8_LDB(B0, 0, 0); PG8_SCHED; PG8_LDA(At, 0, 0); PG8_STAGE(PG8_SA(1, 1), a1 + hstep, voffA);
            PG8_WAIT_L(8); PG8_BAR; PG8_WAIT_L(0); PG8_MMA(0, 0, At, B0); PG8_BAR; PG8_SCHED;
            PG8_LDB(B1, 0, 1); PG8_STAGE(PG8_SB(0, 0), b2, voffB);
            PG8_BAR; PG8_WAIT_L(0); PG8_MMA(0, 1, At, B1); PG8_BAR;
            PG8_LDA(At, 0, 1); PG8_STAGE(PG8_SA(0, 0), a2, voffA);
            PG8_BAR; PG8_WAIT_L(0); PG8_MMA(1, 0, At, B0); PG8_BAR; PG8_SCHED;
            PG8_STAGE(PG8_SB(0, 1), b2 + hstep, voffB);
            PG8_WAIT_V(6); PG8_BAR; PG8_MMA(1, 1, At, B1); PG8_BAR;
            PG8_LDB(B0, 1, 0); PG8_SCHED; PG8_LDA(At, 1, 0); PG8_STAGE(PG8_SA(0, 1), a2 + hstep, voffA);
            PG8_WAIT_L(8); PG8_BAR; PG8_WAIT_L(0); PG8_MMA(0, 0, At, B0); PG8_BAR; PG8_SCHED;
            PG8_LDB(B1, 1, 1); PG8_STAGE(PG8_SB(1, 0), b3, voffB);
            PG8_BAR; PG8_WAIT_L(0); PG8_MMA(0, 1, At, B1); PG8_BAR;
            PG8_LDA(At, 1, 1); PG8_STAGE(PG8_SA(1, 0), a3, voffA);
            PG8_BAR; PG8_WAIT_L(0); PG8_MMA(1, 0, At, B0); PG8_BAR; PG8_SCHED;
            PG8_STAGE(PG8_SB(1, 1), b3 + hstep, voffB);
            PG8_WAIT_V(6); PG8_BAR; PG8_MMA(1, 1, At, B1); PG8_BAR;
            }
        }
        if constexpr (ALIGN_EPI) { if (wr == 0) PG8_BAR; }
        if constexpr (FP8) asm volatile("s_nop 15\n\ts_nop 7" ::: "memory");
        if constexpr (!Epi::AFTER_DRAIN) { E(acc, cur, wr, wc, fr, fq); S.done(cur); }
        if (!has_next) break;
#pragma unroll
        for (int a = 0; a < 2; ++a)
#pragma unroll
            for (int b = 0; b < 2; ++b)
#pragma unroll
                for (int m = 0; m < 4; ++m)
#pragma unroll
                    for (int n = 0; n < 2; ++n) acc[a][b][m][n] = (f32x4){0.f, 0.f, 0.f, 0.f};
        cur = nxt; cA = nA; cB = nB; ++ui;
        if constexpr (ALIGN_EPI) { if (wr == 1) PG8_BAR; }
    }
    PG8_WAIT_V(0);
    if constexpr (!ALIGN_EPI) { if (wr == 0) PG8_BAR; }
    PG8_BAR;
    if constexpr (Epi::AFTER_DRAIN) { E.fused(acc, cur, wr, wc, fr, fq, lds, wid, lane); S.done(cur); }
#undef PG8_SA
#undef PG8_STAGE_A
#undef PG8_SB
#undef PG8_STAGE
#undef PG8_STAGE2
#undef PG8_LDA
#undef PG8_LDB
#undef PG8_MMA
#undef PG8_CAT8
#undef PG8_WAIT_V
#undef PG8_WAIT_VN
#undef PG8_WAIT_L
#undef PG8_BAR
#undef PG8_SCHED
}
}

constexpr int NB = 4, SEQ = 4096, DM = 1024, NTOK = NB * SEQ, DIN = 7168, NH = 8, HD = 128;
constexpr int NEXP = 32, TOPK = 4, MAXBLK = 288, RMAX = MAXBLK * 256;
constexpr float EPS = 1e-6f;
constexpr int NWAVES = 8;

constexpr size_t MiB = 1u << 20, KiB = 1u << 10;
constexpr size_t WS_CTL = 0, CTL_ZERO_BYTES = 1 * MiB;
constexpr size_t WS_MOD = 1 * MiB;
constexpr size_t WS_KMEAN = 1 * MiB + 128 * KiB;
constexpr size_t WS_AGGP = 1 * MiB + 384 * KiB;
constexpr size_t WS_AGGH = 1 * MiB + 640 * KiB;
constexpr size_t WS_WRH = 2 * MiB, WS_WRL = 2 * MiB + 64 * KiB;
constexpr size_t WS_TOKE = 3 * MiB, WS_TOKPOS = 3 * MiB + 256 * KiB;
constexpr int ECAP = 16384;
constexpr size_t WS_ROWTOK = 28 * MiB, WS_ROWGATE = 30 * MiB;
constexpr int CW_UPDONE = 16384;
constexpr int CW_QUEUE = 12288;
constexpr int CW_CNT = 8192;
constexpr size_t WS_TRIG = 4 * MiB;
constexpr size_t WS_WRG = 6 * MiB;
constexpr size_t WS_WIN = 8 * MiB;
constexpr size_t WS_WIN8 = 16 * MiB;
constexpr size_t WS_H8 = 544 * MiB;
constexpr size_t WS_WB = 22 * MiB;
constexpr size_t WS_WO = 26 * MiB;
constexpr size_t WS_WUP = 32 * MiB;
constexpr size_t WS_WDN = 96 * MiB;
constexpr size_t WS_HB = 224 * MiB;
constexpr size_t WS_E = 256 * MiB;
constexpr size_t E_STRIDE = (size_t)NTOK * DM;
constexpr size_t WS_HL = 480 * MiB, WS_PP = 512 * MiB, WS_YCAT = 544 * MiB;
constexpr int CW_MODCNT = 8256;
constexpr size_t WS_ACT = 400 * MiB, WS_YR = 544 * MiB;
constexpr size_t WS_END = 688 * MiB;
constexpr int CW_BAR = 4096;

constexpr int RING_OFF = 0, RING_BYTES = 131072;
constexpr int LDSCTL_OFF = RING_BYTES, MISC_OFF = LDSCTL_OFF + 320;
constexpr int XTRA_OFF = LDSCTL_OFF + 1024;
constexpr int LDS_BYTES = 155648;

#define GAS __attribute__((address_space(1)))
#define LAS __attribute__((address_space(3)))
typedef unsigned short bf16;
typedef unsigned v4u __attribute__((ext_vector_type(4)));
typedef unsigned v2u __attribute__((ext_vector_type(2)));
typedef float f32x4 __attribute__((ext_vector_type(4)));
typedef float f32x2 __attribute__((ext_vector_type(2)));
typedef float f32x16 __attribute__((ext_vector_type(16)));
typedef short bf16x8 __attribute__((ext_vector_type(8)));
typedef short s16x4 __attribute__((ext_vector_type(4)));
typedef GAS unsigned gu32;
#define RLX_AGENT __ATOMIC_RELAXED, __HIP_MEMORY_SCOPE_AGENT
#define LDS_WAIT() asm volatile("s_waitcnt lgkmcnt(0)" ::: "memory")
#define VM_WAIT() asm volatile("s_waitcnt vmcnt(0)" ::: "memory")
#define SBAR() __builtin_amdgcn_sched_barrier(0)
__device__ __forceinline__ unsigned f2bf(float f) { unsigned u = __builtin_bit_cast(unsigned, f); return (u + 0x7fffu + ((u >> 16) & 1u)) >> 16; }
__device__ __forceinline__ unsigned pk2(float lo, float hi) { return f2bf(lo) | (f2bf(hi) << 16); }
__device__ __forceinline__ float bf2f(unsigned short h) { return __builtin_bit_cast(float, (unsigned)h << 16); }
__device__ __forceinline__ float bflo(unsigned w) { return __builtin_bit_cast(float, w << 16); }
__device__ __forceinline__ float bfhi(unsigned w) { return __builtin_bit_cast(float, w & 0xffff0000u); }
__device__ __forceinline__ unsigned cvtpk(float lo, float hi) { unsigned r; asm volatile("v_cvt_pk_bf16_f32 %0, %1, %2" : "=v"(r) : "v"(lo), "v"(hi)); return r; }
__device__ __forceinline__ float fast_sigmoid(float x) { return __builtin_amdgcn_rcpf(1.0f + __builtin_amdgcn_exp2f(-1.4426950408889634f * x)); }
__device__ __forceinline__ float gelu_tanh(float x) { const float z = 1.5957691216057308f * (x + 0.044715f * x * x * x); return x * fast_sigmoid(z); }
__device__ __forceinline__ f32x2 sigmoid_pk(f32x2 x) { const f32x2 z = x * (-1.4426950408889634f); f32x2 e; e.x = __builtin_amdgcn_exp2f(z.x); e.y = __builtin_amdgcn_exp2f(z.y);
    const f32x2 d = e + 1.0f; f32x2 r; r.x = __builtin_amdgcn_rcpf(d.x); r.y = __builtin_amdgcn_rcpf(d.y); return r; }
__device__ __forceinline__ f32x2 gelu_tanh_pk(f32x2 x) {
    const f32x2 u = x * x, w = u * (-0.044715f * 1.5957691216057308f * 1.4426950408889634f) + (-1.5957691216057308f * 1.4426950408889634f), z = x * w;
    f32x2 e; e.x = __builtin_amdgcn_exp2f(z.x); e.y = __builtin_amdgcn_exp2f(z.y);
    const f32x2 d = e + 1.0f; f32x2 r; r.x = __builtin_amdgcn_rcpf(d.x); r.y = __builtin_amdgcn_rcpf(d.y); return x * r; }
__device__ __forceinline__ float wave_sum(float v) {
#pragma unroll
    for (int o = 1; o < 64; o <<= 1) v += __shfl_xor(v, o);
    return v;
}
__device__ __forceinline__ float wave_max(float v) {
#pragma unroll
    for (int o = 1; o < 64; o <<= 1) v = fmaxf(v, __shfl_xor(v, o));
    return v;
}

#define XB_TMO      128
#define XB_XCNT(j)  (256  + 64 * (j))
#define XB_XSUB(j)  (1280 + 64 * (j))
#define XB_XGEN(j)  (2304 + 64 * (j))
#define XB_TOP      3328
#define XB_TOPGEN   3392
#define XCD_BAR_WORDS 3456
#define XB_SPIN_CAP (1u << 20)
__device__ __forceinline__ unsigned xb_ld(unsigned* p)              { return __hip_atomic_load(p, __ATOMIC_RELAXED, __HIP_MEMORY_SCOPE_AGENT); }
__device__ __forceinline__ unsigned xb_add(unsigned* p, unsigned v) { return __hip_atomic_fetch_add(p, v, __ATOMIC_RELAXED, __HIP_MEMORY_SCOPE_AGENT); }
__device__ __forceinline__ unsigned xb_xcc_id() { return (unsigned)__builtin_amdgcn_s_getreg((3 << 11) | 20) & 0xFu; }
#define XB_SPIN(cond, bar) do { unsigned _sp = 0; while (cond) { __builtin_amdgcn_s_sleep(1); \
    if ((++_sp & 255u) == 0u) { if (xb_ld(&(bar)[XB_TMO])) break; if (_sp > XB_SPIN_CAP) { atomicAdd(&(bar)[XB_TMO], 1u); break; } } } } while (0)
struct XcdBarrier { unsigned* bar; unsigned x; volatile LAS unsigned* st; };
__device__ __forceinline__ XcdBarrier xcd_barrier_post(unsigned* bar, volatile LAS unsigned* st) {
    XcdBarrier b; b.bar = bar; b.x = xb_xcc_id(); b.st = st;
    if (threadIdx.x == 0) (void)xb_add(&bar[XB_XCNT(b.x)], 1u);
    return b;
}
__device__ __forceinline__ void xcd_barrier_complete(unsigned* bar, unsigned x, unsigned& nloc, unsigned& nx) {
    const unsigned G = gridDim.x * gridDim.y * gridDim.z;
    unsigned sum, cnt, mine, sp = 0u;
    for (;;) {
        sum = 0u; cnt = 0u; mine = 0u;
#pragma unroll
        for (unsigned j = 0; j < 16; ++j) { const unsigned c = xb_ld(&bar[XB_XCNT(j)]); sum += c; cnt += (c > 0u) ? 1u : 0u; mine = (j == x) ? c : mine; }
        if (sum == G) break;
        __builtin_amdgcn_s_sleep(1);
        if ((++sp & 255u) == 0u) { if (xb_ld(&bar[XB_TMO])) break; if (sp > XB_SPIN_CAP) { atomicAdd(&bar[XB_TMO], 1u); break; } }
    }
    nloc = mine > 0u ? mine : 1u; nx = cnt > 0u ? cnt : 1u;
}
__device__ __forceinline__ void xcd_barrier(const XcdBarrier& b) {
    asm volatile("s_waitcnt vmcnt(0)" ::: "memory");
    __syncthreads();
    if (threadIdx.x == 0) {
        unsigned* bar = b.bar;
        __builtin_amdgcn_s_waitcnt(0);
        unsigned nloc = b.st[0], nx = b.st[1];
        if (nloc == 0u) { xcd_barrier_complete(bar, b.x, nloc, nx); b.st[0] = nloc; b.st[1] = nx; }
        const unsigned old = xb_add(&bar[XB_XSUB(b.x)], 1u);
        const unsigned gen = old / nloc;
        if (old + 1u == (gen + 1u) * nloc) {
            __builtin_amdgcn_fence(__ATOMIC_RELEASE, "agent");
            asm volatile("s_waitcnt vmcnt(0)" ::: "memory");
            const unsigned og = xb_add(&bar[XB_TOP], 1u);
            const unsigned tg = og / nx;
            if (og + 1u == (tg + 1u) * nx) xb_add(&bar[XB_TOPGEN], 1u);
            else XB_SPIN(xb_ld(&bar[XB_TOPGEN]) == tg, bar);
            __builtin_amdgcn_fence(__ATOMIC_ACQUIRE, "agent");
            xb_add(&bar[XB_XGEN(b.x)], 1u);
            asm volatile("s_waitcnt vmcnt(0)" ::: "memory");
        } else {
            XB_SPIN(xb_ld(&bar[XB_XGEN(b.x)]) == gen, bar);
            __builtin_amdgcn_fence(__ATOMIC_ACQUIRE, "agent");
            asm volatile("s_waitcnt vmcnt(0)" ::: "memory");
        }
    }
    __syncthreads();
}

struct Args { const void* in[26]; float* out; unsigned char* ws; int ph_lo, ph_hi; };
struct Frame {
    LAS unsigned char* lds; char* ldsg;
    volatile LAS unsigned* MISC;
    int tid, lane, wave, vcu, G;
    unsigned char* ws; float* out;
};
#define IN_F(k) ((const float*)args.in[k])
#define IN_I(k) ((const int*)args.in[k])
#define WSP(T, off) ((T*)(F.ws + (off)))

namespace pg8 {
struct TileOrder {
    int nM, nN, nwg, G, c; const LAS int* blk_exp; const void* abase;
    __device__ __forceinline__ void init(int nM_, int nN_, int G_, int c_, const LAS int* be, const void* ab = nullptr) { nM = nM_; nN = nN_; nwg = nM * nN; G = G_; c = c_; blk_exp = be; abase = ab; }
    __device__ __forceinline__ const void* a_base(const Unit&) const { return abase; }
    __device__ __forceinline__ bool next(int i, Unit& u) const {
        const long L = (long)i * G + c; if (L >= nwg) return false;
        int wgid = (int)L; { const int q = nwg / NXCD, r = nwg % NXCD, xcd = wgid % NXCD, off = wgid / NXCD; wgid = (xcd < r ? xcd * (q + 1) : r * (q + 1) + (xcd - r) * q) + off; }
        const int nig = WGM * nN, gid = wgid / nig, fm = gid * WGM, gsz = (nM - fm) < WGM ? (nM - fm) : WGM;
        u.pm = fm + ((wgid % nig) % gsz); u.pn = (wgid % nig) / gsz; u.kind = 0;
        if (blk_exp) { const int e = __builtin_amdgcn_readfirstlane(blk_exp[u.pm]); u.pn += e * nN; }
        return true;
    }
    __device__ __forceinline__ void a_ready(const Unit&) const {}
    __device__ __forceinline__ void done(const Unit&) const {}
};

__device__ __forceinline__ void st16_wt(void* p, u32x4 v) { asm volatile("global_store_dwordx4 %0, %1, off sc1\n\ts_nop 1" :: "v"(p), "v"(v) : "memory"); }
struct EpiWin {
    static constexpr bool PERM = true, AFTER_DRAIN = false, MIDK = false; static constexpr int NSTORES = 16;
    bf16_t* E; const float* b_gate; int mode;
    __device__ __forceinline__ void operator()(const f32x4 (&acc)[2][2][4][2], const Unit& u, int wr, int wc, int fr, int fq) const {
        const int opn = mode == 0 ? (u.pn < 8 ? u.pn : u.pn + 8) : (u.pn < 8 ? u.pn + 8 : u.pn + 12);
        const int t = opn >> 2, colt = (opn & 3) * BM;
        bf16_t* base = E + (size_t)t * ((size_t)16384 * 1024);
        int row0 = u.pm * BM + wr * 64 + fr; const int col0 = colt + wc * 32 + 8 * fq;
        asm volatile("" : "+v"(row0));
        f32x4 bv[2][2];
#pragma unroll
        for (int bj = 0; bj < 2; ++bj)
#pragma unroll
            for (int n = 0; n < 2; ++n) bv[bj][n] = (t >= 5) ? *(const f32x4*)(b_gate + (t - 5) * 1024 + col0 + bj * HALF + 4 * n) : (f32x4){0.f, 0.f, 0.f, 0.f};
#pragma unroll
        for (int ai = 0; ai < 2; ++ai)
#pragma unroll
            for (int m = 0; m < 4; ++m) { bf16_t* rowp = base + (size_t)(row0 + ai * HALF + m * 16) * 1024 + col0;
#pragma unroll
                for (int bj = 0; bj < 2; ++bj) { f32x4 v0 = acc[ai][bj][m][0] + bv[bj][0], v1 = acc[ai][bj][m][1] + bv[bj][1];
                    if (t == 1) { const f32x2 a = gelu_tanh_pk((f32x2){v0[0], v0[1]}), b = gelu_tanh_pk((f32x2){v0[2], v0[3]}), c = gelu_tanh_pk((f32x2){v1[0], v1[1]}), d = gelu_tanh_pk((f32x2){v1[2], v1[3]});
                        v0 = (f32x4){a.x, a.y, b.x, b.y}; v1 = (f32x4){c.x, c.y, d.x, d.y}; }
                    else if (t >= 5) { const f32x2 a = sigmoid_pk((f32x2){v0[0], v0[1]}), b = sigmoid_pk((f32x2){v0[2], v0[3]}), c = sigmoid_pk((f32x2){v1[0], v1[1]}), d = sigmoid_pk((f32x2){v1[2], v1[3]});
                        v0 = (f32x4){a.x, a.y, b.x, b.y}; v1 = (f32x4){c.x, c.y, d.x, d.y}; }
                    u32x4 w; w.x = cvt_pk_bf16(v0[0], v0[1]); w.y = cvt_pk_bf16(v0[2], v0[3]); w.z = cvt_pk_bf16(v1[0], v1[1]); w.w = cvt_pk_bf16(v1[2], v1[3]);
                    *(u32x4*)(rowp + bj * HALF) = w; } }
    }
};
struct EpiBranch {
    static constexpr bool PERM = true, AFTER_DRAIN = false, MIDK = true; static constexpr int NSTORES = 16;
    const bf16_t* SG0; const bf16_t* SG1; bf16_t* MIX;
    __device__ __forceinline__ void mid(f32x4 (&acc)[2][2][4][2], const Unit& u, int wr, int wc, int fr, int fq) const {
        int row0 = u.pm * BM + wr * 64 + fr; const int col0 = u.pn * BM + wc * 32 + 8 * fq;
        asm volatile("" : "+v"(row0));
#pragma unroll
        for (int ai = 0; ai < 2; ++ai)
#pragma unroll
            for (int m = 0; m < 4; ++m) { const size_t ro = (size_t)(row0 + ai * HALF + m * 16) * 1024 + col0;
#pragma unroll
                for (int bj = 0; bj < 2; ++bj) { const size_t o = ro + bj * HALF;
                    const u32x4 a = *(const u32x4*)(SG0 + o), b = *(const u32x4*)(SG1 + o);
                    const float r0 = bflo(a.x) * __builtin_amdgcn_rcpf(fmaxf(bflo(b.x), 1e-18f)), r1 = bfhi(a.x) * __builtin_amdgcn_rcpf(fmaxf(bfhi(b.x), 1e-18f));
                    const float r2 = bflo(a.y) * __builtin_amdgcn_rcpf(fmaxf(bflo(b.y), 1e-18f)), r3 = bfhi(a.y) * __builtin_amdgcn_rcpf(fmaxf(bfhi(b.y), 1e-18f));
                    const float r4 = bflo(a.z) * __builtin_amdgcn_rcpf(fmaxf(bflo(b.z), 1e-18f)), r5 = bfhi(a.z) * __builtin_amdgcn_rcpf(fmaxf(bfhi(b.z), 1e-18f));
                    const float r6 = bflo(a.w) * __builtin_amdgcn_rcpf(fmaxf(bflo(b.w), 1e-18f)), r7 = bfhi(a.w) * __builtin_amdgcn_rcpf(fmaxf(bfhi(b.w), 1e-18f));
                    acc[ai][bj][m][0] *= (f32x4){r0, r1, r2, r3}; acc[ai][bj][m][1] *= (f32x4){r4, r5, r6, r7}; }
                asm volatile("" ::: "memory"); }
    }
    __device__ __forceinline__ void operator()(const f32x4 (&acc)[2][2][4][2], const Unit& u, int wr, int wc, int fr, int fq) const {
        int row0 = u.pm * BM + wr * 64 + fr; const int col0 = u.pn * BM + wc * 32 + 8 * fq;
        asm volatile("" : "+v"(row0));
#pragma unroll
        for (int ai = 0; ai < 2; ++ai)
#pragma unroll
            for (int m = 0; m < 4; ++m) { const size_t ro = (size_t)(row0 + ai * HALF + m * 16) * 1024 + col0;
#pragma unroll
                for (int bj = 0; bj < 2; ++bj) { const size_t o = ro + bj * HALF;
                    const u32x4 b = *(const u32x4*)(SG1 + o);
                    const f32x4 g0 = {fmaxf(bflo(b.x), 1e-18f), fmaxf(bfhi(b.x), 1e-18f), fmaxf(bflo(b.y), 1e-18f), fmaxf(bfhi(b.y), 1e-18f)}, g1 = {fmaxf(bflo(b.z), 1e-18f), fmaxf(bfhi(b.z), 1e-18f), fmaxf(bflo(b.w), 1e-18f), fmaxf(bfhi(b.w), 1e-18f)};
                    const f32x4 v0 = acc[ai][bj][m][0] * g0, v1 = acc[ai][bj][m][1] * g1;
                    u32x4 w; w.x = cvt_pk_bf16(v0[0], v0[1]); w.y = cvt_pk_bf16(v0[2], v0[3]); w.z = cvt_pk_bf16(v1[0], v1[1]); w.w = cvt_pk_bf16(v1[2], v1[3]);
                    *(u32x4*)(MIX + o) = w; } }
    }
};
struct EpiWout {
    static constexpr bool PERM = false, AFTER_DRAIN = false, MIDK = false; static constexpr int NSTORES = 32;
    const float* x; float* out; const float* mod;
    __device__ __forceinline__ void operator()(const f32x4 (&acc)[2][2][4][2], const Unit& u, int wr, int wc, int fr, int fq) const {
        int row0 = u.pm * BM + wr * 64 + fr; const int col0 = u.pn * BM + wc * 32 + 4 * fq;
        asm volatile("" : "+v"(row0));
        const float* g1p = mod + (size_t)(u.pm >> 4) * 6144 + 2048;
        f32x4 gv[2][2];
#pragma unroll
        for (int bj = 0; bj < 2; ++bj)
#pragma unroll
            for (int n = 0; n < 2; ++n) gv[bj][n] = *(const f32x4*)(g1p + col0 + bj * HALF + n * 16);
#pragma unroll
        for (int ai = 0; ai < 2; ++ai)
#pragma unroll
            for (int m = 0; m < 4; ++m) { const size_t ro = (size_t)(row0 + ai * HALF + m * 16) * 1024 + col0;
#pragma unroll
                for (int bj = 0; bj < 2; ++bj)
#pragma unroll
                    for (int n = 0; n < 2; ++n) { const size_t o = ro + bj * HALF + n * 16; *(f32x4*)(out + o) = *(const f32x4*)(x + o) + gv[bj][n] * acc[ai][bj][m][n]; } }
    }
};
__device__ __forceinline__ unsigned pk_fp8x4(float a, float b, float c, float d) { int p = __builtin_amdgcn_cvt_pk_fp8_f32(a, b, 0, false); p = __builtin_amdgcn_cvt_pk_fp8_f32(c, d, p, true); return (unsigned)p; }
struct EpiUp {
    static constexpr bool PERM = true, AFTER_DRAIN = false, MIDK = false; static constexpr int NSTORES = 8;
    unsigned char* ACT; const float* b_up;
    __device__ __forceinline__ void operator()(const f32x4 (&acc)[2][2][4][2], const Unit& u, int wr, int wc, int fr, int fq) const {
        const int e = u.pn >> 3, p = u.pn & 7;
        int row0 = u.pm * BM + wr * 64 + fr; const int c0 = p * 128 + wc * 32 + 8 * fq;
        asm volatile("" : "+v"(row0));
        const float* bg = b_up + (size_t)e * 2048 + c0; const float* bl = bg + 1024;
        f32x4 bgv[2], blv[2];
#pragma unroll
        for (int n = 0; n < 2; ++n) { bgv[n] = *(const f32x4*)(bg + 4 * n); blv[n] = *(const f32x4*)(bl + 4 * n) + 1.0f; }
#pragma unroll
        for (int ai = 0; ai < 2; ++ai)
#pragma unroll
            for (int m = 0; m < 4; ++m) { unsigned char* rowp = ACT + (size_t)(row0 + ai * HALF + m * 16) * 1024 + c0;
                f32x4 a[2];
#pragma unroll
                for (int n = 0; n < 2; ++n) {
#pragma unroll
                    for (int j = 0; j < 4; j += 2) { f32x2 g = (f32x2){acc[ai][0][m][n][j], acc[ai][0][m][n][j + 1]} + (f32x2){bgv[n][j], bgv[n][j + 1]};
                        f32x2 l = (f32x2){acc[ai][1][m][n][j], acc[ai][1][m][n][j + 1]} + (f32x2){blv[n][j], blv[n][j + 1]};
                        g.x = fminf(g.x, 7.0f); g.y = fminf(g.y, 7.0f); l.x = __builtin_amdgcn_fmed3f(l.x, -6.0f, 8.0f); l.y = __builtin_amdgcn_fmed3f(l.y, -6.0f, 8.0f);
                        const f32x2 z = g * (-1.702f * 1.4426950408889634f); f32x2 e; e.x = __builtin_amdgcn_exp2f(z.x); e.y = __builtin_amdgcn_exp2f(z.y);
                        const f32x2 d = e + 1.0f; f32x2 r; r.x = __builtin_amdgcn_rcpf(d.x); r.y = __builtin_amdgcn_rcpf(d.y);
                        const f32x2 o = (l * g) * r; a[n][j] = o.x; a[n][j + 1] = o.y; } }
                typedef unsigned u32x2_t __attribute__((ext_vector_type(2)));
                u32x2_t w; w.x = pk_fp8x4(a[0][0], a[0][1], a[0][2], a[0][3]); w.y = pk_fp8x4(a[1][0], a[1][1], a[1][2], a[1][3]);
                *(u32x2_t*)rowp = w; }
    }
};
struct EpiDown {
    static constexpr bool PERM = true, AFTER_DRAIN = false, MIDK = false; static constexpr int NSTORES = 16;
    bf16_t* YR; const float* b_down; const float* row_gate; const LAS int* tbl;
    __device__ __forceinline__ void operator()(const f32x4 (&acc)[2][2][4][2], const Unit& u, int wr, int wc, int fr, int fq) const {
        const int e = u.pn >> 2, p = u.pn & 3;
        int row0 = u.pm * BM + wr * 64 + fr; const int c0 = p * BM + wc * 32 + 8 * fq;
        asm volatile("" : "+v"(row0));
        const int pos0 = row0 - tbl[32 + e] * 256, cnt = tbl[e];
        const float* gp = row_gate + (size_t)e * 16384 + pos0;
        float gt[2][4];
#pragma unroll
        for (int ai = 0; ai < 2; ++ai)
#pragma unroll
            for (int m = 0; m < 4; ++m) { const int o = ai * HALF + m * 16; gt[ai][m] = (pos0 + o < cnt) ? gp[o] : 0.0f; }
        f32x4 bv[2][2];
#pragma unroll
        for (int bj = 0; bj < 2; ++bj)
#pragma unroll
            for (int n = 0; n < 2; ++n) bv[bj][n] = *(const f32x4*)(b_down + (size_t)e * 1024 + c0 + bj * HALF + 4 * n);
#pragma unroll
        for (int ai = 0; ai < 2; ++ai)
#pragma unroll
            for (int m = 0; m < 4; ++m) { const int r = row0 + ai * HALF + m * 16; const float g = gt[ai][m];
                bf16_t* rowp = YR + (size_t)r * 1024 + c0;
#pragma unroll
                for (int bj = 0; bj < 2; ++bj) { const f32x4 v0 = (acc[ai][bj][m][0] + bv[bj][0]) * g, v1 = (acc[ai][bj][m][1] + bv[bj][1]) * g;
                    u32x4 w; w.x = cvt_pk_bf16(v0[0], v0[1]); w.y = cvt_pk_bf16(v0[2], v0[3]); w.z = cvt_pk_bf16(v1[0], v1[1]); w.w = cvt_pk_bf16(v1[2], v1[3]);
                    *(u32x4*)(rowp + bj * HALF) = w; } }
    }
};
}

__device__ __forceinline__ void p0_transpose_item(const float* W, int N, bf16* WT, int Kd, size_t dst_row0, LAS float* scr, int k0, int n0, int lane) {
#pragma unroll 8
    for (int i = 0; i < 32; ++i) { const int kk = 2 * i + (lane >> 5); scr[kk * 33 + (lane & 31)] = W[(size_t)(k0 + kk) * N + n0 + (lane & 31)]; }
    LDS_WAIT(); asm volatile("" ::: "memory");
    const int c = lane & 7;
#pragma unroll
    for (int j = 0; j < 4; ++j) { const int n = (lane >> 3) + 8 * j; const LAS float* s = scr + (8 * c) * 33 + n;
        v4u o; o.x = pk2(s[0 * 33], s[1 * 33]); o.y = pk2(s[2 * 33], s[3 * 33]); o.z = pk2(s[4 * 33], s[5 * 33]); o.w = pk2(s[6 * 33], s[7 * 33]);
        *(GAS v4u*)(WT + (dst_row0 + n) * (size_t)Kd + k0 + 8 * c) = o; }
    LDS_WAIT(); asm volatile("" ::: "memory");
}
__device__ __forceinline__ void p8_transpose_item_fp8(const float* W, int N, unsigned char* WT, int Kd, size_t dst_row0, LAS float* scr, int k0, int n0, int lane) {
#pragma unroll 8
    for (int i = 0; i < 32; ++i) { const int kk = 2 * i + (lane >> 5); scr[kk * 33 + (lane & 31)] = W[(size_t)(k0 + kk) * N + n0 + (lane & 31)] * 64.0f; }
    LDS_WAIT(); asm volatile("" ::: "memory");
    const int c = lane & 7;
#pragma unroll
    for (int j = 0; j < 4; ++j) { const int n = (lane >> 3) + 8 * j; const LAS float* s = scr + (8 * c) * 33 + n;
        v2u o; o.x = pg8::pk_fp8x4(s[0 * 33], s[1 * 33], s[2 * 33], s[3 * 33]); o.y = pg8::pk_fp8x4(s[4 * 33], s[5 * 33], s[6 * 33], s[7 * 33]);
        *(GAS v2u*)(WT + (dst_row0 + n) * (size_t)Kd + k0 + 8 * c) = o; }
    LDS_WAIT(); asm volatile("" ::: "memory");
}
__device__ __forceinline__ void p0_prologue(Frame& F, const Args& args) {
    const float* c_in = IN_F(1); const int* pos = IN_I(2); const float* ada_w = IN_F(3); const float* ada_b = IN_F(4);
    for (int task = F.vcu; task < 192; task += F.G) {
        LAS float* sc = (LAS float*)F.lds;
        LAS float* red = (LAS float*)(F.lds + 16384);
        for (int i = F.tid; i < 4096; i += 512) { const float v = c_in[i]; sc[i] = v / (1.0f + expf(-v)); }
        __syncthreads();
        const int colq = F.lane & 7, kq = F.lane >> 3, col = task * 32 + colq * 4;
        float acc[4][4];
#pragma unroll
        for (int b = 0; b < 4; ++b)
#pragma unroll
            for (int j = 0; j < 4; ++j) acc[b][j] = 0.f;
#pragma unroll 8
        for (int s = 0; s < 16; ++s) { const int k = F.wave * 128 + s * 8 + kq; const f32x4 wv = *(const f32x4*)(ada_w + (size_t)k * 6144 + col);
#pragma unroll
            for (int b = 0; b < 4; ++b) { const float sv = sc[b * 1024 + k];
#pragma unroll
                for (int j = 0; j < 4; ++j) acc[b][j] += sv * wv[j]; } }
#pragma unroll
        for (int b = 0; b < 4; ++b)
#pragma unroll
            for (int j = 0; j < 4; ++j) { float v = acc[b][j]; v += __shfl_xor(v, 8); v += __shfl_xor(v, 16); v += __shfl_xor(v, 32); if (kq == 0) red[(F.wave * 4 + b) * 32 + colq * 4 + j] = v; }
        __syncthreads();
        if (F.tid < 128) { const int b = F.tid >> 5, cc = F.tid & 31; float s = ada_b[task * 32 + cc];
#pragma unroll
            for (int w = 0; w < 8; ++w) s += red[(w * 4 + b) * 32 + cc];
            WSP(float, WS_MOD)[b * 6144 + task * 32 + cc] = s; }
        VM_WAIT(); __syncthreads();
        if (F.tid == 0) { __builtin_amdgcn_fence(__ATOMIC_RELEASE, "agent"); VM_WAIT(); __hip_atomic_fetch_add((unsigned*)(F.ws + WS_CTL) + CW_MODCNT, 1u, RLX_AGENT); }
    }
    const int gt = F.vcu * 512 + F.tid, NGT = F.G * 512;
    for (int idx = gt; idx < NTOK * 16; idx += NGT) { const int m = idx >> 4, i = idx & 15;
        double freq = 1.0; for (int q = 0; q < i; ++q) freq *= 0.44036660267178046;
        const double ang = (double)pos[m] * freq; const double nr = __builtin_rint(ang * 0.15915494309189535);
        const float r = (float)__builtin_fma(-nr, 6.283185307179586, ang);
        float sn, cs; sincosf(r, &sn, &cs);
        WSP(float, WS_TRIG)[m * 32 + i] = cs; WSP(float, WS_TRIG)[m * 32 + 16 + i] = sn; }
    { const float* wr = IN_F(20); for (int idx = gt; idx < 32 * 1024; idx += NGT) { const int e = idx >> 10, k = idx & 1023; const float w = wr[k * 32 + e];
        const unsigned hi = f2bf(w); const float rem = w - __builtin_bit_cast(float, hi << 16); WSP(bf16, WS_WRH)[idx] = (bf16)hi; WSP(bf16, WS_WRL)[idx] = (bf16)f2bf(rem); } }
    LAS float* scr = (LAS float*)(F.lds + 32768 + F.wave * 8704);
    const int gw = F.vcu * NWAVES + F.wave, NGW = F.G * NWAVES;
    constexpr int I_IN = 16 * 224, I_RG = 128, I_B = 1024, I_O = 512;
    constexpr int NITEMS = I_IN + I_RG + I_B + I_O;
    for (int it = gw; it < NITEMS; it += NGW) {
        int r = it;
        if (r < I_IN) { const int kb = r / 224, nb = r % 224, n0 = nb * 32;
            if (n0 < 2048 || (n0 >= 4096 && n0 < 5120)) p0_transpose_item(IN_F(7), DIN, WSP(bf16, WS_WIN), 1024, (size_t)(n0 < 2048 ? n0 : n0 - 2048), scr, kb * 64, n0, F.lane);
            else p8_transpose_item_fp8(IN_F(7), DIN, WSP(unsigned char, WS_WIN8), 1024, (size_t)(n0 < 4096 ? n0 - 2048 : n0 - 3072), scr, kb * 64, n0, F.lane);
            continue; } r -= I_IN;
        if (r < I_RG) { const int mat = r >> 6, blk = (r >> 3) & 7, kb = (r >> 2) & 1, nb = r & 3;
            p0_transpose_item(IN_F(mat ? 12 : 10) + (size_t)blk * 16384, 128, WSP(bf16, WS_WRG) + (size_t)(mat * 8 + blk) * 16384, 128, (size_t)nb * 32, scr, kb * 64, nb * 32, F.lane); continue; } r -= I_RG;
        if (r < I_B) { const int g = r >> 9, q = r & 511, kb = q >> 5, nb = q & 31;
            p0_transpose_item(IN_F(18) + (size_t)g * 1048576, 1024, WSP(bf16, WS_WB) + (size_t)g * 1024, 2048, (size_t)nb * 32, scr, kb * 64, nb * 32, F.lane); continue; } r -= I_B;
        { const int kb = r >> 5, nb = r & 31; p0_transpose_item(IN_F(19), 1024, WSP(bf16, WS_WO), 1024, (size_t)nb * 32, scr, kb * 64, nb * 32, F.lane); }
    }
}
struct WItem { const float* src; unsigned char* dst; int N; };
__device__ __forceinline__ WItem p8_item(const Args& args, unsigned char* ws, int it) {
    WItem w;
    if (it < 32 * 1024) { const int e = it >> 10, q = it & 1023, kb = q >> 6, nb = q & 63, n0 = nb * 32;
        const int bj = n0 >> 10, p = (n0 & 1023) >> 7, oo = n0 & 127;
        w.src = IN_F(22) + (size_t)e * 2097152 + (size_t)(kb * 64) * 2048 + n0; w.N = 2048;
        w.dst = ws + WS_WUP + (size_t)e * 2097152 + (size_t)(p * 256 + bj * 128 + oo) * 1024 + kb * 64; }
    else { const int r = it - 32 * 1024, e = r >> 9, q = r & 511, kb = q >> 5, nb = q & 31;
        w.src = IN_F(24) + (size_t)e * 1048576 + (size_t)(kb * 64) * 1024 + nb * 32; w.N = 1024;
        w.dst = ws + WS_WDN + (size_t)e * 1048576 + (size_t)(nb * 32) * 1024 + kb * 64; }
    return w;
}
__device__ __forceinline__ void p8_load(const WItem& w, f32x4 (&v)[8], int lane) {
#pragma unroll
    for (int i = 0; i < 8; ++i) v[i] = __builtin_nontemporal_load((const f32x4*)(w.src + (size_t)((lane >> 3) + 8 * i) * w.N + (lane & 7) * 4));
}
__device__ __forceinline__ void p8_store(const WItem& w, const f32x4 (&v)[8], LAS float* scr, int lane) {
#pragma unroll
    for (int i = 0; i < 8; ++i) { LAS float* d = scr + ((lane >> 3) + 8 * i) * 33 + (lane & 7) * 4; d[0] = v[i].x * 64.0f; d[1] = v[i].y * 64.0f; d[2] = v[i].z * 64.0f; d[3] = v[i].w * 64.0f; }
    LDS_WAIT(); asm volatile("" ::: "memory");
    const int c = lane & 7;
#pragma unroll
    for (int j = 0; j < 4; ++j) { const int n = (lane >> 3) + 8 * j; const LAS float* s = scr + (8 * c) * 33 + n;
        v2u o; o.x = pg8::pk_fp8x4(s[0 * 33], s[1 * 33], s[2 * 33], s[3 * 33]); o.y = pg8::pk_fp8x4(s[4 * 33], s[5 * 33], s[6 * 33], s[7 * 33]);
        __builtin_nontemporal_store(o, (v2u*)(w.dst + (size_t)n * 1024 + 8 * c)); }
    LDS_WAIT(); asm volatile("" ::: "memory");
}
constexpr int P8_ITEMS = 32 * 1024 + 32 * 512, P8_CHUNK = 128, P8_NCHUNK = P8_ITEMS / P8_CHUNK;
__device__ __forceinline__ void p8_chunk(Frame& F, const Args& args, int ch) {
    LAS float* scr = (LAS float*)(F.lds + 32768 + F.wave * 8704);
    const int it0 = ch * P8_CHUNK + F.wave * 16;
    f32x4 v0[8], v1[8], v2[8], v3[8];
    p8_load(p8_item(args, F.ws, it0), v0, F.lane); p8_load(p8_item(args, F.ws, it0 + 1), v1, F.lane); p8_load(p8_item(args, F.ws, it0 + 2), v2, F.lane); p8_load(p8_item(args, F.ws, it0 + 3), v3, F.lane);
#pragma unroll 1
    for (int j = 0; j < 16; j += 4) { const bool more = j + 4 < 16;
        p8_store(p8_item(args, F.ws, it0 + j), v0, scr, F.lane); if (more) p8_load(p8_item(args, F.ws, it0 + j + 4), v0, F.lane);
        p8_store(p8_item(args, F.ws, it0 + j + 1), v1, scr, F.lane); if (more) p8_load(p8_item(args, F.ws, it0 + j + 5), v1, F.lane);
        p8_store(p8_item(args, F.ws, it0 + j + 2), v2, scr, F.lane); if (more) p8_load(p8_item(args, F.ws, it0 + j + 6), v2, F.lane);
        p8_store(p8_item(args, F.ws, it0 + j + 3), v3, scr, F.lane); if (more) p8_load(p8_item(args, F.ws, it0 + j + 7), v3, F.lane);
    }
}
__device__ __forceinline__ void p8_moe_weights(Frame& F, const Args& args) {
    for (int ch = F.vcu; ch < P8_NCHUNK; ch += F.G) p8_chunk(F, args, ch);
}

__device__ __forceinline__ void p1_hrows(Frame& F, const Args& args) {
    if (F.tid == 0) { unsigned* mc = (unsigned*)(F.ws + WS_CTL) + CW_MODCNT; unsigned sp = 0; while (__hip_atomic_load(mc, RLX_AGENT) < 192u && ++sp < (1u << 22)) __builtin_amdgcn_s_sleep(2);
        __builtin_amdgcn_fence(__ATOMIC_ACQUIRE, "agent"); VM_WAIT(); }
    __syncthreads();
    const float* x = IN_F(0); const float* g1n = IN_F(5); const float* mod = WSP(float, WS_MOD); bf16* H = WSP(bf16, WS_HB); unsigned char* H8 = WSP(unsigned char, WS_H8);
    const int gw = F.vcu * NWAVES + F.wave, NGW = F.G * NWAVES;
    for (int m0 = gw; m0 < NTOK; m0 += 2 * NGW) {
        const int m1 = m0 + NGW;
        const bool has1 = m1 < NTOK;
        f32x4 v0[4], v1[4]; float s0 = 0.f, s1 = 0.f;
        const f32x4* x0 = (const f32x4*)(x + (size_t)m0 * DM) + F.lane; const f32x4* x1 = (const f32x4*)(x + (size_t)(has1 ? m1 : m0) * DM) + F.lane;
#pragma unroll
        for (int j = 0; j < 4; ++j) { v0[j] = x0[64 * j]; v1[j] = x1[64 * j]; }
#pragma unroll
        for (int j = 0; j < 4; ++j) { s0 += (v0[j].x * v0[j].x + v0[j].y * v0[j].y) + (v0[j].z * v0[j].z + v0[j].w * v0[j].w); s1 += (v1[j].x * v1[j].x + v1[j].y * v1[j].y) + (v1[j].z * v1[j].z + v1[j].w * v1[j].w); }
#pragma unroll
        for (int o = 1; o < 64; o <<= 1) { s0 += __shfl_xor(s0, o); s1 += __shfl_xor(s1, o); }
        const float r0 = 1.0f / sqrtf(s0 * (1.f / DM) + EPS), r1 = 1.0f / sqrtf(s1 * (1.f / DM) + EPS);
        const int b0 = m0 >> 12, b1 = (has1 ? m1 : m0) >> 12;
        unsigned long long* o0 = (unsigned long long*)(H + (size_t)m0 * DM) + F.lane; unsigned long long* o1 = (unsigned long long*)(H + (size_t)(has1 ? m1 : m0) * DM) + F.lane;
#pragma unroll
        for (int j = 0; j < 4; ++j) { const int col = 4 * F.lane + 256 * j;
            const f32x4 g = *(const f32x4*)(g1n + col);
            const f32x4 sh0 = *(const f32x4*)(mod + b0 * 6144 + col), sc0 = *(const f32x4*)(mod + b0 * 6144 + 1024 + col);
            const f32x4 sh1 = *(const f32x4*)(mod + b1 * 6144 + col), sc1 = *(const f32x4*)(mod + b1 * 6144 + 1024 + col);
            const f32x4 h0 = v0[j] * r0 * g * (sc0 + 1.0f) + sh0, h1 = v1[j] * r1 * g * (sc1 + 1.0f) + sh1;
            o0[64 * j] = (unsigned long long)cvtpk(h0.x, h0.y) | ((unsigned long long)cvtpk(h0.z, h0.w) << 32);
            ((unsigned*)(H8 + (size_t)m0 * DM))[F.lane + 64 * j] = pg8::pk_fp8x4(h0.x, h0.y, h0.z, h0.w);
            if (has1) { o1[64 * j] = (unsigned long long)cvtpk(h1.x, h1.y) | ((unsigned long long)cvtpk(h1.z, h1.w) << 32);
                ((unsigned*)(H8 + (size_t)m1 * DM))[F.lane + 64 * j] = pg8::pk_fp8x4(h1.x, h1.y, h1.z, h1.w); } }
    }
}

__device__ __forceinline__ void p3_knorm_unit(Frame& F, const Args& args, int unit) {
    const int h = unit & 7, j = (unit >> 3) & 15, b = unit >> 7;
    bf16* KR = WSP(bf16, WS_E) + 3 * E_STRIDE; const float* trig = WSP(float, WS_TRIG); const float* kg = IN_F(16);
    const int rsub = F.lane >> 4, c16 = F.lane & 15;
    float gk[8];
#pragma unroll
    for (int i = 0; i < 8; ++i) gk[i] = kg[c16 * 8 + i];
    float km[8];
#pragma unroll
    for (int i = 0; i < 8; ++i) km[i] = 0.f;
    const int fi = (c16 & 1) * 8;
#pragma unroll 1
    for (int bt = 0; bt < 2; ++bt) {
        v4u raw[4]; f32x4 tcs[4][4];
#pragma unroll
        for (int i4 = 0; i4 < 4; ++i4) { const int m = b * SEQ + j * 256 + F.wave * 32 + (bt * 4 + i4) * 4 + rsub;
            raw[i4] = *(const v4u*)(KR + (size_t)m * DM + h * HD + c16 * 8);
            const float* tp = trig + (size_t)m * 32 + fi;
            tcs[i4][0] = *(const f32x4*)tp; tcs[i4][1] = *(const f32x4*)(tp + 4); tcs[i4][2] = *(const f32x4*)(tp + 16); tcs[i4][3] = *(const f32x4*)(tp + 20); }
#pragma unroll
        for (int i4 = 0; i4 < 4; ++i4) { const int m = b * SEQ + j * 256 + F.wave * 32 + (bt * 4 + i4) * 4 + rsub;
            float v[8] = {bflo(raw[i4].x), bfhi(raw[i4].x), bflo(raw[i4].y), bfhi(raw[i4].y), bflo(raw[i4].z), bfhi(raw[i4].z), bflo(raw[i4].w), bfhi(raw[i4].w)};
            float ss = 0.f;
#pragma unroll
            for (int i = 0; i < 8; ++i) ss += v[i] * v[i];
            ss += __shfl_xor(ss, 1); ss += __shfl_xor(ss, 2); ss += __shfl_xor(ss, 4); ss += __shfl_xor(ss, 8);
            const float rstd = 1.0f / sqrtf(ss * (1.f / HD) + EPS);
#pragma unroll
            for (int i = 0; i < 8; ++i) v[i] = v[i] * rstd * gk[i];
#pragma unroll
            for (int i = 0; i < 8; ++i) { const float other = __shfl_xor(v[i], 2); const float cs = tcs[i4][i >> 2][i & 3], sn = tcs[i4][2 + (i >> 2)][i & 3];
                if (c16 < 4) v[i] = (c16 < 2) ? (v[i] * cs - other * sn) : (v[i] * cs + other * sn); }
#pragma unroll
            for (int i = 0; i < 8; ++i) km[i] += v[i];
            v4u o; o.x = cvtpk(v[0], v[1]); o.y = cvtpk(v[2], v[3]); o.z = cvtpk(v[4], v[5]); o.w = cvtpk(v[6], v[7]);
            *(v4u*)(KR + (size_t)m * DM + h * HD + c16 * 8) = o; }
    }
    LAS float* red = (LAS float*)(F.lds + XTRA_OFF);
#pragma unroll
    for (int i = 0; i < 8; ++i) { float v = km[i]; v += __shfl_xor(v, 16); v += __shfl_xor(v, 32); if (rsub == 0) red[F.wave * 128 + c16 * 8 + i] = v; }
    __syncthreads();
    if (F.tid < 128) { float s = 0.f;
#pragma unroll
        for (int w = 0; w < 8; ++w) s += red[w * 128 + F.tid];
        WSP(float, WS_KMEAN)[((size_t)(b * NH + h) * 16 + j) * HD + F.tid] = s * (1.f / 256.f); }
    __syncthreads();
}

__device__ __forceinline__ void p3_rnn_local_unit(Frame& F, const Args& args, int unit) {
    const int n = unit & 7, c = (unit >> 3) & 15, b = unit >> 7;
    const int t0 = c * 256, m0 = b * SEQ + t0, ch0 = n * 128;
    const bf16* XR = WSP(bf16, WS_E);
    LAS unsigned char* At = F.lds;
    {
        const int cg = F.tid & 15, rs = F.tid >> 4; const int chb = ch0 + cg * 8;
        const float* cw = IN_F(8); const float* cb = IN_F(9);
        float w0[8], w1[8], w2[8], w3[8], bb[8];
#pragma unroll
        for (int i = 0; i < 8; ++i) { w0[i] = cw[chb + i]; w1[i] = cw[1024 + chb + i]; w2[i] = cw[2048 + chb + i]; w3[i] = cw[3072 + chb + i]; bb[i] = cb[chb + i]; }
        const int tr0 = t0 + rs * 8;
        v4u rw[11];
#pragma unroll
        for (int r = 0; r < 11; ++r) { const int tt = tr0 - 3 + r; rw[r] = *(const v4u*)(XR + (size_t)(b * SEQ + (tt < 0 ? 0 : tt)) * DM + chb); if (tt < 0) rw[r] = (v4u){0u, 0u, 0u, 0u}; }
#define UNP(dst, w_) do { dst[0] = bflo(w_.x); dst[1] = bfhi(w_.x); dst[2] = bflo(w_.y); dst[3] = bfhi(w_.y); dst[4] = bflo(w_.z); dst[5] = bfhi(w_.z); dst[6] = bflo(w_.w); dst[7] = bfhi(w_.w); } while (0)
        float p1[8], p2[8], p3[8];
        UNP(p3, rw[0]); UNP(p2, rw[1]); UNP(p1, rw[2]);
#pragma unroll
        for (int r = 0; r < 8; ++r) { float cur[8]; UNP(cur, rw[3 + r]);
            float xc[8];
#pragma unroll
            for (int i = 0; i < 8; ++i) xc[i] = bb[i] + w0[i] * cur[i] + w1[i] * p1[i] + w2[i] * p2[i] + w3[i] * p3[i];
            const int row = rs * 8 + r;
            v4u o; o.x = cvtpk(xc[0], xc[1]); o.y = cvtpk(xc[2], xc[3]); o.z = cvtpk(xc[4], xc[5]); o.w = cvtpk(xc[6], xc[7]);
            *(LAS v4u*)(At + row * 256 + ((cg ^ (row & 15)) << 4)) = o;
#pragma unroll
            for (int i = 0; i < 8; ++i) { p3[i] = p2[i]; p2[i] = p1[i]; p1[i] = cur[i]; } }
#undef UNP
    }
    __syncthreads();
    const int fr = F.lane & 15, fq = F.lane >> 4;
    const int vloc = F.wave * 16 + fr, ch = ch0 + vloc;
    const bf16* WA = WSP(bf16, WS_WRG) + (size_t)n * 16384 + (size_t)vloc * 128 + fq * 8;
    const bf16* WX = WA + 8 * 16384;
    bf16x8 Ba[4], Bx[4];
#pragma unroll
    for (int s = 0; s < 4; ++s) { Ba[s] = *(const bf16x8*)(WA + 32 * s); Bx[s] = *(const bf16x8*)(WX + 32 * s); }
    const float ba = IN_F(11)[ch], bx = IN_F(13)[ch];
    const float sp8 = 8.0f * log1pf(expf(-IN_F(14)[ch]));
    float cP = 1.f, cH = 0.f;
    bf16* HL = WSP(bf16, WS_HL); bf16* PP = WSP(bf16, WS_PP);
    LAS unsigned short* stg = (LAS unsigned short*)(F.lds + 65536);
    for (int rq = 0; rq < 4; ++rq) {
        LAS unsigned short* sb = stg + (rq & 1) * 16384;
#pragma unroll
        for (int ri = 0; ri < 4; ++ri) { const int rt = rq * 4 + ri;
            f32x4 accr = {0.f, 0.f, 0.f, 0.f}, accx = {0.f, 0.f, 0.f, 0.f};
            const int arow = rt * 16 + fr;
#pragma unroll
            for (int s = 0; s < 4; ++s) { const bf16x8 a = *(const LAS bf16x8*)(At + arow * 256 + (((fq + 4 * s) ^ (arow & 15)) << 4));
                accr = __builtin_amdgcn_mfma_f32_16x16x32_bf16(a, Ba[s], accr, 0, 0, 0);
                accx = __builtin_amdgcn_mfma_f32_16x16x32_bf16(a, Bx[s], accx, 0, 0, 0); }
            float pj[4], hj[4];
#pragma unroll
            for (int j = 0; j < 4; ++j) { const int row = rt * 16 + 4 * fq + j;
                const float xcv = bf2f(*(const LAS unsigned short*)(At + row * 256 + ((((vloc >> 3)) ^ (row & 15)) << 4) + (vloc & 7) * 2));
                const float r = fast_sigmoid(accr[j] + ba), ig = fast_sigmoid(accx[j] + bx);
                const float a = __builtin_amdgcn_exp2f(-sp8 * r * 1.4426950408889634f);
                float mult = __builtin_amdgcn_sqrtf(fmaxf(fmaf(-a, a, 1.0f), 0.0f)); if (t0 + row == 0) mult = 1.0f;
                const float u = mult * ig * xcv;
                pj[j] = (j ? pj[j - 1] : 1.0f) * a; hj[j] = (j ? hj[j - 1] * a : 0.0f) + u; }
            const float tp = pj[3], th = hj[3];
            const float pa = __shfl(tp, F.lane - 16), ha = __shfl(th, F.lane - 16);
            const float pb = __shfl(tp, F.lane - 32), hb = __shfl(th, F.lane - 32);
            const float pc = __shfl(tp, F.lane - 48), hc = __shfl(th, F.lane - 48);
            float Pq, Hq;
            if (fq == 0) { Pq = 1.f; Hq = 0.f; } else if (fq == 1) { Pq = pa; Hq = ha; } else if (fq == 2) { Pq = pb * pa; Hq = pa * hb + ha; } else { Pq = pc * pb * pa; Hq = pa * (pb * hc + hb) + ha; }
            const float hstart = Hq + Pq * cH, pstart = Pq * cP;
            float hl3 = 0.f, pp3 = 0.f;
#pragma unroll
            for (int j = 0; j < 4; ++j) { const float hv = hj[j] + pj[j] * hstart, pv = pj[j] * pstart; const int rl = ri * 16 + 4 * fq + j;
                const unsigned pk = cvtpk(hv, pv); sb[rl * 128 + vloc] = (unsigned short)pk; sb[8192 + rl * 128 + vloc] = (unsigned short)(pk >> 16); if (j == 3) { hl3 = hv; pp3 = pv; } }
            cH = __shfl(hl3, fr + 48); cP = __shfl(pp3, fr + 48);
        }
        __syncthreads();
#pragma unroll
        for (int q4 = 0; q4 < 4; ++q4) { const int idx = q4 * 512 + F.tid, arr = idx >> 10, rr = (idx >> 4) & 63, c16 = idx & 15;
            const v4u val = *(const LAS v4u*)(sb + arr * 8192 + rr * 128 + c16 * 8);
            bf16* dst = (arr ? PP : HL) + (size_t)(m0 + rq * 64 + rr) * DM + ch0 + c16 * 8;
            *(v4u*)dst = val; }
    }
    if (fq == 0) { WSP(float, WS_AGGP)[(size_t)(b * 16 + c) * 1024 + ch] = cP; WSP(float, WS_AGGH)[(size_t)(b * 16 + c) * 1024 + ch] = cH; }
    __syncthreads();
}

__device__ __forceinline__ void p4_rnn_final_unit(Frame& F, const Args& args, int unit) {
    const int n = unit & 7, c = (unit >> 3) & 15, b = unit >> 7;
    const int m0 = b * SEQ + c * 256, ch0 = n * 128;
    LAS float* car = (LAS float*)(F.lds + XTRA_OFF);
    if (F.tid < 128) { const int ch = ch0 + F.tid; float h = 0.f;
        for (int cc = 0; cc < c; ++cc) { const float p = WSP(float, WS_AGGP)[(size_t)(b * 16 + cc) * 1024 + ch], hh = WSP(float, WS_AGGH)[(size_t)(b * 16 + cc) * 1024 + ch]; h = p * h + hh; }
        car[F.tid] = h; }
    __syncthreads();
    const bf16* HL = WSP(bf16, WS_HL); const bf16* PP = WSP(bf16, WS_PP); const bf16* GG = WSP(bf16, WS_E) + E_STRIDE; bf16* Y = WSP(bf16, WS_YCAT);
    const int c16 = F.tid & 15, r0 = F.tid >> 4;
    float cv[8];
#pragma unroll
    for (int i = 0; i < 8; ++i) cv[i] = car[c16 * 8 + i];
#pragma unroll 2
    for (int it = 0; it < 8; ++it) { const size_t o = (size_t)(m0 + it * 32 + r0) * DM + ch0 + c16 * 8, oy = (size_t)(m0 + it * 32 + r0) * 2048 + ch0 + c16 * 8;
        const v4u hl = *(const v4u*)(HL + o), pp = *(const v4u*)(PP + o), gg = *(const v4u*)(GG + o);
        v4u y;
        y.x = pk2((bflo(hl.x) + bflo(pp.x) * cv[0]) * bflo(gg.x), (bfhi(hl.x) + bfhi(pp.x) * cv[1]) * bfhi(gg.x));
        y.y = pk2((bflo(hl.y) + bflo(pp.y) * cv[2]) * bflo(gg.y), (bfhi(hl.y) + bfhi(pp.y) * cv[3]) * bfhi(gg.y));
        y.z = pk2((bflo(hl.z) + bflo(pp.z) * cv[4]) * bflo(gg.z), (bfhi(hl.z) + bfhi(pp.z) * cv[5]) * bfhi(gg.z));
        y.w = pk2((bflo(hl.w) + bflo(pp.w) * cv[6]) * bflo(gg.w), (bfhi(hl.w) + bfhi(pp.w) * cv[7]) * bfhi(gg.w));
        *(v4u*)(Y + oy) = y; }
    __syncthreads();
}

namespace att {
constexpr int KVBLK = 64, SHM_K = KVBLK * HD * 2, SHM_V = SHM_K;
constexpr float C2 = 0.08838834764831845f * 1.4426950408889634f;
#define KSWZ(row, colB) ((row) * 256 + ((colB) ^ (((row) & 7) << 4)))
__device__ __forceinline__ int v_st(int k, int c) { const int kk = (k & ~0xC) | ((k & 4) << 1) | ((k & 8) >> 1); return ((kk >> 3) * 4 + (c >> 5)) * 512 + ((kk & 7) * 32 + (c & 31)) * 2; }
__device__ __forceinline__ int v_rd_base(int lane) { return ((lane & 3) << 3) | (((lane >> 2) & 3) << 6) | (((lane >> 4) & 1) << 5) | (((lane >> 5) & 1) << 8); }
constexpr int v_rd_off(int d0, int ks, int half) { return d0 * 512 + ks * 4096 + half * 2048; }
__device__ __forceinline__ int crow(int r, int hi) { return (r & 3) + 8 * (r >> 2) + 4 * hi; }

template <int KB>
__device__ __forceinline__ void qkt(f32x16& p0, f32x16& p1, const char* K_lds, int r32, int hi, const char* qfrag, bool act) {
    if (!act) { const float NEG = -__builtin_inff();
#pragma unroll
        for (int r = 0; r < 16; ++r) { p0[r] = NEG; p1[r] = NEG; } return; }
    p0 = f32x16{}; p1 = f32x16{};
    const char* kb[4];
#pragma unroll
    for (int dd = 0; dd < 4; ++dd) kb[dd] = K_lds + KB * SHM_K + KSWZ(r32, (dd * 16 + hi * 8) * 2);
#pragma unroll
    for (int d0 = 0; d0 < 8; ++d0) { const char* a = kb[d0 & 3] + (d0 >> 2) * 128;
        bf16x8 b0 = *reinterpret_cast<const bf16x8*>(a);
        bf16x8 b1 = *reinterpret_cast<const bf16x8*>(a + 32 * 256);
        const bf16x8 q = *reinterpret_cast<const bf16x8*>(qfrag + d0 * 1024);
        p0 = __builtin_amdgcn_mfma_f32_32x32x16_bf16(b0, q, p0, 0, 0, 0);
        p1 = __builtin_amdgcn_mfma_f32_32x32x16_bf16(b1, q, p1, 0, 0, 0); }
}
template <int VB>
__device__ __forceinline__ void pv_tile(f32x16* o, int vb0, bf16x8 pa0, bf16x8 pa1, bf16x8 pa2, bf16x8 pa3, bool act) {
    if (!act) return;
#define TRRD(dst, off) asm volatile("ds_read_b64_tr_b16 %0, %1 offset:%2" : "=&v"(dst) : "v"(vb0), "i"(off) : "memory")
#define PV_D0(d0) do { s16x4 l0, l1, l2, l3, h0, h1, h2, h3; constexpr int b_ = VB * SHM_V + v_rd_off(d0, 0, 0); \
        TRRD(l0, b_); TRRD(h0, b_ + 2048); TRRD(l1, b_ + 4096); TRRD(h1, b_ + 6144); TRRD(l2, b_ + 8192); TRRD(h2, b_ + 10240); TRRD(l3, b_ + 12288); TRRD(h3, b_ + 14336); \
        asm volatile("s_waitcnt lgkmcnt(0)" ::: "memory"); SBAR(); \
        o[d0] = __builtin_amdgcn_mfma_f32_32x32x16_bf16(pa0, (bf16x8){l0[0], l0[1], l0[2], l0[3], h0[0], h0[1], h0[2], h0[3]}, o[d0], 0, 0, 0);   \
        o[d0] = __builtin_amdgcn_mfma_f32_32x32x16_bf16(pa1, (bf16x8){l1[0], l1[1], l1[2], l1[3], h1[0], h1[1], h1[2], h1[3]}, o[d0], 0, 0, 0);   \
        o[d0] = __builtin_amdgcn_mfma_f32_32x32x16_bf16(pa2, (bf16x8){l2[0], l2[1], l2[2], l2[3], h2[0], h2[1], h2[2], h2[3]}, o[d0], 0, 0, 0);   \
        o[d0] = __builtin_amdgcn_mfma_f32_32x32x16_bf16(pa3, (bf16x8){l3[0], l3[1], l3[2], l3[3], h3[0], h3[1], h3[2], h3[3]}, o[d0], 0, 0, 0); } while (0)
    PV_D0(0); PV_D0(1); PV_D0(2); PV_D0(3);
#undef PV_D0
#undef TRRD
}
__device__ __forceinline__ void sm_a(f32x16& p0) {
#pragma unroll
    for (int r = 0; r < 16; ++r) p0[r] = __builtin_amdgcn_exp2f(p0[r]);
}
__device__ __forceinline__ void sm_b(f32x16& p0, f32x16& p1, float& l_reg, bf16x8& pa0, bf16x8& pa1, bf16x8& pa2, bf16x8& pa3) {
#pragma unroll
    for (int r = 0; r < 16; ++r) p1[r] = __builtin_amdgcn_exp2f(p1[r]);
    float ps = 0;
#pragma unroll
    for (int r = 0; r < 16; ++r) ps += p0[r];
#pragma unroll
    for (int r = 0; r < 16; ++r) ps += p1[r];
    l_reg += ps;
#define PK4(P, B_, OUT) do { unsigned a0 = cvtpk(P[B_+0], P[B_+1]), a1 = cvtpk(P[B_+2], P[B_+3]); \
        unsigned b0 = cvtpk(P[B_+4], P[B_+5]), b1 = cvtpk(P[B_+6], P[B_+7]); \
        auto r0 = __builtin_amdgcn_permlane32_swap(a0, b0, false, false); auto r1 = __builtin_amdgcn_permlane32_swap(a1, b1, false, false); \
        v4u w = {r0[0], r1[0], r0[1], r1[1]}; OUT = *reinterpret_cast<bf16x8*>(&w); } while (0)
    PK4(p0, 0, pa0); PK4(p0, 8, pa1); PK4(p1, 0, pa2); PK4(p1, 8, pa3);
#undef PK4
}

__device__ __forceinline__ void attn_unit(Frame& F, const Args& args, int b, int h, int iq) {
    int tid = F.tid; asm volatile("" : "+v"(tid));
    const int wid = F.wave, lane = tid & 63, r32 = lane & 31, hi = lane >> 5;
    char* lds = F.ldsg;
    char* V_lds = lds; char* K_lds = lds + 2 * SHM_V;
    float* kml = (float*)(lds + XTRA_OFF);
    char* qfrag = lds + 65536 + wid * 8192 + lane * 16;
    const bf16* QR = WSP(bf16, WS_E) + 2 * E_STRIDE; const bf16* KN = WSP(bf16, WS_E) + 3 * E_STRIDE; const bf16* VV = WSP(bf16, WS_E) + 4 * E_STRIDE;
    bf16* YA = WSP(bf16, WS_YCAT) + 1024;
    const size_t mb = (size_t)b * SEQ;
    const int q0 = iq * 256, NT = 4 * (iq + 1);
    const bf16* Kh = KN + mb * DM + h * HD; const bf16* Vh = VV + mb * DM + h * HD;
    { const float* kmg = WSP(float, WS_KMEAN) + (size_t)(b * NH + h) * 16 * HD; for (int idx = tid; idx < iq * HD; idx += 512) kml[idx] = kmg[idx]; }
    const int sr = tid >> 4, sc = (tid & 15) * 8, vst0 = v_st(sr, sc), vst1 = v_st(32 + sr, sc), kws = KSWZ(sr, sc * 2);
    const int vb0 = (int)(uintptr_t)V_lds + v_rd_base(lane);
    bf16x8 st_v0, st_v1, st_k0, st_k1;
    const unsigned goff = (unsigned)(sr * DM + sc) * 2u;
#define ROWP(p, k0, rr) ((const char*)((p) + (size_t)((k0) + (rr)) * DM) + goff)
#define SLOAD(k0) do { st_v0 = *(const bf16x8*)ROWP(Vh, k0, 0); st_v1 = *(const bf16x8*)ROWP(Vh, k0, 32); st_k0 = *(const bf16x8*)ROWP(Kh, k0, 0); st_k1 = *(const bf16x8*)ROWP(Kh, k0, 32); } while (0)
#define SWRITE(bf) do { *(bf16x8*)(V_lds + (bf) * SHM_V + vst0) = st_v0; *(bf16x8*)(V_lds + (bf) * SHM_V + vst1) = st_v1; \
                        *(bf16x8*)(K_lds + (bf) * SHM_K + kws) = st_k0; *(bf16x8*)(K_lds + (bf) * SHM_K + kws + 32 * 256) = st_k1; } while (0)
    SLOAD(0);
    const size_t mq = mb + q0 + wid * 32 + r32;
    unsigned selmask;
    {
        bf16x8 qr[8];
        const bf16* qp = QR + mq * DM + h * HD + hi * 8;
        v4u raw[8];
#pragma unroll
        for (int d0 = 0; d0 < 8; ++d0) raw[d0] = *(const v4u*)(qp + d0 * 16);
        float ss = 0.f;
#pragma unroll
        for (int d0 = 0; d0 < 8; ++d0) { const float a0 = bflo(raw[d0].x), a1 = bfhi(raw[d0].x), a2 = bflo(raw[d0].y), a3 = bfhi(raw[d0].y), a4 = bflo(raw[d0].z), a5 = bfhi(raw[d0].z), a6 = bflo(raw[d0].w), a7 = bfhi(raw[d0].w);
            ss += (a0 * a0 + a1 * a1) + (a2 * a2 + a3 * a3) + (a4 * a4 + a5 * a5) + (a6 * a6 + a7 * a7); }
        ss += __shfl_xor(ss, 32);
        const float rs = C2 / sqrtf(ss * (1.f / HD) + EPS);
        const float* qg = IN_F(15) + hi * 8;
#define UNPK(f, W_) do { const v4u t_ = (W_); f[0] = bflo(t_.x); f[1] = bfhi(t_.x); f[2] = bflo(t_.y); f[3] = bfhi(t_.y); f[4] = bflo(t_.z); f[5] = bfhi(t_.z); f[6] = bflo(t_.w); f[7] = bfhi(t_.w); } while (0)
#define PACK(f) ({ v4u w_; w_.x = cvtpk(f[0], f[1]); w_.y = cvtpk(f[2], f[3]); w_.z = cvtpk(f[4], f[5]); w_.w = cvtpk(f[6], f[7]); *reinterpret_cast<bf16x8*>(&w_); })
        { float f0[8], f1[8]; UNPK(f0, raw[0]); UNPK(f1, raw[1]);
          const float* tg = WSP(float, WS_TRIG) + mq * 32 + hi * 8;
#pragma unroll
          for (int j = 0; j < 8; ++j) { const float x1 = f0[j] * rs * qg[j], x2 = f1[j] * rs * qg[16 + j], cs = tg[j], sn = tg[16 + j]; f0[j] = x1 * cs - x2 * sn; f1[j] = x2 * cs + x1 * sn; }
          qr[0] = PACK(f0); qr[1] = PACK(f1); }
#pragma unroll
        for (int d0 = 2; d0 < 8; ++d0) { float f[8]; UNPK(f, raw[d0]);
#pragma unroll
            for (int j = 0; j < 8; ++j) f[j] *= rs * qg[d0 * 16 + j];
            qr[d0] = PACK(f); }
        __syncthreads();
        float v1 = -__builtin_inff(), v2 = v1, v3 = v1; int i1 = 0, i2 = 0, i3 = 0;
#pragma unroll 1
        for (int jb = 0; jb < iq; ++jb) { const float* km = kml + jb * HD + hi * 8; float g = 0.f;
#pragma unroll
            for (int d0 = 0; d0 < 8; ++d0) { float f[8]; UNPK(f, *reinterpret_cast<const v4u*>(&qr[d0]));
                const f32x4 k0 = *(const f32x4*)(km + d0 * 16), k1 = *(const f32x4*)(km + d0 * 16 + 4);
                g += (f[0] * k0[0] + f[1] * k0[1]) + (f[2] * k0[2] + f[3] * k0[3]) + (f[4] * k1[0] + f[5] * k1[1]) + (f[6] * k1[2] + f[7] * k1[3]); }
            g += __shfl_xor(g, 32);
            if (g > v1) { v3 = v2; i3 = i2; v2 = v1; i2 = i1; v1 = g; i1 = jb; }
            else if (g > v2) { v3 = v2; i3 = i2; v2 = g; i2 = jb; }
            else if (g > v3) { v3 = g; i3 = jb; } }
#undef UNPK
#undef PACK
        selmask = 0u; if (iq >= 1) selmask |= 1u << i1; if (iq >= 2) selmask |= 1u << i2; if (iq >= 3) selmask |= 1u << i3;
#pragma unroll
        for (int d0 = 0; d0 < 8; ++d0) *reinterpret_cast<bf16x8*>(qfrag + d0 * 1024) = qr[d0];
    }
    float l_reg = 0.f; f32x16 o[4] = {};
    const int wrow0 = wid * 32;
#define ACT(t) (((t) >> 2) < iq ? (__ballot((selmask >> ((t) >> 2)) & 1u) != 0ull) : ((((t) - 4 * iq) * 64) <= wrow0 + 31))
#define MASKT(P0_, P1_, t) do { const int blk_ = (t) >> 2; const float NEG_ = -__builtin_inff(); \
        if (blk_ < iq) { if (!((selmask >> blk_) & 1u)) { _Pragma("unroll") for (int r = 0; r < 16; ++r) { P0_[r] = NEG_; P1_[r] = NEG_; } } } \
        else { const int kb_ = ((t) - 4 * iq) * 64; if (kb_ + 63 > wrow0) { int dq_ = wrow0 + r32 - kb_ - 4 * hi; asm volatile("" : "+v"(dq_)); \
            _Pragma("unroll") for (int r = 0; r < 16; ++r) { const int c_ = (r & 3) + 8 * (r >> 2); if (c_ > dq_) P0_[r] = NEG_; if (c_ + 32 > dq_) P1_[r] = NEG_; } } } } while (0)
    f32x16 pA0, pA1, pB0, pB1; bf16x8 pa0, pa1, pa2, pa3;
    VM_WAIT(); SWRITE(0); SBAR();
    SLOAD(64);
    __syncthreads();
    SBAR(); qkt<0>(pA0, pA1, K_lds, r32, hi, qfrag, ACT(0));
    MASKT(pA0, pA1, 0); sm_a(pA0);
    VM_WAIT(); SWRITE(1);
    __syncthreads();
#define HALF_STEP(PX0, PX1, PY0, PY1, t, KB, VB, SB) do { \
        SBAR(); qkt<KB>(PX0, PX1, K_lds, r32, hi, qfrag, ACT(t)); \
        sm_b(PY0, PY1, l_reg, pa0, pa1, pa2, pa3); SBAR(); \
        if ((t) + 1 < NT) { SLOAD(((t) + 1) * 64); SBAR(); } \
        pv_tile<VB>(o, vb0, pa0, pa1, pa2, pa3, ACT((t) - 1)); MASKT(PX0, PX1, (t)); sm_a(PX0); \
        __syncthreads(); \
        if ((t) + 1 < NT) { VM_WAIT(); SWRITE(SB); } \
        __syncthreads(); } while (0)
    for (int t = 1; t + 1 < NT; t += 2) {
        HALF_STEP(pB0, pB1, pA0, pA1, t, 1, 0, 0);
        HALF_STEP(pA0, pA1, pB0, pB1, t + 1, 0, 1, 1);
    }
    SBAR(); qkt<1>(pB0, pB1, K_lds, r32, hi, qfrag, ACT(NT - 1)); SBAR();
    sm_b(pA0, pA1, l_reg, pa0, pa1, pa2, pa3); SBAR();
    pv_tile<0>(o, vb0, pa0, pa1, pa2, pa3, ACT(NT - 2));
    MASKT(pB0, pB1, NT - 1); sm_a(pB0);
    sm_b(pB0, pB1, l_reg, pa0, pa1, pa2, pa3); SBAR();
    pv_tile<1>(o, vb0, pa0, pa1, pa2, pa3, ACT(NT - 1));
    l_reg += __shfl_xor(l_reg, 32);
    float* li_l = (float*)(lds + XTRA_OFF + 8192) + wid * 32;
    if (hi == 0) li_l[r32] = l_reg;
    asm volatile("s_waitcnt lgkmcnt(0)" ::: "memory");
    float rli[16];
#pragma unroll
    for (int r = 0; r < 16; ++r) rli[r] = __builtin_amdgcn_rcpf(li_l[crow(r, hi)]);
    bf16* Ow = YA + (mb + q0 + wid * 32) * 2048 + h * HD;
#pragma unroll
    for (int r = 0; r < 16; ++r) { const int orow = crow(r, hi);
#pragma unroll
        for (int d0 = 0; d0 < 4; ++d0) { const float v = o[d0][r] * rli[r]; const float vn = __shfl_xor(v, 1);
            if ((r32 & 1) == 0) *(unsigned*)(Ow + (size_t)orow * 2048 + d0 * 32 + r32) = cvtpk(v, vn); } }
    __syncthreads();
#undef ROWP
#undef SLOAD
#undef SWRITE
#undef ACT
#undef MASKT
#undef HALF_STEP
}
#undef KSWZ
}

__device__ __forceinline__ void p7_router(Frame& F, const Args& args) {
    LAS float* ssq = (LAS float*)F.lds;
    LAS float* par = (LAS float*)(F.lds + 2048);
    LAS float* lg = (LAS float*)(F.lds + 10240);
    LAS int* hist = (LAS int*)(F.lds + 77824 + 2048);
    LAS int* sel = (LAS int*)(F.lds + 77824 + 4096);
    const float* g2n = IN_F(6); const float* mod = WSP(float, WS_MOD); const float* brt = IN_F(21);
    unsigned char* H2 = WSP(unsigned char, WS_HB);
    unsigned* CNT = (unsigned*)(F.ws + WS_CTL) + CW_CNT;
    const int row = F.lane & 15, q = F.lane >> 4, kw = F.wave * 128;
    bf16x8 Bh[4][2], Bl[4][2];
    { const bf16* wh = WSP(bf16, WS_WRH) + (size_t)row * 1024 + kw + 8 * q; const bf16* wl = WSP(bf16, WS_WRL) + (size_t)row * 1024 + kw + 8 * q;
#pragma unroll
      for (int s = 0; s < 4; ++s) { Bh[s][0] = *(const bf16x8*)(wh + 32 * s); Bh[s][1] = *(const bf16x8*)(wh + 16384 + 32 * s); Bl[s][0] = *(const bf16x8*)(wl + 32 * s); Bl[s][1] = *(const bf16x8*)(wl + 16384 + 32 * s); } }
    for (int vw = F.vcu; vw < 256; vw += F.G) {
        const int m0 = vw * 64, b = m0 >> 12;
        for (int i = F.tid; i < 1024; i += 512) { par[i] = g2n[i] * (1.0f + mod[b * 6144 + 4096 + i]); par[1024 + i] = mod[b * 6144 + 3072 + i]; }
        if (F.tid < 32) hist[F.tid] = 0;
#pragma unroll
        for (int rt = 0; rt < 4; ++rt) { const float* xp = F.out + (size_t)(m0 + rt * 16 + row) * DM + kw + 8 * q; float ss = 0.f;
#pragma unroll
            for (int s = 0; s < 4; ++s) { const f32x4 x0 = *(const f32x4*)(xp + 32 * s), x1 = *(const f32x4*)(xp + 32 * s + 4); const f32x4 a = x0 * x0 + x1 * x1; ss += (a.x + a.y) + (a.z + a.w); }
            ss += __shfl_xor(ss, 16); ss += __shfl_xor(ss, 32);
            if (q == 0) ssq[F.wave * 64 + rt * 16 + row] = ss; }
        __syncthreads();
#pragma unroll
        for (int rt = 0; rt < 4; ++rt) { const int rl = rt * 16 + row; float tot = 0.f;
#pragma unroll
            for (int w = 0; w < 8; ++w) tot += ssq[w * 64 + rl];
            const float rstd = 1.0f / sqrtf(tot * (1.f / DM) + EPS);
            f32x4 acc0 = {0.f, 0.f, 0.f, 0.f}, acc1 = {0.f, 0.f, 0.f, 0.f};
            unsigned char* hp = H2 + (size_t)(m0 + rl) * DM + kw + 8 * q; const float* xp = F.out + (size_t)(m0 + rl) * DM + kw + 8 * q;
            f32x4 xq[4][2];
#pragma unroll
            for (int s = 0; s < 4; ++s) { xq[s][0] = *(const f32x4*)(xp + 32 * s); xq[s][1] = *(const f32x4*)(xp + 32 * s + 4); }
#pragma unroll
            for (int s = 0; s < 4; ++s) { const int col = kw + 32 * s + 8 * q; float h[8];
#pragma unroll
                for (int hf = 0; hf < 2; ++hf) { const f32x4 sc = *(const LAS f32x4*)(par + col + 4 * hf), sh = *(const LAS f32x4*)(par + 1024 + col + 4 * hf);
                    const f32x4 t = xq[s][hf] * rstd * sc + sh; h[4 * hf] = t.x; h[4 * hf + 1] = t.y; h[4 * hf + 2] = t.z; h[4 * hf + 3] = t.w; }
                v4u hi; hi.x = cvtpk(h[0], h[1]); hi.y = cvtpk(h[2], h[3]); hi.z = cvtpk(h[4], h[5]); hi.w = cvtpk(h[6], h[7]);
                { v2u h8; h8.x = pg8::pk_fp8x4(h[0], h[1], h[2], h[3]); h8.y = pg8::pk_fp8x4(h[4], h[5], h[6], h[7]); *(v2u*)(hp + 32 * s) = h8; }
                v4u lo; lo.x = cvtpk(h[0] - bflo(hi.x), h[1] - bfhi(hi.x)); lo.y = cvtpk(h[2] - bflo(hi.y), h[3] - bfhi(hi.y)); lo.z = cvtpk(h[4] - bflo(hi.z), h[5] - bfhi(hi.z)); lo.w = cvtpk(h[6] - bflo(hi.w), h[7] - bfhi(hi.w));
                const bf16x8 ah = *reinterpret_cast<bf16x8*>(&hi), al = *reinterpret_cast<bf16x8*>(&lo);
                acc0 = __builtin_amdgcn_mfma_f32_16x16x32_bf16(ah, Bh[s][0], acc0, 0, 0, 0); acc0 = __builtin_amdgcn_mfma_f32_16x16x32_bf16(ah, Bl[s][0], acc0, 0, 0, 0); acc0 = __builtin_amdgcn_mfma_f32_16x16x32_bf16(al, Bh[s][0], acc0, 0, 0, 0);
                acc1 = __builtin_amdgcn_mfma_f32_16x16x32_bf16(ah, Bh[s][1], acc1, 0, 0, 0); acc1 = __builtin_amdgcn_mfma_f32_16x16x32_bf16(ah, Bl[s][1], acc1, 0, 0, 0); acc1 = __builtin_amdgcn_mfma_f32_16x16x32_bf16(al, Bh[s][1], acc1, 0, 0, 0); }
#pragma unroll
            for (int r = 0; r < 4; ++r) { lg[(F.wave * 64 + rt * 16 + 4 * q + r) * 33 + row] = acc0[r]; lg[(F.wave * 64 + rt * 16 + 4 * q + r) * 33 + 16 + row] = acc1[r]; } }
        __syncthreads();
        { const int rowl = F.tid >> 3, eq = F.tid & 7; float v[4];
#pragma unroll
          for (int j = 0; j < 4; ++j) { float a = brt[4 * eq + j];
#pragma unroll
              for (int w = 0; w < 8; ++w) a += lg[(w * 64 + rowl) * 33 + 4 * eq + j];
              v[j] = a; }
          float tv[4]; int te[4];
#pragma unroll
          for (int k = 0; k < 4; ++k) { float gm = fmaxf(fmaxf(v[0], v[1]), fmaxf(v[2], v[3]));
              gm = fmaxf(gm, __shfl_xor(gm, 1)); gm = fmaxf(gm, __shfl_xor(gm, 2)); gm = fmaxf(gm, __shfl_xor(gm, 4));
              int ci = v[0] == gm ? 4 * eq : v[1] == gm ? 4 * eq + 1 : v[2] == gm ? 4 * eq + 2 : v[3] == gm ? 4 * eq + 3 : 99;
              ci = min(ci, __shfl_xor(ci, 1)); ci = min(ci, __shfl_xor(ci, 2)); ci = min(ci, __shfl_xor(ci, 4));
              te[k] = ci; tv[k] = gm;
#pragma unroll
              for (int j = 0; j < 4; ++j) if (ci == 4 * eq + j) v[j] = -__builtin_inff(); }
          if (eq == 0) { const float w1 = __expf(tv[1] - tv[0]), w2 = __expf(tv[2] - tv[0]), w3 = __expf(tv[3] - tv[0]); const float inv = 1.0f / (1.0f + w1 + w2 + w3);
              const float gk[4] = {inv, w1 * inv, w2 * inv, w3 * inv};
#pragma unroll
              for (int k = 0; k < 4; ++k) { const int lr = atomicAdd((int*)&hist[te[k]], 1); sel[rowl * 4 + k] = te[k]; sel[256 + rowl * 4 + k] = lr; sel[512 + rowl * 4 + k] = __float_as_int(gk[k]); } } }
        __syncthreads();
        if (F.tid < 32) { const int hc = hist[F.tid]; hist[32 + F.tid] = hc ? (int)__hip_atomic_fetch_add(CNT + F.tid, (unsigned)hc, RLX_AGENT) : 0; }
        __syncthreads();
        if (F.tid < 256) { const int e = sel[F.tid], pos = hist[32 + e] + sel[256 + F.tid], mm = m0 + (F.tid >> 2);
            WSP(int, WS_ROWTOK)[(size_t)e * ECAP + pos] = mm; WSP(int, WS_ROWGATE)[(size_t)e * ECAP + pos] = sel[512 + F.tid];
            WSP(int, WS_TOKE)[mm * 4 + (F.tid & 3)] = e; WSP(int, WS_TOKPOS)[mm * 4 + (F.tid & 3)] = pos; }
        __syncthreads();
    }
}

constexpr int MOE_TBL_OFF = XTRA_OFF, MOE_LIST_OFF = XTRA_OFF + 2048;
__device__ __forceinline__ int moe_tables(Frame& F) {
    LAS int* tbl = (LAS int*)(F.lds + MOE_TBL_OFF);
    const unsigned* CNT = (const unsigned*)(F.ws + WS_CTL) + CW_CNT;
    if (F.tid < 32) tbl[F.tid] = (int)__hip_atomic_load(CNT + F.tid, RLX_AGENT);
    __syncthreads();
    if (F.tid == 0) { int run = 0;
#pragma unroll 1
        for (int e = 0; e < 32; ++e) { tbl[32 + e] = run; const int nb = (tbl[e] + 255) >> 8;
#pragma unroll 1
            for (int bb = 0; bb < nb; ++bb) tbl[80 + run + bb] = e;
            run += nb; }
        tbl[64] = run; }
    __syncthreads();
    int nblk = tbl[64]; if (nblk > MAXBLK) nblk = MAXBLK; if (nblk < 1) nblk = 1;
    return __builtin_amdgcn_readfirstlane(nblk);
}

__device__ __forceinline__ void p11_combine(Frame& F, const Args& args) {
    (void)moe_tables(F);
    const LAS int* tbl = (const LAS int*)(F.lds + MOE_TBL_OFF);
    const float* mod = WSP(float, WS_MOD); const bf16* YR = WSP(bf16, WS_YR);
    const int gw = F.vcu * NWAVES + F.wave, NGW = F.G * NWAVES;
    for (int m = gw; m < NTOK; m += NGW) {
        const int b = m >> 12;
        int dk = 0; if (F.lane < 4) { const int e = __hip_atomic_load(WSP(int, WS_TOKE) + m * 4 + F.lane, RLX_AGENT); dk = tbl[32 + e] * 256 + __hip_atomic_load(WSP(int, WS_TOKPOS) + m * 4 + F.lane, RLX_AGENT); }
        const int d0 = __shfl(dk, 0), d1 = __shfl(dk, 1), d2 = __shfl(dk, 2), d3 = __shfl(dk, 3);
        f32x4* xr = (f32x4*)(F.out + (size_t)m * DM) + F.lane;
#pragma unroll
        for (int j = 0; j < 4; ++j) { const int col = 4 * F.lane + 256 * j;
            const v2u y0 = *(const v2u*)(YR + (size_t)d0 * DM + col), y1 = *(const v2u*)(YR + (size_t)d1 * DM + col), y2 = *(const v2u*)(YR + (size_t)d2 * DM + col), y3 = *(const v2u*)(YR + (size_t)d3 * DM + col);
            f32x4 s;
            s.x = (bflo(y0.x) + bflo(y1.x)) + (bflo(y2.x) + bflo(y3.x)); s.y = (bfhi(y0.x) + bfhi(y1.x)) + (bfhi(y2.x) + bfhi(y3.x));
            s.z = (bflo(y0.y) + bflo(y1.y)) + (bflo(y2.y) + bflo(y3.y)); s.w = (bfhi(y0.y) + bfhi(y1.y)) + (bfhi(y2.y) + bfhi(y3.y));
            const f32x4 g2 = *(const f32x4*)(mod + b * 6144 + 5120 + col);
            xr[64 * j] = xr[64 * j] + g2 * s; }
    }
}

#ifndef NSTREAM
#define NSTREAM 8
#endif
#define P4_PULL(ctr, dst) do { __syncthreads(); if (F.tid == 0) bc[0] = (int)__hip_atomic_fetch_add((ctr), 1u, RLX_AGENT); __syncthreads(); dst = bc[0]; } while (0)
__device__ __forceinline__ void p4_phase(Frame& F, const Args& args) {
    unsigned* Q = (unsigned*)(F.ws + WS_CTL) + CW_QUEUE;
    LAS int* bc = (LAS int*)(F.lds + XTRA_OFF + 12288);
    const bool xcd_ok = (F.G == 256);
    const int xg = xcd_ok ? (F.vcu >> 5) : (F.vcu & 7);
    const bool streamer = xcd_ok && (F.vcu & 31) < NSTREAM;
    if (streamer) { for (;;) { int ch; P4_PULL(Q + 64 * 9, ch); if (ch >= P8_NCHUNK) break; p8_chunk(F, args, ch); } }
#pragma unroll 1
    for (int dx = 0; dx < 8; ++dx) { const int x = (xg + dx) & 7;
        for (;;) { int a; P4_PULL(Q + 64 * x, a); if (a >= 64) break;
            const int bh = 4 * x + (a & 3); att::attn_unit(F, args, bh >> 3, bh & 7, 15 - (a >> 2)); } }
    for (;;) { int u; P4_PULL(Q + 64 * 8, u); if (u >= 512) break; p4_rnn_final_unit(F, args, u); }
    if (!streamer) { for (;;) { int ch; P4_PULL(Q + 64 * 9, ch); if (ch >= P8_NCHUNK) break; p8_chunk(F, args, ch); } }
}
#undef P4_PULL

#ifndef MK_N_LAUNCHES
#define MK_N_LAUNCHES 1
#endif
constexpr int PER_PHASE = 12;
constexpr int N_LAUNCHES = MK_N_LAUNCHES;

__global__ void __launch_bounds__(NWAVES * 64, 2) hybrid_fwd(Args args) {
    extern __shared__ __attribute__((aligned(16))) unsigned char lds[];
    Frame F;
    F.lds = (LAS unsigned char*)lds; F.ldsg = (char*)lds;
    F.MISC = (volatile LAS unsigned*)(F.lds + MISC_OFF);
    F.tid = threadIdx.x; F.lane = F.tid & 63; F.wave = __builtin_amdgcn_readfirstlane(F.tid >> 6);
    F.G = gridDim.x; { const int bx = blockIdx.x; F.vcu = (F.G % 8 == 0) ? (bx % 8) * (F.G / 8) + bx / 8 : bx; }
    F.ws = args.ws; F.out = args.out;
    gu32* ctl = (gu32*)(args.ws + WS_CTL);
    for (int u = F.tid; u < (LDS_BYTES - LDSCTL_OFF) / 4; u += NWAVES * 64) ((LAS unsigned*)(F.lds + LDSCTL_OFF))[u] = 0u;
    __syncthreads();
    XcdBarrier bar; bar.bar = (unsigned*)(ctl + CW_BAR); bar.x = 0; bar.st = nullptr;
    if (N_LAUNCHES == 1) bar = xcd_barrier_post((unsigned*)(ctl + CW_BAR), F.MISC + 8);
    const int lo = args.ph_lo, hi = args.ph_hi;
#ifndef PHASE_MASK
#define PHASE_MASK 0xFFF
#endif
#define IN(k) (((PHASE_MASK >> (k)) & 1) && lo <= (k) && (k) < hi)
#define NEXTP(k) ((k) == 0 ? 2 : (k) == 7 ? 9 : (k) + 1)
#define SEAM(k) do { if (IN(k) && IN(NEXTP(k))) xcd_barrier(bar); } while (0)

#ifndef DUP_MASK
#define DUP_MASK 0
#endif
#define PHASE(k, ...) do { if (IN(k)) { __VA_ARGS__ if ((DUP_MASK >> (k)) & 1) { xcd_barrier(bar); __VA_ARGS__ } } SEAM(k); } while (0)
    PHASE(0, { p0_prologue(F, args); p1_hrows(F, args); });
    PHASE(2, {
        { pg8::Gemm g{WSP(bf16, WS_HB), WSP(bf16, WS_WIN), NTOK, 3072, DM}; pg8::TileOrder S; S.init(NTOK / 256, 12, F.G, (int)blockIdx.x, nullptr);
          pg8::EpiWin E{WSP(bf16, WS_E), IN_F(17), 0};
          pg8::gemm_phase<pg8::EpiWin, pg8::TileOrder, true, true>(F.lds + RING_OFF, g, S, E); }
        { pg8::Gemm g{WSP(bf16, WS_H8), WSP(bf16, WS_WIN8), NTOK, 4096, DM / 2}; pg8::TileOrder S; S.init(NTOK / 256, 16, F.G, (int)blockIdx.x, nullptr);
          pg8::EpiWin E{WSP(bf16, WS_E), IN_F(17), 1};
          pg8::gemm_phase<pg8::EpiWin, pg8::TileOrder, true, true, false, true>(F.lds + RING_OFF, g, S, E); }
    });
    int p3rep = 0;
    PHASE(3, {
        for (int u = F.vcu; u < 512; u += F.G) p3_rnn_local_unit(F, args, u);
        if (p3rep++ == 0) { for (int u = F.vcu; u < 512; u += F.G) p3_knorm_unit(F, args, u); }
    });
    PHASE(4, { p4_phase(F, args); });
    PHASE(5, {
        pg8::Gemm g{WSP(bf16, WS_YCAT), WSP(bf16, WS_WB), NTOK, DM, 2 * DM}; pg8::TileOrder S; S.init(NTOK / 256, DM / 256, F.G, (int)blockIdx.x, nullptr);
        pg8::EpiBranch E{WSP(bf16, WS_E) + 5 * E_STRIDE, WSP(bf16, WS_E) + 6 * E_STRIDE, WSP(bf16, WS_HB)};
        pg8::gemm_phase<pg8::EpiBranch, pg8::TileOrder, false, true>(F.lds + RING_OFF, g, S, E);
    });
    PHASE(6, {
        pg8::Gemm g{WSP(bf16, WS_HB), WSP(bf16, WS_WO), NTOK, DM, DM}; pg8::TileOrder S; S.init(NTOK / 256, DM / 256, F.G, (int)blockIdx.x, nullptr);
        pg8::EpiWout E{IN_F(0), F.out, WSP(float, WS_MOD)};
        pg8::gemm_phase<pg8::EpiWout, pg8::TileOrder, false, true>(F.lds + RING_OFF, g, S, E);
    });
    PHASE(7, { p7_router(F, args); });
    PHASE(9, {
        const int nblk = moe_tables(F);
        const LAS int* tbl = (const LAS int*)(F.lds + MOE_TBL_OFF); LAS int* lists = (LAS int*)(F.lds + MOE_LIST_OFF);
        pg8::Gemm g{WSP(bf16, WS_HB), WSP(bf16, WS_WUP), RMAX, 2048 * NEXP, DM / 2}; pg8::TileOrder S; S.init(nblk, 8, F.G, (int)blockIdx.x, tbl + 80, F.ws + WS_HB);
        { pg8::Unit u; for (int i = 0; i < 9 && S.next(i, u); ++i) { if (F.tid < 256) { const int e = u.pn >> 3, pos = (u.pm - tbl[32 + e]) * 256 + F.tid;
              lists[i * 256 + F.tid] = pos < tbl[e] ? __hip_atomic_load(WSP(int, WS_ROWTOK) + (size_t)e * ECAP + pos, RLX_AGENT) : 0; } } }
        __syncthreads();
        pg8::EpiUp E{WSP(unsigned char, WS_ACT), IN_F(23)};
        pg8::gemm_phase<pg8::EpiUp, pg8::TileOrder, true, true, true, true>(F.lds + RING_OFF, g, S, E, lists);
    });
    PHASE(10, {
        const int nblk = moe_tables(F);
        const LAS int* tbl = (const LAS int*)(F.lds + MOE_TBL_OFF);
        pg8::Gemm g{WSP(bf16, WS_ACT), WSP(bf16, WS_WDN), RMAX, 1024 * NEXP, DM / 2}; pg8::TileOrder S; S.init(nblk, 4, F.G, (int)blockIdx.x, tbl + 80);
        pg8::EpiDown E{WSP(bf16, WS_YR), IN_F(25), WSP(float, WS_ROWGATE), tbl};
        pg8::gemm_phase<pg8::EpiDown, pg8::TileOrder, true, true, false, true>(F.lds + RING_OFF, g, S, E);
    });
    PHASE(11, { p11_combine(F, args); });
#undef PHASE
#undef IN
#undef SEAM
}

extern "C" void kernel_launch(void* const* d_in, const int* in_sizes, int n_in, void* d_out, int out_size, void* d_ws, size_t ws_size, hipStream_t stream) {
    static int grid = 0;
    if (grid == 0) {
        if (n_in != 26 || in_sizes[0] != NTOK * DM || out_size != NTOK * DM || ws_size < WS_END) {
            fprintf(stderr, "kernel_launch: shape/workspace mismatch (n_in %d, in0 %d, out %d, ws %zu; need ws >= %zu); nothing launched\n", n_in, n_in > 0 ? in_sizes[0] : -1, out_size, ws_size, (size_t)WS_END); grid = -1; return; }
        int dev = 0, cus = 0, per_cu = 0;
        if (hipGetDevice(&dev) != hipSuccess || hipDeviceGetAttribute(&cus, hipDeviceAttributeMultiprocessorCount, dev) != hipSuccess) { fprintf(stderr, "kernel_launch: device query failed\n"); grid = -1; return; }
        if (hipFuncSetAttribute((const void*)hybrid_fwd, hipFuncAttributeMaxDynamicSharedMemorySize, LDS_BYTES) != hipSuccess) { fprintf(stderr, "kernel_launch: hipFuncSetAttribute failed\n"); grid = -1; return; }
        if (hipOccupancyMaxActiveBlocksPerMultiprocessor(&per_cu, (const void*)hybrid_fwd, NWAVES * 64, LDS_BYTES) != hipSuccess || per_cu < 1) { fprintf(stderr, "kernel_launch: occupancy query says %d blocks/CU\n", per_cu); per_cu = 1; }
        (void)hipGetLastError();
        grid = cus;
        if (grid > 256) grid = 256;
    }
    if (grid < 0) return;
    (void)hipMemsetAsync((char*)d_ws + WS_CTL, 0, CTL_ZERO_BYTES, stream);
    Args a{};
    for (int i = 0; i < 26; ++i) a.in[i] = d_in[i];
    a.out = (float*)d_out; a.ws = (unsigned char*)d_ws;
    for (int li = 0; li < N_LAUNCHES; ++li) {
        a.ph_lo = (N_LAUNCHES == 1) ? 0 : li; a.ph_hi = (N_LAUNCHES == 1) ? PER_PHASE : li + 1;
        hipLaunchKernelGGL(hybrid_fwd, dim3(grid), dim3(NWAVES * 64), LDS_BYTES, stream, a);
        const hipError_t le = hipPeekAtLastError();
        if (le != hipSuccess) { fprintf(stderr, "kernel_launch: launch %d failed: %s\n", li, hipGetErrorName(le)); break; }
    }
}
```

```cpp
#include <hip/hip_runtime.h>
#include <hip/hip_bf16.h>
#include <cstdio>
#include <cstdint>
#include <cmath>
namespace pg8 {
#define PG8_LAS __attribute__((address_space(3)))
typedef unsigned short bf16_t;
typedef short bf16x8 __attribute__((ext_vector_type(8)));
typedef float f32x4 __attribute__((ext_vector_type(4)));
typedef unsigned u32x4 __attribute__((ext_vector_type(4)));
constexpr int BM = 256, BK = 64, HALF = 128, HTB = HALF * BK * 2  , STAGE_BYTES = 8 * HTB, NXCD = 8, WGM = 8;

__host__ __device__ __forceinline__ int lds_byte(int r, int c) { const int st = (r >> 4) * 2 + (c >> 5), rr = r & 15, cc = c & 31, ob = rr * 64 + cc * 2; return st * 1024 + (ob ^ (((ob >> 9) & 1) << 5)); }
__host__ __device__ __forceinline__ void stage_rc(int b, int& R, int& C) { const int st = b / 1024, sb = b % 1024, swz = sb ^ (((sb >> 9) & 1) << 5); R = (st >> 1) * 16 + swz / 64; C = (st & 1) * 32 + (swz % 64) / 2; }
__host__ __device__ __forceinline__ int perm32(int rho) { const int n = rho >> 4, i = rho & 15; return 8 * (i >> 2) + 4 * n + (i & 3); }

struct Unit { int pm, pn, kind; };
struct Gemm { const bf16_t* A; const bf16_t* Bt; int M, N, K; };

struct StaticOrder {
    int nM, nN, nwg, G, c;
    __host__ __device__ void init(int M, int N, int G_, int c_) { nM = M / BM; nN = N / BM; nwg = nM * nN; G = G_; c = c_; }
    __host__ __device__ bool next(int i, Unit& u) const {
        const long L = (long)i * G + c; if (L >= nwg) return false;
        int wgid = (int)L; { const int q = nwg / NXCD, r = nwg % NXCD, xcd = wgid % NXCD, off = wgid / NXCD; wgid = (xcd < r ? xcd * (q + 1) : r * (q + 1) + (xcd - r) * q) + off; }
        const int nig = WGM * nN, gid = wgid / nig, fm = gid * WGM, gsz = (nM - fm) < WGM ? (nM - fm) : WGM;
        u.pm = fm + ((wgid % nig) % gsz); u.pn = (wgid % nig) / gsz; return true;
    }
    __device__ __forceinline__ void a_ready(const Unit&) const {}
    __device__ __forceinline__ void done(const Unit&) const {}
};

__device__ __forceinline__ unsigned cvt_pk_bf16(float lo, float hi) { unsigned r; asm volatile("v_cvt_pk_bf16_f32 %0, %1, %2" : "=v"(r) : "v"(lo), "v"(hi)); return r; }
typedef int v4i_t __attribute__((ext_vector_type(4)));
typedef int v8i_t __attribute__((ext_vector_type(8)));
template <class Epi, class Sched, bool ALIGN_EPI = false, bool SP2 = false, bool GATHER = false, bool FP8 = false>
__device__ __forceinline__ void gemm_phase(PG8_LAS unsigned char* lds, const Gemm g, const Sched& S, const Epi& E, const PG8_LAS int* rowlists = nullptr) {
    static_assert(!GATHER || SP2, "GATHER is implemented for the SP2 loop");
    const int tid = threadIdx.x, wid = __builtin_amdgcn_readfirstlane(tid >> 6), lane = tid & 63, wr = wid >> 2, wc = wid & 3, fr = lane & 15, fq = lane >> 4;
    const int K = g.K, nt = K / BK;
    unsigned voffA, voffB; int gR, gC;
    { int R, C; stage_rc(tid * 16, R, C); const int Rb = Epi::PERM ? ((R & ~31) + perm32(R & 31)) : R; gR = R; gC = C;
      voffA = (unsigned)(R * K + C) * 2u; voffB = (unsigned)(Rb * K + C) * 2u; }
    const size_t row64 = (size_t)64 * K * 2;
    const size_t kstep = (size_t)(BK * 2);
    const size_t hstep = (size_t)HALF * K * 2;
    const size_t tstep = 2 * hstep;
    const unsigned ldsw = (unsigned)wid * 1024u;
    const int aoff = lds_byte(wr * 64 + fr, fq * 8), boff = lds_byte(wc * 32 + fr, fq * 8);
#define PG8_SA(b, h) (((b) * 2 + (h)) * HTB)
#define PG8_SB(b, h) ((4 + (b) * 2 + (h)) * HTB)
#define PG8_STAGE2(bufoff, gbase, v0_, v1_) do { unsigned vo0_ = (v0_), vo1_ = (v1_); asm volatile("" : "+v"(vo0_), "+v"(vo1_));     \
        __builtin_amdgcn_global_load_lds((const unsigned*)((const char*)(gbase) + vo0_), (PG8_LAS unsigned*)(lds + (bufoff) + ldsw), 16, 0, 0); \
        __builtin_amdgcn_global_load_lds((const unsigned*)((const char*)(gbase) + vo1_), (PG8_LAS unsigned*)(lds + (bufoff) + ldsw + 8192), 16, 0, 0); } while (0)
#define PG8_STAGE(bufoff, gbase, voff) do { unsigned vo_ = (voff); asm volatile("" : "+v"(vo_)); \
        __builtin_amdgcn_global_load_lds((const unsigned*)((const char*)(gbase) + vo_), (PG8_LAS unsigned*)(lds + (bufoff) + ldsw), 16, 0, 0); \
        __builtin_amdgcn_global_load_lds((const unsigned*)((const char*)(gbase) + row64 + vo_), (PG8_LAS unsigned*)(lds + (bufoff) + ldsw + 8192), 16, 0, 0); } while (0)
#define PG8_LDA(dst, b, h) do { _Pragma("unroll") for (int m = 0; m < 4; ++m) _Pragma("unroll") for (int k = 0; k < 2; ++k) dst[m][k] = *(const PG8_LAS bf16x8*)(lds + PG8_SA(b, h) + aoff + m * 2048 + k * 1024); } while (0)
#define PG8_LDB(dst, b, h) do { _Pragma("unroll") for (int n = 0; n < 2; ++n) _Pragma("unroll") for (int k = 0; k < 2; ++k) dst[n][k] = *(const PG8_LAS bf16x8*)(lds + PG8_SB(b, h) + boff + n * 2048 + k * 1024); } while (0)
#define PG8_CAT8(x, y) __builtin_shufflevector(__builtin_bit_cast(v4i_t, (x)), __builtin_bit_cast(v4i_t, (y)), 0, 1, 2, 3, 4, 5, 6, 7)
#define PG8_MMA(ai, bj, At, Bt) do { __builtin_amdgcn_s_setprio(1); _Pragma("unroll") for (int m = 0; m < 4; ++m) _Pragma("unroll") for (int n = 0; n < 2; ++n) { \
        if constexpr (FP8) { const v8i_t a8_ = PG8_CAT8(Bt[n][0], Bt[n][1]), b8_ = PG8_CAT8(At[m][0], At[m][1]);     \
            asm volatile("v_mfma_scale_f32_16x16x128_f8f6f4 %0, %1, %2, %0, %3, %4 op_sel_hi:[0,0,0]" : "+v"(acc[ai][bj][m][n]) : "v"(a8_), "v"(b8_), "v"(mxsa_), "v"(mxsb_)); } \
        else { _Pragma("unroll") for (int k = 0; k < 2; ++k) acc[ai][bj][m][n] = __builtin_amdgcn_mfma_f32_16x16x32_bf16(Bt[n][k], At[m][k], acc[ai][bj][m][n], 0, 0, 0); } } \
        __builtin_amdgcn_s_setprio(0); } while (0)
#define PG8_WAIT_V(n) asm volatile("s_waitcnt vmcnt(" #n ")" ::: "memory")
#define PG8_WAIT_VN(n) asm volatile("s_waitcnt vmcnt(%0)" :: "i"(n) : "memory")
#define PG8_WAIT_L(n) asm volatile("s_waitcnt lgkmcnt(" #n ")" ::: "memory")
#define PG8_BAR __builtin_amdgcn_s_barrier()
#define PG8_SCHED __builtin_amdgcn_sched_barrier(0)
    Unit cur, nxt; int ui = 0;
    if (!S.next(0, cur)) return;
    int mxsa_ = 121, mxsb_ = 127; asm volatile("" : "+v"(mxsa_), "+v"(mxsb_));
    f32x4 acc[2][2][4][2];
#pragma unroll
    for (int a = 0; a < 2; ++a)
#pragma unroll
        for (int b = 0; b < 2; ++b)
#pragma unroll
            for (int m = 0; m < 4; ++m)
#pragma unroll
                for (int n = 0; n < 2; ++n) acc[a][b][m][n] = (f32x4){0.f, 0.f, 0.f, 0.f};
    bf16x8 At[4][2], B0[2][2], B1[2][2];
    const char* cA = GATHER ? (const char*)S.a_base(cur) : (const char*)g.A + (size_t)cur.pm * tstep; const char* cB = (const char*)g.Bt + (size_t)cur.pn * tstep;
#define PG8_STAGE_A(bufoff, kptr, half, unx) do { if constexpr (GATHER) { const PG8_LAS int* rl_ = rowlists + (ui + (unx)) * 256 + (half) * HALF + gR; \
        PG8_STAGE2(bufoff, kptr, (unsigned)(rl_[0] * K + gC) * 2u, (unsigned)(rl_[64] * K + gC) * 2u); } \
        else { PG8_STAGE(bufoff, (kptr) + (half) * hstep, voffA); } } while (0)
    S.a_ready(cur);
    if constexpr (SP2) {
        PG8_STAGE(PG8_SB(0, 0), cB, voffB); PG8_STAGE(PG8_SB(0, 1), cB + hstep, voffB); PG8_STAGE_A(PG8_SA(0, 0), cA, 0, 0); PG8_STAGE_A(PG8_SA(0, 1), cA, 1, 0);
        if (wr == 1) PG8_BAR;
        PG8_WAIT_V(2); PG8_BAR;
        PG8_STAGE(PG8_SB(1, 0), cB + kstep, voffB); PG8_STAGE_A(PG8_SA(1, 0), cA + kstep, 0, 0); PG8_STAGE(PG8_SB(1, 1), cB + hstep + kstep, voffB);
        PG8_WAIT_V(6); PG8_BAR;
    } else {
        PG8_STAGE(PG8_SB(0, 0), cB, voffB); PG8_STAGE(PG8_SA(0, 0), cA, voffA); PG8_STAGE(PG8_SB(0, 1), cB + hstep, voffB); PG8_STAGE(PG8_SA(0, 1), cA + hstep, voffA);
        if (wr == 1) PG8_BAR;
        PG8_WAIT_V(4); PG8_BAR;
        PG8_STAGE(PG8_SB(1, 0), cB + kstep, voffB); PG8_STAGE(PG8_SA(1, 0), cA + kstep, voffA); PG8_STAGE(PG8_SB(1, 1), cB + hstep + kstep, voffB);
        PG8_WAIT_V(6); PG8_BAR;
    }
    for (;;) {
        const bool has_next = S.next(ui + 1, nxt);
        const char* nA = GATHER ? (has_next ? (const char*)S.a_base(nxt) : cA) : (has_next ? (const char*)g.A + (size_t)nxt.pm * tstep : cA);
        const char* nB = has_next ? (const char*)g.Bt + (size_t)nxt.pn * tstep : cB;
#pragma unroll 1
        for (int t = 0; t < nt; t += 2) {
            const bool last = (t == nt - 2);
            if constexpr (Epi::MIDK) { if (t == (nt >> 1)) { if constexpr (FP8) asm volatile("s_nop 15\n\ts_nop 7" ::: "memory"); E.mid(acc, cur, wr, wc, fr, fq); } }
            const char* a1 = cA + (size_t)(t + 1) * kstep;
            const char* a2 = last ? nA : cA + (size_t)(t + 2) * kstep; const char* b2 = last ? nB : cB + (size_t)(t + 2) * kstep;
            const char* a3 = a2 + kstep; const char* b3 = b2 + kstep;
            if (last && has_next) S.a_ready(nxt);
            const int unx = (GATHER && last && has_next) ? 1 : 0;
            if constexpr (SP2) {
            PG8_LDB(B0, 0, 0); PG8_LDB(B1, 0, 1); PG8_SCHED; PG8_LDA(At, 0, 0); PG8_STAGE_A(PG8_SA(1, 1), a1, 1, 0);
            PG8_WAIT_V(8); PG8_WAIT_L(0); PG8_BAR; PG8_MMA(0, 0, At, B0); PG8_MMA(0, 1, At, B1); PG8_BAR; PG8_SCHED;
            PG8_LDA(At, 0, 1); PG8_STAGE(PG8_SB(0, 0), b2, voffB); PG8_STAGE(PG8_SB(0, 1), b2 + hstep, voffB); PG8_STAGE_A(PG8_SA(0, 0), a2, 0, unx);
            PG8_WAIT_V(8); PG8_WAIT_L(0); PG8_BAR; PG8_MMA(1, 0, At, B0); PG8_MMA(1, 1, At, B1); PG8_BAR; PG8_SCHED;
            PG8_LDB(B0, 1, 0); PG8_LDB(B1, 1, 1); PG8_SCHED; PG8_LDA(At, 1, 0); PG8_STAGE_A(PG8_SA(0, 1), a2, 1, unx);
            PG8_WAIT_V(8); PG8_WAIT_L(0); PG8_BAR; PG8_MMA(0, 0, At, B0); PG8_MMA(0, 1, At, B1); PG8_BAR; PG8_SCHED;
            PG8_LDA(At, 1, 1); PG8_STAGE(PG8_SB(1, 0), b3, voffB); PG8_STAGE(PG8_SB(1, 1), b3 + hstep, voffB); PG8_STAGE_A(PG8_SA(1, 0), a3, 0, unx);
            PG8_WAIT_V(8); PG8_WAIT_L(0); PG8_BAR; PG8_MMA(1, 0, At, B0); PG8_MMA(1, 1, At, B1); PG8_BAR; PG8_SCHED;
            } else {
            PG8_LDB(B0, 0, 0); PG8_SCHED; PG8_LDA(At, 0, 0); PG8_STAGE(PG8_SA(1, 1), a1 + hstep, voffA);
            PG8_WAIT_L(8); PG8_BAR; PG8_WAIT_L(0); PG8_MMA(0, 0, At, B0); PG8_BAR; PG8_SCHED;
            PG8_LDB(B1, 0, 1); PG8_STAGE(PG8_SB(0, 0), b2, voffB);
            PG8_BAR; PG8_WAIT_L(0); PG8_MMA(0, 1, At, B1); PG8_BAR;
            PG8_LDA(At, 0, 1); PG8_STAGE(PG8_SA(0, 0), a2, voffA);
            PG8_BAR; PG8_WAIT_L(0); PG8_MMA(1, 0, At, B0); PG8_BAR; PG8_SCHED;
            PG8_STAGE(PG8_SB(0, 1), b2 + hstep, voffB);
            PG8_WAIT_V(6); PG8_BAR; PG8_MMA(1, 1, At, B1); PG8_BAR;
            PG8_LDB(B0, 1, 0); PG8_SCHED; PG8_LDA(At, 1, 0); PG8_STAGE(PG8_SA(0, 1), a2 + hstep, voffA);
            PG8_WAIT_L(8); PG8_BAR; PG8_WAIT_L(0); PG8_MMA(0, 0, At, B0); PG8_BAR; PG8_SCHED;
            PG8_LDB(B1, 1, 1); PG8_STAGE(PG8_SB(1, 0), b3, voffB);
            PG8_BAR; PG8_WAIT_L(0); PG8_MMA(0, 1, At, B1); PG8_BAR;
            PG8_LDA(At, 1, 1); PG8_STAGE(PG8_SA(1, 0), a3, voffA);
            PG8_BAR; PG8_WAIT_L(0); PG8_MMA(1, 0, At, B0); PG8_BAR; PG8_SCHED;
            PG8_STAGE(PG8_SB(1, 1), b3 + hstep, voffB);
            PG8_WAIT_V(6); PG8_BAR; PG8_MMA(1, 1, At, B1); PG8_BAR;
            }
        }
        if constexpr (ALIGN_EPI) { if (wr == 0) PG8_BAR; }
        if constexpr (FP8) asm volatile("s_nop 15\n\ts_nop 7" ::: "memory");
        if constexpr (!Epi::AFTER_DRAIN) { E(acc, cur, wr, wc, fr, fq); S.done(cur); }
        if (!has_next) break;
#pragma unroll
        for (int a = 0; a < 2; ++a)
#pragma unroll
            for (int b = 0; b < 2; ++b)
#pragma unroll
                for (int m = 0; m < 4; ++m)
#pragma unroll
                    for (int n = 0; n < 2; ++n) acc[a][b][m][n] = (f32x4){0.f, 0.f, 0.f, 0.f};
        cur = nxt; cA = nA; cB = nB; ++ui;
        if constexpr (ALIGN_EPI) { if (wr == 1) PG8_BAR; }
    }
    PG8_WAIT_V(0);
    if constexpr (!ALIGN_EPI) { if (wr == 0) PG8_BAR; }
    PG8_BAR;
    if constexpr (Epi::AFTER_DRAIN) { E.fused(acc, cur, wr, wc, fr, fq, lds, wid, lane); S.done(cur); }
#undef PG8_SA
#undef PG8_STAGE_A
#undef PG8_SB
#undef PG8_STAGE
#undef PG8_STAGE2
#undef PG8_LDA
#undef PG8_LDB
#undef PG8_MMA
#undef PG8_CAT8
#undef PG8_WAIT_V
#undef PG8_WAIT_VN
#undef PG8_WAIT_L
#undef PG8_BAR
#undef PG8_SCHED
}
}

constexpr int NB = 4, SEQ = 4096, DM = 1024, NTOK = NB * SEQ, DIN = 7168, NH = 8, HD = 128;
constexpr int NEXP = 32, TOPK = 4, MAXBLK = 288, RMAX = MAXBLK * 256;
constexpr float EPS = 1e-6f;
constexpr int NWAVES = 8;

constexpr size_t MiB = 1u << 20, KiB = 1u << 10;
constexpr size_t WS_CTL = 0, CTL_ZERO_BYTES = 1 * MiB;
constexpr size_t WS_MOD = 1 * MiB;
constexpr size_t WS_KMEAN = 1 * MiB + 128 * KiB;
constexpr size_t WS_AGGP = 1 * MiB + 384 * KiB;
constexpr size_t WS_AGGH = 1 * MiB + 640 * KiB;
constexpr size_t WS_WRH = 2 * MiB, WS_WRL = 2 * MiB + 64 * KiB;
constexpr size_t WS_TOKE = 3 * MiB, WS_TOKPOS = 3 * MiB + 256 * KiB;
constexpr int ECAP = 16384;
constexpr size_t WS_ROWTOK = 28 * MiB, WS_ROWGATE = 30 * MiB;
constexpr int CW_UPDONE = 16384;
constexpr int CW_QUEUE = 12288;
constexpr int CW_CNT = 8192;
constexpr size_t WS_TRIG = 4 * MiB;
constexpr size_t WS_WRG = 6 * MiB;
constexpr size_t WS_WIN = 8 * MiB;
constexpr size_t WS_WIN8 = 16 * MiB;
constexpr size_t WS_H8 = 544 * MiB;
constexpr size_t WS_WB = 22 * MiB;
constexpr size_t WS_WO = 26 * MiB;
constexpr size_t WS_WUP = 32 * MiB;
constexpr size_t WS_WDN = 96 * MiB;
constexpr size_t WS_HB = 224 * MiB;
constexpr size_t WS_E = 256 * MiB;
constexpr size_t E_STRIDE = (size_t)NTOK * DM;
constexpr size_t WS_D1 = 256 * MiB;
constexpr size_t WS_HL = 480 * MiB, WS_PP = 512 * MiB, WS_YCAT = 544 * MiB;
constexpr int CW_MODCNT = 8256;
constexpr size_t WS_ACT = 400 * MiB, WS_YR = 544 * MiB;
constexpr size_t WS_END = 688 * MiB;
constexpr int CW_BAR = 4096;

constexpr int RING_OFF = 0, RING_BYTES = 131072;
constexpr int LDSCTL_OFF = RING_BYTES, MISC_OFF = LDSCTL_OFF + 320;
constexpr int XTRA_OFF = LDSCTL_OFF + 1024;
constexpr int LDS_BYTES = 155648;

#define GAS __attribute__((address_space(1)))
#define LAS __attribute__((address_space(3)))
typedef unsigned short bf16;
typedef unsigned v4u __attribute__((ext_vector_type(4)));
typedef unsigned v2u __attribute__((ext_vector_type(2)));
typedef float f32x4 __attribute__((ext_vector_type(4)));
typedef float f32x2 __attribute__((ext_vector_type(2)));
typedef float f32x16 __attribute__((ext_vector_type(16)));
typedef short bf16x8 __attribute__((ext_vector_type(8)));
typedef short s16x4 __attribute__((ext_vector_type(4)));
typedef GAS unsigned gu32;
#define RLX_AGENT __ATOMIC_RELAXED, __HIP_MEMORY_SCOPE_AGENT
#define LDS_WAIT() asm volatile("s_waitcnt lgkmcnt(0)" ::: "memory")
#define VM_WAIT() asm volatile("s_waitcnt vmcnt(0)" ::: "memory")
#define SBAR() __builtin_amdgcn_sched_barrier(0)
__device__ __forceinline__ unsigned f2bf(float f) { unsigned u = __builtin_bit_cast(unsigned, f); return (u + 0x7fffu + ((u >> 16) & 1u)) >> 16; }
__device__ __forceinline__ unsigned pk2(float lo, float hi) { return f2bf(lo) | (f2bf(hi) << 16); }
__device__ __forceinline__ float bf2f(unsigned short h) { return __builtin_bit_cast(float, (unsigned)h << 16); }
__device__ __forceinline__ float bflo(unsigned w) { return __builtin_bit_cast(float, w << 16); }
__device__ __forceinline__ float bfhi(unsigned w) { return __builtin_bit_cast(float, w & 0xffff0000u); }
__device__ __forceinline__ unsigned cvtpk(float lo, float hi) { unsigned r; asm volatile("v_cvt_pk_bf16_f32 %0, %1, %2" : "=v"(r) : "v"(lo), "v"(hi)); return r; }
__device__ __forceinline__ float fast_sigmoid(float x) { return __builtin_amdgcn_rcpf(1.0f + __builtin_amdgcn_exp2f(-1.4426950408889634f * x)); }
__device__ __forceinline__ float gelu_tanh(float x) { const float z = 1.5957691216057308f * (x + 0.044715f * x * x * x); return x * fast_sigmoid(z); }
__device__ __forceinline__ f32x2 sigmoid_pk(f32x2 x) { const f32x2 z = x * (-1.4426950408889634f); f32x2 e; e.x = __builtin_amdgcn_exp2f(z.x); e.y = __builtin_amdgcn_exp2f(z.y);
    const f32x2 d = e + 1.0f; f32x2 r; r.x = __builtin_amdgcn_rcpf(d.x); r.y = __builtin_amdgcn_rcpf(d.y); return r; }
__device__ __forceinline__ f32x2 gelu_tanh_pk(f32x2 x) {
    const f32x2 u = x * x, w = u * (-0.044715f * 1.5957691216057308f * 1.4426950408889634f) + (-1.5957691216057308f * 1.4426950408889634f), z = x * w;
    f32x2 e; e.x = __builtin_amdgcn_exp2f(z.x); e.y = __builtin_amdgcn_exp2f(z.y);
    const f32x2 d = e + 1.0f; f32x2 r; r.x = __builtin_amdgcn_rcpf(d.x); r.y = __builtin_amdgcn_rcpf(d.y); return x * r; }
__device__ __forceinline__ float wave_sum(float v) {
#pragma unroll
    for (int o = 1; o < 64; o <<= 1) v += __shfl_xor(v, o);
    return v;
}
__device__ __forceinline__ float wave_max(float v) {
#pragma unroll
    for (int o = 1; o < 64; o <<= 1) v = fmaxf(v, __shfl_xor(v, o));
    return v;
}

#define XB_TMO      128
#define XB_XCNT(j)  (256  + 64 * (j))
#define XB_XSUB(j)  (1280 + 64 * (j))
#define XB_XGEN(j)  (2304 + 64 * (j))
#define XB_TOP      3328
#define XB_TOPGEN   3392
#define XCD_BAR_WORDS 3456
#define XB_SPIN_CAP (1u << 20)
__device__ __forceinline__ unsigned xb_ld(unsigned* p)              { return __hip_atomic_load(p, __ATOMIC_RELAXED, __HIP_MEMORY_SCOPE_AGENT); }
__device__ __forceinline__ unsigned xb_add(unsigned* p, unsigned v) { return __hip_atomic_fetch_add(p, v, __ATOMIC_RELAXED, __HIP_MEMORY_SCOPE_AGENT); }
__device__ __forceinline__ unsigned xb_xcc_id() { return (unsigned)__builtin_amdgcn_s_getreg((3 << 11) | 20) & 0xFu; }
#define XB_SPIN(cond, bar) do { unsigned _sp = 0; while (cond) { __builtin_amdgcn_s_sleep(1); \
    if ((++_sp & 255u) == 0u) { if (xb_ld(&(bar)[XB_TMO])) break; if (_sp > XB_SPIN_CAP) { atomicAdd(&(bar)[XB_TMO], 1u); break; } } } } while (0)
struct XcdBarrier { unsigned* bar; unsigned x; volatile LAS unsigned* st; };
__device__ __forceinline__ XcdBarrier xcd_barrier_post(unsigned* bar, volatile LAS unsigned* st) {
    XcdBarrier b; b.bar = bar; b.x = xb_xcc_id(); b.st = st;
    if (threadIdx.x == 0) (void)xb_add(&bar[XB_XCNT(b.x)], 1u);
    return b;
}
__device__ __forceinline__ void xcd_barrier_complete(unsigned* bar, unsigned x, unsigned& nloc, unsigned& nx) {
    const unsigned G = gridDim.x * gridDim.y * gridDim.z;
    unsigned sum, cnt, mine, sp = 0u;
    for (;;) {
        sum = 0u; cnt = 0u; mine = 0u;
#pragma unroll
        for (unsigned j = 0; j < 16; ++j) { const unsigned c = xb_ld(&bar[XB_XCNT(j)]); sum += c; cnt += (c > 0u) ? 1u : 0u; mine = (j == x) ? c : mine; }
        if (sum == G) break;
        __builtin_amdgcn_s_sleep(1);
        if ((++sp & 255u) == 0u) { if (xb_ld(&bar[XB_TMO])) break; if (sp > XB_SPIN_CAP) { atomicAdd(&bar[XB_TMO], 1u); break; } }
    }
    nloc = mine > 0u ? mine : 1u; nx = cnt > 0u ? cnt : 1u;
}
__device__ __forceinline__ void xcd_barrier(const XcdBarrier& b) {
    asm volatile("s_waitcnt vmcnt(0)" ::: "memory");
    __syncthreads();
    if (threadIdx.x == 0) {
        unsigned* bar = b.bar;
        __builtin_amdgcn_s_waitcnt(0);
        unsigned nloc = b.st[0], nx = b.st[1];
        if (nloc == 0u) { xcd_barrier_complete(bar, b.x, nloc, nx); b.st[0] = nloc; b.st[1] = nx; }
        const unsigned old = xb_add(&bar[XB_XSUB(b.x)], 1u);
        const unsigned gen = old / nloc;
        if (old + 1u == (gen + 1u) * nloc) {
            __builtin_amdgcn_fence(__ATOMIC_RELEASE, "agent");
            asm volatile("s_waitcnt vmcnt(0)" ::: "memory");
            const unsigned og = xb_add(&bar[XB_TOP], 1u);
            const unsigned tg = og / nx;
            if (og + 1u == (tg + 1u) * nx) xb_add(&bar[XB_TOPGEN], 1u);
            else XB_SPIN(xb_ld(&bar[XB_TOPGEN]) == tg, bar);
            __builtin_amdgcn_fence(__ATOMIC_ACQUIRE, "agent");
            xb_add(&bar[XB_XGEN(b.x)], 1u);
            asm volatile("s_waitcnt vmcnt(0)" ::: "memory");
        } else {
            XB_SPIN(xb_ld(&bar[XB_XGEN(b.x)]) == gen, bar);
            __builtin_amdgcn_fence(__ATOMIC_ACQUIRE, "agent");
            asm volatile("s_waitcnt vmcnt(0)" ::: "memory");
        }
    }
    __syncthreads();
}

struct Args { const void* in[26]; float* out; unsigned char* ws; int ph_lo, ph_hi; };
struct Frame {
    LAS unsigned char* lds; char* ldsg;
    volatile LAS unsigned* MISC;
    int tid, lane, wave, vcu, G;
    unsigned char* ws; float* out;
};
#define IN_F(k) ((const float*)args.in[k])
#define IN_I(k) ((const int*)args.in[k])
#define WSP(T, off) ((T*)(F.ws + (off)))

namespace pg8 {
struct TileOrder {
    int nM, nN, nwg, G, c; const LAS int* blk_exp; const void* abase;
    __device__ __forceinline__ void init(int nM_, int nN_, int G_, int c_, const LAS int* be, const void* ab = nullptr) { nM = nM_; nN = nN_; nwg = nM * nN; G = G_; c = c_; blk_exp = be; abase = ab; }
    __device__ __forceinline__ const void* a_base(const Unit&) const { return abase; }
    __device__ __forceinline__ bool next(int i, Unit& u) const {
        const long L = (long)i * G + c; if (L >= nwg) return false;
        int wgid = (int)L; { const int q = nwg / NXCD, r = nwg % NXCD, xcd = wgid % NXCD, off = wgid / NXCD; wgid = (xcd < r ? xcd * (q + 1) : r * (q + 1) + (xcd - r) * q) + off; }
        const int nig = WGM * nN, gid = wgid / nig, fm = gid * WGM, gsz = (nM - fm) < WGM ? (nM - fm) : WGM;
        u.pm = fm + ((wgid % nig) % gsz); u.pn = (wgid % nig) / gsz; u.kind = 0;
        if (blk_exp) { const int e = __builtin_amdgcn_readfirstlane(blk_exp[u.pm]); u.pn += e * nN; }
        return true;
    }
    __device__ __forceinline__ void a_ready(const Unit&) const {}
    __device__ __forceinline__ void done(const Unit&) const {}
};

__device__ __forceinline__ void st16_wt(void* p, u32x4 v) { asm volatile("global_store_dwordx4 %0, %1, off sc1\n\ts_nop 1" :: "v"(p), "v"(v) : "memory"); }
struct EpiWin {
    static constexpr bool PERM = true, AFTER_DRAIN = false, MIDK = false; static constexpr int NSTORES = 16;
    bf16_t* E; const float* b_gate; int mode;
    __device__ __forceinline__ void operator()(const f32x4 (&acc)[2][2][4][2], const Unit& u, int wr, int wc, int fr, int fq) const {
        int row0 = u.pm * BM + wr * 64 + fr;
        asm volatile("" : "+v"(row0));
        if (mode == 1 && u.pn >= 8) {
            const int d0 = (u.pn - 8) * 128 + wc * 32 + 8 * fq;
            bf16_t* Rb = E + (size_t)5 * ((size_t)16384 * 1024); bf16_t* Sb = E + (size_t)6 * ((size_t)16384 * 1024);
            f32x4 b0[2], b1[2];
#pragma unroll
            for (int n = 0; n < 2; ++n) { b0[n] = *(const f32x4*)(b_gate + d0 + 4 * n); b1[n] = *(const f32x4*)(b_gate + 1024 + d0 + 4 * n); }
#pragma unroll
            for (int ai = 0; ai < 2; ++ai)
#pragma unroll
                for (int m = 0; m < 4; ++m) { const size_t ro = (size_t)(row0 + ai * HALF + m * 16) * 1024 + d0;
                    float r[8], s1[8];
#pragma unroll
                    for (int n = 0; n < 2; ++n)
#pragma unroll
                        for (int j = 0; j < 4; j += 2) { const f32x2 x0 = (f32x2){acc[ai][0][m][n][j], acc[ai][0][m][n][j + 1]} + (f32x2){b0[n][j], b0[n][j + 1]}, x1 = (f32x2){acc[ai][1][m][n][j], acc[ai][1][m][n][j + 1]} + (f32x2){b1[n][j], b1[n][j + 1]};
                            const f32x2 z0 = x0 * (-1.4426950408889634f), z1 = x1 * (-1.4426950408889634f);
                            f32x2 e0, e1; e0.x = __builtin_amdgcn_exp2f(z0.x); e0.y = __builtin_amdgcn_exp2f(z0.y); e1.x = fminf(__builtin_amdgcn_exp2f(z1.x), 1e18f); e1.y = fminf(__builtin_amdgcn_exp2f(z1.y), 1e18f);
                            const f32x2 dn0 = e0 + 1.0f, dn1 = e1 + 1.0f; f32x2 q0, q1; q0.x = __builtin_amdgcn_rcpf(dn0.x); q0.y = __builtin_amdgcn_rcpf(dn0.y); q1.x = __builtin_amdgcn_rcpf(dn1.x); q1.y = __builtin_amdgcn_rcpf(dn1.y);
                            const f32x2 rr = dn1 * q0; r[4 * n + j] = rr.x; r[4 * n + j + 1] = rr.y; s1[4 * n + j] = q1.x; s1[4 * n + j + 1] = q1.y; }
                    u32x4 w; w.x = cvt_pk_bf16(r[0], r[1]); w.y = cvt_pk_bf16(r[2], r[3]); w.z = cvt_pk_bf16(r[4], r[5]); w.w = cvt_pk_bf16(r[6], r[7]); *(u32x4*)(Rb + ro) = w;
                    u32x4 v; v.x = cvt_pk_bf16(s1[0], s1[1]); v.y = cvt_pk_bf16(s1[2], s1[3]); v.z = cvt_pk_bf16(s1[4], s1[5]); v.w = cvt_pk_bf16(s1[6], s1[7]); *(u32x4*)(Sb + ro) = v; }
            return;
        }
        const int opn = mode == 0 ? (u.pn < 8 ? u.pn : u.pn + 8) : u.pn + 8;
        const int t = opn >> 2, colt = (opn & 3) * BM;
        bf16_t* base = E + (size_t)t * ((size_t)16384 * 1024);
        const int col0 = colt + wc * 32 + 8 * fq;
#pragma unroll
        for (int ai = 0; ai < 2; ++ai)
#pragma unroll
            for (int m = 0; m < 4; ++m) { bf16_t* rowp = base + (size_t)(row0 + ai * HALF + m * 16) * 1024 + col0;
#pragma unroll
                for (int bj = 0; bj < 2; ++bj) { f32x4 v0 = acc[ai][bj][m][0], v1 = acc[ai][bj][m][1];
                    if (t == 1) { const f32x2 a = gelu_tanh_pk((f32x2){v0[0], v0[1]}), b = gelu_tanh_pk((f32x2){v0[2], v0[3]}), c = gelu_tanh_pk((f32x2){v1[0], v1[1]}), d = gelu_tanh_pk((f32x2){v1[2], v1[3]});
                        v0 = (f32x4){a.x, a.y, b.x, b.y}; v1 = (f32x4){c.x, c.y, d.x, d.y}; }
                    u32x4 w; w.x = cvt_pk_bf16(v0[0], v0[1]); w.y = cvt_pk_bf16(v0[2], v0[3]); w.z = cvt_pk_bf16(v1[0], v1[1]); w.w = cvt_pk_bf16(v1[2], v1[3]);
                    *(u32x4*)(rowp + bj * HALF) = w; } }
    }
};
struct EpiBranch {
    static constexpr bool PERM = true, AFTER_DRAIN = false, MIDK = true; static constexpr int NSTORES = 16;
    const bf16_t* R; const bf16_t* S1; bf16_t* MIX;
    __device__ __forceinline__ void mid(f32x4 (&acc)[2][2][4][2], const Unit& u, int wr, int wc, int fr, int fq) const {
        int row0 = u.pm * BM + wr * 64 + fr; const int col0 = u.pn * BM + wc * 32 + 8 * fq;
        asm volatile("" : "+v"(row0));
#pragma unroll
        for (int ai = 0; ai < 2; ++ai) { u32x4 a[4][2];
#pragma unroll
            for (int m = 0; m < 4; ++m)
#pragma unroll
                for (int bj = 0; bj < 2; ++bj) a[m][bj] = *(const u32x4*)(R + (size_t)(row0 + ai * HALF + m * 16) * 1024 + col0 + bj * HALF);
#pragma unroll
            for (int m = 0; m < 4; ++m)
#pragma unroll
                for (int bj = 0; bj < 2; ++bj) { acc[ai][bj][m][0] *= (f32x4){bflo(a[m][bj].x), bfhi(a[m][bj].x), bflo(a[m][bj].y), bfhi(a[m][bj].y)}; acc[ai][bj][m][1] *= (f32x4){bflo(a[m][bj].z), bfhi(a[m][bj].z), bflo(a[m][bj].w), bfhi(a[m][bj].w)}; }
            asm volatile("" ::: "memory"); }
    }
    __device__ __forceinline__ void operator()(const f32x4 (&acc)[2][2][4][2], const Unit& u, int wr, int wc, int fr, int fq) const {
        int row0 = u.pm * BM + wr * 64 + fr; const int col0 = u.pn * BM + wc * 32 + 8 * fq;
        asm volatile("" : "+v"(row0));
#pragma unroll
        for (int ai = 0; ai < 2; ++ai) { u32x4 b[4][2];
#pragma unroll
            for (int m = 0; m < 4; ++m)
#pragma unroll
                for (int bj = 0; bj < 2; ++bj) b[m][bj] = *(const u32x4*)(S1 + (size_t)(row0 + ai * HALF + m * 16) * 1024 + col0 + bj * HALF);
#pragma unroll
            for (int m = 0; m < 4; ++m)
#pragma unroll
                for (int bj = 0; bj < 2; ++bj) { const size_t o = (size_t)(row0 + ai * HALF + m * 16) * 1024 + col0 + bj * HALF;
                    const f32x4 v0 = acc[ai][bj][m][0] * (f32x4){bflo(b[m][bj].x), bfhi(b[m][bj].x), bflo(b[m][bj].y), bfhi(b[m][bj].y)}, v1 = acc[ai][bj][m][1] * (f32x4){bflo(b[m][bj].z), bfhi(b[m][bj].z), bflo(b[m][bj].w), bfhi(b[m][bj].w)};
                    u32x4 w; w.x = cvt_pk_bf16(v0[0], v0[1]); w.y = cvt_pk_bf16(v0[2], v0[3]); w.z = cvt_pk_bf16(v1[0], v1[1]); w.w = cvt_pk_bf16(v1[2], v1[3]);
                    *(u32x4*)(MIX + o) = w; }
            asm volatile("" ::: "memory"); }
    }
};
struct EpiWout {
    static constexpr bool PERM = true, AFTER_DRAIN = false, MIDK = false; static constexpr int NSTORES = 16;
    bf16_t* D1; const float* mod;
    __device__ __forceinline__ void operator()(const f32x4 (&acc)[2][2][4][2], const Unit& u, int wr, int wc, int fr, int fq) const {
        int row0 = u.pm * BM + wr * 64 + fr; const int col0 = u.pn * BM + wc * 32 + 8 * fq;
        asm volatile("" : "+v"(row0));
        const float* g1p = mod + (size_t)(u.pm >> 4) * 6144 + 2048;
        f32x4 gv[2][2];
#pragma unroll
        for (int bj = 0; bj < 2; ++bj)
#pragma unroll
            for (int n = 0; n < 2; ++n) gv[bj][n] = *(const f32x4*)(g1p + col0 + bj * HALF + 4 * n);
#pragma unroll
        for (int ai = 0; ai < 2; ++ai)
#pragma unroll
            for (int m = 0; m < 4; ++m) { bf16_t* rowp = D1 + (size_t)(row0 + ai * HALF + m * 16) * 1024 + col0;
#pragma unroll
                for (int bj = 0; bj < 2; ++bj) { const f32x4 v0 = acc[ai][bj][m][0] * gv[bj][0], v1 = acc[ai][bj][m][1] * gv[bj][1];
                    u32x4 w; w.x = cvt_pk_bf16(v0[0], v0[1]); w.y = cvt_pk_bf16(v0[2], v0[3]); w.z = cvt_pk_bf16(v1[0], v1[1]); w.w = cvt_pk_bf16(v1[2], v1[3]);
                    *(u32x4*)(rowp + bj * HALF) = w; } }
    }
};
__device__ __forceinline__ unsigned pk_fp8x4(float a, float b, float c, float d) { int p = __builtin_amdgcn_cvt_pk_fp8_f32(a, b, 0, false); p = __builtin_amdgcn_cvt_pk_fp8_f32(c, d, p, true); return (unsigned)p; }
struct EpiUp {
    static constexpr bool PERM = true, AFTER_DRAIN = false, MIDK = false; static constexpr int NSTORES = 8;
    unsigned char* ACT; const float* b_up;
    __device__ __forceinline__ void operator()(const f32x4 (&acc)[2][2][4][2], const Unit& u, int wr, int wc, int fr, int fq) const {
        const int e = u.pn >> 3, p = u.pn & 7;
        int row0 = u.pm * BM + wr * 64 + fr; const int c0 = p * 128 + wc * 32 + 8 * fq;
        asm volatile("" : "+v"(row0));
        const float* bg = b_up + (size_t)e * 2048 + c0; const float* bl = bg + 1024;
        f32x4 bgv[2], blv[2];
#pragma unroll
        for (int n = 0; n < 2; ++n) { bgv[n] = *(const f32x4*)(bg + 4 * n); blv[n] = *(const f32x4*)(bl + 4 * n) + 1.0f; }
#pragma unroll
        for (int ai = 0; ai < 2; ++ai)
#pragma unroll
            for (int m = 0; m < 4; ++m) { unsigned char* rowp = ACT + (size_t)(row0 + ai * HALF + m * 16) * 1024 + c0;
                f32x4 a[2];
#pragma unroll
                for (int n = 0; n < 2; ++n) {
#pragma unroll
                    for (int j = 0; j < 4; j += 2) { f32x2 g = (f32x2){acc[ai][0][m][n][j], acc[ai][0][m][n][j + 1]} + (f32x2){bgv[n][j], bgv[n][j + 1]};
                        f32x2 l = (f32x2){acc[ai][1][m][n][j], acc[ai][1][m][n][j + 1]} + (f32x2){blv[n][j], blv[n][j + 1]};
                        g.x = fminf(g.x, 7.0f); g.y = fminf(g.y, 7.0f); l.x = __builtin_amdgcn_fmed3f(l.x, -6.0f, 8.0f); l.y = __builtin_amdgcn_fmed3f(l.y, -6.0f, 8.0f);
                        const f32x2 z = g * (-1.702f * 1.4426950408889634f); f32x2 e; e.x = __builtin_amdgcn_exp2f(z.x); e.y = __builtin_amdgcn_exp2f(z.y);
                        const f32x2 d = e + 1.0f; f32x2 r; r.x = __builtin_amdgcn_rcpf(d.x); r.y = __builtin_amdgcn_rcpf(d.y);
                        const f32x2 o = (l * g) * r; a[n][j] = o.x; a[n][j + 1] = o.y; } }
                typedef unsigned u32x2_t __attribute__((ext_vector_type(2)));
                u32x2_t w; w.x = pk_fp8x4(a[0][0], a[0][1], a[0][2], a[0][3]); w.y = pk_fp8x4(a[1][0], a[1][1], a[1][2], a[1][3]);
                *(u32x2_t*)rowp = w; }
    }
};
struct EpiDown {
    static constexpr bool PERM = true, AFTER_DRAIN = false, MIDK = false; static constexpr int NSTORES = 16;
    unsigned char* YR; const float* b_down; const float* row_gate; const LAS int* tbl; LAS unsigned char* stage;
    __device__ __forceinline__ void operator()(const f32x4 (&acc)[2][2][4][2], const Unit& u, int wr, int wc, int fr, int fq) const {
        const int e = u.pn >> 2, p = u.pn & 3;
        int row0 = u.pm * BM + wr * 64 + fr; const int c0 = p * BM + wc * 32 + 8 * fq;
        asm volatile("" : "+v"(row0));
        const int pos0 = row0 - tbl[32 + e] * 256, cnt = tbl[e];
        const float* gp = row_gate + (size_t)e * 16384 + pos0;
        float gt[2][4];
#pragma unroll
        for (int ai = 0; ai < 2; ++ai)
#pragma unroll
            for (int m = 0; m < 4; ++m) { const int o = ai * HALF + m * 16; gt[ai][m] = (pos0 + o < cnt) ? gp[o] * 16.0f : 0.0f; }
        f32x4 bv[2][2];
#pragma unroll
        for (int bj = 0; bj < 2; ++bj)
#pragma unroll
            for (int n = 0; n < 2; ++n) bv[bj][n] = *(const f32x4*)(b_down + (size_t)e * 1024 + c0 + bj * HALF + 4 * n);
        typedef unsigned u32x2_t __attribute__((ext_vector_type(2)));
        const int lane = (int)(threadIdx.x & 63), wv = (int)(threadIdx.x >> 6);
        LAS unsigned char* stg = stage + wv * 1024;
        const int srow = lane >> 2, sch = lane & 3;
#pragma unroll
        for (int ai = 0; ai < 2; ++ai)
#pragma unroll
            for (int m = 0; m < 4; ++m) { const float g = gt[ai][m];
#pragma unroll
                for (int bj = 0; bj < 2; ++bj) { const f32x4 v0 = (acc[ai][bj][m][0] + bv[bj][0]) * g, v1 = (acc[ai][bj][m][1] + bv[bj][1]) * g;
                    u32x2_t w; w.x = pk_fp8x4(v0[0], v0[1], v0[2], v0[3]); w.y = pk_fp8x4(v1[0], v1[1], v1[2], v1[3]);
                    *(LAS u32x2_t*)(stg + fr * 64 + bj * 32 + 8 * fq) = w; }
                asm volatile("s_waitcnt lgkmcnt(0)" ::: "memory");
                const u32x4 o = *(const LAS u32x4*)(stg + srow * 64 + sch * 16);
                asm volatile("s_waitcnt lgkmcnt(0)" ::: "memory");
                const int r = u.pm * BM + wr * 64 + ai * HALF + m * 16 + srow;
                *(u32x4*)(YR + (size_t)r * 1024 + p * BM + wc * 32 + (sch >> 1) * HALF + (sch & 1) * 16) = o; }
    }
};
}

__device__ __forceinline__ void p0_transpose_item(const float* W, int N, bf16* WT, int Kd, size_t dst_row0, LAS float* scr, int k0, int n0, int lane) {
#pragma unroll 8
    for (int i = 0; i < 32; ++i) { const int kk = 2 * i + (lane >> 5); scr[kk * 33 + (lane & 31)] = W[(size_t)(k0 + kk) * N + n0 + (lane & 31)]; }
    LDS_WAIT(); asm volatile("" ::: "memory");
    const int c = lane & 7;
#pragma unroll
    for (int j = 0; j < 4; ++j) { const int n = (lane >> 3) + 8 * j; const LAS float* s = scr + (8 * c) * 33 + n;
        v4u o; o.x = pk2(s[0 * 33], s[1 * 33]); o.y = pk2(s[2 * 33], s[3 * 33]); o.z = pk2(s[4 * 33], s[5 * 33]); o.w = pk2(s[6 * 33], s[7 * 33]);
        *(GAS v4u*)(WT + (dst_row0 + n) * (size_t)Kd + k0 + 8 * c) = o; }
    LDS_WAIT(); asm volatile("" ::: "memory");
}
__device__ __forceinline__ void p8_transpose_item_fp8(const float* W, int N, unsigned char* WT, int Kd, size_t dst_row0, LAS float* scr, int k0, int n0, int lane) {
#pragma unroll 8
    for (int i = 0; i < 32; ++i) { const int kk = 2 * i + (lane >> 5); scr[kk * 33 + (lane & 31)] = W[(size_t)(k0 + kk) * N + n0 + (lane & 31)] * 64.0f; }
    LDS_WAIT(); asm volatile("" ::: "memory");
    const int c = lane & 7;
#pragma unroll
    for (int j = 0; j < 4; ++j) { const int n = (lane >> 3) + 8 * j; const LAS float* s = scr + (8 * c) * 33 + n;
        v2u o; o.x = pg8::pk_fp8x4(s[0 * 33], s[1 * 33], s[2 * 33], s[3 * 33]); o.y = pg8::pk_fp8x4(s[4 * 33], s[5 * 33], s[6 * 33], s[7 * 33]);
        *(GAS v2u*)(WT + (dst_row0 + n) * (size_t)Kd + k0 + 8 * c) = o; }
    LDS_WAIT(); asm volatile("" ::: "memory");
}
__device__ __forceinline__ void p0_prologue(Frame& F, const Args& args) {
    const float* c_in = IN_F(1); const int* pos = IN_I(2); const float* ada_w = IN_F(3); const float* ada_b = IN_F(4);
    for (int task = F.vcu; task < 192; task += F.G) {
        LAS float* sc = (LAS float*)F.lds;
        LAS float* red = (LAS float*)(F.lds + 16384);
        for (int i = F.tid; i < 4096; i += 512) { const float v = c_in[i]; sc[i] = v / (1.0f + expf(-v)); }
        __syncthreads();
        const int colq = F.lane & 7, kq = F.lane >> 3, col = task * 32 + colq * 4;
        float acc[4][4];
#pragma unroll
        for (int b = 0; b < 4; ++b)
#pragma unroll
            for (int j = 0; j < 4; ++j) acc[b][j] = 0.f;
#pragma unroll 8
        for (int s = 0; s < 16; ++s) { const int k = F.wave * 128 + s * 8 + kq; const f32x4 wv = *(const f32x4*)(ada_w + (size_t)k * 6144 + col);
#pragma unroll
            for (int b = 0; b < 4; ++b) { const float sv = sc[b * 1024 + k];
#pragma unroll
                for (int j = 0; j < 4; ++j) acc[b][j] += sv * wv[j]; } }
#pragma unroll
        for (int b = 0; b < 4; ++b)
#pragma unroll
            for (int j = 0; j < 4; ++j) { float v = acc[b][j]; v += __shfl_xor(v, 8); v += __shfl_xor(v, 16); v += __shfl_xor(v, 32); if (kq == 0) red[(F.wave * 4 + b) * 32 + colq * 4 + j] = v; }
        __syncthreads();
        if (F.tid < 128) { const int b = F.tid >> 5, cc = F.tid & 31; float s = ada_b[task * 32 + cc];
#pragma unroll
            for (int w = 0; w < 8; ++w) s += red[(w * 4 + b) * 32 + cc];
            WSP(float, WS_MOD)[b * 6144 + task * 32 + cc] = s; }
        VM_WAIT(); __syncthreads();
        if (F.tid == 0) { __builtin_amdgcn_fence(__ATOMIC_RELEASE, "agent"); VM_WAIT(); __hip_atomic_fetch_add((unsigned*)(F.ws + WS_CTL) + CW_MODCNT, 1u, RLX_AGENT); }
    }
    const int gt = F.vcu * 512 + F.tid, NGT = F.G * 512;
    for (int idx = gt; idx < NTOK * 16; idx += NGT) { const int m = idx >> 4, i = idx & 15;
        double freq = 1.0; for (int q = 0; q < i; ++q) freq *= 0.44036660267178046;
        const double ang = (double)pos[m] * freq; const double nr = __builtin_rint(ang * 0.15915494309189535);
        const float r = (float)__builtin_fma(-nr, 6.283185307179586, ang);
        float sn, cs; sincosf(r, &sn, &cs);
        WSP(float, WS_TRIG)[m * 32 + i] = cs; WSP(float, WS_TRIG)[m * 32 + 16 + i] = sn; }
    { const float* wr = IN_F(20); for (int idx = gt; idx < 32 * 1024; idx += NGT) { const int e = idx >> 10, k = idx & 1023; const float w = wr[k * 32 + e];
        const unsigned hi = f2bf(w); const float rem = w - __builtin_bit_cast(float, hi << 16); WSP(bf16, WS_WRH)[idx] = (bf16)hi; WSP(bf16, WS_WRL)[idx] = (bf16)f2bf(rem); } }
    LAS float* scr = (LAS float*)(F.lds + 32768 + F.wave * 8704);
    const int gw = F.vcu * NWAVES + F.wave, NGW = F.G * NWAVES;
    constexpr int I_IN = 16 * 224, I_RG = 128, I_B = 1024, I_O = 512;
    constexpr int NITEMS = I_IN + I_RG + I_B + I_O;
    for (int it = gw; it < NITEMS; it += NGW) {
        int r = it;
        if (r < I_IN) { const int kb = r / 224, nb = r % 224, n0 = nb * 32;
            if (n0 < 2048 || (n0 >= 4096 && n0 < 5120)) p0_transpose_item(IN_F(7), DIN, WSP(bf16, WS_WIN), 1024, (size_t)(n0 < 2048 ? n0 : n0 - 2048), scr, kb * 64, n0, F.lane);
            else { const int gl = n0 - 5120;
                const size_t row = n0 < 4096 ? (size_t)(n0 - 2048) : (size_t)(2048 + ((gl & 1023) >> 7) * 256 + (gl >> 10) * 128 + (gl & 127));
                p8_transpose_item_fp8(IN_F(7), DIN, WSP(unsigned char, WS_WIN8), 1024, row, scr, kb * 64, n0, F.lane); }
            continue; } r -= I_IN;
        if (r < I_RG) { const int mat = r >> 6, blk = (r >> 3) & 7, kb = (r >> 2) & 1, nb = r & 3;
            p0_transpose_item(IN_F(mat ? 12 : 10) + (size_t)blk * 16384, 128, WSP(bf16, WS_WRG) + (size_t)(mat * 8 + blk) * 16384, 128, (size_t)nb * 32, scr, kb * 64, nb * 32, F.lane); continue; } r -= I_RG;
        if (r < I_B) { const int g = r >> 9, q = r & 511, kb = q >> 5, nb = q & 31;
            p0_transpose_item(IN_F(18) + (size_t)g * 1048576, 1024, WSP(bf16, WS_WB) + (size_t)g * 1024, 2048, (size_t)nb * 32, scr, kb * 64, nb * 32, F.lane); continue; } r -= I_B;
        { const int kb = r >> 5, nb = r & 31; p0_transpose_item(IN_F(19), 1024, WSP(bf16, WS_WO), 1024, (size_t)nb * 32, scr, kb * 64, nb * 32, F.lane); }
    }
}
struct WItem { const float* src; unsigned char* dst; int N; };
__device__ __forceinline__ WItem p8_item(const Args& args, unsigned char* ws, int it) {
    WItem w;
    if (it < 32 * 1024) { const int e = it >> 10, q = it & 1023, kb = q >> 6, nb = q & 63, n0 = nb * 32;
        const int bj = n0 >> 10, p = (n0 & 1023) >> 7, oo = n0 & 127;
        w.src = IN_F(22) + (size_t)e * 2097152 + (size_t)(kb * 64) * 2048 + n0; w.N = 2048;
        w.dst = ws + WS_WUP + (size_t)e * 2097152 + (size_t)(p * 256 + bj * 128 + oo) * 1024 + kb * 64; }
    else { const int r = it - 32 * 1024, e = r >> 9, q = r & 511, kb = q >> 5, nb = q & 31;
        w.src = IN_F(24) + (size_t)e * 1048576 + (size_t)(kb * 64) * 1024 + nb * 32; w.N = 1024;
        w.dst = ws + WS_WDN + (size_t)e * 1048576 + (size_t)(nb * 32) * 1024 + kb * 64; }
    return w;
}
__device__ __forceinline__ void p8_load(const WItem& w, f32x4 (&v)[8], int lane) {
#pragma unroll
    for (int i = 0; i < 8; ++i) v[i] = __builtin_nontemporal_load((const f32x4*)(w.src + (size_t)((lane >> 3) + 8 * i) * w.N + (lane & 7) * 4));
}
__device__ __forceinline__ void p8_store(const WItem& w, const f32x4 (&v)[8], LAS float* scr, int lane) {
#pragma unroll
    for (int i = 0; i < 8; ++i) { LAS float* d = scr + ((lane >> 3) + 8 * i) * 33 + (lane & 7) * 4; d[0] = v[i].x * 64.0f; d[1] = v[i].y * 64.0f; d[2] = v[i].z * 64.0f; d[3] = v[i].w * 64.0f; }
    LDS_WAIT(); asm volatile("" ::: "memory");
    const int c = lane & 7;
#pragma unroll
    for (int j = 0; j < 4; ++j) { const int n = (lane >> 3) + 8 * j; const LAS float* s = scr + (8 * c) * 33 + n;
        v2u o; o.x = pg8::pk_fp8x4(s[0 * 33], s[1 * 33], s[2 * 33], s[3 * 33]); o.y = pg8::pk_fp8x4(s[4 * 33], s[5 * 33], s[6 * 33], s[7 * 33]);
        __builtin_nontemporal_store(o, (v2u*)(w.dst + (size_t)n * 1024 + 8 * c)); }
    LDS_WAIT(); asm volatile("" ::: "memory");
}
constexpr int P8_ITEMS = 32 * 1024 + 32 * 512, P8_CHUNK = 128, P8_NCHUNK = P8_ITEMS / P8_CHUNK;
__device__ __forceinline__ void p8_chunk(Frame& F, const Args& args, int ch) {
    LAS float* scr = (LAS float*)(F.lds + 32768 + F.wave * 8704);
    const int it0 = ch * P8_CHUNK + F.wave * 16;
    f32x4 v0[8], v1[8], v2[8], v3[8];
    p8_load(p8_item(args, F.ws, it0), v0, F.lane); p8_load(p8_item(args, F.ws, it0 + 1), v1, F.lane); p8_load(p8_item(args, F.ws, it0 + 2), v2, F.lane); p8_load(p8_item(args, F.ws, it0 + 3), v3, F.lane);
#pragma unroll 1
    for (int j = 0; j < 16; j += 4) { const bool more = j + 4 < 16;
        p8_store(p8_item(args, F.ws, it0 + j), v0, scr, F.lane); if (more) p8_load(p8_item(args, F.ws, it0 + j + 4), v0, F.lane);
        p8_store(p8_item(args, F.ws, it0 + j + 1), v1, scr, F.lane); if (more) p8_load(p8_item(args, F.ws, it0 + j + 5), v1, F.lane);
        p8_store(p8_item(args, F.ws, it0 + j + 2), v2, scr, F.lane); if (more) p8_load(p8_item(args, F.ws, it0 + j + 6), v2, F.lane);
        p8_store(p8_item(args, F.ws, it0 + j + 3), v3, scr, F.lane); if (more) p8_load(p8_item(args, F.ws, it0 + j + 7), v3, F.lane);
    }
}
__device__ __forceinline__ void p8_moe_weights(Frame& F, const Args& args) {
    for (int ch = F.vcu; ch < P8_NCHUNK; ch += F.G) p8_chunk(F, args, ch);
}

__device__ __forceinline__ void p1_hrows(Frame& F, const Args& args) {
    if (F.tid == 0) { unsigned* mc = (unsigned*)(F.ws + WS_CTL) + CW_MODCNT; unsigned sp = 0; while (__hip_atomic_load(mc, RLX_AGENT) < 192u && ++sp < (1u << 22)) __builtin_amdgcn_s_sleep(2);
        __builtin_amdgcn_fence(__ATOMIC_ACQUIRE, "agent"); VM_WAIT(); }
    __syncthreads();
    const float* x = IN_F(0); const float* g1n = IN_F(5); const float* mod = WSP(float, WS_MOD); bf16* H = WSP(bf16, WS_HB); unsigned char* H8 = WSP(unsigned char, WS_H8);
    const int gw = F.vcu * NWAVES + F.wave, NGW = F.G * NWAVES;
    f32x4 v0[4], v1[4], n0[4], n1[4];
#define P1_LOADX(ma, mb, A, B) do { const f32x4* xa_ = (const f32x4*)(x + (size_t)(ma) * DM) + F.lane; const f32x4* xb_ = (const f32x4*)(x + (size_t)(mb) * DM) + F.lane; \
        _Pragma("unroll") for (int j_ = 0; j_ < 4; ++j_) { A[j_] = xa_[64 * j_]; B[j_] = xb_[64 * j_]; } } while (0)
    int m0 = gw;
    if (m0 < NTOK) { const int m1 = (m0 + NGW < NTOK) ? m0 + NGW : m0; P1_LOADX(m0, m1, v0, v1); }
    for (; m0 < NTOK; m0 += 2 * NGW) {
        const bool has1 = m0 + NGW < NTOK; const int m1 = has1 ? m0 + NGW : m0;
        const int b0 = m0 >> 12, b1 = m1 >> 12;
        f32x4 g[4], sh0[4], sc0[4], sh1[4], sc1[4];
#pragma unroll
        for (int j = 0; j < 4; ++j) { const int col = 4 * F.lane + 256 * j; g[j] = *(const f32x4*)(g1n + col);
            sh0[j] = *(const f32x4*)(mod + b0 * 6144 + col); sc0[j] = *(const f32x4*)(mod + b0 * 6144 + 1024 + col); sh1[j] = *(const f32x4*)(mod + b1 * 6144 + col); sc1[j] = *(const f32x4*)(mod + b1 * 6144 + 1024 + col); }
        const int p0 = m0 + 2 * NGW; const bool hasn = p0 < NTOK;
        if (hasn) { const int p1 = (p0 + NGW < NTOK) ? p0 + NGW : p0; P1_LOADX(p0, p1, n0, n1); }
        float s0 = 0.f, s1 = 0.f;
#pragma unroll
        for (int j = 0; j < 4; ++j) { s0 += (v0[j].x * v0[j].x + v0[j].y * v0[j].y) + (v0[j].z * v0[j].z + v0[j].w * v0[j].w); s1 += (v1[j].x * v1[j].x + v1[j].y * v1[j].y) + (v1[j].z * v1[j].z + v1[j].w * v1[j].w); }
#pragma unroll
        for (int o = 1; o < 64; o <<= 1) { s0 += __shfl_xor(s0, o); s1 += __shfl_xor(s1, o); }
        const float r0 = 1.0f / sqrtf(s0 * (1.f / DM) + EPS), r1 = 1.0f / sqrtf(s1 * (1.f / DM) + EPS);
        unsigned long long* o0 = (unsigned long long*)(H + (size_t)m0 * DM) + F.lane; unsigned long long* o1 = (unsigned long long*)(H + (size_t)m1 * DM) + F.lane;
#pragma unroll
        for (int j = 0; j < 4; ++j) {
            const f32x4 h0 = v0[j] * r0 * g[j] * (sc0[j] + 1.0f) + sh0[j], h1 = v1[j] * r1 * g[j] * (sc1[j] + 1.0f) + sh1[j];
            o0[64 * j] = (unsigned long long)cvtpk(h0.x, h0.y) | ((unsigned long long)cvtpk(h0.z, h0.w) << 32);
            ((unsigned*)(H8 + (size_t)m0 * DM))[F.lane + 64 * j] = pg8::pk_fp8x4(h0.x, h0.y, h0.z, h0.w);
            if (has1) { o1[64 * j] = (unsigned long long)cvtpk(h1.x, h1.y) | ((unsigned long long)cvtpk(h1.z, h1.w) << 32);
                ((unsigned*)(H8 + (size_t)m1 * DM))[F.lane + 64 * j] = pg8::pk_fp8x4(h1.x, h1.y, h1.z, h1.w); } }
#pragma unroll
        for (int j = 0; j < 4; ++j) { v0[j] = n0[j]; v1[j] = n1[j]; }
    }
#undef P1_LOADX
}

__device__ __forceinline__ void p3_knorm_unit(Frame& F, const Args& args, int unit) {
    const int h = unit & 7, j = (unit >> 3) & 15, b = unit >> 7;
    bf16* KR = WSP(bf16, WS_E) + 3 * E_STRIDE; const float* trig = WSP(float, WS_TRIG); const float* kg = IN_F(16);
    const int rsub = F.lane >> 4, c16 = F.lane & 15;
    float gk[8];
#pragma unroll
    for (int i = 0; i < 8; ++i) gk[i] = kg[c16 * 8 + i];
    float km[8];
#pragma unroll
    for (int i = 0; i < 8; ++i) km[i] = 0.f;
    const int fi = (c16 & 1) * 8;
    v4u raw[4]; f32x4 tcs[4][4]; v4u outp[4];
#define KN_LOAD(bt_) do { _Pragma("unroll") for (int i4 = 0; i4 < 4; ++i4) { const int m_ = b * SEQ + j * 256 + F.wave * 32 + ((bt_) * 4 + i4) * 4 + rsub; \
        raw[i4] = *(const v4u*)(KR + (size_t)m_ * DM + h * HD + c16 * 8); const float* tp_ = trig + (size_t)m_ * 32 + fi; \
        tcs[i4][0] = *(const f32x4*)tp_; tcs[i4][1] = *(const f32x4*)(tp_ + 4); tcs[i4][2] = *(const f32x4*)(tp_ + 16); tcs[i4][3] = *(const f32x4*)(tp_ + 20); } } while (0)
    KN_LOAD(0);
#pragma unroll
    for (int bt = 0; bt < 2; ++bt) {
#pragma unroll
        for (int i4 = 0; i4 < 4; ++i4) {
            float v[8] = {bflo(raw[i4].x), bfhi(raw[i4].x), bflo(raw[i4].y), bfhi(raw[i4].y), bflo(raw[i4].z), bfhi(raw[i4].z), bflo(raw[i4].w), bfhi(raw[i4].w)};
            float ss = 0.f;
#pragma unroll
            for (int i = 0; i < 8; ++i) ss += v[i] * v[i];
            ss += __shfl_xor(ss, 1); ss += __shfl_xor(ss, 2); ss += __shfl_xor(ss, 4); ss += __shfl_xor(ss, 8);
            const float rstd = 1.0f / sqrtf(ss * (1.f / HD) + EPS);
#pragma unroll
            for (int i = 0; i < 8; ++i) v[i] = v[i] * rstd * gk[i];
#pragma unroll
            for (int i = 0; i < 8; ++i) { const float other = __shfl_xor(v[i], 2); const float cs = tcs[i4][i >> 2][i & 3], sn = tcs[i4][2 + (i >> 2)][i & 3];
                if (c16 < 4) v[i] = (c16 < 2) ? (v[i] * cs - other * sn) : (v[i] * cs + other * sn); }
#pragma unroll
            for (int i = 0; i < 8; ++i) km[i] += v[i];
            outp[i4].x = cvtpk(v[0], v[1]); outp[i4].y = cvtpk(v[2], v[3]); outp[i4].z = cvtpk(v[4], v[5]); outp[i4].w = cvtpk(v[6], v[7]); }
        if (bt == 0) KN_LOAD(1);
#pragma unroll
        for (int i4 = 0; i4 < 4; ++i4) { const int m = b * SEQ + j * 256 + F.wave * 32 + (bt * 4 + i4) * 4 + rsub; *(v4u*)(KR + (size_t)m * DM + h * HD + c16 * 8) = outp[i4]; }
    }
#undef KN_LOAD
    LAS float* red = (LAS float*)(F.lds + XTRA_OFF);
#pragma unroll
    for (int i = 0; i < 8; ++i) { float v = km[i]; v += __shfl_xor(v, 16); v += __shfl_xor(v, 32); if (rsub == 0) red[F.wave * 128 + c16 * 8 + i] = v; }
    __syncthreads();
    if (F.tid < 128) { float s = 0.f;
#pragma unroll
        for (int w = 0; w < 8; ++w) s += red[w * 128 + F.tid];
        WSP(float, WS_KMEAN)[((size_t)(b * NH + h) * 16 + j) * HD + F.tid] = s * (1.f / 256.f); }
    __syncthreads();
}

__device__ __forceinline__ void p3_rnn_local_unit(Frame& F, const Args& args, int unit) {
    const int n = unit & 7, c = (unit >> 3) & 15, b = unit >> 7;
    const int t0 = c * 256, m0 = b * SEQ + t0, ch0 = n * 128;
    const bf16* XR = WSP(bf16, WS_E);
    LAS unsigned char* At = F.lds;
    {
        const int cg = F.tid & 15, rs = F.tid >> 4; const int chb = ch0 + cg * 8;
        const float* cw = IN_F(8); const float* cb = IN_F(9);
        float w0[8], w1[8], w2[8], w3[8], bb[8];
#pragma unroll
        for (int i = 0; i < 8; ++i) { w0[i] = cw[chb + i]; w1[i] = cw[1024 + chb + i]; w2[i] = cw[2048 + chb + i]; w3[i] = cw[3072 + chb + i]; bb[i] = cb[chb + i]; }
        const int tr0 = t0 + rs * 8;
        v4u rw[11];
#pragma unroll
        for (int r = 0; r < 11; ++r) { const int tt = tr0 - 3 + r; rw[r] = *(const v4u*)(XR + (size_t)(b * SEQ + (tt < 0 ? 0 : tt)) * DM + chb); if (tt < 0) rw[r] = (v4u){0u, 0u, 0u, 0u}; }
#define UNP(dst, w_) do { dst[0] = bflo(w_.x); dst[1] = bfhi(w_.x); dst[2] = bflo(w_.y); dst[3] = bfhi(w_.y); dst[4] = bflo(w_.z); dst[5] = bfhi(w_.z); dst[6] = bflo(w_.w); dst[7] = bfhi(w_.w); } while (0)
        float p1[8], p2[8], p3[8];
        UNP(p3, rw[0]); UNP(p2, rw[1]); UNP(p1, rw[2]);
#pragma unroll
        for (int r = 0; r < 8; ++r) { float cur[8]; UNP(cur, rw[3 + r]);
            float xc[8];
#pragma unroll
            for (int i = 0; i < 8; ++i) xc[i] = bb[i] + w0[i] * cur[i] + w1[i] * p1[i] + w2[i] * p2[i] + w3[i] * p3[i];
            const int row = rs * 8 + r;
            v4u o; o.x = cvtpk(xc[0], xc[1]); o.y = cvtpk(xc[2], xc[3]); o.z = cvtpk(xc[4], xc[5]); o.w = cvtpk(xc[6], xc[7]);
            *(LAS v4u*)(At + row * 256 + ((cg ^ (row & 15)) << 4)) = o;
#pragma unroll
            for (int i = 0; i < 8; ++i) { p3[i] = p2[i]; p2[i] = p1[i]; p1[i] = cur[i]; } }
#undef UNP
    }
    __syncthreads();
    const int fr = F.lane & 15, fq = F.lane >> 4;
    const int vloc = F.wave * 16 + fr, ch = ch0 + vloc;
    const bf16* WA = WSP(bf16, WS_WRG) + (size_t)n * 16384 + (size_t)vloc * 128 + fq * 8;
    const bf16* WX = WA + 8 * 16384;
    bf16x8 Ba[4], Bx[4];
#pragma unroll
    for (int s = 0; s < 4; ++s) { Ba[s] = *(const bf16x8*)(WA + 32 * s); Bx[s] = *(const bf16x8*)(WX + 32 * s); }
    const float ba = IN_F(11)[ch], bx = IN_F(13)[ch];
    const float sp8 = 8.0f * log1pf(expf(-IN_F(14)[ch]));
    float cP = 1.f, cH = 0.f;
    bf16* HL = WSP(bf16, WS_HL); bf16* PP = WSP(bf16, WS_PP);
    LAS unsigned short* stg = (LAS unsigned short*)(F.lds + 65536);
    for (int rq = 0; rq < 4; ++rq) {
        LAS unsigned short* sb = stg + (rq & 1) * 16384;
#pragma unroll
        for (int ri = 0; ri < 4; ++ri) { const int rt = rq * 4 + ri;
            f32x4 accr = {0.f, 0.f, 0.f, 0.f}, accx = {0.f, 0.f, 0.f, 0.f};
            const int arow = rt * 16 + fr;
#pragma unroll
            for (int s = 0; s < 4; ++s) { const bf16x8 a = *(const LAS bf16x8*)(At + arow * 256 + (((fq + 4 * s) ^ (arow & 15)) << 4));
                accr = __builtin_amdgcn_mfma_f32_16x16x32_bf16(a, Ba[s], accr, 0, 0, 0);
                accx = __builtin_amdgcn_mfma_f32_16x16x32_bf16(a, Bx[s], accx, 0, 0, 0); }
            float pj[4], hj[4];
#pragma unroll
            for (int j = 0; j < 4; ++j) { const int row = rt * 16 + 4 * fq + j;
                const float xcv = bf2f(*(const LAS unsigned short*)(At + row * 256 + ((((vloc >> 3)) ^ (row & 15)) << 4) + (vloc & 7) * 2));
                const float r = fast_sigmoid(accr[j] + ba), ig = fast_sigmoid(accx[j] + bx);
                const float a = __builtin_amdgcn_exp2f(-sp8 * r * 1.4426950408889634f);
                float mult = __builtin_amdgcn_sqrtf(fmaxf(fmaf(-a, a, 1.0f), 0.0f)); if (t0 + row == 0) mult = 1.0f;
                const float u = mult * ig * xcv;
                pj[j] = (j ? pj[j - 1] : 1.0f) * a; hj[j] = (j ? hj[j - 1] * a : 0.0f) + u; }
            const float tp = pj[3], th = hj[3];
            const float pa = __shfl(tp, F.lane - 16), ha = __shfl(th, F.lane - 16);
            const float pb = __shfl(tp, F.lane - 32), hb = __shfl(th, F.lane - 32);
            const float pc = __shfl(tp, F.lane - 48), hc = __shfl(th, F.lane - 48);
            float Pq, Hq;
            if (fq == 0) { Pq = 1.f; Hq = 0.f; } else if (fq == 1) { Pq = pa; Hq = ha; } else if (fq == 2) { Pq = pb * pa; Hq = pa * hb + ha; } else { Pq = pc * pb * pa; Hq = pa * (pb * hc + hb) + ha; }
            const float hstart = Hq + Pq * cH, pstart = Pq * cP;
            float hl3 = 0.f, pp3 = 0.f;
#pragma unroll
            for (int j = 0; j < 4; ++j) { const float hv = hj[j] + pj[j] * hstart, pv = pj[j] * pstart; const int rl = ri * 16 + 4 * fq + j;
                const unsigned pk = cvtpk(hv, pv); sb[rl * 128 + vloc] = (unsigned short)pk; sb[8192 + rl * 128 + vloc] = (unsigned short)(pk >> 16); if (j == 3) { hl3 = hv; pp3 = pv; } }
            cH = __shfl(hl3, fr + 48); cP = __shfl(pp3, fr + 48);
        }
        __syncthreads();
#pragma unroll
        for (int q4 = 0; q4 < 4; ++q4) { const int idx = q4 * 512 + F.tid, arr = idx >> 10, rr = (idx >> 4) & 63, c16 = idx & 15;
            const v4u val = *(const LAS v4u*)(sb + arr * 8192 + rr * 128 + c16 * 8);
            bf16* dst = (arr ? PP : HL) + (size_t)(m0 + rq * 64 + rr) * DM + ch0 + c16 * 8;
            *(v4u*)dst = val; }
    }
    if (fq == 0) { WSP(float, WS_AGGP)[(size_t)(b * 16 + c) * 1024 + ch] = cP; WSP(float, WS_AGGH)[(size_t)(b * 16 + c) * 1024 + ch] = cH; }
    __syncthreads();
}

__device__ __forceinline__ void p4_rnn_final_unit(Frame& F, const Args& args, int unit) {
    const int n = unit & 7, c = (unit >> 3) & 15, b = unit >> 7;
    const int m0 = b * SEQ + c * 256, ch0 = n * 128;
    LAS float* car = (LAS float*)(F.lds + XTRA_OFF);
    if (F.tid < 128) { const int ch = ch0 + F.tid; float h = 0.f;
        for (int cc = 0; cc < c; ++cc) { const float p = WSP(float, WS_AGGP)[(size_t)(b * 16 + cc) * 1024 + ch], hh = WSP(float, WS_AGGH)[(size_t)(b * 16 + cc) * 1024 + ch]; h = p * h + hh; }
        car[F.tid] = h; }
    __syncthreads();
    const bf16* HL = WSP(bf16, WS_HL); const bf16* PP = WSP(bf16, WS_PP); const bf16* GG = WSP(bf16, WS_E) + E_STRIDE; bf16* Y = WSP(bf16, WS_YCAT);
    const int c16 = F.tid & 15, r0 = F.tid >> 4;
    float cv[8];
#pragma unroll
    for (int i = 0; i < 8; ++i) cv[i] = car[c16 * 8 + i];
    v4u hl[8], pp[8], gg[8];
#pragma unroll
    for (int it = 0; it < 8; ++it) { const size_t o = (size_t)(m0 + it * 32 + r0) * DM + ch0 + c16 * 8; hl[it] = *(const v4u*)(HL + o); pp[it] = *(const v4u*)(PP + o); gg[it] = *(const v4u*)(GG + o); }
#pragma unroll
    for (int it = 0; it < 8; ++it) { const size_t oy = (size_t)(m0 + it * 32 + r0) * 2048 + ch0 + c16 * 8;
        v4u y;
        y.x = cvtpk((bflo(hl[it].x) + bflo(pp[it].x) * cv[0]) * bflo(gg[it].x), (bfhi(hl[it].x) + bfhi(pp[it].x) * cv[1]) * bfhi(gg[it].x));
        y.y = cvtpk((bflo(hl[it].y) + bflo(pp[it].y) * cv[2]) * bflo(gg[it].y), (bfhi(hl[it].y) + bfhi(pp[it].y) * cv[3]) * bfhi(gg[it].y));
        y.z = cvtpk((bflo(hl[it].z) + bflo(pp[it].z) * cv[4]) * bflo(gg[it].z), (bfhi(hl[it].z) + bfhi(pp[it].z) * cv[5]) * bfhi(gg[it].z));
        y.w = cvtpk((bflo(hl[it].w) + bflo(pp[it].w) * cv[6]) * bflo(gg[it].w), (bfhi(hl[it].w) + bfhi(pp[it].w) * cv[7]) * bfhi(gg[it].w));
        *(v4u*)(Y + oy) = y; }
    __syncthreads();
}

namespace att {
constexpr int KVBLK = 64, SHM_K = KVBLK * HD * 2, SHM_V = SHM_K;
constexpr float C2 = 0.08838834764831845f * 1.4426950408889634f;
#define KSWZ(row, colB) ((row) * 256 + ((colB) ^ (((row) & 7) << 4)))
__device__ __forceinline__ int v_st(int k, int c) { const int kk = (k & ~0xC) | ((k & 4) << 1) | ((k & 8) >> 1); return ((kk >> 3) * 4 + (c >> 5)) * 512 + ((kk & 7) * 32 + (c & 31)) * 2; }
__device__ __forceinline__ int v_rd_base(int lane) { return ((lane & 3) << 3) | (((lane >> 2) & 3) << 6) | (((lane >> 4) & 1) << 5) | (((lane >> 5) & 1) << 8); }
constexpr int v_rd_off(int d0, int ks, int half) { return d0 * 512 + ks * 4096 + half * 2048; }
__device__ __forceinline__ int crow(int r, int hi) { return (r & 3) + 8 * (r >> 2) + 4 * hi; }

template <int KB>
__device__ __forceinline__ void qkt(f32x16& p0, f32x16& p1, const char* K_lds, int r32, int hi, const char* qfrag, bool act) {
    if (!act) { const float NEG = -__builtin_inff();
#pragma unroll
        for (int r = 0; r < 16; ++r) { p0[r] = NEG; p1[r] = NEG; } return; }
    p0 = f32x16{}; p1 = f32x16{};
    const char* kb[4];
#pragma unroll
    for (int dd = 0; dd < 4; ++dd) kb[dd] = K_lds + KB * SHM_K + KSWZ(r32, (dd * 16 + hi * 8) * 2);
#pragma unroll
    for (int d0 = 0; d0 < 8; ++d0) { const char* a = kb[d0 & 3] + (d0 >> 2) * 128;
        bf16x8 b0 = *reinterpret_cast<const bf16x8*>(a);
        bf16x8 b1 = *reinterpret_cast<const bf16x8*>(a + 32 * 256);
        const bf16x8 q = *reinterpret_cast<const bf16x8*>(qfrag + d0 * 1024);
        p0 = __builtin_amdgcn_mfma_f32_32x32x16_bf16(b0, q, p0, 0, 0, 0);
        p1 = __builtin_amdgcn_mfma_f32_32x32x16_bf16(b1, q, p1, 0, 0, 0); }
}
template <int VB>
__device__ __forceinline__ void pv_tile(f32x16* o, int vb0, bf16x8 pa0, bf16x8 pa1, bf16x8 pa2, bf16x8 pa3, bool act) {
    if (!act) return;
#define TRRD(dst, off) asm volatile("ds_read_b64_tr_b16 %0, %1 offset:%2" : "=&v"(dst) : "v"(vb0), "i"(off) : "memory")
#define PV_D0(d0) do { s16x4 l0, l1, l2, l3, h0, h1, h2, h3; constexpr int b_ = VB * SHM_V + v_rd_off(d0, 0, 0); \
        TRRD(l0, b_); TRRD(h0, b_ + 2048); TRRD(l1, b_ + 4096); TRRD(h1, b_ + 6144); TRRD(l2, b_ + 8192); TRRD(h2, b_ + 10240); TRRD(l3, b_ + 12288); TRRD(h3, b_ + 14336); \
        asm volatile("s_waitcnt lgkmcnt(0)" ::: "memory"); SBAR(); \
        o[d0] = __builtin_amdgcn_mfma_f32_32x32x16_bf16(pa0, (bf16x8){l0[0], l0[1], l0[2], l0[3], h0[0], h0[1], h0[2], h0[3]}, o[d0], 0, 0, 0);   \
        o[d0] = __builtin_amdgcn_mfma_f32_32x32x16_bf16(pa1, (bf16x8){l1[0], l1[1], l1[2], l1[3], h1[0], h1[1], h1[2], h1[3]}, o[d0], 0, 0, 0);   \
        o[d0] = __builtin_amdgcn_mfma_f32_32x32x16_bf16(pa2, (bf16x8){l2[0], l2[1], l2[2], l2[3], h2[0], h2[1], h2[2], h2[3]}, o[d0], 0, 0, 0);   \
        o[d0] = __builtin_amdgcn_mfma_f32_32x32x16_bf16(pa3, (bf16x8){l3[0], l3[1], l3[2], l3[3], h3[0], h3[1], h3[2], h3[3]}, o[d0], 0, 0, 0); } while (0)
    PV_D0(0); PV_D0(1); PV_D0(2); PV_D0(3);
#undef PV_D0
#undef TRRD
}
__device__ __forceinline__ void sm_a(f32x16& p0) {
#pragma unroll
    for (int r = 0; r < 16; ++r) p0[r] = __builtin_amdgcn_exp2f(p0[r]);
}
__device__ __forceinline__ void sm_b(f32x16& p0, f32x16& p1, float& l_reg, bf16x8& pa0, bf16x8& pa1, bf16x8& pa2, bf16x8& pa3) {
#pragma unroll
    for (int r = 0; r < 16; ++r) p1[r] = __builtin_amdgcn_exp2f(p1[r]);
    float ps = 0;
#pragma unroll
    for (int r = 0; r < 16; ++r) ps += p0[r];
#pragma unroll
    for (int r = 0; r < 16; ++r) ps += p1[r];
    l_reg += ps;
#define PK4(P, B_, OUT) do { unsigned a0 = cvtpk(P[B_+0], P[B_+1]), a1 = cvtpk(P[B_+2], P[B_+3]); \
        unsigned b0 = cvtpk(P[B_+4], P[B_+5]), b1 = cvtpk(P[B_+6], P[B_+7]); \
        auto r0 = __builtin_amdgcn_permlane32_swap(a0, b0, false, false); auto r1 = __builtin_amdgcn_permlane32_swap(a1, b1, false, false); \
        v4u w = {r0[0], r1[0], r0[1], r1[1]}; OUT = *reinterpret_cast<bf16x8*>(&w); } while (0)
    PK4(p0, 0, pa0); PK4(p0, 8, pa1); PK4(p1, 0, pa2); PK4(p1, 8, pa3);
#undef PK4
}

__device__ __forceinline__ void attn_unit(Frame& F, const Args& args, int b, int h, int iq) {
    int tid = F.tid; asm volatile("" : "+v"(tid));
    const int wid = F.wave, lane = tid & 63, r32 = lane & 31, hi = lane >> 5;
    char* lds = F.ldsg;
    char* V_lds = lds; char* K_lds = lds + 2 * SHM_V;
    float* kml = (float*)(lds + XTRA_OFF);
    char* qfrag = lds + 65536 + wid * 8192 + lane * 16;
    const bf16* QR = WSP(bf16, WS_E) + 2 * E_STRIDE; const bf16* KN = WSP(bf16, WS_E) + 3 * E_STRIDE; const bf16* VV = WSP(bf16, WS_E) + 4 * E_STRIDE;
    bf16* YA = WSP(bf16, WS_YCAT) + 1024;
    const size_t mb = (size_t)b * SEQ;
    const int q0 = iq * 256, NT = 4 * (iq + 1);
    const bf16* Kh = KN + mb * DM + h * HD; const bf16* Vh = VV + mb * DM + h * HD;
    { const float* kmg = WSP(float, WS_KMEAN) + (size_t)(b * NH + h) * 16 * HD; for (int idx = tid; idx < iq * HD; idx += 512) kml[idx] = kmg[idx]; }
    const int sr = tid >> 4, sc = (tid & 15) * 8, vst0 = v_st(sr, sc), vst1 = v_st(32 + sr, sc), kws = KSWZ(sr, sc * 2);
    const int vb0 = (int)(uintptr_t)V_lds + v_rd_base(lane);
    bf16x8 st_v0, st_v1, st_k0, st_k1;
    const unsigned goff = (unsigned)(sr * DM + sc) * 2u;
#define ROWP(p, k0, rr) ((const char*)((p) + (size_t)((k0) + (rr)) * DM) + goff)
#define SLOAD(k0) do { st_v0 = *(const bf16x8*)ROWP(Vh, k0, 0); st_v1 = *(const bf16x8*)ROWP(Vh, k0, 32); st_k0 = *(const bf16x8*)ROWP(Kh, k0, 0); st_k1 = *(const bf16x8*)ROWP(Kh, k0, 32); } while (0)
#define SWRITE(bf) do { *(bf16x8*)(V_lds + (bf) * SHM_V + vst0) = st_v0; *(bf16x8*)(V_lds + (bf) * SHM_V + vst1) = st_v1; \
                        *(bf16x8*)(K_lds + (bf) * SHM_K + kws) = st_k0; *(bf16x8*)(K_lds + (bf) * SHM_K + kws + 32 * 256) = st_k1; } while (0)
    SLOAD(0);
    const size_t mq = mb + q0 + wid * 32 + r32;
    unsigned selmask;
    {
        bf16x8 qr[8];
        const bf16* qp = QR + mq * DM + h * HD + hi * 8;
        v4u raw[8];
#pragma unroll
        for (int d0 = 0; d0 < 8; ++d0) raw[d0] = *(const v4u*)(qp + d0 * 16);
        float ss = 0.f;
#pragma unroll
        for (int d0 = 0; d0 < 8; ++d0) { const float a0 = bflo(raw[d0].x), a1 = bfhi(raw[d0].x), a2 = bflo(raw[d0].y), a3 = bfhi(raw[d0].y), a4 = bflo(raw[d0].z), a5 = bfhi(raw[d0].z), a6 = bflo(raw[d0].w), a7 = bfhi(raw[d0].w);
            ss += (a0 * a0 + a1 * a1) + (a2 * a2 + a3 * a3) + (a4 * a4 + a5 * a5) + (a6 * a6 + a7 * a7); }
        ss += __shfl_xor(ss, 32);
        const float rs = C2 / sqrtf(ss * (1.f / HD) + EPS);
        const float* qg = IN_F(15) + hi * 8;
#define UNPK(f, W_) do { const v4u t_ = (W_); f[0] = bflo(t_.x); f[1] = bfhi(t_.x); f[2] = bflo(t_.y); f[3] = bfhi(t_.y); f[4] = bflo(t_.z); f[5] = bfhi(t_.z); f[6] = bflo(t_.w); f[7] = bfhi(t_.w); } while (0)
#define PACK(f) ({ v4u w_; w_.x = cvtpk(f[0], f[1]); w_.y = cvtpk(f[2], f[3]); w_.z = cvtpk(f[4], f[5]); w_.w = cvtpk(f[6], f[7]); *reinterpret_cast<bf16x8*>(&w_); })
        { float f0[8], f1[8]; UNPK(f0, raw[0]); UNPK(f1, raw[1]);
          const float* tg = WSP(float, WS_TRIG) + mq * 32 + hi * 8;
#pragma unroll
          for (int j = 0; j < 8; ++j) { const float x1 = f0[j] * rs * qg[j], x2 = f1[j] * rs * qg[16 + j], cs = tg[j], sn = tg[16 + j]; f0[j] = x1 * cs - x2 * sn; f1[j] = x2 * cs + x1 * sn; }
          qr[0] = PACK(f0); qr[1] = PACK(f1); }
#pragma unroll
        for (int d0 = 2; d0 < 8; ++d0) { float f[8]; UNPK(f, raw[d0]);
#pragma unroll
            for (int j = 0; j < 8; ++j) f[j] *= rs * qg[d0 * 16 + j];
            qr[d0] = PACK(f); }
        __syncthreads();
        float v1 = -__builtin_inff(), v2 = v1, v3 = v1; int i1 = 0, i2 = 0, i3 = 0;
#pragma unroll 1
        for (int jb = 0; jb < iq; ++jb) { const float* km = kml + jb * HD + hi * 8; float g = 0.f;
#pragma unroll
            for (int d0 = 0; d0 < 8; ++d0) { float f[8]; UNPK(f, *reinterpret_cast<const v4u*>(&qr[d0]));
                const f32x4 k0 = *(const f32x4*)(km + d0 * 16), k1 = *(const f32x4*)(km + d0 * 16 + 4);
                g += (f[0] * k0[0] + f[1] * k0[1]) + (f[2] * k0[2] + f[3] * k0[3]) + (f[4] * k1[0] + f[5] * k1[1]) + (f[6] * k1[2] + f[7] * k1[3]); }
            g += __shfl_xor(g, 32);
            if (g > v1) { v3 = v2; i3 = i2; v2 = v1; i2 = i1; v1 = g; i1 = jb; }
            else if (g > v2) { v3 = v2; i3 = i2; v2 = g; i2 = jb; }
            else if (g > v3) { v3 = g; i3 = jb; } }
#undef UNPK
#undef PACK
        selmask = 0u; if (iq >= 1) selmask |= 1u << i1; if (iq >= 2) selmask |= 1u << i2; if (iq >= 3) selmask |= 1u << i3;
#pragma unroll
        for (int d0 = 0; d0 < 8; ++d0) *reinterpret_cast<bf16x8*>(qfrag + d0 * 1024) = qr[d0];
    }
    float l_reg = 0.f; f32x16 o[4] = {};
    const int wrow0 = wid * 32;
#define ACT(t) (((t) >> 2) < iq ? (__ballot((selmask >> ((t) >> 2)) & 1u) != 0ull) : ((((t) - 4 * iq) * 64) <= wrow0 + 31))
#define MASKT(P0_, P1_, t) do { const int blk_ = (t) >> 2; const float NEG_ = -__builtin_inff(); \
        if (blk_ < iq) { if (!((selmask >> blk_) & 1u)) { _Pragma("unroll") for (int r = 0; r < 16; ++r) { P0_[r] = NEG_; P1_[r] = NEG_; } } } \
        else { const int kb_ = ((t) - 4 * iq) * 64; if (kb_ + 63 > wrow0) { int dq_ = wrow0 + r32 - kb_ - 4 * hi; asm volatile("" : "+v"(dq_)); \
            _Pragma("unroll") for (int r = 0; r < 16; ++r) { const int c_ = (r & 3) + 8 * (r >> 2); if (c_ > dq_) P0_[r] = NEG_; if (c_ + 32 > dq_) P1_[r] = NEG_; } } } } while (0)
    f32x16 pA0, pA1, pB0, pB1; bf16x8 pa0, pa1, pa2, pa3;
    VM_WAIT(); SWRITE(0); SBAR();
    SLOAD(64);
    __syncthreads();
    SBAR(); qkt<0>(pA0, pA1, K_lds, r32, hi, qfrag, ACT(0));
    MASKT(pA0, pA1, 0); sm_a(pA0);
    VM_WAIT(); SWRITE(1);
    __syncthreads();
#define HALF_STEP(PX0, PX1, PY0, PY1, t, KB, VB, SB) do { \
        SBAR(); qkt<KB>(PX0, PX1, K_lds, r32, hi, qfrag, ACT(t)); \
        sm_b(PY0, PY1, l_reg, pa0, pa1, pa2, pa3); SBAR(); \
        if ((t) + 1 < NT) { SLOAD(((t) + 1) * 64); SBAR(); } \
        pv_tile<VB>(o, vb0, pa0, pa1, pa2, pa3, ACT((t) - 1)); MASKT(PX0, PX1, (t)); sm_a(PX0); \
        __syncthreads(); \
        if ((t) + 1 < NT) { VM_WAIT(); SWRITE(SB); } \
        __syncthreads(); } while (0)
    for (int t = 1; t + 1 < NT; t += 2) {
        HALF_STEP(pB0, pB1, pA0, pA1, t, 1, 0, 0);
        HALF_STEP(pA0, pA1, pB0, pB1, t + 1, 0, 1, 1);
    }
    SBAR(); qkt<1>(pB0, pB1, K_lds, r32, hi, qfrag, ACT(NT - 1)); SBAR();
    sm_b(pA0, pA1, l_reg, pa0, pa1, pa2, pa3); SBAR();
    pv_tile<0>(o, vb0, pa0, pa1, pa2, pa3, ACT(NT - 2));
    MASKT(pB0, pB1, NT - 1); sm_a(pB0);
    sm_b(pB0, pB1, l_reg, pa0, pa1, pa2, pa3); SBAR();
    pv_tile<1>(o, vb0, pa0, pa1, pa2, pa3, ACT(NT - 1));
    l_reg += __shfl_xor(l_reg, 32);
    float* li_l = (float*)(lds + XTRA_OFF + 8192) + wid * 32;
    if (hi == 0) li_l[r32] = l_reg;
    asm volatile("s_waitcnt lgkmcnt(0)" ::: "memory");
    float rli[16];
#pragma unroll
    for (int r = 0; r < 16; ++r) rli[r] = __builtin_amdgcn_rcpf(li_l[crow(r, hi)]);
    bf16* Ow = YA + (mb + q0 + wid * 32) * 2048 + h * HD;
#pragma unroll
    for (int r = 0; r < 16; ++r) { const int orow = crow(r, hi);
#pragma unroll
        for (int d0 = 0; d0 < 4; ++d0) { const float v = o[d0][r] * rli[r]; const float vn = __shfl_xor(v, 1);
            if ((r32 & 1) == 0) *(unsigned*)(Ow + (size_t)orow * 2048 + d0 * 32 + r32) = cvtpk(v, vn); } }
    __syncthreads();
#undef ROWP
#undef SLOAD
#undef SWRITE
#undef ACT
#undef MASKT
#undef HALF_STEP
}
#undef KSWZ
}

__device__ __forceinline__ void p7_router(Frame& F, const Args& args) {
    LAS float* ssq = (LAS float*)F.lds;
    LAS float* par = (LAS float*)(F.lds + 2048);
    LAS float* lg = (LAS float*)(F.lds + 10240);
    LAS int* hist = (LAS int*)(F.lds + 77824 + 2048);
    LAS int* sel = (LAS int*)(F.lds + 77824 + 4096);
    const float* g2n = IN_F(6); const float* mod = WSP(float, WS_MOD); const float* brt = IN_F(21);
    unsigned char* H2 = WSP(unsigned char, WS_HB);
    const float* xin = IN_F(0); const bf16* D1 = WSP(bf16, WS_D1);
    unsigned* CNT = (unsigned*)(F.ws + WS_CTL) + CW_CNT;
    const int row = F.lane & 15, q = F.lane >> 4, kw = F.wave * 128;
    bf16x8 Bh[4][2], Bl[4][2];
    { const bf16* wh = WSP(bf16, WS_WRH) + (size_t)row * 1024 + kw + 8 * q; const bf16* wl = WSP(bf16, WS_WRL) + (size_t)row * 1024 + kw + 8 * q;
#pragma unroll
      for (int s = 0; s < 4; ++s) { Bh[s][0] = *(const bf16x8*)(wh + 32 * s); Bh[s][1] = *(const bf16x8*)(wh + 16384 + 32 * s); Bl[s][0] = *(const bf16x8*)(wl + 32 * s); Bl[s][1] = *(const bf16x8*)(wl + 16384 + 32 * s); } }
    for (int vw = F.vcu; vw < 256; vw += F.G) {
        const int m0 = vw * 64, b = m0 >> 12;
        for (int i = F.tid; i < 1024; i += 512) { par[i] = g2n[i] * (1.0f + mod[b * 6144 + 4096 + i]); par[1024 + i] = mod[b * 6144 + 3072 + i]; }
        if (F.tid < 32) hist[F.tid] = 0;
#pragma unroll
        for (int rt = 0; rt < 4; ++rt) { const float* xp = xin + (size_t)(m0 + rt * 16 + row) * DM + kw + 8 * q; const bf16* dp = D1 + (size_t)(m0 + rt * 16 + row) * DM + kw + 8 * q; float ss = 0.f;
#pragma unroll
            for (int s = 0; s < 4; ++s) { const v4u dd = *(const v4u*)(dp + 32 * s);
                const f32x4 x0 = *(const f32x4*)(xp + 32 * s) + (f32x4){bflo(dd.x), bfhi(dd.x), bflo(dd.y), bfhi(dd.y)}, x1 = *(const f32x4*)(xp + 32 * s + 4) + (f32x4){bflo(dd.z), bfhi(dd.z), bflo(dd.w), bfhi(dd.w)};
                const f32x4 a = x0 * x0 + x1 * x1; ss += (a.x + a.y) + (a.z + a.w); }
            ss += __shfl_xor(ss, 16); ss += __shfl_xor(ss, 32);
            if (q == 0) ssq[F.wave * 64 + rt * 16 + row] = ss; }
        __syncthreads();
        f32x4 xraw[2][4][2]; v4u draw[2][4];
#define P7_LOADRT(rt_) do { const float* xp_ = xin + (size_t)(m0 + (rt_) * 16 + row) * DM + kw + 8 * q; const bf16* dp_ = D1 + (size_t)(m0 + (rt_) * 16 + row) * DM + kw + 8 * q; \
        _Pragma("unroll") for (int s_ = 0; s_ < 4; ++s_) { draw[(rt_) & 1][s_] = *(const v4u*)(dp_ + 32 * s_); xraw[(rt_) & 1][s_][0] = *(const f32x4*)(xp_ + 32 * s_); xraw[(rt_) & 1][s_][1] = *(const f32x4*)(xp_ + 32 * s_ + 4); } } while (0)
        P7_LOADRT(0);
#pragma unroll
        for (int rt = 0; rt < 4; ++rt) { const int rl = rt * 16 + row; float tot = 0.f;
            if (rt + 1 < 4) P7_LOADRT(rt + 1);
#pragma unroll
            for (int w = 0; w < 8; ++w) tot += ssq[w * 64 + rl];
            const float rstd = 1.0f / sqrtf(tot * (1.f / DM) + EPS);
            f32x4 acc0 = {0.f, 0.f, 0.f, 0.f}, acc1 = {0.f, 0.f, 0.f, 0.f};
            unsigned char* hp = H2 + (size_t)(m0 + rl) * DM + kw + 8 * q;
            f32x4 xq[4][2];
#pragma unroll
            for (int s = 0; s < 4; ++s) { const v4u dd = draw[rt & 1][s];
                xq[s][0] = xraw[rt & 1][s][0] + (f32x4){bflo(dd.x), bfhi(dd.x), bflo(dd.y), bfhi(dd.y)}; xq[s][1] = xraw[rt & 1][s][1] + (f32x4){bflo(dd.z), bfhi(dd.z), bflo(dd.w), bfhi(dd.w)}; }
#pragma unroll
            for (int s = 0; s < 4; ++s) { const int col = kw + 32 * s + 8 * q; float h[8];
#pragma unroll
                for (int hf = 0; hf < 2; ++hf) { const f32x4 sc = *(const LAS f32x4*)(par + col + 4 * hf), sh = *(const LAS f32x4*)(par + 1024 + col + 4 * hf);
                    const f32x4 t = xq[s][hf] * rstd * sc + sh; h[4 * hf] = t.x; h[4 * hf + 1] = t.y; h[4 * hf + 2] = t.z; h[4 * hf + 3] = t.w; }
                v4u hi; hi.x = cvtpk(h[0], h[1]); hi.y = cvtpk(h[2], h[3]); hi.z = cvtpk(h[4], h[5]); hi.w = cvtpk(h[6], h[7]);
                { v2u h8; h8.x = pg8::pk_fp8x4(h[0], h[1], h[2], h[3]); h8.y = pg8::pk_fp8x4(h[4], h[5], h[6], h[7]); *(v2u*)(hp + 32 * s) = h8; }
                v4u lo; lo.x = cvtpk(h[0] - bflo(hi.x), h[1] - bfhi(hi.x)); lo.y = cvtpk(h[2] - bflo(hi.y), h[3] - bfhi(hi.y)); lo.z = cvtpk(h[4] - bflo(hi.z), h[5] - bfhi(hi.z)); lo.w = cvtpk(h[6] - bflo(hi.w), h[7] - bfhi(hi.w));
                const bf16x8 ah = *reinterpret_cast<bf16x8*>(&hi), al = *reinterpret_cast<bf16x8*>(&lo);
                acc0 = __builtin_amdgcn_mfma_f32_16x16x32_bf16(ah, Bh[s][0], acc0, 0, 0, 0); acc0 = __builtin_amdgcn_mfma_f32_16x16x32_bf16(ah, Bl[s][0], acc0, 0, 0, 0); acc0 = __builtin_amdgcn_mfma_f32_16x16x32_bf16(al, Bh[s][0], acc0, 0, 0, 0);
                acc1 = __builtin_amdgcn_mfma_f32_16x16x32_bf16(ah, Bh[s][1], acc1, 0, 0, 0); acc1 = __builtin_amdgcn_mfma_f32_16x16x32_bf16(ah, Bl[s][1], acc1, 0, 0, 0); acc1 = __builtin_amdgcn_mfma_f32_16x16x32_bf16(al, Bh[s][1], acc1, 0, 0, 0); }
#pragma unroll
            for (int r = 0; r < 4; ++r) { lg[(F.wave * 64 + rt * 16 + 4 * q + r) * 33 + row] = acc0[r]; lg[(F.wave * 64 + rt * 16 + 4 * q + r) * 33 + 16 + row] = acc1[r]; } }
#undef P7_LOADRT
        __syncthreads();
        { const int rowl = F.tid >> 3, eq = F.tid & 7; float v[4];
#pragma unroll
          for (int j = 0; j < 4; ++j) { float a = brt[4 * eq + j];
#pragma unroll
              for (int w = 0; w < 8; ++w) a += lg[(w * 64 + rowl) * 33 + 4 * eq + j];
              v[j] = a; }
          float tv[4]; int te[4];
#pragma unroll
          for (int k = 0; k < 4; ++k) { float gm = fmaxf(fmaxf(v[0], v[1]), fmaxf(v[2], v[3]));
              gm = fmaxf(gm, __shfl_xor(gm, 1)); gm = fmaxf(gm, __shfl_xor(gm, 2)); gm = fmaxf(gm, __shfl_xor(gm, 4));
              int ci = v[0] == gm ? 4 * eq : v[1] == gm ? 4 * eq + 1 : v[2] == gm ? 4 * eq + 2 : v[3] == gm ? 4 * eq + 3 : 99;
              ci = min(ci, __shfl_xor(ci, 1)); ci = min(ci, __shfl_xor(ci, 2)); ci = min(ci, __shfl_xor(ci, 4));
              te[k] = ci; tv[k] = gm;
#pragma unroll
              for (int j = 0; j < 4; ++j) if (ci == 4 * eq + j) v[j] = -__builtin_inff(); }
          if (eq == 0) { const float w1 = __expf(tv[1] - tv[0]), w2 = __expf(tv[2] - tv[0]), w3 = __expf(tv[3] - tv[0]); const float inv = 1.0f / (1.0f + w1 + w2 + w3);
              const float gk[4] = {inv, w1 * inv, w2 * inv, w3 * inv};
#pragma unroll
              for (int k = 0; k < 4; ++k) { const int lr = atomicAdd((int*)&hist[te[k]], 1); sel[rowl * 4 + k] = te[k]; sel[256 + rowl * 4 + k] = lr; sel[512 + rowl * 4 + k] = __float_as_int(gk[k]); } } }
        __syncthreads();
        if (F.tid < 32) { const int hc = hist[F.tid]; hist[32 + F.tid] = hc ? (int)__hip_atomic_fetch_add(CNT + F.tid, (unsigned)hc, RLX_AGENT) : 0; }
        __syncthreads();
        if (F.tid < 256) { const int e = sel[F.tid], pos = hist[32 + e] + sel[256 + F.tid], mm = m0 + (F.tid >> 2);
            WSP(int, WS_ROWTOK)[(size_t)e * ECAP + pos] = mm; WSP(int, WS_ROWGATE)[(size_t)e * ECAP + pos] = sel[512 + F.tid];
            WSP(int, WS_TOKE)[mm * 4 + (F.tid & 3)] = e; WSP(int, WS_TOKPOS)[mm * 4 + (F.tid & 3)] = pos; }
        __syncthreads();
    }
}

constexpr int MOE_TBL_OFF = XTRA_OFF, MOE_LIST_OFF = XTRA_OFF + 2048;
__device__ __forceinline__ int moe_tables(Frame& F) {
    LAS int* tbl = (LAS int*)(F.lds + MOE_TBL_OFF);
    const unsigned* CNT = (const unsigned*)(F.ws + WS_CTL) + CW_CNT;
    if (F.tid < 32) tbl[F.tid] = (int)__hip_atomic_load(CNT + F.tid, RLX_AGENT);
    __syncthreads();
    if (F.tid == 0) { int run = 0;
#pragma unroll 1
        for (int e = 0; e < 32; ++e) { tbl[32 + e] = run; const int nb = (tbl[e] + 255) >> 8;
#pragma unroll 1
            for (int bb = 0; bb < nb; ++bb) tbl[80 + run + bb] = e;
            run += nb; }
        tbl[64] = run; }
    __syncthreads();
    int nblk = tbl[64]; if (nblk > MAXBLK) nblk = MAXBLK; if (nblk < 1) nblk = 1;
    return __builtin_amdgcn_readfirstlane(nblk);
}

__device__ __forceinline__ void p11_combine(Frame& F, const Args& args) {
    (void)moe_tables(F);
    const LAS int* tbl = (const LAS int*)(F.lds + MOE_TBL_OFF);
    const float* mod = WSP(float, WS_MOD); const unsigned char* YR = WSP(unsigned char, WS_YR); const float* xin = IN_F(0); const bf16* D1 = WSP(bf16, WS_D1);
    const int gw = F.vcu * NWAVES + F.wave, NGW = F.G * NWAVES;
    const int col = 16 * F.lane;
#define P11_LOAD(m_, Y0, Y1, Y2, Y3, DA, DB, X) do { int dk_ = 0; if (F.lane < 4) { const int e_ = __hip_atomic_load(WSP(int, WS_TOKE) + (m_) * 4 + F.lane, RLX_AGENT); dk_ = tbl[32 + e_] * 256 + __hip_atomic_load(WSP(int, WS_TOKPOS) + (m_) * 4 + F.lane, RLX_AGENT); } \
        const int d0_ = __shfl(dk_, 0), d1_ = __shfl(dk_, 1), d2_ = __shfl(dk_, 2), d3_ = __shfl(dk_, 3); \
        Y0 = *(const v4u*)(YR + (size_t)d0_ * DM + col); Y1 = *(const v4u*)(YR + (size_t)d1_ * DM + col); Y2 = *(const v4u*)(YR + (size_t)d2_ * DM + col); Y3 = *(const v4u*)(YR + (size_t)d3_ * DM + col); \
        DA = *(const v4u*)(D1 + (size_t)(m_) * DM + col); DB = *(const v4u*)(D1 + (size_t)(m_) * DM + col + 8); \
        _Pragma("unroll") for (int q_ = 0; q_ < 4; ++q_) X[q_] = *(const f32x4*)(xin + (size_t)(m_) * DM + col + 4 * q_); } while (0)
#define P11_STORE(m_, Y0, Y1, Y2, Y3, DA, DB, X) do { const int b_ = (m_) >> 12; const unsigned dw_[8] = {DA.x, DA.y, DA.z, DA.w, DB.x, DB.y, DB.z, DB.w}; \
        const unsigned w0_[4] = {Y0.x, Y0.y, Y0.z, Y0.w}, w1_[4] = {Y1.x, Y1.y, Y1.z, Y1.w}, w2_[4] = {Y2.x, Y2.y, Y2.z, Y2.w}, w3_[4] = {Y3.x, Y3.y, Y3.z, Y3.w}; \
        _Pragma("unroll") for (int q_ = 0; q_ < 4; ++q_) { \
            const f32x2 a0_ = __builtin_amdgcn_cvt_pk_f32_fp8((int)w0_[q_], false) + __builtin_amdgcn_cvt_pk_f32_fp8((int)w1_[q_], false) + __builtin_amdgcn_cvt_pk_f32_fp8((int)w2_[q_], false) + __builtin_amdgcn_cvt_pk_f32_fp8((int)w3_[q_], false); \
            const f32x2 a1_ = __builtin_amdgcn_cvt_pk_f32_fp8((int)w0_[q_], true) + __builtin_amdgcn_cvt_pk_f32_fp8((int)w1_[q_], true) + __builtin_amdgcn_cvt_pk_f32_fp8((int)w2_[q_], true) + __builtin_amdgcn_cvt_pk_f32_fp8((int)w3_[q_], true); \
            const f32x4 s_ = {a0_.x, a0_.y, a1_.x, a1_.y}; \
            const f32x4 g2_ = *(const f32x4*)(mod + b_ * 6144 + 5120 + col + 4 * q_) * 0.0625f; \
            const f32x4 dl_ = {bflo(dw_[2 * q_]), bfhi(dw_[2 * q_]), bflo(dw_[2 * q_ + 1]), bfhi(dw_[2 * q_ + 1])}; \
            *(f32x4*)(F.out + (size_t)(m_) * DM + col + 4 * q_) = X[q_] + dl_ + g2_ * s_; } } while (0)
    v4u ya0, ya1, ya2, ya3, daa, dab; f32x4 xa[4]; v4u yb0, yb1, yb2, yb3, dba, dbb; f32x4 xb[4];
    int m = gw;
    if (m < NTOK) P11_LOAD(m, ya0, ya1, ya2, ya3, daa, dab, xa);
    for (; m < NTOK; m += 2 * NGW) {
        const int m1 = m + NGW, m2 = m + 2 * NGW;
        if (m1 < NTOK) P11_LOAD(m1, yb0, yb1, yb2, yb3, dba, dbb, xb);
        P11_STORE(m, ya0, ya1, ya2, ya3, daa, dab, xa);
        if (m2 < NTOK) P11_LOAD(m2, ya0, ya1, ya2, ya3, daa, dab, xa);
        if (m1 < NTOK) P11_STORE(m1, yb0, yb1, yb2, yb3, dba, dbb, xb);
    }
#undef P11_LOAD
#undef P11_STORE
}

#ifndef NSTREAM
#define NSTREAM 8
#endif
#define P4_PULL(ctr, dst) do { __syncthreads(); if (F.tid == 0) bc[0] = (int)__hip_atomic_fetch_add((ctr), 1u, RLX_AGENT); __syncthreads(); dst = bc[0]; } while (0)
__device__ __forceinline__ void p4_phase(Frame& F, const Args& args) {
    unsigned* Q = (unsigned*)(F.ws + WS_CTL) + CW_QUEUE;
    LAS int* bc = (LAS int*)(F.lds + XTRA_OFF + 12288);
    const bool xcd_ok = (F.G == 256);
    const int xg = xcd_ok ? (F.vcu >> 5) : (F.vcu & 7);
    const bool streamer = xcd_ok && (F.vcu & 31) < NSTREAM;
    if (streamer) { for (;;) { int ch; P4_PULL(Q + 64 * 9, ch); if (ch >= P8_NCHUNK) break; p8_chunk(F, args, ch); } }
#pragma unroll 1
    for (int dx = 0; dx < 8; ++dx) { const int x = (xg + dx) & 7;
        for (;;) { int a; P4_PULL(Q + 64 * x, a); if (a >= 64) break;
            const int bh = 4 * x + (a & 3); att::attn_unit(F, args, bh >> 3, bh & 7, 15 - (a >> 2)); } }
    for (;;) { int u; P4_PULL(Q + 64 * 8, u); if (u >= 512) break; p4_rnn_final_unit(F, args, u); }
    if (!streamer) { for (;;) { int ch; P4_PULL(Q + 64 * 9, ch); if (ch >= P8_NCHUNK) break; p8_chunk(F, args, ch); } }
}
#undef P4_PULL

#ifndef MK_N_LAUNCHES
#define MK_N_LAUNCHES 1
#endif
constexpr int PER_PHASE = 12;
constexpr int N_LAUNCHES = MK_N_LAUNCHES;

__global__ void __launch_bounds__(NWAVES * 64, 2) hybrid_fwd(Args args) {
    extern __shared__ __attribute__((aligned(16))) unsigned char lds[];
    Frame F;
    F.lds = (LAS unsigned char*)lds; F.ldsg = (char*)lds;
    F.MISC = (volatile LAS unsigned*)(F.lds + MISC_OFF);
    F.tid = threadIdx.x; F.lane = F.tid & 63; F.wave = __builtin_amdgcn_readfirstlane(F.tid >> 6);
    F.G = gridDim.x; { const int bx = blockIdx.x; F.vcu = (F.G % 8 == 0) ? (bx % 8) * (F.G / 8) + bx / 8 : bx; }
    F.ws = args.ws; F.out = args.out;
    gu32* ctl = (gu32*)(args.ws + WS_CTL);
    for (int u = F.tid; u < (LDS_BYTES - LDSCTL_OFF) / 4; u += NWAVES * 64) ((LAS unsigned*)(F.lds + LDSCTL_OFF))[u] = 0u;
    __syncthreads();
    XcdBarrier bar; bar.bar = (unsigned*)(ctl + CW_BAR); bar.x = 0; bar.st = nullptr;
    if (N_LAUNCHES == 1) bar = xcd_barrier_post((unsigned*)(ctl + CW_BAR), F.MISC + 8);
    const int lo = args.ph_lo, hi = args.ph_hi;
#ifndef PHASE_MASK
#define PHASE_MASK 0xFFF
#endif
#define IN(k) (((PHASE_MASK >> (k)) & 1) && lo <= (k) && (k) < hi)
#define NEXTP(k) ((k) == 0 ? 2 : (k) == 7 ? 9 : (k) + 1)
#define SEAM(k) do { if (IN(k) && IN(NEXTP(k))) xcd_barrier(bar); } while (0)

#ifndef DUP_MASK
#define DUP_MASK 0
#endif
#define PHASE(k, ...) do { if (IN(k)) { __VA_ARGS__ if ((DUP_MASK >> (k)) & 1) { xcd_barrier(bar); __VA_ARGS__ } } SEAM(k); } while (0)
    PHASE(0, { p0_prologue(F, args); p1_hrows(F, args); });
    PHASE(2, {
        { pg8::Gemm g{WSP(bf16, WS_HB), WSP(bf16, WS_WIN), NTOK, 3072, DM}; pg8::TileOrder S; S.init(NTOK / 256, 12, F.G, (int)blockIdx.x, nullptr);
          pg8::EpiWin E{WSP(bf16, WS_E), IN_F(17), 0};
          pg8::gemm_phase<pg8::EpiWin, pg8::TileOrder, true, true>(F.lds + RING_OFF, g, S, E); }
        { pg8::Gemm g{WSP(bf16, WS_H8), WSP(bf16, WS_WIN8), NTOK, 4096, DM / 2}; pg8::TileOrder S; S.init(NTOK / 256, 16, F.G, (int)blockIdx.x, nullptr);
          pg8::EpiWin E{WSP(bf16, WS_E), IN_F(17), 1};
          pg8::gemm_phase<pg8::EpiWin, pg8::TileOrder, true, true, false, true>(F.lds + RING_OFF, g, S, E); }
    });
    int p3rep = 0;
    PHASE(3, {
        for (int u = F.vcu; u < 512; u += F.G) p3_rnn_local_unit(F, args, u);
        if (p3rep++ == 0) { for (int u = F.vcu; u < 512; u += F.G) p3_knorm_unit(F, args, u); }
    });
    PHASE(4, { p4_phase(F, args); });
    PHASE(5, {
        pg8::Gemm g{WSP(bf16, WS_YCAT), WSP(bf16, WS_WB), NTOK, DM, 2 * DM}; pg8::TileOrder S; S.init(NTOK / 256, DM / 256, F.G, (int)blockIdx.x, nullptr);
        pg8::EpiBranch E{WSP(bf16, WS_E) + 5 * E_STRIDE, WSP(bf16, WS_E) + 6 * E_STRIDE, WSP(bf16, WS_HB)};
        pg8::gemm_phase<pg8::EpiBranch, pg8::TileOrder, false, true>(F.lds + RING_OFF, g, S, E);
    });
    PHASE(6, {
        pg8::Gemm g{WSP(bf16, WS_HB), WSP(bf16, WS_WO), NTOK, DM, DM}; pg8::TileOrder S; S.init(NTOK / 256, DM / 256, F.G, (int)blockIdx.x, nullptr);
        pg8::EpiWout E{WSP(bf16, WS_D1), WSP(float, WS_MOD)};
        pg8::gemm_phase<pg8::EpiWout, pg8::TileOrder, false, true>(F.lds + RING_OFF, g, S, E);
    });
    PHASE(7, { p7_router(F, args); });
    PHASE(9, {
        const int nblk = moe_tables(F);
        const LAS int* tbl = (const LAS int*)(F.lds + MOE_TBL_OFF); LAS int* lists = (LAS int*)(F.lds + MOE_LIST_OFF);
        pg8::Gemm g{WSP(bf16, WS_HB), WSP(bf16, WS_WUP), RMAX, 2048 * NEXP, DM / 2}; pg8::TileOrder S; S.init(nblk, 8, F.G, (int)blockIdx.x, tbl + 80, F.ws + WS_HB);
        { pg8::Unit u; for (int i = 0; i < 9 && S.next(i, u); ++i) { if (F.tid < 256) { const int e = u.pn >> 3, pos = (u.pm - tbl[32 + e]) * 256 + F.tid;
              lists[i * 256 + F.tid] = pos < tbl[e] ? __hip_atomic_load(WSP(int, WS_ROWTOK) + (size_t)e * ECAP + pos, RLX_AGENT) : 0; } } }
        __syncthreads();
        pg8::EpiUp E{WSP(unsigned char, WS_ACT), IN_F(23)};
        pg8::gemm_phase<pg8::EpiUp, pg8::TileOrder, true, true, true, true>(F.lds + RING_OFF, g, S, E, lists);
    });
    PHASE(10, {
        const int nblk = moe_tables(F);
        const LAS int* tbl = (const LAS int*)(F.lds + MOE_TBL_OFF);
        pg8::Gemm g{WSP(bf16, WS_ACT), WSP(bf16, WS_WDN), RMAX, 1024 * NEXP, DM / 2}; pg8::TileOrder S; S.init(nblk, 4, F.G, (int)blockIdx.x, tbl + 80);
        pg8::EpiDown E{WSP(unsigned char, WS_YR), IN_F(25), WSP(float, WS_ROWGATE), tbl, F.lds + XTRA_OFF + 12288};
        pg8::gemm_phase<pg8::EpiDown, pg8::TileOrder, true, true, false, true>(F.lds + RING_OFF, g, S, E);
    });
    PHASE(11, { p11_combine(F, args); });
#undef PHASE
#undef IN
#undef SEAM
}

extern "C" void kernel_launch(void* const* d_in, const int* in_sizes, int n_in, void* d_out, int out_size, void* d_ws, size_t ws_size, hipStream_t stream) {
    static int grid = 0;
    if (grid == 0) {
        if (n_in != 26 || in_sizes[0] != NTOK * DM || out_size != NTOK * DM || ws_size < WS_END) {
            fprintf(stderr, "kernel_launch: shape/workspace mismatch (n_in %d, in0 %d, out %d, ws %zu; need ws >= %zu); nothing launched\n", n_in, n_in > 0 ? in_sizes[0] : -1, out_size, ws_size, (size_t)WS_END); grid = -1; return; }
        int dev = 0, cus = 0, per_cu = 0;
        if (hipGetDevice(&dev) != hipSuccess || hipDeviceGetAttribute(&cus, hipDeviceAttributeMultiprocessorCount, dev) != hipSuccess) { fprintf(stderr, "kernel_launch: device query failed\n"); grid = -1; return; }
        if (hipFuncSetAttribute((const void*)hybrid_fwd, hipFuncAttributeMaxDynamicSharedMemorySize, LDS_BYTES) != hipSuccess) { fprintf(stderr, "kernel_launch: hipFuncSetAttribute failed\n"); grid = -1; return; }
        if (hipOccupancyMaxActiveBlocksPerMultiprocessor(&per_cu, (const void*)hybrid_fwd, NWAVES * 64, LDS_BYTES) != hipSuccess || per_cu < 1) { fprintf(stderr, "kernel_launch: occupancy query says %d blocks/CU\n", per_cu); per_cu = 1; }
        (void)hipGetLastError();
        grid = cus;
        if (grid > 256) grid = 256;
    }
    if (grid < 0) return;
    (void)hipMemsetAsync((char*)d_ws + WS_CTL, 0, CTL_ZERO_BYTES, stream);
    Args a{};
    for (int i = 0; i < 26; ++i) a.in[i] = d_in[i];
    a.out = (float*)d_out; a.ws = (unsigned char*)d_ws;
    for (int li = 0; li < N_LAUNCHES; ++li) {
        a.ph_lo = (N_LAUNCHES == 1) ? 0 : li; a.ph_hi = (N_LAUNCHES == 1) ? PER_PHASE : li + 1;
        hipLaunchKernelGGL(hybrid_fwd, dim3(grid), dim3(NWAVES * 64), LDS_BYTES, stream, a);
        const hipError_t le = hipPeekAtLastError();
        if (le != hipSuccess) { fprintf(stderr, "kernel_launch: launch %d failed: %s\n", li, hipGetErrorName(le)); break; }
    }
}
```

```cpp
#include <hip/hip_runtime.h>
#include <hip/hip_bf16.h>
#include <cstdio>
#include <cstdint>
#include <cmath>
namespace pg8 {
#define PG8_LAS __attribute__((address_space(3)))
typedef unsigned short bf16_t;
typedef short bf16x8 __attribute__((ext_vector_type(8)));
typedef float f32x4 __attribute__((ext_vector_type(4)));
typedef unsigned u32x4 __attribute__((ext_vector_type(4)));
constexpr int BM = 256, BK = 64, HALF = 128, HTB = HALF * BK * 2  , STAGE_BYTES = 8 * HTB, NXCD = 8, WGM = 8;

__host__ __device__ __forceinline__ int lds_byte(int r, int c) { const int st = (r >> 4) * 2 + (c >> 5), rr = r & 15, cc = c & 31, ob = rr * 64 + cc * 2; return st * 1024 + (ob ^ (((ob >> 9) & 1) << 5)); }
__host__ __device__ __forceinline__ void stage_rc(int b, int& R, int& C) { const int st = b / 1024, sb = b % 1024, swz = sb ^ (((sb >> 9) & 1) << 5); R = (st >> 1) * 16 + swz / 64; C = (st & 1) * 32 + (swz % 64) / 2; }
__host__ __device__ __forceinline__ int perm32(int rho) { const int n = rho >> 4, i = rho & 15; return 8 * (i >> 2) + 4 * n + (i & 3); }

struct Unit { int pm, pn, kind; };
struct Gemm { const bf16_t* A; const bf16_t* Bt; int M, N, K; };

struct StaticOrder {
    int nM, nN, nwg, G, c;
    __host__ __device__ void init(int M, int N, int G_, int c_) { nM = M / BM; nN = N / BM; nwg = nM * nN; G = G_; c = c_; }
    __host__ __device__ bool next(int i, Unit& u) const {
        const long L = (long)i * G + c; if (L >= nwg) return false;
        int wgid = (int)L; { const int q = nwg / NXCD, r = nwg % NXCD, xcd = wgid % NXCD, off = wgid / NXCD; wgid = (xcd < r ? xcd * (q + 1) : r * (q + 1) + (xcd - r) * q) + off; }
        const int nig = WGM * nN, gid = wgid / nig, fm = gid * WGM, gsz = (nM - fm) < WGM ? (nM - fm) : WGM;
        u.pm = fm + ((wgid % nig) % gsz); u.pn = (wgid % nig) / gsz; return true;
    }
    __device__ __forceinline__ void a_ready(const Unit&) const {}
    __device__ __forceinline__ void done(const Unit&) const {}
};

__device__ __forceinline__ unsigned cvt_pk_bf16(float lo, float hi) { unsigned r; asm volatile("v_cvt_pk_bf16_f32 %0, %1, %2" : "=v"(r) : "v"(lo), "v"(hi)); return r; }
typedef int v4i_t __attribute__((ext_vector_type(4)));
typedef int v8i_t __attribute__((ext_vector_type(8)));
template <class Epi, class Sched, bool ALIGN_EPI = false, bool SP2 = false, bool GATHER = false, bool FP8 = false>
__device__ __forceinline__ void gemm_phase(PG8_LAS unsigned char* lds, const Gemm g, const Sched& S, const Epi& E, const PG8_LAS int* rowlists = nullptr) {
    static_assert(!GATHER || SP2, "GATHER is implemented for the SP2 loop");
    const int tid = threadIdx.x, wid = __builtin_amdgcn_readfirstlane(tid >> 6), lane = tid & 63, wr = wid >> 2, wc = wid & 3, fr = lane & 15, fq = lane >> 4;
    const int K = g.K, nt = K / BK;
    unsigned voffA, voffB; int gR, gC;
    { int R, C; stage_rc(tid * 16, R, C); const int Rb = Epi::PERM ? ((R & ~31) + perm32(R & 31)) : R; gR = R; gC = C;
      voffA = (unsigned)(R * K + C) * 2u; voffB = (unsigned)(Rb * K + C) * 2u; }
    const size_t row64 = (size_t)64 * K * 2;
    const size_t kstep = (size_t)(BK * 2);
    const size_t hstep = (size_t)HALF * K * 2;
    const size_t tstep = 2 * hstep;
    const unsigned ldsw = (unsigned)wid * 1024u;
    const int aoff = lds_byte(wr * 64 + fr, fq * 8), boff = lds_byte(wc * 32 + fr, fq * 8);
#define PG8_SA(b, h) (((b) * 2 + (h)) * HTB)
#define PG8_SB(b, h) ((4 + (b) * 2 + (h)) * HTB)
#define PG8_STAGE2(bufoff, gbase, v0_, v1_) do { unsigned vo0_ = (v0_), vo1_ = (v1_); asm volatile("" : "+v"(vo0_), "+v"(vo1_));     \
        __builtin_amdgcn_global_load_lds((const unsigned*)((const char*)(gbase) + vo0_), (PG8_LAS unsigned*)(lds + (bufoff) + ldsw), 16, 0, 0); \
        __builtin_amdgcn_global_load_lds((const unsigned*)((const char*)(gbase) + vo1_), (PG8_LAS unsigned*)(lds + (bufoff) + ldsw + 8192), 16, 0, 0); } while (0)
#define PG8_STAGE(bufoff, gbase, voff) do { unsigned vo_ = (voff); asm volatile("" : "+v"(vo_)); \
        __builtin_amdgcn_global_load_lds((const unsigned*)((const char*)(gbase) + vo_), (PG8_LAS unsigned*)(lds + (bufoff) + ldsw), 16, 0, 0); \
        __builtin_amdgcn_global_load_lds((const unsigned*)((const char*)(gbase) + row64 + vo_), (PG8_LAS unsigned*)(lds + (bufoff) + ldsw + 8192), 16, 0, 0); } while (0)
#define PG8_LDA(dst, b, h) do { _Pragma("unroll") for (int m = 0; m < 4; ++m) _Pragma("unroll") for (int k = 0; k < 2; ++k) dst[m][k] = *(const PG8_LAS bf16x8*)(lds + PG8_SA(b, h) + aoff + m * 2048 + k * 1024); } while (0)
#define PG8_LDB(dst, b, h) do { _Pragma("unroll") for (int n = 0; n < 2; ++n) _Pragma("unroll") for (int k = 0; k < 2; ++k) dst[n][k] = *(const PG8_LAS bf16x8*)(lds + PG8_SB(b, h) + boff + n * 2048 + k * 1024); } while (0)
#define PG8_CAT8(x, y) __builtin_shufflevector(__builtin_bit_cast(v4i_t, (x)), __builtin_bit_cast(v4i_t, (y)), 0, 1, 2, 3, 4, 5, 6, 7)
#define PG8_MMA(ai, bj, At, Bt) do { __builtin_amdgcn_s_setprio(1); _Pragma("unroll") for (int m = 0; m < 4; ++m) _Pragma("unroll") for (int n = 0; n < 2; ++n) { \
        if constexpr (FP8) { const v8i_t a8_ = PG8_CAT8(Bt[n][0], Bt[n][1]), b8_ = PG8_CAT8(At[m][0], At[m][1]);     \
            asm volatile("v_mfma_scale_f32_16x16x128_f8f6f4 %0, %1, %2, %0, %3, %4 op_sel_hi:[0,0,0]" : "+v"(acc[ai][bj][m][n]) : "v"(a8_), "v"(b8_), "v"(mxsa_), "v"(mxsb_)); } \
        else { _Pragma("unroll") for (int k = 0; k < 2; ++k) acc[ai][bj][m][n] = __builtin_amdgcn_mfma_f32_16x16x32_bf16(Bt[n][k], At[m][k], acc[ai][bj][m][n], 0, 0, 0); } } \
        __builtin_amdgcn_s_setprio(0); } while (0)
#define PG8_WAIT_V(n) asm volatile("s_waitcnt vmcnt(" #n ")" ::: "memory")
#define PG8_WAIT_VN(n) asm volatile("s_waitcnt vmcnt(%0)" :: "i"(n) : "memory")
#define PG8_WAIT_L(n) asm volatile("s_waitcnt lgkmcnt(" #n ")" ::: "memory")
#define PG8_BAR __builtin_amdgcn_s_barrier()
#define PG8_SCHED __builtin_amdgcn_sched_barrier(0)
    Unit cur, nxt; int ui = 0;
    if (!S.next(0, cur)) return;
    int mxsa_ = 121, mxsb_ = 127; asm volatile("" : "+v"(mxsa_), "+v"(mxsb_));
    f32x4 acc[2][2][4][2];
#pragma unroll
    for (int a = 0; a < 2; ++a)
#pragma unroll
        for (int b = 0; b < 2; ++b)
#pragma unroll
            for (int m = 0; m < 4; ++m)
#pragma unroll
                for (int n = 0; n < 2; ++n) acc[a][b][m][n] = (f32x4){0.f, 0.f, 0.f, 0.f};
    bf16x8 At[4][2], B0[2][2], B1[2][2];
    const char* cA = GATHER ? (const char*)S.a_base(cur) : (const char*)g.A + (size_t)cur.pm * tstep; const char* cB = (const char*)g.Bt + (size_t)cur.pn * tstep;
#define PG8_STAGE_A(bufoff, kptr, half, unx) do { if constexpr (GATHER) { const PG8_LAS int* rl_ = rowlists + (ui + (unx)) * 256 + (half) * HALF + gR; \
        PG8_STAGE2(bufoff, kptr, (unsigned)(rl_[0] * K + gC) * 2u, (unsigned)(rl_[64] * K + gC) * 2u); } \
        else { PG8_STAGE(bufoff, (kptr) + (half) * hstep, voffA); } } while (0)
    S.a_ready(cur);
    if constexpr (SP2) {
        PG8_STAGE(PG8_SB(0, 0), cB, voffB); PG8_STAGE(PG8_SB(0, 1), cB + hstep, voffB); PG8_STAGE_A(PG8_SA(0, 0), cA, 0, 0); PG8_STAGE_A(PG8_SA(0, 1), cA, 1, 0);
        if (wr == 1) PG8_BAR;
        PG8_WAIT_V(2); PG8_BAR;
        PG8_STAGE(PG8_SB(1, 0), cB + kstep, voffB); PG8_STAGE_A(PG8_SA(1, 0), cA + kstep, 0, 0); PG8_STAGE(PG8_SB(1, 1), cB + hstep + kstep, voffB);
        PG8_WAIT_V(6); PG8_BAR;
    } else {
        PG8_STAGE(PG8_SB(0, 0), cB, voffB); PG8_STAGE(PG8_SA(0, 0), cA, voffA); PG8_STAGE(PG8_SB(0, 1), cB + hstep, voffB); PG8_STAGE(PG8_SA(0, 1), cA + hstep, voffA);
        if (wr == 1) PG8_BAR;
        PG8_WAIT_V(4); PG8_BAR;
        PG8_STAGE(PG8_SB(1, 0), cB + kstep, voffB); PG8_STAGE(PG8_SA(1, 0), cA + kstep, voffA); PG8_STAGE(PG8_SB(1, 1), cB + hstep + kstep, voffB);
        PG8_WAIT_V(6); PG8_BAR;
    }
    for (;;) {
        const bool has_next = S.next(ui + 1, nxt);
        const char* nA = GATHER ? (has_next ? (const char*)S.a_base(nxt) : cA) : (has_next ? (const char*)g.A + (size_t)nxt.pm * tstep : cA);
        const char* nB = has_next ? (const char*)g.Bt + (size_t)nxt.pn * tstep : cB;
#pragma unroll 1
        for (int t = 0; t < nt; t += 2) {
            const bool last = (t == nt - 2);
            if constexpr (Epi::MIDK) { if (t == (nt >> 1)) { if constexpr (FP8) asm volatile("s_nop 15\n\ts_nop 7" ::: "memory"); E.mid(acc, cur, wr, wc, fr, fq); } }
            const char* a1 = cA + (size_t)(t + 1) * kstep;
            const char* a2 = last ? nA : cA + (size_t)(t + 2) * kstep; const char* b2 = last ? nB : cB + (size_t)(t + 2) * kstep;
            const char* a3 = a2 + kstep; const char* b3 = b2 + kstep;
            if (last && has_next) S.a_ready(nxt);
            const int unx = (GATHER && last && has_next) ? 1 : 0;
            if constexpr (SP2) {
            PG8_LDB(B0, 0, 0); PG8_LDB(B1, 0, 1); PG8_SCHED; PG8_LDA(At, 0, 0); PG8_STAGE_A(PG8_SA(1, 1), a1, 1, 0);
            PG8_WAIT_V(8); PG8_WAIT_L(0); PG8_BAR; PG8_MMA(0, 0, At, B0); PG8_MMA(0, 1, At, B1); PG8_BAR; PG8_SCHED;
            PG8_LDA(At, 0, 1); PG8_STAGE(PG8_SB(0, 0), b2, voffB); PG8_STAGE(PG8_SB(0, 1), b2 + hstep, voffB); PG8_STAGE_A(PG8_SA(0, 0), a2, 0, unx);
            PG8_WAIT_V(8); PG8_WAIT_L(0); PG8_BAR; PG8_MMA(1, 0, At, B0); PG8_MMA(1, 1, At, B1); PG8_BAR; PG8_SCHED;
            PG8_LDB(B0, 1, 0); PG8_LDB(B1, 1, 1); PG8_SCHED; PG8_LDA(At, 1, 0); PG8_STAGE_A(PG8_SA(0, 1), a2, 1, unx);
            PG8_WAIT_V(8); PG8_WAIT_L(0); PG8_BAR; PG8_MMA(0, 0, At, B0); PG8_MMA(0, 1, At, B1); PG8_BAR; PG8_SCHED;
            PG8_LDA(At, 1, 1); PG8_STAGE(PG8_SB(1, 0), b3, voffB); PG8_STAGE(PG8_SB(1, 1), b3 + hstep, voffB); PG8_STAGE_A(PG8_SA(1, 0), a3, 0, unx);
            PG8_WAIT_V(8); PG8_WAIT_L(0); PG8_BAR; PG8_MMA(1, 0, At, B0); PG8_MMA(1, 1, At, B1); PG8_BAR; PG8_SCHED;
            } else {
            PG8_LDB(B0, 0, 0); PG8_SCHED; PG8_LDA(At, 0, 0); PG8_STAGE(PG8_SA(1, 1), a1 + hstep, voffA);
            PG8_WAIT_L(8); PG8_BAR; PG8_WAIT_L(0); PG8_MMA(0, 0, At, B0); PG8_BAR; PG8_SCHED;
            PG8_LDB(B1, 0, 1); PG8_STAGE(PG8_SB(0, 0), b2, voffB);
            PG8_BAR; PG8_WAIT_L(0); PG8_MMA(0, 1, At, B1); PG8_BAR;
            PG8_LDA(At, 0, 1); PG8_STAGE(PG8_SA(0, 0), a2, voffA);
            PG8_BAR; PG8_WAIT_L(0); PG8_MMA(1, 0, At, B0); PG8_BAR; PG8_SCHED;
            PG8_STAGE(PG8_SB(0, 1), b2 + hstep, voffB);
            PG8_WAIT_V(6); PG8_BAR; PG8_MMA(1, 1, At, B1); PG8_BAR;
            PG8_LDB(B0, 1, 0); PG8_SCHED; PG8_LDA(At, 1, 0); PG8_STAGE(PG8_SA(0, 1), a2 + hstep, voffA);
            PG8_WAIT_L(8); PG8_BAR; PG8_WAIT_L(0); PG8_MMA(0, 0, At, B0); PG8_BAR; PG8_SCHED;
            PG8_LDB(B1, 1, 1); PG8_STAGE(PG8_SB(1, 0), b3, voffB);
            PG8_BAR; PG8_WAIT_L(0); PG8_MMA(0, 1, At, B1); PG8_BAR;
            PG8_LDA(At, 1, 1); PG8_STAGE(PG8_SA(1, 0), a3, voffA);
            PG8_BAR; PG8_WAIT_L(0); PG8_MMA(1, 0, At, B0); PG8_BAR; PG8_SCHED;
            PG8_STAGE(PG8_SB(1, 1), b3 + hstep, voffB);
            PG8_WAIT_V(6); PG8_BAR; PG8_MMA(1, 1, At, B1); PG8_BAR;
            }
        }
        if constexpr (ALIGN_EPI) { if (wr == 0) PG8_BAR; }
        if constexpr (FP8) asm volatile("s_nop 15\n\ts_nop 7" ::: "memory");
        if constexpr (!Epi::AFTER_DRAIN) { E(acc, cur, wr, wc, fr, fq); S.done(cur); }
        if (!has_next) break;
#pragma unroll
        for (int a = 0; a < 2; ++a)
#pragma unroll
            for (int b = 0; b < 2; ++b)
#pragma unroll
                for (int m = 0; m < 4; ++m)
#pragma unroll
                    for (int n = 0; n < 2; ++n) acc[a][b][m][n] = (f32x4){0.f, 0.f, 0.f, 0.f};
        cur = nxt; cA = nA; cB = nB; ++ui;
        if constexpr (ALIGN_EPI) { if (wr == 1) PG8_BAR; }
    }
    PG8_WAIT_V(0);
    if constexpr (!ALIGN_EPI) { if (wr == 0) PG8_BAR; }
    PG8_BAR;
    if constexpr (Epi::AFTER_DRAIN) { E.fused(acc, cur, wr, wc, fr, fq, lds, wid, lane); S.done(cur); }
#undef PG8_SA
#undef PG8_STAGE_A
#undef PG8_SB
#undef PG8_STAGE
#undef PG8_STAGE2
#undef PG8_LDA
#undef PG8_LDB
#undef PG8_MMA
#undef PG8_CAT8
#undef PG8_WAIT_V
#undef PG8_WAIT_VN
#undef PG8_WAIT_L
#undef PG8_BAR
#undef PG8_SCHED
}
}

constexpr int NB = 4, SEQ = 4096, DM = 1024, NTOK = NB * SEQ, DIN = 7168, NH = 8, HD = 128;
constexpr int NEXP = 32, TOPK = 4, MAXBLK = 288, RMAX = MAXBLK * 256;
constexpr float EPS = 1e-6f;
constexpr int NWAVES = 8;

constexpr size_t MiB = 1u << 20, KiB = 1u << 10;
constexpr size_t WS_CTL = 0, CTL_ZERO_BYTES = 1 * MiB;
constexpr size_t WS_MOD = 1 * MiB;
constexpr size_t WS_KMEAN = 1 * MiB + 128 * KiB;
constexpr size_t WS_AGGP = 1 * MiB + 384 * KiB;
constexpr size_t WS_AGGH = 1 * MiB + 640 * KiB;
constexpr size_t WS_WRH = 2 * MiB, WS_WRL = 2 * MiB + 64 * KiB;
constexpr size_t WS_TOKE = 3 * MiB, WS_TOKPOS = 3 * MiB + 256 * KiB;
constexpr int ECAP = 16384;
constexpr size_t WS_ROWTOK = 28 * MiB, WS_ROWGATE = 30 * MiB;
constexpr int CW_UPDONE = 16384;
constexpr int CW_QUEUE = 12288;
constexpr int CW_CNT = 8192;
constexpr size_t WS_TRIG = 4 * MiB;
constexpr size_t WS_WRG = 6 * MiB;
constexpr size_t WS_WIN = 8 * MiB;
constexpr size_t WS_WIN8 = 16 * MiB;
constexpr size_t WS_H8 = 544 * MiB;
constexpr size_t WS_WB = 22 * MiB;
constexpr size_t WS_WO = 26 * MiB;
constexpr size_t WS_WUP = 32 * MiB;
constexpr size_t WS_WDN = 96 * MiB;
constexpr size_t WS_HB = 224 * MiB;
constexpr size_t WS_E = 256 * MiB;
constexpr size_t E_STRIDE = (size_t)NTOK * DM;
constexpr size_t WS_D1 = 256 * MiB;
constexpr size_t WS_HL = 480 * MiB, WS_PP = 512 * MiB, WS_YCAT = 544 * MiB;
constexpr int CW_MODCNT = 8256;
constexpr size_t WS_ACT = 400 * MiB, WS_YR = 544 * MiB;
constexpr size_t WS_END = 688 * MiB;
constexpr int CW_BAR = 4096;

constexpr int RING_OFF = 0, RING_BYTES = 131072;
constexpr int LDSCTL_OFF = RING_BYTES, MISC_OFF = LDSCTL_OFF + 320;
constexpr int XTRA_OFF = LDSCTL_OFF + 1024;
constexpr int LDS_BYTES = 155648;

#define GAS __attribute__((address_space(1)))
#define LAS __attribute__((address_space(3)))
typedef unsigned short bf16;
typedef unsigned v4u __attribute__((ext_vector_type(4)));
typedef unsigned v2u __attribute__((ext_vector_type(2)));
typedef float f32x4 __attribute__((ext_vector_type(4)));
typedef float f32x2 __attribute__((ext_vector_type(2)));
typedef float f32x16 __attribute__((ext_vector_type(16)));
typedef short bf16x8 __attribute__((ext_vector_type(8)));
typedef short s16x4 __attribute__((ext_vector_type(4)));
typedef GAS unsigned gu32;
#define RLX_AGENT __ATOMIC_RELAXED, __HIP_MEMORY_SCOPE_AGENT
#define LDS_WAIT() asm volatile("s_waitcnt lgkmcnt(0)" ::: "memory")
#define VM_WAIT() asm volatile("s_waitcnt vmcnt(0)" ::: "memory")
#define SBAR() __builtin_amdgcn_sched_barrier(0)
__device__ __forceinline__ unsigned f2bf(float f) { unsigned u = __builtin_bit_cast(unsigned, f); return (u + 0x7fffu + ((u >> 16) & 1u)) >> 16; }
__device__ __forceinline__ unsigned pk2(float lo, float hi) { return f2bf(lo) | (f2bf(hi) << 16); }
__device__ __forceinline__ float bf2f(unsigned short h) { return __builtin_bit_cast(float, (unsigned)h << 16); }
__device__ __forceinline__ float bflo(unsigned w) { return __builtin_bit_cast(float, w << 16); }
__device__ __forceinline__ float bfhi(unsigned w) { return __builtin_bit_cast(float, w & 0xffff0000u); }
__device__ __forceinline__ unsigned cvtpk(float lo, float hi) { unsigned r; asm volatile("v_cvt_pk_bf16_f32 %0, %1, %2" : "=v"(r) : "v"(lo), "v"(hi)); return r; }
__device__ __forceinline__ float fast_sigmoid(float x) { return __builtin_amdgcn_rcpf(1.0f + __builtin_amdgcn_exp2f(-1.4426950408889634f * x)); }
__device__ __forceinline__ float gelu_tanh(float x) { const float z = 1.5957691216057308f * (x + 0.044715f * x * x * x); return x * fast_sigmoid(z); }
__device__ __forceinline__ f32x2 sigmoid_pk(f32x2 x) { const f32x2 z = x * (-1.4426950408889634f); f32x2 e; e.x = __builtin_amdgcn_exp2f(z.x); e.y = __builtin_amdgcn_exp2f(z.y);
    const f32x2 d = e + 1.0f; f32x2 r; r.x = __builtin_amdgcn_rcpf(d.x); r.y = __builtin_amdgcn_rcpf(d.y); return r; }
__device__ __forceinline__ f32x2 gelu_tanh_pk(f32x2 x) {
    const f32x2 u = x * x, w = u * (-0.044715f * 1.5957691216057308f * 1.4426950408889634f) + (-1.5957691216057308f * 1.4426950408889634f), z = x * w;
    f32x2 e; e.x = __builtin_amdgcn_exp2f(z.x); e.y = __builtin_amdgcn_exp2f(z.y);
    const f32x2 d = e + 1.0f; f32x2 r; r.x = __builtin_amdgcn_rcpf(d.x); r.y = __builtin_amdgcn_rcpf(d.y); return x * r; }
__device__ __forceinline__ float wave_sum(float v) {
#pragma unroll
    for (int o = 1; o < 64; o <<= 1) v += __shfl_xor(v, o);
    return v;
}
__device__ __forceinline__ float wave_max(float v) {
#pragma unroll
    for (int o = 1; o < 64; o <<= 1) v = fmaxf(v, __shfl_xor(v, o));
    return v;
}

#define XB_TMO      128
#define XB_XCNT(j)  (256  + 64 * (j))
#define XB_XSUB(j)  (1280 + 64 * (j))
#define XB_XGEN(j)  (2304 + 64 * (j))
#define XB_TOP      3328
#define XB_TOPGEN   3392
#define XCD_BAR_WORDS 3456
#define XB_SPIN_CAP (1u << 20)
__device__ __forceinline__ unsigned xb_ld(unsigned* p)              { return __hip_atomic_load(p, __ATOMIC_RELAXED, __HIP_MEMORY_SCOPE_AGENT); }
__device__ __forceinline__ unsigned xb_add(unsigned* p, unsigned v) { return __hip_atomic_fetch_add(p, v, __ATOMIC_RELAXED, __HIP_MEMORY_SCOPE_AGENT); }
__device__ __forceinline__ unsigned xb_xcc_id() { return (unsigned)__builtin_amdgcn_s_getreg((3 << 11) | 20) & 0xFu; }
#define XB_SPIN(cond, bar) do { unsigned _sp = 0; while (cond) { __builtin_amdgcn_s_sleep(1); \
    if ((++_sp & 255u) == 0u) { if (xb_ld(&(bar)[XB_TMO])) break; if (_sp > XB_SPIN_CAP) { atomicAdd(&(bar)[XB_TMO], 1u); break; } } } } while (0)
struct XcdBarrier { unsigned* bar; unsigned x; volatile LAS unsigned* st; };
__device__ __forceinline__ XcdBarrier xcd_barrier_post(unsigned* bar, volatile LAS unsigned* st) {
    XcdBarrier b; b.bar = bar; b.x = xb_xcc_id(); b.st = st;
    if (threadIdx.x == 0) (void)xb_add(&bar[XB_XCNT(b.x)], 1u);
    return b;
}
__device__ __forceinline__ void xcd_barrier_complete(unsigned* bar, unsigned x, unsigned& nloc, unsigned& nx) {
    const unsigned G = gridDim.x * gridDim.y * gridDim.z;
    unsigned sum, cnt, mine, sp = 0u;
    for (;;) {
        sum = 0u; cnt = 0u; mine = 0u;
#pragma unroll
        for (unsigned j = 0; j < 16; ++j) { const unsigned c = xb_ld(&bar[XB_XCNT(j)]); sum += c; cnt += (c > 0u) ? 1u : 0u; mine = (j == x) ? c : mine; }
        if (sum == G) break;
        __builtin_amdgcn_s_sleep(1);
        if ((++sp & 255u) == 0u) { if (xb_ld(&bar[XB_TMO])) break; if (sp > XB_SPIN_CAP) { atomicAdd(&bar[XB_TMO], 1u); break; } }
    }
    nloc = mine > 0u ? mine : 1u; nx = cnt > 0u ? cnt : 1u;
}
__device__ __forceinline__ void xcd_barrier(const XcdBarrier& b) {
    asm volatile("s_waitcnt vmcnt(0)" ::: "memory");
    __syncthreads();
    if (threadIdx.x == 0) {
        unsigned* bar = b.bar;
        __builtin_amdgcn_s_waitcnt(0);
        unsigned nloc = b.st[0], nx = b.st[1];
        if (nloc == 0u) { xcd_barrier_complete(bar, b.x, nloc, nx); b.st[0] = nloc; b.st[1] = nx; }
        const unsigned old = xb_add(&bar[XB_XSUB(b.x)], 1u);
        const unsigned gen = old / nloc;
        if (old + 1u == (gen + 1u) * nloc) {
            __builtin_amdgcn_fence(__ATOMIC_RELEASE, "agent");
            asm volatile("s_waitcnt vmcnt(0)" ::: "memory");
            const unsigned og = xb_add(&bar[XB_TOP], 1u);
            const unsigned tg = og / nx;
            if (og + 1u == (tg + 1u) * nx) xb_add(&bar[XB_TOPGEN], 1u);
            else XB_SPIN(xb_ld(&bar[XB_TOPGEN]) == tg, bar);
            __builtin_amdgcn_fence(__ATOMIC_ACQUIRE, "agent");
            xb_add(&bar[XB_XGEN(b.x)], 1u);
            asm volatile("s_waitcnt vmcnt(0)" ::: "memory");
        } else {
            XB_SPIN(xb_ld(&bar[XB_XGEN(b.x)]) == gen, bar);
            __builtin_amdgcn_fence(__ATOMIC_ACQUIRE, "agent");
            asm volatile("s_waitcnt vmcnt(0)" ::: "memory");
        }
    }
    __syncthreads();
}

struct Args { const void* in[26]; float* out; unsigned char* ws; int ph_lo, ph_hi; };
struct Frame {
    LAS unsigned char* lds; char* ldsg;
    volatile LAS unsigned* MISC;
    int tid, lane, wave, vcu, G;
    unsigned char* ws; float* out;
};
#define IN_F(k) ((const float*)args.in[k])
#define IN_I(k) ((const int*)args.in[k])
#define WSP(T, off) ((T*)(F.ws + (off)))

namespace pg8 {
struct TileOrder {
    int nM, nN, nwg, G, c; const LAS int* blk_exp; const void* abase;
    __device__ __forceinline__ void init(int nM_, int nN_, int G_, int c_, const LAS int* be, const void* ab = nullptr) { nM = nM_; nN = nN_; nwg = nM * nN; G = G_; c = c_; blk_exp = be; abase = ab; }
    __device__ __forceinline__ const void* a_base(const Unit&) const { return abase; }
    __device__ __forceinline__ bool next(int i, Unit& u) const {
        const long L = (long)i * G + c; if (L >= nwg) return false;
        int wgid = (int)L; { const int q = nwg / NXCD, r = nwg % NXCD, xcd = wgid % NXCD, off = wgid / NXCD; wgid = (xcd < r ? xcd * (q + 1) : r * (q + 1) + (xcd - r) * q) + off; }
        const int nig = WGM * nN, gid = wgid / nig, fm = gid * WGM, gsz = (nM - fm) < WGM ? (nM - fm) : WGM;
        u.pm = fm + ((wgid % nig) % gsz); u.pn = (wgid % nig) / gsz; u.kind = 0;
        if (blk_exp) { const int e = __builtin_amdgcn_readfirstlane(blk_exp[u.pm]); u.pn += e * nN; }
        return true;
    }
    __device__ __forceinline__ void a_ready(const Unit&) const {}
    __device__ __forceinline__ void done(const Unit&) const {}
};

__device__ __forceinline__ void st16_wt(void* p, u32x4 v) { asm volatile("global_store_dwordx4 %0, %1, off sc1\n\ts_nop 1" :: "v"(p), "v"(v) : "memory"); }
struct EpiWin {
    static constexpr bool PERM = true, AFTER_DRAIN = false, MIDK = false; static constexpr int NSTORES = 16;
    bf16_t* E; const float* b_gate; int mode;
    __device__ __forceinline__ void operator()(const f32x4 (&acc)[2][2][4][2], const Unit& u, int wr, int wc, int fr, int fq) const {
        int row0 = u.pm * BM + wr * 64 + fr;
        asm volatile("" : "+v"(row0));
        if (mode == 1 && u.pn >= 8) {
            const int d0 = (u.pn - 8) * 128 + wc * 32 + 8 * fq;
            bf16_t* Rb = E + (size_t)5 * ((size_t)16384 * 1024); bf16_t* Sb = E + (size_t)6 * ((size_t)16384 * 1024);
            f32x4 b0[2], b1[2];
#pragma unroll
            for (int n = 0; n < 2; ++n) { b0[n] = *(const f32x4*)(b_gate + d0 + 4 * n); b1[n] = *(const f32x4*)(b_gate + 1024 + d0 + 4 * n); }
#pragma unroll
            for (int ai = 0; ai < 2; ++ai)
#pragma unroll
                for (int m = 0; m < 4; ++m) { const size_t ro = (size_t)(row0 + ai * HALF + m * 16) * 1024 + d0;
                    float r[8], s1[8];
#pragma unroll
                    for (int n = 0; n < 2; ++n)
#pragma unroll
                        for (int j = 0; j < 4; j += 2) { const f32x2 x0 = (f32x2){acc[ai][0][m][n][j], acc[ai][0][m][n][j + 1]} + (f32x2){b0[n][j], b0[n][j + 1]}, x1 = (f32x2){acc[ai][1][m][n][j], acc[ai][1][m][n][j + 1]} + (f32x2){b1[n][j], b1[n][j + 1]};
                            const f32x2 z0 = x0 * (-1.4426950408889634f), z1 = x1 * (-1.4426950408889634f);
                            f32x2 e0, e1; e0.x = __builtin_amdgcn_exp2f(z0.x); e0.y = __builtin_amdgcn_exp2f(z0.y); e1.x = fminf(__builtin_amdgcn_exp2f(z1.x), 1e18f); e1.y = fminf(__builtin_amdgcn_exp2f(z1.y), 1e18f);
                            const f32x2 dn0 = e0 + 1.0f, dn1 = e1 + 1.0f; f32x2 q0, q1; q0.x = __builtin_amdgcn_rcpf(dn0.x); q0.y = __builtin_amdgcn_rcpf(dn0.y); q1.x = __builtin_amdgcn_rcpf(dn1.x); q1.y = __builtin_amdgcn_rcpf(dn1.y);
                            const f32x2 rr = dn1 * q0; r[4 * n + j] = rr.x; r[4 * n + j + 1] = rr.y; s1[4 * n + j] = q1.x; s1[4 * n + j + 1] = q1.y; }
                    u32x4 w; w.x = cvt_pk_bf16(r[0], r[1]); w.y = cvt_pk_bf16(r[2], r[3]); w.z = cvt_pk_bf16(r[4], r[5]); w.w = cvt_pk_bf16(r[6], r[7]); *(u32x4*)(Rb + ro) = w;
                    u32x4 v; v.x = cvt_pk_bf16(s1[0], s1[1]); v.y = cvt_pk_bf16(s1[2], s1[3]); v.z = cvt_pk_bf16(s1[4], s1[5]); v.w = cvt_pk_bf16(s1[6], s1[7]); *(u32x4*)(Sb + ro) = v; }
            return;
        }
        const int opn = mode == 0 ? (u.pn < 8 ? u.pn : u.pn + 8) : u.pn + 8;
        const int t = opn >> 2, colt = (opn & 3) * BM;
        bf16_t* base = E + (size_t)t * ((size_t)16384 * 1024);
        const int col0 = colt + wc * 32 + 8 * fq;
#pragma unroll
        for (int ai = 0; ai < 2; ++ai)
#pragma unroll
            for (int m = 0; m < 4; ++m) { bf16_t* rowp = base + (size_t)(row0 + ai * HALF + m * 16) * 1024 + col0;
#pragma unroll
                for (int bj = 0; bj < 2; ++bj) { f32x4 v0 = acc[ai][bj][m][0], v1 = acc[ai][bj][m][1];
                    if (t == 1) { const f32x2 a = gelu_tanh_pk((f32x2){v0[0], v0[1]}), b = gelu_tanh_pk((f32x2){v0[2], v0[3]}), c = gelu_tanh_pk((f32x2){v1[0], v1[1]}), d = gelu_tanh_pk((f32x2){v1[2], v1[3]});
                        v0 = (f32x4){a.x, a.y, b.x, b.y}; v1 = (f32x4){c.x, c.y, d.x, d.y}; }
                    u32x4 w; w.x = cvt_pk_bf16(v0[0], v0[1]); w.y = cvt_pk_bf16(v0[2], v0[3]); w.z = cvt_pk_bf16(v1[0], v1[1]); w.w = cvt_pk_bf16(v1[2], v1[3]);
                    *(u32x4*)(rowp + bj * HALF) = w; } }
    }
};
struct EpiBranch {
    static constexpr bool PERM = true, AFTER_DRAIN = false, MIDK = true; static constexpr int NSTORES = 16;
    const bf16_t* R; const bf16_t* S1; bf16_t* MIX;
    __device__ __forceinline__ void mid(f32x4 (&acc)[2][2][4][2], const Unit& u, int wr, int wc, int fr, int fq) const {
        int row0 = u.pm * BM + wr * 64 + fr; const int col0 = u.pn * BM + wc * 32 + 8 * fq;
        asm volatile("" : "+v"(row0));
#pragma unroll
        for (int ai = 0; ai < 2; ++ai) { u32x4 a[4][2];
#pragma unroll
            for (int m = 0; m < 4; ++m)
#pragma unroll
                for (int bj = 0; bj < 2; ++bj) a[m][bj] = *(const u32x4*)(R + (size_t)(row0 + ai * HALF + m * 16) * 1024 + col0 + bj * HALF);
#pragma unroll
            for (int m = 0; m < 4; ++m)
#pragma unroll
                for (int bj = 0; bj < 2; ++bj) { acc[ai][bj][m][0] *= (f32x4){bflo(a[m][bj].x), bfhi(a[m][bj].x), bflo(a[m][bj].y), bfhi(a[m][bj].y)}; acc[ai][bj][m][1] *= (f32x4){bflo(a[m][bj].z), bfhi(a[m][bj].z), bflo(a[m][bj].w), bfhi(a[m][bj].w)}; }
            asm volatile("" ::: "memory"); }
    }
    __device__ __forceinline__ void operator()(const f32x4 (&acc)[2][2][4][2], const Unit& u, int wr, int wc, int fr, int fq) const {
        int row0 = u.pm * BM + wr * 64 + fr; const int col0 = u.pn * BM + wc * 32 + 8 * fq;
        asm volatile("" : "+v"(row0));
#pragma unroll
        for (int ai = 0; ai < 2; ++ai) { u32x4 b[4][2];
#pragma unroll
            for (int m = 0; m < 4; ++m)
#pragma unroll
                for (int bj = 0; bj < 2; ++bj) b[m][bj] = *(const u32x4*)(S1 + (size_t)(row0 + ai * HALF + m * 16) * 1024 + col0 + bj * HALF);
#pragma unroll
            for (int m = 0; m < 4; ++m)
#pragma unroll
                for (int bj = 0; bj < 2; ++bj) { const size_t o = (size_t)(row0 + ai * HALF + m * 16) * 1024 + col0 + bj * HALF;
                    const f32x4 v0 = acc[ai][bj][m][0] * (f32x4){bflo(b[m][bj].x), bfhi(b[m][bj].x), bflo(b[m][bj].y), bfhi(b[m][bj].y)}, v1 = acc[ai][bj][m][1] * (f32x4){bflo(b[m][bj].z), bfhi(b[m][bj].z), bflo(b[m][bj].w), bfhi(b[m][bj].w)};
                    u32x4 w; w.x = cvt_pk_bf16(v0[0], v0[1]); w.y = cvt_pk_bf16(v0[2], v0[3]); w.z = cvt_pk_bf16(v1[0], v1[1]); w.w = cvt_pk_bf16(v1[2], v1[3]);
                    *(u32x4*)(MIX + o) = w; }
            asm volatile("" ::: "memory"); }
    }
};
struct EpiWout {
    static constexpr bool PERM = true, AFTER_DRAIN = false, MIDK = false; static constexpr int NSTORES = 16;
    bf16_t* D1; const float* mod;
    __device__ __forceinline__ void operator()(const f32x4 (&acc)[2][2][4][2], const Unit& u, int wr, int wc, int fr, int fq) const {
        int row0 = u.pm * BM + wr * 64 + fr; const int col0 = u.pn * BM + wc * 32 + 8 * fq;
        asm volatile("" : "+v"(row0));
        const float* g1p = mod + (size_t)(u.pm >> 4) * 6144 + 2048;
        f32x4 gv[2][2];
#pragma unroll
        for (int bj = 0; bj < 2; ++bj)
#pragma unroll
            for (int n = 0; n < 2; ++n) gv[bj][n] = *(const f32x4*)(g1p + col0 + bj * HALF + 4 * n);
#pragma unroll
        for (int ai = 0; ai < 2; ++ai)
#pragma unroll
            for (int m = 0; m < 4; ++m) { bf16_t* rowp = D1 + (size_t)(row0 + ai * HALF + m * 16) * 1024 + col0;
#pragma unroll
                for (int bj = 0; bj < 2; ++bj) { const f32x4 v0 = acc[ai][bj][m][0] * gv[bj][0], v1 = acc[ai][bj][m][1] * gv[bj][1];
                    u32x4 w; w.x = cvt_pk_bf16(v0[0], v0[1]); w.y = cvt_pk_bf16(v0[2], v0[3]); w.z = cvt_pk_bf16(v1[0], v1[1]); w.w = cvt_pk_bf16(v1[2], v1[3]);
                    *(u32x4*)(rowp + bj * HALF) = w; } }
    }
};
__device__ __forceinline__ unsigned pk_fp8x4(float a, float b, float c, float d) { int p = __builtin_amdgcn_cvt_pk_fp8_f32(a, b, 0, false); p = __builtin_amdgcn_cvt_pk_fp8_f32(c, d, p, true); return (unsigned)p; }
struct EpiUp {
    static constexpr bool PERM = true, AFTER_DRAIN = false, MIDK = false; static constexpr int NSTORES = 8;
    unsigned char* ACT; const float* b_up;
    __device__ __forceinline__ void operator()(const f32x4 (&acc)[2][2][4][2], const Unit& u, int wr, int wc, int fr, int fq) const {
        const int e = u.pn >> 3, p = u.pn & 7;
        int row0 = u.pm * BM + wr * 64 + fr; const int c0 = p * 128 + wc * 32 + 8 * fq;
        asm volatile("" : "+v"(row0));
        const float* bg = b_up + (size_t)e * 2048 + c0; const float* bl = bg + 1024;
        f32x4 bgv[2], blv[2];
#pragma unroll
        for (int n = 0; n < 2; ++n) { bgv[n] = *(const f32x4*)(bg + 4 * n); blv[n] = *(const f32x4*)(bl + 4 * n) + 1.0f; }
#pragma unroll
        for (int ai = 0; ai < 2; ++ai)
#pragma unroll
            for (int m = 0; m < 4; ++m) { unsigned char* rowp = ACT + (size_t)(row0 + ai * HALF + m * 16) * 1024 + c0;
                f32x4 a[2];
#pragma unroll
                for (int n = 0; n < 2; ++n) {
#pragma unroll
                    for (int j = 0; j < 4; j += 2) { f32x2 g = (f32x2){acc[ai][0][m][n][j], acc[ai][0][m][n][j + 1]} + (f32x2){bgv[n][j], bgv[n][j + 1]};
                        f32x2 l = (f32x2){acc[ai][1][m][n][j], acc[ai][1][m][n][j + 1]} + (f32x2){blv[n][j], blv[n][j + 1]};
                        g.x = fminf(g.x, 7.0f); g.y = fminf(g.y, 7.0f); l.x = __builtin_amdgcn_fmed3f(l.x, -6.0f, 8.0f); l.y = __builtin_amdgcn_fmed3f(l.y, -6.0f, 8.0f);
                        const f32x2 z = g * (-1.702f * 1.4426950408889634f); f32x2 e; e.x = __builtin_amdgcn_exp2f(z.x); e.y = __builtin_amdgcn_exp2f(z.y);
                        const f32x2 d = e + 1.0f; f32x2 r; r.x = __builtin_amdgcn_rcpf(d.x); r.y = __builtin_amdgcn_rcpf(d.y);
                        const f32x2 o = (l * g) * r; a[n][j] = o.x; a[n][j + 1] = o.y; } }
                typedef unsigned u32x2_t __attribute__((ext_vector_type(2)));
                u32x2_t w; w.x = pk_fp8x4(a[0][0], a[0][1], a[0][2], a[0][3]); w.y = pk_fp8x4(a[1][0], a[1][1], a[1][2], a[1][3]);
                *(u32x2_t*)rowp = w; }
    }
};
struct EpiDown {
    static constexpr bool PERM = true, AFTER_DRAIN = false, MIDK = false; static constexpr int NSTORES = 16;
    unsigned char* YR; const float* b_down; const float* row_gate; const LAS int* tbl; LAS unsigned char* stage;
    __device__ __forceinline__ void operator()(const f32x4 (&acc)[2][2][4][2], const Unit& u, int wr, int wc, int fr, int fq) const {
        const int e = u.pn >> 2, p = u.pn & 3;
        int row0 = u.pm * BM + wr * 64 + fr; const int c0 = p * BM + wc * 32 + 8 * fq;
        asm volatile("" : "+v"(row0));
        const int pos0 = row0 - tbl[32 + e] * 256, cnt = tbl[e];
        const float* gp = row_gate + (size_t)e * 16384 + pos0;
        float gt[2][4];
#pragma unroll
        for (int ai = 0; ai < 2; ++ai)
#pragma unroll
            for (int m = 0; m < 4; ++m) { const int o = ai * HALF + m * 16; gt[ai][m] = (pos0 + o < cnt) ? gp[o] * 16.0f : 0.0f; }
        f32x4 bv[2][2];
#pragma unroll
        for (int bj = 0; bj < 2; ++bj)
#pragma unroll
            for (int n = 0; n < 2; ++n) bv[bj][n] = *(const f32x4*)(b_down + (size_t)e * 1024 + c0 + bj * HALF + 4 * n);
        typedef unsigned u32x2_t __attribute__((ext_vector_type(2)));
        const int lane = (int)(threadIdx.x & 63), wv = (int)(threadIdx.x >> 6);
        LAS unsigned char* stg = stage + wv * 1024;
        const int srow = lane >> 2, sch = lane & 3;
#pragma unroll
        for (int ai = 0; ai < 2; ++ai)
#pragma unroll
            for (int m = 0; m < 4; ++m) { const float g = gt[ai][m];
#pragma unroll
                for (int bj = 0; bj < 2; ++bj) { const f32x4 v0 = (acc[ai][bj][m][0] + bv[bj][0]) * g, v1 = (acc[ai][bj][m][1] + bv[bj][1]) * g;
                    u32x2_t w; w.x = pk_fp8x4(v0[0], v0[1], v0[2], v0[3]); w.y = pk_fp8x4(v1[0], v1[1], v1[2], v1[3]);
                    *(LAS u32x2_t*)(stg + fr * 64 + bj * 32 + 8 * fq) = w; }
                asm volatile("s_waitcnt lgkmcnt(0)" ::: "memory");
                const u32x4 o = *(const LAS u32x4*)(stg + srow * 64 + sch * 16);
                asm volatile("s_waitcnt lgkmcnt(0)" ::: "memory");
                const int r = u.pm * BM + wr * 64 + ai * HALF + m * 16 + srow;
                *(u32x4*)(YR + (size_t)r * 1024 + p * BM + wc * 32 + (sch >> 1) * HALF + (sch & 1) * 16) = o; }
    }
};
}

__device__ __forceinline__ void p0_transpose_item(const float* W, int N, bf16* WT, int Kd, size_t dst_row0, LAS float* scr, int k0, int n0, int lane) {
#pragma unroll 8
    for (int i = 0; i < 32; ++i) { const int kk = 2 * i + (lane >> 5); scr[kk * 33 + (lane & 31)] = W[(size_t)(k0 + kk) * N + n0 + (lane & 31)]; }
    LDS_WAIT(); asm volatile("" ::: "memory");
    const int c = lane & 7;
#pragma unroll
    for (int j = 0; j < 4; ++j) { const int n = (lane >> 3) + 8 * j; const LAS float* s = scr + (8 * c) * 33 + n;
        v4u o; o.x = pk2(s[0 * 33], s[1 * 33]); o.y = pk2(s[2 * 33], s[3 * 33]); o.z = pk2(s[4 * 33], s[5 * 33]); o.w = pk2(s[6 * 33], s[7 * 33]);
        *(GAS v4u*)(WT + (dst_row0 + n) * (size_t)Kd + k0 + 8 * c) = o; }
    LDS_WAIT(); asm volatile("" ::: "memory");
}
__device__ __forceinline__ void p8_transpose_item_fp8(const float* W, int N, unsigned char* WT, int Kd, size_t dst_row0, LAS float* scr, int k0, int n0, int lane) {
#pragma unroll 8
    for (int i = 0; i < 32; ++i) { const int kk = 2 * i + (lane >> 5); scr[kk * 33 + (lane & 31)] = W[(size_t)(k0 + kk) * N + n0 + (lane & 31)] * 64.0f; }
    LDS_WAIT(); asm volatile("" ::: "memory");
    const int c = lane & 7;
#pragma unroll
    for (int j = 0; j < 4; ++j) { const int n = (lane >> 3) + 8 * j; const LAS float* s = scr + (8 * c) * 33 + n;
        v2u o; o.x = pg8::pk_fp8x4(s[0 * 33], s[1 * 33], s[2 * 33], s[3 * 33]); o.y = pg8::pk_fp8x4(s[4 * 33], s[5 * 33], s[6 * 33], s[7 * 33]);
        *(GAS v2u*)(WT + (dst_row0 + n) * (size_t)Kd + k0 + 8 * c) = o; }
    LDS_WAIT(); asm volatile("" ::: "memory");
}
__device__ __forceinline__ void p0_prologue(Frame& F, const Args& args) {
    const float* c_in = IN_F(1); const int* pos = IN_I(2); const float* ada_w = IN_F(3); const float* ada_b = IN_F(4);
    for (int task = F.vcu; task < 192; task += F.G) {
        LAS float* sc = (LAS float*)F.lds;
        LAS float* red = (LAS float*)(F.lds + 16384);
        for (int i = F.tid; i < 4096; i += 512) { const float v = c_in[i]; sc[i] = v / (1.0f + expf(-v)); }
        __syncthreads();
        const int colq = F.lane & 7, kq = F.lane >> 3, col = task * 32 + colq * 4;
        float acc[4][4];
#pragma unroll
        for (int b = 0; b < 4; ++b)
#pragma unroll
            for (int j = 0; j < 4; ++j) acc[b][j] = 0.f;
#pragma unroll 8
        for (int s = 0; s < 16; ++s) { const int k = F.wave * 128 + s * 8 + kq; const f32x4 wv = *(const f32x4*)(ada_w + (size_t)k * 6144 + col);
#pragma unroll
            for (int b = 0; b < 4; ++b) { const float sv = sc[b * 1024 + k];
#pragma unroll
                for (int j = 0; j < 4; ++j) acc[b][j] += sv * wv[j]; } }
#pragma unroll
        for (int b = 0; b < 4; ++b)
#pragma unroll
            for (int j = 0; j < 4; ++j) { float v = acc[b][j]; v += __shfl_xor(v, 8); v += __shfl_xor(v, 16); v += __shfl_xor(v, 32); if (kq == 0) red[(F.wave * 4 + b) * 32 + colq * 4 + j] = v; }
        __syncthreads();
        if (F.tid < 128) { const int b = F.tid >> 5, cc = F.tid & 31; float s = ada_b[task * 32 + cc];
#pragma unroll
            for (int w = 0; w < 8; ++w) s += red[(w * 4 + b) * 32 + cc];
            WSP(float, WS_MOD)[b * 6144 + task * 32 + cc] = s; }
        VM_WAIT(); __syncthreads();
        if (F.tid == 0) { __builtin_amdgcn_fence(__ATOMIC_RELEASE, "agent"); VM_WAIT(); __hip_atomic_fetch_add((unsigned*)(F.ws + WS_CTL) + CW_MODCNT, 1u, RLX_AGENT); }
    }
    const int gt = F.vcu * 512 + F.tid, NGT = F.G * 512;
    for (int idx = gt; idx < NTOK * 16; idx += NGT) { const int m = idx >> 4, i = idx & 15;
        double freq = 1.0; for (int q = 0; q < i; ++q) freq *= 0.44036660267178046;
        const double ang = (double)pos[m] * freq; const double nr = __builtin_rint(ang * 0.15915494309189535);
        const float r = (float)__builtin_fma(-nr, 6.283185307179586, ang);
        float sn, cs; sincosf(r, &sn, &cs);
        WSP(float, WS_TRIG)[m * 32 + i] = cs; WSP(float, WS_TRIG)[m * 32 + 16 + i] = sn; }
    { const float* wr = IN_F(20); for (int idx = gt; idx < 32 * 1024; idx += NGT) { const int e = idx >> 10, k = idx & 1023; const float w = wr[k * 32 + e];
        const unsigned hi = f2bf(w); const float rem = w - __builtin_bit_cast(float, hi << 16); WSP(bf16, WS_WRH)[idx] = (bf16)hi; WSP(bf16, WS_WRL)[idx] = (bf16)f2bf(rem); } }
    LAS float* scr = (LAS float*)(F.lds + 32768 + F.wave * 8704);
    const int gw = F.vcu * NWAVES + F.wave, NGW = F.G * NWAVES;
    constexpr int I_IN = 16 * 224, I_RG = 128, I_B = 1024, I_O = 512;
    constexpr int NITEMS = I_IN + I_RG + I_B + I_O;
    for (int it = gw; it < NITEMS; it += NGW) {
        int r = it;
        if (r < I_IN) { const int kb = r / 224, nb = r % 224, n0 = nb * 32;
            if (n0 < 2048 || (n0 >= 4096 && n0 < 5120)) p0_transpose_item(IN_F(7), DIN, WSP(bf16, WS_WIN), 1024, (size_t)(n0 < 2048 ? n0 : n0 - 2048), scr, kb * 64, n0, F.lane);
            else { const int gl = n0 - 5120;
                const size_t row = n0 < 4096 ? (size_t)(n0 - 2048) : (size_t)(2048 + ((gl & 1023) >> 7) * 256 + (gl >> 10) * 128 + (gl & 127));
                p8_transpose_item_fp8(IN_F(7), DIN, WSP(unsigned char, WS_WIN8), 1024, row, scr, kb * 64, n0, F.lane); }
            continue; } r -= I_IN;
        if (r < I_RG) { const int mat = r >> 6, blk = (r >> 3) & 7, kb = (r >> 2) & 1, nb = r & 3;
            p0_transpose_item(IN_F(mat ? 12 : 10) + (size_t)blk * 16384, 128, WSP(bf16, WS_WRG) + (size_t)(mat * 8 + blk) * 16384, 128, (size_t)nb * 32, scr, kb * 64, nb * 32, F.lane); continue; } r -= I_RG;
        if (r < I_B) { const int g = r >> 9, q = r & 511, kb = q >> 5, nb = q & 31;
            p0_transpose_item(IN_F(18) + (size_t)g * 1048576, 1024, WSP(bf16, WS_WB) + (size_t)g * 1024, 2048, (size_t)nb * 32, scr, kb * 64, nb * 32, F.lane); continue; } r -= I_B;
        { const int kb = r >> 5, nb = r & 31; p0_transpose_item(IN_F(19), 1024, WSP(bf16, WS_WO), 1024, (size_t)nb * 32, scr, kb * 64, nb * 32, F.lane); }
    }
}
struct WItem { const float* src; unsigned char* dst; int N; };
__device__ __forceinline__ WItem p8_item(const Args& args, unsigned char* ws, int it) {
    WItem w;
    if (it < 32 * 1024) { const int e = it >> 10, q = it & 1023, kb = q >> 6, nb = q & 63, n0 = nb * 32;
        const int bj = n0 >> 10, p = (n0 & 1023) >> 7, oo = n0 & 127;
        w.src = IN_F(22) + (size_t)e * 2097152 + (size_t)(kb * 64) * 2048 + n0; w.N = 2048;
        w.dst = ws + WS_WUP + (size_t)e * 2097152 + (size_t)(p * 256 + bj * 128 + oo) * 1024 + kb * 64; }
    else { const int r = it - 32 * 1024, e = r >> 9, q = r & 511, kb = q >> 5, nb = q & 31;
        w.src = IN_F(24) + (size_t)e * 1048576 + (size_t)(kb * 64) * 1024 + nb * 32; w.N = 1024;
        w.dst = ws + WS_WDN + (size_t)e * 1048576 + (size_t)(nb * 32) * 1024 + kb * 64; }
    return w;
}
__device__ __forceinline__ void p8_load(const WItem& w, f32x4 (&v)[8], int lane) {
#pragma unroll
    for (int i = 0; i < 8; ++i) v[i] = __builtin_nontemporal_load((const f32x4*)(w.src + (size_t)((lane >> 3) + 8 * i) * w.N + (lane & 7) * 4));
}
__device__ __forceinline__ void p8_store(const WItem& w, const f32x4 (&v)[8], LAS float* scr, int lane) {
#pragma unroll
    for (int i = 0; i < 8; ++i) { LAS float* d = scr + ((lane >> 3) + 8 * i) * 33 + (lane & 7) * 4; d[0] = v[i].x * 64.0f; d[1] = v[i].y * 64.0f; d[2] = v[i].z * 64.0f; d[3] = v[i].w * 64.0f; }
    LDS_WAIT(); asm volatile("" ::: "memory");
    const int c = lane & 7;
#pragma unroll
    for (int j = 0; j < 4; ++j) { const int n = (lane >> 3) + 8 * j; const LAS float* s = scr + (8 * c) * 33 + n;
        v2u o; o.x = pg8::pk_fp8x4(s[0 * 33], s[1 * 33], s[2 * 33], s[3 * 33]); o.y = pg8::pk_fp8x4(s[4 * 33], s[5 * 33], s[6 * 33], s[7 * 33]);
        __builtin_nontemporal_store(o, (v2u*)(w.dst + (size_t)n * 1024 + 8 * c)); }
    LDS_WAIT(); asm volatile("" ::: "memory");
}
constexpr int P8_ITEMS = 32 * 1024 + 32 * 512, P8_CHUNK = 128, P8_NCHUNK = P8_ITEMS / P8_CHUNK;
__device__ __forceinline__ void p8_chunk(Frame& F, const Args& args, int ch) {
    LAS float* scr = (LAS float*)(F.lds + 32768 + F.wave * 8704);
    const int it0 = ch * P8_CHUNK + F.wave * 16;
    f32x4 v0[8], v1[8], v2[8], v3[8];
    p8_load(p8_item(args, F.ws, it0), v0, F.lane); p8_load(p8_item(args, F.ws, it0 + 1), v1, F.lane); p8_load(p8_item(args, F.ws, it0 + 2), v2, F.lane); p8_load(p8_item(args, F.ws, it0 + 3), v3, F.lane);
#pragma unroll 1
    for (int j = 0; j < 16; j += 4) { const bool more = j + 4 < 16;
        p8_store(p8_item(args, F.ws, it0 + j), v0, scr, F.lane); if (more) p8_load(p8_item(args, F.ws, it0 + j + 4), v0, F.lane);
        p8_store(p8_item(args, F.ws, it0 + j + 1), v1, scr, F.lane); if (more) p8_load(p8_item(args, F.ws, it0 + j + 5), v1, F.lane);
        p8_store(p8_item(args, F.ws, it0 + j + 2), v2, scr, F.lane); if (more) p8_load(p8_item(args, F.ws, it0 + j + 6), v2, F.lane);
        p8_store(p8_item(args, F.ws, it0 + j + 3), v3, scr, F.lane); if (more) p8_load(p8_item(args, F.ws, it0 + j + 7), v3, F.lane);
    }
}
__device__ __forceinline__ void p8_moe_weights(Frame& F, const Args& args) {
    for (int ch = F.vcu; ch < P8_NCHUNK; ch += F.G) p8_chunk(F, args, ch);
}

__device__ __forceinline__ void p1_hrows(Frame& F, const Args& args) {
    if (F.tid == 0) { unsigned* mc = (unsigned*)(F.ws + WS_CTL) + CW_MODCNT; unsigned sp = 0; while (__hip_atomic_load(mc, RLX_AGENT) < 192u && ++sp < (1u << 22)) __builtin_amdgcn_s_sleep(2);
        __builtin_amdgcn_fence(__ATOMIC_ACQUIRE, "agent"); VM_WAIT(); }
    __syncthreads();
    const float* x = IN_F(0); const float* g1n = IN_F(5); const float* mod = WSP(float, WS_MOD); bf16* H = WSP(bf16, WS_HB); unsigned char* H8 = WSP(unsigned char, WS_H8);
    const int gw = F.vcu * NWAVES + F.wave, NGW = F.G * NWAVES;
    f32x4 v0[4], v1[4], n0[4], n1[4];
#define P1_LOADX(ma, mb, A, B) do { const f32x4* xa_ = (const f32x4*)(x + (size_t)(ma) * DM) + F.lane; const f32x4* xb_ = (const f32x4*)(x + (size_t)(mb) * DM) + F.lane; \
        _Pragma("unroll") for (int j_ = 0; j_ < 4; ++j_) { A[j_] = xa_[64 * j_]; B[j_] = xb_[64 * j_]; } } while (0)
    int m0 = gw;
    if (m0 < NTOK) { const int m1 = (m0 + NGW < NTOK) ? m0 + NGW : m0; P1_LOADX(m0, m1, v0, v1); }
    for (; m0 < NTOK; m0 += 2 * NGW) {
        const bool has1 = m0 + NGW < NTOK; const int m1 = has1 ? m0 + NGW : m0;
        const int b0 = m0 >> 12, b1 = m1 >> 12;
        f32x4 g[4], sh0[4], sc0[4], sh1[4], sc1[4];
#pragma unroll
        for (int j = 0; j < 4; ++j) { const int col = 4 * F.lane + 256 * j; g[j] = *(const f32x4*)(g1n + col);
            sh0[j] = *(const f32x4*)(mod + b0 * 6144 + col); sc0[j] = *(const f32x4*)(mod + b0 * 6144 + 1024 + col); sh1[j] = *(const f32x4*)(mod + b1 * 6144 + col); sc1[j] = *(const f32x4*)(mod + b1 * 6144 + 1024 + col); }
        const int p0 = m0 + 2 * NGW; const bool hasn = p0 < NTOK;
        if (hasn) { const int p1 = (p0 + NGW < NTOK) ? p0 + NGW : p0; P1_LOADX(p0, p1, n0, n1); }
        float s0 = 0.f, s1 = 0.f;
#pragma unroll
        for (int j = 0; j < 4; ++j) { s0 += (v0[j].x * v0[j].x + v0[j].y * v0[j].y) + (v0[j].z * v0[j].z + v0[j].w * v0[j].w); s1 += (v1[j].x * v1[j].x + v1[j].y * v1[j].y) + (v1[j].z * v1[j].z + v1[j].w * v1[j].w); }
#pragma unroll
        for (int o = 1; o < 64; o <<= 1) { s0 += __shfl_xor(s0, o); s1 += __shfl_xor(s1, o); }
        const float r0 = 1.0f / sqrtf(s0 * (1.f / DM) + EPS), r1 = 1.0f / sqrtf(s1 * (1.f / DM) + EPS);
        unsigned long long* o0 = (unsigned long long*)(H + (size_t)m0 * DM) + F.lane; unsigned long long* o1 = (unsigned long long*)(H + (size_t)m1 * DM) + F.lane;
#pragma unroll
        for (int j = 0; j < 4; ++j) {
            const f32x4 h0 = v0[j] * r0 * g[j] * (sc0[j] + 1.0f) + sh0[j], h1 = v1[j] * r1 * g[j] * (sc1[j] + 1.0f) + sh1[j];
            o0[64 * j] = (unsigned long long)cvtpk(h0.x, h0.y) | ((unsigned long long)cvtpk(h0.z, h0.w) << 32);
            ((unsigned*)(H8 + (size_t)m0 * DM))[F.lane + 64 * j] = pg8::pk_fp8x4(h0.x, h0.y, h0.z, h0.w);
            if (has1) { o1[64 * j] = (unsigned long long)cvtpk(h1.x, h1.y) | ((unsigned long long)cvtpk(h1.z, h1.w) << 32);
                ((unsigned*)(H8 + (size_t)m1 * DM))[F.lane + 64 * j] = pg8::pk_fp8x4(h1.x, h1.y, h1.z, h1.w); } }
#pragma unroll
        for (int j = 0; j < 4; ++j) { v0[j] = n0[j]; v1[j] = n1[j]; }
    }
#undef P1_LOADX
}

__device__ __forceinline__ void p3_knorm_unit(Frame& F, const Args& args, int unit) {
    const int h = unit & 7, j = (unit >> 3) & 15, b = unit >> 7;
    bf16* KR = WSP(bf16, WS_E) + 3 * E_STRIDE; const float* trig = WSP(float, WS_TRIG); const float* kg = IN_F(16);
    const int rsub = F.lane >> 4, c16 = F.lane & 15;
    float gk[8];
#pragma unroll
    for (int i = 0; i < 8; ++i) gk[i] = kg[c16 * 8 + i];
    float km[8];
#pragma unroll
    for (int i = 0; i < 8; ++i) km[i] = 0.f;
    const int fi = (c16 & 1) * 8;
    v4u raw[4]; f32x4 tcs[4][4]; v4u outp[4];
#define KN_LOAD(bt_) do { _Pragma("unroll") for (int i4 = 0; i4 < 4; ++i4) { const int m_ = b * SEQ + j * 256 + F.wave * 32 + ((bt_) * 4 + i4) * 4 + rsub; \
        raw[i4] = *(const v4u*)(KR + (size_t)m_ * DM + h * HD + c16 * 8); const float* tp_ = trig + (size_t)m_ * 32 + fi; \
        tcs[i4][0] = *(const f32x4*)tp_; tcs[i4][1] = *(const f32x4*)(tp_ + 4); tcs[i4][2] = *(const f32x4*)(tp_ + 16); tcs[i4][3] = *(const f32x4*)(tp_ + 20); } } while (0)
    KN_LOAD(0);
#pragma unroll
    for (int bt = 0; bt < 2; ++bt) {
#pragma unroll
        for (int i4 = 0; i4 < 4; ++i4) {
            float v[8] = {bflo(raw[i4].x), bfhi(raw[i4].x), bflo(raw[i4].y), bfhi(raw[i4].y), bflo(raw[i4].z), bfhi(raw[i4].z), bflo(raw[i4].w), bfhi(raw[i4].w)};
            float ss = 0.f;
#pragma unroll
            for (int i = 0; i < 8; ++i) ss += v[i] * v[i];
            ss += __shfl_xor(ss, 1); ss += __shfl_xor(ss, 2); ss += __shfl_xor(ss, 4); ss += __shfl_xor(ss, 8);
            const float rstd = 1.0f / sqrtf(ss * (1.f / HD) + EPS);
#pragma unroll
            for (int i = 0; i < 8; ++i) v[i] = v[i] * rstd * gk[i];
#pragma unroll
            for (int i = 0; i < 8; ++i) { const float other = __shfl_xor(v[i], 2); const float cs = tcs[i4][i >> 2][i & 3], sn = tcs[i4][2 + (i >> 2)][i & 3];
                if (c16 < 4) v[i] = (c16 < 2) ? (v[i] * cs - other * sn) : (v[i] * cs + other * sn); }
#pragma unroll
            for (int i = 0; i < 8; ++i) km[i] += v[i];
            outp[i4].x = cvtpk(v[0], v[1]); outp[i4].y = cvtpk(v[2], v[3]); outp[i4].z = cvtpk(v[4], v[5]); outp[i4].w = cvtpk(v[6], v[7]); }
        if (bt == 0) KN_LOAD(1);
#pragma unroll
        for (int i4 = 0; i4 < 4; ++i4) { const int m = b * SEQ + j * 256 + F.wave * 32 + (bt * 4 + i4) * 4 + rsub; *(v4u*)(KR + (size_t)m * DM + h * HD + c16 * 8) = outp[i4]; }
    }
#undef KN_LOAD
    LAS float* red = (LAS float*)(F.lds + XTRA_OFF);
#pragma unroll
    for (int i = 0; i < 8; ++i) { float v = km[i]; v += __shfl_xor(v, 16); v += __shfl_xor(v, 32); if (rsub == 0) red[F.wave * 128 + c16 * 8 + i] = v; }
    __syncthreads();
    if (F.tid < 128) { float s = 0.f;
#pragma unroll
        for (int w = 0; w < 8; ++w) s += red[w * 128 + F.tid];
        WSP(float, WS_KMEAN)[((size_t)(b * NH + h) * 16 + j) * HD + F.tid] = s * (1.f / 256.f); }
    __syncthreads();
}

__device__ __forceinline__ void p3_rnn_local_unit(Frame& F, const Args& args, int unit) {
    const int n = unit & 7, c = (unit >> 3) & 15, b = unit >> 7;
    const int t0 = c * 256, m0 = b * SEQ + t0, ch0 = n * 128;
    const bf16* XR = WSP(bf16, WS_E);
    LAS unsigned char* At = F.lds;
    {
        const int cg = F.tid & 15, rs = F.tid >> 4; const int chb = ch0 + cg * 8;
        const float* cw = IN_F(8); const float* cb = IN_F(9);
        float w0[8], w1[8], w2[8], w3[8], bb[8];
#pragma unroll
        for (int i = 0; i < 8; ++i) { w0[i] = cw[chb + i]; w1[i] = cw[1024 + chb + i]; w2[i] = cw[2048 + chb + i]; w3[i] = cw[3072 + chb + i]; bb[i] = cb[chb + i]; }
        const int tr0 = t0 + rs * 8;
        v4u rw[11];
#pragma unroll
        for (int r = 0; r < 11; ++r) { const int tt = tr0 - 3 + r; rw[r] = *(const v4u*)(XR + (size_t)(b * SEQ + (tt < 0 ? 0 : tt)) * DM + chb); if (tt < 0) rw[r] = (v4u){0u, 0u, 0u, 0u}; }
#define UNP(dst, w_) do { dst[0] = bflo(w_.x); dst[1] = bfhi(w_.x); dst[2] = bflo(w_.y); dst[3] = bfhi(w_.y); dst[4] = bflo(w_.z); dst[5] = bfhi(w_.z); dst[6] = bflo(w_.w); dst[7] = bfhi(w_.w); } while (0)
        float p1[8], p2[8], p3[8];
        UNP(p3, rw[0]); UNP(p2, rw[1]); UNP(p1, rw[2]);
#pragma unroll
        for (int r = 0; r < 8; ++r) { float cur[8]; UNP(cur, rw[3 + r]);
            float xc[8];
#pragma unroll
            for (int i = 0; i < 8; ++i) xc[i] = bb[i] + w0[i] * cur[i] + w1[i] * p1[i] + w2[i] * p2[i] + w3[i] * p3[i];
            const int row = rs * 8 + r;
            v4u o; o.x = cvtpk(xc[0], xc[1]); o.y = cvtpk(xc[2], xc[3]); o.z = cvtpk(xc[4], xc[5]); o.w = cvtpk(xc[6], xc[7]);
            *(LAS v4u*)(At + row * 256 + ((cg ^ (row & 15)) << 4)) = o;
#pragma unroll
            for (int i = 0; i < 8; ++i) { p3[i] = p2[i]; p2[i] = p1[i]; p1[i] = cur[i]; } }
#undef UNP
    }
    __syncthreads();
    const int fr = F.lane & 15, fq = F.lane >> 4;
    const int vloc = F.wave * 16 + fr, ch = ch0 + vloc;
    const bf16* WA = WSP(bf16, WS_WRG) + (size_t)n * 16384 + (size_t)vloc * 128 + fq * 8;
    const bf16* WX = WA + 8 * 16384;
    bf16x8 Ba[4], Bx[4];
#pragma unroll
    for (int s = 0; s < 4; ++s) { Ba[s] = *(const bf16x8*)(WA + 32 * s); Bx[s] = *(const bf16x8*)(WX + 32 * s); }
    const float ba = IN_F(11)[ch], bx = IN_F(13)[ch];
    const float sp8 = 8.0f * log1pf(expf(-IN_F(14)[ch]));
    float cP = 1.f, cH = 0.f;
    bf16* HL = WSP(bf16, WS_HL); bf16* PP = WSP(bf16, WS_PP);
    LAS unsigned short* stg = (LAS unsigned short*)(F.lds + 65536);
    for (int rq = 0; rq < 4; ++rq) {
        LAS unsigned short* sb = stg + (rq & 1) * 16384;
#pragma unroll
        for (int ri = 0; ri < 4; ++ri) { const int rt = rq * 4 + ri;
            f32x4 accr = {0.f, 0.f, 0.f, 0.f}, accx = {0.f, 0.f, 0.f, 0.f};
            const int arow = rt * 16 + fr;
#pragma unroll
            for (int s = 0; s < 4; ++s) { const bf16x8 a = *(const LAS bf16x8*)(At + arow * 256 + (((fq + 4 * s) ^ (arow & 15)) << 4));
                accr = __builtin_amdgcn_mfma_f32_16x16x32_bf16(a, Ba[s], accr, 0, 0, 0);
                accx = __builtin_amdgcn_mfma_f32_16x16x32_bf16(a, Bx[s], accx, 0, 0, 0); }
            float pj[4], hj[4];
#pragma unroll
            for (int j = 0; j < 4; ++j) { const int row = rt * 16 + 4 * fq + j;
                const float xcv = bf2f(*(const LAS unsigned short*)(At + row * 256 + ((((vloc >> 3)) ^ (row & 15)) << 4) + (vloc & 7) * 2));
                const float r = fast_sigmoid(accr[j] + ba), ig = fast_sigmoid(accx[j] + bx);
                const float a = __builtin_amdgcn_exp2f(-sp8 * r * 1.4426950408889634f);
                float mult = __builtin_amdgcn_sqrtf(fmaxf(fmaf(-a, a, 1.0f), 0.0f)); if (t0 + row == 0) mult = 1.0f;
                const float u = mult * ig * xcv;
                pj[j] = (j ? pj[j - 1] : 1.0f) * a; hj[j] = (j ? hj[j - 1] * a : 0.0f) + u; }
            const float tp = pj[3], th = hj[3];
            const float pa = __shfl(tp, F.lane - 16), ha = __shfl(th, F.lane - 16);
            const float pb = __shfl(tp, F.lane - 32), hb = __shfl(th, F.lane - 32);
            const float pc = __shfl(tp, F.lane - 48), hc = __shfl(th, F.lane - 48);
            float Pq, Hq;
            if (fq == 0) { Pq = 1.f; Hq = 0.f; } else if (fq == 1) { Pq = pa; Hq = ha; } else if (fq == 2) { Pq = pb * pa; Hq = pa * hb + ha; } else { Pq = pc * pb * pa; Hq = pa * (pb * hc + hb) + ha; }
            const float hstart = Hq + Pq * cH, pstart = Pq * cP;
            float hl3 = 0.f, pp3 = 0.f;
#pragma unroll
            for (int j = 0; j < 4; ++j) { const float hv = hj[j] + pj[j] * hstart, pv = pj[j] * pstart; const int rl = ri * 16 + 4 * fq + j;
                const unsigned pk = cvtpk(hv, pv); sb[rl * 128 + vloc] = (unsigned short)pk; sb[8192 + rl * 128 + vloc] = (unsigned short)(pk >> 16); if (j == 3) { hl3 = hv; pp3 = pv; } }
            cH = __shfl(hl3, fr + 48); cP = __shfl(pp3, fr + 48);
        }
        __syncthreads();
#pragma unroll
        for (int q4 = 0; q4 < 4; ++q4) { const int idx = q4 * 512 + F.tid, arr = idx >> 10, rr = (idx >> 4) & 63, c16 = idx & 15;
            const v4u val = *(const LAS v4u*)(sb + arr * 8192 + rr * 128 + c16 * 8);
            bf16* dst = (arr ? PP : HL) + (size_t)(m0 + rq * 64 + rr) * DM + ch0 + c16 * 8;
            *(v4u*)dst = val; }
    }
    if (fq == 0) { WSP(float, WS_AGGP)[(size_t)(b * 16 + c) * 1024 + ch] = cP; WSP(float, WS_AGGH)[(size_t)(b * 16 + c) * 1024 + ch] = cH; }
    __syncthreads();
}

__device__ __forceinline__ void p4_rnn_final_unit(Frame& F, const Args& args, int unit) {
    const int n = unit & 7, c = (unit >> 3) & 15, b = unit >> 7;
    const int m0 = b * SEQ + c * 256, ch0 = n * 128;
    LAS float* car = (LAS float*)(F.lds + XTRA_OFF);
    if (F.tid < 128) { const int ch = ch0 + F.tid; float h = 0.f;
        for (int cc = 0; cc < c; ++cc) { const float p = WSP(float, WS_AGGP)[(size_t)(b * 16 + cc) * 1024 + ch], hh = WSP(float, WS_AGGH)[(size_t)(b * 16 + cc) * 1024 + ch]; h = p * h + hh; }
        car[F.tid] = h; }
    __syncthreads();
    const bf16* HL = WSP(bf16, WS_HL); const bf16* PP = WSP(bf16, WS_PP); const bf16* GG = WSP(bf16, WS_E) + E_STRIDE; bf16* Y = WSP(bf16, WS_YCAT);
    const int c16 = F.tid & 15, r0 = F.tid >> 4;
    float cv[8];
#pragma unroll
    for (int i = 0; i < 8; ++i) cv[i] = car[c16 * 8 + i];
    v4u hl[8], pp[8], gg[8];
#pragma unroll
    for (int it = 0; it < 8; ++it) { const size_t o = (size_t)(m0 + it * 32 + r0) * DM + ch0 + c16 * 8; hl[it] = *(const v4u*)(HL + o); pp[it] = *(const v4u*)(PP + o); gg[it] = *(const v4u*)(GG + o); }
#pragma unroll
    for (int it = 0; it < 8; ++it) { const size_t oy = (size_t)(m0 + it * 32 + r0) * 2048 + ch0 + c16 * 8;
        v4u y;
        y.x = cvtpk((bflo(hl[it].x) + bflo(pp[it].x) * cv[0]) * bflo(gg[it].x), (bfhi(hl[it].x) + bfhi(pp[it].x) * cv[1]) * bfhi(gg[it].x));
        y.y = cvtpk((bflo(hl[it].y) + bflo(pp[it].y) * cv[2]) * bflo(gg[it].y), (bfhi(hl[it].y) + bfhi(pp[it].y) * cv[3]) * bfhi(gg[it].y));
        y.z = cvtpk((bflo(hl[it].z) + bflo(pp[it].z) * cv[4]) * bflo(gg[it].z), (bfhi(hl[it].z) + bfhi(pp[it].z) * cv[5]) * bfhi(gg[it].z));
        y.w = cvtpk((bflo(hl[it].w) + bflo(pp[it].w) * cv[6]) * bflo(gg[it].w), (bfhi(hl[it].w) + bfhi(pp[it].w) * cv[7]) * bfhi(gg[it].w));
        *(v4u*)(Y + oy) = y; }
    __syncthreads();
}

namespace att {
constexpr int KVBLK = 64, SHM_K = KVBLK * HD * 2, SHM_V = SHM_K;
constexpr float C2 = 0.08838834764831845f * 1.4426950408889634f;
#define KSWZ(row, colB) ((row) * 256 + ((colB) ^ (((row) & 7) << 4)))
__device__ __forceinline__ int v_st(int k, int c) { const int kk = (k & ~0xC) | ((k & 4) << 1) | ((k & 8) >> 1); return ((kk >> 3) * 4 + (c >> 5)) * 512 + ((kk & 7) * 32 + (c & 31)) * 2; }
__device__ __forceinline__ int v_rd_base(int lane) { return ((lane & 3) << 3) | (((lane >> 2) & 3) << 6) | (((lane >> 4) & 1) << 5) | (((lane >> 5) & 1) << 8); }
constexpr int v_rd_off(int d0, int ks, int half) { return d0 * 512 + ks * 4096 + half * 2048; }
__device__ __forceinline__ int crow(int r, int hi) { return (r & 3) + 8 * (r >> 2) + 4 * hi; }

template <int KB>
__device__ __forceinline__ void qkt(f32x16& p0, f32x16& p1, const char* K_lds, int r32, int hi, const char* qfrag, bool act) {
    if (!act) { const float NEG = -__builtin_inff();
#pragma unroll
        for (int r = 0; r < 16; ++r) { p0[r] = NEG; p1[r] = NEG; } return; }
    p0 = f32x16{}; p1 = f32x16{};
    const char* kb[4];
#pragma unroll
    for (int dd = 0; dd < 4; ++dd) kb[dd] = K_lds + KB * SHM_K + KSWZ(r32, (dd * 16 + hi * 8) * 2);
#pragma unroll
    for (int d0 = 0; d0 < 8; ++d0) { const char* a = kb[d0 & 3] + (d0 >> 2) * 128;
        bf16x8 b0 = *reinterpret_cast<const bf16x8*>(a);
        bf16x8 b1 = *reinterpret_cast<const bf16x8*>(a + 32 * 256);
        const bf16x8 q = *reinterpret_cast<const bf16x8*>(qfrag + d0 * 1024);
        p0 = __builtin_amdgcn_mfma_f32_32x32x16_bf16(b0, q, p0, 0, 0, 0);
        p1 = __builtin_amdgcn_mfma_f32_32x32x16_bf16(b1, q, p1, 0, 0, 0); }
}
template <int VB>
__device__ __forceinline__ void pv_tile(f32x16* o, int vb0, bf16x8 pa0, bf16x8 pa1, bf16x8 pa2, bf16x8 pa3, bool act) {
    if (!act) return;
#define TRRD(dst, off) asm volatile("ds_read_b64_tr_b16 %0, %1 offset:%2" : "=&v"(dst) : "v"(vb0), "i"(off) : "memory")
#define PV_D0(d0) do { s16x4 l0, l1, l2, l3, h0, h1, h2, h3; constexpr int b_ = VB * SHM_V + v_rd_off(d0, 0, 0); \
        TRRD(l0, b_); TRRD(h0, b_ + 2048); TRRD(l1, b_ + 4096); TRRD(h1, b_ + 6144); TRRD(l2, b_ + 8192); TRRD(h2, b_ + 10240); TRRD(l3, b_ + 12288); TRRD(h3, b_ + 14336); \
        asm volatile("s_waitcnt lgkmcnt(0)" ::: "memory"); SBAR(); \
        o[d0] = __builtin_amdgcn_mfma_f32_32x32x16_bf16(pa0, (bf16x8){l0[0], l0[1], l0[2], l0[3], h0[0], h0[1], h0[2], h0[3]}, o[d0], 0, 0, 0);   \
        o[d0] = __builtin_amdgcn_mfma_f32_32x32x16_bf16(pa1, (bf16x8){l1[0], l1[1], l1[2], l1[3], h1[0], h1[1], h1[2], h1[3]}, o[d0], 0, 0, 0);   \
        o[d0] = __builtin_amdgcn_mfma_f32_32x32x16_bf16(pa2, (bf16x8){l2[0], l2[1], l2[2], l2[3], h2[0], h2[1], h2[2], h2[3]}, o[d0], 0, 0, 0);   \
        o[d0] = __builtin_amdgcn_mfma_f32_32x32x16_bf16(pa3, (bf16x8){l3[0], l3[1], l3[2], l3[3], h3[0], h3[1], h3[2], h3[3]}, o[d0], 0, 0, 0); } while (0)
    PV_D0(0); PV_D0(1); PV_D0(2); PV_D0(3);
#undef PV_D0
#undef TRRD
}
__device__ __forceinline__ void sm_a(f32x16& p0) {
#pragma unroll
    for (int r = 0; r < 16; ++r) p0[r] = __builtin_amdgcn_exp2f(p0[r]);
}
__device__ __forceinline__ void sm_b(f32x16& p0, f32x16& p1, float& l_reg, bf16x8& pa0, bf16x8& pa1, bf16x8& pa2, bf16x8& pa3) {
#pragma unroll
    for (int r = 0; r < 16; ++r) p1[r] = __builtin_amdgcn_exp2f(p1[r]);
    float ps = 0;
#pragma unroll
    for (int r = 0; r < 16; ++r) ps += p0[r];
#pragma unroll
    for (int r = 0; r < 16; ++r) ps += p1[r];
    l_reg += ps;
#define PK4(P, B_, OUT) do { unsigned a0 = cvtpk(P[B_+0], P[B_+1]), a1 = cvtpk(P[B_+2], P[B_+3]); \
        unsigned b0 = cvtpk(P[B_+4], P[B_+5]), b1 = cvtpk(P[B_+6], P[B_+7]); \
        auto r0 = __builtin_amdgcn_permlane32_swap(a0, b0, false, false); auto r1 = __builtin_amdgcn_permlane32_swap(a1, b1, false, false); \
        v4u w = {r0[0], r1[0], r0[1], r1[1]}; OUT = *reinterpret_cast<bf16x8*>(&w); } while (0)
    PK4(p0, 0, pa0); PK4(p0, 8, pa1); PK4(p1, 0, pa2); PK4(p1, 8, pa3);
#undef PK4
}

__device__ __forceinline__ void attn_unit(Frame& F, const Args& args, int b, int h, int iq) {
    int tid = F.tid; asm volatile("" : "+v"(tid));
    const int wid = F.wave, lane = tid & 63, r32 = lane & 31, hi = lane >> 5;
    char* lds = F.ldsg;
    char* V_lds = lds; char* K_lds = lds + 2 * SHM_V;
    float* kml = (float*)(lds + XTRA_OFF);
    char* qfrag = lds + 65536 + wid * 8192 + lane * 16;
    const bf16* QR = WSP(bf16, WS_E) + 2 * E_STRIDE; const bf16* KN = WSP(bf16, WS_E) + 3 * E_STRIDE; const bf16* VV = WSP(bf16, WS_E) + 4 * E_STRIDE;
    bf16* YA = WSP(bf16, WS_YCAT) + 1024;
    const size_t mb = (size_t)b * SEQ;
    const int q0 = iq * 256, NT = 4 * (iq + 1);
    const bf16* Kh = KN + mb * DM + h * HD; const bf16* Vh = VV + mb * DM + h * HD;
    { const float* kmg = WSP(float, WS_KMEAN) + (size_t)(b * NH + h) * 16 * HD; for (int idx = tid; idx < iq * HD; idx += 512) kml[idx] = kmg[idx]; }
    const int vb0 = (int)(uintptr_t)V_lds + v_rd_base(lane);
    unsigned koff[2], voff[2];
#pragma unroll
    for (int jq = 0; jq < 2; ++jq) { const int p = (2 * wid + jq) * 64 + lane;
        { const int row = p >> 4, c = (p & 15) ^ (row & 7); koff[jq] = (unsigned)(row * DM + c * 8) * 2u; }
        { const int st = p >> 5, idx = p & 31, kk = (st >> 2) * 8 + (idx >> 2), col = (st & 3) * 32 + (idx & 3) * 8, k = (kk & ~0xC) | ((kk & 4) << 1) | ((kk & 8) >> 1); voff[jq] = (unsigned)(k * DM + col) * 2u; } }
#define DMA_K(t, bf) do { _Pragma("unroll") for (int jq_ = 0; jq_ < 2; ++jq_) __builtin_amdgcn_global_load_lds((const unsigned*)((const char*)(Kh + (size_t)(t) * 64 * DM) + koff[jq_]), (LAS unsigned*)(F.lds + 2 * SHM_V + (bf) * SHM_K + (2 * wid + jq_) * 1024), 16, 0, 0); } while (0)
#define DMA_V(t, bf) do { _Pragma("unroll") for (int jq_ = 0; jq_ < 2; ++jq_) __builtin_amdgcn_global_load_lds((const unsigned*)((const char*)(Vh + (size_t)(t) * 64 * DM) + voff[jq_]), (LAS unsigned*)(F.lds + (bf) * SHM_V + (2 * wid + jq_) * 1024), 16, 0, 0); } while (0)
    DMA_K(0, 0); DMA_V(0, 0);
    const size_t mq = mb + q0 + wid * 32 + r32;
    unsigned selmask;
    {
        bf16x8 qr[8];
        const bf16* qp = QR + mq * DM + h * HD + hi * 8;
        v4u raw[8];
#pragma unroll
        for (int d0 = 0; d0 < 8; ++d0) raw[d0] = *(const v4u*)(qp + d0 * 16);
        float ss = 0.f;
#pragma unroll
        for (int d0 = 0; d0 < 8; ++d0) { const float a0 = bflo(raw[d0].x), a1 = bfhi(raw[d0].x), a2 = bflo(raw[d0].y), a3 = bfhi(raw[d0].y), a4 = bflo(raw[d0].z), a5 = bfhi(raw[d0].z), a6 = bflo(raw[d0].w), a7 = bfhi(raw[d0].w);
            ss += (a0 * a0 + a1 * a1) + (a2 * a2 + a3 * a3) + (a4 * a4 + a5 * a5) + (a6 * a6 + a7 * a7); }
        ss += __shfl_xor(ss, 32);
        const float rs = C2 / sqrtf(ss * (1.f / HD) + EPS);
        const float* qg = IN_F(15) + hi * 8;
#define UNPK(f, W_) do { const v4u t_ = (W_); f[0] = bflo(t_.x); f[1] = bfhi(t_.x); f[2] = bflo(t_.y); f[3] = bfhi(t_.y); f[4] = bflo(t_.z); f[5] = bfhi(t_.z); f[6] = bflo(t_.w); f[7] = bfhi(t_.w); } while (0)
#define PACK(f) ({ v4u w_; w_.x = cvtpk(f[0], f[1]); w_.y = cvtpk(f[2], f[3]); w_.z = cvtpk(f[4], f[5]); w_.w = cvtpk(f[6], f[7]); *reinterpret_cast<bf16x8*>(&w_); })
        { float f0[8], f1[8]; UNPK(f0, raw[0]); UNPK(f1, raw[1]);
          const float* tg = WSP(float, WS_TRIG) + mq * 32 + hi * 8;
#pragma unroll
          for (int j = 0; j < 8; ++j) { const float x1 = f0[j] * rs * qg[j], x2 = f1[j] * rs * qg[16 + j], cs = tg[j], sn = tg[16 + j]; f0[j] = x1 * cs - x2 * sn; f1[j] = x2 * cs + x1 * sn; }
          qr[0] = PACK(f0); qr[1] = PACK(f1); }
#pragma unroll
        for (int d0 = 2; d0 < 8; ++d0) { float f[8]; UNPK(f, raw[d0]);
#pragma unroll
            for (int j = 0; j < 8; ++j) f[j] *= rs * qg[d0 * 16 + j];
            qr[d0] = PACK(f); }
        __syncthreads();
        float v1 = -__builtin_inff(), v2 = v1, v3 = v1; int i1 = 0, i2 = 0, i3 = 0;
#pragma unroll 1
        for (int jb = 0; jb < iq; ++jb) { const float* km = kml + jb * HD + hi * 8; float g = 0.f;
#pragma unroll
            for (int d0 = 0; d0 < 8; ++d0) { float f[8]; UNPK(f, *reinterpret_cast<const v4u*>(&qr[d0]));
                const f32x4 k0 = *(const f32x4*)(km + d0 * 16), k1 = *(const f32x4*)(km + d0 * 16 + 4);
                g += (f[0] * k0[0] + f[1] * k0[1]) + (f[2] * k0[2] + f[3] * k0[3]) + (f[4] * k1[0] + f[5] * k1[1]) + (f[6] * k1[2] + f[7] * k1[3]); }
            g += __shfl_xor(g, 32);
            if (g > v1) { v3 = v2; i3 = i2; v2 = v1; i2 = i1; v1 = g; i1 = jb; }
            else if (g > v2) { v3 = v2; i3 = i2; v2 = g; i2 = jb; }
            else if (g > v3) { v3 = g; i3 = jb; } }
#undef UNPK
#undef PACK
        selmask = 0u; if (iq >= 1) selmask |= 1u << i1; if (iq >= 2) selmask |= 1u << i2; if (iq >= 3) selmask |= 1u << i3;
#pragma unroll
        for (int d0 = 0; d0 < 8; ++d0) *reinterpret_cast<bf16x8*>(qfrag + d0 * 1024) = qr[d0];
    }
    float l_reg = 0.f; f32x16 o[4] = {};
    const int wrow0 = wid * 32;
#define ACT(t) (((t) >> 2) < iq ? (__ballot((selmask >> ((t) >> 2)) & 1u) != 0ull) : ((((t) - 4 * iq) * 64) <= wrow0 + 31))
#define MASKT(P0_, P1_, t) do { const int blk_ = (t) >> 2; const float NEG_ = -__builtin_inff(); \
        if (blk_ < iq) { if (!((selmask >> blk_) & 1u)) { _Pragma("unroll") for (int r = 0; r < 16; ++r) { P0_[r] = NEG_; P1_[r] = NEG_; } } } \
        else { const int kb_ = ((t) - 4 * iq) * 64; if (kb_ + 63 > wrow0) { int dq_ = wrow0 + r32 - kb_ - 4 * hi; asm volatile("" : "+v"(dq_)); \
            _Pragma("unroll") for (int r = 0; r < 16; ++r) { const int c_ = (r & 3) + 8 * (r >> 2); if (c_ > dq_) P0_[r] = NEG_; if (c_ + 32 > dq_) P1_[r] = NEG_; } } } } while (0)
    f32x16 pA0, pA1, pB0, pB1; bf16x8 pa0, pa1, pa2, pa3;
    DMA_K(1, 1);
    VM_WAIT(); __syncthreads();
    SBAR(); qkt<0>(pA0, pA1, K_lds, r32, hi, qfrag, ACT(0));
    MASKT(pA0, pA1, 0); sm_a(pA0);
    VM_WAIT(); __syncthreads();
#define STEP(PX0, PX1, PY0, PY1, t, KB, VB) do { \
        if ((t) + 1 < NT) DMA_K((t) + 1, (KB) ^ 1); DMA_V((t), (KB)); \
        SBAR(); qkt<KB>(PX0, PX1, K_lds, r32, hi, qfrag, ACT(t)); \
        sm_b(PY0, PY1, l_reg, pa0, pa1, pa2, pa3); SBAR(); \
        pv_tile<VB>(o, vb0, pa0, pa1, pa2, pa3, ACT((t) - 1)); MASKT(PX0, PX1, (t)); sm_a(PX0); \
        VM_WAIT(); __syncthreads(); } while (0)
    for (int t = 1; t + 1 < NT; t += 2) {
        STEP(pB0, pB1, pA0, pA1, t, 1, 0);
        STEP(pA0, pA1, pB0, pB1, t + 1, 0, 1);
    }
    STEP(pB0, pB1, pA0, pA1, NT - 1, 1, 0);
    sm_b(pB0, pB1, l_reg, pa0, pa1, pa2, pa3); SBAR();
    pv_tile<1>(o, vb0, pa0, pa1, pa2, pa3, ACT(NT - 1));
#undef STEP
#undef DMA_K
#undef DMA_V
    l_reg += __shfl_xor(l_reg, 32);
    float* li_l = (float*)(lds + XTRA_OFF + 8192) + wid * 32;
    if (hi == 0) li_l[r32] = l_reg;
    asm volatile("s_waitcnt lgkmcnt(0)" ::: "memory");
    float rli[16];
#pragma unroll
    for (int r = 0; r < 16; ++r) rli[r] = __builtin_amdgcn_rcpf(li_l[crow(r, hi)]);
    __syncthreads();
    { unsigned short* stg = (unsigned short*)(lds + wid * 8192);
#pragma unroll
      for (int r = 0; r < 16; ++r) { const int orow = crow(r, hi);
#pragma unroll
          for (int d0 = 0; d0 < 4; ++d0) stg[orow * 128 + d0 * 32 + r32] = (unsigned short)f2bf(o[d0][r] * rli[r]); }
      asm volatile("s_waitcnt lgkmcnt(0)" ::: "memory");
      bf16* Ow = YA + (mb + q0 + wid * 32) * 2048 + h * HD;
#pragma unroll
      for (int i = 0; i < 8; ++i) { const int row = i * 4 + (lane >> 4), ch = lane & 15; const v4u v = *(const v4u*)(stg + row * 128 + ch * 8); *(v4u*)(Ow + (size_t)row * 2048 + ch * 8) = v; } }
    __syncthreads();
#undef ACT
#undef MASKT
}
#undef KSWZ
}

__device__ __forceinline__ void p7_router(Frame& F, const Args& args) {
    LAS float* ssq = (LAS float*)F.lds;
    LAS float* par = (LAS float*)(F.lds + 2048);
    LAS float* lg = (LAS float*)(F.lds + 10240);
    LAS int* hist = (LAS int*)(F.lds + 77824 + 2048);
    LAS int* sel = (LAS int*)(F.lds + 77824 + 4096);
    const float* g2n = IN_F(6); const float* mod = WSP(float, WS_MOD); const float* brt = IN_F(21);
    unsigned char* H2 = WSP(unsigned char, WS_HB);
    const float* xin = IN_F(0); const bf16* D1 = WSP(bf16, WS_D1);
    unsigned* CNT = (unsigned*)(F.ws + WS_CTL) + CW_CNT;
    const int row = F.lane & 15, q = F.lane >> 4, kw = F.wave * 128;
    bf16x8 Bh[4][2], Bl[4][2];
    { const bf16* wh = WSP(bf16, WS_WRH) + (size_t)row * 1024 + kw + 8 * q; const bf16* wl = WSP(bf16, WS_WRL) + (size_t)row * 1024 + kw + 8 * q;
#pragma unroll
      for (int s = 0; s < 4; ++s) { Bh[s][0] = *(const bf16x8*)(wh + 32 * s); Bh[s][1] = *(const bf16x8*)(wh + 16384 + 32 * s); Bl[s][0] = *(const bf16x8*)(wl + 32 * s); Bl[s][1] = *(const bf16x8*)(wl + 16384 + 32 * s); } }
    for (int vw = F.vcu; vw < 256; vw += F.G) {
        const int m0 = vw * 64, b = m0 >> 12;
        for (int i = F.tid; i < 1024; i += 512) { par[i] = g2n[i] * (1.0f + mod[b * 6144 + 4096 + i]); par[1024 + i] = mod[b * 6144 + 3072 + i]; }
        if (F.tid < 32) hist[F.tid] = 0;
#pragma unroll
        for (int rt = 0; rt < 4; ++rt) { const float* xp = xin + (size_t)(m0 + rt * 16 + row) * DM + kw + 8 * q; const bf16* dp = D1 + (size_t)(m0 + rt * 16 + row) * DM + kw + 8 * q; float ss = 0.f;
#pragma unroll
            for (int s = 0; s < 4; ++s) { const v4u dd = *(const v4u*)(dp + 32 * s);
                const f32x4 x0 = *(const f32x4*)(xp + 32 * s) + (f32x4){bflo(dd.x), bfhi(dd.x), bflo(dd.y), bfhi(dd.y)}, x1 = *(const f32x4*)(xp + 32 * s + 4) + (f32x4){bflo(dd.z), bfhi(dd.z), bflo(dd.w), bfhi(dd.w)};
                const f32x4 a = x0 * x0 + x1 * x1; ss += (a.x + a.y) + (a.z + a.w); }
            ss += __shfl_xor(ss, 16); ss += __shfl_xor(ss, 32);
            if (q == 0) ssq[F.wave * 64 + rt * 16 + row] = ss; }
        __syncthreads();
        f32x4 xraw[2][4][2]; v4u draw[2][4];
#define P7_LOADRT(rt_) do { const float* xp_ = xin + (size_t)(m0 + (rt_) * 16 + row) * DM + kw + 8 * q; const bf16* dp_ = D1 + (size_t)(m0 + (rt_) * 16 + row) * DM + kw + 8 * q; \
        _Pragma("unroll") for (int s_ = 0; s_ < 4; ++s_) { draw[(rt_) & 1][s_] = *(const v4u*)(dp_ + 32 * s_); xraw[(rt_) & 1][s_][0] = *(const f32x4*)(xp_ + 32 * s_); xraw[(rt_) & 1][s_][1] = *(const f32x4*)(xp_ + 32 * s_ + 4); } } while (0)
        P7_LOADRT(0);
#pragma unroll
        for (int rt = 0; rt < 4; ++rt) { const int rl = rt * 16 + row; float tot = 0.f;
            if (rt + 1 < 4) P7_LOADRT(rt + 1);
#pragma unroll
            for (int w = 0; w < 8; ++w) tot += ssq[w * 64 + rl];
            const float rstd = 1.0f / sqrtf(tot * (1.f / DM) + EPS);
            f32x4 acc0 = {0.f, 0.f, 0.f, 0.f}, acc1 = {0.f, 0.f, 0.f, 0.f};
            unsigned char* hp = H2 + (size_t)(m0 + rl) * DM + kw + 8 * q;
            f32x4 xq[4][2];
#pragma unroll
            for (int s = 0; s < 4; ++s) { const v4u dd = draw[rt & 1][s];
                xq[s][0] = xraw[rt & 1][s][0] + (f32x4){bflo(dd.x), bfhi(dd.x), bflo(dd.y), bfhi(dd.y)}; xq[s][1] = xraw[rt & 1][s][1] + (f32x4){bflo(dd.z), bfhi(dd.z), bflo(dd.w), bfhi(dd.w)}; }
#pragma unroll
            for (int s = 0; s < 4; ++s) { const int col = kw + 32 * s + 8 * q; float h[8];
#pragma unroll
                for (int hf = 0; hf < 2; ++hf) { const f32x4 sc = *(const LAS f32x4*)(par + col + 4 * hf), sh = *(const LAS f32x4*)(par + 1024 + col + 4 * hf);
                    const f32x4 t = xq[s][hf] * rstd * sc + sh; h[4 * hf] = t.x; h[4 * hf + 1] = t.y; h[4 * hf + 2] = t.z; h[4 * hf + 3] = t.w; }
                v4u hi; hi.x = cvtpk(h[0], h[1]); hi.y = cvtpk(h[2], h[3]); hi.z = cvtpk(h[4], h[5]); hi.w = cvtpk(h[6], h[7]);
                { v2u h8; h8.x = pg8::pk_fp8x4(h[0], h[1], h[2], h[3]); h8.y = pg8::pk_fp8x4(h[4], h[5], h[6], h[7]); *(v2u*)(hp + 32 * s) = h8; }
                v4u lo; lo.x = cvtpk(h[0] - bflo(hi.x), h[1] - bfhi(hi.x)); lo.y = cvtpk(h[2] - bflo(hi.y), h[3] - bfhi(hi.y)); lo.z = cvtpk(h[4] - bflo(hi.z), h[5] - bfhi(hi.z)); lo.w = cvtpk(h[6] - bflo(hi.w), h[7] - bfhi(hi.w));
                const bf16x8 ah = *reinterpret_cast<bf16x8*>(&hi), al = *reinterpret_cast<bf16x8*>(&lo);
                acc0 = __builtin_amdgcn_mfma_f32_16x16x32_bf16(ah, Bh[s][0], acc0, 0, 0, 0); acc0 = __builtin_amdgcn_mfma_f32_16x16x32_bf16(ah, Bl[s][0], acc0, 0, 0, 0); acc0 = __builtin_amdgcn_mfma_f32_16x16x32_bf16(al, Bh[s][0], acc0, 0, 0, 0);
                acc1 = __builtin_amdgcn_mfma_f32_16x16x32_bf16(ah, Bh[s][1], acc1, 0, 0, 0); acc1 = __builtin_amdgcn_mfma_f32_16x16x32_bf16(ah, Bl[s][1], acc1, 0, 0, 0); acc1 = __builtin_amdgcn_mfma_f32_16x16x32_bf16(al, Bh[s][1], acc1, 0, 0, 0); }
#pragma unroll
            for (int r = 0; r < 4; ++r) { lg[(F.wave * 64 + rt * 16 + 4 * q + r) * 33 + row] = acc0[r]; lg[(F.wave * 64 + rt * 16 + 4 * q + r) * 33 + 16 + row] = acc1[r]; } }
#undef P7_LOADRT
        __syncthreads();
        { const int rowl = F.tid >> 3, eq = F.tid & 7; float v[4];
#pragma unroll
          for (int j = 0; j < 4; ++j) { float a = brt[4 * eq + j];
#pragma unroll
              for (int w = 0; w < 8; ++w) a += lg[(w * 64 + rowl) * 33 + 4 * eq + j];
              v[j] = a; }
          float tv[4]; int te[4];
#pragma unroll
          for (int k = 0; k < 4; ++k) { float gm = fmaxf(fmaxf(v[0], v[1]), fmaxf(v[2], v[3]));
              gm = fmaxf(gm, __shfl_xor(gm, 1)); gm = fmaxf(gm, __shfl_xor(gm, 2)); gm = fmaxf(gm, __shfl_xor(gm, 4));
              int ci = v[0] == gm ? 4 * eq : v[1] == gm ? 4 * eq + 1 : v[2] == gm ? 4 * eq + 2 : v[3] == gm ? 4 * eq + 3 : 99;
              ci = min(ci, __shfl_xor(ci, 1)); ci = min(ci, __shfl_xor(ci, 2)); ci = min(ci, __shfl_xor(ci, 4));
              te[k] = ci; tv[k] = gm;
#pragma unroll
              for (int j = 0; j < 4; ++j) if (ci == 4 * eq + j) v[j] = -__builtin_inff(); }
          if (eq == 0) { const float w1 = __expf(tv[1] - tv[0]), w2 = __expf(tv[2] - tv[0]), w3 = __expf(tv[3] - tv[0]); const float inv = 1.0f / (1.0f + w1 + w2 + w3);
              const float gk[4] = {inv, w1 * inv, w2 * inv, w3 * inv};
#pragma unroll
              for (int k = 0; k < 4; ++k) { const int lr = atomicAdd((int*)&hist[te[k]], 1); sel[rowl * 4 + k] = te[k]; sel[256 + rowl * 4 + k] = lr; sel[512 + rowl * 4 + k] = __float_as_int(gk[k]); } } }
        __syncthreads();
        if (F.tid < 32) { const int hc = hist[F.tid]; hist[32 + F.tid] = hc ? (int)__hip_atomic_fetch_add(CNT + F.tid, (unsigned)hc, RLX_AGENT) : 0; }
        __syncthreads();
        if (F.tid < 256) { const int e = sel[F.tid], pos = hist[32 + e] + sel[256 + F.tid], mm = m0 + (F.tid >> 2);
            WSP(int, WS_ROWTOK)[(size_t)e * ECAP + pos] = mm; WSP(int, WS_ROWGATE)[(size_t)e * ECAP + pos] = sel[512 + F.tid];
            WSP(int, WS_TOKE)[mm * 4 + (F.tid & 3)] = e; WSP(int, WS_TOKPOS)[mm * 4 + (F.tid & 3)] = pos; }
        __syncthreads();
    }
}

constexpr int MOE_TBL_OFF = XTRA_OFF, MOE_LIST_OFF = XTRA_OFF + 2048;
__device__ __forceinline__ int moe_tables(Frame& F) {
    LAS int* tbl = (LAS int*)(F.lds + MOE_TBL_OFF);
    const unsigned* CNT = (const unsigned*)(F.ws + WS_CTL) + CW_CNT;
    if (F.tid < 32) tbl[F.tid] = (int)__hip_atomic_load(CNT + F.tid, RLX_AGENT);
    __syncthreads();
    if (F.tid == 0) { int run = 0;
#pragma unroll 1
        for (int e = 0; e < 32; ++e) { tbl[32 + e] = run; const int nb = (tbl[e] + 255) >> 8;
#pragma unroll 1
            for (int bb = 0; bb < nb; ++bb) tbl[80 + run + bb] = e;
            run += nb; }
        tbl[64] = run; }
    __syncthreads();
    int nblk = tbl[64]; if (nblk > MAXBLK) nblk = MAXBLK; if (nblk < 1) nblk = 1;
    return __builtin_amdgcn_readfirstlane(nblk);
}

__device__ __forceinline__ void p11_combine(Frame& F, const Args& args) {
    (void)moe_tables(F);
    const LAS int* tbl = (const LAS int*)(F.lds + MOE_TBL_OFF);
    const float* mod = WSP(float, WS_MOD); const unsigned char* YR = WSP(unsigned char, WS_YR); const float* xin = IN_F(0); const bf16* D1 = WSP(bf16, WS_D1);
    const int gw = F.vcu * NWAVES + F.wave, NGW = F.G * NWAVES;
    const int col = 16 * F.lane;
#define P11_LOAD(m_, Y0, Y1, Y2, Y3, DA, DB, X) do { int dk_ = 0; if (F.lane < 4) { const int e_ = __hip_atomic_load(WSP(int, WS_TOKE) + (m_) * 4 + F.lane, RLX_AGENT); dk_ = tbl[32 + e_] * 256 + __hip_atomic_load(WSP(int, WS_TOKPOS) + (m_) * 4 + F.lane, RLX_AGENT); } \
        const int d0_ = __shfl(dk_, 0), d1_ = __shfl(dk_, 1), d2_ = __shfl(dk_, 2), d3_ = __shfl(dk_, 3); \
        Y0 = *(const v4u*)(YR + (size_t)d0_ * DM + col); Y1 = *(const v4u*)(YR + (size_t)d1_ * DM + col); Y2 = *(const v4u*)(YR + (size_t)d2_ * DM + col); Y3 = *(const v4u*)(YR + (size_t)d3_ * DM + col); \
        DA = *(const v4u*)(D1 + (size_t)(m_) * DM + col); DB = *(const v4u*)(D1 + (size_t)(m_) * DM + col + 8); \
        _Pragma("unroll") for (int q_ = 0; q_ < 4; ++q_) X[q_] = *(const f32x4*)(xin + (size_t)(m_) * DM + col + 4 * q_); } while (0)
#define P11_STORE(m_, Y0, Y1, Y2, Y3, DA, DB, X) do { const int b_ = (m_) >> 12; const unsigned dw_[8] = {DA.x, DA.y, DA.z, DA.w, DB.x, DB.y, DB.z, DB.w}; \
        const unsigned w0_[4] = {Y0.x, Y0.y, Y0.z, Y0.w}, w1_[4] = {Y1.x, Y1.y, Y1.z, Y1.w}, w2_[4] = {Y2.x, Y2.y, Y2.z, Y2.w}, w3_[4] = {Y3.x, Y3.y, Y3.z, Y3.w}; \
        _Pragma("unroll") for (int q_ = 0; q_ < 4; ++q_) { \
            const f32x2 a0_ = __builtin_amdgcn_cvt_pk_f32_fp8((int)w0_[q_], false) + __builtin_amdgcn_cvt_pk_f32_fp8((int)w1_[q_], false) + __builtin_amdgcn_cvt_pk_f32_fp8((int)w2_[q_], false) + __builtin_amdgcn_cvt_pk_f32_fp8((int)w3_[q_], false); \
            const f32x2 a1_ = __builtin_amdgcn_cvt_pk_f32_fp8((int)w0_[q_], true) + __builtin_amdgcn_cvt_pk_f32_fp8((int)w1_[q_], true) + __builtin_amdgcn_cvt_pk_f32_fp8((int)w2_[q_], true) + __builtin_amdgcn_cvt_pk_f32_fp8((int)w3_[q_], true); \
            const f32x4 s_ = {a0_.x, a0_.y, a1_.x, a1_.y}; \
            const f32x4 g2_ = *(const f32x4*)(mod + b_ * 6144 + 5120 + col + 4 * q_) * 0.0625f; \
            const f32x4 dl_ = {bflo(dw_[2 * q_]), bfhi(dw_[2 * q_]), bflo(dw_[2 * q_ + 1]), bfhi(dw_[2 * q_ + 1])}; \
            *(f32x4*)(F.out + (size_t)(m_) * DM + col + 4 * q_) = X[q_] + dl_ + g2_ * s_; } } while (0)
    v4u ya0, ya1, ya2, ya3, daa, dab; f32x4 xa[4]; v4u yb0, yb1, yb2, yb3, dba, dbb; f32x4 xb[4];
    int m = gw;
    if (m < NTOK) P11_LOAD(m, ya0, ya1, ya2, ya3, daa, dab, xa);
    for (; m < NTOK; m += 2 * NGW) {
        const int m1 = m + NGW, m2 = m + 2 * NGW;
        if (m1 < NTOK) P11_LOAD(m1, yb0, yb1, yb2, yb3, dba, dbb, xb);
        P11_STORE(m, ya0, ya1, ya2, ya3, daa, dab, xa);
        if (m2 < NTOK) P11_LOAD(m2, ya0, ya1, ya2, ya3, daa, dab, xa);
        if (m1 < NTOK) P11_STORE(m1, yb0, yb1, yb2, yb3, dba, dbb, xb);
    }
#undef P11_LOAD
#undef P11_STORE
}

#ifndef NSTREAM
#define NSTREAM 8
#endif
#define P4_PULL(ctr, dst) do { __syncthreads(); if (F.tid == 0) bc[0] = (int)__hip_atomic_fetch_add((ctr), 1u, RLX_AGENT); __syncthreads(); dst = bc[0]; } while (0)
__device__ __forceinline__ void p4_phase(Frame& F, const Args& args) {
    unsigned* Q = (unsigned*)(F.ws + WS_CTL) + CW_QUEUE;
    LAS int* bc = (LAS int*)(F.lds + XTRA_OFF + 12288);
    const bool xcd_ok = (F.G == 256);
    const int xg = xcd_ok ? (F.vcu >> 5) : (F.vcu & 7);
    const bool streamer = xcd_ok && (F.vcu & 31) < NSTREAM;
    if (streamer) { for (;;) { int ch; P4_PULL(Q + 64 * 9, ch); if (ch >= P8_NCHUNK) break; p8_chunk(F, args, ch); } }
#pragma unroll 1
    for (int dx = 0; dx < 8; ++dx) { const int x = (xg + dx) & 7;
        for (;;) { int a; P4_PULL(Q + 64 * x, a); if (a >= 64) break;
            const int bh = 4 * x + (a & 3); att::attn_unit(F, args, bh >> 3, bh & 7, 15 - (a >> 2)); } }
    for (;;) { int u; P4_PULL(Q + 64 * 8, u); if (u >= 512) break; p4_rnn_final_unit(F, args, u); }
    if (!streamer) { for (;;) { int ch; P4_PULL(Q + 64 * 9, ch); if (ch >= P8_NCHUNK) break; p8_chunk(F, args, ch); } }
}
#undef P4_PULL

#ifndef MK_N_LAUNCHES
#define MK_N_LAUNCHES 1
#endif
constexpr int PER_PHASE = 12;
constexpr int N_LAUNCHES = MK_N_LAUNCHES;

__global__ void __launch_bounds__(NWAVES * 64, 2) hybrid_fwd(Args args) {
    extern __shared__ __attribute__((aligned(16))) unsigned char lds[];
    Frame F;
    F.lds = (LAS unsigned char*)lds; F.ldsg = (char*)lds;
    F.MISC = (volatile LAS unsigned*)(F.lds + MISC_OFF);
    F.tid = threadIdx.x; F.lane = F.tid & 63; F.wave = __builtin_amdgcn_readfirstlane(F.tid >> 6);
    F.G = gridDim.x; { const int bx = blockIdx.x; F.vcu = (F.G % 8 == 0) ? (bx % 8) * (F.G / 8) + bx / 8 : bx; }
    F.ws = args.ws; F.out = args.out;
    gu32* ctl = (gu32*)(args.ws + WS_CTL);
    for (int u = F.tid; u < (LDS_BYTES - LDSCTL_OFF) / 4; u += NWAVES * 64) ((LAS unsigned*)(F.lds + LDSCTL_OFF))[u] = 0u;
    __syncthreads();
    XcdBarrier bar; bar.bar = (unsigned*)(ctl + CW_BAR); bar.x = 0; bar.st = nullptr;
    if (N_LAUNCHES == 1) bar = xcd_barrier_post((unsigned*)(ctl + CW_BAR), F.MISC + 8);
    const int lo = args.ph_lo, hi = args.ph_hi;
#ifndef PHASE_MASK
#define PHASE_MASK 0xFFF
#endif
#define IN(k) (((PHASE_MASK >> (k)) & 1) && lo <= (k) && (k) < hi)
#define NEXTP(k) ((k) == 0 ? 2 : (k) == 7 ? 9 : (k) + 1)
#define SEAM(k) do { if (IN(k) && IN(NEXTP(k))) xcd_barrier(bar); } while (0)

#ifndef DUP_MASK
#define DUP_MASK 0
#endif
#define PHASE(k, ...) do { if (IN(k)) { __VA_ARGS__ if ((DUP_MASK >> (k)) & 1) { xcd_barrier(bar); __VA_ARGS__ } } SEAM(k); } while (0)
    PHASE(0, { p0_prologue(F, args); p1_hrows(F, args); });
    PHASE(2, {
        { pg8::Gemm g{WSP(bf16, WS_HB), WSP(bf16, WS_WIN), NTOK, 3072, DM}; pg8::TileOrder S; S.init(NTOK / 256, 12, F.G, (int)blockIdx.x, nullptr);
          pg8::EpiWin E{WSP(bf16, WS_E), IN_F(17), 0};
          pg8::gemm_phase<pg8::EpiWin, pg8::TileOrder, true, true>(F.lds + RING_OFF, g, S, E); }
        { pg8::Gemm g{WSP(bf16, WS_H8), WSP(bf16, WS_WIN8), NTOK, 4096, DM / 2}; pg8::TileOrder S; S.init(NTOK / 256, 16, F.G, (int)blockIdx.x, nullptr);
          pg8::EpiWin E{WSP(bf16, WS_E), IN_F(17), 1};
          pg8::gemm_phase<pg8::EpiWin, pg8::TileOrder, true, true, false, true>(F.lds + RING_OFF, g, S, E); }
    });
    int p3rep = 0;
    PHASE(3, {
        for (int u = F.vcu; u < 512; u += F.G) p3_rnn_local_unit(F, args, u);
        if (p3rep++ == 0) { for (int u = F.vcu; u < 512; u += F.G) p3_knorm_unit(F, args, u); }
    });
    PHASE(4, { p4_phase(F, args); });
    PHASE(5, {
        pg8::Gemm g{WSP(bf16, WS_YCAT), WSP(bf16, WS_WB), NTOK, DM, 2 * DM}; pg8::TileOrder S; S.init(NTOK / 256, DM / 256, F.G, (int)blockIdx.x, nullptr);
        pg8::EpiBranch E{WSP(bf16, WS_E) + 5 * E_STRIDE, WSP(bf16, WS_E) + 6 * E_STRIDE, WSP(bf16, WS_HB)};
        pg8::gemm_phase<pg8::EpiBranch, pg8::TileOrder, false, true>(F.lds + RING_OFF, g, S, E);
    });
    PHASE(6, {
        pg8::Gemm g{WSP(bf16, WS_HB), WSP(bf16, WS_WO), NTOK, DM, DM}; pg8::TileOrder S; S.init(NTOK / 256, DM / 256, F.G, (int)blockIdx.x, nullptr);
        pg8::EpiWout E{WSP(bf16, WS_D1), WSP(float, WS_MOD)};
        pg8::gemm_phase<pg8::EpiWout, pg8::TileOrder, false, true>(F.lds + RING_OFF, g, S, E);
    });
    PHASE(7, { p7_router(F, args); });
    PHASE(9, {
        const int nblk = moe_tables(F);
        const LAS int* tbl = (const LAS int*)(F.lds + MOE_TBL_OFF); LAS int* lists = (LAS int*)(F.lds + MOE_LIST_OFF);
        pg8::Gemm g{WSP(bf16, WS_HB), WSP(bf16, WS_WUP), RMAX, 2048 * NEXP, DM / 2}; pg8::TileOrder S; S.init(nblk, 8, F.G, (int)blockIdx.x, tbl + 80, F.ws + WS_HB);
        { pg8::Unit u; for (int i = 0; i < 9 && S.next(i, u); ++i) { if (F.tid < 256) { const int e = u.pn >> 3, pos = (u.pm - tbl[32 + e]) * 256 + F.tid;
              lists[i * 256 + F.tid] = pos < tbl[e] ? __hip_atomic_load(WSP(int, WS_ROWTOK) + (size_t)e * ECAP + pos, RLX_AGENT) : 0; } } }
        __syncthreads();
        pg8::EpiUp E{WSP(unsigned char, WS_ACT), IN_F(23)};
        pg8::gemm_phase<pg8::EpiUp, pg8::TileOrder, true, true, true, true>(F.lds + RING_OFF, g, S, E, lists);
    });
    PHASE(10, {
        const int nblk = moe_tables(F);
        const LAS int* tbl = (const LAS int*)(F.lds + MOE_TBL_OFF);
        pg8::Gemm g{WSP(bf16, WS_ACT), WSP(bf16, WS_WDN), RMAX, 1024 * NEXP, DM / 2}; pg8::TileOrder S; S.init(nblk, 4, F.G, (int)blockIdx.x, tbl + 80);
        pg8::EpiDown E{WSP(unsigned char, WS_YR), IN_F(25), WSP(float, WS_ROWGATE), tbl, F.lds + XTRA_OFF + 12288};
        pg8::gemm_phase<pg8::EpiDown, pg8::TileOrder, true, true, false, true>(F.lds + RING_OFF, g, S, E);
    });
    PHASE(11, { p11_combine(F, args); });
#undef PHASE
#undef IN
#undef SEAM
}

extern "C" void kernel_launch(void* const* d_in, const int* in_sizes, int n_in, void* d_out, int out_size, void* d_ws, size_t ws_size, hipStream_t stream) {
    static int grid = 0;
    if (grid == 0) {
        if (n_in != 26 || in_sizes[0] != NTOK * DM || out_size != NTOK * DM || ws_size < WS_END) {
            fprintf(stderr, "kernel_launch: shape/workspace mismatch (n_in %d, in0 %d, out %d, ws %zu; need ws >= %zu); nothing launched\n", n_in, n_in > 0 ? in_sizes[0] : -1, out_size, ws_size, (size_t)WS_END); grid = -1; return; }
        int dev = 0, cus = 0, per_cu = 0;
        if (hipGetDevice(&dev) != hipSuccess || hipDeviceGetAttribute(&cus, hipDeviceAttributeMultiprocessorCount, dev) != hipSuccess) { fprintf(stderr, "kernel_launch: device query failed\n"); grid = -1; return; }
        if (hipFuncSetAttribute((const void*)hybrid_fwd, hipFuncAttributeMaxDynamicSharedMemorySize, LDS_BYTES) != hipSuccess) { fprintf(stderr, "kernel_launch: hipFuncSetAttribute failed\n"); grid = -1; return; }
        if (hipOccupancyMaxActiveBlocksPerMultiprocessor(&per_cu, (const void*)hybrid_fwd, NWAVES * 64, LDS_BYTES) != hipSuccess || per_cu < 1) { fprintf(stderr, "kernel_launch: occupancy query says %d blocks/CU\n", per_cu); per_cu = 1; }
        (void)hipGetLastError();
        grid = cus;
        if (grid > 256) grid = 256;
    }
    if (grid < 0) return;
    (void)hipMemsetAsync((char*)d_ws + WS_CTL, 0, CTL_ZERO_BYTES, stream);
    Args a{};
    for (int i = 0; i < 26; ++i) a.in[i] = d_in[i];
    a.out = (float*)d_out; a.ws = (unsigned char*)d_ws;
    for (int li = 0; li < N_LAUNCHES; ++li) {
        a.ph_lo = (N_LAUNCHES == 1) ? 0 : li; a.ph_hi = (N_LAUNCHES == 1) ? PER_PHASE : li + 1;
        hipLaunchKernelGGL(hybrid_fwd, dim3(grid), dim3(NWAVES * 64), LDS_BYTES, stream, a);
        const hipError_t le = hipPeekAtLastError();
        if (le != hipSuccess) { fprintf(stderr, "kernel_launch: launch %d failed: %s\n", li, hipGetErrorName(le)); break; }
    }
}
```

```cpp
#include <hip/hip_runtime.h>
#include <hip/hip_bf16.h>
#include <cstdio>
#include <cstdint>
#include <cmath>
namespace pg8 {
#define PG8_LAS __attribute__((address_space(3)))
typedef unsigned short bf16_t;
typedef short bf16x8 __attribute__((ext_vector_type(8)));
typedef float f32x4 __attribute__((ext_vector_type(4)));
typedef unsigned u32x4 __attribute__((ext_vector_type(4)));
constexpr int BM = 256, BK = 64, HALF = 128, HTB = HALF * BK * 2  , STAGE_BYTES = 8 * HTB, NXCD = 8, WGM = 8;

__host__ __device__ __forceinline__ int lds_byte(int r, int c) { const int st = (r >> 4) * 2 + (c >> 5), rr = r & 15, cc = c & 31, ob = rr * 64 + cc * 2; return st * 1024 + (ob ^ (((ob >> 9) & 1) << 5)); }
__host__ __device__ __forceinline__ void stage_rc(int b, int& R, int& C) { const int st = b / 1024, sb = b % 1024, swz = sb ^ (((sb >> 9) & 1) << 5); R = (st >> 1) * 16 + swz / 64; C = (st & 1) * 32 + (swz % 64) / 2; }
__host__ __device__ __forceinline__ int perm32(int rho) { const int n = rho >> 4, i = rho & 15; return 8 * (i >> 2) + 4 * n + (i & 3); }

struct Unit { int pm, pn, kind; };
struct Gemm { const bf16_t* A; const bf16_t* Bt; int M, N, K; };

struct StaticOrder {
    int nM, nN, nwg, G, c;
    __host__ __device__ void init(int M, int N, int G_, int c_) { nM = M / BM; nN = N / BM; nwg = nM * nN; G = G_; c = c_; }
    __host__ __device__ bool next(int i, Unit& u) const {
        const long L = (long)i * G + c; if (L >= nwg) return false;
        int wgid = (int)L; { const int q = nwg / NXCD, r = nwg % NXCD, xcd = wgid % NXCD, off = wgid / NXCD; wgid = (xcd < r ? xcd * (q + 1) : r * (q + 1) + (xcd - r) * q) + off; }
        const int nig = WGM * nN, gid = wgid / nig, fm = gid * WGM, gsz = (nM - fm) < WGM ? (nM - fm) : WGM;
        u.pm = fm + ((wgid % nig) % gsz); u.pn = (wgid % nig) / gsz; return true;
    }
    __device__ __forceinline__ void a_ready(const Unit&) const {}
    __device__ __forceinline__ void done(const Unit&) const {}
};

__device__ __forceinline__ unsigned cvt_pk_bf16(float lo, float hi) { unsigned r; asm volatile("v_cvt_pk_bf16_f32 %0, %1, %2" : "=v"(r) : "v"(lo), "v"(hi)); return r; }
typedef int v4i_t __attribute__((ext_vector_type(4)));
typedef int v8i_t __attribute__((ext_vector_type(8)));
template <class Epi, class Sched, bool ALIGN_EPI = false, bool SP2 = false, bool GATHER = false, bool FP8 = false>
__device__ __forceinline__ void gemm_phase(PG8_LAS unsigned char* lds, const Gemm g, const Sched& S, const Epi& E, const PG8_LAS int* rowlists = nullptr) {
    static_assert(!GATHER || SP2, "GATHER is implemented for the SP2 loop");
    const int tid = threadIdx.x, wid = __builtin_amdgcn_readfirstlane(tid >> 6), lane = tid & 63, wr = wid >> 2, wc = wid & 3, fr = lane & 15, fq = lane >> 4;
    const int K = g.K, nt = K / BK;
    unsigned voffA, voffB; int gR, gC;
    { int R, C; stage_rc(tid * 16, R, C); const int Rb = Epi::PERM ? ((R & ~31) + perm32(R & 31)) : R; gR = R; gC = C;
      voffA = (unsigned)(R * K + C) * 2u; voffB = (unsigned)(Rb * K + C) * 2u; }
    const size_t row64 = (size_t)64 * K * 2;
    const size_t kstep = (size_t)(BK * 2);
    const size_t hstep = (size_t)HALF * K * 2;
    const size_t tstep = 2 * hstep;
    const unsigned ldsw = (unsigned)wid * 1024u;
    const int aoff = lds_byte(wr * 64 + fr, fq * 8), boff = lds_byte(wc * 32 + fr, fq * 8);
#define PG8_SA(b, h) (((b) * 2 + (h)) * HTB)
#define PG8_SB(b, h) ((4 + (b) * 2 + (h)) * HTB)
#define PG8_STAGE2(bufoff, gbase, v0_, v1_) do { unsigned vo0_ = (v0_), vo1_ = (v1_); asm volatile("" : "+v"(vo0_), "+v"(vo1_));     \
        __builtin_amdgcn_global_load_lds((const unsigned*)((const char*)(gbase) + vo0_), (PG8_LAS unsigned*)(lds + (bufoff) + ldsw), 16, 0, 0); \
        __builtin_amdgcn_global_load_lds((const unsigned*)((const char*)(gbase) + vo1_), (PG8_LAS unsigned*)(lds + (bufoff) + ldsw + 8192), 16, 0, 0); } while (0)
#define PG8_STAGE(bufoff, gbase, voff) do { unsigned vo_ = (voff); asm volatile("" : "+v"(vo_)); \
        __builtin_amdgcn_global_load_lds((const unsigned*)((const char*)(gbase) + vo_), (PG8_LAS unsigned*)(lds + (bufoff) + ldsw), 16, 0, 0); \
        __builtin_amdgcn_global_load_lds((const unsigned*)((const char*)(gbase) + row64 + vo_), (PG8_LAS unsigned*)(lds + (bufoff) + ldsw + 8192), 16, 0, 0); } while (0)
#define PG8_LDA(dst, b, h) do { _Pragma("unroll") for (int m = 0; m < 4; ++m) _Pragma("unroll") for (int k = 0; k < 2; ++k) dst[m][k] = *(const PG8_LAS bf16x8*)(lds + PG8_SA(b, h) + aoff + m * 2048 + k * 1024); } while (0)
#define PG8_LDB(dst, b, h) do { _Pragma("unroll") for (int n = 0; n < 2; ++n) _Pragma("unroll") for (int k = 0; k < 2; ++k) dst[n][k] = *(const PG8_LAS bf16x8*)(lds + PG8_SB(b, h) + boff + n * 2048 + k * 1024); } while (0)
#define PG8_CAT8(x, y) __builtin_shufflevector(__builtin_bit_cast(v4i_t, (x)), __builtin_bit_cast(v4i_t, (y)), 0, 1, 2, 3, 4, 5, 6, 7)
#define PG8_MMA(ai, bj, At, Bt) do { __builtin_amdgcn_s_setprio(1); _Pragma("unroll") for (int m = 0; m < 4; ++m) _Pragma("unroll") for (int n = 0; n < 2; ++n) { \
        if constexpr (FP8) { const v8i_t a8_ = PG8_CAT8(Bt[n][0], Bt[n][1]), b8_ = PG8_CAT8(At[m][0], At[m][1]);     \
            asm volatile("v_mfma_scale_f32_16x16x128_f8f6f4 %0, %1, %2, %0, %3, %4 op_sel_hi:[0,0,0]" : "+v"(acc[ai][bj][m][n]) : "v"(a8_), "v"(b8_), "v"(mxsa_), "v"(mxsb_)); } \
        else { _Pragma("unroll") for (int k = 0; k < 2; ++k) acc[ai][bj][m][n] = __builtin_amdgcn_mfma_f32_16x16x32_bf16(Bt[n][k], At[m][k], acc[ai][bj][m][n], 0, 0, 0); } } \
        __builtin_amdgcn_s_setprio(0); } while (0)
#define PG8_WAIT_V(n) asm volatile("s_waitcnt vmcnt(" #n ")" ::: "memory")
#define PG8_WAIT_VN(n) asm volatile("s_waitcnt vmcnt(%0)" :: "i"(n) : "memory")
#define PG8_WAIT_L(n) asm volatile("s_waitcnt lgkmcnt(" #n ")" ::: "memory")
#define PG8_BAR __builtin_amdgcn_s_barrier()
#define PG8_SCHED __builtin_amdgcn_sched_barrier(0)
    Unit cur, nxt; int ui = 0;
    if (!S.next(0, cur)) return;
    int mxsa_ = 121, mxsb_ = 127; asm volatile("" : "+v"(mxsa_), "+v"(mxsb_));
    f32x4 acc[2][2][4][2];
#pragma unroll
    for (int a = 0; a < 2; ++a)
#pragma unroll
        for (int b = 0; b < 2; ++b)
#pragma unroll
            for (int m = 0; m < 4; ++m)
#pragma unroll
                for (int n = 0; n < 2; ++n) acc[a][b][m][n] = (f32x4){0.f, 0.f, 0.f, 0.f};
    bf16x8 At[4][2], B0[2][2], B1[2][2];
    const char* cA = GATHER ? (const char*)S.a_base(cur) : (const char*)g.A + (size_t)cur.pm * tstep; const char* cB = (const char*)g.Bt + (size_t)cur.pn * tstep;
#define PG8_STAGE_A(bufoff, kptr, half, unx) do { if constexpr (GATHER) { const PG8_LAS int* rl_ = rowlists + (ui + (unx)) * 256 + (half) * HALF + gR; \
        PG8_STAGE2(bufoff, kptr, (unsigned)(rl_[0] * K + gC) * 2u, (unsigned)(rl_[64] * K + gC) * 2u); } \
        else { PG8_STAGE(bufoff, (kptr) + (half) * hstep, voffA); } } while (0)
    S.a_ready(cur);
    if constexpr (SP2) {
        PG8_STAGE(PG8_SB(0, 0), cB, voffB); PG8_STAGE(PG8_SB(0, 1), cB + hstep, voffB); PG8_STAGE_A(PG8_SA(0, 0), cA, 0, 0); PG8_STAGE_A(PG8_SA(0, 1), cA, 1, 0);
        if (wr == 1) PG8_BAR;
        PG8_WAIT_V(2); PG8_BAR;
        PG8_STAGE(PG8_SB(1, 0), cB + kstep, voffB); PG8_STAGE_A(PG8_SA(1, 0), cA + kstep, 0, 0); PG8_STAGE(PG8_SB(1, 1), cB + hstep + kstep, voffB);
        PG8_WAIT_V(6); PG8_BAR;
    } else {
        PG8_STAGE(PG8_SB(0, 0), cB, voffB); PG8_STAGE(PG8_SA(0, 0), cA, voffA); PG8_STAGE(PG8_SB(0, 1), cB + hstep, voffB); PG8_STAGE(PG8_SA(0, 1), cA + hstep, voffA);
        if (wr == 1) PG8_BAR;
        PG8_WAIT_V(4); PG8_BAR;
        PG8_STAGE(PG8_SB(1, 0), cB + kstep, voffB); PG8_STAGE(PG8_SA(1, 0), cA + kstep, voffA); PG8_STAGE(PG8_SB(1, 1), cB + hstep + kstep, voffB);
        PG8_WAIT_V(6); PG8_BAR;
    }
    for (;;) {
        const bool has_next = S.next(ui + 1, nxt);
        const char* nA = GATHER ? (has_next ? (const char*)S.a_base(nxt) : cA) : (has_next ? (const char*)g.A + (size_t)nxt.pm * tstep : cA);
        const char* nB = has_next ? (const char*)g.Bt + (size_t)nxt.pn * tstep : cB;
#pragma unroll 1
        for (int t = 0; t < nt; t += 2) {
            const bool last = (t == nt - 2);
            if constexpr (Epi::MIDK) { if (t == (nt >> 1)) { if constexpr (FP8) asm volatile("s_nop 15\n\ts_nop 7" ::: "memory"); E.mid(acc, cur, wr, wc, fr, fq); } }
            const char* a1 = cA + (size_t)(t + 1) * kstep;
            const char* a2 = last ? nA : cA + (size_t)(t + 2) * kstep; const char* b2 = last ? nB : cB + (size_t)(t + 2) * kstep;
            const char* a3 = a2 + kstep; const char* b3 = b2 + kstep;
            if (last && has_next) S.a_ready(nxt);
            const int unx = (GATHER && last && has_next) ? 1 : 0;
            if constexpr (SP2) {
            PG8_LDB(B0, 0, 0); PG8_LDB(B1, 0, 1); PG8_SCHED; PG8_LDA(At, 0, 0); PG8_STAGE_A(PG8_SA(1, 1), a1, 1, 0);
            PG8_WAIT_V(8); PG8_WAIT_L(0); PG8_BAR; PG8_MMA(0, 0, At, B0); PG8_MMA(0, 1, At, B1); PG8_BAR; PG8_SCHED;
            PG8_LDA(At, 0, 1); PG8_STAGE(PG8_SB(0, 0), b2, voffB); PG8_STAGE(PG8_SB(0, 1), b2 + hstep, voffB); PG8_STAGE_A(PG8_SA(0, 0), a2, 0, unx);
            PG8_WAIT_V(8); PG8_WAIT_L(0); PG8_BAR; PG8_MMA(1, 0, At, B0); PG8_MMA(1, 1, At, B1); PG8_BAR; PG8_SCHED;
            PG8_LDB(B0, 1, 0); PG8_LDB(B1, 1, 1); PG8_SCHED; PG8_LDA(At, 1, 0); PG8_STAGE_A(PG8_SA(0, 1), a2, 1, unx);
            PG8_WAIT_V(8); PG8_WAIT_L(0); PG8_BAR; PG8_MMA(0, 0, At, B0); PG8_MMA(0, 1, At, B1); PG8_BAR; PG8_SCHED;
            PG8_LDA(At, 1, 1); PG8_STAGE(PG8_SB(1, 0), b3, voffB); PG8_STAGE(PG8_SB(1, 1), b3 + hstep, voffB); PG8_STAGE_A(PG8_SA(1, 0), a3, 0, unx);
            PG8_WAIT_V(8); PG8_WAIT_L(0); PG8_BAR; PG8_MMA(1, 0, At, B0); PG8_MMA(1, 1, At, B1); PG8_BAR; PG8_SCHED;
            } else {
            PG8_LDB(B0, 0, 0); PG8_SCHED; PG8_LDA(At, 0, 0); PG8_STAGE(PG8_SA(1, 1), a1 + hstep, voffA);
            PG8_WAIT_L(8); PG8_BAR; PG8_WAIT_L(0); PG8_MMA(0, 0, At, B0); PG8_BAR; PG8_SCHED;
            PG8_LDB(B1, 0, 1); PG8_STAGE(PG8_SB(0, 0), b2, voffB);
            PG8_BAR; PG8_WAIT_L(0); PG8_MMA(0, 1, At, B1); PG8_BAR;
            PG8_LDA(At, 0, 1); PG8_STAGE(PG8_SA(0, 0), a2, voffA);
            PG8_BAR; PG8_WAIT_L(0); PG8_MMA(1, 0, At, B0); PG8_BAR; PG8_SCHED;
            PG8_STAGE(PG8_SB(0, 1), b2 + hstep, voffB);
            PG8_WAIT_V(6); PG8_BAR; PG8_MMA(1, 1, At, B1); PG8_BAR;
            PG8_LDB(B0, 1, 0); PG8_SCHED; PG8_LDA(At, 1, 0); PG8_STAGE(PG8_SA(0, 1), a2 + hstep, voffA);
            PG8_WAIT_L(8); PG8_BAR; PG8_WAIT_L(0); PG8_MMA(0, 0, At, B0); PG8_BAR; PG8_SCHED;
            PG8_LDB(B1, 1, 1); PG8_STAGE(PG8_SB(1, 0), b3, voffB);
            PG8_BAR; PG8_WAIT_L(0); PG8_MMA(0, 1, At, B1); PG8_BAR;
            PG8_LDA(At, 1, 1); PG8_STAGE(PG8_SA(1, 0), a3, voffA);
            PG8_BAR; PG8_WAIT_L(0); PG8_MMA(1, 0, At, B0); PG8_BAR; PG8_SCHED;
            PG8_STAGE(PG8_SB(1, 1), b3 + hstep, voffB);
            PG8_WAIT_V(6); PG8_BAR; PG8_MMA(1, 1, At, B1); PG8_BAR;
            }
        }
        if constexpr (ALIGN_EPI) { if (wr == 0) PG8_BAR; }
        if constexpr (FP8) asm volatile("s_nop 15\n\ts_nop 7" ::: "memory");
        if constexpr (!Epi::AFTER_DRAIN) { E(acc, cur, wr, wc, fr, fq); S.done(cur); }
        if (!has_next) break;
#pragma unroll
        for (int a = 0; a < 2; ++a)
#pragma unroll
            for (int b = 0; b < 2; ++b)
#pragma unroll
                for (int m = 0; m < 4; ++m)
#pragma unroll
                    for (int n = 0; n < 2; ++n) acc[a][b][m][n] = (f32x4){0.f, 0.f, 0.f, 0.f};
        cur = nxt; cA = nA; cB = nB; ++ui;
        if constexpr (ALIGN_EPI) { if (wr == 1) PG8_BAR; }
    }
    PG8_WAIT_V(0);
    if constexpr (!ALIGN_EPI) { if (wr == 0) PG8_BAR; }
    PG8_BAR;
    if constexpr (Epi::AFTER_DRAIN) { E.fused(acc, cur, wr, wc, fr, fq, lds, wid, lane); S.done(cur); }
#undef PG8_SA
#undef PG8_STAGE_A
#undef PG8_SB
#undef PG8_STAGE
#undef PG8_STAGE2
#undef PG8_LDA
#undef PG8_LDB
#undef PG8_MMA
#undef PG8_CAT8
#undef PG8_WAIT_V
#undef PG8_WAIT_VN
#undef PG8_WAIT_L
#undef PG8_BAR
#undef PG8_SCHED
}
}

constexpr int NB = 4, SEQ = 4096, DM = 1024, NTOK = NB * SEQ, DIN = 7168, NH = 8, HD = 128;
constexpr int NEXP = 32, TOPK = 4, MAXBLK = 288, RMAX = MAXBLK * 256;
constexpr float EPS = 1e-6f;
constexpr int NWAVES = 8;

constexpr size_t MiB = 1u << 20, KiB = 1u << 10;
constexpr size_t WS_CTL = 0, CTL_ZERO_BYTES = 1 * MiB;
constexpr size_t WS_MOD = 1 * MiB;
constexpr size_t WS_KMEAN = 1 * MiB + 128 * KiB;
constexpr size_t WS_AGGP = 1 * MiB + 384 * KiB;
constexpr size_t WS_AGGH = 1 * MiB + 640 * KiB;
constexpr size_t WS_WRH = 2 * MiB, WS_WRL = 2 * MiB + 64 * KiB;
constexpr size_t WS_TOKE = 3 * MiB, WS_TOKPOS = 3 * MiB + 256 * KiB;
constexpr int ECAP = 16384;
constexpr size_t WS_ROWTOK = 28 * MiB, WS_ROWGATE = 30 * MiB;
constexpr int CW_UPDONE = 16384;
constexpr int CW_QUEUE = 12288;
constexpr int CW_CNT = 8192;
constexpr size_t WS_TRIG = 4 * MiB;
constexpr size_t WS_WRG = 6 * MiB;
constexpr size_t WS_WIN = 8 * MiB;
constexpr size_t WS_WIN8 = 16 * MiB;
constexpr size_t WS_H8 = 544 * MiB;
constexpr size_t WS_WB = 22 * MiB;
constexpr size_t WS_WO = 26 * MiB;
constexpr size_t WS_WUP = 32 * MiB;
constexpr size_t WS_WDN = 96 * MiB;
constexpr size_t WS_HB = 224 * MiB;
constexpr size_t WS_E = 256 * MiB;
constexpr size_t E_STRIDE = (size_t)NTOK * DM;
constexpr size_t WS_D1 = 256 * MiB;
constexpr size_t WS_HL = 480 * MiB, WS_PP = 512 * MiB, WS_YCAT = 544 * MiB;
constexpr int CW_MODCNT = 8256;
constexpr size_t WS_ACT = 400 * MiB, WS_YR = 544 * MiB;
constexpr size_t WS_END = 688 * MiB;
constexpr int CW_BAR = 4096;

constexpr int RING_OFF = 0, RING_BYTES = 131072;
constexpr int LDSCTL_OFF = RING_BYTES, MISC_OFF = LDSCTL_OFF + 320;
constexpr int XTRA_OFF = LDSCTL_OFF + 1024;
constexpr int LDS_BYTES = 155648;

#define GAS __attribute__((address_space(1)))
#define LAS __attribute__((address_space(3)))
typedef unsigned short bf16;
typedef unsigned v4u __attribute__((ext_vector_type(4)));
typedef unsigned v2u __attribute__((ext_vector_type(2)));
typedef float f32x4 __attribute__((ext_vector_type(4)));
typedef float f32x2 __attribute__((ext_vector_type(2)));
typedef float f32x16 __attribute__((ext_vector_type(16)));
typedef short bf16x8 __attribute__((ext_vector_type(8)));
typedef short s16x4 __attribute__((ext_vector_type(4)));
typedef GAS unsigned gu32;
#define RLX_AGENT __ATOMIC_RELAXED, __HIP_MEMORY_SCOPE_AGENT
#define LDS_WAIT() asm volatile("s_waitcnt lgkmcnt(0)" ::: "memory")
#define VM_WAIT() asm volatile("s_waitcnt vmcnt(0)" ::: "memory")
#define SBAR() __builtin_amdgcn_sched_barrier(0)
__device__ __forceinline__ unsigned f2bf(float f) { unsigned u = __builtin_bit_cast(unsigned, f); return (u + 0x7fffu + ((u >> 16) & 1u)) >> 16; }
__device__ __forceinline__ unsigned pk2(float lo, float hi) { return f2bf(lo) | (f2bf(hi) << 16); }
__device__ __forceinline__ float bf2f(unsigned short h) { return __builtin_bit_cast(float, (unsigned)h << 16); }
__device__ __forceinline__ float bflo(unsigned w) { return __builtin_bit_cast(float, w << 16); }
__device__ __forceinline__ float bfhi(unsigned w) { return __builtin_bit_cast(float, w & 0xffff0000u); }
__device__ __forceinline__ unsigned cvtpk(float lo, float hi) { unsigned r; asm volatile("v_cvt_pk_bf16_f32 %0, %1, %2" : "=v"(r) : "v"(lo), "v"(hi)); return r; }
__device__ __forceinline__ float fast_sigmoid(float x) { return __builtin_amdgcn_rcpf(1.0f + __builtin_amdgcn_exp2f(-1.4426950408889634f * x)); }
__device__ __forceinline__ float gelu_tanh(float x) { const float z = 1.5957691216057308f * (x + 0.044715f * x * x * x); return x * fast_sigmoid(z); }
__device__ __forceinline__ f32x2 sigmoid_pk(f32x2 x) { const f32x2 z = x * (-1.4426950408889634f); f32x2 e; e.x = __builtin_amdgcn_exp2f(z.x); e.y = __builtin_amdgcn_exp2f(z.y);
    const f32x2 d = e + 1.0f; f32x2 r; r.x = __builtin_amdgcn_rcpf(d.x); r.y = __builtin_amdgcn_rcpf(d.y); return r; }
__device__ __forceinline__ f32x2 gelu_tanh_pk(f32x2 x) {
    const f32x2 u = x * x, w = u * (-0.044715f * 1.5957691216057308f * 1.4426950408889634f) + (-1.5957691216057308f * 1.4426950408889634f), z = x * w;
    f32x2 e; e.x = __builtin_amdgcn_exp2f(z.x); e.y = __builtin_amdgcn_exp2f(z.y);
    const f32x2 d = e + 1.0f; f32x2 r; r.x = __builtin_amdgcn_rcpf(d.x); r.y = __builtin_amdgcn_rcpf(d.y); return x * r; }
__device__ __forceinline__ float wave_sum(float v) {
#pragma unroll
    for (int o = 1; o < 64; o <<= 1) v += __shfl_xor(v, o);
    return v;
}
__device__ __forceinline__ float wave_max(float v) {
#pragma unroll
    for (int o = 1; o < 64; o <<= 1) v = fmaxf(v, __shfl_xor(v, o));
    return v;
}

#define XB_TMO      128
#define XB_XCNT(j)  (256  + 64 * (j))
#define XB_XSUB(j)  (1280 + 64 * (j))
#define XB_XGEN(j)  (2304 + 64 * (j))
#define XB_TOP      3328
#define XB_TOPGEN   3392
#define XCD_BAR_WORDS 3456
#define XB_SPIN_CAP (1u << 20)
__device__ __forceinline__ unsigned xb_ld(unsigned* p)              { return __hip_atomic_load(p, __ATOMIC_RELAXED, __HIP_MEMORY_SCOPE_AGENT); }
__device__ __forceinline__ unsigned xb_add(unsigned* p, unsigned v) { return __hip_atomic_fetch_add(p, v, __ATOMIC_RELAXED, __HIP_MEMORY_SCOPE_AGENT); }
__device__ __forceinline__ unsigned xb_xcc_id() { return (unsigned)__builtin_amdgcn_s_getreg((3 << 11) | 20) & 0xFu; }
#define XB_SPIN(cond, bar) do { unsigned _sp = 0; while (cond) { __builtin_amdgcn_s_sleep(1); \
    if ((++_sp & 255u) == 0u) { if (xb_ld(&(bar)[XB_TMO])) break; if (_sp > XB_SPIN_CAP) { atomicAdd(&(bar)[XB_TMO], 1u); break; } } } } while (0)
struct XcdBarrier { unsigned* bar; unsigned x; volatile LAS unsigned* st; };
__device__ __forceinline__ XcdBarrier xcd_barrier_post(unsigned* bar, volatile LAS unsigned* st) {
    XcdBarrier b; b.bar = bar; b.x = xb_xcc_id(); b.st = st;
    if (threadIdx.x == 0) (void)xb_add(&bar[XB_XCNT(b.x)], 1u);
    return b;
}
__device__ __forceinline__ void xcd_barrier_complete(unsigned* bar, unsigned x, unsigned& nloc, unsigned& nx) {
    const unsigned G = gridDim.x * gridDim.y * gridDim.z;
    unsigned sum, cnt, mine, sp = 0u;
    for (;;) {
        sum = 0u; cnt = 0u; mine = 0u;
#pragma unroll
        for (unsigned j = 0; j < 16; ++j) { const unsigned c = xb_ld(&bar[XB_XCNT(j)]); sum += c; cnt += (c > 0u) ? 1u : 0u; mine = (j == x) ? c : mine; }
        if (sum == G) break;
        __builtin_amdgcn_s_sleep(1);
        if ((++sp & 255u) == 0u) { if (xb_ld(&bar[XB_TMO])) break; if (sp > XB_SPIN_CAP) { atomicAdd(&bar[XB_TMO], 1u); break; } }
    }
    nloc = mine > 0u ? mine : 1u; nx = cnt > 0u ? cnt : 1u;
}
__device__ __forceinline__ void xcd_barrier(const XcdBarrier& b) {
    asm volatile("s_waitcnt vmcnt(0)" ::: "memory");
    __syncthreads();
    if (threadIdx.x == 0) {
        unsigned* bar = b.bar;
        __builtin_amdgcn_s_waitcnt(0);
        unsigned nloc = b.st[0], nx = b.st[1];
        if (nloc == 0u) { xcd_barrier_complete(bar, b.x, nloc, nx); b.st[0] = nloc; b.st[1] = nx; }
        const unsigned old = xb_add(&bar[XB_XSUB(b.x)], 1u);
        const unsigned gen = old / nloc;
        if (old + 1u == (gen + 1u) * nloc) {
            __builtin_amdgcn_fence(__ATOMIC_RELEASE, "agent");
            asm volatile("s_waitcnt vmcnt(0)" ::: "memory");
            const unsigned og = xb_add(&bar[XB_TOP], 1u);
            const unsigned tg = og / nx;
            if (og + 1u == (tg + 1u) * nx) xb_add(&bar[XB_TOPGEN], 1u);
            else XB_SPIN(xb_ld(&bar[XB_TOPGEN]) == tg, bar);
            __builtin_amdgcn_fence(__ATOMIC_ACQUIRE, "agent");
            xb_add(&bar[XB_XGEN(b.x)], 1u);
            asm volatile("s_waitcnt vmcnt(0)" ::: "memory");
        } else {
            XB_SPIN(xb_ld(&bar[XB_XGEN(b.x)]) == gen, bar);
            __builtin_amdgcn_fence(__ATOMIC_ACQUIRE, "agent");
            asm volatile("s_waitcnt vmcnt(0)" ::: "memory");
        }
    }
    __syncthreads();
}

struct Args { const void* in[26]; float* out; unsigned char* ws; int ph_lo, ph_hi; };
struct Frame {
    LAS unsigned char* lds; char* ldsg;
    volatile LAS unsigned* MISC;
    int tid, lane, wave, vcu, G;
    unsigned char* ws; float* out;
};
#define IN_F(k) ((const float*)args.in[k])
#define IN_I(k) ((const int*)args.in[k])
#define WSP(T, off) ((T*)(F.ws + (off)))

namespace pg8 {
struct TileOrder {
    int nM, nN, nwg, G, c; const LAS int* blk_exp; const void* abase;
    __device__ __forceinline__ void init(int nM_, int nN_, int G_, int c_, const LAS int* be, const void* ab = nullptr) { nM = nM_; nN = nN_; nwg = nM * nN; G = G_; c = c_; blk_exp = be; abase = ab; }
    __device__ __forceinline__ const void* a_base(const Unit&) const { return abase; }
    __device__ __forceinline__ bool next(int i, Unit& u) const {
        const long L = (long)i * G + c; if (L >= nwg) return false;
        int wgid = (int)L; { const int q = nwg / NXCD, r = nwg % NXCD, xcd = wgid % NXCD, off = wgid / NXCD; wgid = (xcd < r ? xcd * (q + 1) : r * (q + 1) + (xcd - r) * q) + off; }
        const int nig = WGM * nN, gid = wgid / nig, fm = gid * WGM, gsz = (nM - fm) < WGM ? (nM - fm) : WGM;
        u.pm = fm + ((wgid % nig) % gsz); u.pn = (wgid % nig) / gsz; u.kind = 0;
        if (blk_exp) { const int e = __builtin_amdgcn_readfirstlane(blk_exp[u.pm]); u.pn += e * nN; }
        return true;
    }
    __device__ __forceinline__ void a_ready(const Unit&) const {}
    __device__ __forceinline__ void done(const Unit&) const {}
};

__device__ __forceinline__ void st16_wt(void* p, u32x4 v) { asm volatile("global_store_dwordx4 %0, %1, off sc1\n\ts_nop 1" :: "v"(p), "v"(v) : "memory"); }
struct EpiWin {
    static constexpr bool PERM = true, AFTER_DRAIN = false, MIDK = false; static constexpr int NSTORES = 16;
    bf16_t* E; const float* b_gate; int mode;
    __device__ __forceinline__ void operator()(const f32x4 (&acc)[2][2][4][2], const Unit& u, int wr, int wc, int fr, int fq) const {
        int row0 = u.pm * BM + wr * 64 + fr;
        asm volatile("" : "+v"(row0));
        if (mode == 1 && u.pn >= 8) {
            const int d0 = (u.pn - 8) * 128 + wc * 32 + 8 * fq;
            bf16_t* Rb = E + (size_t)5 * ((size_t)16384 * 1024); bf16_t* Sb = E + (size_t)6 * ((size_t)16384 * 1024);
            f32x4 b0[2], b1[2];
#pragma unroll
            for (int n = 0; n < 2; ++n) { b0[n] = *(const f32x4*)(b_gate + d0 + 4 * n); b1[n] = *(const f32x4*)(b_gate + 1024 + d0 + 4 * n); }
#pragma unroll
            for (int ai = 0; ai < 2; ++ai)
#pragma unroll
                for (int m = 0; m < 4; ++m) { const size_t ro = (size_t)(row0 + ai * HALF + m * 16) * 1024 + d0;
                    float r[8], s1[8];
#pragma unroll
                    for (int n = 0; n < 2; ++n)
#pragma unroll
                        for (int j = 0; j < 4; j += 2) { const f32x2 x0 = (f32x2){acc[ai][0][m][n][j], acc[ai][0][m][n][j + 1]} + (f32x2){b0[n][j], b0[n][j + 1]}, x1 = (f32x2){acc[ai][1][m][n][j], acc[ai][1][m][n][j + 1]} + (f32x2){b1[n][j], b1[n][j + 1]};
                            const f32x2 z0 = x0 * (-1.4426950408889634f), z1 = x1 * (-1.4426950408889634f);
                            f32x2 e0, e1; e0.x = __builtin_amdgcn_exp2f(z0.x); e0.y = __builtin_amdgcn_exp2f(z0.y); e1.x = fminf(__builtin_amdgcn_exp2f(z1.x), 1e18f); e1.y = fminf(__builtin_amdgcn_exp2f(z1.y), 1e18f);
                            const f32x2 dn0 = e0 + 1.0f, dn1 = e1 + 1.0f; f32x2 q0, q1; q0.x = __builtin_amdgcn_rcpf(dn0.x); q0.y = __builtin_amdgcn_rcpf(dn0.y); q1.x = __builtin_amdgcn_rcpf(dn1.x); q1.y = __builtin_amdgcn_rcpf(dn1.y);
                            const f32x2 rr = dn1 * q0; r[4 * n + j] = rr.x; r[4 * n + j + 1] = rr.y; s1[4 * n + j] = q1.x; s1[4 * n + j + 1] = q1.y; }
                    u32x4 w; w.x = cvt_pk_bf16(r[0], r[1]); w.y = cvt_pk_bf16(r[2], r[3]); w.z = cvt_pk_bf16(r[4], r[5]); w.w = cvt_pk_bf16(r[6], r[7]); *(u32x4*)(Rb + ro) = w;
                    u32x4 v; v.x = cvt_pk_bf16(s1[0], s1[1]); v.y = cvt_pk_bf16(s1[2], s1[3]); v.z = cvt_pk_bf16(s1[4], s1[5]); v.w = cvt_pk_bf16(s1[6], s1[7]); *(u32x4*)(Sb + ro) = v; }
            return;
        }
        const int opn = mode == 0 ? (u.pn < 8 ? u.pn : u.pn + 8) : u.pn + 8;
        const int t = opn >> 2, colt = (opn & 3) * BM;
        bf16_t* base = E + (size_t)t * ((size_t)16384 * 1024);
        const int col0 = colt + wc * 32 + 8 * fq;
#pragma unroll
        for (int ai = 0; ai < 2; ++ai)
#pragma unroll
            for (int m = 0; m < 4; ++m) { bf16_t* rowp = base + (size_t)(row0 + ai * HALF + m * 16) * 1024 + col0;
#pragma unroll
                for (int bj = 0; bj < 2; ++bj) { f32x4 v0 = acc[ai][bj][m][0], v1 = acc[ai][bj][m][1];
                    if (t == 1) { const f32x2 a = gelu_tanh_pk((f32x2){v0[0], v0[1]}), b = gelu_tanh_pk((f32x2){v0[2], v0[3]}), c = gelu_tanh_pk((f32x2){v1[0], v1[1]}), d = gelu_tanh_pk((f32x2){v1[2], v1[3]});
                        v0 = (f32x4){a.x, a.y, b.x, b.y}; v1 = (f32x4){c.x, c.y, d.x, d.y}; }
                    u32x4 w; w.x = cvt_pk_bf16(v0[0], v0[1]); w.y = cvt_pk_bf16(v0[2], v0[3]); w.z = cvt_pk_bf16(v1[0], v1[1]); w.w = cvt_pk_bf16(v1[2], v1[3]);
                    *(u32x4*)(rowp + bj * HALF) = w; } }
    }
};
struct EpiBranch {
    static constexpr bool PERM = true, AFTER_DRAIN = false, MIDK = true; static constexpr int NSTORES = 16;
    const bf16_t* R; const bf16_t* S1; bf16_t* MIX;
    __device__ __forceinline__ void mid(f32x4 (&acc)[2][2][4][2], const Unit& u, int wr, int wc, int fr, int fq) const {
        int row0 = u.pm * BM + wr * 64 + fr; const int col0 = u.pn * BM + wc * 32 + 8 * fq;
        asm volatile("" : "+v"(row0));
#pragma unroll
        for (int ai = 0; ai < 2; ++ai) { u32x4 a[4][2];
#pragma unroll
            for (int m = 0; m < 4; ++m)
#pragma unroll
                for (int bj = 0; bj < 2; ++bj) a[m][bj] = *(const u32x4*)(R + (size_t)(row0 + ai * HALF + m * 16) * 1024 + col0 + bj * HALF);
#pragma unroll
            for (int m = 0; m < 4; ++m)
#pragma unroll
                for (int bj = 0; bj < 2; ++bj) { acc[ai][bj][m][0] *= (f32x4){bflo(a[m][bj].x), bfhi(a[m][bj].x), bflo(a[m][bj].y), bfhi(a[m][bj].y)}; acc[ai][bj][m][1] *= (f32x4){bflo(a[m][bj].z), bfhi(a[m][bj].z), bflo(a[m][bj].w), bfhi(a[m][bj].w)}; }
            asm volatile("" ::: "memory"); }
    }
    __device__ __forceinline__ void operator()(const f32x4 (&acc)[2][2][4][2], const Unit& u, int wr, int wc, int fr, int fq) const {
        int row0 = u.pm * BM + wr * 64 + fr; const int col0 = u.pn * BM + wc * 32 + 8 * fq;
        asm volatile("" : "+v"(row0));
#pragma unroll
        for (int ai = 0; ai < 2; ++ai) { u32x4 b[4][2];
#pragma unroll
            for (int m = 0; m < 4; ++m)
#pragma unroll
                for (int bj = 0; bj < 2; ++bj) b[m][bj] = *(const u32x4*)(S1 + (size_t)(row0 + ai * HALF + m * 16) * 1024 + col0 + bj * HALF);
#pragma unroll
            for (int m = 0; m < 4; ++m)
#pragma unroll
                for (int bj = 0; bj < 2; ++bj) { const size_t o = (size_t)(row0 + ai * HALF + m * 16) * 1024 + col0 + bj * HALF;
                    const f32x4 v0 = acc[ai][bj][m][0] * (f32x4){bflo(b[m][bj].x), bfhi(b[m][bj].x), bflo(b[m][bj].y), bfhi(b[m][bj].y)}, v1 = acc[ai][bj][m][1] * (f32x4){bflo(b[m][bj].z), bfhi(b[m][bj].z), bflo(b[m][bj].w), bfhi(b[m][bj].w)};
                    u32x4 w; w.x = cvt_pk_bf16(v0[0], v0[1]); w.y = cvt_pk_bf16(v0[2], v0[3]); w.z = cvt_pk_bf16(v1[0], v1[1]); w.w = cvt_pk_bf16(v1[2], v1[3]);
                    *(u32x4*)(MIX + o) = w; }
            asm volatile("" ::: "memory"); }
    }
};
struct EpiWout {
    static constexpr bool PERM = true, AFTER_DRAIN = false, MIDK = false; static constexpr int NSTORES = 16;
    bf16_t* D1; const float* mod;
    __device__ __forceinline__ void operator()(const f32x4 (&acc)[2][2][4][2], const Unit& u, int wr, int wc, int fr, int fq) const {
        int row0 = u.pm * BM + wr * 64 + fr; const int col0 = u.pn * BM + wc * 32 + 8 * fq;
        asm volatile("" : "+v"(row0));
        const float* g1p = mod + (size_t)(u.pm >> 4) * 6144 + 2048;
        f32x4 gv[2][2];
#pragma unroll
        for (int bj = 0; bj < 2; ++bj)
#pragma unroll
            for (int n = 0; n < 2; ++n) gv[bj][n] = *(const f32x4*)(g1p + col0 + bj * HALF + 4 * n);
#pragma unroll
        for (int ai = 0; ai < 2; ++ai)
#pragma unroll
            for (int m = 0; m < 4; ++m) { bf16_t* rowp = D1 + (size_t)(row0 + ai * HALF + m * 16) * 1024 + col0;
#pragma unroll
                for (int bj = 0; bj < 2; ++bj) { const f32x4 v0 = acc[ai][bj][m][0] * gv[bj][0], v1 = acc[ai][bj][m][1] * gv[bj][1];
                    u32x4 w; w.x = cvt_pk_bf16(v0[0], v0[1]); w.y = cvt_pk_bf16(v0[2], v0[3]); w.z = cvt_pk_bf16(v1[0], v1[1]); w.w = cvt_pk_bf16(v1[2], v1[3]);
                    *(u32x4*)(rowp + bj * HALF) = w; } }
    }
};
__device__ __forceinline__ unsigned pk_fp8x4(float a, float b, float c, float d) { int p = __builtin_amdgcn_cvt_pk_fp8_f32(a, b, 0, false); p = __builtin_amdgcn_cvt_pk_fp8_f32(c, d, p, true); return (unsigned)p; }
struct EpiUp {
    static constexpr bool PERM = true, AFTER_DRAIN = false, MIDK = false; static constexpr int NSTORES = 8;
    unsigned char* ACT; const float* b_up;
    __device__ __forceinline__ void operator()(const f32x4 (&acc)[2][2][4][2], const Unit& u, int wr, int wc, int fr, int fq) const {
        const int e = u.pn >> 3, p = u.pn & 7;
        int row0 = u.pm * BM + wr * 64 + fr; const int c0 = p * 128 + wc * 32 + 8 * fq;
        asm volatile("" : "+v"(row0));
        const float* bg = b_up + (size_t)e * 2048 + c0; const float* bl = bg + 1024;
        f32x4 bgv[2], blv[2];
#pragma unroll
        for (int n = 0; n < 2; ++n) { bgv[n] = *(const f32x4*)(bg + 4 * n); blv[n] = *(const f32x4*)(bl + 4 * n) + 1.0f; }
#pragma unroll
        for (int ai = 0; ai < 2; ++ai)
#pragma unroll
            for (int m = 0; m < 4; ++m) { unsigned char* rowp = ACT + (size_t)(row0 + ai * HALF + m * 16) * 1024 + c0;
                f32x4 a[2];
#pragma unroll
                for (int n = 0; n < 2; ++n) {
#pragma unroll
                    for (int j = 0; j < 4; j += 2) { f32x2 g = (f32x2){acc[ai][0][m][n][j], acc[ai][0][m][n][j + 1]} + (f32x2){bgv[n][j], bgv[n][j + 1]};
                        f32x2 l = (f32x2){acc[ai][1][m][n][j], acc[ai][1][m][n][j + 1]} + (f32x2){blv[n][j], blv[n][j + 1]};
                        g.x = fminf(g.x, 7.0f); g.y = fminf(g.y, 7.0f); l.x = __builtin_amdgcn_fmed3f(l.x, -6.0f, 8.0f); l.y = __builtin_amdgcn_fmed3f(l.y, -6.0f, 8.0f);
                        const f32x2 z = g * (-1.702f * 1.4426950408889634f); f32x2 e; e.x = __builtin_amdgcn_exp2f(z.x); e.y = __builtin_amdgcn_exp2f(z.y);
                        const f32x2 d = e + 1.0f; f32x2 r; r.x = __builtin_amdgcn_rcpf(d.x); r.y = __builtin_amdgcn_rcpf(d.y);
                        const f32x2 o = (l * g) * r; a[n][j] = o.x; a[n][j + 1] = o.y; } }
                typedef unsigned u32x2_t __attribute__((ext_vector_type(2)));
                u32x2_t w; w.x = pk_fp8x4(a[0][0], a[0][1], a[0][2], a[0][3]); w.y = pk_fp8x4(a[1][0], a[1][1], a[1][2], a[1][3]);
                *(u32x2_t*)rowp = w; }
    }
};
struct EpiDown {
    static constexpr bool PERM = true, AFTER_DRAIN = false, MIDK = false; static constexpr int NSTORES = 16;
    unsigned char* YR; const float* b_down; const float* row_gate; const LAS int* tbl; LAS unsigned char* stage;
    __device__ __forceinline__ void operator()(const f32x4 (&acc)[2][2][4][2], const Unit& u, int wr, int wc, int fr, int fq) const {
        const int e = u.pn >> 2, p = u.pn & 3;
        int row0 = u.pm * BM + wr * 64 + fr; const int c0 = p * BM + wc * 32 + 8 * fq;
        asm volatile("" : "+v"(row0));
        const int pos0 = row0 - tbl[32 + e] * 256, cnt = tbl[e];
        const float* gp = row_gate + (size_t)e * 16384 + pos0;
        float gt[2][4];
#pragma unroll
        for (int ai = 0; ai < 2; ++ai)
#pragma unroll
            for (int m = 0; m < 4; ++m) { const int o = ai * HALF + m * 16; gt[ai][m] = (pos0 + o < cnt) ? gp[o] * 16.0f : 0.0f; }
        f32x4 bv[2][2];
#pragma unroll
        for (int bj = 0; bj < 2; ++bj)
#pragma unroll
            for (int n = 0; n < 2; ++n) bv[bj][n] = *(const f32x4*)(b_down + (size_t)e * 1024 + c0 + bj * HALF + 4 * n);
        typedef unsigned u32x2_t __attribute__((ext_vector_type(2)));
        const int lane = (int)(threadIdx.x & 63), wv = (int)(threadIdx.x >> 6);
        LAS unsigned char* stg = stage + wv * 1024;
        const int srow = lane >> 2, sch = lane & 3;
#pragma unroll
        for (int ai = 0; ai < 2; ++ai)
#pragma unroll
            for (int m = 0; m < 4; ++m) { const float g = gt[ai][m];
#pragma unroll
                for (int bj = 0; bj < 2; ++bj) { const f32x4 v0 = (acc[ai][bj][m][0] + bv[bj][0]) * g, v1 = (acc[ai][bj][m][1] + bv[bj][1]) * g;
                    u32x2_t w; w.x = pk_fp8x4(v0[0], v0[1], v0[2], v0[3]); w.y = pk_fp8x4(v1[0], v1[1], v1[2], v1[3]);
                    *(LAS u32x2_t*)(stg + fr * 64 + bj * 32 + 8 * fq) = w; }
                asm volatile("s_waitcnt lgkmcnt(0)" ::: "memory");
                const u32x4 o = *(const LAS u32x4*)(stg + srow * 64 + sch * 16);
                asm volatile("s_waitcnt lgkmcnt(0)" ::: "memory");
                const int r = u.pm * BM + wr * 64 + ai * HALF + m * 16 + srow;
                *(u32x4*)(YR + (size_t)r * 1024 + p * BM + wc * 32 + (sch >> 1) * HALF + (sch & 1) * 16) = o; }
    }
};
}

__device__ __forceinline__ void p0_transpose_item(const float* W, int N, bf16* WT, int Kd, size_t dst_row0, LAS float* scr, int k0, int n0, int lane) {
#pragma unroll 8
    for (int i = 0; i < 32; ++i) { const int kk = 2 * i + (lane >> 5); scr[kk * 33 + (lane & 31)] = W[(size_t)(k0 + kk) * N + n0 + (lane & 31)]; }
    LDS_WAIT(); asm volatile("" ::: "memory");
    const int c = lane & 7;
#pragma unroll
    for (int j = 0; j < 4; ++j) { const int n = (lane >> 3) + 8 * j; const LAS float* s = scr + (8 * c) * 33 + n;
        v4u o; o.x = pk2(s[0 * 33], s[1 * 33]); o.y = pk2(s[2 * 33], s[3 * 33]); o.z = pk2(s[4 * 33], s[5 * 33]); o.w = pk2(s[6 * 33], s[7 * 33]);
        *(GAS v4u*)(WT + (dst_row0 + n) * (size_t)Kd + k0 + 8 * c) = o; }
    LDS_WAIT(); asm volatile("" ::: "memory");
}
__device__ __forceinline__ void p8_transpose_item_fp8(const float* W, int N, unsigned char* WT, int Kd, size_t dst_row0, LAS float* scr, int k0, int n0, int lane) {
#pragma unroll 8
    for (int i = 0; i < 32; ++i) { const int kk = 2 * i + (lane >> 5); scr[kk * 33 + (lane & 31)] = W[(size_t)(k0 + kk) * N + n0 + (lane & 31)] * 64.0f; }
    LDS_WAIT(); asm volatile("" ::: "memory");
    const int c = lane & 7;
#pragma unroll
    for (int j = 0; j < 4; ++j) { const int n = (lane >> 3) + 8 * j; const LAS float* s = scr + (8 * c) * 33 + n;
        v2u o; o.x = pg8::pk_fp8x4(s[0 * 33], s[1 * 33], s[2 * 33], s[3 * 33]); o.y = pg8::pk_fp8x4(s[4 * 33], s[5 * 33], s[6 * 33], s[7 * 33]);
        *(GAS v2u*)(WT + (dst_row0 + n) * (size_t)Kd + k0 + 8 * c) = o; }
    LDS_WAIT(); asm volatile("" ::: "memory");
}
__device__ __forceinline__ void p0_prologue(Frame& F, const Args& args) {
    const float* c_in = IN_F(1); const int* pos = IN_I(2); const float* ada_w = IN_F(3); const float* ada_b = IN_F(4);
    for (int task = F.vcu; task < 192; task += F.G) {
        LAS float* sc = (LAS float*)F.lds;
        LAS float* red = (LAS float*)(F.lds + 16384);
        for (int i = F.tid; i < 4096; i += 512) { const float v = c_in[i]; sc[i] = v / (1.0f + expf(-v)); }
        __syncthreads();
        const int colq = F.lane & 7, kq = F.lane >> 3, col = task * 32 + colq * 4;
        float acc[4][4];
#pragma unroll
        for (int b = 0; b < 4; ++b)
#pragma unroll
            for (int j = 0; j < 4; ++j) acc[b][j] = 0.f;
#pragma unroll 8
        for (int s = 0; s < 16; ++s) { const int k = F.wave * 128 + s * 8 + kq; const f32x4 wv = *(const f32x4*)(ada_w + (size_t)k * 6144 + col);
#pragma unroll
            for (int b = 0; b < 4; ++b) { const float sv = sc[b * 1024 + k];
#pragma unroll
                for (int j = 0; j < 4; ++j) acc[b][j] += sv * wv[j]; } }
#pragma unroll
        for (int b = 0; b < 4; ++b)
#pragma unroll
            for (int j = 0; j < 4; ++j) { float v = acc[b][j]; v += __shfl_xor(v, 8); v += __shfl_xor(v, 16); v += __shfl_xor(v, 32); if (kq == 0) red[(F.wave * 4 + b) * 32 + colq * 4 + j] = v; }
        __syncthreads();
        if (F.tid < 128) { const int b = F.tid >> 5, cc = F.tid & 31; float s = ada_b[task * 32 + cc];
#pragma unroll
            for (int w = 0; w < 8; ++w) s += red[(w * 4 + b) * 32 + cc];
            WSP(float, WS_MOD)[b * 6144 + task * 32 + cc] = s; }
        VM_WAIT(); __syncthreads();
        if (F.tid == 0) { __builtin_amdgcn_fence(__ATOMIC_RELEASE, "agent"); VM_WAIT(); __hip_atomic_fetch_add((unsigned*)(F.ws + WS_CTL) + CW_MODCNT, 1u, RLX_AGENT); }
    }
    const int gt = F.vcu * 512 + F.tid, NGT = F.G * 512;
    for (int idx = gt; idx < NTOK * 16; idx += NGT) { const int m = idx >> 4, i = idx & 15;
        double freq = 1.0; for (int q = 0; q < i; ++q) freq *= 0.44036660267178046;
        const double ang = (double)pos[m] * freq; const double nr = __builtin_rint(ang * 0.15915494309189535);
        const float r = (float)__builtin_fma(-nr, 6.283185307179586, ang);
        float sn, cs; sincosf(r, &sn, &cs);
        WSP(float, WS_TRIG)[m * 32 + i] = cs; WSP(float, WS_TRIG)[m * 32 + 16 + i] = sn; }
    { const float* wr = IN_F(20); for (int idx = gt; idx < 32 * 1024; idx += NGT) { const int e = idx >> 10, k = idx & 1023; const float w = wr[k * 32 + e];
        const unsigned hi = f2bf(w); const float rem = w - __builtin_bit_cast(float, hi << 16); WSP(bf16, WS_WRH)[idx] = (bf16)hi; WSP(bf16, WS_WRL)[idx] = (bf16)f2bf(rem); } }
    LAS float* scr = (LAS float*)(F.lds + 32768 + F.wave * 8704);
    const int gw = F.vcu * NWAVES + F.wave, NGW = F.G * NWAVES;
    constexpr int I_IN = 16 * 224, I_RG = 128, I_B = 1024, I_O = 512;
    constexpr int NITEMS = I_IN + I_RG + I_B + I_O;
    for (int it = gw; it < NITEMS; it += NGW) {
        int r = it;
        if (r < I_IN) { const int kb = r / 224, nb = r % 224, n0 = nb * 32;
            if (n0 < 2048 || (n0 >= 4096 && n0 < 5120)) p0_transpose_item(IN_F(7), DIN, WSP(bf16, WS_WIN), 1024, (size_t)(n0 < 2048 ? n0 : n0 - 2048), scr, kb * 64, n0, F.lane);
            else { const int gl = n0 - 5120;
                const size_t row = n0 < 4096 ? (size_t)(n0 - 2048) : (size_t)(2048 + ((gl & 1023) >> 7) * 256 + (gl >> 10) * 128 + (gl & 127));
                p8_transpose_item_fp8(IN_F(7), DIN, WSP(unsigned char, WS_WIN8), 1024, row, scr, kb * 64, n0, F.lane); }
            continue; } r -= I_IN;
        if (r < I_RG) { const int mat = r >> 6, blk = (r >> 3) & 7, kb = (r >> 2) & 1, nb = r & 3;
            p0_transpose_item(IN_F(mat ? 12 : 10) + (size_t)blk * 16384, 128, WSP(bf16, WS_WRG) + (size_t)(mat * 8 + blk) * 16384, 128, (size_t)nb * 32, scr, kb * 64, nb * 32, F.lane); continue; } r -= I_RG;
        if (r < I_B) { const int g = r >> 9, q = r & 511, kb = q >> 5, nb = q & 31;
            p0_transpose_item(IN_F(18) + (size_t)g * 1048576, 1024, WSP(bf16, WS_WB) + (size_t)g * 1024, 2048, (size_t)nb * 32, scr, kb * 64, nb * 32, F.lane); continue; } r -= I_B;
        { const int kb = r >> 5, nb = r & 31; p0_transpose_item(IN_F(19), 1024, WSP(bf16, WS_WO), 1024, (size_t)nb * 32, scr, kb * 64, nb * 32, F.lane); }
    }
}
struct WItem { const float* src; unsigned char* dst; int N; };
__device__ __forceinline__ WItem p8_item(const Args& args, unsigned char* ws, int it) {
    WItem w;
    if (it < 32 * 1024) { const int e = it >> 10, q = it & 1023, kb = q >> 6, nb = q & 63, n0 = nb * 32;
        const int bj = n0 >> 10, p = (n0 & 1023) >> 7, oo = n0 & 127;
        w.src = IN_F(22) + (size_t)e * 2097152 + (size_t)(kb * 64) * 2048 + n0; w.N = 2048;
        w.dst = ws + WS_WUP + (size_t)e * 2097152 + (size_t)(p * 256 + bj * 128 + oo) * 1024 + kb * 64; }
    else { const int r = it - 32 * 1024, e = r >> 9, q = r & 511, kb = q >> 5, nb = q & 31;
        w.src = IN_F(24) + (size_t)e * 1048576 + (size_t)(kb * 64) * 1024 + nb * 32; w.N = 1024;
        w.dst = ws + WS_WDN + (size_t)e * 1048576 + (size_t)(nb * 32) * 1024 + kb * 64; }
    return w;
}
__device__ __forceinline__ void p8_load(const WItem& w, f32x4 (&v)[8], int lane) {
#pragma unroll
    for (int i = 0; i < 8; ++i) v[i] = __builtin_nontemporal_load((const f32x4*)(w.src + (size_t)((lane >> 3) + 8 * i) * w.N + (lane & 7) * 4));
}
__device__ __forceinline__ void p8_store(const WItem& w, const f32x4 (&v)[8], LAS float* scr, int lane) {
#pragma unroll
    for (int i = 0; i < 8; ++i) { LAS float* d = scr + ((lane >> 3) + 8 * i) * 33 + (lane & 7) * 4; d[0] = v[i].x * 64.0f; d[1] = v[i].y * 64.0f; d[2] = v[i].z * 64.0f; d[3] = v[i].w * 64.0f; }
    LDS_WAIT(); asm volatile("" ::: "memory");
    const int c = lane & 7;
#pragma unroll
    for (int j = 0; j < 4; ++j) { const int n = (lane >> 3) + 8 * j; const LAS float* s = scr + (8 * c) * 33 + n;
        v2u o; o.x = pg8::pk_fp8x4(s[0 * 33], s[1 * 33], s[2 * 33], s[3 * 33]); o.y = pg8::pk_fp8x4(s[4 * 33], s[5 * 33], s[6 * 33], s[7 * 33]);
        __builtin_nontemporal_store(o, (v2u*)(w.dst + (size_t)n * 1024 + 8 * c)); }
    LDS_WAIT(); asm volatile("" ::: "memory");
}
constexpr int P8_ITEMS = 32 * 1024 + 32 * 512, P8_CHUNK = 128, P8_NCHUNK = P8_ITEMS / P8_CHUNK;
__device__ __forceinline__ void p8_chunk(Frame& F, const Args& args, int ch) {
    LAS float* scr = (LAS float*)(F.lds + 32768 + F.wave * 8704);
    const int it0 = ch * P8_CHUNK + F.wave * 16;
    f32x4 v0[8], v1[8], v2[8], v3[8];
    p8_load(p8_item(args, F.ws, it0), v0, F.lane); p8_load(p8_item(args, F.ws, it0 + 1), v1, F.lane); p8_load(p8_item(args, F.ws, it0 + 2), v2, F.lane); p8_load(p8_item(args, F.ws, it0 + 3), v3, F.lane);
#pragma unroll 1
    for (int j = 0; j < 16; j += 4) { const bool more = j + 4 < 16;
        p8_store(p8_item(args, F.ws, it0 + j), v0, scr, F.lane); if (more) p8_load(p8_item(args, F.ws, it0 + j + 4), v0, F.lane);
        p8_store(p8_item(args, F.ws, it0 + j + 1), v1, scr, F.lane); if (more) p8_load(p8_item(args, F.ws, it0 + j + 5), v1, F.lane);
        p8_store(p8_item(args, F.ws, it0 + j + 2), v2, scr, F.lane); if (more) p8_load(p8_item(args, F.ws, it0 + j + 6), v2, F.lane);
        p8_store(p8_item(args, F.ws, it0 + j + 3), v3, scr, F.lane); if (more) p8_load(p8_item(args, F.ws, it0 + j + 7), v3, F.lane);
    }
}
__device__ __forceinline__ void p8_moe_weights(Frame& F, const Args& args) {
    for (int ch = F.vcu; ch < P8_NCHUNK; ch += F.G) p8_chunk(F, args, ch);
}

__device__ __forceinline__ void p1_hrows(Frame& F, const Args& args) {
    if (F.tid == 0) { unsigned* mc = (unsigned*)(F.ws + WS_CTL) + CW_MODCNT; unsigned sp = 0; while (__hip_atomic_load(mc, RLX_AGENT) < 192u && ++sp < (1u << 22)) __builtin_amdgcn_s_sleep(2);
        __builtin_amdgcn_fence(__ATOMIC_ACQUIRE, "agent"); VM_WAIT(); }
    __syncthreads();
    const float* x = IN_F(0); const float* g1n = IN_F(5); const float* mod = WSP(float, WS_MOD); bf16* H = WSP(bf16, WS_HB); unsigned char* H8 = WSP(unsigned char, WS_H8);
    const int gw = F.vcu * NWAVES + F.wave, NGW = F.G * NWAVES;
    f32x4 v0[4], v1[4], n0[4], n1[4];
#define P1_LOADX(ma, mb, A, B) do { const f32x4* xa_ = (const f32x4*)(x + (size_t)(ma) * DM) + F.lane; const f32x4* xb_ = (const f32x4*)(x + (size_t)(mb) * DM) + F.lane; \
        _Pragma("unroll") for (int j_ = 0; j_ < 4; ++j_) { A[j_] = xa_[64 * j_]; B[j_] = xb_[64 * j_]; } } while (0)
    int m0 = gw;
    if (m0 < NTOK) { const int m1 = (m0 + NGW < NTOK) ? m0 + NGW : m0; P1_LOADX(m0, m1, v0, v1); }
    for (; m0 < NTOK; m0 += 2 * NGW) {
        const bool has1 = m0 + NGW < NTOK; const int m1 = has1 ? m0 + NGW : m0;
        const int b0 = m0 >> 12, b1 = m1 >> 12;
        f32x4 g[4], sh0[4], sc0[4], sh1[4], sc1[4];
#pragma unroll
        for (int j = 0; j < 4; ++j) { const int col = 4 * F.lane + 256 * j; g[j] = *(const f32x4*)(g1n + col);
            sh0[j] = *(const f32x4*)(mod + b0 * 6144 + col); sc0[j] = *(const f32x4*)(mod + b0 * 6144 + 1024 + col); sh1[j] = *(const f32x4*)(mod + b1 * 6144 + col); sc1[j] = *(const f32x4*)(mod + b1 * 6144 + 1024 + col); }
        const int p0 = m0 + 2 * NGW; const bool hasn = p0 < NTOK;
        if (hasn) { const int p1 = (p0 + NGW < NTOK) ? p0 + NGW : p0; P1_LOADX(p0, p1, n0, n1); }
        float s0 = 0.f, s1 = 0.f;
#pragma unroll
        for (int j = 0; j < 4; ++j) { s0 += (v0[j].x * v0[j].x + v0[j].y * v0[j].y) + (v0[j].z * v0[j].z + v0[j].w * v0[j].w); s1 += (v1[j].x * v1[j].x + v1[j].y * v1[j].y) + (v1[j].z * v1[j].z + v1[j].w * v1[j].w); }
#pragma unroll
        for (int o = 1; o < 64; o <<= 1) { s0 += __shfl_xor(s0, o); s1 += __shfl_xor(s1, o); }
        const float r0 = 1.0f / sqrtf(s0 * (1.f / DM) + EPS), r1 = 1.0f / sqrtf(s1 * (1.f / DM) + EPS);
        unsigned long long* o0 = (unsigned long long*)(H + (size_t)m0 * DM) + F.lane; unsigned long long* o1 = (unsigned long long*)(H + (size_t)m1 * DM) + F.lane;
#pragma unroll
        for (int j = 0; j < 4; ++j) {
            const f32x4 h0 = v0[j] * r0 * g[j] * (sc0[j] + 1.0f) + sh0[j], h1 = v1[j] * r1 * g[j] * (sc1[j] + 1.0f) + sh1[j];
            o0[64 * j] = (unsigned long long)cvtpk(h0.x, h0.y) | ((unsigned long long)cvtpk(h0.z, h0.w) << 32);
            ((unsigned*)(H8 + (size_t)m0 * DM))[F.lane + 64 * j] = pg8::pk_fp8x4(h0.x, h0.y, h0.z, h0.w);
            if (has1) { o1[64 * j] = (unsigned long long)cvtpk(h1.x, h1.y) | ((unsigned long long)cvtpk(h1.z, h1.w) << 32);
                ((unsigned*)(H8 + (size_t)m1 * DM))[F.lane + 64 * j] = pg8::pk_fp8x4(h1.x, h1.y, h1.z, h1.w); } }
#pragma unroll
        for (int j = 0; j < 4; ++j) { v0[j] = n0[j]; v1[j] = n1[j]; }
    }
#undef P1_LOADX
}

__device__ __forceinline__ void p3_knorm_unit(Frame& F, const Args& args, int unit) {
    const int h = unit & 7, j = (unit >> 3) & 15, b = unit >> 7;
    bf16* KR = WSP(bf16, WS_E) + 3 * E_STRIDE; const float* trig = WSP(float, WS_TRIG); const float* kg = IN_F(16);
    const int rsub = F.lane >> 4, c16 = F.lane & 15;
    float gk[8];
#pragma unroll
    for (int i = 0; i < 8; ++i) gk[i] = kg[c16 * 8 + i];
    float km[8];
#pragma unroll
    for (int i = 0; i < 8; ++i) km[i] = 0.f;
    const int fi = (c16 & 1) * 8;
    v4u raw[4]; f32x4 tcs[4][4]; v4u outp[4];
#define KN_LOAD(bt_) do { _Pragma("unroll") for (int i4 = 0; i4 < 4; ++i4) { const int m_ = b * SEQ + j * 256 + F.wave * 32 + ((bt_) * 4 + i4) * 4 + rsub; \
        raw[i4] = *(const v4u*)(KR + (size_t)m_ * DM + h * HD + c16 * 8); const float* tp_ = trig + (size_t)m_ * 32 + fi; \
        tcs[i4][0] = *(const f32x4*)tp_; tcs[i4][1] = *(const f32x4*)(tp_ + 4); tcs[i4][2] = *(const f32x4*)(tp_ + 16); tcs[i4][3] = *(const f32x4*)(tp_ + 20); } } while (0)
    KN_LOAD(0);
#pragma unroll
    for (int bt = 0; bt < 2; ++bt) {
#pragma unroll
        for (int i4 = 0; i4 < 4; ++i4) {
            float v[8] = {bflo(raw[i4].x), bfhi(raw[i4].x), bflo(raw[i4].y), bfhi(raw[i4].y), bflo(raw[i4].z), bfhi(raw[i4].z), bflo(raw[i4].w), bfhi(raw[i4].w)};
            float ss = 0.f;
#pragma unroll
            for (int i = 0; i < 8; ++i) ss += v[i] * v[i];
            ss += __shfl_xor(ss, 1); ss += __shfl_xor(ss, 2); ss += __shfl_xor(ss, 4); ss += __shfl_xor(ss, 8);
            const float rstd = 1.0f / sqrtf(ss * (1.f / HD) + EPS);
#pragma unroll
            for (int i = 0; i < 8; ++i) v[i] = v[i] * rstd * gk[i];
#pragma unroll
            for (int i = 0; i < 8; ++i) { const float other = __shfl_xor(v[i], 2); const float cs = tcs[i4][i >> 2][i & 3], sn = tcs[i4][2 + (i >> 2)][i & 3];
                if (c16 < 4) v[i] = (c16 < 2) ? (v[i] * cs - other * sn) : (v[i] * cs + other * sn); }
#pragma unroll
            for (int i = 0; i < 8; ++i) km[i] += v[i];
            outp[i4].x = cvtpk(v[0], v[1]); outp[i4].y = cvtpk(v[2], v[3]); outp[i4].z = cvtpk(v[4], v[5]); outp[i4].w = cvtpk(v[6], v[7]); }
        if (bt == 0) KN_LOAD(1);
#pragma unroll
        for (int i4 = 0; i4 < 4; ++i4) { const int m = b * SEQ + j * 256 + F.wave * 32 + (bt * 4 + i4) * 4 + rsub; *(v4u*)(KR + (size_t)m * DM + h * HD + c16 * 8) = outp[i4]; }
    }
#undef KN_LOAD
    LAS float* red = (LAS float*)(F.lds + XTRA_OFF);
#pragma unroll
    for (int i = 0; i < 8; ++i) { float v = km[i]; v += __shfl_xor(v, 16); v += __shfl_xor(v, 32); if (rsub == 0) red[F.wave * 128 + c16 * 8 + i] = v; }
    __syncthreads();
    if (F.tid < 128) { float s = 0.f;
#pragma unroll
        for (int w = 0; w < 8; ++w) s += red[w * 128 + F.tid];
        WSP(float, WS_KMEAN)[((size_t)(b * NH + h) * 16 + j) * HD + F.tid] = s * (1.f / 256.f); }
    __syncthreads();
}

__device__ __forceinline__ void p3_rnn_local_unit(Frame& F, const Args& args, int unit) {
    const int n = unit & 7, c = (unit >> 3) & 15, b = unit >> 7;
    const int t0 = c * 256, m0 = b * SEQ + t0, ch0 = n * 128;
    const bf16* XR = WSP(bf16, WS_E);
    LAS unsigned char* At = F.lds;
    {
        const int cg = F.tid & 15, rs = F.tid >> 4; const int chb = ch0 + cg * 8;
        const float* cw = IN_F(8); const float* cb = IN_F(9);
        float w0[8], w1[8], w2[8], w3[8], bb[8];
#pragma unroll
        for (int i = 0; i < 8; ++i) { w0[i] = cw[chb + i]; w1[i] = cw[1024 + chb + i]; w2[i] = cw[2048 + chb + i]; w3[i] = cw[3072 + chb + i]; bb[i] = cb[chb + i]; }
        const int tr0 = t0 + rs * 8;
        v4u rw[11];
#pragma unroll
        for (int r = 0; r < 11; ++r) { const int tt = tr0 - 3 + r; rw[r] = *(const v4u*)(XR + (size_t)(b * SEQ + (tt < 0 ? 0 : tt)) * DM + chb); if (tt < 0) rw[r] = (v4u){0u, 0u, 0u, 0u}; }
#define UNP(dst, w_) do { dst[0] = bflo(w_.x); dst[1] = bfhi(w_.x); dst[2] = bflo(w_.y); dst[3] = bfhi(w_.y); dst[4] = bflo(w_.z); dst[5] = bfhi(w_.z); dst[6] = bflo(w_.w); dst[7] = bfhi(w_.w); } while (0)
        float p1[8], p2[8], p3[8];
        UNP(p3, rw[0]); UNP(p2, rw[1]); UNP(p1, rw[2]);
#pragma unroll
        for (int r = 0; r < 8; ++r) { float cur[8]; UNP(cur, rw[3 + r]);
            float xc[8];
#pragma unroll
            for (int i = 0; i < 8; ++i) xc[i] = bb[i] + w0[i] * cur[i] + w1[i] * p1[i] + w2[i] * p2[i] + w3[i] * p3[i];
            const int row = rs * 8 + r;
            v4u o; o.x = cvtpk(xc[0], xc[1]); o.y = cvtpk(xc[2], xc[3]); o.z = cvtpk(xc[4], xc[5]); o.w = cvtpk(xc[6], xc[7]);
            *(LAS v4u*)(At + row * 256 + ((cg ^ (row & 15)) << 4)) = o;
#pragma unroll
            for (int i = 0; i < 8; ++i) { p3[i] = p2[i]; p2[i] = p1[i]; p1[i] = cur[i]; } }
#undef UNP
    }
    __syncthreads();
    const int fr = F.lane & 15, fq = F.lane >> 4;
    const int vloc = F.wave * 16 + fr, ch = ch0 + vloc;
    const bf16* WA = WSP(bf16, WS_WRG) + (size_t)n * 16384 + (size_t)vloc * 128 + fq * 8;
    const bf16* WX = WA + 8 * 16384;
    bf16x8 Ba[4], Bx[4];
#pragma unroll
    for (int s = 0; s < 4; ++s) { Ba[s] = *(const bf16x8*)(WA + 32 * s); Bx[s] = *(const bf16x8*)(WX + 32 * s); }
    const float ba = IN_F(11)[ch], bx = IN_F(13)[ch];
    const float sp8 = 8.0f * log1pf(expf(-IN_F(14)[ch]));
    float cP = 1.f, cH = 0.f;
    bf16* HL = WSP(bf16, WS_HL); bf16* PP = WSP(bf16, WS_PP);
    LAS unsigned short* stg = (LAS unsigned short*)(F.lds + 65536);
    for (int rq = 0; rq < 4; ++rq) {
        LAS unsigned short* sb = stg + (rq & 1) * 16384;
#pragma unroll
        for (int ri = 0; ri < 4; ++ri) { const int rt = rq * 4 + ri;
            f32x4 accr = {0.f, 0.f, 0.f, 0.f}, accx = {0.f, 0.f, 0.f, 0.f};
            const int arow = rt * 16 + fr;
#pragma unroll
            for (int s = 0; s < 4; ++s) { const bf16x8 a = *(const LAS bf16x8*)(At + arow * 256 + (((fq + 4 * s) ^ (arow & 15)) << 4));
                accr = __builtin_amdgcn_mfma_f32_16x16x32_bf16(a, Ba[s], accr, 0, 0, 0);
                accx = __builtin_amdgcn_mfma_f32_16x16x32_bf16(a, Bx[s], accx, 0, 0, 0); }
            float pj[4], hj[4];
#pragma unroll
            for (int j = 0; j < 4; ++j) { const int row = rt * 16 + 4 * fq + j;
                const float xcv = bf2f(*(const LAS unsigned short*)(At + row * 256 + ((((vloc >> 3)) ^ (row & 15)) << 4) + (vloc & 7) * 2));
                const float r = fast_sigmoid(accr[j] + ba), ig = fast_sigmoid(accx[j] + bx);
                const float a = __builtin_amdgcn_exp2f(-sp8 * r * 1.4426950408889634f);
                float mult = __builtin_amdgcn_sqrtf(fmaxf(fmaf(-a, a, 1.0f), 0.0f)); if (t0 + row == 0) mult = 1.0f;
                const float u = mult * ig * xcv;
                pj[j] = (j ? pj[j - 1] : 1.0f) * a; hj[j] = (j ? hj[j - 1] * a : 0.0f) + u; }
            const float tp = pj[3], th = hj[3];
            const float pa = __shfl(tp, F.lane - 16), ha = __shfl(th, F.lane - 16);
            const float pb = __shfl(tp, F.lane - 32), hb = __shfl(th, F.lane - 32);
            const float pc = __shfl(tp, F.lane - 48), hc = __shfl(th, F.lane - 48);
            float Pq, Hq;
            if (fq == 0) { Pq = 1.f; Hq = 0.f; } else if (fq == 1) { Pq = pa; Hq = ha; } else if (fq == 2) { Pq = pb * pa; Hq = pa * hb + ha; } else { Pq = pc * pb * pa; Hq = pa * (pb * hc + hb) + ha; }
            const float hstart = Hq + Pq * cH, pstart = Pq * cP;
            float hl3 = 0.f, pp3 = 0.f;
#pragma unroll
            for (int j = 0; j < 4; ++j) { const float hv = hj[j] + pj[j] * hstart, pv = pj[j] * pstart; const int rl = ri * 16 + 4 * fq + j;
                const unsigned pk = cvtpk(hv, pv); sb[rl * 128 + vloc] = (unsigned short)pk; sb[8192 + rl * 128 + vloc] = (unsigned short)(pk >> 16); if (j == 3) { hl3 = hv; pp3 = pv; } }
            cH = __shfl(hl3, fr + 48); cP = __shfl(pp3, fr + 48);
        }
        __syncthreads();
#pragma unroll
        for (int q4 = 0; q4 < 4; ++q4) { const int idx = q4 * 512 + F.tid, arr = idx >> 10, rr = (idx >> 4) & 63, c16 = idx & 15;
            const v4u val = *(const LAS v4u*)(sb + arr * 8192 + rr * 128 + c16 * 8);
            bf16* dst = (arr ? PP : HL) + (size_t)(m0 + rq * 64 + rr) * DM + ch0 + c16 * 8;
            *(v4u*)dst = val; }
    }
    if (fq == 0) { WSP(float, WS_AGGP)[(size_t)(b * 16 + c) * 1024 + ch] = cP; WSP(float, WS_AGGH)[(size_t)(b * 16 + c) * 1024 + ch] = cH; }
    __syncthreads();
}

__device__ __forceinline__ void p4_rnn_final_unit(Frame& F, const Args& args, int unit) {
    const int n = unit & 7, c = (unit >> 3) & 15, b = unit >> 7;
    const int m0 = b * SEQ + c * 256, ch0 = n * 128;
    LAS float* car = (LAS float*)(F.lds + XTRA_OFF);
    if (F.tid < 128) { const int ch = ch0 + F.tid; float h = 0.f;
        for (int cc = 0; cc < c; ++cc) { const float p = WSP(float, WS_AGGP)[(size_t)(b * 16 + cc) * 1024 + ch], hh = WSP(float, WS_AGGH)[(size_t)(b * 16 + cc) * 1024 + ch]; h = p * h + hh; }
        car[F.tid] = h; }
    __syncthreads();
    const bf16* HL = WSP(bf16, WS_HL); const bf16* PP = WSP(bf16, WS_PP); const bf16* GG = WSP(bf16, WS_E) + E_STRIDE; bf16* Y = WSP(bf16, WS_YCAT);
    const int c16 = F.tid & 15, r0 = F.tid >> 4;
    float cv[8];
#pragma unroll
    for (int i = 0; i < 8; ++i) cv[i] = car[c16 * 8 + i];
    v4u hl[8], pp[8], gg[8];
#pragma unroll
    for (int it = 0; it < 8; ++it) { const size_t o = (size_t)(m0 + it * 32 + r0) * DM + ch0 + c16 * 8; hl[it] = *(const v4u*)(HL + o); pp[it] = *(const v4u*)(PP + o); gg[it] = *(const v4u*)(GG + o); }
#pragma unroll
    for (int it = 0; it < 8; ++it) { const size_t oy = (size_t)(m0 + it * 32 + r0) * 2048 + ch0 + c16 * 8;
        v4u y;
        y.x = cvtpk((bflo(hl[it].x) + bflo(pp[it].x) * cv[0]) * bflo(gg[it].x), (bfhi(hl[it].x) + bfhi(pp[it].x) * cv[1]) * bfhi(gg[it].x));
        y.y = cvtpk((bflo(hl[it].y) + bflo(pp[it].y) * cv[2]) * bflo(gg[it].y), (bfhi(hl[it].y) + bfhi(pp[it].y) * cv[3]) * bfhi(gg[it].y));
        y.z = cvtpk((bflo(hl[it].z) + bflo(pp[it].z) * cv[4]) * bflo(gg[it].z), (bfhi(hl[it].z) + bfhi(pp[it].z) * cv[5]) * bfhi(gg[it].z));
        y.w = cvtpk((bflo(hl[it].w) + bflo(pp[it].w) * cv[6]) * bflo(gg[it].w), (bfhi(hl[it].w) + bfhi(pp[it].w) * cv[7]) * bfhi(gg[it].w));
        *(v4u*)(Y + oy) = y; }
    __syncthreads();
}

namespace att {
constexpr int KVBLK = 64, SHM_K = KVBLK * HD * 2, SHM_V = SHM_K;
constexpr float C2 = 0.08838834764831845f * 1.4426950408889634f;
#define KSWZ(row, colB) ((row) * 256 + ((colB) ^ (((row) & 7) << 4)))
__device__ __forceinline__ int v_st(int k, int c) { const int kk = (k & ~0xC) | ((k & 4) << 1) | ((k & 8) >> 1); return ((kk >> 3) * 4 + (c >> 5)) * 512 + ((kk & 7) * 32 + (c & 31)) * 2; }
__device__ __forceinline__ int v_rd_base(int lane) { return ((lane & 3) << 3) | (((lane >> 2) & 3) << 6) | (((lane >> 4) & 1) << 5) | (((lane >> 5) & 1) << 8); }
constexpr int v_rd_off(int d0, int ks, int half) { return d0 * 512 + ks * 4096 + half * 2048; }
__device__ __forceinline__ int crow(int r, int hi) { return (r & 3) + 8 * (r >> 2) + 4 * hi; }

#define RD128(dst, addr, off) asm volatile("ds_read_b128 %0, %1 offset:%2" : "=&v"(dst) : "v"(addr), "i"(off) : "memory")
#define TRRD(dst, addr, off) asm volatile("ds_read_b64_tr_b16 %0, %1 offset:%2" : "=&v"(dst) : "v"(addr), "i"(off) : "memory")
#define XWAIT(n, U) asm volatile("s_waitcnt lgkmcnt(" #n ")" : "+v"(U[0]), "+v"(U[1]), "+v"(U[2]), "+v"(U[3]) :: "memory")
template <int KB, int VB, int MODE>
__device__ __forceinline__ void xphase(f32x16& p0, f32x16& p1, f32x16* o, const bf16x8* q, const int* ka, int vb0, bf16x8 pa0, bf16x8 pa1, bf16x8 pa2, bf16x8 pa3) {
    v4u ku[4][4]; s16x4 vu[8][4];
#define RK(g) do { constexpr int o_ = 2 * SHM_V + KB * SHM_K + ((g) >> 1) * 128; \
        RD128(ku[g][0], ka[(2 * (g)) & 3], o_); RD128(ku[g][1], ka[(2 * (g)) & 3], o_ + 8192); RD128(ku[g][2], ka[(2 * (g) + 1) & 3], o_); RD128(ku[g][3], ka[(2 * (g) + 1) & 3], o_ + 8192); } while (0)
#define KF(g, j) (*reinterpret_cast<const bf16x8*>(&ku[g][j]))
#define MK(g) do { if constexpr ((g) == 0) { p0 = __builtin_amdgcn_mfma_f32_32x32x16_bf16(KF(g, 0), q[2 * (g)], f32x16{}, 0, 0, 0); p1 = __builtin_amdgcn_mfma_f32_32x32x16_bf16(KF(g, 1), q[2 * (g)], f32x16{}, 0, 0, 0); } \
        else { p0 = __builtin_amdgcn_mfma_f32_32x32x16_bf16(KF(g, 0), q[2 * (g)], p0, 0, 0, 0); p1 = __builtin_amdgcn_mfma_f32_32x32x16_bf16(KF(g, 1), q[2 * (g)], p1, 0, 0, 0); } \
        p0 = __builtin_amdgcn_mfma_f32_32x32x16_bf16(KF(g, 2), q[2 * (g) + 1], p0, 0, 0, 0); p1 = __builtin_amdgcn_mfma_f32_32x32x16_bf16(KF(g, 3), q[2 * (g) + 1], p1, 0, 0, 0); } while (0)
#define RV(u) do { constexpr int o_ = VB * SHM_V + ((u) & 1) * 1024 + ((u) >> 1) * 4096; \
        TRRD(vu[u][0], vb0, o_); TRRD(vu[u][1], vb0, o_ + 2048); TRRD(vu[u][2], vb0, o_ + 512); TRRD(vu[u][3], vb0, o_ + 512 + 2048); } while (0)
#define VF(u, j) ((bf16x8){vu[u][j][0], vu[u][j][1], vu[u][j][2], vu[u][j][3], vu[u][j + 1][0], vu[u][j + 1][1], vu[u][j + 1][2], vu[u][j + 1][3]})
#define MV(u, PA) do { o[((u) & 1) * 2] = __builtin_amdgcn_mfma_f32_32x32x16_bf16(PA, VF(u, 0), o[((u) & 1) * 2], 0, 0, 0); o[((u) & 1) * 2 + 1] = __builtin_amdgcn_mfma_f32_32x32x16_bf16(PA, VF(u, 2), o[((u) & 1) * 2 + 1], 0, 0, 0); } while (0)
    if constexpr (MODE == 3) {
        RK(0); RK(1);
        XWAIT(4, ku[0]); MK(0); RK(2);
        XWAIT(4, ku[1]); MK(1); RK(3);
        XWAIT(4, ku[2]); MK(2); RV(0); RV(1);
        XWAIT(8, ku[3]); MK(3); RV(2);
        XWAIT(8, vu[0]); MV(0, pa0); RV(3);
        XWAIT(8, vu[1]); MV(1, pa0); RV(4);
        XWAIT(8, vu[2]); MV(2, pa1); RV(5);
        XWAIT(8, vu[3]); MV(3, pa1); RV(6);
        XWAIT(8, vu[4]); MV(4, pa2); RV(7);
        XWAIT(8, vu[5]); MV(5, pa2);
        XWAIT(4, vu[6]); MV(6, pa3);
        XWAIT(0, vu[7]); MV(7, pa3);
    } else if constexpr (MODE == 1) {
        RK(0); RK(1);
        XWAIT(4, ku[0]); MK(0); RK(2);
        XWAIT(4, ku[1]); MK(1); RK(3);
        XWAIT(4, ku[2]); MK(2);
        XWAIT(0, ku[3]); MK(3);
    } else {
        RV(0); RV(1); RV(2);
        XWAIT(8, vu[0]); MV(0, pa0); RV(3);
        XWAIT(8, vu[1]); MV(1, pa0); RV(4);
        XWAIT(8, vu[2]); MV(2, pa1); RV(5);
        XWAIT(8, vu[3]); MV(3, pa1); RV(6);
        XWAIT(8, vu[4]); MV(4, pa2); RV(7);
        XWAIT(8, vu[5]); MV(5, pa2);
        XWAIT(4, vu[6]); MV(6, pa3);
        XWAIT(0, vu[7]); MV(7, pa3);
    }
#undef RK
#undef KF
#undef MK
#undef RV
#undef VF
#undef MV
}
#undef RD128
#undef TRRD
#undef XWAIT
__device__ __forceinline__ void sm_a(f32x16& p0) {
#pragma unroll
    for (int r = 0; r < 16; ++r) p0[r] = __builtin_amdgcn_exp2f(p0[r]);
}
__device__ __forceinline__ void sm_b(f32x16& p0, f32x16& p1, float& l_reg, bf16x8& pa0, bf16x8& pa1, bf16x8& pa2, bf16x8& pa3) {
#pragma unroll
    for (int r = 0; r < 16; ++r) p1[r] = __builtin_amdgcn_exp2f(p1[r]);
    float ps = 0;
#pragma unroll
    for (int r = 0; r < 16; ++r) ps += p0[r];
#pragma unroll
    for (int r = 0; r < 16; ++r) ps += p1[r];
    l_reg += ps;
#define PK4(P, B_, OUT) do { unsigned a0 = cvtpk(P[B_+0], P[B_+1]), a1 = cvtpk(P[B_+2], P[B_+3]); \
        unsigned b0 = cvtpk(P[B_+4], P[B_+5]), b1 = cvtpk(P[B_+6], P[B_+7]); \
        auto r0 = __builtin_amdgcn_permlane32_swap(a0, b0, false, false); auto r1 = __builtin_amdgcn_permlane32_swap(a1, b1, false, false); \
        v4u w = {r0[0], r1[0], r0[1], r1[1]}; OUT = *reinterpret_cast<bf16x8*>(&w); } while (0)
    PK4(p0, 0, pa0); PK4(p0, 8, pa1); PK4(p1, 0, pa2); PK4(p1, 8, pa3);
#undef PK4
}

__device__ __forceinline__ void attn_unit(Frame& F, const Args& args, int b, int h, int iq) {
    int tid = F.tid; asm volatile("" : "+v"(tid));
    const int wid = F.wave, lane = tid & 63, r32 = lane & 31, hi = lane >> 5;
    char* lds = F.ldsg;
    char* V_lds = lds; char* K_lds = lds + 2 * SHM_V;
    float* kml = (float*)(lds + XTRA_OFF);
    const bf16* QR = WSP(bf16, WS_E) + 2 * E_STRIDE; const bf16* KN = WSP(bf16, WS_E) + 3 * E_STRIDE; const bf16* VV = WSP(bf16, WS_E) + 4 * E_STRIDE;
    bf16* YA = WSP(bf16, WS_YCAT) + 1024;
    const size_t mb = (size_t)b * SEQ;
    const int q0 = iq * 256, NT = 4 * (iq + 1);
    const bf16* Kh = KN + mb * DM + h * HD; const bf16* Vh = VV + mb * DM + h * HD;
    { const float* kmg = WSP(float, WS_KMEAN) + (size_t)(b * NH + h) * 16 * HD; for (int idx = tid; idx < iq * HD; idx += 512) kml[idx] = kmg[idx]; }
    const int vb0 = (int)(uintptr_t)V_lds + v_rd_base(lane);
    unsigned koff[2], voff[2];
#pragma unroll
    for (int jq = 0; jq < 2; ++jq) { const int p = (2 * wid + jq) * 64 + lane;
        { const int row = p >> 4, c = (p & 15) ^ (row & 7); koff[jq] = (unsigned)(row * DM + c * 8) * 2u; }
        { const int st = p >> 5, idx = p & 31, kk = (st >> 2) * 8 + (idx >> 2), col = (st & 3) * 32 + (idx & 3) * 8, k = (kk & ~0xC) | ((kk & 4) << 1) | ((kk & 8) >> 1); voff[jq] = (unsigned)(k * DM + col) * 2u; } }
#define DMA_K(t, bf) do { _Pragma("unroll") for (int jq_ = 0; jq_ < 2; ++jq_) __builtin_amdgcn_global_load_lds((const unsigned*)((const char*)(Kh + (size_t)(t) * 64 * DM) + koff[jq_]), (LAS unsigned*)(F.lds + 2 * SHM_V + (bf) * SHM_K + (2 * wid + jq_) * 1024), 16, 0, 0); } while (0)
#define DMA_V(t, bf) do { _Pragma("unroll") for (int jq_ = 0; jq_ < 2; ++jq_) __builtin_amdgcn_global_load_lds((const unsigned*)((const char*)(Vh + (size_t)(t) * 64 * DM) + voff[jq_]), (LAS unsigned*)(F.lds + (bf) * SHM_V + (2 * wid + jq_) * 1024), 16, 0, 0); } while (0)
    DMA_K(0, 0); DMA_V(0, 0);
    const size_t mq = mb + q0 + wid * 32 + r32;
    unsigned selmask; bf16x8 qr[8];
    {
        const bf16* qp = QR + mq * DM + h * HD + hi * 8;
        v4u raw[8];
#pragma unroll
        for (int d0 = 0; d0 < 8; ++d0) raw[d0] = *(const v4u*)(qp + d0 * 16);
        float ss = 0.f;
#pragma unroll
        for (int d0 = 0; d0 < 8; ++d0) { const float a0 = bflo(raw[d0].x), a1 = bfhi(raw[d0].x), a2 = bflo(raw[d0].y), a3 = bfhi(raw[d0].y), a4 = bflo(raw[d0].z), a5 = bfhi(raw[d0].z), a6 = bflo(raw[d0].w), a7 = bfhi(raw[d0].w);
            ss += (a0 * a0 + a1 * a1) + (a2 * a2 + a3 * a3) + (a4 * a4 + a5 * a5) + (a6 * a6 + a7 * a7); }
        ss += __shfl_xor(ss, 32);
        const float rs = C2 / sqrtf(ss * (1.f / HD) + EPS);
        const float* qg = IN_F(15) + hi * 8;
#define UNPK(f, W_) do { const v4u t_ = (W_); f[0] = bflo(t_.x); f[1] = bfhi(t_.x); f[2] = bflo(t_.y); f[3] = bfhi(t_.y); f[4] = bflo(t_.z); f[5] = bfhi(t_.z); f[6] = bflo(t_.w); f[7] = bfhi(t_.w); } while (0)
#define PACK(f) ({ v4u w_; w_.x = cvtpk(f[0], f[1]); w_.y = cvtpk(f[2], f[3]); w_.z = cvtpk(f[4], f[5]); w_.w = cvtpk(f[6], f[7]); *reinterpret_cast<bf16x8*>(&w_); })
        { float f0[8], f1[8]; UNPK(f0, raw[0]); UNPK(f1, raw[1]);
          const float* tg = WSP(float, WS_TRIG) + mq * 32 + hi * 8;
#pragma unroll
          for (int j = 0; j < 8; ++j) { const float x1 = f0[j] * rs * qg[j], x2 = f1[j] * rs * qg[16 + j], cs = tg[j], sn = tg[16 + j]; f0[j] = x1 * cs - x2 * sn; f1[j] = x2 * cs + x1 * sn; }
          qr[0] = PACK(f0); qr[1] = PACK(f1); }
#pragma unroll
        for (int d0 = 2; d0 < 8; ++d0) { float f[8]; UNPK(f, raw[d0]);
#pragma unroll
            for (int j = 0; j < 8; ++j) f[j] *= rs * qg[d0 * 16 + j];
            qr[d0] = PACK(f); }
        __syncthreads();
        float v1 = -__builtin_inff(), v2 = v1, v3 = v1; int i1 = 0, i2 = 0, i3 = 0;
#pragma unroll 1
        for (int jb = 0; jb < iq; ++jb) { const float* km = kml + jb * HD + hi * 8; float g = 0.f;
#pragma unroll
            for (int d0 = 0; d0 < 8; ++d0) { float f[8]; UNPK(f, *reinterpret_cast<const v4u*>(&qr[d0]));
                const f32x4 k0 = *(const f32x4*)(km + d0 * 16), k1 = *(const f32x4*)(km + d0 * 16 + 4);
                g += (f[0] * k0[0] + f[1] * k0[1]) + (f[2] * k0[2] + f[3] * k0[3]) + (f[4] * k1[0] + f[5] * k1[1]) + (f[6] * k1[2] + f[7] * k1[3]); }
            g += __shfl_xor(g, 32);
            if (g > v1) { v3 = v2; i3 = i2; v2 = v1; i2 = i1; v1 = g; i1 = jb; }
            else if (g > v2) { v3 = v2; i3 = i2; v2 = g; i2 = jb; }
            else if (g > v3) { v3 = g; i3 = jb; } }
#undef UNPK
#undef PACK
        selmask = 0u; if (iq >= 1) selmask |= 1u << i1; if (iq >= 2) selmask |= 1u << i2; if (iq >= 3) selmask |= 1u << i3;
    }
    float l_reg = 0.f; f32x16 o[4] = {};
    const int wrow0 = wid * 32;
#define ACT(t) (((t) >> 2) < iq ? (__ballot((selmask >> ((t) >> 2)) & 1u) != 0ull) : ((((t) - 4 * iq) * 64) <= wrow0 + 31))
#define MASKT(P0_, P1_, t) do { const int blk_ = (t) >> 2; const float NEG_ = -__builtin_inff(); \
        if (blk_ < iq) { if (!((selmask >> blk_) & 1u)) { _Pragma("unroll") for (int r = 0; r < 16; ++r) { P0_[r] = NEG_; P1_[r] = NEG_; } } } \
        else { const int kb_ = ((t) - 4 * iq) * 64; if (kb_ + 63 > wrow0) { int dq_ = wrow0 + r32 - kb_ - 4 * hi; asm volatile("" : "+v"(dq_)); \
            _Pragma("unroll") for (int r = 0; r < 16; ++r) { const int c_ = (r & 3) + 8 * (r >> 2); if (c_ > dq_) P0_[r] = NEG_; if (c_ + 32 > dq_) P1_[r] = NEG_; } } } } while (0)
    f32x16 p0, p1; bf16x8 pa0 = {}, pa1 = {}, pa2 = {}, pa3 = {};
    int ka[4];
#pragma unroll
    for (int dd = 0; dd < 4; ++dd) ka[dd] = (int)(uintptr_t)lds + KSWZ(r32, dd * 32 + hi * 16);
    const int grp = wid >> 2;
#define BAR() do { asm volatile("" ::: "memory"); __builtin_amdgcn_s_barrier(); asm volatile("" ::: "memory"); } while (0)
#define ISSUE_E(t) do { DMA_K((t) + 1, 1); DMA_V((t), 0); } while (0)
#define ISSUE_O(t) do { if ((t) + 1 < NT) DMA_K((t) + 1, 0); DMA_V((t), 1); } while (0)
#define YPH(t) do { MASKT(p0, p1, (t)); sm_a(p0); sm_b(p0, p1, l_reg, pa0, pa1, pa2, pa3); } while (0)
    VM_WAIT(); __syncthreads();
    if (grp) { ISSUE_E(0); BAR(); }
    if (!grp) ISSUE_E(0);
    xphase<0, 1, 1>(p0, p1, o, qr, ka, vb0, pa0, pa1, pa2, pa3);
    if (grp) VM_WAIT();
    BAR();
    if (grp) ISSUE_O(1);
    YPH(0);
    if (!grp) VM_WAIT();
    BAR();
    for (int t = 1; t + 1 < NT; t += 2) {
        if (!grp) ISSUE_O(t);
        xphase<1, 0, 3>(p0, p1, o, qr, ka, vb0, pa0, pa1, pa2, pa3);
        if (grp) VM_WAIT();
        BAR();
        if (grp) ISSUE_E(t + 1);
        YPH(t);
        if (!grp) VM_WAIT();
        BAR();
        if (!grp) ISSUE_E(t + 1);
        xphase<0, 1, 3>(p0, p1, o, qr, ka, vb0, pa0, pa1, pa2, pa3);
        if (grp) VM_WAIT();
        BAR();
        if (grp) ISSUE_O(t + 2);
        YPH(t + 1);
        if (!grp) VM_WAIT();
        BAR();
    }
    if (!grp) ISSUE_O(NT - 1);
    xphase<1, 0, 3>(p0, p1, o, qr, ka, vb0, pa0, pa1, pa2, pa3);
    if (grp) VM_WAIT();
    BAR();
    YPH(NT - 1);
    if (!grp) VM_WAIT();
    BAR();
    xphase<0, 1, 2>(p0, p1, o, qr, ka, vb0, pa0, pa1, pa2, pa3);
    BAR();
    if (!grp) BAR();
#undef YPH
#undef ISSUE_E
#undef ISSUE_O
#undef BAR
#undef DMA_K
#undef DMA_V
    l_reg += __shfl_xor(l_reg, 32);
    float* li_l = (float*)(lds + XTRA_OFF + 8192) + wid * 32;
    if (hi == 0) li_l[r32] = l_reg;
    asm volatile("s_waitcnt lgkmcnt(0)" ::: "memory");
    float rli[16];
#pragma unroll
    for (int r = 0; r < 16; ++r) rli[r] = __builtin_amdgcn_rcpf(li_l[crow(r, hi)]);
    { unsigned short* stg = (unsigned short*)(lds + wid * 8192);
#pragma unroll
      for (int r = 0; r < 16; ++r) { const int orow = crow(r, hi);
#pragma unroll
          for (int d0 = 0; d0 < 4; ++d0) stg[orow * 128 + d0 * 32 + r32] = (unsigned short)f2bf(o[d0][r] * rli[r]); }
      asm volatile("s_waitcnt lgkmcnt(0)" ::: "memory");
      bf16* Ow = YA + (mb + q0 + wid * 32) * 2048 + h * HD;
#pragma unroll
      for (int i = 0; i < 8; ++i) { const int row = i * 4 + (lane >> 4), ch = lane & 15; const v4u v = *(const v4u*)(stg + row * 128 + ch * 8); *(v4u*)(Ow + (size_t)row * 2048 + ch * 8) = v; } }
    __syncthreads();
#undef ACT
#undef MASKT
}
#undef KSWZ
}

__device__ __forceinline__ void p7_router(Frame& F, const Args& args) {
    LAS float* ssq = (LAS float*)F.lds;
    LAS float* par = (LAS float*)(F.lds + 2048);
    LAS float* lg = (LAS float*)(F.lds + 10240);
    LAS int* hist = (LAS int*)(F.lds + 77824 + 2048);
    LAS int* sel = (LAS int*)(F.lds + 77824 + 4096);
    const float* g2n = IN_F(6); const float* mod = WSP(float, WS_MOD); const float* brt = IN_F(21);
    unsigned char* H2 = WSP(unsigned char, WS_HB);
    const float* xin = IN_F(0); const bf16* D1 = WSP(bf16, WS_D1);
    unsigned* CNT = (unsigned*)(F.ws + WS_CTL) + CW_CNT;
    const int row = F.lane & 15, q = F.lane >> 4, kw = F.wave * 128;
    bf16x8 Bh[4][2], Bl[4][2];
    { const bf16* wh = WSP(bf16, WS_WRH) + (size_t)row * 1024 + kw + 8 * q; const bf16* wl = WSP(bf16, WS_WRL) + (size_t)row * 1024 + kw + 8 * q;
#pragma unroll
      for (int s = 0; s < 4; ++s) { Bh[s][0] = *(const bf16x8*)(wh + 32 * s); Bh[s][1] = *(const bf16x8*)(wh + 16384 + 32 * s); Bl[s][0] = *(const bf16x8*)(wl + 32 * s); Bl[s][1] = *(const bf16x8*)(wl + 16384 + 32 * s); } }
    for (int vw = F.vcu; vw < 256; vw += F.G) {
        const int m0 = vw * 64, b = m0 >> 12;
        for (int i = F.tid; i < 1024; i += 512) { par[i] = g2n[i] * (1.0f + mod[b * 6144 + 4096 + i]); par[1024 + i] = mod[b * 6144 + 3072 + i]; }
        if (F.tid < 32) hist[F.tid] = 0;
#pragma unroll
        for (int rt = 0; rt < 4; ++rt) { const float* xp = xin + (size_t)(m0 + rt * 16 + row) * DM + kw + 8 * q; const bf16* dp = D1 + (size_t)(m0 + rt * 16 + row) * DM + kw + 8 * q; float ss = 0.f;
#pragma unroll
            for (int s = 0; s < 4; ++s) { const v4u dd = *(const v4u*)(dp + 32 * s);
                const f32x4 x0 = *(const f32x4*)(xp + 32 * s) + (f32x4){bflo(dd.x), bfhi(dd.x), bflo(dd.y), bfhi(dd.y)}, x1 = *(const f32x4*)(xp + 32 * s + 4) + (f32x4){bflo(dd.z), bfhi(dd.z), bflo(dd.w), bfhi(dd.w)};
                const f32x4 a = x0 * x0 + x1 * x1; ss += (a.x + a.y) + (a.z + a.w); }
            ss += __shfl_xor(ss, 16); ss += __shfl_xor(ss, 32);
            if (q == 0) ssq[F.wave * 64 + rt * 16 + row] = ss; }
        __syncthreads();
        f32x4 xraw[2][4][2]; v4u draw[2][4];
#define P7_LOADRT(rt_) do { const float* xp_ = xin + (size_t)(m0 + (rt_) * 16 + row) * DM + kw + 8 * q; const bf16* dp_ = D1 + (size_t)(m0 + (rt_) * 16 + row) * DM + kw + 8 * q; \
        _Pragma("unroll") for (int s_ = 0; s_ < 4; ++s_) { draw[(rt_) & 1][s_] = *(const v4u*)(dp_ + 32 * s_); xraw[(rt_) & 1][s_][0] = *(const f32x4*)(xp_ + 32 * s_); xraw[(rt_) & 1][s_][1] = *(const f32x4*)(xp_ + 32 * s_ + 4); } } while (0)
        P7_LOADRT(0);
#pragma unroll
        for (int rt = 0; rt < 4; ++rt) { const int rl = rt * 16 + row; float tot = 0.f;
            if (rt + 1 < 4) P7_LOADRT(rt + 1);
#pragma unroll
            for (int w = 0; w < 8; ++w) tot += ssq[w * 64 + rl];
            const float rstd = 1.0f / sqrtf(tot * (1.f / DM) + EPS);
            f32x4 acc0 = {0.f, 0.f, 0.f, 0.f}, acc1 = {0.f, 0.f, 0.f, 0.f};
            unsigned char* hp = H2 + (size_t)(m0 + rl) * DM + kw + 8 * q;
            f32x4 xq[4][2];
#pragma unroll
            for (int s = 0; s < 4; ++s) { const v4u dd = draw[rt & 1][s];
                xq[s][0] = xraw[rt & 1][s][0] + (f32x4){bflo(dd.x), bfhi(dd.x), bflo(dd.y), bfhi(dd.y)}; xq[s][1] = xraw[rt & 1][s][1] + (f32x4){bflo(dd.z), bfhi(dd.z), bflo(dd.w), bfhi(dd.w)}; }
#pragma unroll
            for (int s = 0; s < 4; ++s) { const int col = kw + 32 * s + 8 * q; float h[8];
#pragma unroll
                for (int hf = 0; hf < 2; ++hf) { const f32x4 sc = *(const LAS f32x4*)(par + col + 4 * hf), sh = *(const LAS f32x4*)(par + 1024 + col + 4 * hf);
                    const f32x4 t = xq[s][hf] * rstd * sc + sh; h[4 * hf] = t.x; h[4 * hf + 1] = t.y; h[4 * hf + 2] = t.z; h[4 * hf + 3] = t.w; }
                v4u hi; hi.x = cvtpk(h[0], h[1]); hi.y = cvtpk(h[2], h[3]); hi.z = cvtpk(h[4], h[5]); hi.w = cvtpk(h[6], h[7]);
                { v2u h8; h8.x = pg8::pk_fp8x4(h[0], h[1], h[2], h[3]); h8.y = pg8::pk_fp8x4(h[4], h[5], h[6], h[7]); *(v2u*)(hp + 32 * s) = h8; }
                v4u lo; lo.x = cvtpk(h[0] - bflo(hi.x), h[1] - bfhi(hi.x)); lo.y = cvtpk(h[2] - bflo(hi.y), h[3] - bfhi(hi.y)); lo.z = cvtpk(h[4] - bflo(hi.z), h[5] - bfhi(hi.z)); lo.w = cvtpk(h[6] - bflo(hi.w), h[7] - bfhi(hi.w));
                const bf16x8 ah = *reinterpret_cast<bf16x8*>(&hi), al = *reinterpret_cast<bf16x8*>(&lo);
                acc0 = __builtin_amdgcn_mfma_f32_16x16x32_bf16(ah, Bh[s][0], acc0, 0, 0, 0); acc0 = __builtin_amdgcn_mfma_f32_16x16x32_bf16(ah, Bl[s][0], acc0, 0, 0, 0); acc0 = __builtin_amdgcn_mfma_f32_16x16x32_bf16(al, Bh[s][0], acc0, 0, 0, 0);
                acc1 = __builtin_amdgcn_mfma_f32_16x16x32_bf16(ah, Bh[s][1], acc1, 0, 0, 0); acc1 = __builtin_amdgcn_mfma_f32_16x16x32_bf16(ah, Bl[s][1], acc1, 0, 0, 0); acc1 = __builtin_amdgcn_mfma_f32_16x16x32_bf16(al, Bh[s][1], acc1, 0, 0, 0); }
#pragma unroll
            for (int r = 0; r < 4; ++r) { lg[(F.wave * 64 + rt * 16 + 4 * q + r) * 33 + row] = acc0[r]; lg[(F.wave * 64 + rt * 16 + 4 * q + r) * 33 + 16 + row] = acc1[r]; } }
#undef P7_LOADRT
        __syncthreads();
        { const int rowl = F.tid >> 3, eq = F.tid & 7; float v[4];
#pragma unroll
          for (int j = 0; j < 4; ++j) { float a = brt[4 * eq + j];
#pragma unroll
              for (int w = 0; w < 8; ++w) a += lg[(w * 64 + rowl) * 33 + 4 * eq + j];
              v[j] = a; }
          float tv[4]; int te[4];
#pragma unroll
          for (int k = 0; k < 4; ++k) { float gm = fmaxf(fmaxf(v[0], v[1]), fmaxf(v[2], v[3]));
              gm = fmaxf(gm, __shfl_xor(gm, 1)); gm = fmaxf(gm, __shfl_xor(gm, 2)); gm = fmaxf(gm, __shfl_xor(gm, 4));
              int ci = v[0] == gm ? 4 * eq : v[1] == gm ? 4 * eq + 1 : v[2] == gm ? 4 * eq + 2 : v[3] == gm ? 4 * eq + 3 : 99;
              ci = min(ci, __shfl_xor(ci, 1)); ci = min(ci, __shfl_xor(ci, 2)); ci = min(ci, __shfl_xor(ci, 4));
              te[k] = ci; tv[k] = gm;
#pragma unroll
              for (int j = 0; j < 4; ++j) if (ci == 4 * eq + j) v[j] = -__builtin_inff(); }
          if (eq == 0) { const float w1 = __expf(tv[1] - tv[0]), w2 = __expf(tv[2] - tv[0]), w3 = __expf(tv[3] - tv[0]); const float inv = 1.0f / (1.0f + w1 + w2 + w3);
              const float gk[4] = {inv, w1 * inv, w2 * inv, w3 * inv};
#pragma unroll
              for (int k = 0; k < 4; ++k) { const int lr = atomicAdd((int*)&hist[te[k]], 1); sel[rowl * 4 + k] = te[k]; sel[256 + rowl * 4 + k] = lr; sel[512 + rowl * 4 + k] = __float_as_int(gk[k]); } } }
        __syncthreads();
        if (F.tid < 32) { const int hc = hist[F.tid]; hist[32 + F.tid] = hc ? (int)__hip_atomic_fetch_add(CNT + F.tid, (unsigned)hc, RLX_AGENT) : 0; }
        __syncthreads();
        if (F.tid < 256) { const int e = sel[F.tid], pos = hist[32 + e] + sel[256 + F.tid], mm = m0 + (F.tid >> 2);
            WSP(int, WS_ROWTOK)[(size_t)e * ECAP + pos] = mm; WSP(int, WS_ROWGATE)[(size_t)e * ECAP + pos] = sel[512 + F.tid];
            WSP(int, WS_TOKE)[mm * 4 + (F.tid & 3)] = e; WSP(int, WS_TOKPOS)[mm * 4 + (F.tid & 3)] = pos; }
        __syncthreads();
    }
}

constexpr int MOE_TBL_OFF = XTRA_OFF, MOE_LIST_OFF = XTRA_OFF + 2048;
__device__ __forceinline__ int moe_tables(Frame& F) {
    LAS int* tbl = (LAS int*)(F.lds + MOE_TBL_OFF);
    const unsigned* CNT = (const unsigned*)(F.ws + WS_CTL) + CW_CNT;
    if (F.tid < 32) tbl[F.tid] = (int)__hip_atomic_load(CNT + F.tid, RLX_AGENT);
    __syncthreads();
    if (F.tid == 0) { int run = 0;
#pragma unroll 1
        for (int e = 0; e < 32; ++e) { tbl[32 + e] = run; const int nb = (tbl[e] + 255) >> 8;
#pragma unroll 1
            for (int bb = 0; bb < nb; ++bb) tbl[80 + run + bb] = e;
            run += nb; }
        tbl[64] = run; }
    __syncthreads();
    int nblk = tbl[64]; if (nblk > MAXBLK) nblk = MAXBLK; if (nblk < 1) nblk = 1;
    return __builtin_amdgcn_readfirstlane(nblk);
}

__device__ __forceinline__ void p11_combine(Frame& F, const Args& args) {
    (void)moe_tables(F);
    const LAS int* tbl = (const LAS int*)(F.lds + MOE_TBL_OFF);
    const float* mod = WSP(float, WS_MOD); const unsigned char* YR = WSP(unsigned char, WS_YR); const float* xin = IN_F(0); const bf16* D1 = WSP(bf16, WS_D1);
    const int gw = F.vcu * NWAVES + F.wave, NGW = F.G * NWAVES;
    const int col = 16 * F.lane;
#define P11_LOAD(m_, Y0, Y1, Y2, Y3, DA, DB, X) do { int dk_ = 0; if (F.lane < 4) { const int e_ = __hip_atomic_load(WSP(int, WS_TOKE) + (m_) * 4 + F.lane, RLX_AGENT); dk_ = tbl[32 + e_] * 256 + __hip_atomic_load(WSP(int, WS_TOKPOS) + (m_) * 4 + F.lane, RLX_AGENT); } \
        const int d0_ = __shfl(dk_, 0), d1_ = __shfl(dk_, 1), d2_ = __shfl(dk_, 2), d3_ = __shfl(dk_, 3); \
        Y0 = *(const v4u*)(YR + (size_t)d0_ * DM + col); Y1 = *(const v4u*)(YR + (size_t)d1_ * DM + col); Y2 = *(const v4u*)(YR + (size_t)d2_ * DM + col); Y3 = *(const v4u*)(YR + (size_t)d3_ * DM + col); \
        DA = *(const v4u*)(D1 + (size_t)(m_) * DM + col); DB = *(const v4u*)(D1 + (size_t)(m_) * DM + col + 8); \
        _Pragma("unroll") for (int q_ = 0; q_ < 4; ++q_) X[q_] = *(const f32x4*)(xin + (size_t)(m_) * DM + col + 4 * q_); } while (0)
#define P11_STORE(m_, Y0, Y1, Y2, Y3, DA, DB, X) do { const int b_ = (m_) >> 12; const unsigned dw_[8] = {DA.x, DA.y, DA.z, DA.w, DB.x, DB.y, DB.z, DB.w}; \
        const unsigned w0_[4] = {Y0.x, Y0.y, Y0.z, Y0.w}, w1_[4] = {Y1.x, Y1.y, Y1.z, Y1.w}, w2_[4] = {Y2.x, Y2.y, Y2.z, Y2.w}, w3_[4] = {Y3.x, Y3.y, Y3.z, Y3.w}; \
        _Pragma("unroll") for (int q_ = 0; q_ < 4; ++q_) { \
            const f32x2 a0_ = __builtin_amdgcn_cvt_pk_f32_fp8((int)w0_[q_], false) + __builtin_amdgcn_cvt_pk_f32_fp8((int)w1_[q_], false) + __builtin_amdgcn_cvt_pk_f32_fp8((int)w2_[q_], false) + __builtin_amdgcn_cvt_pk_f32_fp8((int)w3_[q_], false); \
            const f32x2 a1_ = __builtin_amdgcn_cvt_pk_f32_fp8((int)w0_[q_], true) + __builtin_amdgcn_cvt_pk_f32_fp8((int)w1_[q_], true) + __builtin_amdgcn_cvt_pk_f32_fp8((int)w2_[q_], true) + __builtin_amdgcn_cvt_pk_f32_fp8((int)w3_[q_], true); \
            const f32x4 s_ = {a0_.x, a0_.y, a1_.x, a1_.y}; \
            const f32x4 g2_ = *(const f32x4*)(mod + b_ * 6144 + 5120 + col + 4 * q_) * 0.0625f; \
            const f32x4 dl_ = {bflo(dw_[2 * q_]), bfhi(dw_[2 * q_]), bflo(dw_[2 * q_ + 1]), bfhi(dw_[2 * q_ + 1])}; \
            *(f32x4*)(F.out + (size_t)(m_) * DM + col + 4 * q_) = X[q_] + dl_ + g2_ * s_; } } while (0)
    v4u ya0, ya1, ya2, ya3, daa, dab; f32x4 xa[4]; v4u yb0, yb1, yb2, yb3, dba, dbb; f32x4 xb[4];
    int m = gw;
    if (m < NTOK) P11_LOAD(m, ya0, ya1, ya2, ya3, daa, dab, xa);
    for (; m < NTOK; m += 2 * NGW) {
        const int m1 = m + NGW, m2 = m + 2 * NGW;
        if (m1 < NTOK) P11_LOAD(m1, yb0, yb1, yb2, yb3, dba, dbb, xb);
        P11_STORE(m, ya0, ya1, ya2, ya3, daa, dab, xa);
        if (m2 < NTOK) P11_LOAD(m2, ya0, ya1, ya2, ya3, daa, dab, xa);
        if (m1 < NTOK) P11_STORE(m1, yb0, yb1, yb2, yb3, dba, dbb, xb);
    }
#undef P11_LOAD
#undef P11_STORE
}

#ifndef NSTREAM
#define NSTREAM 8
#endif
#define P4_PULL(ctr, dst) do { __syncthreads(); if (F.tid == 0) bc[0] = (int)__hip_atomic_fetch_add((ctr), 1u, RLX_AGENT); __syncthreads(); dst = bc[0]; } while (0)
__device__ __forceinline__ void p4_phase(Frame& F, const Args& args) {
    unsigned* Q = (unsigned*)(F.ws + WS_CTL) + CW_QUEUE;
    LAS int* bc = (LAS int*)(F.lds + XTRA_OFF + 12288);
    const bool xcd_ok = (F.G == 256);
    const int xg = xcd_ok ? (F.vcu >> 5) : (F.vcu & 7);
    const bool streamer = xcd_ok && (F.vcu & 31) < NSTREAM;
    if (streamer) { for (;;) { int ch; P4_PULL(Q + 64 * 9, ch); if (ch >= P8_NCHUNK) break; p8_chunk(F, args, ch); } }
#pragma unroll 1
    for (int dx = 0; dx < 8; ++dx) { const int x = (xg + dx) & 7;
        for (;;) { int a; P4_PULL(Q + 64 * x, a); if (a >= 64) break;
            const int bh = 4 * x + (a & 3); att::attn_unit(F, args, bh >> 3, bh & 7, 15 - (a >> 2)); } }
    for (;;) { int u; P4_PULL(Q + 64 * 8, u); if (u >= 512) break; p4_rnn_final_unit(F, args, u); }
    if (!streamer) { for (;;) { int ch; P4_PULL(Q + 64 * 9, ch); if (ch >= P8_NCHUNK) break; p8_chunk(F, args, ch); } }
}
#undef P4_PULL

#ifndef MK_N_LAUNCHES
#define MK_N_LAUNCHES 1
#endif
constexpr int PER_PHASE = 12;
constexpr int N_LAUNCHES = MK_N_LAUNCHES;

__global__ void __launch_bounds__(NWAVES * 64, 2) hybrid_fwd(Args args) {
    extern __shared__ __attribute__((aligned(16))) unsigned char lds[];
    Frame F;
    F.lds = (LAS unsigned char*)lds; F.ldsg = (char*)lds;
    F.MISC = (volatile LAS unsigned*)(F.lds + MISC_OFF);
    F.tid = threadIdx.x; F.lane = F.tid & 63; F.wave = __builtin_amdgcn_readfirstlane(F.tid >> 6);
    F.G = gridDim.x; { const int bx = blockIdx.x; F.vcu = (F.G % 8 == 0) ? (bx % 8) * (F.G / 8) + bx / 8 : bx; }
    F.ws = args.ws; F.out = args.out;
    gu32* ctl = (gu32*)(args.ws + WS_CTL);
    for (int u = F.tid; u < (LDS_BYTES - LDSCTL_OFF) / 4; u += NWAVES * 64) ((LAS unsigned*)(F.lds + LDSCTL_OFF))[u] = 0u;
    __syncthreads();
    XcdBarrier bar; bar.bar = (unsigned*)(ctl + CW_BAR); bar.x = 0; bar.st = nullptr;
    if (N_LAUNCHES == 1) bar = xcd_barrier_post((unsigned*)(ctl + CW_BAR), F.MISC + 8);
    const int lo = args.ph_lo, hi = args.ph_hi;
#ifndef PHASE_MASK
#define PHASE_MASK 0xFFF
#endif
#define IN(k) (((PHASE_MASK >> (k)) & 1) && lo <= (k) && (k) < hi)
#define NEXTP(k) ((k) == 0 ? 2 : (k) == 7 ? 9 : (k) + 1)
#define SEAM(k) do { if (IN(k) && IN(NEXTP(k))) xcd_barrier(bar); } while (0)

#ifndef DUP_MASK
#define DUP_MASK 0
#endif
#define PHASE(k, ...) do { if (IN(k)) { __VA_ARGS__ if ((DUP_MASK >> (k)) & 1) { xcd_barrier(bar); __VA_ARGS__ } } SEAM(k); } while (0)
    PHASE(0, { p0_prologue(F, args); p1_hrows(F, args); });
    PHASE(2, {
        { pg8::Gemm g{WSP(bf16, WS_HB), WSP(bf16, WS_WIN), NTOK, 3072, DM}; pg8::TileOrder S; S.init(NTOK / 256, 12, F.G, (int)blockIdx.x, nullptr);
          pg8::EpiWin E{WSP(bf16, WS_E), IN_F(17), 0};
          pg8::gemm_phase<pg8::EpiWin, pg8::TileOrder, true, true>(F.lds + RING_OFF, g, S, E); }
        { pg8::Gemm g{WSP(bf16, WS_H8), WSP(bf16, WS_WIN8), NTOK, 4096, DM / 2}; pg8::TileOrder S; S.init(NTOK / 256, 16, F.G, (int)blockIdx.x, nullptr);
          pg8::EpiWin E{WSP(bf16, WS_E), IN_F(17), 1};
          pg8::gemm_phase<pg8::EpiWin, pg8::TileOrder, true, true, false, true>(F.lds + RING_OFF, g, S, E); }
    });
    int p3rep = 0;
    PHASE(3, {
        for (int u = F.vcu; u < 512; u += F.G) p3_rnn_local_unit(F, args, u);
        if (p3rep++ == 0) { for (int u = F.vcu; u < 512; u += F.G) p3_knorm_unit(F, args, u); }
    });
    PHASE(4, { p4_phase(F, args); });
    PHASE(5, {
        pg8::Gemm g{WSP(bf16, WS_YCAT), WSP(bf16, WS_WB), NTOK, DM, 2 * DM}; pg8::TileOrder S; S.init(NTOK / 256, DM / 256, F.G, (int)blockIdx.x, nullptr);
        pg8::EpiBranch E{WSP(bf16, WS_E) + 5 * E_STRIDE, WSP(bf16, WS_E) + 6 * E_STRIDE, WSP(bf16, WS_HB)};
        pg8::gemm_phase<pg8::EpiBranch, pg8::TileOrder, false, true>(F.lds + RING_OFF, g, S, E);
    });
    PHASE(6, {
        pg8::Gemm g{WSP(bf16, WS_HB), WSP(bf16, WS_WO), NTOK, DM, DM}; pg8::TileOrder S; S.init(NTOK / 256, DM / 256, F.G, (int)blockIdx.x, nullptr);
        pg8::EpiWout E{WSP(bf16, WS_D1), WSP(float, WS_MOD)};
        pg8::gemm_phase<pg8::EpiWout, pg8::TileOrder, false, true>(F.lds + RING_OFF, g, S, E);
    });
    PHASE(7, { p7_router(F, args); });
    PHASE(9, {
        const int nblk = moe_tables(F);
        const LAS int* tbl = (const LAS int*)(F.lds + MOE_TBL_OFF); LAS int* lists = (LAS int*)(F.lds + MOE_LIST_OFF);
        pg8::Gemm g{WSP(bf16, WS_HB), WSP(bf16, WS_WUP), RMAX, 2048 * NEXP, DM / 2}; pg8::TileOrder S; S.init(nblk, 8, F.G, (int)blockIdx.x, tbl + 80, F.ws + WS_HB);
        { pg8::Unit u; for (int i = 0; i < 9 && S.next(i, u); ++i) { if (F.tid < 256) { const int e = u.pn >> 3, pos = (u.pm - tbl[32 + e]) * 256 + F.tid;
              lists[i * 256 + F.tid] = pos < tbl[e] ? __hip_atomic_load(WSP(int, WS_ROWTOK) + (size_t)e * ECAP + pos, RLX_AGENT) : 0; } } }
        __syncthreads();
        pg8::EpiUp E{WSP(unsigned char, WS_ACT), IN_F(23)};
        pg8::gemm_phase<pg8::EpiUp, pg8::TileOrder, true, true, true, true>(F.lds + RING_OFF, g, S, E, lists);
    });
    PHASE(10, {
        const int nblk = moe_tables(F);
        const LAS int* tbl = (const LAS int*)(F.lds + MOE_TBL_OFF);
        pg8::Gemm g{WSP(bf16, WS_ACT), WSP(bf16, WS_WDN), RMAX, 1024 * NEXP, DM / 2}; pg8::TileOrder S; S.init(nblk, 4, F.G, (int)blockIdx.x, tbl + 80);
        pg8::EpiDown E{WSP(unsigned char, WS_YR), IN_F(25), WSP(float, WS_ROWGATE), tbl, F.lds + XTRA_OFF + 12288};
        pg8::gemm_phase<pg8::EpiDown, pg8::TileOrder, true, true, false, true>(F.lds + RING_OFF, g, S, E);
    });
    PHASE(11, { p11_combine(F, args); });
#undef PHASE
#undef IN
#undef SEAM
}

extern "C" void kernel_launch(void* const* d_in, const int* in_sizes, int n_in, void* d_out, int out_size, void* d_ws, size_t ws_size, hipStream_t stream) {
    static int grid = 0;
    if (grid == 0) {
        if (n_in != 26 || in_sizes[0] != NTOK * DM || out_size != NTOK * DM || ws_size < WS_END) {
            fprintf(stderr, "kernel_launch: shape/workspace mismatch (n_in %d, in0 %d, out %d, ws %zu; need ws >= %zu); nothing launched\n", n_in, n_in > 0 ? in_sizes[0] : -1, out_size, ws_size, (size_t)WS_END); grid = -1; return; }
        int dev = 0, cus = 0, per_cu = 0;
        if (hipGetDevice(&dev) != hipSuccess || hipDeviceGetAttribute(&cus, hipDeviceAttributeMultiprocessorCount, dev) != hipSuccess) { fprintf(stderr, "kernel_launch: device query failed\n"); grid = -1; return; }
        if (hipFuncSetAttribute((const void*)hybrid_fwd, hipFuncAttributeMaxDynamicSharedMemorySize, LDS_BYTES) != hipSuccess) { fprintf(stderr, "kernel_launch: hipFuncSetAttribute failed\n"); grid = -1; return; }
        if (hipOccupancyMaxActiveBlocksPerMultiprocessor(&per_cu, (const void*)hybrid_fwd, NWAVES * 64, LDS_BYTES) != hipSuccess || per_cu < 1) { fprintf(stderr, "kernel_launch: occupancy query says %d blocks/CU\n", per_cu); per_cu = 1; }
        (void)hipGetLastError();
        grid = cus;
        if (grid > 256) grid = 256;
    }
    if (grid < 0) return;
    (void)hipMemsetAsync((char*)d_ws + WS_CTL, 0, CTL_ZERO_BYTES, stream);
    Args a{};
    for (int i = 0; i < 26; ++i) a.in[i] = d_in[i];
    a.out = (float*)d_out; a.ws = (unsigned char*)d_ws;
    for (int li = 0; li < N_LAUNCHES; ++li) {
        a.ph_lo = (N_LAUNCHES == 1) ? 0 : li; a.ph_hi = (N_LAUNCHES == 1) ? PER_PHASE : li + 1;
        hipLaunchKernelGGL(hybrid_fwd, dim3(grid), dim3(NWAVES * 64), LDS_BYTES, stream, a);
        const hipError_t le = hipPeekAtLastError();
        if (le != hipSuccess) { fprintf(stderr, "kernel_launch: launch %d failed: %s\n", li, hipGetErrorName(le)); break; }
    }
}
```

```cpp
#include <hip/hip_runtime.h>
#include <hip/hip_bf16.h>
#include <cstdio>
#include <cstdint>
#include <cmath>
namespace pg8 {
#define PG8_LAS __attribute__((address_space(3)))
typedef unsigned short bf16_t;
typedef short bf16x8 __attribute__((ext_vector_type(8)));
typedef float f32x4 __attribute__((ext_vector_type(4)));
typedef unsigned u32x4 __attribute__((ext_vector_type(4)));
constexpr int BM = 256, BK = 64, HALF = 128, HTB = HALF * BK * 2  , STAGE_BYTES = 8 * HTB, NXCD = 8, WGM = 8;

__host__ __device__ __forceinline__ int lds_byte(int r, int c) { const int st = (r >> 4) * 2 + (c >> 5), rr = r & 15, cc = c & 31, ob = rr * 64 + cc * 2; return st * 1024 + (ob ^ (((ob >> 9) & 1) << 5)); }
__host__ __device__ __forceinline__ void stage_rc(int b, int& R, int& C) { const int st = b / 1024, sb = b % 1024, swz = sb ^ (((sb >> 9) & 1) << 5); R = (st >> 1) * 16 + swz / 64; C = (st & 1) * 32 + (swz % 64) / 2; }
__host__ __device__ __forceinline__ int perm32(int rho) { const int n = rho >> 4, i = rho & 15; return 8 * (i >> 2) + 4 * n + (i & 3); }

struct Unit { int pm, pn, kind; };
struct Gemm { const bf16_t* A; const bf16_t* Bt; int M, N, K; };

struct StaticOrder {
    int nM, nN, nwg, G, c;
    __host__ __device__ void init(int M, int N, int G_, int c_) { nM = M / BM; nN = N / BM; nwg = nM * nN; G = G_; c = c_; }
    __host__ __device__ bool next(int i, Unit& u) const {
        const long L = (long)i * G + c; if (L >= nwg) return false;
        int wgid = (int)L; { const int q = nwg / NXCD, r = nwg % NXCD, xcd = wgid % NXCD, off = wgid / NXCD; wgid = (xcd < r ? xcd * (q + 1) : r * (q + 1) + (xcd - r) * q) + off; }
        const int nig = WGM * nN, gid = wgid / nig, fm = gid * WGM, gsz = (nM - fm) < WGM ? (nM - fm) : WGM;
        u.pm = fm + ((wgid % nig) % gsz); u.pn = (wgid % nig) / gsz; return true;
    }
    __device__ __forceinline__ void a_ready(const Unit&) const {}
    __device__ __forceinline__ void done(const Unit&) const {}
};

__device__ __forceinline__ unsigned cvt_pk_bf16(float lo, float hi) { unsigned r; asm volatile("v_cvt_pk_bf16_f32 %0, %1, %2" : "=v"(r) : "v"(lo), "v"(hi)); return r; }
typedef int v4i_t __attribute__((ext_vector_type(4)));
typedef int v8i_t __attribute__((ext_vector_type(8)));
template <class Epi, class Sched, bool ALIGN_EPI = false, bool SP2 = false, bool GATHER = false, bool FP8 = false>
__device__ __forceinline__ void gemm_phase(PG8_LAS unsigned char* lds, const Gemm g, const Sched& S, const Epi& E, const PG8_LAS int* rowlists = nullptr) {
    static_assert(!GATHER || SP2, "GATHER is implemented for the SP2 loop");
    const int tid = threadIdx.x, wid = __builtin_amdgcn_readfirstlane(tid >> 6), lane = tid & 63, wr = wid >> 2, wc = wid & 3, fr = lane & 15, fq = lane >> 4;
    const int K = g.K, nt = K / BK;
    unsigned voffA, voffB; int gR, gC;
    { int R, C; stage_rc(tid * 16, R, C); const int Rb = Epi::PERM ? ((R & ~31) + perm32(R & 31)) : R; gR = R; gC = C;
      voffA = (unsigned)(R * K + C) * 2u; voffB = (unsigned)(Rb * K + C) * 2u; }
    const size_t row64 = (size_t)64 * K * 2;
    const size_t kstep = (size_t)(BK * 2);
    const size_t hstep = (size_t)HALF * K * 2;
    const size_t tstep = 2 * hstep;
    const unsigned ldsw = (unsigned)wid * 1024u;
    const int aoff = lds_byte(wr * 64 + fr, fq * 8), boff = lds_byte(wc * 32 + fr, fq * 8);
#define PG8_SA(b, h) (((b) * 2 + (h)) * HTB)
#define PG8_SB(b, h) ((4 + (b) * 2 + (h)) * HTB)
#define PG8_STAGE2(bufoff, gbase, v0_, v1_) do { unsigned vo0_ = (v0_), vo1_ = (v1_); asm volatile("" : "+v"(vo0_), "+v"(vo1_));     \
        __builtin_amdgcn_global_load_lds((const unsigned*)((const char*)(gbase) + vo0_), (PG8_LAS unsigned*)(lds + (bufoff) + ldsw), 16, 0, 0); \
        __builtin_amdgcn_global_load_lds((const unsigned*)((const char*)(gbase) + vo1_), (PG8_LAS unsigned*)(lds + (bufoff) + ldsw + 8192), 16, 0, 0); } while (0)
#define PG8_STAGE(bufoff, gbase, voff) do { unsigned vo_ = (voff); asm volatile("" : "+v"(vo_)); \
        __builtin_amdgcn_global_load_lds((const unsigned*)((const char*)(gbase) + vo_), (PG8_LAS unsigned*)(lds + (bufoff) + ldsw), 16, 0, 0); \
        __builtin_amdgcn_global_load_lds((const unsigned*)((const char*)(gbase) + row64 + vo_), (PG8_LAS unsigned*)(lds + (bufoff) + ldsw + 8192), 16, 0, 0); } while (0)
#define PG8_LDA(dst, b, h) do { _Pragma("unroll") for (int m = 0; m < 4; ++m) _Pragma("unroll") for (int k = 0; k < 2; ++k) dst[m][k] = *(const PG8_LAS bf16x8*)(lds + PG8_SA(b, h) + aoff + m * 2048 + k * 1024); } while (0)
#define PG8_LDB(dst, b, h) do { _Pragma("unroll") for (int n = 0; n < 2; ++n) _Pragma("unroll") for (int k = 0; k < 2; ++k) dst[n][k] = *(const PG8_LAS bf16x8*)(lds + PG8_SB(b, h) + boff + n * 2048 + k * 1024); } while (0)
#define PG8_CAT8(x, y) __builtin_shufflevector(__builtin_bit_cast(v4i_t, (x)), __builtin_bit_cast(v4i_t, (y)), 0, 1, 2, 3, 4, 5, 6, 7)
#define PG8_MMA(ai, bj, At, Bt) do { __builtin_amdgcn_s_setprio(1); _Pragma("unroll") for (int m = 0; m < 4; ++m) _Pragma("unroll") for (int n = 0; n < 2; ++n) { \
        if constexpr (FP8) { const v8i_t a8_ = PG8_CAT8(Bt[n][0], Bt[n][1]), b8_ = PG8_CAT8(At[m][0], At[m][1]);     \
            asm volatile("v_mfma_scale_f32_16x16x128_f8f6f4 %0, %1, %2, %0, %3, %4 op_sel_hi:[0,0,0]" : "+v"(acc[ai][bj][m][n]) : "v"(a8_), "v"(b8_), "v"(mxsa_), "v"(mxsb_)); } \
        else { _Pragma("unroll") for (int k = 0; k < 2; ++k) acc[ai][bj][m][n] = __builtin_amdgcn_mfma_f32_16x16x32_bf16(Bt[n][k], At[m][k], acc[ai][bj][m][n], 0, 0, 0); } } \
        __builtin_amdgcn_s_setprio(0); } while (0)
#define PG8_WAIT_V(n) asm volatile("s_waitcnt vmcnt(" #n ")" ::: "memory")
#define PG8_WAIT_VN(n) asm volatile("s_waitcnt vmcnt(%0)" :: "i"(n) : "memory")
#define PG8_WAIT_L(n) asm volatile("s_waitcnt lgkmcnt(" #n ")" ::: "memory")
#define PG8_BAR __builtin_amdgcn_s_barrier()
#define PG8_SCHED __builtin_amdgcn_sched_barrier(0)
    Unit cur, nxt; int ui = 0;
    if (!S.next(0, cur)) return;
    int mxsa_ = 121, mxsb_ = 127; asm volatile("" : "+v"(mxsa_), "+v"(mxsb_));
    f32x4 acc[2][2][4][2];
#pragma unroll
    for (int a = 0; a < 2; ++a)
#pragma unroll
        for (int b = 0; b < 2; ++b)
#pragma unroll
            for (int m = 0; m < 4; ++m)
#pragma unroll
                for (int n = 0; n < 2; ++n) acc[a][b][m][n] = (f32x4){0.f, 0.f, 0.f, 0.f};
    bf16x8 At[4][2], B0[2][2], B1[2][2];
    const char* cA = GATHER ? (const char*)S.a_base(cur) : (const char*)g.A + (size_t)cur.pm * tstep; const char* cB = (const char*)g.Bt + (size_t)cur.pn * tstep;
#define PG8_STAGE_A(bufoff, kptr, half, unx) do { if constexpr (GATHER) { const PG8_LAS int* rl_ = rowlists + (ui + (unx)) * 256 + (half) * HALF + gR; \
        PG8_STAGE2(bufoff, kptr, (unsigned)(rl_[0] * K + gC) * 2u, (unsigned)(rl_[64] * K + gC) * 2u); } \
        else { PG8_STAGE(bufoff, (kptr) + (half) * hstep, voffA); } } while (0)
    S.a_ready(cur);
    if constexpr (SP2) {
        PG8_STAGE(PG8_SB(0, 0), cB, voffB); PG8_STAGE(PG8_SB(0, 1), cB + hstep, voffB); PG8_STAGE_A(PG8_SA(0, 0), cA, 0, 0); PG8_STAGE_A(PG8_SA(0, 1), cA, 1, 0);
        if (wr == 1) PG8_BAR;
        PG8_WAIT_V(2); PG8_BAR;
        PG8_STAGE(PG8_SB(1, 0), cB + kstep, voffB); PG8_STAGE_A(PG8_SA(1, 0), cA + kstep, 0, 0); PG8_STAGE(PG8_SB(1, 1), cB + hstep + kstep, voffB);
        PG8_WAIT_V(6); PG8_BAR;
    } else {
        PG8_STAGE(PG8_SB(0, 0), cB, voffB); PG8_STAGE(PG8_SA(0, 0), cA, voffA); PG8_STAGE(PG8_SB(0, 1), cB + hstep, voffB); PG8_STAGE(PG8_SA(0, 1), cA + hstep, voffA);
        if (wr == 1) PG8_BAR;
        PG8_WAIT_V(4); PG8_BAR;
        PG8_STAGE(PG8_SB(1, 0), cB + kstep, voffB); PG8_STAGE(PG8_SA(1, 0), cA + kstep, voffA); PG8_STAGE(PG8_SB(1, 1), cB + hstep + kstep, voffB);
        PG8_WAIT_V(6); PG8_BAR;
    }
    for (;;) {
        const bool has_next = S.next(ui + 1, nxt);
        const char* nA = GATHER ? (has_next ? (const char*)S.a_base(nxt) : cA) : (has_next ? (const char*)g.A + (size_t)nxt.pm * tstep : cA);
        const char* nB = has_next ? (const char*)g.Bt + (size_t)nxt.pn * tstep : cB;
#pragma unroll 1
        for (int t = 0; t < nt; t += 2) {
            const bool last = (t == nt - 2);
            if constexpr (Epi::MIDK) { if (t == (nt >> 1)) { if constexpr (FP8) asm volatile("s_nop 15\n\ts_nop 7" ::: "memory"); E.mid(acc, cur, wr, wc, fr, fq); } }
            const char* a1 = cA + (size_t)(t + 1) * kstep;
            const char* a2 = last ? nA : cA + (size_t)(t + 2) * kstep; const char* b2 = last ? nB : cB + (size_t)(t + 2) * kstep;
            const char* a3 = a2 + kstep; const char* b3 = b2 + kstep;
            if (last && has_next) S.a_ready(nxt);
            const int unx = (GATHER && last && has_next) ? 1 : 0;
            if constexpr (SP2) {
            PG8_LDB(B0, 0, 0); PG8_LDB(B1, 0, 1); PG8_SCHED; PG8_LDA(At, 0, 0); PG8_STAGE_A(PG8_SA(1, 1), a1, 1, 0);
            PG8_WAIT_V(8); PG8_WAIT_L(0); PG8_BAR; PG8_MMA(0, 0, At, B0); PG8_MMA(0, 1, At, B1); PG8_BAR; PG8_SCHED;
            PG8_LDA(At, 0, 1); PG8_STAGE(PG8_SB(0, 0), b2, voffB); PG8_STAGE(PG8_SB(0, 1), b2 + hstep, voffB); PG8_STAGE_A(PG8_SA(0, 0), a2, 0, unx);
            PG8_WAIT_V(8); PG8_WAIT_L(0); PG8_BAR; PG8_MMA(1, 0, At, B0); PG8_MMA(1, 1, At, B1); PG8_BAR; PG8_SCHED;
            PG8_LDB(B0, 1, 0); PG8_LDB(B1, 1, 1); PG8_SCHED; PG8_LDA(At, 1, 0); PG8_STAGE_A(PG8_SA(0, 1), a2, 1, unx);
            PG8_WAIT_V(8); PG8_WAIT_L(0); PG8_BAR; PG8_MMA(0, 0, At, B0); PG8_MMA(0, 1, At, B1); PG8_BAR; PG8_SCHED;
            PG8_LDA(At, 1, 1); PG8_STAGE(PG8_SB(1, 0), b3, voffB); PG8_STAGE(PG8_SB(1, 1), b3 + hstep, voffB); PG8_STAGE_A(PG8_SA(1, 0), a3, 0, unx);
            PG8_WAIT_V(8); PG8_WAIT_L(0); PG8_BAR; PG8_MMA(1, 0, At, B0); PG8_MMA(1, 1, At, B1); PG8_BAR; PG8_SCHED;
            } else {
            PG8_LDB(B0, 0, 0); PG8_SCHED; PG8_LDA(At, 0, 0); PG8_STAGE(PG8_SA(1, 1), a1 + hstep, voffA);
            PG8_WAIT_L(8); PG8_BAR; PG8_WAIT_L(0); PG8_MMA(0, 0, At, B0); PG8_BAR; PG8_SCHED;
            PG8_LDB(B1, 0, 1); PG8_STAGE(PG8_SB(0, 0), b2, voffB);
            PG8_BAR; PG8_WAIT_L(0); PG8_MMA(0, 1, At, B1); PG8_BAR;
            PG8_LDA(At, 0, 1); PG8_STAGE(PG8_SA(0, 0), a2, voffA);
            PG8_BAR; PG8_WAIT_L(0); PG8_MMA(1, 0, At, B0); PG8_BAR; PG8_SCHED;
            PG8_STAGE(PG8_SB(0, 1), b2 + hstep, voffB);
            PG8_WAIT_V(6); PG8_BAR; PG8_MMA(1, 1, At, B1); PG8_BAR;
            PG8_LDB(B0, 1, 0); PG8_SCHED; PG8_LDA(At, 1, 0); PG8_STAGE(PG8_SA(0, 1), a2 + hstep, voffA);
            PG8_WAIT_L(8); PG8_BAR; PG8_WAIT_L(0); PG8_MMA(0, 0, At, B0); PG8_BAR; PG8_SCHED;
            PG8_LDB(B1, 1, 1); PG8_STAGE(PG8_SB(1, 0), b3, voffB);
            PG8_BAR; PG8_WAIT_L(0); PG8_MMA(0, 1, At, B1); PG8_BAR;
            PG8_LDA(At, 1, 1); PG8_STAGE(PG8_SA(1, 0), a3, voffA);
            PG8_BAR; PG8_WAIT_L(0); PG8_MMA(1, 0, At, B0); PG8_BAR; PG8_SCHED;
            PG8_STAGE(PG8_SB(1, 1), b3 + hstep, voffB);
            PG8_WAIT_V(6); PG8_BAR; PG8_MMA(1, 1, At, B1); PG8_BAR;
            }
        }
        if constexpr (ALIGN_EPI) { if (wr == 0) PG8_BAR; }
        if constexpr (FP8) asm volatile("s_nop 15\n\ts_nop 7" ::: "memory");
        if constexpr (!Epi::AFTER_DRAIN) { E(acc, cur, wr, wc, fr, fq); S.done(cur); }
        if (!has_next) break;
#pragma unroll
        for (int a = 0; a < 2; ++a)
#pragma unroll
            for (int b = 0; b < 2; ++b)
#pragma unroll
                for (int m = 0; m < 4; ++m)
#pragma unroll
                    for (int n = 0; n < 2; ++n) acc[a][b][m][n] = (f32x4){0.f, 0.f, 0.f, 0.f};
        cur = nxt; cA = nA; cB = nB; ++ui;
        if constexpr (ALIGN_EPI) { if (wr == 1) PG8_BAR; }
    }
    PG8_WAIT_V(0);
    if constexpr (!ALIGN_EPI) { if (wr == 0) PG8_BAR; }
    PG8_BAR;
    if constexpr (Epi::AFTER_DRAIN) { E.fused(acc, cur, wr, wc, fr, fq, lds, wid, lane); S.done(cur); }
#undef PG8_SA
#undef PG8_STAGE_A
#undef PG8_SB
#undef PG8_STAGE
#undef PG8_STAGE2
#undef PG8_LDA
#undef PG8_LDB
#undef PG8_MMA
#undef PG8_CAT8
#undef PG8_WAIT_V
#undef PG8_WAIT_VN
#undef PG8_WAIT_L
#undef PG8_BAR
#undef PG8_SCHED
}
}

constexpr int NB = 4, SEQ = 4096, DM = 1024, NTOK = NB * SEQ, DIN = 7168, NH = 8, HD = 128;
constexpr int NEXP = 32, TOPK = 4, MAXBLK = 288, RMAX = MAXBLK * 256;
constexpr float EPS = 1e-6f;
constexpr int NWAVES = 8;

constexpr size_t MiB = 1u << 20, KiB = 1u << 10;
constexpr size_t WS_CTL = 0, CTL_ZERO_BYTES = 1 * MiB;
constexpr size_t WS_MOD = 1 * MiB;
constexpr size_t WS_KMEAN = 1 * MiB + 128 * KiB;
constexpr size_t WS_AGGP = 1 * MiB + 384 * KiB;
constexpr size_t WS_AGGH = 1 * MiB + 640 * KiB;
constexpr size_t WS_WRH = 2 * MiB, WS_WRL = 2 * MiB + 64 * KiB;
constexpr size_t WS_TOKE = 3 * MiB, WS_TOKPOS = 3 * MiB + 256 * KiB;
constexpr int ECAP = 16384;
constexpr size_t WS_ROWTOK = 28 * MiB, WS_ROWGATE = 30 * MiB;
constexpr int CW_UPDONE = 16384;
constexpr int CW_QUEUE = 12288;
constexpr int CW_CNT = 8192;
constexpr size_t WS_TRIG = 4 * MiB;
constexpr size_t WS_WRG = 6 * MiB;
constexpr size_t WS_WIN = 8 * MiB;
constexpr size_t WS_WIN8 = 16 * MiB;
constexpr size_t WS_H8 = 544 * MiB;
constexpr size_t WS_WB = 22 * MiB;
constexpr size_t WS_WO = 26 * MiB;
constexpr size_t WS_WUP = 32 * MiB;
constexpr size_t WS_WDN = 96 * MiB;
constexpr size_t WS_HB = 224 * MiB;
constexpr size_t WS_E = 256 * MiB;
constexpr size_t E_STRIDE = (size_t)NTOK * DM;
constexpr size_t WS_D1 = 256 * MiB;
constexpr size_t WS_HL = 480 * MiB, WS_PP = 512 * MiB, WS_YCAT = 544 * MiB;
constexpr int CW_MODCNT = 8256;
constexpr size_t WS_ACT = 400 * MiB, WS_YR = 544 * MiB;
constexpr size_t WS_END = 688 * MiB;
constexpr int CW_BAR = 4096;

constexpr int RING_OFF = 0, RING_BYTES = 131072;
constexpr int LDSCTL_OFF = RING_BYTES, MISC_OFF = LDSCTL_OFF + 320;
constexpr int XTRA_OFF = LDSCTL_OFF + 1024;
constexpr int LDS_BYTES = 155648;

#define GAS __attribute__((address_space(1)))
#define LAS __attribute__((address_space(3)))
typedef unsigned short bf16;
typedef unsigned v4u __attribute__((ext_vector_type(4)));
typedef unsigned v2u __attribute__((ext_vector_type(2)));
typedef float f32x4 __attribute__((ext_vector_type(4)));
typedef float f32x2 __attribute__((ext_vector_type(2)));
typedef float f32x16 __attribute__((ext_vector_type(16)));
typedef short bf16x8 __attribute__((ext_vector_type(8)));
typedef short s16x4 __attribute__((ext_vector_type(4)));
typedef GAS unsigned gu32;
#define RLX_AGENT __ATOMIC_RELAXED, __HIP_MEMORY_SCOPE_AGENT
#define LDS_WAIT() asm volatile("s_waitcnt lgkmcnt(0)" ::: "memory")
#define VM_WAIT() asm volatile("s_waitcnt vmcnt(0)" ::: "memory")
#define SBAR() __builtin_amdgcn_sched_barrier(0)
__device__ __forceinline__ unsigned f2bf(float f) { unsigned u = __builtin_bit_cast(unsigned, f); return (u + 0x7fffu + ((u >> 16) & 1u)) >> 16; }
__device__ __forceinline__ unsigned pk2(float lo, float hi) { return f2bf(lo) | (f2bf(hi) << 16); }
__device__ __forceinline__ float bf2f(unsigned short h) { return __builtin_bit_cast(float, (unsigned)h << 16); }
__device__ __forceinline__ float bflo(unsigned w) { return __builtin_bit_cast(float, w << 16); }
__device__ __forceinline__ float bfhi(unsigned w) { return __builtin_bit_cast(float, w & 0xffff0000u); }
__device__ __forceinline__ unsigned cvtpk(float lo, float hi) { unsigned r; asm volatile("v_cvt_pk_bf16_f32 %0, %1, %2" : "=v"(r) : "v"(lo), "v"(hi)); return r; }
__device__ __forceinline__ float fast_sigmoid(float x) { return __builtin_amdgcn_rcpf(1.0f + __builtin_amdgcn_exp2f(-1.4426950408889634f * x)); }
__device__ __forceinline__ float gelu_tanh(float x) { const float z = 1.5957691216057308f * (x + 0.044715f * x * x * x); return x * fast_sigmoid(z); }
__device__ __forceinline__ f32x2 sigmoid_pk(f32x2 x) { const f32x2 z = x * (-1.4426950408889634f); f32x2 e; e.x = __builtin_amdgcn_exp2f(z.x); e.y = __builtin_amdgcn_exp2f(z.y);
    const f32x2 d = e + 1.0f; f32x2 r; r.x = __builtin_amdgcn_rcpf(d.x); r.y = __builtin_amdgcn_rcpf(d.y); return r; }
__device__ __forceinline__ f32x2 gelu_tanh_pk(f32x2 x) {
    const f32x2 u = x * x, w = u * (-0.044715f * 1.5957691216057308f * 1.4426950408889634f) + (-1.5957691216057308f * 1.4426950408889634f), z = x * w;
    f32x2 e; e.x = __builtin_amdgcn_exp2f(z.x); e.y = __builtin_amdgcn_exp2f(z.y);
    const f32x2 d = e + 1.0f; f32x2 r; r.x = __builtin_amdgcn_rcpf(d.x); r.y = __builtin_amdgcn_rcpf(d.y); return x * r; }
__device__ __forceinline__ float wave_sum(float v) {
#pragma unroll
    for (int o = 1; o < 64; o <<= 1) v += __shfl_xor(v, o);
    return v;
}
__device__ __forceinline__ float wave_max(float v) {
#pragma unroll
    for (int o = 1; o < 64; o <<= 1) v = fmaxf(v, __shfl_xor(v, o));
    return v;
}

#define XB_TMO      128
#define XB_XCNT(j)  (256  + 64 * (j))
#define XB_XSUB(j)  (1280 + 64 * (j))
#define XB_XGEN(j)  (2304 + 64 * (j))
#define XB_TOP      3328
#define XB_TOPGEN   3392
#define XCD_BAR_WORDS 3456
#define XB_SPIN_CAP (1u << 20)
__device__ __forceinline__ unsigned xb_ld(unsigned* p)              { return __hip_atomic_load(p, __ATOMIC_RELAXED, __HIP_MEMORY_SCOPE_AGENT); }
__device__ __forceinline__ unsigned xb_add(unsigned* p, unsigned v) { return __hip_atomic_fetch_add(p, v, __ATOMIC_RELAXED, __HIP_MEMORY_SCOPE_AGENT); }
__device__ __forceinline__ unsigned xb_xcc_id() { return (unsigned)__builtin_amdgcn_s_getreg((3 << 11) | 20) & 0xFu; }
#define XB_SPIN(cond, bar) do { unsigned _sp = 0; while (cond) { __builtin_amdgcn_s_sleep(1); \
    if ((++_sp & 255u) == 0u) { if (xb_ld(&(bar)[XB_TMO])) break; if (_sp > XB_SPIN_CAP) { atomicAdd(&(bar)[XB_TMO], 1u); break; } } } } while (0)
struct XcdBarrier { unsigned* bar; unsigned x; volatile LAS unsigned* st; };
__device__ __forceinline__ XcdBarrier xcd_barrier_post(unsigned* bar, volatile LAS unsigned* st) {
    XcdBarrier b; b.bar = bar; b.x = xb_xcc_id(); b.st = st;
    if (threadIdx.x == 0) (void)xb_add(&bar[XB_XCNT(b.x)], 1u);
    return b;
}
__device__ __forceinline__ void xcd_barrier_complete(unsigned* bar, unsigned x, unsigned& nloc, unsigned& nx) {
    const unsigned G = gridDim.x * gridDim.y * gridDim.z;
    unsigned sum, cnt, mine, sp = 0u;
    for (;;) {
        sum = 0u; cnt = 0u; mine = 0u;
#pragma unroll
        for (unsigned j = 0; j < 16; ++j) { const unsigned c = xb_ld(&bar[XB_XCNT(j)]); sum += c; cnt += (c > 0u) ? 1u : 0u; mine = (j == x) ? c : mine; }
        if (sum == G) break;
        __builtin_amdgcn_s_sleep(1);
        if ((++sp & 255u) == 0u) { if (xb_ld(&bar[XB_TMO])) break; if (sp > XB_SPIN_CAP) { atomicAdd(&bar[XB_TMO], 1u); break; } }
    }
    nloc = mine > 0u ? mine : 1u; nx = cnt > 0u ? cnt : 1u;
}
__device__ __forceinline__ void xcd_barrier(const XcdBarrier& b) {
    asm volatile("s_waitcnt vmcnt(0)" ::: "memory");
    __syncthreads();
    if (threadIdx.x == 0) {
        unsigned* bar = b.bar;
        __builtin_amdgcn_s_waitcnt(0);
        unsigned nloc = b.st[0], nx = b.st[1];
        if (nloc == 0u) { xcd_barrier_complete(bar, b.x, nloc, nx); b.st[0] = nloc; b.st[1] = nx; }
        const unsigned old = xb_add(&bar[XB_XSUB(b.x)], 1u);
        const unsigned gen = old / nloc;
        if (old + 1u == (gen + 1u) * nloc) {
            __builtin_amdgcn_fence(__ATOMIC_RELEASE, "agent");
            asm volatile("s_waitcnt vmcnt(0)" ::: "memory");
            const unsigned og = xb_add(&bar[XB_TOP], 1u);
            const unsigned tg = og / nx;
            if (og + 1u == (tg + 1u) * nx) xb_add(&bar[XB_TOPGEN], 1u);
            else XB_SPIN(xb_ld(&bar[XB_TOPGEN]) == tg, bar);
            __builtin_amdgcn_fence(__ATOMIC_ACQUIRE, "agent");
            xb_add(&bar[XB_XGEN(b.x)], 1u);
            asm volatile("s_waitcnt vmcnt(0)" ::: "memory");
        } else {
            XB_SPIN(xb_ld(&bar[XB_XGEN(b.x)]) == gen, bar);
            __builtin_amdgcn_fence(__ATOMIC_ACQUIRE, "agent");
            asm volatile("s_waitcnt vmcnt(0)" ::: "memory");
        }
    }
    __syncthreads();
}

struct Args { const void* in[26]; float* out; unsigned char* ws; int ph_lo, ph_hi; };
struct Frame {
    LAS unsigned char* lds; char* ldsg;
    volatile LAS unsigned* MISC;
    int tid, lane, wave, vcu, G;
    unsigned char* ws; float* out;
};
#define IN_F(k) ((const float*)args.in[k])
#define IN_I(k) ((const int*)args.in[k])
#define WSP(T, off) ((T*)(F.ws + (off)))

namespace pg8 {
struct TileOrder {
    int nM, nN, nwg, G, c; const LAS int* blk_exp; const void* abase;
    __device__ __forceinline__ void init(int nM_, int nN_, int G_, int c_, const LAS int* be, const void* ab = nullptr) { nM = nM_; nN = nN_; nwg = nM * nN; G = G_; c = c_; blk_exp = be; abase = ab; }
    __device__ __forceinline__ const void* a_base(const Unit&) const { return abase; }
    __device__ __forceinline__ bool next(int i, Unit& u) const {
        const long L = (long)i * G + c; if (L >= nwg) return false;
        int wgid = (int)L; { const int q = nwg / NXCD, r = nwg % NXCD, xcd = wgid % NXCD, off = wgid / NXCD; wgid = (xcd < r ? xcd * (q + 1) : r * (q + 1) + (xcd - r) * q) + off; }
        const int nig = WGM * nN, gid = wgid / nig, fm = gid * WGM, gsz = (nM - fm) < WGM ? (nM - fm) : WGM;
        u.pm = fm + ((wgid % nig) % gsz); u.pn = (wgid % nig) / gsz; u.kind = 0;
        if (blk_exp) { const int e = __builtin_amdgcn_readfirstlane(blk_exp[u.pm]); u.pn += e * nN; }
        return true;
    }
    __device__ __forceinline__ void a_ready(const Unit&) const {}
    __device__ __forceinline__ void done(const Unit&) const {}
};

__device__ __forceinline__ void st16_wt(void* p, u32x4 v) { asm volatile("global_store_dwordx4 %0, %1, off sc1\n\ts_nop 1" :: "v"(p), "v"(v) : "memory"); }
struct EpiWin {
    static constexpr bool PERM = true, AFTER_DRAIN = false, MIDK = false; static constexpr int NSTORES = 16;
    bf16_t* E; const float* b_gate; int mode;
    __device__ __forceinline__ void operator()(const f32x4 (&acc)[2][2][4][2], const Unit& u, int wr, int wc, int fr, int fq) const {
        int row0 = u.pm * BM + wr * 64 + fr;
        asm volatile("" : "+v"(row0));
        if (mode == 1 && u.pn >= 8) {
            const int d0 = (u.pn - 8) * 128 + wc * 32 + 8 * fq;
            bf16_t* Rb = E + (size_t)5 * ((size_t)16384 * 1024); bf16_t* Sb = E + (size_t)6 * ((size_t)16384 * 1024);
            f32x4 b0[2], b1[2];
#pragma unroll
            for (int n = 0; n < 2; ++n) { b0[n] = *(const f32x4*)(b_gate + d0 + 4 * n); b1[n] = *(const f32x4*)(b_gate + 1024 + d0 + 4 * n); }
#pragma unroll
            for (int ai = 0; ai < 2; ++ai)
#pragma unroll
                for (int m = 0; m < 4; ++m) { const size_t ro = (size_t)(row0 + ai * HALF + m * 16) * 1024 + d0;
                    float r[8], s1[8];
#pragma unroll
                    for (int n = 0; n < 2; ++n)
#pragma unroll
                        for (int j = 0; j < 4; j += 2) { const f32x2 x0 = (f32x2){acc[ai][0][m][n][j], acc[ai][0][m][n][j + 1]} + (f32x2){b0[n][j], b0[n][j + 1]}, x1 = (f32x2){acc[ai][1][m][n][j], acc[ai][1][m][n][j + 1]} + (f32x2){b1[n][j], b1[n][j + 1]};
                            const f32x2 z0 = x0 * (-1.4426950408889634f), z1 = x1 * (-1.4426950408889634f);
                            f32x2 e0, e1; e0.x = __builtin_amdgcn_exp2f(z0.x); e0.y = __builtin_amdgcn_exp2f(z0.y); e1.x = fminf(__builtin_amdgcn_exp2f(z1.x), 1e18f); e1.y = fminf(__builtin_amdgcn_exp2f(z1.y), 1e18f);
                            const f32x2 dn0 = e0 + 1.0f, dn1 = e1 + 1.0f; f32x2 q0, q1; q0.x = __builtin_amdgcn_rcpf(dn0.x); q0.y = __builtin_amdgcn_rcpf(dn0.y); q1.x = __builtin_amdgcn_rcpf(dn1.x); q1.y = __builtin_amdgcn_rcpf(dn1.y);
                            const f32x2 rr = dn1 * q0; r[4 * n + j] = rr.x; r[4 * n + j + 1] = rr.y; s1[4 * n + j] = q1.x; s1[4 * n + j + 1] = q1.y; }
                    u32x4 w; w.x = cvt_pk_bf16(r[0], r[1]); w.y = cvt_pk_bf16(r[2], r[3]); w.z = cvt_pk_bf16(r[4], r[5]); w.w = cvt_pk_bf16(r[6], r[7]); *(u32x4*)(Rb + ro) = w;
                    u32x4 v; v.x = cvt_pk_bf16(s1[0], s1[1]); v.y = cvt_pk_bf16(s1[2], s1[3]); v.z = cvt_pk_bf16(s1[4], s1[5]); v.w = cvt_pk_bf16(s1[6], s1[7]); *(u32x4*)(Sb + ro) = v; }
            return;
        }
        const int opn = mode == 0 ? (u.pn < 8 ? u.pn : u.pn + 8) : u.pn + 8;
        const int t = opn >> 2, colt = (opn & 3) * BM;
        bf16_t* base = E + (size_t)t * ((size_t)16384 * 1024);
        const int col0 = colt + wc * 32 + 8 * fq;
#pragma unroll
        for (int ai = 0; ai < 2; ++ai)
#pragma unroll
            for (int m = 0; m < 4; ++m) { bf16_t* rowp = base + (size_t)(row0 + ai * HALF + m * 16) * 1024 + col0;
#pragma unroll
                for (int bj = 0; bj < 2; ++bj) { f32x4 v0 = acc[ai][bj][m][0], v1 = acc[ai][bj][m][1];
                    if (t == 1) { const f32x2 a = gelu_tanh_pk((f32x2){v0[0], v0[1]}), b = gelu_tanh_pk((f32x2){v0[2], v0[3]}), c = gelu_tanh_pk((f32x2){v1[0], v1[1]}), d = gelu_tanh_pk((f32x2){v1[2], v1[3]});
                        v0 = (f32x4){a.x, a.y, b.x, b.y}; v1 = (f32x4){c.x, c.y, d.x, d.y}; }
                    u32x4 w; w.x = cvt_pk_bf16(v0[0], v0[1]); w.y = cvt_pk_bf16(v0[2], v0[3]); w.z = cvt_pk_bf16(v1[0], v1[1]); w.w = cvt_pk_bf16(v1[2], v1[3]);
                    *(u32x4*)(rowp + bj * HALF) = w; } }
    }
};
struct EpiBranch {
    static constexpr bool PERM = true, AFTER_DRAIN = false, MIDK = true; static constexpr int NSTORES = 16;
    const bf16_t* R; const bf16_t* S1; bf16_t* MIX;
    __device__ __forceinline__ void mid(f32x4 (&acc)[2][2][4][2], const Unit& u, int wr, int wc, int fr, int fq) const {
        int row0 = u.pm * BM + wr * 64 + fr; const int col0 = u.pn * BM + wc * 32 + 8 * fq;
        asm volatile("" : "+v"(row0));
#pragma unroll
        for (int ai = 0; ai < 2; ++ai) { u32x4 a[4][2];
#pragma unroll
            for (int m = 0; m < 4; ++m)
#pragma unroll
                for (int bj = 0; bj < 2; ++bj) a[m][bj] = *(const u32x4*)(R + (size_t)(row0 + ai * HALF + m * 16) * 1024 + col0 + bj * HALF);
#pragma unroll
            for (int m = 0; m < 4; ++m)
#pragma unroll
                for (int bj = 0; bj < 2; ++bj) { acc[ai][bj][m][0] *= (f32x4){bflo(a[m][bj].x), bfhi(a[m][bj].x), bflo(a[m][bj].y), bfhi(a[m][bj].y)}; acc[ai][bj][m][1] *= (f32x4){bflo(a[m][bj].z), bfhi(a[m][bj].z), bflo(a[m][bj].w), bfhi(a[m][bj].w)}; }
            asm volatile("" ::: "memory"); }
    }
    __device__ __forceinline__ void operator()(const f32x4 (&acc)[2][2][4][2], const Unit& u, int wr, int wc, int fr, int fq) const {
        int row0 = u.pm * BM + wr * 64 + fr; const int col0 = u.pn * BM + wc * 32 + 8 * fq;
        asm volatile("" : "+v"(row0));
#pragma unroll
        for (int ai = 0; ai < 2; ++ai) { u32x4 b[4][2];
#pragma unroll
            for (int m = 0; m < 4; ++m)
#pragma unroll
                for (int bj = 0; bj < 2; ++bj) b[m][bj] = *(const u32x4*)(S1 + (size_t)(row0 + ai * HALF + m * 16) * 1024 + col0 + bj * HALF);
#pragma unroll
            for (int m = 0; m < 4; ++m)
#pragma unroll
                for (int bj = 0; bj < 2; ++bj) { const size_t o = (size_t)(row0 + ai * HALF + m * 16) * 1024 + col0 + bj * HALF;
                    const f32x4 v0 = acc[ai][bj][m][0] * (f32x4){bflo(b[m][bj].x), bfhi(b[m][bj].x), bflo(b[m][bj].y), bfhi(b[m][bj].y)}, v1 = acc[ai][bj][m][1] * (f32x4){bflo(b[m][bj].z), bfhi(b[m][bj].z), bflo(b[m][bj].w), bfhi(b[m][bj].w)};
                    u32x4 w; w.x = cvt_pk_bf16(v0[0], v0[1]); w.y = cvt_pk_bf16(v0[2], v0[3]); w.z = cvt_pk_bf16(v1[0], v1[1]); w.w = cvt_pk_bf16(v1[2], v1[3]);
                    *(u32x4*)(MIX + o) = w; }
            asm volatile("" ::: "memory"); }
    }
};
struct EpiWout {
    static constexpr bool PERM = true, AFTER_DRAIN = false, MIDK = false; static constexpr int NSTORES = 16;
    bf16_t* D1; const float* mod;
    __device__ __forceinline__ void operator()(const f32x4 (&acc)[2][2][4][2], const Unit& u, int wr, int wc, int fr, int fq) const {
        int row0 = u.pm * BM + wr * 64 + fr; const int col0 = u.pn * BM + wc * 32 + 8 * fq;
        asm volatile("" : "+v"(row0));
        const float* g1p = mod + (size_t)(u.pm >> 4) * 6144 + 2048;
        f32x4 gv[2][2];
#pragma unroll
        for (int bj = 0; bj < 2; ++bj)
#pragma unroll
            for (int n = 0; n < 2; ++n) gv[bj][n] = *(const f32x4*)(g1p + col0 + bj * HALF + 4 * n);
#pragma unroll
        for (int ai = 0; ai < 2; ++ai)
#pragma unroll
            for (int m = 0; m < 4; ++m) { bf16_t* rowp = D1 + (size_t)(row0 + ai * HALF + m * 16) * 1024 + col0;
#pragma unroll
                for (int bj = 0; bj < 2; ++bj) { const f32x4 v0 = acc[ai][bj][m][0] * gv[bj][0], v1 = acc[ai][bj][m][1] * gv[bj][1];
                    u32x4 w; w.x = cvt_pk_bf16(v0[0], v0[1]); w.y = cvt_pk_bf16(v0[2], v0[3]); w.z = cvt_pk_bf16(v1[0], v1[1]); w.w = cvt_pk_bf16(v1[2], v1[3]);
                    *(u32x4*)(rowp + bj * HALF) = w; } }
    }
};
__device__ __forceinline__ unsigned pk_fp8x4(float a, float b, float c, float d) { int p = __builtin_amdgcn_cvt_pk_fp8_f32(a, b, 0, false); p = __builtin_amdgcn_cvt_pk_fp8_f32(c, d, p, true); return (unsigned)p; }
struct EpiUp {
    static constexpr bool PERM = true, AFTER_DRAIN = false, MIDK = false; static constexpr int NSTORES = 8;
    unsigned char* ACT; const float* b_up;
    __device__ __forceinline__ void operator()(const f32x4 (&acc)[2][2][4][2], const Unit& u, int wr, int wc, int fr, int fq) const {
        const int e = u.pn >> 3, p = u.pn & 7;
        int row0 = u.pm * BM + wr * 64 + fr; const int c0 = p * 128 + wc * 32 + 8 * fq;
        asm volatile("" : "+v"(row0));
        const float* bg = b_up + (size_t)e * 2048 + c0; const float* bl = bg + 1024;
        f32x4 bgv[2], blv[2];
#pragma unroll
        for (int n = 0; n < 2; ++n) { bgv[n] = *(const f32x4*)(bg + 4 * n); blv[n] = *(const f32x4*)(bl + 4 * n) + 1.0f; }
#pragma unroll
        for (int ai = 0; ai < 2; ++ai)
#pragma unroll
            for (int m = 0; m < 4; ++m) { unsigned char* rowp = ACT + (size_t)(row0 + ai * HALF + m * 16) * 1024 + c0;
                f32x4 a[2];
#pragma unroll
                for (int n = 0; n < 2; ++n) {
#pragma unroll
                    for (int j = 0; j < 4; j += 2) { f32x2 g = (f32x2){acc[ai][0][m][n][j], acc[ai][0][m][n][j + 1]} + (f32x2){bgv[n][j], bgv[n][j + 1]};
                        f32x2 l = (f32x2){acc[ai][1][m][n][j], acc[ai][1][m][n][j + 1]} + (f32x2){blv[n][j], blv[n][j + 1]};
                        g.x = fminf(g.x, 7.0f); g.y = fminf(g.y, 7.0f); l.x = __builtin_amdgcn_fmed3f(l.x, -6.0f, 8.0f); l.y = __builtin_amdgcn_fmed3f(l.y, -6.0f, 8.0f);
                        const f32x2 z = g * (-1.702f * 1.4426950408889634f); f32x2 e; e.x = __builtin_amdgcn_exp2f(z.x); e.y = __builtin_amdgcn_exp2f(z.y);
                        const f32x2 d = e + 1.0f; f32x2 r; r.x = __builtin_amdgcn_rcpf(d.x); r.y = __builtin_amdgcn_rcpf(d.y);
                        const f32x2 o = (l * g) * r; a[n][j] = o.x; a[n][j + 1] = o.y; } }
                typedef unsigned u32x2_t __attribute__((ext_vector_type(2)));
                u32x2_t w; w.x = pk_fp8x4(a[0][0], a[0][1], a[0][2], a[0][3]); w.y = pk_fp8x4(a[1][0], a[1][1], a[1][2], a[1][3]);
                *(u32x2_t*)rowp = w; }
    }
};
struct EpiDown {
    static constexpr bool PERM = true, AFTER_DRAIN = false, MIDK = false; static constexpr int NSTORES = 16;
    unsigned char* YR; const float* b_down; const float* row_gate; const LAS int* tbl; LAS unsigned char* stage;
    __device__ __forceinline__ void operator()(const f32x4 (&acc)[2][2][4][2], const Unit& u, int wr, int wc, int fr, int fq) const {
        const int e = u.pn >> 2, p = u.pn & 3;
        int row0 = u.pm * BM + wr * 64 + fr; const int c0 = p * BM + wc * 32 + 8 * fq;
        asm volatile("" : "+v"(row0));
        const int pos0 = row0 - tbl[32 + e] * 256, cnt = tbl[e];
        const float* gp = row_gate + (size_t)e * 16384 + pos0;
        float gt[2][4];
#pragma unroll
        for (int ai = 0; ai < 2; ++ai)
#pragma unroll
            for (int m = 0; m < 4; ++m) { const int o = ai * HALF + m * 16; gt[ai][m] = (pos0 + o < cnt) ? gp[o] * 16.0f : 0.0f; }
        f32x4 bv[2][2];
#pragma unroll
        for (int bj = 0; bj < 2; ++bj)
#pragma unroll
            for (int n = 0; n < 2; ++n) bv[bj][n] = *(const f32x4*)(b_down + (size_t)e * 1024 + c0 + bj * HALF + 4 * n);
        typedef unsigned u32x2_t __attribute__((ext_vector_type(2)));
        const int lane = (int)(threadIdx.x & 63), wv = (int)(threadIdx.x >> 6);
        LAS unsigned char* stg = stage + wv * 1024;
        const int srow = lane >> 2, sch = lane & 3;
#pragma unroll
        for (int ai = 0; ai < 2; ++ai)
#pragma unroll
            for (int m = 0; m < 4; ++m) { const float g = gt[ai][m];
#pragma unroll
                for (int bj = 0; bj < 2; ++bj) { const f32x4 v0 = (acc[ai][bj][m][0] + bv[bj][0]) * g, v1 = (acc[ai][bj][m][1] + bv[bj][1]) * g;
                    u32x2_t w; w.x = pk_fp8x4(v0[0], v0[1], v0[2], v0[3]); w.y = pk_fp8x4(v1[0], v1[1], v1[2], v1[3]);
                    *(LAS u32x2_t*)(stg + fr * 64 + bj * 32 + 8 * fq) = w; }
                asm volatile("s_waitcnt lgkmcnt(0)" ::: "memory");
                const u32x4 o = *(const LAS u32x4*)(stg + srow * 64 + sch * 16);
                asm volatile("s_waitcnt lgkmcnt(0)" ::: "memory");
                const int r = u.pm * BM + wr * 64 + ai * HALF + m * 16 + srow;
                *(u32x4*)(YR + (size_t)r * 1024 + p * BM + wc * 32 + (sch >> 1) * HALF + (sch & 1) * 16) = o; }
    }
};
}

__device__ __forceinline__ void p0_transpose_item(const float* W, int N, bf16* WT, int Kd, size_t dst_row0, LAS float* scr, int k0, int n0, int lane) {
#pragma unroll 8
    for (int i = 0; i < 32; ++i) { const int kk = 2 * i + (lane >> 5); scr[kk * 33 + (lane & 31)] = W[(size_t)(k0 + kk) * N + n0 + (lane & 31)]; }
    LDS_WAIT(); asm volatile("" ::: "memory");
    const int c = lane & 7;
#pragma unroll
    for (int j = 0; j < 4; ++j) { const int n = (lane >> 3) + 8 * j; const LAS float* s = scr + (8 * c) * 33 + n;
        v4u o; o.x = pk2(s[0 * 33], s[1 * 33]); o.y = pk2(s[2 * 33], s[3 * 33]); o.z = pk2(s[4 * 33], s[5 * 33]); o.w = pk2(s[6 * 33], s[7 * 33]);
        *(GAS v4u*)(WT + (dst_row0 + n) * (size_t)Kd + k0 + 8 * c) = o; }
    LDS_WAIT(); asm volatile("" ::: "memory");
}
__device__ __forceinline__ void p8_transpose_item_fp8(const float* W, int N, unsigned char* WT, int Kd, size_t dst_row0, LAS float* scr, int k0, int n0, int lane) {
#pragma unroll 8
    for (int i = 0; i < 32; ++i) { const int kk = 2 * i + (lane >> 5); scr[kk * 33 + (lane & 31)] = W[(size_t)(k0 + kk) * N + n0 + (lane & 31)] * 64.0f; }
    LDS_WAIT(); asm volatile("" ::: "memory");
    const int c = lane & 7;
#pragma unroll
    for (int j = 0; j < 4; ++j) { const int n = (lane >> 3) + 8 * j; const LAS float* s = scr + (8 * c) * 33 + n;
        v2u o; o.x = pg8::pk_fp8x4(s[0 * 33], s[1 * 33], s[2 * 33], s[3 * 33]); o.y = pg8::pk_fp8x4(s[4 * 33], s[5 * 33], s[6 * 33], s[7 * 33]);
        *(GAS v2u*)(WT + (dst_row0 + n) * (size_t)Kd + k0 + 8 * c) = o; }
    LDS_WAIT(); asm volatile("" ::: "memory");
}
__device__ __forceinline__ void p0_prologue(Frame& F, const Args& args) {
    const float* c_in = IN_F(1); const int* pos = IN_I(2); const float* ada_w = IN_F(3); const float* ada_b = IN_F(4);
    for (int task = F.vcu; task < 192; task += F.G) {
        LAS float* sc = (LAS float*)F.lds;
        LAS float* red = (LAS float*)(F.lds + 16384);
        for (int i = F.tid; i < 4096; i += 512) { const float v = c_in[i]; sc[i] = v / (1.0f + expf(-v)); }
        __syncthreads();
        const int colq = F.lane & 7, kq = F.lane >> 3, col = task * 32 + colq * 4;
        float acc[4][4];
#pragma unroll
        for (int b = 0; b < 4; ++b)
#pragma unroll
            for (int j = 0; j < 4; ++j) acc[b][j] = 0.f;
#pragma unroll 8
        for (int s = 0; s < 16; ++s) { const int k = F.wave * 128 + s * 8 + kq; const f32x4 wv = *(const f32x4*)(ada_w + (size_t)k * 6144 + col);
#pragma unroll
            for (int b = 0; b < 4; ++b) { const float sv = sc[b * 1024 + k];
#pragma unroll
                for (int j = 0; j < 4; ++j) acc[b][j] += sv * wv[j]; } }
#pragma unroll
        for (int b = 0; b < 4; ++b)
#pragma unroll
            for (int j = 0; j < 4; ++j) { float v = acc[b][j]; v += __shfl_xor(v, 8); v += __shfl_xor(v, 16); v += __shfl_xor(v, 32); if (kq == 0) red[(F.wave * 4 + b) * 32 + colq * 4 + j] = v; }
        __syncthreads();
        if (F.tid < 128) { const int b = F.tid >> 5, cc = F.tid & 31; float s = ada_b[task * 32 + cc];
#pragma unroll
            for (int w = 0; w < 8; ++w) s += red[(w * 4 + b) * 32 + cc];
            WSP(float, WS_MOD)[b * 6144 + task * 32 + cc] = s; }
        VM_WAIT(); __syncthreads();
        if (F.tid == 0) { __builtin_amdgcn_fence(__ATOMIC_RELEASE, "agent"); VM_WAIT(); __hip_atomic_fetch_add((unsigned*)(F.ws + WS_CTL) + CW_MODCNT, 1u, RLX_AGENT); }
    }
    const int gt = F.vcu * 512 + F.tid, NGT = F.G * 512;
    for (int idx = gt; idx < NTOK * 16; idx += NGT) { const int m = idx >> 4, i = idx & 15;
        double freq = 1.0; for (int q = 0; q < i; ++q) freq *= 0.44036660267178046;
        const double ang = (double)pos[m] * freq; const double nr = __builtin_rint(ang * 0.15915494309189535);
        const float r = (float)__builtin_fma(-nr, 6.283185307179586, ang);
        float sn, cs; sincosf(r, &sn, &cs);
        WSP(float, WS_TRIG)[m * 32 + i] = cs; WSP(float, WS_TRIG)[m * 32 + 16 + i] = sn; }
    { const float* wr = IN_F(20); for (int idx = gt; idx < 32 * 1024; idx += NGT) { const int e = idx >> 10, k = idx & 1023; const float w = wr[k * 32 + e];
        const unsigned hi = f2bf(w); const float rem = w - __builtin_bit_cast(float, hi << 16); WSP(bf16, WS_WRH)[idx] = (bf16)hi; WSP(bf16, WS_WRL)[idx] = (bf16)f2bf(rem); } }
    LAS float* scr = (LAS float*)(F.lds + 32768 + F.wave * 8704);
    const int gw = F.vcu * NWAVES + F.wave, NGW = F.G * NWAVES;
    constexpr int I_IN = 16 * 224, I_RG = 128, I_B = 1024, I_O = 512;
    constexpr int NITEMS = I_IN + I_RG + I_B + I_O;
    for (int it = gw; it < NITEMS; it += NGW) {
        int r = it;
        if (r < I_IN) { const int kb = r / 224, nb = r % 224, n0 = nb * 32;
            if (n0 < 2048 || (n0 >= 4096 && n0 < 5120)) p0_transpose_item(IN_F(7), DIN, WSP(bf16, WS_WIN), 1024, (size_t)(n0 < 2048 ? n0 : n0 - 2048), scr, kb * 64, n0, F.lane);
            else { const int gl = n0 - 5120;
                const size_t row = n0 < 4096 ? (size_t)(n0 - 2048) : (size_t)(2048 + ((gl & 1023) >> 7) * 256 + (gl >> 10) * 128 + (gl & 127));
                p8_transpose_item_fp8(IN_F(7), DIN, WSP(unsigned char, WS_WIN8), 1024, row, scr, kb * 64, n0, F.lane); }
            continue; } r -= I_IN;
        if (r < I_RG) { const int mat = r >> 6, blk = (r >> 3) & 7, kb = (r >> 2) & 1, nb = r & 3;
            p0_transpose_item(IN_F(mat ? 12 : 10) + (size_t)blk * 16384, 128, WSP(bf16, WS_WRG) + (size_t)(mat * 8 + blk) * 16384, 128, (size_t)nb * 32, scr, kb * 64, nb * 32, F.lane); continue; } r -= I_RG;
        if (r < I_B) { const int g = r >> 9, q = r & 511, kb = q >> 5, nb = q & 31;
            p0_transpose_item(IN_F(18) + (size_t)g * 1048576, 1024, WSP(bf16, WS_WB) + (size_t)g * 1024, 2048, (size_t)nb * 32, scr, kb * 64, nb * 32, F.lane); continue; } r -= I_B;
        { const int kb = r >> 5, nb = r & 31; p0_transpose_item(IN_F(19), 1024, WSP(bf16, WS_WO), 1024, (size_t)nb * 32, scr, kb * 64, nb * 32, F.lane); }
    }
}
struct WItem { const float* src; unsigned char* dst; int N; };
__device__ __forceinline__ WItem p8_item(const Args& args, unsigned char* ws, int it) {
    WItem w;
    if (it < 32 * 1024) { const int e = it >> 10, q = it & 1023, kb = q >> 6, nb = q & 63, n0 = nb * 32;
        const int bj = n0 >> 10, p = (n0 & 1023) >> 7, oo = n0 & 127;
        w.src = IN_F(22) + (size_t)e * 2097152 + (size_t)(kb * 64) * 2048 + n0; w.N = 2048;
        w.dst = ws + WS_WUP + (size_t)e * 2097152 + (size_t)(p * 256 + bj * 128 + oo) * 1024 + kb * 64; }
    else { const int r = it - 32 * 1024, e = r >> 9, q = r & 511, kb = q >> 5, nb = q & 31;
        w.src = IN_F(24) + (size_t)e * 1048576 + (size_t)(kb * 64) * 1024 + nb * 32; w.N = 1024;
        w.dst = ws + WS_WDN + (size_t)e * 1048576 + (size_t)(nb * 32) * 1024 + kb * 64; }
    return w;
}
__device__ __forceinline__ void p8_load(const WItem& w, f32x4 (&v)[8], int lane) {
#pragma unroll
    for (int i = 0; i < 8; ++i) v[i] = __builtin_nontemporal_load((const f32x4*)(w.src + (size_t)((lane >> 3) + 8 * i) * w.N + (lane & 7) * 4));
}
__device__ __forceinline__ void p8_store(const WItem& w, const f32x4 (&v)[8], LAS float* scr, int lane) {
#pragma unroll
    for (int i = 0; i < 8; ++i) { LAS float* d = scr + ((lane >> 3) + 8 * i) * 33 + (lane & 7) * 4; d[0] = v[i].x * 64.0f; d[1] = v[i].y * 64.0f; d[2] = v[i].z * 64.0f; d[3] = v[i].w * 64.0f; }
    LDS_WAIT(); asm volatile("" ::: "memory");
    const int c = lane & 7;
#pragma unroll
    for (int j = 0; j < 4; ++j) { const int n = (lane >> 3) + 8 * j; const LAS float* s = scr + (8 * c) * 33 + n;
        v2u o; o.x = pg8::pk_fp8x4(s[0 * 33], s[1 * 33], s[2 * 33], s[3 * 33]); o.y = pg8::pk_fp8x4(s[4 * 33], s[5 * 33], s[6 * 33], s[7 * 33]);
        __builtin_nontemporal_store(o, (v2u*)(w.dst + (size_t)n * 1024 + 8 * c)); }
    LDS_WAIT(); asm volatile("" ::: "memory");
}
constexpr int P8_ITEMS = 32 * 1024 + 32 * 512, P8_CHUNK = 128, P8_NCHUNK = P8_ITEMS / P8_CHUNK;
__device__ __forceinline__ void p8_chunk(Frame& F, const Args& args, int ch) {
    LAS float* scr = (LAS float*)(F.lds + 32768 + F.wave * 8704);
    const int it0 = ch * P8_CHUNK + F.wave * 16;
    f32x4 v0[8], v1[8], v2[8], v3[8];
    p8_load(p8_item(args, F.ws, it0), v0, F.lane); p8_load(p8_item(args, F.ws, it0 + 1), v1, F.lane); p8_load(p8_item(args, F.ws, it0 + 2), v2, F.lane); p8_load(p8_item(args, F.ws, it0 + 3), v3, F.lane);
#pragma unroll 1
    for (int j = 0; j < 16; j += 4) { const bool more = j + 4 < 16;
        p8_store(p8_item(args, F.ws, it0 + j), v0, scr, F.lane); if (more) p8_load(p8_item(args, F.ws, it0 + j + 4), v0, F.lane);
        p8_store(p8_item(args, F.ws, it0 + j + 1), v1, scr, F.lane); if (more) p8_load(p8_item(args, F.ws, it0 + j + 5), v1, F.lane);
        p8_store(p8_item(args, F.ws, it0 + j + 2), v2, scr, F.lane); if (more) p8_load(p8_item(args, F.ws, it0 + j + 6), v2, F.lane);
        p8_store(p8_item(args, F.ws, it0 + j + 3), v3, scr, F.lane); if (more) p8_load(p8_item(args, F.ws, it0 + j + 7), v3, F.lane);
    }
}
__device__ __forceinline__ void p8_moe_weights(Frame& F, const Args& args) {
    for (int ch = F.vcu; ch < P8_NCHUNK; ch += F.G) p8_chunk(F, args, ch);
}

__device__ __forceinline__ void p1_hrows(Frame& F, const Args& args) {
    if (F.tid == 0) { unsigned* mc = (unsigned*)(F.ws + WS_CTL) + CW_MODCNT; unsigned sp = 0; while (__hip_atomic_load(mc, RLX_AGENT) < 192u && ++sp < (1u << 22)) __builtin_amdgcn_s_sleep(2);
        __builtin_amdgcn_fence(__ATOMIC_ACQUIRE, "agent"); VM_WAIT(); }
    __syncthreads();
    const float* x = IN_F(0); const float* g1n = IN_F(5); const float* mod = WSP(float, WS_MOD); bf16* H = WSP(bf16, WS_HB); unsigned char* H8 = WSP(unsigned char, WS_H8);
    const int gw = F.vcu * NWAVES + F.wave, NGW = F.G * NWAVES;
    f32x4 v0[4], v1[4], n0[4], n1[4];
#define P1_LOADX(ma, mb, A, B) do { const f32x4* xa_ = (const f32x4*)(x + (size_t)(ma) * DM) + F.lane; const f32x4* xb_ = (const f32x4*)(x + (size_t)(mb) * DM) + F.lane; \
        _Pragma("unroll") for (int j_ = 0; j_ < 4; ++j_) { A[j_] = xa_[64 * j_]; B[j_] = xb_[64 * j_]; } } while (0)
    int m0 = gw;
    if (m0 < NTOK) { const int m1 = (m0 + NGW < NTOK) ? m0 + NGW : m0; P1_LOADX(m0, m1, v0, v1); }
    for (; m0 < NTOK; m0 += 2 * NGW) {
        const bool has1 = m0 + NGW < NTOK; const int m1 = has1 ? m0 + NGW : m0;
        const int b0 = m0 >> 12, b1 = m1 >> 12;
        f32x4 g[4], sh0[4], sc0[4], sh1[4], sc1[4];
#pragma unroll
        for (int j = 0; j < 4; ++j) { const int col = 4 * F.lane + 256 * j; g[j] = *(const f32x4*)(g1n + col);
            sh0[j] = *(const f32x4*)(mod + b0 * 6144 + col); sc0[j] = *(const f32x4*)(mod + b0 * 6144 + 1024 + col); sh1[j] = *(const f32x4*)(mod + b1 * 6144 + col); sc1[j] = *(const f32x4*)(mod + b1 * 6144 + 1024 + col); }
        const int p0 = m0 + 2 * NGW; const bool hasn = p0 < NTOK;
        if (hasn) { const int p1 = (p0 + NGW < NTOK) ? p0 + NGW : p0; P1_LOADX(p0, p1, n0, n1); }
        float s0 = 0.f, s1 = 0.f;
#pragma unroll
        for (int j = 0; j < 4; ++j) { s0 += (v0[j].x * v0[j].x + v0[j].y * v0[j].y) + (v0[j].z * v0[j].z + v0[j].w * v0[j].w); s1 += (v1[j].x * v1[j].x + v1[j].y * v1[j].y) + (v1[j].z * v1[j].z + v1[j].w * v1[j].w); }
#pragma unroll
        for (int o = 1; o < 64; o <<= 1) { s0 += __shfl_xor(s0, o); s1 += __shfl_xor(s1, o); }
        const float r0 = 1.0f / sqrtf(s0 * (1.f / DM) + EPS), r1 = 1.0f / sqrtf(s1 * (1.f / DM) + EPS);
        unsigned long long* o0 = (unsigned long long*)(H + (size_t)m0 * DM) + F.lane; unsigned long long* o1 = (unsigned long long*)(H + (size_t)m1 * DM) + F.lane;
#pragma unroll
        for (int j = 0; j < 4; ++j) {
            const f32x4 h0 = v0[j] * r0 * g[j] * (sc0[j] + 1.0f) + sh0[j], h1 = v1[j] * r1 * g[j] * (sc1[j] + 1.0f) + sh1[j];
            o0[64 * j] = (unsigned long long)cvtpk(h0.x, h0.y) | ((unsigned long long)cvtpk(h0.z, h0.w) << 32);
            ((unsigned*)(H8 + (size_t)m0 * DM))[F.lane + 64 * j] = pg8::pk_fp8x4(h0.x, h0.y, h0.z, h0.w);
            if (has1) { o1[64 * j] = (unsigned long long)cvtpk(h1.x, h1.y) | ((unsigned long long)cvtpk(h1.z, h1.w) << 32);
                ((unsigned*)(H8 + (size_t)m1 * DM))[F.lane + 64 * j] = pg8::pk_fp8x4(h1.x, h1.y, h1.z, h1.w); } }
#pragma unroll
        for (int j = 0; j < 4; ++j) { v0[j] = n0[j]; v1[j] = n1[j]; }
    }
#undef P1_LOADX
}

__device__ __forceinline__ void p3_knorm_unit(Frame& F, const Args& args, int unit) {
    const int h = unit & 7, j = (unit >> 3) & 15, b = unit >> 7;
    bf16* KR = WSP(bf16, WS_E) + 3 * E_STRIDE; const float* trig = WSP(float, WS_TRIG); const float* kg = IN_F(16);
    const int rsub = F.lane >> 4, c16 = F.lane & 15;
    float gk[8];
#pragma unroll
    for (int i = 0; i < 8; ++i) gk[i] = kg[c16 * 8 + i];
    float km[8];
#pragma unroll
    for (int i = 0; i < 8; ++i) km[i] = 0.f;
    const int fi = (c16 & 1) * 8;
    v4u raw[4]; f32x4 tcs[4][4]; v4u outp[4];
#define KN_LOAD(bt_) do { _Pragma("unroll") for (int i4 = 0; i4 < 4; ++i4) { const int m_ = b * SEQ + j * 256 + F.wave * 32 + ((bt_) * 4 + i4) * 4 + rsub; \
        raw[i4] = *(const v4u*)(KR + (size_t)m_ * DM + h * HD + c16 * 8); const float* tp_ = trig + (size_t)m_ * 32 + fi; \
        tcs[i4][0] = *(const f32x4*)tp_; tcs[i4][1] = *(const f32x4*)(tp_ + 4); tcs[i4][2] = *(const f32x4*)(tp_ + 16); tcs[i4][3] = *(const f32x4*)(tp_ + 20); } } while (0)
    KN_LOAD(0);
#pragma unroll
    for (int bt = 0; bt < 2; ++bt) {
#pragma unroll
        for (int i4 = 0; i4 < 4; ++i4) {
            float v[8] = {bflo(raw[i4].x), bfhi(raw[i4].x), bflo(raw[i4].y), bfhi(raw[i4].y), bflo(raw[i4].z), bfhi(raw[i4].z), bflo(raw[i4].w), bfhi(raw[i4].w)};
            float ss = 0.f;
#pragma unroll
            for (int i = 0; i < 8; ++i) ss += v[i] * v[i];
            ss += __shfl_xor(ss, 1); ss += __shfl_xor(ss, 2); ss += __shfl_xor(ss, 4); ss += __shfl_xor(ss, 8);
            const float rstd = 1.0f / sqrtf(ss * (1.f / HD) + EPS);
#pragma unroll
            for (int i = 0; i < 8; ++i) v[i] = v[i] * rstd * gk[i];
#pragma unroll
            for (int i = 0; i < 8; ++i) { const float other = __shfl_xor(v[i], 2); const float cs = tcs[i4][i >> 2][i & 3], sn = tcs[i4][2 + (i >> 2)][i & 3];
                if (c16 < 4) v[i] = (c16 < 2) ? (v[i] * cs - other * sn) : (v[i] * cs + other * sn); }
#pragma unroll
            for (int i = 0; i < 8; ++i) km[i] += v[i];
            outp[i4].x = cvtpk(v[0], v[1]); outp[i4].y = cvtpk(v[2], v[3]); outp[i4].z = cvtpk(v[4], v[5]); outp[i4].w = cvtpk(v[6], v[7]); }
        if (bt == 0) KN_LOAD(1);
#pragma unroll
        for (int i4 = 0; i4 < 4; ++i4) { const int m = b * SEQ + j * 256 + F.wave * 32 + (bt * 4 + i4) * 4 + rsub; *(v4u*)(KR + (size_t)m * DM + h * HD + c16 * 8) = outp[i4]; }
    }
#undef KN_LOAD
    LAS float* red = (LAS float*)(F.lds + XTRA_OFF);
#pragma unroll
    for (int i = 0; i < 8; ++i) { float v = km[i]; v += __shfl_xor(v, 16); v += __shfl_xor(v, 32); if (rsub == 0) red[F.wave * 128 + c16 * 8 + i] = v; }
    __syncthreads();
    if (F.tid < 128) { float s = 0.f;
#pragma unroll
        for (int w = 0; w < 8; ++w) s += red[w * 128 + F.tid];
        WSP(float, WS_KMEAN)[((size_t)(b * NH + h) * 16 + j) * HD + F.tid] = s * (1.f / 256.f); }
    __syncthreads();
}

__device__ __forceinline__ void p3_rnn_local_unit(Frame& F, const Args& args, int unit) {
    const int n = unit & 7, c = (unit >> 3) & 15, b = unit >> 7;
    const int t0 = c * 256, m0 = b * SEQ + t0, ch0 = n * 128;
    const bf16* XR = WSP(bf16, WS_E);
    LAS unsigned char* At = F.lds;
    {
        const int cg = F.tid & 15, rs = F.tid >> 4; const int chb = ch0 + cg * 8;
        const float* cw = IN_F(8); const float* cb = IN_F(9);
        float w0[8], w1[8], w2[8], w3[8], bb[8];
#pragma unroll
        for (int i = 0; i < 8; ++i) { w0[i] = cw[chb + i]; w1[i] = cw[1024 + chb + i]; w2[i] = cw[2048 + chb + i]; w3[i] = cw[3072 + chb + i]; bb[i] = cb[chb + i]; }
        const int tr0 = t0 + rs * 8;
        v4u rw[11];
#pragma unroll
        for (int r = 0; r < 11; ++r) { const int tt = tr0 - 3 + r; rw[r] = *(const v4u*)(XR + (size_t)(b * SEQ + (tt < 0 ? 0 : tt)) * DM + chb); if (tt < 0) rw[r] = (v4u){0u, 0u, 0u, 0u}; }
#define UNP(dst, w_) do { dst[0] = bflo(w_.x); dst[1] = bfhi(w_.x); dst[2] = bflo(w_.y); dst[3] = bfhi(w_.y); dst[4] = bflo(w_.z); dst[5] = bfhi(w_.z); dst[6] = bflo(w_.w); dst[7] = bfhi(w_.w); } while (0)
        float p1[8], p2[8], p3[8];
        UNP(p3, rw[0]); UNP(p2, rw[1]); UNP(p1, rw[2]);
#pragma unroll
        for (int r = 0; r < 8; ++r) { float cur[8]; UNP(cur, rw[3 + r]);
            float xc[8];
#pragma unroll
            for (int i = 0; i < 8; ++i) xc[i] = bb[i] + w0[i] * cur[i] + w1[i] * p1[i] + w2[i] * p2[i] + w3[i] * p3[i];
            const int row = rs * 8 + r;
            v4u o; o.x = cvtpk(xc[0], xc[1]); o.y = cvtpk(xc[2], xc[3]); o.z = cvtpk(xc[4], xc[5]); o.w = cvtpk(xc[6], xc[7]);
            *(LAS v4u*)(At + row * 256 + ((cg ^ (row & 15)) << 4)) = o;
#pragma unroll
            for (int i = 0; i < 8; ++i) { p3[i] = p2[i]; p2[i] = p1[i]; p1[i] = cur[i]; } }
#undef UNP
    }
    __syncthreads();
    const int fr = F.lane & 15, fq = F.lane >> 4;
    const int vloc = F.wave * 16 + fr, ch = ch0 + vloc;
    const bf16* WA = WSP(bf16, WS_WRG) + (size_t)n * 16384 + (size_t)vloc * 128 + fq * 8;
    const bf16* WX = WA + 8 * 16384;
    bf16x8 Ba[4], Bx[4];
#pragma unroll
    for (int s = 0; s < 4; ++s) { Ba[s] = *(const bf16x8*)(WA + 32 * s); Bx[s] = *(const bf16x8*)(WX + 32 * s); }
    const float ba = IN_F(11)[ch], bx = IN_F(13)[ch];
    const float sp8 = 8.0f * log1pf(expf(-IN_F(14)[ch]));
    float cP = 1.f, cH = 0.f;
    bf16* HL = WSP(bf16, WS_HL); bf16* PP = WSP(bf16, WS_PP);
    LAS unsigned short* stg = (LAS unsigned short*)(F.lds + 65536);
    for (int rq = 0; rq < 4; ++rq) {
        LAS unsigned short* sb = stg + (rq & 1) * 16384;
#pragma unroll
        for (int ri = 0; ri < 4; ++ri) { const int rt = rq * 4 + ri;
            f32x4 accr = {0.f, 0.f, 0.f, 0.f}, accx = {0.f, 0.f, 0.f, 0.f};
            const int arow = rt * 16 + fr;
#pragma unroll
            for (int s = 0; s < 4; ++s) { const bf16x8 a = *(const LAS bf16x8*)(At + arow * 256 + (((fq + 4 * s) ^ (arow & 15)) << 4));
                accr = __builtin_amdgcn_mfma_f32_16x16x32_bf16(a, Ba[s], accr, 0, 0, 0);
                accx = __builtin_amdgcn_mfma_f32_16x16x32_bf16(a, Bx[s], accx, 0, 0, 0); }
            float pj[4], hj[4];
#pragma unroll
            for (int j = 0; j < 4; ++j) { const int row = rt * 16 + 4 * fq + j;
                const float xcv = bf2f(*(const LAS unsigned short*)(At + row * 256 + ((((vloc >> 3)) ^ (row & 15)) << 4) + (vloc & 7) * 2));
                const float r = fast_sigmoid(accr[j] + ba), ig = fast_sigmoid(accx[j] + bx);
                const float a = __builtin_amdgcn_exp2f(-sp8 * r * 1.4426950408889634f);
                float mult = __builtin_amdgcn_sqrtf(fmaxf(fmaf(-a, a, 1.0f), 0.0f)); if (t0 + row == 0) mult = 1.0f;
                const float u = mult * ig * xcv;
                pj[j] = (j ? pj[j - 1] : 1.0f) * a; hj[j] = (j ? hj[j - 1] * a : 0.0f) + u; }
            const float tp = pj[3], th = hj[3];
            const float pa = __shfl(tp, F.lane - 16), ha = __shfl(th, F.lane - 16);
            const float pb = __shfl(tp, F.lane - 32), hb = __shfl(th, F.lane - 32);
            const float pc = __shfl(tp, F.lane - 48), hc = __shfl(th, F.lane - 48);
            float Pq, Hq;
            if (fq == 0) { Pq = 1.f; Hq = 0.f; } else if (fq == 1) { Pq = pa; Hq = ha; } else if (fq == 2) { Pq = pb * pa; Hq = pa * hb + ha; } else { Pq = pc * pb * pa; Hq = pa * (pb * hc + hb) + ha; }
            const float hstart = Hq + Pq * cH, pstart = Pq * cP;
            float hl3 = 0.f, pp3 = 0.f;
#pragma unroll
            for (int j = 0; j < 4; ++j) { const float hv = hj[j] + pj[j] * hstart, pv = pj[j] * pstart; const int rl = ri * 16 + 4 * fq + j;
                const unsigned pk = cvtpk(hv, pv); sb[rl * 128 + vloc] = (unsigned short)pk; sb[8192 + rl * 128 + vloc] = (unsigned short)(pk >> 16); if (j == 3) { hl3 = hv; pp3 = pv; } }
            cH = __shfl(hl3, fr + 48); cP = __shfl(pp3, fr + 48);
        }
        __syncthreads();
#pragma unroll
        for (int q4 = 0; q4 < 4; ++q4) { const int idx = q4 * 512 + F.tid, arr = idx >> 10, rr = (idx >> 4) & 63, c16 = idx & 15;
            const v4u val = *(const LAS v4u*)(sb + arr * 8192 + rr * 128 + c16 * 8);
            bf16* dst = (arr ? PP : HL) + (size_t)(m0 + rq * 64 + rr) * DM + ch0 + c16 * 8;
            *(v4u*)dst = val; }
    }
    if (fq == 0) { WSP(float, WS_AGGP)[(size_t)(b * 16 + c) * 1024 + ch] = cP; WSP(float, WS_AGGH)[(size_t)(b * 16 + c) * 1024 + ch] = cH; }
    __syncthreads();
}

__device__ __forceinline__ void p4_rnn_final_unit(Frame& F, const Args& args, int unit) {
    const int n = unit & 7, c = (unit >> 3) & 15, b = unit >> 7;
    const int m0 = b * SEQ + c * 256, ch0 = n * 128;
    LAS float* car = (LAS float*)(F.lds + XTRA_OFF);
    if (F.tid < 128) { const int ch = ch0 + F.tid; float h = 0.f;
        for (int cc = 0; cc < c; ++cc) { const float p = WSP(float, WS_AGGP)[(size_t)(b * 16 + cc) * 1024 + ch], hh = WSP(float, WS_AGGH)[(size_t)(b * 16 + cc) * 1024 + ch]; h = p * h + hh; }
        car[F.tid] = h; }
    __syncthreads();
    const bf16* HL = WSP(bf16, WS_HL); const bf16* PP = WSP(bf16, WS_PP); const bf16* GG = WSP(bf16, WS_E) + E_STRIDE; bf16* Y = WSP(bf16, WS_YCAT);
    const int c16 = F.tid & 15, r0 = F.tid >> 4;
    float cv[8];
#pragma unroll
    for (int i = 0; i < 8; ++i) cv[i] = car[c16 * 8 + i];
    v4u hl[8], pp[8], gg[8];
#pragma unroll
    for (int it = 0; it < 8; ++it) { const size_t o = (size_t)(m0 + it * 32 + r0) * DM + ch0 + c16 * 8; hl[it] = *(const v4u*)(HL + o); pp[it] = *(const v4u*)(PP + o); gg[it] = *(const v4u*)(GG + o); }
#pragma unroll
    for (int it = 0; it < 8; ++it) { const size_t oy = (size_t)(m0 + it * 32 + r0) * 2048 + ch0 + c16 * 8;
        v4u y;
        y.x = cvtpk((bflo(hl[it].x) + bflo(pp[it].x) * cv[0]) * bflo(gg[it].x), (bfhi(hl[it].x) + bfhi(pp[it].x) * cv[1]) * bfhi(gg[it].x));
        y.y = cvtpk((bflo(hl[it].y) + bflo(pp[it].y) * cv[2]) * bflo(gg[it].y), (bfhi(hl[it].y) + bfhi(pp[it].y) * cv[3]) * bfhi(gg[it].y));
        y.z = cvtpk((bflo(hl[it].z) + bflo(pp[it].z) * cv[4]) * bflo(gg[it].z), (bfhi(hl[it].z) + bfhi(pp[it].z) * cv[5]) * bfhi(gg[it].z));
        y.w = cvtpk((bflo(hl[it].w) + bflo(pp[it].w) * cv[6]) * bflo(gg[it].w), (bfhi(hl[it].w) + bfhi(pp[it].w) * cv[7]) * bfhi(gg[it].w));
        *(v4u*)(Y + oy) = y; }
    __syncthreads();
}

namespace att {
#ifndef XPRIO
#define XPRIO 0
#define YPRIO 1
#endif
constexpr int KVBLK = 64, SHM_K = KVBLK * HD * 2, SHM_V = SHM_K;
constexpr float C2 = 0.08838834764831845f * 1.4426950408889634f;
#define KSWZ(row, colB) ((row) * 256 + ((colB) ^ (((row) & 7) << 4)))
__device__ __forceinline__ int v_st(int k, int c) { const int kk = (k & ~0xC) | ((k & 4) << 1) | ((k & 8) >> 1); return ((kk >> 3) * 4 + (c >> 5)) * 512 + ((kk & 7) * 32 + (c & 31)) * 2; }
__device__ __forceinline__ int v_rd_base(int lane) { return ((lane & 3) << 3) | (((lane >> 2) & 3) << 6) | (((lane >> 4) & 1) << 5) | (((lane >> 5) & 1) << 8); }
constexpr int v_rd_off(int d0, int ks, int half) { return d0 * 512 + ks * 4096 + half * 2048; }
__device__ __forceinline__ int crow(int r, int hi) { return (r & 3) + 8 * (r >> 2) + 4 * hi; }

#define RD128(dst, addr, off) asm volatile("ds_read_b128 %0, %1 offset:%2" : "=&v"(dst) : "v"(addr), "i"(off) : "memory")
#define TRRD(dst, addr, off) asm volatile("ds_read_b64_tr_b16 %0, %1 offset:%2" : "=&v"(dst) : "v"(addr), "i"(off) : "memory")
#define XWAIT(n, U) asm volatile("s_waitcnt lgkmcnt(" #n ")" : "+v"(U[0]), "+v"(U[1]), "+v"(U[2]), "+v"(U[3]) :: "memory")
template <int KB, int VB, int MODE>
__device__ __forceinline__ void xphase(f32x16& p0, f32x16& p1, f32x16* o, const bf16x8* q, const int* ka, int vb0, bf16x8 pa0, bf16x8 pa1, bf16x8 pa2, bf16x8 pa3) {
    v4u ku[4][4]; s16x4 vu[8][4];
    __builtin_amdgcn_s_setprio(XPRIO);
#define RK(g) do { constexpr int o_ = 2 * SHM_V + KB * SHM_K + ((g) >> 1) * 128; \
        RD128(ku[g][0], ka[(2 * (g)) & 3], o_); RD128(ku[g][1], ka[(2 * (g)) & 3], o_ + 8192); RD128(ku[g][2], ka[(2 * (g) + 1) & 3], o_); RD128(ku[g][3], ka[(2 * (g) + 1) & 3], o_ + 8192); } while (0)
#define KF(g, j) (*reinterpret_cast<const bf16x8*>(&ku[g][j]))
#define MK(g) do { if constexpr ((g) == 0) { p0 = __builtin_amdgcn_mfma_f32_32x32x16_bf16(KF(g, 0), q[2 * (g)], f32x16{}, 0, 0, 0); p1 = __builtin_amdgcn_mfma_f32_32x32x16_bf16(KF(g, 1), q[2 * (g)], f32x16{}, 0, 0, 0); } \
        else { p0 = __builtin_amdgcn_mfma_f32_32x32x16_bf16(KF(g, 0), q[2 * (g)], p0, 0, 0, 0); p1 = __builtin_amdgcn_mfma_f32_32x32x16_bf16(KF(g, 1), q[2 * (g)], p1, 0, 0, 0); } \
        p0 = __builtin_amdgcn_mfma_f32_32x32x16_bf16(KF(g, 2), q[2 * (g) + 1], p0, 0, 0, 0); p1 = __builtin_amdgcn_mfma_f32_32x32x16_bf16(KF(g, 3), q[2 * (g) + 1], p1, 0, 0, 0); } while (0)
#define RV(u) do { constexpr int o_ = VB * SHM_V + ((u) & 1) * 1024 + ((u) >> 1) * 4096; \
        TRRD(vu[u][0], vb0, o_); TRRD(vu[u][1], vb0, o_ + 2048); TRRD(vu[u][2], vb0, o_ + 512); TRRD(vu[u][3], vb0, o_ + 512 + 2048); } while (0)
#define VF(u, j) ((bf16x8){vu[u][j][0], vu[u][j][1], vu[u][j][2], vu[u][j][3], vu[u][j + 1][0], vu[u][j + 1][1], vu[u][j + 1][2], vu[u][j + 1][3]})
#define MV(u, PA) do { o[((u) & 1) * 2] = __builtin_amdgcn_mfma_f32_32x32x16_bf16(PA, VF(u, 0), o[((u) & 1) * 2], 0, 0, 0); o[((u) & 1) * 2 + 1] = __builtin_amdgcn_mfma_f32_32x32x16_bf16(PA, VF(u, 2), o[((u) & 1) * 2 + 1], 0, 0, 0); } while (0)
    if constexpr (MODE == 3) {
        RK(0); RK(1);
        XWAIT(4, ku[0]); MK(0); RK(2);
        XWAIT(4, ku[1]); MK(1); RK(3);
        XWAIT(4, ku[2]); MK(2); RV(0); RV(1);
        XWAIT(8, ku[3]); MK(3); RV(2);
        XWAIT(8, vu[0]); MV(0, pa0); RV(3);
        XWAIT(8, vu[1]); MV(1, pa0); RV(4);
        XWAIT(8, vu[2]); MV(2, pa1); RV(5);
        XWAIT(8, vu[3]); MV(3, pa1); RV(6);
        XWAIT(8, vu[4]); MV(4, pa2); RV(7);
        XWAIT(8, vu[5]); MV(5, pa2);
        XWAIT(4, vu[6]); MV(6, pa3);
        XWAIT(0, vu[7]); MV(7, pa3);
    } else if constexpr (MODE == 1) {
        RK(0); RK(1);
        XWAIT(4, ku[0]); MK(0); RK(2);
        XWAIT(4, ku[1]); MK(1); RK(3);
        XWAIT(4, ku[2]); MK(2);
        XWAIT(0, ku[3]); MK(3);
    } else {
        RV(0); RV(1); RV(2);
        XWAIT(8, vu[0]); MV(0, pa0); RV(3);
        XWAIT(8, vu[1]); MV(1, pa0); RV(4);
        XWAIT(8, vu[2]); MV(2, pa1); RV(5);
        XWAIT(8, vu[3]); MV(3, pa1); RV(6);
        XWAIT(8, vu[4]); MV(4, pa2); RV(7);
        XWAIT(8, vu[5]); MV(5, pa2);
        XWAIT(4, vu[6]); MV(6, pa3);
        XWAIT(0, vu[7]); MV(7, pa3);
    }
    __builtin_amdgcn_s_setprio(YPRIO);
#undef RK
#undef KF
#undef MK
#undef RV
#undef VF
#undef MV
}
#undef RD128
#undef TRRD
#undef XWAIT
__device__ __forceinline__ void sm_a(f32x16& p0) {
#pragma unroll
    for (int r = 0; r < 16; ++r) p0[r] = __builtin_amdgcn_exp2f(p0[r]);
}
__device__ __forceinline__ void sm_b(f32x16& p0, f32x16& p1, float& l_reg, bf16x8& pa0, bf16x8& pa1, bf16x8& pa2, bf16x8& pa3) {
#pragma unroll
    for (int r = 0; r < 16; ++r) p1[r] = __builtin_amdgcn_exp2f(p1[r]);
    float ps = 0;
#pragma unroll
    for (int r = 0; r < 16; ++r) ps += p0[r];
#pragma unroll
    for (int r = 0; r < 16; ++r) ps += p1[r];
    l_reg += ps;
#define PK4(P, B_, OUT) do { unsigned a0 = cvtpk(P[B_+0], P[B_+1]), a1 = cvtpk(P[B_+2], P[B_+3]); \
        unsigned b0 = cvtpk(P[B_+4], P[B_+5]), b1 = cvtpk(P[B_+6], P[B_+7]); \
        auto r0 = __builtin_amdgcn_permlane32_swap(a0, b0, false, false); auto r1 = __builtin_amdgcn_permlane32_swap(a1, b1, false, false); \
        v4u w = {r0[0], r1[0], r0[1], r1[1]}; OUT = *reinterpret_cast<bf16x8*>(&w); } while (0)
    PK4(p0, 0, pa0); PK4(p0, 8, pa1); PK4(p1, 0, pa2); PK4(p1, 8, pa3);
#undef PK4
}

__device__ __forceinline__ void attn_unit(Frame& F, const Args& args, int b, int h, int iq) {
#if defined(PROBE_B) && PROBE_B >= 10
    unsigned tacc = 0, tlast = (unsigned)__builtin_amdgcn_s_memrealtime();
#define TP(k) do { const unsigned now_ = (unsigned)__builtin_amdgcn_s_memrealtime(); if ((k) == PROBE_B - 10) tacc += now_ - tlast; tlast = now_; } while (0)
#else
#define TP(k) do { } while (0)
#endif
    int tid = F.tid; asm volatile("" : "+v"(tid));
    const int wid = F.wave, lane = tid & 63, r32 = lane & 31, hi = lane >> 5;
    char* lds = F.ldsg;
    char* V_lds = lds; char* K_lds = lds + 2 * SHM_V;
    float* kml = (float*)(lds + XTRA_OFF);
    const bf16* QR = WSP(bf16, WS_E) + 2 * E_STRIDE; const bf16* KN = WSP(bf16, WS_E) + 3 * E_STRIDE; const bf16* VV = WSP(bf16, WS_E) + 4 * E_STRIDE;
    bf16* YA = WSP(bf16, WS_YCAT) + 1024;
    const size_t mb = (size_t)b * SEQ;
    const int q0 = iq * 256, NT = 4 * (iq + 1);
    const bf16* Kh = KN + mb * DM + h * HD; const bf16* Vh = VV + mb * DM + h * HD;
    { const float* kmg = WSP(float, WS_KMEAN) + (size_t)(b * NH + h) * 16 * HD; for (int idx = tid; idx < iq * HD; idx += 512) kml[idx] = kmg[idx]; }
    const int vb0 = (int)(uintptr_t)V_lds + v_rd_base(lane);
    unsigned koff[2], voff[2];
#pragma unroll
    for (int jq = 0; jq < 2; ++jq) { const int p = (2 * wid + jq) * 64 + lane;
        { const int row = p >> 4, c = (p & 15) ^ (row & 7); koff[jq] = (unsigned)(row * DM + c * 8) * 2u; }
        { const int st = p >> 5, idx = p & 31, kk = (st >> 2) * 8 + (idx >> 2), col = (st & 3) * 32 + (idx & 3) * 8, k = (kk & ~0xC) | ((kk & 4) << 1) | ((kk & 8) >> 1); voff[jq] = (unsigned)(k * DM + col) * 2u; } }
#define DMA_K(t, bf) do { _Pragma("unroll") for (int jq_ = 0; jq_ < 2; ++jq_) __builtin_amdgcn_global_load_lds((const unsigned*)((const char*)(Kh + (size_t)(t) * 64 * DM) + koff[jq_]), (LAS unsigned*)(F.lds + 2 * SHM_V + (bf) * SHM_K + (2 * wid + jq_) * 1024), 16, 0, 0); } while (0)
#define DMA_V(t, bf) do { _Pragma("unroll") for (int jq_ = 0; jq_ < 2; ++jq_) __builtin_amdgcn_global_load_lds((const unsigned*)((const char*)(Vh + (size_t)(t) * 64 * DM) + voff[jq_]), (LAS unsigned*)(F.lds + (bf) * SHM_V + (2 * wid + jq_) * 1024), 16, 0, 0); } while (0)
    DMA_K(0, 0); DMA_V(0, 0);
    const size_t mq = mb + q0 + wid * 32 + r32;
    unsigned selmask; bf16x8 qr[8];
    {
        const bf16* qp = QR + mq * DM + h * HD + hi * 8;
        v4u raw[8];
#pragma unroll
        for (int d0 = 0; d0 < 8; ++d0) raw[d0] = *(const v4u*)(qp + d0 * 16);
        float ss = 0.f;
#pragma unroll
        for (int d0 = 0; d0 < 8; ++d0) { const float a0 = bflo(raw[d0].x), a1 = bfhi(raw[d0].x), a2 = bflo(raw[d0].y), a3 = bfhi(raw[d0].y), a4 = bflo(raw[d0].z), a5 = bfhi(raw[d0].z), a6 = bflo(raw[d0].w), a7 = bfhi(raw[d0].w);
            ss += (a0 * a0 + a1 * a1) + (a2 * a2 + a3 * a3) + (a4 * a4 + a5 * a5) + (a6 * a6 + a7 * a7); }
        ss += __shfl_xor(ss, 32);
        const float rs = C2 / sqrtf(ss * (1.f / HD) + EPS);
        const float* qg = IN_F(15) + hi * 8;
#define UNPK(f, W_) do { const v4u t_ = (W_); f[0] = bflo(t_.x); f[1] = bfhi(t_.x); f[2] = bflo(t_.y); f[3] = bfhi(t_.y); f[4] = bflo(t_.z); f[5] = bfhi(t_.z); f[6] = bflo(t_.w); f[7] = bfhi(t_.w); } while (0)
#define PACK(f) ({ v4u w_; w_.x = cvtpk(f[0], f[1]); w_.y = cvtpk(f[2], f[3]); w_.z = cvtpk(f[4], f[5]); w_.w = cvtpk(f[6], f[7]); *reinterpret_cast<bf16x8*>(&w_); })
        { float f0[8], f1[8]; UNPK(f0, raw[0]); UNPK(f1, raw[1]);
          const float* tg = WSP(float, WS_TRIG) + mq * 32 + hi * 8;
#pragma unroll
          for (int j = 0; j < 8; ++j) { const float x1 = f0[j] * rs * qg[j], x2 = f1[j] * rs * qg[16 + j], cs = tg[j], sn = tg[16 + j]; f0[j] = x1 * cs - x2 * sn; f1[j] = x2 * cs + x1 * sn; }
          qr[0] = PACK(f0); qr[1] = PACK(f1); }
#pragma unroll
        for (int d0 = 2; d0 < 8; ++d0) { float f[8]; UNPK(f, raw[d0]);
#pragma unroll
            for (int j = 0; j < 8; ++j) f[j] *= rs * qg[d0 * 16 + j];
            qr[d0] = PACK(f); }
        __syncthreads();
        float v1 = -__builtin_inff(), v2 = v1, v3 = v1; int i1 = 0, i2 = 0, i3 = 0;
#pragma unroll 1
        for (int jb = 0; jb < iq; ++jb) { const float* km = kml + jb * HD + hi * 8; float g = 0.f;
#pragma unroll
            for (int d0 = 0; d0 < 8; ++d0) { float f[8]; UNPK(f, *reinterpret_cast<const v4u*>(&qr[d0]));
                const f32x4 k0 = *(const f32x4*)(km + d0 * 16), k1 = *(const f32x4*)(km + d0 * 16 + 4);
                g += (f[0] * k0[0] + f[1] * k0[1]) + (f[2] * k0[2] + f[3] * k0[3]) + (f[4] * k1[0] + f[5] * k1[1]) + (f[6] * k1[2] + f[7] * k1[3]); }
            g += __shfl_xor(g, 32);
            if (g > v1) { v3 = v2; i3 = i2; v2 = v1; i2 = i1; v1 = g; i1 = jb; }
            else if (g > v2) { v3 = v2; i3 = i2; v2 = g; i2 = jb; }
            else if (g > v3) { v3 = g; i3 = jb; } }
#undef UNPK
#undef PACK
        selmask = 0u; if (iq >= 1) selmask |= 1u << i1; if (iq >= 2) selmask |= 1u << i2; if (iq >= 3) selmask |= 1u << i3;
    }
    float l_reg = 0.f; f32x16 o[4] = {};
    const int wrow0 = wid * 32;
#define ACT(t) (((t) >> 2) < iq ? (__ballot((selmask >> ((t) >> 2)) & 1u) != 0ull) : ((((t) - 4 * iq) * 64) <= wrow0 + 31))
#define MASKT(P0_, P1_, t) do { const int blk_ = (t) >> 2; const float NEG_ = -__builtin_inff(); \
        if (blk_ < iq) { if (!((selmask >> blk_) & 1u)) { _Pragma("unroll") for (int r = 0; r < 16; ++r) { P0_[r] = NEG_; P1_[r] = NEG_; } } } \
        else { const int kb_ = ((t) - 4 * iq) * 64; if (kb_ + 63 > wrow0) { int dq_ = wrow0 + r32 - kb_ - 4 * hi; asm volatile("" : "+v"(dq_)); \
            _Pragma("unroll") for (int r = 0; r < 16; ++r) { const int c_ = (r & 3) + 8 * (r >> 2); if (c_ > dq_) P0_[r] = NEG_; if (c_ + 32 > dq_) P1_[r] = NEG_; } } } } while (0)
    f32x16 p0, p1; bf16x8 pa0 = {}, pa1 = {}, pa2 = {}, pa3 = {};
    int ka[4];
#pragma unroll
    for (int dd = 0; dd < 4; ++dd) ka[dd] = (int)(uintptr_t)lds + KSWZ(r32, dd * 32 + hi * 16);
    const int grp = wid >> 2;
#define BAR() do { asm volatile("" ::: "memory"); __builtin_amdgcn_s_barrier(); asm volatile("" ::: "memory"); } while (0)
#define ISSUE_E(t) do { DMA_K((t) + 1, 1); DMA_V((t), 0); } while (0)
#define ISSUE_O(t) do { if ((t) + 1 < NT) DMA_K((t) + 1, 0); DMA_V((t), 1); } while (0)
#define YPH(t) do { MASKT(p0, p1, (t)); sm_a(p0); sm_b(p0, p1, l_reg, pa0, pa1, pa2, pa3); } while (0)
    VM_WAIT(); __syncthreads();
    if (grp) { ISSUE_E(0); BAR(); }
    if (!grp) ISSUE_E(0);
    xphase<0, 1, 1>(p0, p1, o, qr, ka, vb0, pa0, pa1, pa2, pa3);
    if (grp) VM_WAIT();
    BAR();
    if (grp) ISSUE_O(1);
    YPH(0);
    if (!grp) VM_WAIT();
    BAR();
    TP(4);
    for (int t = 1; t + 1 < NT; t += 2) {
        if (!grp) ISSUE_O(t);
        xphase<1, 0, 3>(p0, p1, o, qr, ka, vb0, pa0, pa1, pa2, pa3);
        TP(0);
        if (grp) VM_WAIT();
        BAR();
        TP(1);
        if (grp) ISSUE_E(t + 1);
        YPH(t);
        TP(2);
        if (!grp) VM_WAIT();
        BAR();
        TP(3);
        if (!grp) ISSUE_E(t + 1);
        xphase<0, 1, 3>(p0, p1, o, qr, ka, vb0, pa0, pa1, pa2, pa3);
        TP(0);
        if (grp) VM_WAIT();
        BAR();
        TP(1);
        if (grp) ISSUE_O(t + 2);
        YPH(t + 1);
        TP(2);
        if (!grp) VM_WAIT();
        BAR();
        TP(3);
    }
    if (!grp) ISSUE_O(NT - 1);
    xphase<1, 0, 3>(p0, p1, o, qr, ka, vb0, pa0, pa1, pa2, pa3);
    if (grp) VM_WAIT();
    BAR();
    YPH(NT - 1);
    if (!grp) VM_WAIT();
    BAR();
    xphase<0, 1, 2>(p0, p1, o, qr, ka, vb0, pa0, pa1, pa2, pa3);
    BAR();
    if (!grp) BAR();
#undef YPH
#undef ISSUE_E
#undef ISSUE_O
#undef BAR
#undef DMA_K
#undef DMA_V
    l_reg += __shfl_xor(l_reg, 32);
    float* li_l = (float*)(lds + XTRA_OFF + 8192) + wid * 32;
    if (hi == 0) li_l[r32] = l_reg;
    asm volatile("s_waitcnt lgkmcnt(0)" ::: "memory");
    float rli[16];
#pragma unroll
    for (int r = 0; r < 16; ++r) rli[r] = __builtin_amdgcn_rcpf(li_l[crow(r, hi)]);
    { unsigned short* stg = (unsigned short*)(lds + wid * 8192);
#pragma unroll
      for (int r = 0; r < 16; ++r) { const int orow = crow(r, hi);
#pragma unroll
          for (int d0 = 0; d0 < 4; ++d0) stg[orow * 128 + d0 * 32 + r32] = (unsigned short)f2bf(o[d0][r] * rli[r]); }
      asm volatile("s_waitcnt lgkmcnt(0)" ::: "memory");
      bf16* Ow = YA + (mb + q0 + wid * 32) * 2048 + h * HD;
#pragma unroll
      for (int i = 0; i < 8; ++i) { const int row = i * 4 + (lane >> 4), ch = lane & 15; const v4u v = *(const v4u*)(stg + row * 128 + ch * 8); *(v4u*)(Ow + (size_t)row * 2048 + ch * 8) = v; } }
    __syncthreads();
#if defined(PROBE_B) && PROBE_B >= 10
    TP(5);
    if (F.tid == 0) F.MISC[17] = F.MISC[17] + tacc;
#endif
#undef TP
#undef ACT
#undef MASKT
}
#undef KSWZ
}

__device__ __forceinline__ void p7_router(Frame& F, const Args& args) {
    LAS float* ssq = (LAS float*)F.lds;
    LAS float* par = (LAS float*)(F.lds + 2048);
    LAS float* lg = (LAS float*)(F.lds + 10240);
    LAS int* hist = (LAS int*)(F.lds + 77824 + 2048);
    LAS int* sel = (LAS int*)(F.lds + 77824 + 4096);
    const float* g2n = IN_F(6); const float* mod = WSP(float, WS_MOD); const float* brt = IN_F(21);
    unsigned char* H2 = WSP(unsigned char, WS_HB);
    const float* xin = IN_F(0); const bf16* D1 = WSP(bf16, WS_D1);
    unsigned* CNT = (unsigned*)(F.ws + WS_CTL) + CW_CNT;
    const int row = F.lane & 15, q = F.lane >> 4, kw = F.wave * 128;
    bf16x8 Bh[4][2], Bl[4][2];
    { const bf16* wh = WSP(bf16, WS_WRH) + (size_t)row * 1024 + kw + 8 * q; const bf16* wl = WSP(bf16, WS_WRL) + (size_t)row * 1024 + kw + 8 * q;
#pragma unroll
      for (int s = 0; s < 4; ++s) { Bh[s][0] = *(const bf16x8*)(wh + 32 * s); Bh[s][1] = *(const bf16x8*)(wh + 16384 + 32 * s); Bl[s][0] = *(const bf16x8*)(wl + 32 * s); Bl[s][1] = *(const bf16x8*)(wl + 16384 + 32 * s); } }
    for (int vw = F.vcu; vw < 256; vw += F.G) {
        const int m0 = vw * 64, b = m0 >> 12;
        for (int i = F.tid; i < 1024; i += 512) { par[i] = g2n[i] * (1.0f + mod[b * 6144 + 4096 + i]); par[1024 + i] = mod[b * 6144 + 3072 + i]; }
        if (F.tid < 32) hist[F.tid] = 0;
#pragma unroll
        for (int rt = 0; rt < 4; ++rt) { const float* xp = xin + (size_t)(m0 + rt * 16 + row) * DM + kw + 8 * q; const bf16* dp = D1 + (size_t)(m0 + rt * 16 + row) * DM + kw + 8 * q; float ss = 0.f;
#pragma unroll
            for (int s = 0; s < 4; ++s) { const v4u dd = *(const v4u*)(dp + 32 * s);
                const f32x4 x0 = *(const f32x4*)(xp + 32 * s) + (f32x4){bflo(dd.x), bfhi(dd.x), bflo(dd.y), bfhi(dd.y)}, x1 = *(const f32x4*)(xp + 32 * s + 4) + (f32x4){bflo(dd.z), bfhi(dd.z), bflo(dd.w), bfhi(dd.w)};
                const f32x4 a = x0 * x0 + x1 * x1; ss += (a.x + a.y) + (a.z + a.w); }
            ss += __shfl_xor(ss, 16); ss += __shfl_xor(ss, 32);
            if (q == 0) ssq[F.wave * 64 + rt * 16 + row] = ss; }
        __syncthreads();
        f32x4 xraw[2][4][2]; v4u draw[2][4];
#define P7_LOADRT(rt_) do { const float* xp_ = xin + (size_t)(m0 + (rt_) * 16 + row) * DM + kw + 8 * q; const bf16* dp_ = D1 + (size_t)(m0 + (rt_) * 16 + row) * DM + kw + 8 * q; \
        _Pragma("unroll") for (int s_ = 0; s_ < 4; ++s_) { draw[(rt_) & 1][s_] = *(const v4u*)(dp_ + 32 * s_); xraw[(rt_) & 1][s_][0] = *(const f32x4*)(xp_ + 32 * s_); xraw[(rt_) & 1][s_][1] = *(const f32x4*)(xp_ + 32 * s_ + 4); } } while (0)
        P7_LOADRT(0);
#pragma unroll
        for (int rt = 0; rt < 4; ++rt) { const int rl = rt * 16 + row; float tot = 0.f;
            if (rt + 1 < 4) P7_LOADRT(rt + 1);
#pragma unroll
            for (int w = 0; w < 8; ++w) tot += ssq[w * 64 + rl];
            const float rstd = 1.0f / sqrtf(tot * (1.f / DM) + EPS);
            f32x4 acc0 = {0.f, 0.f, 0.f, 0.f}, acc1 = {0.f, 0.f, 0.f, 0.f};
            unsigned char* hp = H2 + (size_t)(m0 + rl) * DM + kw + 8 * q;
            f32x4 xq[4][2];
#pragma unroll
            for (int s = 0; s < 4; ++s) { const v4u dd = draw[rt & 1][s];
                xq[s][0] = xraw[rt & 1][s][0] + (f32x4){bflo(dd.x), bfhi(dd.x), bflo(dd.y), bfhi(dd.y)}; xq[s][1] = xraw[rt & 1][s][1] + (f32x4){bflo(dd.z), bfhi(dd.z), bflo(dd.w), bfhi(dd.w)}; }
#pragma unroll
            for (int s = 0; s < 4; ++s) { const int col = kw + 32 * s + 8 * q; float h[8];
#pragma unroll
                for (int hf = 0; hf < 2; ++hf) { const f32x4 sc = *(const LAS f32x4*)(par + col + 4 * hf), sh = *(const LAS f32x4*)(par + 1024 + col + 4 * hf);
                    const f32x4 t = xq[s][hf] * rstd * sc + sh; h[4 * hf] = t.x; h[4 * hf + 1] = t.y; h[4 * hf + 2] = t.z; h[4 * hf + 3] = t.w; }
                v4u hi; hi.x = cvtpk(h[0], h[1]); hi.y = cvtpk(h[2], h[3]); hi.z = cvtpk(h[4], h[5]); hi.w = cvtpk(h[6], h[7]);
                { v2u h8; h8.x = pg8::pk_fp8x4(h[0], h[1], h[2], h[3]); h8.y = pg8::pk_fp8x4(h[4], h[5], h[6], h[7]); *(v2u*)(hp + 32 * s) = h8; }
                v4u lo; lo.x = cvtpk(h[0] - bflo(hi.x), h[1] - bfhi(hi.x)); lo.y = cvtpk(h[2] - bflo(hi.y), h[3] - bfhi(hi.y)); lo.z = cvtpk(h[4] - bflo(hi.z), h[5] - bfhi(hi.z)); lo.w = cvtpk(h[6] - bflo(hi.w), h[7] - bfhi(hi.w));
                const bf16x8 ah = *reinterpret_cast<bf16x8*>(&hi), al = *reinterpret_cast<bf16x8*>(&lo);
                acc0 = __builtin_amdgcn_mfma_f32_16x16x32_bf16(ah, Bh[s][0], acc0, 0, 0, 0); acc0 = __builtin_amdgcn_mfma_f32_16x16x32_bf16(ah, Bl[s][0], acc0, 0, 0, 0); acc0 = __builtin_amdgcn_mfma_f32_16x16x32_bf16(al, Bh[s][0], acc0, 0, 0, 0);
                acc1 = __builtin_amdgcn_mfma_f32_16x16x32_bf16(ah, Bh[s][1], acc1, 0, 0, 0); acc1 = __builtin_amdgcn_mfma_f32_16x16x32_bf16(ah, Bl[s][1], acc1, 0, 0, 0); acc1 = __builtin_amdgcn_mfma_f32_16x16x32_bf16(al, Bh[s][1], acc1, 0, 0, 0); }
#pragma unroll
            for (int r = 0; r < 4; ++r) { lg[(F.wave * 64 + rt * 16 + 4 * q + r) * 33 + row] = acc0[r]; lg[(F.wave * 64 + rt * 16 + 4 * q + r) * 33 + 16 + row] = acc1[r]; } }
#undef P7_LOADRT
        __syncthreads();
        { const int rowl = F.tid >> 3, eq = F.tid & 7; float v[4];
#pragma unroll
          for (int j = 0; j < 4; ++j) { float a = brt[4 * eq + j];
#pragma unroll
              for (int w = 0; w < 8; ++w) a += lg[(w * 64 + rowl) * 33 + 4 * eq + j];
              v[j] = a; }
          float tv[4]; int te[4];
#pragma unroll
          for (int k = 0; k < 4; ++k) { float gm = fmaxf(fmaxf(v[0], v[1]), fmaxf(v[2], v[3]));
              gm = fmaxf(gm, __shfl_xor(gm, 1)); gm = fmaxf(gm, __shfl_xor(gm, 2)); gm = fmaxf(gm, __shfl_xor(gm, 4));
              int ci = v[0] == gm ? 4 * eq : v[1] == gm ? 4 * eq + 1 : v[2] == gm ? 4 * eq + 2 : v[3] == gm ? 4 * eq + 3 : 99;
              ci = min(ci, __shfl_xor(ci, 1)); ci = min(ci, __shfl_xor(ci, 2)); ci = min(ci, __shfl_xor(ci, 4));
              te[k] = ci; tv[k] = gm;
#pragma unroll
              for (int j = 0; j < 4; ++j) if (ci == 4 * eq + j) v[j] = -__builtin_inff(); }
          if (eq == 0) { const float w1 = __expf(tv[1] - tv[0]), w2 = __expf(tv[2] - tv[0]), w3 = __expf(tv[3] - tv[0]); const float inv = 1.0f / (1.0f + w1 + w2 + w3);
              const float gk[4] = {inv, w1 * inv, w2 * inv, w3 * inv};
#pragma unroll
              for (int k = 0; k < 4; ++k) { const int lr = atomicAdd((int*)&hist[te[k]], 1); sel[rowl * 4 + k] = te[k]; sel[256 + rowl * 4 + k] = lr; sel[512 + rowl * 4 + k] = __float_as_int(gk[k]); } } }
        __syncthreads();
        if (F.tid < 32) { const int hc = hist[F.tid]; hist[32 + F.tid] = hc ? (int)__hip_atomic_fetch_add(CNT + F.tid, (unsigned)hc, RLX_AGENT) : 0; }
        __syncthreads();
        if (F.tid < 256) { const int e = sel[F.tid], pos = hist[32 + e] + sel[256 + F.tid], mm = m0 + (F.tid >> 2);
            WSP(int, WS_ROWTOK)[(size_t)e * ECAP + pos] = mm; WSP(int, WS_ROWGATE)[(size_t)e * ECAP + pos] = sel[512 + F.tid];
            WSP(int, WS_TOKE)[mm * 4 + (F.tid & 3)] = e; WSP(int, WS_TOKPOS)[mm * 4 + (F.tid & 3)] = pos; }
        __syncthreads();
    }
}

constexpr int MOE_TBL_OFF = XTRA_OFF, MOE_LIST_OFF = XTRA_OFF + 2048;
__device__ __forceinline__ int moe_tables(Frame& F) {
    LAS int* tbl = (LAS int*)(F.lds + MOE_TBL_OFF);
    const unsigned* CNT = (const unsigned*)(F.ws + WS_CTL) + CW_CNT;
    if (F.tid < 32) tbl[F.tid] = (int)__hip_atomic_load(CNT + F.tid, RLX_AGENT);
    __syncthreads();
    if (F.tid == 0) { int run = 0;
#pragma unroll 1
        for (int e = 0; e < 32; ++e) { tbl[32 + e] = run; const int nb = (tbl[e] + 255) >> 8;
#pragma unroll 1
            for (int bb = 0; bb < nb; ++bb) tbl[80 + run + bb] = e;
            run += nb; }
        tbl[64] = run; }
    __syncthreads();
    int nblk = tbl[64]; if (nblk > MAXBLK) nblk = MAXBLK; if (nblk < 1) nblk = 1;
    return __builtin_amdgcn_readfirstlane(nblk);
}

__device__ __forceinline__ void p11_combine(Frame& F, const Args& args) {
    (void)moe_tables(F);
    const LAS int* tbl = (const LAS int*)(F.lds + MOE_TBL_OFF);
    const float* mod = WSP(float, WS_MOD); const unsigned char* YR = WSP(unsigned char, WS_YR); const float* xin = IN_F(0); const bf16* D1 = WSP(bf16, WS_D1);
    const int gw = F.vcu * NWAVES + F.wave, NGW = F.G * NWAVES;
    const int col = 16 * F.lane;
#define P11_LOAD(m_, Y0, Y1, Y2, Y3, DA, DB, X) do { int dk_ = 0; if (F.lane < 4) { const int e_ = __hip_atomic_load(WSP(int, WS_TOKE) + (m_) * 4 + F.lane, RLX_AGENT); dk_ = tbl[32 + e_] * 256 + __hip_atomic_load(WSP(int, WS_TOKPOS) + (m_) * 4 + F.lane, RLX_AGENT); } \
        const int d0_ = __shfl(dk_, 0), d1_ = __shfl(dk_, 1), d2_ = __shfl(dk_, 2), d3_ = __shfl(dk_, 3); \
        Y0 = *(const v4u*)(YR + (size_t)d0_ * DM + col); Y1 = *(const v4u*)(YR + (size_t)d1_ * DM + col); Y2 = *(const v4u*)(YR + (size_t)d2_ * DM + col); Y3 = *(const v4u*)(YR + (size_t)d3_ * DM + col); \
        DA = *(const v4u*)(D1 + (size_t)(m_) * DM + col); DB = *(const v4u*)(D1 + (size_t)(m_) * DM + col + 8); \
        _Pragma("unroll") for (int q_ = 0; q_ < 4; ++q_) X[q_] = *(const f32x4*)(xin + (size_t)(m_) * DM + col + 4 * q_); } while (0)
#define P11_STORE(m_, Y0, Y1, Y2, Y3, DA, DB, X) do { const int b_ = (m_) >> 12; const unsigned dw_[8] = {DA.x, DA.y, DA.z, DA.w, DB.x, DB.y, DB.z, DB.w}; \
        const unsigned w0_[4] = {Y0.x, Y0.y, Y0.z, Y0.w}, w1_[4] = {Y1.x, Y1.y, Y1.z, Y1.w}, w2_[4] = {Y2.x, Y2.y, Y2.z, Y2.w}, w3_[4] = {Y3.x, Y3.y, Y3.z, Y3.w}; \
        _Pragma("unroll") for (int q_ = 0; q_ < 4; ++q_) { \
            const f32x2 a0_ = __builtin_amdgcn_cvt_pk_f32_fp8((int)w0_[q_], false) + __builtin_amdgcn_cvt_pk_f32_fp8((int)w1_[q_], false) + __builtin_amdgcn_cvt_pk_f32_fp8((int)w2_[q_], false) + __builtin_amdgcn_cvt_pk_f32_fp8((int)w3_[q_], false); \
            const f32x2 a1_ = __builtin_amdgcn_cvt_pk_f32_fp8((int)w0_[q_], true) + __builtin_amdgcn_cvt_pk_f32_fp8((int)w1_[q_], true) + __builtin_amdgcn_cvt_pk_f32_fp8((int)w2_[q_], true) + __builtin_amdgcn_cvt_pk_f32_fp8((int)w3_[q_], true); \
            const f32x4 s_ = {a0_.x, a0_.y, a1_.x, a1_.y}; \
            const f32x4 g2_ = *(const f32x4*)(mod + b_ * 6144 + 5120 + col + 4 * q_) * 0.0625f; \
            const f32x4 dl_ = {bflo(dw_[2 * q_]), bfhi(dw_[2 * q_]), bflo(dw_[2 * q_ + 1]), bfhi(dw_[2 * q_ + 1])}; \
            *(f32x4*)(F.out + (size_t)(m_) * DM + col + 4 * q_) = X[q_] + dl_ + g2_ * s_; } } while (0)
    v4u ya0, ya1, ya2, ya3, daa, dab; f32x4 xa[4]; v4u yb0, yb1, yb2, yb3, dba, dbb; f32x4 xb[4];
    int m = gw;
    if (m < NTOK) P11_LOAD(m, ya0, ya1, ya2, ya3, daa, dab, xa);
    for (; m < NTOK; m += 2 * NGW) {
        const int m1 = m + NGW, m2 = m + 2 * NGW;
        if (m1 < NTOK) P11_LOAD(m1, yb0, yb1, yb2, yb3, dba, dbb, xb);
        P11_STORE(m, ya0, ya1, ya2, ya3, daa, dab, xa);
        if (m2 < NTOK) P11_LOAD(m2, ya0, ya1, ya2, ya3, daa, dab, xa);
        if (m1 < NTOK) P11_STORE(m1, yb0, yb1, yb2, yb3, dba, dbb, xb);
    }
#undef P11_LOAD
#undef P11_STORE
}

#ifndef NSTREAM
#define NSTREAM 8
#endif
#define P4_PULL(ctr, dst) do { __syncthreads(); if (F.tid == 0) bc[0] = (int)__hip_atomic_fetch_add((ctr), 1u, RLX_AGENT); __syncthreads(); dst = bc[0]; } while (0)
__device__ __forceinline__ void p4_phase(Frame& F, const Args& args) {
    unsigned* Q = (unsigned*)(F.ws + WS_CTL) + CW_QUEUE;
    LAS int* bc = (LAS int*)(F.lds + XTRA_OFF + 12288);
    const bool xcd_ok = (F.G == 256);
    const int xg = xcd_ok ? (F.vcu >> 5) : (F.vcu & 7);
    const bool streamer = xcd_ok && (F.vcu & 31) < NSTREAM;
#ifdef PROBE_B
#define P4_STAMP(k) do { if (PROBE_B >= 10) { if ((k) == 0 && F.tid == 0) { F.MISC[16] = 0u; F.MISC[17] = 0u; } } else { if ((k) == 0 && F.tid == 0) F.MISC[16] = (unsigned)__builtin_amdgcn_s_memrealtime(); if ((k) == PROBE_B && F.tid == 0) F.MISC[17] = (unsigned)__builtin_amdgcn_s_memrealtime(); } } while (0)
#else
#define P4_STAMP(k) do { } while (0)
#endif
    P4_STAMP(0);
    if (streamer) { for (;;) { int ch; P4_PULL(Q + 64 * 9, ch); if (ch >= P8_NCHUNK) break; p8_chunk(F, args, ch); } }
    P4_STAMP(1);
#pragma unroll 1
    for (int dx = 0; dx < 8; ++dx) { const int x = (xg + dx) & 7;
        for (;;) { int a; P4_PULL(Q + 64 * x, a); if (a >= 64) break;
            const int bh = 4 * x + (a & 3); att::attn_unit(F, args, bh >> 3, bh & 7, 15 - (a >> 2)); } }
    P4_STAMP(2);
    for (;;) { int u; P4_PULL(Q + 64 * 8, u); if (u >= 512) break; p4_rnn_final_unit(F, args, u); }
    P4_STAMP(3);
    if (!streamer) { for (;;) { int ch; P4_PULL(Q + 64 * 9, ch); if (ch >= P8_NCHUNK) break; p8_chunk(F, args, ch); } }
}
#undef P4_PULL
#undef P4_STAMP

#ifndef MK_N_LAUNCHES
#define MK_N_LAUNCHES 1
#endif
constexpr int PER_PHASE = 12;
constexpr int N_LAUNCHES = MK_N_LAUNCHES;

__global__ void __launch_bounds__(NWAVES * 64, 2) hybrid_fwd(Args args) {
    extern __shared__ __attribute__((aligned(16))) unsigned char lds[];
    Frame F;
    F.lds = (LAS unsigned char*)lds; F.ldsg = (char*)lds;
    F.MISC = (volatile LAS unsigned*)(F.lds + MISC_OFF);
    F.tid = threadIdx.x; F.lane = F.tid & 63; F.wave = __builtin_amdgcn_readfirstlane(F.tid >> 6);
    F.G = gridDim.x; { const int bx = blockIdx.x; F.vcu = (F.G % 8 == 0) ? (bx % 8) * (F.G / 8) + bx / 8 : bx; }
    F.ws = args.ws; F.out = args.out;
    gu32* ctl = (gu32*)(args.ws + WS_CTL);
    for (int u = F.tid; u < (LDS_BYTES - LDSCTL_OFF) / 4; u += NWAVES * 64) ((LAS unsigned*)(F.lds + LDSCTL_OFF))[u] = 0u;
    __syncthreads();
    XcdBarrier bar; bar.bar = (unsigned*)(ctl + CW_BAR); bar.x = 0; bar.st = nullptr;
    if (N_LAUNCHES == 1) bar = xcd_barrier_post((unsigned*)(ctl + CW_BAR), F.MISC + 8);
    const int lo = args.ph_lo, hi = args.ph_hi;
#ifndef PHASE_MASK
#define PHASE_MASK 0xFFF
#endif
#define IN(k) (((PHASE_MASK >> (k)) & 1) && lo <= (k) && (k) < hi)
#define NEXTP(k) ((k) == 0 ? 2 : (k) == 7 ? 9 : (k) + 1)
#define SEAM(k) do { if (IN(k) && IN(NEXTP(k))) xcd_barrier(bar); } while (0)

#ifndef DUP_MASK
#define DUP_MASK 0
#endif
#ifdef PROBE_A
#define PHASE(k, ...) do { if ((k) == PROBE_A && F.tid == 0) F.MISC[16] = (unsigned)__builtin_amdgcn_s_memrealtime(); \
    if (IN(k)) { __VA_ARGS__ } SEAM(k); if ((k) == PROBE_A && F.tid == 0) F.MISC[17] = (unsigned)__builtin_amdgcn_s_memrealtime(); } while (0)
#else
#define PHASE(k, ...) do { if (IN(k)) { __VA_ARGS__ if ((DUP_MASK >> (k)) & 1) { xcd_barrier(bar); __VA_ARGS__ } } SEAM(k); } while (0)
#endif
    PHASE(0, { p0_prologue(F, args); p1_hrows(F, args); });
    PHASE(2, {
        { pg8::Gemm g{WSP(bf16, WS_HB), WSP(bf16, WS_WIN), NTOK, 3072, DM}; pg8::TileOrder S; S.init(NTOK / 256, 12, F.G, (int)blockIdx.x, nullptr);
          pg8::EpiWin E{WSP(bf16, WS_E), IN_F(17), 0};
          pg8::gemm_phase<pg8::EpiWin, pg8::TileOrder, true, true>(F.lds + RING_OFF, g, S, E); }
        { pg8::Gemm g{WSP(bf16, WS_H8), WSP(bf16, WS_WIN8), NTOK, 4096, DM / 2}; pg8::TileOrder S; S.init(NTOK / 256, 16, F.G, (int)blockIdx.x, nullptr);
          pg8::EpiWin E{WSP(bf16, WS_E), IN_F(17), 1};
          pg8::gemm_phase<pg8::EpiWin, pg8::TileOrder, true, true, false, true>(F.lds + RING_OFF, g, S, E); }
    });
    int p3rep = 0;
    PHASE(3, {
        for (int u = F.vcu; u < 512; u += F.G) p3_rnn_local_unit(F, args, u);
        if (p3rep++ == 0) { for (int u = F.vcu; u < 512; u += F.G) p3_knorm_unit(F, args, u); }
    });
    PHASE(4, { p4_phase(F, args); });
    PHASE(5, {
        pg8::Gemm g{WSP(bf16, WS_YCAT), WSP(bf16, WS_WB), NTOK, DM, 2 * DM}; pg8::TileOrder S; S.init(NTOK / 256, DM / 256, F.G, (int)blockIdx.x, nullptr);
        pg8::EpiBranch E{WSP(bf16, WS_E) + 5 * E_STRIDE, WSP(bf16, WS_E) + 6 * E_STRIDE, WSP(bf16, WS_HB)};
        pg8::gemm_phase<pg8::EpiBranch, pg8::TileOrder, false, true>(F.lds + RING_OFF, g, S, E);
    });
    PHASE(6, {
        pg8::Gemm g{WSP(bf16, WS_HB), WSP(bf16, WS_WO), NTOK, DM, DM}; pg8::TileOrder S; S.init(NTOK / 256, DM / 256, F.G, (int)blockIdx.x, nullptr);
        pg8::EpiWout E{WSP(bf16, WS_D1), WSP(float, WS_MOD)};
        pg8::gemm_phase<pg8::EpiWout, pg8::TileOrder, false, true>(F.lds + RING_OFF, g, S, E);
    });
    PHASE(7, { p7_router(F, args); });
    PHASE(9, {
        const int nblk = moe_tables(F);
        const LAS int* tbl = (const LAS int*)(F.lds + MOE_TBL_OFF); LAS int* lists = (LAS int*)(F.lds + MOE_LIST_OFF);
        pg8::Gemm g{WSP(bf16, WS_HB), WSP(bf16, WS_WUP), RMAX, 2048 * NEXP, DM / 2}; pg8::TileOrder S; S.init(nblk, 8, F.G, (int)blockIdx.x, tbl + 80, F.ws + WS_HB);
        { pg8::Unit u; for (int i = 0; i < 9 && S.next(i, u); ++i) { if (F.tid < 256) { const int e = u.pn >> 3, pos = (u.pm - tbl[32 + e]) * 256 + F.tid;
              lists[i * 256 + F.tid] = pos < tbl[e] ? __hip_atomic_load(WSP(int, WS_ROWTOK) + (size_t)e * ECAP + pos, RLX_AGENT) : 0; } } }
        __syncthreads();
        pg8::EpiUp E{WSP(unsigned char, WS_ACT), IN_F(23)};
        pg8::gemm_phase<pg8::EpiUp, pg8::TileOrder, true, true, true, true>(F.lds + RING_OFF, g, S, E, lists);
    });
    PHASE(10, {
        const int nblk = moe_tables(F);
        const LAS int* tbl = (const LAS int*)(F.lds + MOE_TBL_OFF);
        pg8::Gemm g{WSP(bf16, WS_ACT), WSP(bf16, WS_WDN), RMAX, 1024 * NEXP, DM / 2}; pg8::TileOrder S; S.init(nblk, 4, F.G, (int)blockIdx.x, tbl + 80);
        pg8::EpiDown E{WSP(unsigned char, WS_YR), IN_F(25), WSP(float, WS_ROWGATE), tbl, F.lds + XTRA_OFF + 12288};
        pg8::gemm_phase<pg8::EpiDown, pg8::TileOrder, true, true, false, true>(F.lds + RING_OFF, g, S, E);
    });
    PHASE(11, { p11_combine(F, args); });
#undef PHASE
#ifdef PROBE_A
    if (F.tid == 0) __hip_atomic_store((unsigned*)(ctl + 20480 + F.vcu), (unsigned)(F.MISC[17] - F.MISC[16]), __ATOMIC_RELAXED, __HIP_MEMORY_SCOPE_AGENT);
    xcd_barrier(bar);
    { unsigned mx = 0, sm = 0;
      for (int w = 0; w < F.G; ++w) { const unsigned v = __hip_atomic_load((unsigned*)(ctl + 20480 + w), __ATOMIC_RELAXED, __HIP_MEMORY_SCOPE_AGENT); mx = v > mx ? v : mx; sm += v; }
#ifndef PROBE_STAT
#define PROBE_STAT 0
#endif
      const float eps = (PROBE_STAT == 0 ? (float)mx : (float)sm / (float)F.G) * 0.01f * PROBE_SCALE;
      const int gw = F.vcu * NWAVES + F.wave, NGW = F.G * NWAVES;
      for (int m = gw; m < NTOK; m += NGW) { f32x4* xr = (f32x4*)(F.out + (size_t)m * DM) + F.lane;
#pragma unroll
          for (int j = 0; j < 4; ++j) xr[64 * j] = xr[64 * j] + eps; } }
#endif
#undef IN
#undef SEAM
}

extern "C" void kernel_launch(void* const* d_in, const int* in_sizes, int n_in, void* d_out, int out_size, void* d_ws, size_t ws_size, hipStream_t stream) {
    static int grid = 0;
    if (grid == 0) {
        if (n_in != 26 || in_sizes[0] != NTOK * DM || out_size != NTOK * DM || ws_size < WS_END) {
            fprintf(stderr, "kernel_launch: shape/workspace mismatch (n_in %d, in0 %d, out %d, ws %zu; need ws >= %zu); nothing launched\n", n_in, n_in > 0 ? in_sizes[0] : -1, out_size, ws_size, (size_t)WS_END); grid = -1; return; }
        int dev = 0, cus = 0, per_cu = 0;
        if (hipGetDevice(&dev) != hipSuccess || hipDeviceGetAttribute(&cus, hipDeviceAttributeMultiprocessorCount, dev) != hipSuccess) { fprintf(stderr, "kernel_launch: device query failed\n"); grid = -1; return; }
        if (hipFuncSetAttribute((const void*)hybrid_fwd, hipFuncAttributeMaxDynamicSharedMemorySize, LDS_BYTES) != hipSuccess) { fprintf(stderr, "kernel_launch: hipFuncSetAttribute failed\n"); grid = -1; return; }
        if (hipOccupancyMaxActiveBlocksPerMultiprocessor(&per_cu, (const void*)hybrid_fwd, NWAVES * 64, LDS_BYTES) != hipSuccess || per_cu < 1) { fprintf(stderr, "kernel_launch: occupancy query says %d blocks/CU\n", per_cu); per_cu = 1; }
        (void)hipGetLastError();
        grid = cus;
        if (grid > 256) grid = 256;
    }
    if (grid < 0) return;
    (void)hipMemsetAsync((char*)d_ws + WS_CTL, 0, CTL_ZERO_BYTES, stream);
    Args a{};
    for (int i = 0; i < 26; ++i) a.in[i] = d_in[i];
    a.out = (float*)d_out; a.ws = (unsigned char*)d_ws;
    for (int li = 0; li < N_LAUNCHES; ++li) {
        a.ph_lo = (N_LAUNCHES == 1) ? 0 : li; a.ph_hi = (N_LAUNCHES == 1) ? PER_PHASE : li + 1;
        hipLaunchKernelGGL(hybrid_fwd, dim3(grid), dim3(NWAVES * 64), LDS_BYTES, stream, a);
        const hipError_t le = hipPeekAtLastError();
        if (le != hipSuccess) { fprintf(stderr, "kernel_launch: launch %d failed: %s\n", li, hipGetErrorName(le)); break; }
    }
}
```

```cpp
#include <hip/hip_runtime.h>
#include <hip/hip_bf16.h>
#include <cstdio>
#include <cstdint>
#include <cmath>
namespace pg8 {
#define PG8_LAS __attribute__((address_space(3)))
typedef unsigned short bf16_t;
typedef short bf16x8 __attribute__((ext_vector_type(8)));
typedef float f32x4 __attribute__((ext_vector_type(4)));
typedef unsigned u32x4 __attribute__((ext_vector_type(4)));
constexpr int BM = 256, BK = 64, HALF = 128, HTB = HALF * BK * 2  , STAGE_BYTES = 8 * HTB, NXCD = 8, WGM = 8;

__host__ __device__ __forceinline__ int lds_byte(int r, int c) { const int st = (r >> 4) * 2 + (c >> 5), rr = r & 15, cc = c & 31, ob = rr * 64 + cc * 2; return st * 1024 + (ob ^ (((ob >> 9) & 1) << 5)); }
__host__ __device__ __forceinline__ void stage_rc(int b, int& R, int& C) { const int st = b / 1024, sb = b % 1024, swz = sb ^ (((sb >> 9) & 1) << 5); R = (st >> 1) * 16 + swz / 64; C = (st & 1) * 32 + (swz % 64) / 2; }
__host__ __device__ __forceinline__ int perm32(int rho) { const int n = rho >> 4, i = rho & 15; return 8 * (i >> 2) + 4 * n + (i & 3); }

struct Unit { int pm, pn, kind; };
struct Gemm { const bf16_t* A; const bf16_t* Bt; int M, N, K; };

struct StaticOrder {
    int nM, nN, nwg, G, c;
    __host__ __device__ void init(int M, int N, int G_, int c_) { nM = M / BM; nN = N / BM; nwg = nM * nN; G = G_; c = c_; }
    __host__ __device__ bool next(int i, Unit& u) const {
        const long L = (long)i * G + c; if (L >= nwg) return false;
        int wgid = (int)L; { const int q = nwg / NXCD, r = nwg % NXCD, xcd = wgid % NXCD, off = wgid / NXCD; wgid = (xcd < r ? xcd * (q + 1) : r * (q + 1) + (xcd - r) * q) + off; }
        const int nig = WGM * nN, gid = wgid / nig, fm = gid * WGM, gsz = (nM - fm) < WGM ? (nM - fm) : WGM;
        u.pm = fm + ((wgid % nig) % gsz); u.pn = (wgid % nig) / gsz; return true;
    }
    __device__ __forceinline__ void a_ready(const Unit&) const {}
    __device__ __forceinline__ void done(const Unit&) const {}
};

__device__ __forceinline__ unsigned cvt_pk_bf16(float lo, float hi) { unsigned r; asm volatile("v_cvt_pk_bf16_f32 %0, %1, %2" : "=v"(r) : "v"(lo), "v"(hi)); return r; }
typedef int v4i_t __attribute__((ext_vector_type(4)));
typedef int v8i_t __attribute__((ext_vector_type(8)));
template <class Epi, class Sched, bool ALIGN_EPI = false, bool SP2 = false, bool GATHER = false, bool FP8 = false>
__device__ __forceinline__ void gemm_phase(PG8_LAS unsigned char* lds, const Gemm g, const Sched& S, const Epi& E, const PG8_LAS int* rowlists = nullptr) {
    static_assert(!GATHER || SP2, "GATHER is implemented for the SP2 loop");
    const int tid = threadIdx.x, wid = __builtin_amdgcn_readfirstlane(tid >> 6), lane = tid & 63, wr = wid >> 2, wc = wid & 3, fr = lane & 15, fq = lane >> 4;
    const int K = g.K, nt = K / BK;
    unsigned voffA, voffB; int gR, gC;
    { int R, C; stage_rc(tid * 16, R, C); const int Rb = Epi::PERM ? ((R & ~31) + perm32(R & 31)) : R; gR = R; gC = C;
      voffA = (unsigned)(R * K + C) * 2u; voffB = (unsigned)(Rb * K + C) * 2u; }
    const size_t row64 = (size_t)64 * K * 2;
    const size_t kstep = (size_t)(BK * 2);
    const size_t hstep = (size_t)HALF * K * 2;
    const size_t tstep = 2 * hstep;
    const unsigned ldsw = (unsigned)wid * 1024u;
    const int aoff = lds_byte(wr * 64 + fr, fq * 8), boff = lds_byte(wc * 32 + fr, fq * 8);
#define PG8_SA(b, h) (((b) * 2 + (h)) * HTB)
#define PG8_SB(b, h) ((4 + (b) * 2 + (h)) * HTB)
#define PG8_STAGE2(bufoff, gbase, v0_, v1_) do { unsigned vo0_ = (v0_), vo1_ = (v1_); asm volatile("" : "+v"(vo0_), "+v"(vo1_));     \
        __builtin_amdgcn_global_load_lds((const unsigned*)((const char*)(gbase) + vo0_), (PG8_LAS unsigned*)(lds + (bufoff) + ldsw), 16, 0, 0); \
        __builtin_amdgcn_global_load_lds((const unsigned*)((const char*)(gbase) + vo1_), (PG8_LAS unsigned*)(lds + (bufoff) + ldsw + 8192), 16, 0, 0); } while (0)
#define PG8_STAGE(bufoff, gbase, voff) do { unsigned vo_ = (voff); asm volatile("" : "+v"(vo_)); \
        __builtin_amdgcn_global_load_lds((const unsigned*)((const char*)(gbase) + vo_), (PG8_LAS unsigned*)(lds + (bufoff) + ldsw), 16, 0, 0); \
        __builtin_amdgcn_global_load_lds((const unsigned*)((const char*)(gbase) + row64 + vo_), (PG8_LAS unsigned*)(lds + (bufoff) + ldsw + 8192), 16, 0, 0); } while (0)
#define PG8_LDA(dst, b, h) do { _Pragma("unroll") for (int m = 0; m < 4; ++m) _Pragma("unroll") for (int k = 0; k < 2; ++k) dst[m][k] = *(const PG8_LAS bf16x8*)(lds + PG8_SA(b, h) + aoff + m * 2048 + k * 1024); } while (0)
#define PG8_LDB(dst, b, h) do { _Pragma("unroll") for (int n = 0; n < 2; ++n) _Pragma("unroll") for (int k = 0; k < 2; ++k) dst[n][k] = *(const PG8_LAS bf16x8*)(lds + PG8_SB(b, h) + boff + n * 2048 + k * 1024); } while (0)
#define PG8_CAT8(x, y) __builtin_shufflevector(__builtin_bit_cast(v4i_t, (x)), __builtin_bit_cast(v4i_t, (y)), 0, 1, 2, 3, 4, 5, 6, 7)
#define PG8_MMA(ai, bj, At, Bt) do { __builtin_amdgcn_s_setprio(1); _Pragma("unroll") for (int m = 0; m < 4; ++m) _Pragma("unroll") for (int n = 0; n < 2; ++n) { \
        if constexpr (FP8) { const v8i_t a8_ = PG8_CAT8(Bt[n][0], Bt[n][1]), b8_ = PG8_CAT8(At[m][0], At[m][1]);     \
            asm volatile("v_mfma_scale_f32_16x16x128_f8f6f4 %0, %1, %2, %0, %3, %4 op_sel_hi:[0,0,0]" : "+v"(acc[ai][bj][m][n]) : "v"(a8_), "v"(b8_), "v"(mxsa_), "v"(mxsb_)); } \
        else { _Pragma("unroll") for (int k = 0; k < 2; ++k) acc[ai][bj][m][n] = __builtin_amdgcn_mfma_f32_16x16x32_bf16(Bt[n][k], At[m][k], acc[ai][bj][m][n], 0, 0, 0); } } \
        __builtin_amdgcn_s_setprio(0); } while (0)
#define PG8_WAIT_V(n) asm volatile("s_waitcnt vmcnt(" #n ")" ::: "memory")
#define PG8_WAIT_VN(n) asm volatile("s_waitcnt vmcnt(%0)" :: "i"(n) : "memory")
#define PG8_WAIT_L(n) asm volatile("s_waitcnt lgkmcnt(" #n ")" ::: "memory")
#define PG8_BAR __builtin_amdgcn_s_barrier()
#define PG8_SCHED __builtin_amdgcn_sched_barrier(0)
    Unit cur, nxt; int ui = 0;
    if (!S.next(0, cur)) return;
    int mxsa_ = 121, mxsb_ = 127; asm volatile("" : "+v"(mxsa_), "+v"(mxsb_));
    f32x4 acc[2][2][4][2];
#pragma unroll
    for (int a = 0; a < 2; ++a)
#pragma unroll
        for (int b = 0; b < 2; ++b)
#pragma unroll
            for (int m = 0; m < 4; ++m)
#pragma unroll
                for (int n = 0; n < 2; ++n) acc[a][b][m][n] = (f32x4){0.f, 0.f, 0.f, 0.f};
    bf16x8 At[4][2], B0[2][2], B1[2][2];
    const char* cA = GATHER ? (const char*)S.a_base(cur) : (const char*)g.A + (size_t)cur.pm * tstep; const char* cB = (const char*)g.Bt + (size_t)cur.pn * tstep;
#define PG8_STAGE_A(bufoff, kptr, half, unx) do { if constexpr (GATHER) { const PG8_LAS int* rl_ = rowlists + (ui + (unx)) * 256 + (half) * HALF + gR; \
        PG8_STAGE2(bufoff, kptr, (unsigned)(rl_[0] * K + gC) * 2u, (unsigned)(rl_[64] * K + gC) * 2u); } \
        else { PG8_STAGE(bufoff, (kptr) + (half) * hstep, voffA); } } while (0)
    S.a_ready(cur);
    if constexpr (SP2) {
        PG8_STAGE(PG8_SB(0, 0), cB, voffB); PG8_STAGE(PG8_SB(0, 1), cB + hstep, voffB); PG8_STAGE_A(PG8_SA(0, 0), cA, 0, 0); PG8_STAGE_A(PG8_SA(0, 1), cA, 1, 0);
        if (wr == 1) PG8_BAR;
        PG8_WAIT_V(2); PG8_BAR;
        PG8_STAGE(PG8_SB(1, 0), cB + kstep, voffB); PG8_STAGE_A(PG8_SA(1, 0), cA + kstep, 0, 0); PG8_STAGE(PG8_SB(1, 1), cB + hstep + kstep, voffB);
        PG8_WAIT_V(6); PG8_BAR;
    } else {
        PG8_STAGE(PG8_SB(0, 0), cB, voffB); PG8_STAGE(PG8_SA(0, 0), cA, voffA); PG8_STAGE(PG8_SB(0, 1), cB + hstep, voffB); PG8_STAGE(PG8_SA(0, 1), cA + hstep, voffA);
        if (wr == 1) PG8_BAR;
        PG8_WAIT_V(4); PG8_BAR;
        PG8_STAGE(PG8_SB(1, 0), cB + kstep, voffB); PG8_STAGE(PG8_SA(1, 0), cA + kstep, voffA); PG8_STAGE(PG8_SB(1, 1), cB + hstep + kstep, voffB);
        PG8_WAIT_V(6); PG8_BAR;
    }
    for (;;) {
        const bool has_next = S.next(ui + 1, nxt);
        const char* nA = GATHER ? (has_next ? (const char*)S.a_base(nxt) : cA) : (has_next ? (const char*)g.A + (size_t)nxt.pm * tstep : cA);
        const char* nB = has_next ? (const char*)g.Bt + (size_t)nxt.pn * tstep : cB;
#pragma unroll 1
        for (int t = 0; t < nt; t += 2) {
            const bool last = (t == nt - 2);
            if constexpr (Epi::MIDK) { if (t == (nt >> 1)) { if constexpr (FP8) asm volatile("s_nop 15\n\ts_nop 7" ::: "memory"); E.mid(acc, cur, wr, wc, fr, fq); } }
            const char* a1 = cA + (size_t)(t + 1) * kstep;
            const char* a2 = last ? nA : cA + (size_t)(t + 2) * kstep; const char* b2 = last ? nB : cB + (size_t)(t + 2) * kstep;
            const char* a3 = a2 + kstep; const char* b3 = b2 + kstep;
            if (last && has_next) S.a_ready(nxt);
            const int unx = (GATHER && last && has_next) ? 1 : 0;
            if constexpr (SP2) {
            PG8_LDB(B0, 0, 0); PG8_LDB(B1, 0, 1); PG8_SCHED; PG8_LDA(At, 0, 0); PG8_STAGE_A(PG8_SA(1, 1), a1, 1, 0);
            PG8_WAIT_V(8); PG8_WAIT_L(0); PG8_BAR; PG8_MMA(0, 0, At, B0); PG8_MMA(0, 1, At, B1); PG8_BAR; PG8_SCHED;
            PG8_LDA(At, 0, 1); PG8_STAGE(PG8_SB(0, 0), b2, voffB); PG8_STAGE(PG8_SB(0, 1), b2 + hstep, voffB); PG8_STAGE_A(PG8_SA(0, 0), a2, 0, unx);
            PG8_WAIT_V(8); PG8_WAIT_L(0); PG8_BAR; PG8_MMA(1, 0, At, B0); PG8_MMA(1, 1, At, B1); PG8_BAR; PG8_SCHED;
            PG8_LDB(B0, 1, 0); PG8_LDB(B1, 1, 1); PG8_SCHED; PG8_LDA(At, 1, 0); PG8_STAGE_A(PG8_SA(0, 1), a2, 1, unx);
            PG8_WAIT_V(8); PG8_WAIT_L(0); PG8_BAR; PG8_MMA(0, 0, At, B0); PG8_MMA(0, 1, At, B1); PG8_BAR; PG8_SCHED;
            PG8_LDA(At, 1, 1); PG8_STAGE(PG8_SB(1, 0), b3, voffB); PG8_STAGE(PG8_SB(1, 1), b3 + hstep, voffB); PG8_STAGE_A(PG8_SA(1, 0), a3, 0, unx);
            PG8_WAIT_V(8); PG8_WAIT_L(0); PG8_BAR; PG8_MMA(1, 0, At, B0); PG8_MMA(1, 1, At, B1); PG8_BAR; PG8_SCHED;
            } else {
            PG8_LDB(B0, 0, 0); PG8_SCHED; PG8_LDA(At, 0, 0); PG8_STAGE(PG8_SA(1, 1), a1 + hstep, voffA);
            PG8_WAIT_L(8); PG8_BAR; PG8_WAIT_L(0); PG8_MMA(0, 0, At, B0); PG8_BAR; PG8_SCHED;
            PG8_LDB(B1, 0, 1); PG8_STAGE(PG8_SB(0, 0), b2, voffB);
            PG8_BAR; PG8_WAIT_L(0); PG8_MMA(0, 1, At, B1); PG8_BAR;
            PG8_LDA(At, 0, 1); PG8_STAGE(PG8_SA(0, 0), a2, voffA);
            PG8_BAR; PG8_WAIT_L(0); PG8_MMA(1, 0, At, B0); PG8_BAR; PG8_SCHED;
            PG8_STAGE(PG8_SB(0, 1), b2 + hstep, voffB);
            PG8_WAIT_V(6); PG8_BAR; PG8_MMA(1, 1, At, B1); PG8_BAR;
            PG8_LDB(B0, 1, 0); PG8_SCHED; PG8_LDA(At, 1, 0); PG8_STAGE(PG8_SA(0, 1), a2 + hstep, voffA);
            PG8_WAIT_L(8); PG8_BAR; PG8_WAIT_L(0); PG8_MMA(0, 0, At, B0); PG8_BAR; PG8_SCHED;
            PG8_LDB(B1, 1, 1); PG8_STAGE(PG8_SB(1, 0), b3, voffB);
            PG8_BAR; PG8_WAIT_L(0); PG8_MMA(0, 1, At, B1); PG8_BAR;
            PG8_LDA(At, 1, 1); PG8_STAGE(PG8_SA(1, 0), a3, voffA);
            PG8_BAR; PG8_WAIT_L(0); PG8_MMA(1, 0, At, B0); PG8_BAR; PG8_SCHED;
            PG8_STAGE(PG8_SB(1, 1), b3 + hstep, voffB);
            PG8_WAIT_V(6); PG8_BAR; PG8_MMA(1, 1, At, B1); PG8_BAR;
            }
        }
        if constexpr (ALIGN_EPI) { if (wr == 0) PG8_BAR; }
        if constexpr (FP8) asm volatile("s_nop 15\n\ts_nop 7" ::: "memory");
        if constexpr (!Epi::AFTER_DRAIN) { E(acc, cur, wr, wc, fr, fq); S.done(cur); }
        if (!has_next) break;
#pragma unroll
        for (int a = 0; a < 2; ++a)
#pragma unroll
            for (int b = 0; b < 2; ++b)
#pragma unroll
                for (int m = 0; m < 4; ++m)
#pragma unroll
                    for (int n = 0; n < 2; ++n) acc[a][b][m][n] = (f32x4){0.f, 0.f, 0.f, 0.f};
        cur = nxt; cA = nA; cB = nB; ++ui;
        if constexpr (ALIGN_EPI) { if (wr == 1) PG8_BAR; }
    }
    PG8_WAIT_V(0);
    if constexpr (!ALIGN_EPI) { if (wr == 0) PG8_BAR; }
    PG8_BAR;
    if constexpr (Epi::AFTER_DRAIN) { E.fused(acc, cur, wr, wc, fr, fq, lds, wid, lane); S.done(cur); }
#undef PG8_SA
#undef PG8_STAGE_A
#undef PG8_SB
#undef PG8_STAGE
#undef PG8_STAGE2
#undef PG8_LDA
#undef PG8_LDB
#undef PG8_MMA
#undef PG8_CAT8
#undef PG8_WAIT_V
#undef PG8_WAIT_VN
#undef PG8_WAIT_L
#undef PG8_BAR
#undef PG8_SCHED
}
}

constexpr int NB = 4, SEQ = 4096, DM = 1024, NTOK = NB * SEQ, DIN = 7168, NH = 8, HD = 128;
constexpr int NEXP = 32, TOPK = 4, MAXBLK = 288, RMAX = MAXBLK * 256;
constexpr float EPS = 1e-6f;
constexpr int NWAVES = 8;

constexpr size_t MiB = 1u << 20, KiB = 1u << 10;
constexpr size_t WS_CTL = 0, CTL_ZERO_BYTES = 1 * MiB;
constexpr size_t WS_MOD = 1 * MiB;
constexpr size_t WS_KMEAN = 1 * MiB + 128 * KiB;
constexpr size_t WS_AGGP = 1 * MiB + 384 * KiB;
constexpr size_t WS_AGGH = 1 * MiB + 640 * KiB;
constexpr size_t WS_WRH = 2 * MiB, WS_WRL = 2 * MiB + 64 * KiB;
constexpr size_t WS_TOKE = 3 * MiB, WS_TOKPOS = 3 * MiB + 256 * KiB;
constexpr int ECAP = 16384;
constexpr size_t WS_ROWTOK = 28 * MiB, WS_ROWGATE = 30 * MiB;
constexpr int CW_UPDONE = 16384;
constexpr int CW_QUEUE = 12288;
constexpr int CW_CNT = 8192;
constexpr size_t WS_TRIG = 4 * MiB;
constexpr size_t WS_WRG = 6 * MiB;
constexpr size_t WS_WIN = 8 * MiB;
constexpr size_t WS_WIN8 = 16 * MiB;
constexpr size_t WS_H8 = 544 * MiB;
constexpr size_t WS_WB = 22 * MiB;
constexpr size_t WS_WO = 26 * MiB;
constexpr size_t WS_WUP = 32 * MiB;
constexpr size_t WS_WDN = 96 * MiB;
constexpr size_t WS_HB = 224 * MiB;
constexpr size_t WS_E = 256 * MiB;
constexpr size_t E_STRIDE = (size_t)NTOK * DM;
constexpr size_t WS_D1 = 256 * MiB;
constexpr size_t WS_HL = 480 * MiB, WS_PP = 512 * MiB, WS_YCAT = 544 * MiB;
constexpr int CW_MODCNT = 8256;
constexpr size_t WS_ACT = 400 * MiB, WS_YR = 544 * MiB;
constexpr size_t WS_END = 688 * MiB;
constexpr int CW_BAR = 4096;

constexpr int RING_OFF = 0, RING_BYTES = 131072;
constexpr int LDSCTL_OFF = RING_BYTES, MISC_OFF = LDSCTL_OFF + 320;
constexpr int XTRA_OFF = LDSCTL_OFF + 1024;
constexpr int LDS_BYTES = 155648;

#define GAS __attribute__((address_space(1)))
#define LAS __attribute__((address_space(3)))
typedef unsigned short bf16;
typedef unsigned v4u __attribute__((ext_vector_type(4)));
typedef unsigned v2u __attribute__((ext_vector_type(2)));
typedef float f32x4 __attribute__((ext_vector_type(4)));
typedef float f32x2 __attribute__((ext_vector_type(2)));
typedef float f32x16 __attribute__((ext_vector_type(16)));
typedef short bf16x8 __attribute__((ext_vector_type(8)));
typedef short s16x4 __attribute__((ext_vector_type(4)));
typedef GAS unsigned gu32;
#define RLX_AGENT __ATOMIC_RELAXED, __HIP_MEMORY_SCOPE_AGENT
#define LDS_WAIT() asm volatile("s_waitcnt lgkmcnt(0)" ::: "memory")
#define VM_WAIT() asm volatile("s_waitcnt vmcnt(0)" ::: "memory")
#define SBAR() __builtin_amdgcn_sched_barrier(0)
__device__ __forceinline__ unsigned f2bf(float f) { unsigned u = __builtin_bit_cast(unsigned, f); return (u + 0x7fffu + ((u >> 16) & 1u)) >> 16; }
__device__ __forceinline__ unsigned pk2(float lo, float hi) { return f2bf(lo) | (f2bf(hi) << 16); }
__device__ __forceinline__ float bf2f(unsigned short h) { return __builtin_bit_cast(float, (unsigned)h << 16); }
__device__ __forceinline__ float bflo(unsigned w) { return __builtin_bit_cast(float, w << 16); }
__device__ __forceinline__ float bfhi(unsigned w) { return __builtin_bit_cast(float, w & 0xffff0000u); }
__device__ __forceinline__ unsigned cvtpk(float lo, float hi) { unsigned r; asm volatile("v_cvt_pk_bf16_f32 %0, %1, %2" : "=v"(r) : "v"(lo), "v"(hi)); return r; }
__device__ __forceinline__ float fast_sigmoid(float x) { return __builtin_amdgcn_rcpf(1.0f + __builtin_amdgcn_exp2f(-1.4426950408889634f * x)); }
__device__ __forceinline__ float gelu_tanh(float x) { const float z = 1.5957691216057308f * (x + 0.044715f * x * x * x); return x * fast_sigmoid(z); }
__device__ __forceinline__ f32x2 sigmoid_pk(f32x2 x) { const f32x2 z = x * (-1.4426950408889634f); f32x2 e; e.x = __builtin_amdgcn_exp2f(z.x); e.y = __builtin_amdgcn_exp2f(z.y);
    const f32x2 d = e + 1.0f; f32x2 r; r.x = __builtin_amdgcn_rcpf(d.x); r.y = __builtin_amdgcn_rcpf(d.y); return r; }
__device__ __forceinline__ f32x2 gelu_tanh_pk(f32x2 x) {
    const f32x2 u = x * x, w = u * (-0.044715f * 1.5957691216057308f * 1.4426950408889634f) + (-1.5957691216057308f * 1.4426950408889634f), z = x * w;
    f32x2 e; e.x = __builtin_amdgcn_exp2f(z.x); e.y = __builtin_amdgcn_exp2f(z.y);
    const f32x2 d = e + 1.0f; f32x2 r; r.x = __builtin_amdgcn_rcpf(d.x); r.y = __builtin_amdgcn_rcpf(d.y); return x * r; }
__device__ __forceinline__ float wave_sum(float v) {
#pragma unroll
    for (int o = 1; o < 64; o <<= 1) v += __shfl_xor(v, o);
    return v;
}
__device__ __forceinline__ float wave_max(float v) {
#pragma unroll
    for (int o = 1; o < 64; o <<= 1) v = fmaxf(v, __shfl_xor(v, o));
    return v;
}

#define XB_TMO      128
#define XB_XCNT(j)  (256  + 64 * (j))
#define XB_XSUB(j)  (1280 + 64 * (j))
#define XB_XGEN(j)  (2304 + 64 * (j))
#define XB_TOP      3328
#define XB_TOPGEN   3392
#define XCD_BAR_WORDS 3456
#define XB_SPIN_CAP (1u << 20)
__device__ __forceinline__ unsigned xb_ld(unsigned* p)              { return __hip_atomic_load(p, __ATOMIC_RELAXED, __HIP_MEMORY_SCOPE_AGENT); }
__device__ __forceinline__ unsigned xb_add(unsigned* p, unsigned v) { return __hip_atomic_fetch_add(p, v, __ATOMIC_RELAXED, __HIP_MEMORY_SCOPE_AGENT); }
__device__ __forceinline__ unsigned xb_xcc_id() { return (unsigned)__builtin_amdgcn_s_getreg((3 << 11) | 20) & 0xFu; }
#define XB_SPIN(cond, bar) do { unsigned _sp = 0; while (cond) { __builtin_amdgcn_s_sleep(1); \
    if ((++_sp & 255u) == 0u) { if (xb_ld(&(bar)[XB_TMO])) break; if (_sp > XB_SPIN_CAP) { atomicAdd(&(bar)[XB_TMO], 1u); break; } } } } while (0)
struct XcdBarrier { unsigned* bar; unsigned x; volatile LAS unsigned* st; };
__device__ __forceinline__ XcdBarrier xcd_barrier_post(unsigned* bar, volatile LAS unsigned* st) {
    XcdBarrier b; b.bar = bar; b.x = xb_xcc_id(); b.st = st;
    if (threadIdx.x == 0) (void)xb_add(&bar[XB_XCNT(b.x)], 1u);
    return b;
}
__device__ __forceinline__ void xcd_barrier_complete(unsigned* bar, unsigned x, unsigned& nloc, unsigned& nx) {
    const unsigned G = gridDim.x * gridDim.y * gridDim.z;
    unsigned sum, cnt, mine, sp = 0u;
    for (;;) {
        sum = 0u; cnt = 0u; mine = 0u;
#pragma unroll
        for (unsigned j = 0; j < 16; ++j) { const unsigned c = xb_ld(&bar[XB_XCNT(j)]); sum += c; cnt += (c > 0u) ? 1u : 0u; mine = (j == x) ? c : mine; }
        if (sum == G) break;
        __builtin_amdgcn_s_sleep(1);
        if ((++sp & 255u) == 0u) { if (xb_ld(&bar[XB_TMO])) break; if (sp > XB_SPIN_CAP) { atomicAdd(&bar[XB_TMO], 1u); break; } }
    }
    nloc = mine > 0u ? mine : 1u; nx = cnt > 0u ? cnt : 1u;
}
__device__ __forceinline__ void xcd_barrier(const XcdBarrier& b) {
    asm volatile("s_waitcnt vmcnt(0)" ::: "memory");
    __syncthreads();
    if (threadIdx.x == 0) {
        unsigned* bar = b.bar;
        __builtin_amdgcn_s_waitcnt(0);
        unsigned nloc = b.st[0], nx = b.st[1];
        if (nloc == 0u) { xcd_barrier_complete(bar, b.x, nloc, nx); b.st[0] = nloc; b.st[1] = nx; }
        const unsigned old = xb_add(&bar[XB_XSUB(b.x)], 1u);
        const unsigned gen = old / nloc;
        if (old + 1u == (gen + 1u) * nloc) {
            __builtin_amdgcn_fence(__ATOMIC_RELEASE, "agent");
            asm volatile("s_waitcnt vmcnt(0)" ::: "memory");
            const unsigned og = xb_add(&bar[XB_TOP], 1u);
            const unsigned tg = og / nx;
            if (og + 1u == (tg + 1u) * nx) xb_add(&bar[XB_TOPGEN], 1u);
            else XB_SPIN(xb_ld(&bar[XB_TOPGEN]) == tg, bar);
            __builtin_amdgcn_fence(__ATOMIC_ACQUIRE, "agent");
            xb_add(&bar[XB_XGEN(b.x)], 1u);
            asm volatile("s_waitcnt vmcnt(0)" ::: "memory");
        } else {
            XB_SPIN(xb_ld(&bar[XB_XGEN(b.x)]) == gen, bar);
            __builtin_amdgcn_fence(__ATOMIC_ACQUIRE, "agent");
            asm volatile("s_waitcnt vmcnt(0)" ::: "memory");
        }
    }
    __syncthreads();
}

struct Args { const void* in[26]; float* out; unsigned char* ws; int ph_lo, ph_hi; };
struct Frame {
    LAS unsigned char* lds; char* ldsg;
    volatile LAS unsigned* MISC;
    int tid, lane, wave, vcu, G;
    unsigned char* ws; float* out;
};
#define IN_F(k) ((const float*)args.in[k])
#define IN_I(k) ((const int*)args.in[k])
#define WSP(T, off) ((T*)(F.ws + (off)))

namespace pg8 {
struct TileOrder {
    int nM, nN, nwg, G, c; const LAS int* blk_exp; const void* abase;
    __device__ __forceinline__ void init(int nM_, int nN_, int G_, int c_, const LAS int* be, const void* ab = nullptr) { nM = nM_; nN = nN_; nwg = nM * nN; G = G_; c = c_; blk_exp = be; abase = ab; }
    __device__ __forceinline__ const void* a_base(const Unit&) const { return abase; }
    __device__ __forceinline__ bool next(int i, Unit& u) const {
        const long L = (long)i * G + c; if (L >= nwg) return false;
        int wgid = (int)L; { const int q = nwg / NXCD, r = nwg % NXCD, xcd = wgid % NXCD, off = wgid / NXCD; wgid = (xcd < r ? xcd * (q + 1) : r * (q + 1) + (xcd - r) * q) + off; }
        constexpr int WGMX = 4;
        const int nig = WGMX * nN, gid = wgid / nig, fm = gid * WGMX, gsz = (nM - fm) < WGMX ? (nM - fm) : WGMX;
        u.pm = fm + ((wgid % nig) % gsz); u.pn = (wgid % nig) / gsz; u.kind = 0;
        if (blk_exp) { const int e = __builtin_amdgcn_readfirstlane(blk_exp[u.pm]); u.pn += e * nN; }
        return true;
    }
    __device__ __forceinline__ void a_ready(const Unit&) const {}
    __device__ __forceinline__ void done(const Unit&) const {}
};

__device__ __forceinline__ void st16_wt(void* p, u32x4 v) { asm volatile("global_store_dwordx4 %0, %1, off sc1\n\ts_nop 1" :: "v"(p), "v"(v) : "memory"); }
struct EpiWin {
    static constexpr bool PERM = true, AFTER_DRAIN = false, MIDK = false; static constexpr int NSTORES = 16;
    bf16_t* E; const float* b_gate; int mode;
    __device__ __forceinline__ void operator()(const f32x4 (&acc)[2][2][4][2], const Unit& u, int wr, int wc, int fr, int fq) const {
        int row0 = u.pm * BM + wr * 64 + fr;
        asm volatile("" : "+v"(row0));
        if (mode == 1 && u.pn >= 8) {
            const int d0 = (u.pn - 8) * 128 + wc * 32 + 8 * fq;
            bf16_t* Rb = E + (size_t)5 * ((size_t)16384 * 1024); bf16_t* Sb = E + (size_t)6 * ((size_t)16384 * 1024);
            f32x4 b0[2], b1[2];
#pragma unroll
            for (int n = 0; n < 2; ++n) { b0[n] = *(const f32x4*)(b_gate + d0 + 4 * n); b1[n] = *(const f32x4*)(b_gate + 1024 + d0 + 4 * n); }
#pragma unroll
            for (int ai = 0; ai < 2; ++ai)
#pragma unroll
                for (int m = 0; m < 4; ++m) { const size_t ro = (size_t)(row0 + ai * HALF + m * 16) * 1024 + d0;
                    float r[8], s1[8];
#pragma unroll
                    for (int n = 0; n < 2; ++n)
#pragma unroll
                        for (int j = 0; j < 4; j += 2) { const f32x2 x0 = (f32x2){acc[ai][0][m][n][j], acc[ai][0][m][n][j + 1]} + (f32x2){b0[n][j], b0[n][j + 1]}, x1 = (f32x2){acc[ai][1][m][n][j], acc[ai][1][m][n][j + 1]} + (f32x2){b1[n][j], b1[n][j + 1]};
                            const f32x2 z0 = x0 * (-1.4426950408889634f), z1 = x1 * (-1.4426950408889634f);
                            f32x2 e0, e1; e0.x = __builtin_amdgcn_exp2f(z0.x); e0.y = __builtin_amdgcn_exp2f(z0.y); e1.x = fminf(__builtin_amdgcn_exp2f(z1.x), 1e18f); e1.y = fminf(__builtin_amdgcn_exp2f(z1.y), 1e18f);
                            const f32x2 dn0 = e0 + 1.0f, dn1 = e1 + 1.0f; f32x2 q0, q1; q0.x = __builtin_amdgcn_rcpf(dn0.x); q0.y = __builtin_amdgcn_rcpf(dn0.y); q1.x = __builtin_amdgcn_rcpf(dn1.x); q1.y = __builtin_amdgcn_rcpf(dn1.y);
                            const f32x2 rr = dn1 * q0; r[4 * n + j] = rr.x; r[4 * n + j + 1] = rr.y; s1[4 * n + j] = q1.x; s1[4 * n + j + 1] = q1.y; }
                    u32x4 w; w.x = cvt_pk_bf16(r[0], r[1]); w.y = cvt_pk_bf16(r[2], r[3]); w.z = cvt_pk_bf16(r[4], r[5]); w.w = cvt_pk_bf16(r[6], r[7]); *(u32x4*)(Rb + ro) = w;
                    u32x4 v; v.x = cvt_pk_bf16(s1[0], s1[1]); v.y = cvt_pk_bf16(s1[2], s1[3]); v.z = cvt_pk_bf16(s1[4], s1[5]); v.w = cvt_pk_bf16(s1[6], s1[7]); *(u32x4*)(Sb + ro) = v; }
            return;
        }
        const int opn = mode == 0 ? (u.pn < 8 ? u.pn : u.pn + 8) : u.pn + 8;
        const int t = opn >> 2, colt = (opn & 3) * BM;
        bf16_t* base = E + (size_t)t * ((size_t)16384 * 1024);
        const int col0 = colt + wc * 32 + 8 * fq;
#pragma unroll
        for (int ai = 0; ai < 2; ++ai)
#pragma unroll
            for (int m = 0; m < 4; ++m) { bf16_t* rowp = base + (size_t)(row0 + ai * HALF + m * 16) * 1024 + col0;
#pragma unroll
                for (int bj = 0; bj < 2; ++bj) { f32x4 v0 = acc[ai][bj][m][0], v1 = acc[ai][bj][m][1];
                    if (t == 1) { const f32x2 a = gelu_tanh_pk((f32x2){v0[0], v0[1]}), b = gelu_tanh_pk((f32x2){v0[2], v0[3]}), c = gelu_tanh_pk((f32x2){v1[0], v1[1]}), d = gelu_tanh_pk((f32x2){v1[2], v1[3]});
                        v0 = (f32x4){a.x, a.y, b.x, b.y}; v1 = (f32x4){c.x, c.y, d.x, d.y}; }
                    u32x4 w; w.x = cvt_pk_bf16(v0[0], v0[1]); w.y = cvt_pk_bf16(v0[2], v0[3]); w.z = cvt_pk_bf16(v1[0], v1[1]); w.w = cvt_pk_bf16(v1[2], v1[3]);
                    *(u32x4*)(rowp + bj * HALF) = w; } }
    }
};
struct EpiBranch {
    static constexpr bool PERM = true, AFTER_DRAIN = false, MIDK = true; static constexpr int NSTORES = 16;
    const bf16_t* R; const bf16_t* S1; bf16_t* MIX;
    __device__ __forceinline__ void mid(f32x4 (&acc)[2][2][4][2], const Unit& u, int wr, int wc, int fr, int fq) const {
        int row0 = u.pm * BM + wr * 64 + fr; const int col0 = u.pn * BM + wc * 32 + 8 * fq;
        asm volatile("" : "+v"(row0));
#pragma unroll
        for (int ai = 0; ai < 2; ++ai) { u32x4 a[4][2];
#pragma unroll
            for (int m = 0; m < 4; ++m)
#pragma unroll
                for (int bj = 0; bj < 2; ++bj) a[m][bj] = *(const u32x4*)(R + (size_t)(row0 + ai * HALF + m * 16) * 1024 + col0 + bj * HALF);
#pragma unroll
            for (int m = 0; m < 4; ++m)
#pragma unroll
                for (int bj = 0; bj < 2; ++bj) { acc[ai][bj][m][0] *= (f32x4){bflo(a[m][bj].x), bfhi(a[m][bj].x), bflo(a[m][bj].y), bfhi(a[m][bj].y)}; acc[ai][bj][m][1] *= (f32x4){bflo(a[m][bj].z), bfhi(a[m][bj].z), bflo(a[m][bj].w), bfhi(a[m][bj].w)}; }
            asm volatile("" ::: "memory"); }
    }
    __device__ __forceinline__ void operator()(const f32x4 (&acc)[2][2][4][2], const Unit& u, int wr, int wc, int fr, int fq) const {
        int row0 = u.pm * BM + wr * 64 + fr; const int col0 = u.pn * BM + wc * 32 + 8 * fq;
        asm volatile("" : "+v"(row0));
#pragma unroll
        for (int ai = 0; ai < 2; ++ai) { u32x4 b[4][2];
#pragma unroll
            for (int m = 0; m < 4; ++m)
#pragma unroll
                for (int bj = 0; bj < 2; ++bj) b[m][bj] = *(const u32x4*)(S1 + (size_t)(row0 + ai * HALF + m * 16) * 1024 + col0 + bj * HALF);
#pragma unroll
            for (int m = 0; m < 4; ++m)
#pragma unroll
                for (int bj = 0; bj < 2; ++bj) { const size_t o = (size_t)(row0 + ai * HALF + m * 16) * 1024 + col0 + bj * HALF;
                    const f32x4 v0 = acc[ai][bj][m][0] * (f32x4){bflo(b[m][bj].x), bfhi(b[m][bj].x), bflo(b[m][bj].y), bfhi(b[m][bj].y)}, v1 = acc[ai][bj][m][1] * (f32x4){bflo(b[m][bj].z), bfhi(b[m][bj].z), bflo(b[m][bj].w), bfhi(b[m][bj].w)};
                    u32x4 w; w.x = cvt_pk_bf16(v0[0], v0[1]); w.y = cvt_pk_bf16(v0[2], v0[3]); w.z = cvt_pk_bf16(v1[0], v1[1]); w.w = cvt_pk_bf16(v1[2], v1[3]);
                    *(u32x4*)(MIX + o) = w; }
            asm volatile("" ::: "memory"); }
    }
};
struct EpiWout {
    static constexpr bool PERM = true, AFTER_DRAIN = false, MIDK = false; static constexpr int NSTORES = 16;
    bf16_t* D1; const float* mod;
    __device__ __forceinline__ void operator()(const f32x4 (&acc)[2][2][4][2], const Unit& u, int wr, int wc, int fr, int fq) const {
        int row0 = u.pm * BM + wr * 64 + fr; const int col0 = u.pn * BM + wc * 32 + 8 * fq;
        asm volatile("" : "+v"(row0));
        const float* g1p = mod + (size_t)(u.pm >> 4) * 6144 + 2048;
        f32x4 gv[2][2];
#pragma unroll
        for (int bj = 0; bj < 2; ++bj)
#pragma unroll
            for (int n = 0; n < 2; ++n) gv[bj][n] = *(const f32x4*)(g1p + col0 + bj * HALF + 4 * n);
#pragma unroll
        for (int ai = 0; ai < 2; ++ai)
#pragma unroll
            for (int m = 0; m < 4; ++m) { bf16_t* rowp = D1 + (size_t)(row0 + ai * HALF + m * 16) * 1024 + col0;
#pragma unroll
                for (int bj = 0; bj < 2; ++bj) { const f32x4 v0 = acc[ai][bj][m][0] * gv[bj][0], v1 = acc[ai][bj][m][1] * gv[bj][1];
                    u32x4 w; w.x = cvt_pk_bf16(v0[0], v0[1]); w.y = cvt_pk_bf16(v0[2], v0[3]); w.z = cvt_pk_bf16(v1[0], v1[1]); w.w = cvt_pk_bf16(v1[2], v1[3]);
                    *(u32x4*)(rowp + bj * HALF) = w; } }
    }
};
__device__ __forceinline__ unsigned pk_fp8x4(float a, float b, float c, float d) { int p = __builtin_amdgcn_cvt_pk_fp8_f32(a, b, 0, false); p = __builtin_amdgcn_cvt_pk_fp8_f32(c, d, p, true); return (unsigned)p; }
struct EpiUp {
    static constexpr bool PERM = true, AFTER_DRAIN = false, MIDK = false; static constexpr int NSTORES = 8;
    unsigned char* ACT; const float* b_up;
    __device__ __forceinline__ void operator()(const f32x4 (&acc)[2][2][4][2], const Unit& u, int wr, int wc, int fr, int fq) const {
        const int e = u.pn >> 3, p = u.pn & 7;
        int row0 = u.pm * BM + wr * 64 + fr; const int c0 = p * 128 + wc * 32 + 8 * fq;
        asm volatile("" : "+v"(row0));
        const float* bg = b_up + (size_t)e * 2048 + c0; const float* bl = bg + 1024;
        f32x4 bgv[2], blv[2];
#pragma unroll
        for (int n = 0; n < 2; ++n) { bgv[n] = *(const f32x4*)(bg + 4 * n); blv[n] = *(const f32x4*)(bl + 4 * n) + 1.0f; }
#pragma unroll
        for (int ai = 0; ai < 2; ++ai)
#pragma unroll
            for (int m = 0; m < 4; ++m) { unsigned char* rowp = ACT + (size_t)(row0 + ai * HALF + m * 16) * 1024 + c0;
                f32x4 a[2];
#pragma unroll
                for (int n = 0; n < 2; ++n) {
#pragma unroll
                    for (int j = 0; j < 4; j += 2) { f32x2 g = (f32x2){acc[ai][0][m][n][j], acc[ai][0][m][n][j + 1]} + (f32x2){bgv[n][j], bgv[n][j + 1]};
                        f32x2 l = (f32x2){acc[ai][1][m][n][j], acc[ai][1][m][n][j + 1]} + (f32x2){blv[n][j], blv[n][j + 1]};
                        g.x = fminf(g.x, 7.0f); g.y = fminf(g.y, 7.0f); l.x = __builtin_amdgcn_fmed3f(l.x, -6.0f, 8.0f); l.y = __builtin_amdgcn_fmed3f(l.y, -6.0f, 8.0f);
                        const f32x2 z = g * (-1.702f * 1.4426950408889634f); f32x2 e; e.x = __builtin_amdgcn_exp2f(z.x); e.y = __builtin_amdgcn_exp2f(z.y);
                        const f32x2 d = e + 1.0f; f32x2 r; r.x = __builtin_amdgcn_rcpf(d.x); r.y = __builtin_amdgcn_rcpf(d.y);
                        const f32x2 o = (l * g) * r; a[n][j] = o.x; a[n][j + 1] = o.y; } }
                typedef unsigned u32x2_t __attribute__((ext_vector_type(2)));
                u32x2_t w; w.x = pk_fp8x4(a[0][0], a[0][1], a[0][2], a[0][3]); w.y = pk_fp8x4(a[1][0], a[1][1], a[1][2], a[1][3]);
                *(u32x2_t*)rowp = w; }
    }
};
struct EpiDown {
    static constexpr bool PERM = true, AFTER_DRAIN = false, MIDK = false; static constexpr int NSTORES = 16;
    unsigned char* YR; const float* b_down; const float* row_gate; const LAS int* tbl; LAS unsigned char* stage;
    __device__ __forceinline__ void operator()(const f32x4 (&acc)[2][2][4][2], const Unit& u, int wr, int wc, int fr, int fq) const {
        const int e = u.pn >> 2, p = u.pn & 3;
        int row0 = u.pm * BM + wr * 64 + fr; const int c0 = p * BM + wc * 32 + 8 * fq;
        asm volatile("" : "+v"(row0));
        const int pos0 = row0 - tbl[32 + e] * 256, cnt = tbl[e];
        const float* gp = row_gate + (size_t)e * 16384 + pos0;
        float gt[2][4];
#pragma unroll
        for (int ai = 0; ai < 2; ++ai)
#pragma unroll
            for (int m = 0; m < 4; ++m) { const int o = ai * HALF + m * 16; gt[ai][m] = (pos0 + o < cnt) ? gp[o] * 16.0f : 0.0f; }
        f32x4 bv[2][2];
#pragma unroll
        for (int bj = 0; bj < 2; ++bj)
#pragma unroll
            for (int n = 0; n < 2; ++n) bv[bj][n] = *(const f32x4*)(b_down + (size_t)e * 1024 + c0 + bj * HALF + 4 * n);
        typedef unsigned u32x2_t __attribute__((ext_vector_type(2)));
        const int lane = (int)(threadIdx.x & 63), wv = (int)(threadIdx.x >> 6);
        LAS unsigned char* stg = stage + wv * 1024;
        const int srow = lane >> 2, sch = lane & 3;
#pragma unroll
        for (int ai = 0; ai < 2; ++ai)
#pragma unroll
            for (int m = 0; m < 4; ++m) { const float g = gt[ai][m];
#pragma unroll
                for (int bj = 0; bj < 2; ++bj) { const f32x4 v0 = (acc[ai][bj][m][0] + bv[bj][0]) * g, v1 = (acc[ai][bj][m][1] + bv[bj][1]) * g;
                    u32x2_t w; w.x = pk_fp8x4(v0[0], v0[1], v0[2], v0[3]); w.y = pk_fp8x4(v1[0], v1[1], v1[2], v1[3]);
                    *(LAS u32x2_t*)(stg + fr * 64 + bj * 32 + 8 * fq) = w; }
                asm volatile("s_waitcnt lgkmcnt(0)" ::: "memory");
                const u32x4 o = *(const LAS u32x4*)(stg + srow * 64 + sch * 16);
                asm volatile("s_waitcnt lgkmcnt(0)" ::: "memory");
                const int r = u.pm * BM + wr * 64 + ai * HALF + m * 16 + srow;
                *(u32x4*)(YR + (size_t)r * 1024 + p * BM + wc * 32 + (sch >> 1) * HALF + (sch & 1) * 16) = o; }
    }
};
}

__device__ __forceinline__ void p0_transpose_item(const float* W, int N, bf16* WT, int Kd, size_t dst_row0, LAS float* scr, int k0, int n0, int lane) {
#pragma unroll 8
    for (int i = 0; i < 32; ++i) { const int kk = 2 * i + (lane >> 5); scr[kk * 33 + (lane & 31)] = W[(size_t)(k0 + kk) * N + n0 + (lane & 31)]; }
    LDS_WAIT(); asm volatile("" ::: "memory");
    const int c = lane & 7;
#pragma unroll
    for (int j = 0; j < 4; ++j) { const int n = (lane >> 3) + 8 * j; const LAS float* s = scr + (8 * c) * 33 + n;
        v4u o; o.x = pk2(s[0 * 33], s[1 * 33]); o.y = pk2(s[2 * 33], s[3 * 33]); o.z = pk2(s[4 * 33], s[5 * 33]); o.w = pk2(s[6 * 33], s[7 * 33]);
        *(GAS v4u*)(WT + (dst_row0 + n) * (size_t)Kd + k0 + 8 * c) = o; }
    LDS_WAIT(); asm volatile("" ::: "memory");
}
__device__ __forceinline__ void p8_transpose_item_fp8(const float* W, int N, unsigned char* WT, int Kd, size_t dst_row0, LAS float* scr, int k0, int n0, int lane) {
#pragma unroll 8
    for (int i = 0; i < 32; ++i) { const int kk = 2 * i + (lane >> 5); scr[kk * 33 + (lane & 31)] = W[(size_t)(k0 + kk) * N + n0 + (lane & 31)] * 64.0f; }
    LDS_WAIT(); asm volatile("" ::: "memory");
    const int c = lane & 7;
#pragma unroll
    for (int j = 0; j < 4; ++j) { const int n = (lane >> 3) + 8 * j; const LAS float* s = scr + (8 * c) * 33 + n;
        v2u o; o.x = pg8::pk_fp8x4(s[0 * 33], s[1 * 33], s[2 * 33], s[3 * 33]); o.y = pg8::pk_fp8x4(s[4 * 33], s[5 * 33], s[6 * 33], s[7 * 33]);
        *(GAS v2u*)(WT + (dst_row0 + n) * (size_t)Kd + k0 + 8 * c) = o; }
    LDS_WAIT(); asm volatile("" ::: "memory");
}
struct PItem { const float* src; int N; unsigned char* dst; int pitch; int fp8; };
__device__ __forceinline__ PItem p0_item(const Args& args, unsigned char* ws, int it) {
    constexpr int I_IN = 16 * 224, I_RG = 128, I_B = 1024;
    PItem w; int r = it;
    if (r < I_IN) { const int kb = r / 224, nb = r % 224, n0 = nb * 32;
        w.src = IN_F(7) + (size_t)(kb * 64) * DIN + n0; w.N = DIN;
        if (n0 < 2048 || (n0 >= 4096 && n0 < 5120)) { w.fp8 = 0; w.pitch = 2048; w.dst = ws + WS_WIN + ((size_t)(n0 < 2048 ? n0 : n0 - 2048) * 1024 + kb * 64) * 2; }
        else { const int gl = n0 - 5120;
            const size_t row = n0 < 4096 ? (size_t)(n0 - 2048) : (size_t)(2048 + ((gl & 1023) >> 7) * 256 + (gl >> 10) * 128 + (gl & 127));
            w.fp8 = 1; w.pitch = 1024; w.dst = ws + WS_WIN8 + row * 1024 + kb * 64; }
        return w; } r -= I_IN;
    if (r < I_RG) { const int mat = r >> 6, blk = (r >> 3) & 7, kb = (r >> 2) & 1, nb = r & 3;
        w.src = IN_F(mat ? 12 : 10) + (size_t)blk * 16384 + (size_t)(kb * 64) * 128 + nb * 32; w.N = 128; w.fp8 = 0; w.pitch = 256;
        w.dst = ws + WS_WRG + ((size_t)(mat * 8 + blk) * 16384 + (size_t)(nb * 32) * 128 + kb * 64) * 2; return w; } r -= I_RG;
    if (r < I_B) { const int g = r >> 9, q = r & 511, kb = q >> 5, nb = q & 31;
        w.src = IN_F(18) + (size_t)g * 1048576 + (size_t)(kb * 64) * 1024 + nb * 32; w.N = 1024; w.fp8 = 0; w.pitch = 4096;
        w.dst = ws + WS_WB + ((size_t)g * 1024 + (size_t)(nb * 32) * 2048 + kb * 64) * 2; return w; } r -= I_B;
    { const int kb = r >> 5, nb = r & 31;
      w.src = IN_F(19) + (size_t)(kb * 64) * 1024 + nb * 32; w.N = 1024; w.fp8 = 0; w.pitch = 2048;
      w.dst = ws + WS_WO + ((size_t)(nb * 32) * 1024 + kb * 64) * 2; }
    return w;
}
__device__ __forceinline__ void p0_load(const PItem& w, f32x4 (&v)[8], int lane) {
#pragma unroll
    for (int i = 0; i < 8; ++i) v[i] = __builtin_nontemporal_load((const f32x4*)(w.src + (size_t)((lane >> 3) + 8 * i) * w.N + (lane & 7) * 4));
}
__device__ __forceinline__ void p0_store(const PItem& w, const f32x4 (&v)[8], LAS float* scr, int lane) {
    const float sc = w.fp8 ? 64.0f : 1.0f;
#pragma unroll
    for (int i = 0; i < 8; ++i) { LAS float* d = scr + ((lane >> 3) + 8 * i) * 33 + (lane & 7) * 4; d[0] = v[i].x * sc; d[1] = v[i].y * sc; d[2] = v[i].z * sc; d[3] = v[i].w * sc; }
    LDS_WAIT(); asm volatile("" ::: "memory");
    const int c = lane & 7;
#pragma unroll
    for (int j = 0; j < 4; ++j) { const int n = (lane >> 3) + 8 * j; const LAS float* s = scr + (8 * c) * 33 + n;
        if (w.fp8) { v2u o; o.x = pg8::pk_fp8x4(s[0 * 33], s[1 * 33], s[2 * 33], s[3 * 33]); o.y = pg8::pk_fp8x4(s[4 * 33], s[5 * 33], s[6 * 33], s[7 * 33]); *(GAS v2u*)(w.dst + (size_t)n * w.pitch + 8 * c) = o; }
        else { v4u o; o.x = pk2(s[0 * 33], s[1 * 33]); o.y = pk2(s[2 * 33], s[3 * 33]); o.z = pk2(s[4 * 33], s[5 * 33]); o.w = pk2(s[6 * 33], s[7 * 33]); *(GAS v4u*)(w.dst + (size_t)n * w.pitch + 16 * c) = o; } }
    LDS_WAIT(); asm volatile("" ::: "memory");
}
__device__ __forceinline__ void p0_prologue(Frame& F, const Args& args) {
    const float* c_in = IN_F(1); const int* pos = IN_I(2); const float* ada_w = IN_F(3); const float* ada_b = IN_F(4);
    for (int task = F.vcu; task < 192; task += F.G) {
        LAS float* sc = (LAS float*)F.lds;
        LAS float* red = (LAS float*)(F.lds + 16384);
        for (int i = F.tid; i < 4096; i += 512) { const float v = c_in[i]; sc[i] = v / (1.0f + expf(-v)); }
        __syncthreads();
        const int colq = F.lane & 7, kq = F.lane >> 3, col = task * 32 + colq * 4;
        float acc[4][4];
#pragma unroll
        for (int b = 0; b < 4; ++b)
#pragma unroll
            for (int j = 0; j < 4; ++j) acc[b][j] = 0.f;
#pragma unroll 8
        for (int s = 0; s < 16; ++s) { const int k = F.wave * 128 + s * 8 + kq; const f32x4 wv = *(const f32x4*)(ada_w + (size_t)k * 6144 + col);
#pragma unroll
            for (int b = 0; b < 4; ++b) { const float sv = sc[b * 1024 + k];
#pragma unroll
                for (int j = 0; j < 4; ++j) acc[b][j] += sv * wv[j]; } }
#pragma unroll
        for (int b = 0; b < 4; ++b)
#pragma unroll
            for (int j = 0; j < 4; ++j) { float v = acc[b][j]; v += __shfl_xor(v, 8); v += __shfl_xor(v, 16); v += __shfl_xor(v, 32); if (kq == 0) red[(F.wave * 4 + b) * 32 + colq * 4 + j] = v; }
        __syncthreads();
        if (F.tid < 128) { const int b = F.tid >> 5, cc = F.tid & 31; float s = ada_b[task * 32 + cc];
#pragma unroll
            for (int w = 0; w < 8; ++w) s += red[(w * 4 + b) * 32 + cc];
            WSP(float, WS_MOD)[b * 6144 + task * 32 + cc] = s; }
        VM_WAIT(); __syncthreads();
        if (F.tid == 0) { __builtin_amdgcn_fence(__ATOMIC_RELEASE, "agent"); VM_WAIT(); __hip_atomic_fetch_add((unsigned*)(F.ws + WS_CTL) + CW_MODCNT, 1u, RLX_AGENT); }
    }
    const int gt = F.vcu * 512 + F.tid, NGT = F.G * 512;
    for (int idx = gt; idx < NTOK * 16; idx += NGT) { const int m = idx >> 4, i = idx & 15;
        double freq = 1.0; for (int q = 0; q < i; ++q) freq *= 0.44036660267178046;
        const double ang = (double)pos[m] * freq; const double nr = __builtin_rint(ang * 0.15915494309189535);
        const float r = (float)__builtin_fma(-nr, 6.283185307179586, ang);
        float sn, cs; sincosf(r, &sn, &cs);
        WSP(float, WS_TRIG)[m * 32 + i] = cs; WSP(float, WS_TRIG)[m * 32 + 16 + i] = sn; }
    { const float* wr = IN_F(20); for (int idx = gt; idx < 32 * 1024; idx += NGT) { const int e = idx >> 10, k = idx & 1023; const float w = wr[k * 32 + e];
        const unsigned hi = f2bf(w); const float rem = w - __builtin_bit_cast(float, hi << 16); WSP(bf16, WS_WRH)[idx] = (bf16)hi; WSP(bf16, WS_WRL)[idx] = (bf16)f2bf(rem); } }
    LAS float* scr = (LAS float*)(F.lds + 32768 + F.wave * 8704);
    const int gw = F.vcu * NWAVES + F.wave, NGW = F.G * NWAVES;
    constexpr int NITEMS = 16 * 224 + 128 + 1024 + 512;
    for (int it0 = gw; it0 < NITEMS; it0 += 3 * NGW) {
        const int it1 = it0 + NGW, it2 = it0 + 2 * NGW; const bool h1 = it1 < NITEMS, h2 = it2 < NITEMS;
        f32x4 v0[8], v1[8], v2[8];
        p0_load(p0_item(args, F.ws, it0), v0, F.lane);
        if (h1) p0_load(p0_item(args, F.ws, it1), v1, F.lane);
        if (h2) p0_load(p0_item(args, F.ws, it2), v2, F.lane);
        p0_store(p0_item(args, F.ws, it0), v0, scr, F.lane);
        if (h1) p0_store(p0_item(args, F.ws, it1), v1, scr, F.lane);
        if (h2) p0_store(p0_item(args, F.ws, it2), v2, scr, F.lane);
    }
}
struct WItem { const float* src; unsigned char* dst; int N; };
__device__ __forceinline__ WItem p8_item(const Args& args, unsigned char* ws, int it) {
    WItem w;
    if (it < 32 * 1024) { const int e = it >> 10, q = it & 1023, kb = q >> 6, nb = q & 63, n0 = nb * 32;
        const int bj = n0 >> 10, p = (n0 & 1023) >> 7, oo = n0 & 127;
        w.src = IN_F(22) + (size_t)e * 2097152 + (size_t)(kb * 64) * 2048 + n0; w.N = 2048;
        w.dst = ws + WS_WUP + (size_t)e * 2097152 + (size_t)(p * 256 + bj * 128 + oo) * 1024 + kb * 64; }
    else { const int r = it - 32 * 1024, e = r >> 9, q = r & 511, kb = q >> 5, nb = q & 31;
        w.src = IN_F(24) + (size_t)e * 1048576 + (size_t)(kb * 64) * 1024 + nb * 32; w.N = 1024;
        w.dst = ws + WS_WDN + (size_t)e * 1048576 + (size_t)(nb * 32) * 1024 + kb * 64; }
    return w;
}
__device__ __forceinline__ void p8_load(const WItem& w, f32x4 (&v)[8], int lane) {
#pragma unroll
    for (int i = 0; i < 8; ++i) v[i] = __builtin_nontemporal_load((const f32x4*)(w.src + (size_t)((lane >> 3) + 8 * i) * w.N + (lane & 7) * 4));
}
__device__ __forceinline__ void p8_store(const WItem& w, const f32x4 (&v)[8], LAS float* scr, int lane) {
#pragma unroll
    for (int i = 0; i < 8; ++i) { LAS float* d = scr + ((lane >> 3) + 8 * i) * 33 + (lane & 7) * 4; d[0] = v[i].x * 64.0f; d[1] = v[i].y * 64.0f; d[2] = v[i].z * 64.0f; d[3] = v[i].w * 64.0f; }
    LDS_WAIT(); asm volatile("" ::: "memory");
    const int c = lane & 7;
#pragma unroll
    for (int j = 0; j < 4; ++j) { const int n = (lane >> 3) + 8 * j; const LAS float* s = scr + (8 * c) * 33 + n;
        v2u o; o.x = pg8::pk_fp8x4(s[0 * 33], s[1 * 33], s[2 * 33], s[3 * 33]); o.y = pg8::pk_fp8x4(s[4 * 33], s[5 * 33], s[6 * 33], s[7 * 33]);
        __builtin_nontemporal_store(o, (v2u*)(w.dst + (size_t)n * 1024 + 8 * c)); }
    LDS_WAIT(); asm volatile("" ::: "memory");
}
constexpr int P8_ITEMS = 32 * 1024 + 32 * 512, P8_CHUNK = 128, P8_NCHUNK = P8_ITEMS / P8_CHUNK;
__device__ __forceinline__ void p8_chunk(Frame& F, const Args& args, int ch) {
    LAS float* scr = (LAS float*)(F.lds + 32768 + F.wave * 8704);
    const int it0 = ch * P8_CHUNK + F.wave * 16;
    f32x4 v0[8], v1[8], v2[8], v3[8];
    p8_load(p8_item(args, F.ws, it0), v0, F.lane); p8_load(p8_item(args, F.ws, it0 + 1), v1, F.lane); p8_load(p8_item(args, F.ws, it0 + 2), v2, F.lane); p8_load(p8_item(args, F.ws, it0 + 3), v3, F.lane);
#pragma unroll 1
    for (int j = 0; j < 16; j += 4) { const bool more = j + 4 < 16;
        p8_store(p8_item(args, F.ws, it0 + j), v0, scr, F.lane); if (more) p8_load(p8_item(args, F.ws, it0 + j + 4), v0, F.lane);
        p8_store(p8_item(args, F.ws, it0 + j + 1), v1, scr, F.lane); if (more) p8_load(p8_item(args, F.ws, it0 + j + 5), v1, F.lane);
        p8_store(p8_item(args, F.ws, it0 + j + 2), v2, scr, F.lane); if (more) p8_load(p8_item(args, F.ws, it0 + j + 6), v2, F.lane);
        p8_store(p8_item(args, F.ws, it0 + j + 3), v3, scr, F.lane); if (more) p8_load(p8_item(args, F.ws, it0 + j + 7), v3, F.lane);
    }
}
__device__ __forceinline__ void p8_moe_weights(Frame& F, const Args& args) {
    for (int ch = F.vcu; ch < P8_NCHUNK; ch += F.G) p8_chunk(F, args, ch);
}

__device__ __forceinline__ void p1_hrows(Frame& F, const Args& args) {
    if (F.tid == 0) { unsigned* mc = (unsigned*)(F.ws + WS_CTL) + CW_MODCNT; unsigned sp = 0; while (__hip_atomic_load(mc, RLX_AGENT) < 192u && ++sp < (1u << 22)) __builtin_amdgcn_s_sleep(2);
        __builtin_amdgcn_fence(__ATOMIC_ACQUIRE, "agent"); VM_WAIT(); }
    __syncthreads();
    const float* x = IN_F(0); const float* g1n = IN_F(5); const float* mod = WSP(float, WS_MOD); bf16* H = WSP(bf16, WS_HB); unsigned char* H8 = WSP(unsigned char, WS_H8);
    const int gw = F.vcu * NWAVES + F.wave, NGW = F.G * NWAVES;
    f32x4 v0[4], v1[4], n0[4], n1[4];
#define P1_LOADX(ma, mb, A, B) do { const f32x4* xa_ = (const f32x4*)(x + (size_t)(ma) * DM) + F.lane; const f32x4* xb_ = (const f32x4*)(x + (size_t)(mb) * DM) + F.lane; \
        _Pragma("unroll") for (int j_ = 0; j_ < 4; ++j_) { A[j_] = xa_[64 * j_]; B[j_] = xb_[64 * j_]; } } while (0)
    f32x4 g[4];
#pragma unroll
    for (int j = 0; j < 4; ++j) g[j] = *(const f32x4*)(g1n + 4 * F.lane + 256 * j);
    int m0 = gw;
    if (m0 < NTOK) { const int m1 = (m0 + NGW < NTOK) ? m0 + NGW : m0; P1_LOADX(m0, m1, v0, v1); }
    for (; m0 < NTOK; m0 += 2 * NGW) {
        const bool has1 = m0 + NGW < NTOK; const int m1 = has1 ? m0 + NGW : m0;
        const int b0 = m0 >> 12, b1 = m1 >> 12;
        f32x4 sh0[4], sc0[4], sh1[4], sc1[4];
#pragma unroll
        for (int j = 0; j < 4; ++j) { const int col = 4 * F.lane + 256 * j;
            sh0[j] = *(const f32x4*)(mod + b0 * 6144 + col); sc0[j] = *(const f32x4*)(mod + b0 * 6144 + 1024 + col); }
        if (b1 != b0) {
#pragma unroll
            for (int j = 0; j < 4; ++j) { const int col = 4 * F.lane + 256 * j; sh1[j] = *(const f32x4*)(mod + b1 * 6144 + col); sc1[j] = *(const f32x4*)(mod + b1 * 6144 + 1024 + col); } }
        else {
#pragma unroll
            for (int j = 0; j < 4; ++j) { sh1[j] = sh0[j]; sc1[j] = sc0[j]; } }
        const int p0 = m0 + 2 * NGW; const bool hasn = p0 < NTOK;
        if (hasn) { const int p1 = (p0 + NGW < NTOK) ? p0 + NGW : p0; P1_LOADX(p0, p1, n0, n1); }
        float s0 = 0.f, s1 = 0.f;
#pragma unroll
        for (int j = 0; j < 4; ++j) { s0 += (v0[j].x * v0[j].x + v0[j].y * v0[j].y) + (v0[j].z * v0[j].z + v0[j].w * v0[j].w); s1 += (v1[j].x * v1[j].x + v1[j].y * v1[j].y) + (v1[j].z * v1[j].z + v1[j].w * v1[j].w); }
#pragma unroll
        for (int o = 1; o < 64; o <<= 1) { s0 += __shfl_xor(s0, o); s1 += __shfl_xor(s1, o); }
        const float r0 = 1.0f / sqrtf(s0 * (1.f / DM) + EPS), r1 = 1.0f / sqrtf(s1 * (1.f / DM) + EPS);
        unsigned long long* o0 = (unsigned long long*)(H + (size_t)m0 * DM) + F.lane; unsigned long long* o1 = (unsigned long long*)(H + (size_t)m1 * DM) + F.lane;
#pragma unroll
        for (int j = 0; j < 4; ++j) {
            const f32x4 h0 = v0[j] * r0 * g[j] * (sc0[j] + 1.0f) + sh0[j], h1 = v1[j] * r1 * g[j] * (sc1[j] + 1.0f) + sh1[j];
            o0[64 * j] = (unsigned long long)cvtpk(h0.x, h0.y) | ((unsigned long long)cvtpk(h0.z, h0.w) << 32);
            ((unsigned*)(H8 + (size_t)m0 * DM))[F.lane + 64 * j] = pg8::pk_fp8x4(h0.x, h0.y, h0.z, h0.w);
            if (has1) { o1[64 * j] = (unsigned long long)cvtpk(h1.x, h1.y) | ((unsigned long long)cvtpk(h1.z, h1.w) << 32);
                ((unsigned*)(H8 + (size_t)m1 * DM))[F.lane + 64 * j] = pg8::pk_fp8x4(h1.x, h1.y, h1.z, h1.w); } }
#pragma unroll
        for (int j = 0; j < 4; ++j) { v0[j] = n0[j]; v1[j] = n1[j]; }
    }
#undef P1_LOADX
}

__device__ __forceinline__ void p3_knorm_unit(Frame& F, const Args& args, int unit) {
    const int h = unit & 7, j = (unit >> 3) & 15, b = unit >> 7;
    bf16* KR = WSP(bf16, WS_E) + 3 * E_STRIDE; const float* trig = WSP(float, WS_TRIG); const float* kg = IN_F(16);
    const int rsub = F.lane >> 4, c16 = F.lane & 15;
    float gk[8];
#pragma unroll
    for (int i = 0; i < 8; ++i) gk[i] = kg[c16 * 8 + i];
    float km[8];
#pragma unroll
    for (int i = 0; i < 8; ++i) km[i] = 0.f;
    const int fi = (c16 & 1) * 8;
    v4u raw[2][4]; f32x4 tcs[2][4][4]; v4u outp[4];
#define KN_LOAD(bt_) do { _Pragma("unroll") for (int i4 = 0; i4 < 4; ++i4) { const int m_ = b * SEQ + j * 256 + F.wave * 32 + ((bt_) * 4 + i4) * 4 + rsub; \
        raw[bt_][i4] = *(const v4u*)(KR + (size_t)m_ * DM + h * HD + c16 * 8); const float* tp_ = trig + (size_t)m_ * 32 + fi; \
        tcs[bt_][i4][0] = *(const f32x4*)tp_; tcs[bt_][i4][1] = *(const f32x4*)(tp_ + 4); tcs[bt_][i4][2] = *(const f32x4*)(tp_ + 16); tcs[bt_][i4][3] = *(const f32x4*)(tp_ + 20); } } while (0)
    KN_LOAD(0); KN_LOAD(1);
#pragma unroll
    for (int bt = 0; bt < 2; ++bt) {
#pragma unroll
        for (int i4 = 0; i4 < 4; ++i4) {
            float v[8] = {bflo(raw[bt][i4].x), bfhi(raw[bt][i4].x), bflo(raw[bt][i4].y), bfhi(raw[bt][i4].y), bflo(raw[bt][i4].z), bfhi(raw[bt][i4].z), bflo(raw[bt][i4].w), bfhi(raw[bt][i4].w)};
            float ss = 0.f;
#pragma unroll
            for (int i = 0; i < 8; ++i) ss += v[i] * v[i];
            ss += __shfl_xor(ss, 1); ss += __shfl_xor(ss, 2); ss += __shfl_xor(ss, 4); ss += __shfl_xor(ss, 8);
            const float rstd = 1.0f / sqrtf(ss * (1.f / HD) + EPS);
#pragma unroll
            for (int i = 0; i < 8; ++i) v[i] = v[i] * rstd * gk[i];
#pragma unroll
            for (int i = 0; i < 8; ++i) { const float other = __shfl_xor(v[i], 2); const float cs = tcs[bt][i4][i >> 2][i & 3], sn = tcs[bt][i4][2 + (i >> 2)][i & 3];
                if (c16 < 4) v[i] = (c16 < 2) ? (v[i] * cs - other * sn) : (v[i] * cs + other * sn); }
#pragma unroll
            for (int i = 0; i < 8; ++i) km[i] += v[i];
            outp[i4].x = cvtpk(v[0], v[1]); outp[i4].y = cvtpk(v[2], v[3]); outp[i4].z = cvtpk(v[4], v[5]); outp[i4].w = cvtpk(v[6], v[7]); }
#pragma unroll
        for (int i4 = 0; i4 < 4; ++i4) { const int m = b * SEQ + j * 256 + F.wave * 32 + (bt * 4 + i4) * 4 + rsub; *(v4u*)(KR + (size_t)m * DM + h * HD + c16 * 8) = outp[i4]; }
    }
#undef KN_LOAD
    LAS float* red = (LAS float*)(F.lds + XTRA_OFF);
#pragma unroll
    for (int i = 0; i < 8; ++i) { float v = km[i]; v += __shfl_xor(v, 16); v += __shfl_xor(v, 32); if (rsub == 0) red[F.wave * 128 + c16 * 8 + i] = v; }
    __syncthreads();
    if (F.tid < 128) { float s = 0.f;
#pragma unroll
        for (int w = 0; w < 8; ++w) s += red[w * 128 + F.tid];
        WSP(float, WS_KMEAN)[((size_t)(b * NH + h) * 16 + j) * HD + F.tid] = s * (1.f / 256.f); }
    __syncthreads();
}

__device__ __forceinline__ void p3_rnn_local_unit(Frame& F, const Args& args, int unit) {
    const int n = unit & 7, c = (unit >> 3) & 15, b = unit >> 7;
    const int t0 = c * 256, m0 = b * SEQ + t0, ch0 = n * 128;
    const bf16* XR = WSP(bf16, WS_E);
    LAS unsigned char* At = F.lds;
    const int fr = F.lane & 15, fq = F.lane >> 4;
    const int vloc = F.wave * 16 + fr, ch = ch0 + vloc;
    const bf16* WA = WSP(bf16, WS_WRG) + (size_t)n * 16384 + (size_t)vloc * 128 + fq * 8;
    const bf16* WX = WA + 8 * 16384;
    bf16x8 Ba[4], Bx[4];
#pragma unroll
    for (int s = 0; s < 4; ++s) { Ba[s] = *(const bf16x8*)(WA + 32 * s); Bx[s] = *(const bf16x8*)(WX + 32 * s); }
    const float ba = IN_F(11)[ch], bx = IN_F(13)[ch];
    const float sp8 = 8.0f * log1pf(expf(-IN_F(14)[ch]));
    {
        const int cg = F.tid & 15, rs = F.tid >> 4; const int chb = ch0 + cg * 8;
        const float* cw = IN_F(8); const float* cb = IN_F(9);
        float w0[8], w1[8], w2[8], w3[8], bb[8];
#pragma unroll
        for (int i = 0; i < 8; i += 4) { const f32x4 a0 = *(const f32x4*)(cw + chb + i), a1 = *(const f32x4*)(cw + 1024 + chb + i), a2 = *(const f32x4*)(cw + 2048 + chb + i), a3 = *(const f32x4*)(cw + 3072 + chb + i), ab = *(const f32x4*)(cb + chb + i);
#pragma unroll
            for (int j = 0; j < 4; ++j) { w0[i + j] = a0[j]; w1[i + j] = a1[j]; w2[i + j] = a2[j]; w3[i + j] = a3[j]; bb[i + j] = ab[j]; } }
        const int tr0 = t0 + rs * 8;
        v4u rw[11];
#pragma unroll
        for (int r = 0; r < 11; ++r) { const int tt = tr0 - 3 + r; rw[r] = *(const v4u*)(XR + (size_t)(b * SEQ + (tt < 0 ? 0 : tt)) * DM + chb); if (tt < 0) rw[r] = (v4u){0u, 0u, 0u, 0u}; }
#define UNP(dst, w_) do { dst[0] = bflo(w_.x); dst[1] = bfhi(w_.x); dst[2] = bflo(w_.y); dst[3] = bfhi(w_.y); dst[4] = bflo(w_.z); dst[5] = bfhi(w_.z); dst[6] = bflo(w_.w); dst[7] = bfhi(w_.w); } while (0)
        float p1[8], p2[8], p3[8];
        UNP(p3, rw[0]); UNP(p2, rw[1]); UNP(p1, rw[2]);
#pragma unroll
        for (int r = 0; r < 8; ++r) { float cur[8]; UNP(cur, rw[3 + r]);
            float xc[8];
#pragma unroll
            for (int i = 0; i < 8; ++i) xc[i] = bb[i] + w0[i] * cur[i] + w1[i] * p1[i] + w2[i] * p2[i] + w3[i] * p3[i];
            const int row = rs * 8 + r;
            v4u o; o.x = cvtpk(xc[0], xc[1]); o.y = cvtpk(xc[2], xc[3]); o.z = cvtpk(xc[4], xc[5]); o.w = cvtpk(xc[6], xc[7]);
            *(LAS v4u*)(At + row * 256 + ((cg ^ (row & 15)) << 4)) = o;
#pragma unroll
            for (int i = 0; i < 8; ++i) { p3[i] = p2[i]; p2[i] = p1[i]; p1[i] = cur[i]; } }
#undef UNP
    }
    __syncthreads();
    float cP = 1.f, cH = 0.f;
    bf16* HL = WSP(bf16, WS_HL); bf16* PP = WSP(bf16, WS_PP);
    LAS unsigned short* stg = (LAS unsigned short*)(F.lds + 65536);
    for (int rq = 0; rq < 4; ++rq) {
        LAS unsigned short* sb = stg + (rq & 1) * 16384;
#pragma unroll
        for (int ri = 0; ri < 4; ++ri) { const int rt = rq * 4 + ri;
            f32x4 accr = {0.f, 0.f, 0.f, 0.f}, accx = {0.f, 0.f, 0.f, 0.f};
            const int arow = rt * 16 + fr;
#pragma unroll
            for (int s = 0; s < 4; ++s) { const bf16x8 a = *(const LAS bf16x8*)(At + arow * 256 + (((fq + 4 * s) ^ (arow & 15)) << 4));
                accr = __builtin_amdgcn_mfma_f32_16x16x32_bf16(a, Ba[s], accr, 0, 0, 0);
                accx = __builtin_amdgcn_mfma_f32_16x16x32_bf16(a, Bx[s], accx, 0, 0, 0); }
            float pj[4], hj[4];
#pragma unroll
            for (int j = 0; j < 4; ++j) { const int row = rt * 16 + 4 * fq + j;
                const float xcv = bf2f(*(const LAS unsigned short*)(At + row * 256 + ((((vloc >> 3)) ^ (row & 15)) << 4) + (vloc & 7) * 2));
                const float r = fast_sigmoid(accr[j] + ba), ig = fast_sigmoid(accx[j] + bx);
                const float a = __builtin_amdgcn_exp2f(-sp8 * r * 1.4426950408889634f);
                float mult = __builtin_amdgcn_sqrtf(fmaxf(fmaf(-a, a, 1.0f), 0.0f)); if (t0 + row == 0) mult = 1.0f;
                const float u = mult * ig * xcv;
                pj[j] = (j ? pj[j - 1] : 1.0f) * a; hj[j] = (j ? hj[j - 1] * a : 0.0f) + u; }
            const float tp = pj[3], th = hj[3];
            const float pa = __shfl(tp, F.lane - 16), ha = __shfl(th, F.lane - 16);
            const float pb = __shfl(tp, F.lane - 32), hb = __shfl(th, F.lane - 32);
            const float pc = __shfl(tp, F.lane - 48), hc = __shfl(th, F.lane - 48);
            float Pq, Hq;
            if (fq == 0) { Pq = 1.f; Hq = 0.f; } else if (fq == 1) { Pq = pa; Hq = ha; } else if (fq == 2) { Pq = pb * pa; Hq = pa * hb + ha; } else { Pq = pc * pb * pa; Hq = pa * (pb * hc + hb) + ha; }
            const float hstart = Hq + Pq * cH, pstart = Pq * cP;
            float hl3 = 0.f, pp3 = 0.f;
#pragma unroll
            for (int j = 0; j < 4; ++j) { const float hv = hj[j] + pj[j] * hstart, pv = pj[j] * pstart; const int rl = ri * 16 + 4 * fq + j;
                const unsigned pk = cvtpk(hv, pv); sb[rl * 128 + vloc] = (unsigned short)pk; sb[8192 + rl * 128 + vloc] = (unsigned short)(pk >> 16); if (j == 3) { hl3 = hv; pp3 = pv; } }
            cH = __shfl(hl3, fr + 48); cP = __shfl(pp3, fr + 48);
        }
        __syncthreads();
#pragma unroll
        for (int q4 = 0; q4 < 4; ++q4) { const int idx = q4 * 512 + F.tid, arr = idx >> 10, rr = (idx >> 4) & 63, c16 = idx & 15;
            const v4u val = *(const LAS v4u*)(sb + arr * 8192 + rr * 128 + c16 * 8);
            bf16* dst = (arr ? PP : HL) + (size_t)(m0 + rq * 64 + rr) * DM + ch0 + c16 * 8;
            *(v4u*)dst = val; }
    }
    if (fq == 0) { WSP(float, WS_AGGP)[(size_t)(b * 16 + c) * 1024 + ch] = cP; WSP(float, WS_AGGH)[(size_t)(b * 16 + c) * 1024 + ch] = cH; }
    __syncthreads();
}

__device__ __forceinline__ void p4_rnn_final_unit(Frame& F, const Args& args, int unit) {
    const int n = unit & 7, c = (unit >> 3) & 15, b = unit >> 7;
    const int m0 = b * SEQ + c * 256, ch0 = n * 128;
    LAS float* car = (LAS float*)(F.lds + XTRA_OFF);
    if (F.tid < 128) { const int ch = ch0 + F.tid; float h = 0.f;
        for (int cc = 0; cc < c; ++cc) { const float p = WSP(float, WS_AGGP)[(size_t)(b * 16 + cc) * 1024 + ch], hh = WSP(float, WS_AGGH)[(size_t)(b * 16 + cc) * 1024 + ch]; h = p * h + hh; }
        car[F.tid] = h; }
    __syncthreads();
    const bf16* HL = WSP(bf16, WS_HL); const bf16* PP = WSP(bf16, WS_PP); const bf16* GG = WSP(bf16, WS_E) + E_STRIDE; bf16* Y = WSP(bf16, WS_YCAT);
    const int c16 = F.tid & 15, r0 = F.tid >> 4;
    float cv[8];
#pragma unroll
    for (int i = 0; i < 8; ++i) cv[i] = car[c16 * 8 + i];
    v4u hl[8], pp[8], gg[8];
#pragma unroll
    for (int it = 0; it < 8; ++it) { const size_t o = (size_t)(m0 + it * 32 + r0) * DM + ch0 + c16 * 8; hl[it] = *(const v4u*)(HL + o); pp[it] = *(const v4u*)(PP + o); gg[it] = *(const v4u*)(GG + o); }
#pragma unroll
    for (int it = 0; it < 8; ++it) { const size_t oy = (size_t)(m0 + it * 32 + r0) * 2048 + ch0 + c16 * 8;
        v4u y;
        y.x = cvtpk((bflo(hl[it].x) + bflo(pp[it].x) * cv[0]) * bflo(gg[it].x), (bfhi(hl[it].x) + bfhi(pp[it].x) * cv[1]) * bfhi(gg[it].x));
        y.y = cvtpk((bflo(hl[it].y) + bflo(pp[it].y) * cv[2]) * bflo(gg[it].y), (bfhi(hl[it].y) + bfhi(pp[it].y) * cv[3]) * bfhi(gg[it].y));
        y.z = cvtpk((bflo(hl[it].z) + bflo(pp[it].z) * cv[4]) * bflo(gg[it].z), (bfhi(hl[it].z) + bfhi(pp[it].z) * cv[5]) * bfhi(gg[it].z));
        y.w = cvtpk((bflo(hl[it].w) + bflo(pp[it].w) * cv[6]) * bflo(gg[it].w), (bfhi(hl[it].w) + bfhi(pp[it].w) * cv[7]) * bfhi(gg[it].w));
        *(v4u*)(Y + oy) = y; }
    __syncthreads();
}

namespace att {
#ifndef XPRIO
#define XPRIO 0
#define YPRIO 1
#endif
constexpr int KVBLK = 64, SHM_K = KVBLK * HD * 2, SHM_V = SHM_K;
constexpr float C2 = 0.08838834764831845f * 1.4426950408889634f;
#define KSWZ(row, colB) ((row) * 256 + ((colB) ^ (((row) & 7) << 4)))
__device__ __forceinline__ int v_st(int k, int c) { const int kk = (k & ~0xC) | ((k & 4) << 1) | ((k & 8) >> 1); return ((kk >> 3) * 4 + (c >> 5)) * 512 + ((kk & 7) * 32 + (c & 31)) * 2; }
__device__ __forceinline__ int v_rd_base(int lane) { return ((lane & 3) << 3) | (((lane >> 2) & 3) << 6) | (((lane >> 4) & 1) << 5) | (((lane >> 5) & 1) << 8); }
constexpr int v_rd_off(int d0, int ks, int half) { return d0 * 512 + ks * 4096 + half * 2048; }
__device__ __forceinline__ int crow(int r, int hi) { return (r & 3) + 8 * (r >> 2) + 4 * hi; }

#define RD128(dst, addr, off) asm volatile("ds_read_b128 %0, %1 offset:%2" : "=&v"(dst) : "v"(addr), "i"(off) : "memory")
#define TRRD(dst, addr, off) asm volatile("ds_read_b64_tr_b16 %0, %1 offset:%2" : "=&v"(dst) : "v"(addr), "i"(off) : "memory")
#define XWAIT(n, U) asm volatile("s_waitcnt lgkmcnt(" #n ")" : "+v"(U[0]), "+v"(U[1]), "+v"(U[2]), "+v"(U[3]) :: "memory")
template <int KB, int VB, int MODE>
__device__ __forceinline__ void xphase(f32x16& p0, f32x16& p1, f32x16* o, const bf16x8* q, const int* ka, int vb0, bf16x8 pa0, bf16x8 pa1, bf16x8 pa2, bf16x8 pa3) {
    v4u ku[4][4]; s16x4 vu[8][4];
    __builtin_amdgcn_s_setprio(XPRIO);
#define RK(g) do { constexpr int o_ = 2 * SHM_V + KB * SHM_K + ((g) >> 1) * 128; \
        RD128(ku[g][0], ka[(2 * (g)) & 3], o_); RD128(ku[g][1], ka[(2 * (g)) & 3], o_ + 8192); RD128(ku[g][2], ka[(2 * (g) + 1) & 3], o_); RD128(ku[g][3], ka[(2 * (g) + 1) & 3], o_ + 8192); } while (0)
#define KF(g, j) (*reinterpret_cast<const bf16x8*>(&ku[g][j]))
#define MK(g) do { if constexpr ((g) == 0) { p0 = __builtin_amdgcn_mfma_f32_32x32x16_bf16(KF(g, 0), q[2 * (g)], f32x16{}, 0, 0, 0); p1 = __builtin_amdgcn_mfma_f32_32x32x16_bf16(KF(g, 1), q[2 * (g)], f32x16{}, 0, 0, 0); } \
        else { p0 = __builtin_amdgcn_mfma_f32_32x32x16_bf16(KF(g, 0), q[2 * (g)], p0, 0, 0, 0); p1 = __builtin_amdgcn_mfma_f32_32x32x16_bf16(KF(g, 1), q[2 * (g)], p1, 0, 0, 0); } \
        p0 = __builtin_amdgcn_mfma_f32_32x32x16_bf16(KF(g, 2), q[2 * (g) + 1], p0, 0, 0, 0); p1 = __builtin_amdgcn_mfma_f32_32x32x16_bf16(KF(g, 3), q[2 * (g) + 1], p1, 0, 0, 0); } while (0)
#define RV(u) do { constexpr int o_ = VB * SHM_V + ((u) & 1) * 1024 + ((u) >> 1) * 4096; \
        TRRD(vu[u][0], vb0, o_); TRRD(vu[u][1], vb0, o_ + 2048); TRRD(vu[u][2], vb0, o_ + 512); TRRD(vu[u][3], vb0, o_ + 512 + 2048); } while (0)
#define VF(u, j) ((bf16x8){vu[u][j][0], vu[u][j][1], vu[u][j][2], vu[u][j][3], vu[u][j + 1][0], vu[u][j + 1][1], vu[u][j + 1][2], vu[u][j + 1][3]})
#define MV(u, PA) do { o[((u) & 1) * 2] = __builtin_amdgcn_mfma_f32_32x32x16_bf16(PA, VF(u, 0), o[((u) & 1) * 2], 0, 0, 0); o[((u) & 1) * 2 + 1] = __builtin_amdgcn_mfma_f32_32x32x16_bf16(PA, VF(u, 2), o[((u) & 1) * 2 + 1], 0, 0, 0); } while (0)
    if constexpr (MODE == 3) {
        RK(0); RK(1);
        XWAIT(4, ku[0]); MK(0); RK(2);
        XWAIT(4, ku[1]); MK(1); RK(3);
        XWAIT(4, ku[2]); MK(2); RV(0); RV(1);
        XWAIT(8, ku[3]); MK(3); RV(2);
        XWAIT(8, vu[0]); MV(0, pa0); RV(3);
        XWAIT(8, vu[1]); MV(1, pa0); RV(4);
        XWAIT(8, vu[2]); MV(2, pa1); RV(5);
        XWAIT(8, vu[3]); MV(3, pa1); RV(6);
        XWAIT(8, vu[4]); MV(4, pa2); RV(7);
        XWAIT(8, vu[5]); MV(5, pa2);
        XWAIT(4, vu[6]); MV(6, pa3);
        XWAIT(0, vu[7]); MV(7, pa3);
    } else if constexpr (MODE == 1) {
        RK(0); RK(1);
        XWAIT(4, ku[0]); MK(0); RK(2);
        XWAIT(4, ku[1]); MK(1); RK(3);
        XWAIT(4, ku[2]); MK(2);
        XWAIT(0, ku[3]); MK(3);
    } else {
        RV(0); RV(1); RV(2);
        XWAIT(8, vu[0]); MV(0, pa0); RV(3);
        XWAIT(8, vu[1]); MV(1, pa0); RV(4);
        XWAIT(8, vu[2]); MV(2, pa1); RV(5);
        XWAIT(8, vu[3]); MV(3, pa1); RV(6);
        XWAIT(8, vu[4]); MV(4, pa2); RV(7);
        XWAIT(8, vu[5]); MV(5, pa2);
        XWAIT(4, vu[6]); MV(6, pa3);
        XWAIT(0, vu[7]); MV(7, pa3);
    }
    __builtin_amdgcn_s_setprio(YPRIO);
#undef RK
#undef KF
#undef MK
#undef RV
#undef VF
#undef MV
}
#undef RD128
#undef TRRD
#undef XWAIT
__device__ __forceinline__ void sm_a(f32x16& p0) {
#pragma unroll
    for (int r = 0; r < 16; ++r) p0[r] = __builtin_amdgcn_exp2f(p0[r]);
}
__device__ __forceinline__ void sm_b(f32x16& p0, f32x16& p1, float& l_reg, bf16x8& pa0, bf16x8& pa1, bf16x8& pa2, bf16x8& pa3) {
#pragma unroll
    for (int r = 0; r < 16; ++r) p1[r] = __builtin_amdgcn_exp2f(p1[r]);
    float ps = 0;
#pragma unroll
    for (int r = 0; r < 16; ++r) ps += p0[r];
#pragma unroll
    for (int r = 0; r < 16; ++r) ps += p1[r];
    l_reg += ps;
#define PK4(P, B_, OUT) do { unsigned a0 = cvtpk(P[B_+0], P[B_+1]), a1 = cvtpk(P[B_+2], P[B_+3]); \
        unsigned b0 = cvtpk(P[B_+4], P[B_+5]), b1 = cvtpk(P[B_+6], P[B_+7]); \
        auto r0 = __builtin_amdgcn_permlane32_swap(a0, b0, false, false); auto r1 = __builtin_amdgcn_permlane32_swap(a1, b1, false, false); \
        v4u w = {r0[0], r1[0], r0[1], r1[1]}; OUT = *reinterpret_cast<bf16x8*>(&w); } while (0)
    PK4(p0, 0, pa0); PK4(p0, 8, pa1); PK4(p1, 0, pa2); PK4(p1, 8, pa3);
#undef PK4
}

__device__ __forceinline__ void attn_unit(Frame& F, const Args& args, int b, int h, int iq) {
#if defined(PROBE_B) && PROBE_B >= 10
    unsigned tacc = 0, tlast = (unsigned)__builtin_amdgcn_s_memrealtime();
#define TP(k) do { const unsigned now_ = (unsigned)__builtin_amdgcn_s_memrealtime(); if ((k) == PROBE_B - 10 || (PROBE_B == 16 && (k) <= 3) || PROBE_B == 17) tacc += now_ - tlast; tlast = now_; } while (0)
#else
#define TP(k) do { } while (0)
#endif
    int tid = F.tid; asm volatile("" : "+v"(tid));
    const int wid = F.wave, lane = tid & 63, r32 = lane & 31, hi = lane >> 5;
    char* lds = F.ldsg;
    char* V_lds = lds; char* K_lds = lds + 2 * SHM_V;
    float* kml = (float*)(lds + XTRA_OFF);
    constexpr int KMS = 132;
    const bf16* QR = WSP(bf16, WS_E) + 2 * E_STRIDE; const bf16* KN = WSP(bf16, WS_E) + 3 * E_STRIDE; const bf16* VV = WSP(bf16, WS_E) + 4 * E_STRIDE;
    bf16* YA = WSP(bf16, WS_YCAT) + 1024;
    const size_t mb = (size_t)b * SEQ;
    const int q0 = iq * 256, NT = 4 * (iq + 1);
    const bf16* Kh = KN + mb * DM + h * HD; const bf16* Vh = VV + mb * DM + h * HD;
    { const float* kmg = WSP(float, WS_KMEAN) + (size_t)(b * NH + h) * 16 * HD; for (int idx = tid; idx < iq * HD; idx += 512) kml[(idx >> 7) * KMS + (idx & 127)] = kmg[idx]; }
    const int vb0 = (int)(uintptr_t)V_lds + v_rd_base(lane);
    unsigned koff[2], voff[2];
#pragma unroll
    for (int jq = 0; jq < 2; ++jq) { const int p = (2 * wid + jq) * 64 + lane;
        { const int row = p >> 4, c = (p & 15) ^ (row & 7); koff[jq] = (unsigned)(row * DM + c * 8) * 2u; }
        { const int st = p >> 5, idx = p & 31, kk = (st >> 2) * 8 + (idx >> 2), col = (st & 3) * 32 + (idx & 3) * 8, k = (kk & ~0xC) | ((kk & 4) << 1) | ((kk & 8) >> 1); voff[jq] = (unsigned)(k * DM + col) * 2u; } }
#define DMA_K(t, bf) do { _Pragma("unroll") for (int jq_ = 0; jq_ < 2; ++jq_) __builtin_amdgcn_global_load_lds((const unsigned*)((const char*)(Kh + (size_t)(t) * 64 * DM) + koff[jq_]), (LAS unsigned*)(F.lds + 2 * SHM_V + (bf) * SHM_K + (2 * wid + jq_) * 1024), 16, 0, 0); } while (0)
#define DMA_V(t, bf) do { _Pragma("unroll") for (int jq_ = 0; jq_ < 2; ++jq_) __builtin_amdgcn_global_load_lds((const unsigned*)((const char*)(Vh + (size_t)(t) * 64 * DM) + voff[jq_]), (LAS unsigned*)(F.lds + (bf) * SHM_V + (2 * wid + jq_) * 1024), 16, 0, 0); } while (0)
    DMA_K(0, 0); DMA_V(0, 0);
    const size_t mq = mb + q0 + wid * 32 + r32;
    unsigned selmask; bf16x8 qr[8];
    {
        const bf16* qp = QR + mq * DM + h * HD + hi * 8;
        v4u raw[8];
#pragma unroll
        for (int d0 = 0; d0 < 8; ++d0) raw[d0] = *(const v4u*)(qp + d0 * 16);
        float ss = 0.f;
#pragma unroll
        for (int d0 = 0; d0 < 8; ++d0) { const float a0 = bflo(raw[d0].x), a1 = bfhi(raw[d0].x), a2 = bflo(raw[d0].y), a3 = bfhi(raw[d0].y), a4 = bflo(raw[d0].z), a5 = bfhi(raw[d0].z), a6 = bflo(raw[d0].w), a7 = bfhi(raw[d0].w);
            ss += (a0 * a0 + a1 * a1) + (a2 * a2 + a3 * a3) + (a4 * a4 + a5 * a5) + (a6 * a6 + a7 * a7); }
        ss += __shfl_xor(ss, 32);
        const float rs = C2 / sqrtf(ss * (1.f / HD) + EPS);
        const float* qg = IN_F(15) + hi * 8;
#define UNPK(f, W_) do { const v4u t_ = (W_); f[0] = bflo(t_.x); f[1] = bfhi(t_.x); f[2] = bflo(t_.y); f[3] = bfhi(t_.y); f[4] = bflo(t_.z); f[5] = bfhi(t_.z); f[6] = bflo(t_.w); f[7] = bfhi(t_.w); } while (0)
#define PACK(f) ({ v4u w_; w_.x = cvtpk(f[0], f[1]); w_.y = cvtpk(f[2], f[3]); w_.z = cvtpk(f[4], f[5]); w_.w = cvtpk(f[6], f[7]); *reinterpret_cast<bf16x8*>(&w_); })
        { float f0[8], f1[8]; UNPK(f0, raw[0]); UNPK(f1, raw[1]);
          const float* tg = WSP(float, WS_TRIG) + mq * 32 + hi * 8;
#pragma unroll
          for (int j = 0; j < 8; ++j) { const float x1 = f0[j] * rs * qg[j], x2 = f1[j] * rs * qg[16 + j], cs = tg[j], sn = tg[16 + j]; f0[j] = x1 * cs - x2 * sn; f1[j] = x2 * cs + x1 * sn; }
          qr[0] = PACK(f0); qr[1] = PACK(f1); }
#pragma unroll
        for (int d0 = 2; d0 < 8; ++d0) { float f[8]; UNPK(f, raw[d0]);
#pragma unroll
            for (int j = 0; j < 8; ++j) f[j] *= rs * qg[d0 * 16 + j];
            qr[d0] = PACK(f); }
        __syncthreads();
        float v1 = -__builtin_inff(), v2 = v1, v3 = v1; int i1 = 0, i2 = 0, i3 = 0;
        {
            f32x16 g = {};
            const float* km = kml + r32 * KMS + hi * 8; const bool rowok = r32 < iq;
#pragma unroll
            for (int d0 = 0; d0 < 8; ++d0) {
                f32x4 k0 = {0.f, 0.f, 0.f, 0.f}, k1 = k0;
                if (rowok) { k0 = *(const f32x4*)(km + d0 * 16); k1 = *(const f32x4*)(km + d0 * 16 + 4); }
                v4u h, l;
                h.x = cvtpk(k0[0], k0[1]); h.y = cvtpk(k0[2], k0[3]); h.z = cvtpk(k1[0], k1[1]); h.w = cvtpk(k1[2], k1[3]);
                l.x = cvtpk(k0[0] - bflo(h.x), k0[1] - bfhi(h.x)); l.y = cvtpk(k0[2] - bflo(h.y), k0[3] - bfhi(h.y)); l.z = cvtpk(k1[0] - bflo(h.z), k1[1] - bfhi(h.z)); l.w = cvtpk(k1[2] - bflo(h.w), k1[3] - bfhi(h.w));
                g = __builtin_amdgcn_mfma_f32_32x32x16_bf16(*reinterpret_cast<bf16x8*>(&h), qr[d0], g, 0, 0, 0);
                g = __builtin_amdgcn_mfma_f32_32x32x16_bf16(*reinterpret_cast<bf16x8*>(&l), qr[d0], g, 0, 0, 0); }
#define INS(val, idx) do { const float g_ = (val); const int j_ = (idx); \
                if (g_ > v1) { v3 = v2; i3 = i2; v2 = v1; i2 = i1; v1 = g_; i1 = j_; } else if (g_ > v2) { v3 = v2; i3 = i2; v2 = g_; i2 = j_; } else if (g_ > v3) { v3 = g_; i3 = j_; } } while (0)
#pragma unroll
            for (int r = 0; r < 8; ++r) { const int jb = (r & 3) + 8 * (r >> 2) + 4 * hi; INS(jb < iq ? g[r] : -__builtin_inff(), jb); }
            const float w1 = __shfl_xor(v1, 32), w2 = __shfl_xor(v2, 32), w3 = __shfl_xor(v3, 32); const int j1 = __shfl_xor(i1, 32), j2 = __shfl_xor(i2, 32), j3 = __shfl_xor(i3, 32);
            INS(w1, j1); INS(w2, j2); INS(w3, j3);
#undef INS
        }
#undef UNPK
#undef PACK
        selmask = 0u; if (iq >= 1) selmask |= 1u << i1; if (iq >= 2) selmask |= 1u << i2; if (iq >= 3) selmask |= 1u << i3;
    }
    float l_reg = 0.f; f32x16 o[4] = {};
    const int wrow0 = wid * 32;
#define ACT(t) (((t) >> 2) < iq ? (__ballot((selmask >> ((t) >> 2)) & 1u) != 0ull) : ((((t) - 4 * iq) * 64) <= wrow0 + 31))
#define MASKT(P0_, P1_, t) do { const int blk_ = (t) >> 2; const float NEG_ = -__builtin_inff(); \
        if (blk_ < iq) { if (!((selmask >> blk_) & 1u)) { _Pragma("unroll") for (int r = 0; r < 16; ++r) { P0_[r] = NEG_; P1_[r] = NEG_; } } } \
        else { const int kb_ = ((t) - 4 * iq) * 64; if (kb_ + 63 > wrow0) { int dq_ = wrow0 + r32 - kb_ - 4 * hi; asm volatile("" : "+v"(dq_)); \
            _Pragma("unroll") for (int r = 0; r < 16; ++r) { const int c_ = (r & 3) + 8 * (r >> 2); if (c_ > dq_) P0_[r] = NEG_; if (c_ + 32 > dq_) P1_[r] = NEG_; } } } } while (0)
    f32x16 p0, p1; bf16x8 pa0 = {}, pa1 = {}, pa2 = {}, pa3 = {};
    int ka[4];
#pragma unroll
    for (int dd = 0; dd < 4; ++dd) ka[dd] = (int)(uintptr_t)lds + KSWZ(r32, dd * 32 + hi * 16);
    const int grp = wid >> 2;
#define BAR() do { asm volatile("" ::: "memory"); __builtin_amdgcn_s_barrier(); asm volatile("" ::: "memory"); } while (0)
#define ISSUE_E(t) do { DMA_K((t) + 1, 1); DMA_V((t), 0); } while (0)
#define ISSUE_O(t) do { if ((t) + 1 < NT) DMA_K((t) + 1, 0); DMA_V((t), 1); } while (0)
#define YPH(t) do { MASKT(p0, p1, (t)); sm_a(p0); sm_b(p0, p1, l_reg, pa0, pa1, pa2, pa3); } while (0)
    VM_WAIT(); __syncthreads();
    if (grp) { ISSUE_E(0); BAR(); }
    if (!grp) ISSUE_E(0);
    xphase<0, 1, 1>(p0, p1, o, qr, ka, vb0, pa0, pa1, pa2, pa3);
    if (grp) VM_WAIT();
    BAR();
    if (grp) ISSUE_O(1);
    YPH(0);
    if (!grp) VM_WAIT();
    BAR();
    TP(4);
    for (int t = 1; t + 1 < NT; t += 2) {
        if (!grp) ISSUE_O(t);
        xphase<1, 0, 3>(p0, p1, o, qr, ka, vb0, pa0, pa1, pa2, pa3);
        TP(0);
        if (grp) VM_WAIT();
        BAR();
        TP(1);
        if (grp) ISSUE_E(t + 1);
        YPH(t);
        TP(2);
        if (!grp) VM_WAIT();
        BAR();
        TP(3);
        if (!grp) ISSUE_E(t + 1);
        xphase<0, 1, 3>(p0, p1, o, qr, ka, vb0, pa0, pa1, pa2, pa3);
        TP(0);
        if (grp) VM_WAIT();
        BAR();
        TP(1);
        if (grp) ISSUE_O(t + 2);
        YPH(t + 1);
        TP(2);
        if (!grp) VM_WAIT();
        BAR();
        TP(3);
    }
    if (!grp) ISSUE_O(NT - 1);
    xphase<1, 0, 3>(p0, p1, o, qr, ka, vb0, pa0, pa1, pa2, pa3);
    if (grp) VM_WAIT();
    BAR();
    YPH(NT - 1);
    if (!grp) VM_WAIT();
    BAR();
    xphase<0, 1, 2>(p0, p1, o, qr, ka, vb0, pa0, pa1, pa2, pa3);
    BAR();
    if (!grp) BAR();
#undef YPH
#undef ISSUE_E
#undef ISSUE_O
#undef BAR
#undef DMA_K
#undef DMA_V
    l_reg += __shfl_xor(l_reg, 32);
    float* li_l = (float*)(lds + XTRA_OFF + 8192) + wid * 32;
    if (hi == 0) li_l[r32] = l_reg;
    asm volatile("s_waitcnt lgkmcnt(0)" ::: "memory");
    float rli[16];
#pragma unroll
    for (int r = 0; r < 16; ++r) rli[r] = __builtin_amdgcn_rcpf(li_l[crow(r, hi)]);
    { unsigned short* stg = (unsigned short*)(lds + wid * 8192);
#pragma unroll
      for (int r = 0; r < 16; ++r) { const int orow = crow(r, hi);
#pragma unroll
          for (int d0 = 0; d0 < 4; ++d0) stg[orow * 128 + d0 * 32 + r32] = (unsigned short)f2bf(o[d0][r] * rli[r]); }
      asm volatile("s_waitcnt lgkmcnt(0)" ::: "memory");
      bf16* Ow = YA + (mb + q0 + wid * 32) * 2048 + h * HD;
#pragma unroll
      for (int i = 0; i < 8; ++i) { const int row = i * 4 + (lane >> 4), ch = lane & 15; const v4u v = *(const v4u*)(stg + row * 128 + ch * 8); *(v4u*)(Ow + (size_t)row * 2048 + ch * 8) = v; } }
    __syncthreads();
#if defined(PROBE_B) && PROBE_B >= 10
    TP(5);
    if (F.tid == 0) F.MISC[17] = F.MISC[17] + tacc;
#endif
#undef TP
#undef ACT
#undef MASKT
}
#undef KSWZ
}

__device__ __forceinline__ void p7_router(Frame& F, const Args& args) {
    LAS float* ssq = (LAS float*)F.lds;
    LAS float* par = (LAS float*)(F.lds + 2048);
    LAS float* lg = (LAS float*)(F.lds + 10240);
    LAS int* hist = (LAS int*)(F.lds + 77824 + 2048);
    LAS int* sel = (LAS int*)(F.lds + 77824 + 4096);
    const float* g2n = IN_F(6); const float* mod = WSP(float, WS_MOD); const float* brt = IN_F(21);
    unsigned char* H2 = WSP(unsigned char, WS_HB);
    const float* xin = IN_F(0); const bf16* D1 = WSP(bf16, WS_D1);
    bf16* X1B = WSP(bf16, WS_E) + 1 * E_STRIDE;
    unsigned* CNT = (unsigned*)(F.ws + WS_CTL) + CW_CNT;
    const int row = F.lane & 15, q = F.lane >> 4, kw = F.wave * 128;
    bf16x8 Bh[4][2], Bl[4][2];
    { const bf16* wh = WSP(bf16, WS_WRH) + (size_t)row * 1024 + kw + 8 * q; const bf16* wl = WSP(bf16, WS_WRL) + (size_t)row * 1024 + kw + 8 * q;
#pragma unroll
      for (int s = 0; s < 4; ++s) { Bh[s][0] = *(const bf16x8*)(wh + 32 * s); Bh[s][1] = *(const bf16x8*)(wh + 16384 + 32 * s); Bl[s][0] = *(const bf16x8*)(wl + 32 * s); Bl[s][1] = *(const bf16x8*)(wl + 16384 + 32 * s); } }
    for (int vw = F.vcu; vw < 256; vw += F.G) {
        const int m0 = vw * 64, b = m0 >> 12;
        for (int i = F.tid; i < 1024; i += 512) { par[i] = g2n[i] * (1.0f + mod[b * 6144 + 4096 + i]); par[1024 + i] = mod[b * 6144 + 3072 + i]; }
        if (F.tid < 32) hist[F.tid] = 0;
#pragma unroll
        for (int rt = 0; rt < 4; ++rt) { const float* xp = xin + (size_t)(m0 + rt * 16 + row) * DM + kw + 8 * q; const bf16* dp = D1 + (size_t)(m0 + rt * 16 + row) * DM + kw + 8 * q; float ss = 0.f;
#pragma unroll
            for (int s = 0; s < 4; ++s) { const v4u dd = *(const v4u*)(dp + 32 * s);
                const f32x4 x0 = *(const f32x4*)(xp + 32 * s) + (f32x4){bflo(dd.x), bfhi(dd.x), bflo(dd.y), bfhi(dd.y)}, x1 = *(const f32x4*)(xp + 32 * s + 4) + (f32x4){bflo(dd.z), bfhi(dd.z), bflo(dd.w), bfhi(dd.w)};
                const f32x4 a = x0 * x0 + x1 * x1; ss += (a.x + a.y) + (a.z + a.w); }
            ss += __shfl_xor(ss, 16); ss += __shfl_xor(ss, 32);
            if (q == 0) ssq[F.wave * 64 + rt * 16 + row] = ss; }
        __syncthreads();
        f32x4 xraw[2][4][2]; v4u draw[2][4];
#define P7_LOADRT(rt_) do { const float* xp_ = xin + (size_t)(m0 + (rt_) * 16 + row) * DM + kw + 8 * q; const bf16* dp_ = D1 + (size_t)(m0 + (rt_) * 16 + row) * DM + kw + 8 * q; \
        _Pragma("unroll") for (int s_ = 0; s_ < 4; ++s_) { draw[(rt_) & 1][s_] = *(const v4u*)(dp_ + 32 * s_); xraw[(rt_) & 1][s_][0] = *(const f32x4*)(xp_ + 32 * s_); xraw[(rt_) & 1][s_][1] = *(const f32x4*)(xp_ + 32 * s_ + 4); } } while (0)
        P7_LOADRT(0);
#pragma unroll
        for (int rt = 0; rt < 4; ++rt) { const int rl = rt * 16 + row; float tot = 0.f;
            if (rt + 1 < 4) P7_LOADRT(rt + 1);
#pragma unroll
            for (int w = 0; w < 8; ++w) tot += ssq[w * 64 + rl];
            const float rstd = 1.0f / sqrtf(tot * (1.f / DM) + EPS);
            f32x4 acc0 = {0.f, 0.f, 0.f, 0.f}, acc1 = {0.f, 0.f, 0.f, 0.f};
            unsigned char* hp = H2 + (size_t)(m0 + rl) * DM + kw + 8 * q;
            bf16* xbp = X1B + (size_t)(m0 + rl) * DM + kw + 8 * q;
            f32x4 xq[4][2];
#pragma unroll
            for (int s = 0; s < 4; ++s) { const v4u dd = draw[rt & 1][s];
                xq[s][0] = xraw[rt & 1][s][0] + (f32x4){bflo(dd.x), bfhi(dd.x), bflo(dd.y), bfhi(dd.y)}; xq[s][1] = xraw[rt & 1][s][1] + (f32x4){bflo(dd.z), bfhi(dd.z), bflo(dd.w), bfhi(dd.w)}; }
#pragma unroll
            for (int s = 0; s < 4; ++s) { v4u xb; xb.x = cvtpk(xq[s][0].x, xq[s][0].y); xb.y = cvtpk(xq[s][0].z, xq[s][0].w); xb.z = cvtpk(xq[s][1].x, xq[s][1].y); xb.w = cvtpk(xq[s][1].z, xq[s][1].w); *(v4u*)(xbp + 32 * s) = xb; }
#pragma unroll
            for (int s = 0; s < 4; ++s) { const int col = kw + 32 * s + 8 * q; float h[8];
#pragma unroll
                for (int hf = 0; hf < 2; ++hf) { const f32x4 sc = *(const LAS f32x4*)(par + col + 4 * hf), sh = *(const LAS f32x4*)(par + 1024 + col + 4 * hf);
                    const f32x4 t = xq[s][hf] * rstd * sc + sh; h[4 * hf] = t.x; h[4 * hf + 1] = t.y; h[4 * hf + 2] = t.z; h[4 * hf + 3] = t.w; }
                v4u hi; hi.x = cvtpk(h[0], h[1]); hi.y = cvtpk(h[2], h[3]); hi.z = cvtpk(h[4], h[5]); hi.w = cvtpk(h[6], h[7]);
                { v2u h8; h8.x = pg8::pk_fp8x4(h[0], h[1], h[2], h[3]); h8.y = pg8::pk_fp8x4(h[4], h[5], h[6], h[7]); *(v2u*)(hp + 32 * s) = h8; }
                v4u lo; lo.x = cvtpk(h[0] - bflo(hi.x), h[1] - bfhi(hi.x)); lo.y = cvtpk(h[2] - bflo(hi.y), h[3] - bfhi(hi.y)); lo.z = cvtpk(h[4] - bflo(hi.z), h[5] - bfhi(hi.z)); lo.w = cvtpk(h[6] - bflo(hi.w), h[7] - bfhi(hi.w));
                const bf16x8 ah = *reinterpret_cast<bf16x8*>(&hi), al = *reinterpret_cast<bf16x8*>(&lo);
                acc0 = __builtin_amdgcn_mfma_f32_16x16x32_bf16(ah, Bh[s][0], acc0, 0, 0, 0); acc0 = __builtin_amdgcn_mfma_f32_16x16x32_bf16(ah, Bl[s][0], acc0, 0, 0, 0); acc0 = __builtin_amdgcn_mfma_f32_16x16x32_bf16(al, Bh[s][0], acc0, 0, 0, 0);
                acc1 = __builtin_amdgcn_mfma_f32_16x16x32_bf16(ah, Bh[s][1], acc1, 0, 0, 0); acc1 = __builtin_amdgcn_mfma_f32_16x16x32_bf16(ah, Bl[s][1], acc1, 0, 0, 0); acc1 = __builtin_amdgcn_mfma_f32_16x16x32_bf16(al, Bh[s][1], acc1, 0, 0, 0); }
#pragma unroll
            for (int r = 0; r < 4; ++r) { lg[(F.wave * 64 + rt * 16 + 4 * q + r) * 33 + row] = acc0[r]; lg[(F.wave * 64 + rt * 16 + 4 * q + r) * 33 + 16 + row] = acc1[r]; } }
#undef P7_LOADRT
        __syncthreads();
        { const int rowl = F.tid >> 3, eq = F.tid & 7; float v[4];
#pragma unroll
          for (int j = 0; j < 4; ++j) { float a = brt[4 * eq + j];
#pragma unroll
              for (int w = 0; w < 8; ++w) a += lg[(w * 64 + rowl) * 33 + 4 * eq + j];
              v[j] = a; }
          float tv[4]; int te[4];
#pragma unroll
          for (int k = 0; k < 4; ++k) { float gm = fmaxf(fmaxf(v[0], v[1]), fmaxf(v[2], v[3]));
              gm = fmaxf(gm, __shfl_xor(gm, 1)); gm = fmaxf(gm, __shfl_xor(gm, 2)); gm = fmaxf(gm, __shfl_xor(gm, 4));
              int ci = v[0] == gm ? 4 * eq : v[1] == gm ? 4 * eq + 1 : v[2] == gm ? 4 * eq + 2 : v[3] == gm ? 4 * eq + 3 : 99;
              ci = min(ci, __shfl_xor(ci, 1)); ci = min(ci, __shfl_xor(ci, 2)); ci = min(ci, __shfl_xor(ci, 4));
              te[k] = ci; tv[k] = gm;
#pragma unroll
              for (int j = 0; j < 4; ++j) if (ci == 4 * eq + j) v[j] = -__builtin_inff(); }
          if (eq == 0) { const float w1 = __expf(tv[1] - tv[0]), w2 = __expf(tv[2] - tv[0]), w3 = __expf(tv[3] - tv[0]); const float inv = 1.0f / (1.0f + w1 + w2 + w3);
              const float gk[4] = {inv, w1 * inv, w2 * inv, w3 * inv};
#pragma unroll
              for (int k = 0; k < 4; ++k) { const int lr = atomicAdd((int*)&hist[te[k]], 1); sel[rowl * 4 + k] = te[k]; sel[256 + rowl * 4 + k] = lr; sel[512 + rowl * 4 + k] = __float_as_int(gk[k]); } } }
        __syncthreads();
        if (F.tid < 32) { const int hc = hist[F.tid]; hist[32 + F.tid] = hc ? (int)__hip_atomic_fetch_add(CNT + F.tid, (unsigned)hc, RLX_AGENT) : 0; }
        __syncthreads();
        if (F.tid < 256) { const int e = sel[F.tid], pos = hist[32 + e] + sel[256 + F.tid], mm = m0 + (F.tid >> 2);
            WSP(int, WS_ROWTOK)[(size_t)e * ECAP + pos] = mm; WSP(int, WS_ROWGATE)[(size_t)e * ECAP + pos] = sel[512 + F.tid];
            WSP(int, WS_TOKE)[mm * 4 + (F.tid & 3)] = e; WSP(int, WS_TOKPOS)[mm * 4 + (F.tid & 3)] = pos; }
        __syncthreads();
    }
}

constexpr int MOE_TBL_OFF = XTRA_OFF, MOE_LIST_OFF = XTRA_OFF + 2048;
__device__ __forceinline__ int moe_tables(Frame& F, bool reuse = false) {
    LAS int* tbl = (LAS int*)(F.lds + MOE_TBL_OFF);
    if (reuse) { int nb_ = tbl[64]; if (nb_ > MAXBLK) nb_ = MAXBLK; if (nb_ < 1) nb_ = 1; return __builtin_amdgcn_readfirstlane(nb_); }
    const unsigned* CNT = (const unsigned*)(F.ws + WS_CTL) + CW_CNT;
    if (F.tid < 32) tbl[F.tid] = (int)__hip_atomic_load(CNT + F.tid, RLX_AGENT);
    __syncthreads();
    if (F.tid == 0) { int run = 0;
#pragma unroll 8
        for (int e = 0; e < 32; ++e) { tbl[32 + e] = run; run += (tbl[e] + 255) >> 8; }
        tbl[64] = run; }
    __syncthreads();
    if (F.tid < 32) { const int first = tbl[32 + F.tid], nb = (tbl[F.tid] + 255) >> 8;
        for (int bb = 0; bb < nb; ++bb) tbl[80 + first + bb] = F.tid; }
    __syncthreads();
    int nblk = tbl[64]; if (nblk > MAXBLK) nblk = MAXBLK; if (nblk < 1) nblk = 1;
    return __builtin_amdgcn_readfirstlane(nblk);
}

__device__ __forceinline__ void p11_combine(Frame& F, const Args& args, bool reuse) {
    (void)moe_tables(F, reuse);
    const LAS int* tbl = (const LAS int*)(F.lds + MOE_TBL_OFF);
    const float* mod = WSP(float, WS_MOD); const unsigned char* YR = WSP(unsigned char, WS_YR); const bf16* X1B = WSP(bf16, WS_E) + 1 * E_STRIDE;
    const int gw = F.vcu * NWAVES + F.wave, NGW = F.G * NWAVES;
    const int col = 16 * F.lane;
#define P11_LOAD(m_, Y0, Y1, Y2, Y3, DA, DB, X) do { int dk_ = 0; if (F.lane < 4) { const int e_ = __hip_atomic_load(WSP(int, WS_TOKE) + (m_) * 4 + F.lane, RLX_AGENT); dk_ = tbl[32 + e_] * 256 + __hip_atomic_load(WSP(int, WS_TOKPOS) + (m_) * 4 + F.lane, RLX_AGENT); } \
        const int d0_ = __shfl(dk_, 0), d1_ = __shfl(dk_, 1), d2_ = __shfl(dk_, 2), d3_ = __shfl(dk_, 3); \
        Y0 = *(const v4u*)(YR + (size_t)d0_ * DM + col); Y1 = *(const v4u*)(YR + (size_t)d1_ * DM + col); Y2 = *(const v4u*)(YR + (size_t)d2_ * DM + col); Y3 = *(const v4u*)(YR + (size_t)d3_ * DM + col); \
        DA = *(const v4u*)(X1B + (size_t)(m_) * DM + col); DB = *(const v4u*)(X1B + (size_t)(m_) * DM + col + 8); } while (0)
#define P11_STORE(m_, Y0, Y1, Y2, Y3, DA, DB, X) do { const int b_ = (m_) >> 12; const unsigned dw_[8] = {DA.x, DA.y, DA.z, DA.w, DB.x, DB.y, DB.z, DB.w}; \
        const unsigned w0_[4] = {Y0.x, Y0.y, Y0.z, Y0.w}, w1_[4] = {Y1.x, Y1.y, Y1.z, Y1.w}, w2_[4] = {Y2.x, Y2.y, Y2.z, Y2.w}, w3_[4] = {Y3.x, Y3.y, Y3.z, Y3.w}; \
        _Pragma("unroll") for (int q_ = 0; q_ < 4; ++q_) { \
            const f32x2 a0_ = __builtin_amdgcn_cvt_pk_f32_fp8((int)w0_[q_], false) + __builtin_amdgcn_cvt_pk_f32_fp8((int)w1_[q_], false) + __builtin_amdgcn_cvt_pk_f32_fp8((int)w2_[q_], false) + __builtin_amdgcn_cvt_pk_f32_fp8((int)w3_[q_], false); \
            const f32x2 a1_ = __builtin_amdgcn_cvt_pk_f32_fp8((int)w0_[q_], true) + __builtin_amdgcn_cvt_pk_f32_fp8((int)w1_[q_], true) + __builtin_amdgcn_cvt_pk_f32_fp8((int)w2_[q_], true) + __builtin_amdgcn_cvt_pk_f32_fp8((int)w3_[q_], true); \
            const f32x4 s_ = {a0_.x, a0_.y, a1_.x, a1_.y}; \
            const f32x4 g2_ = *(const f32x4*)(mod + b_ * 6144 + 5120 + col + 4 * q_) * 0.0625f; \
            const f32x4 dl_ = {bflo(dw_[2 * q_]), bfhi(dw_[2 * q_]), bflo(dw_[2 * q_ + 1]), bfhi(dw_[2 * q_ + 1])}; \
            *(f32x4*)(F.out + (size_t)(m_) * DM + col + 4 * q_) = dl_ + g2_ * s_; } } while (0)
    for (int base = gw; base < NTOK; base += 8 * NGW) {
        v4u y0[4], y1[4], y2[4], y3[4], da[4], db[4]; int xx[4];
#pragma unroll
        for (int j = 0; j < 4; ++j) { const int m = base + j * NGW; if (m < NTOK) P11_LOAD(m, y0[j], y1[j], y2[j], y3[j], da[j], db[j], xx[j]); }
#pragma unroll
        for (int j = 0; j < 8; ++j) { const int m = base + j * NGW, mn = m + 4 * NGW;
            if (m < NTOK) P11_STORE(m, y0[j & 3], y1[j & 3], y2[j & 3], y3[j & 3], da[j & 3], db[j & 3], xx[j & 3]);
            if (j < 4 && mn < NTOK) P11_LOAD(mn, y0[j & 3], y1[j & 3], y2[j & 3], y3[j & 3], da[j & 3], db[j & 3], xx[j & 3]); }
    }
#undef P11_LOAD
#undef P11_STORE
}

#ifndef NSTREAM
#define NSTREAM 10
#endif
#define P4_PULL(ctr, dst) do { __syncthreads(); if (F.tid == 0) bc[0] = (int)__hip_atomic_fetch_add((ctr), 1u, RLX_AGENT); __syncthreads(); dst = bc[0]; } while (0)
__device__ __forceinline__ void p4_phase(Frame& F, const Args& args) {
    unsigned* Q = (unsigned*)(F.ws + WS_CTL) + CW_QUEUE;
    LAS int* bc = (LAS int*)(F.lds + XTRA_OFF + 12288);
    const bool xcd_ok = (F.G == 256);
    const int xg = xcd_ok ? (F.vcu >> 5) : (F.vcu & 7);
    const bool streamer = xcd_ok && (F.vcu & 31) < NSTREAM;
#ifdef PROBE_B
#define P4_STAMP(k) do { if (PROBE_B >= 10) { if ((k) == 0 && F.tid == 0) { F.MISC[16] = 0u; F.MISC[17] = 0u; } } else { if ((k) == 0 && F.tid == 0) F.MISC[16] = (unsigned)__builtin_amdgcn_s_memrealtime(); if ((k) == PROBE_B && F.tid == 0) F.MISC[17] = (unsigned)__builtin_amdgcn_s_memrealtime(); } } while (0)
#else
#define P4_STAMP(k) do { } while (0)
#endif
    P4_STAMP(0);
    if (streamer) { for (;;) { int ch; P4_PULL(Q + 64 * 9, ch); if (ch >= P8_NCHUNK) break; p8_chunk(F, args, ch); } }
    P4_STAMP(1);
#pragma unroll 1
    for (int dx = 0; dx < 8; ++dx) { const int x = (xg + dx) & 7;
        int a; P4_PULL(Q + 64 * x, a);
        while (a < 64) {
            unsigned an = 0u; if (F.tid == 0) an = __hip_atomic_fetch_add(Q + 64 * x, 1u, RLX_AGENT);
            const int bh = 4 * x + (a & 3); att::attn_unit(F, args, bh >> 3, bh & 7, 15 - (a >> 2));
            if (F.tid == 0) bc[0] = (int)an; __syncthreads(); a = bc[0]; __syncthreads(); } }
    P4_STAMP(2);
    for (;;) { int u; P4_PULL(Q + 64 * 8, u); if (u >= 512) break; p4_rnn_final_unit(F, args, u); }
    P4_STAMP(3);
    if (!streamer) { for (;;) { int ch; P4_PULL(Q + 64 * 9, ch); if (ch >= P8_NCHUNK) break; p8_chunk(F, args, ch); } }
}
#undef P4_PULL
#undef P4_STAMP

#ifndef MK_N_LAUNCHES
#define MK_N_LAUNCHES 1
#endif
constexpr int PER_PHASE = 12;
constexpr int N_LAUNCHES = MK_N_LAUNCHES;

__global__ void __launch_bounds__(NWAVES * 64, 2) hybrid_fwd(Args args) {
    extern __shared__ __attribute__((aligned(16))) unsigned char lds[];
    Frame F;
    F.lds = (LAS unsigned char*)lds; F.ldsg = (char*)lds;
    F.MISC = (volatile LAS unsigned*)(F.lds + MISC_OFF);
    F.tid = threadIdx.x; F.lane = F.tid & 63; F.wave = __builtin_amdgcn_readfirstlane(F.tid >> 6);
    F.G = gridDim.x; { const int bx = blockIdx.x; F.vcu = (F.G % 8 == 0) ? (bx % 8) * (F.G / 8) + bx / 8 : bx; }
    F.ws = args.ws; F.out = args.out;
    gu32* ctl = (gu32*)(args.ws + WS_CTL);
    for (int u = F.tid; u < (LDS_BYTES - LDSCTL_OFF) / 4; u += NWAVES * 64) ((LAS unsigned*)(F.lds + LDSCTL_OFF))[u] = 0u;
    __syncthreads();
    XcdBarrier bar; bar.bar = (unsigned*)(ctl + CW_BAR); bar.x = 0; bar.st = nullptr;
    if (N_LAUNCHES == 1) bar = xcd_barrier_post((unsigned*)(ctl + CW_BAR), F.MISC + 8);
    const int lo = args.ph_lo, hi = args.ph_hi;
#ifndef PHASE_MASK
#define PHASE_MASK 0xFFF
#endif
#define IN(k) (((PHASE_MASK >> (k)) & 1) && lo <= (k) && (k) < hi)
#define NEXTP(k) ((k) == 0 ? 2 : (k) == 7 ? 9 : (k) + 1)
#define SEAM(k) do { if (IN(k) && IN(NEXTP(k))) xcd_barrier(bar); } while (0)

#ifndef DUP_MASK
#define DUP_MASK 0
#endif
#ifdef PROBE_A
#ifndef PROBE_S
#define PROBE_S PROBE_A
#endif
#define PHASE(k, ...) do { if ((k) == PROBE_S && F.tid == 0) F.MISC[16] = (unsigned)__builtin_amdgcn_s_memrealtime(); \
    if (IN(k)) { __VA_ARGS__ } SEAM(k); if ((k) == PROBE_A && F.tid == 0) F.MISC[17] = (unsigned)__builtin_amdgcn_s_memrealtime(); } while (0)
#else
#define PHASE(k, ...) do { if (IN(k)) { __VA_ARGS__ if ((DUP_MASK >> (k)) & 1) { xcd_barrier(bar); __VA_ARGS__ } } SEAM(k); } while (0)
#endif
    PHASE(0, { p0_prologue(F, args); p1_hrows(F, args); });
    PHASE(2, {
        { pg8::Gemm g{WSP(bf16, WS_HB), WSP(bf16, WS_WIN), NTOK, 3072, DM}; pg8::TileOrder S; S.init(NTOK / 256, 12, F.G, (int)blockIdx.x, nullptr);
          pg8::EpiWin E{WSP(bf16, WS_E), IN_F(17), 0};
          pg8::gemm_phase<pg8::EpiWin, pg8::TileOrder, true, true>(F.lds + RING_OFF, g, S, E); }
        { pg8::Gemm g{WSP(bf16, WS_H8), WSP(bf16, WS_WIN8), NTOK, 4096, DM / 2}; pg8::TileOrder S; S.init(NTOK / 256, 16, F.G, (int)blockIdx.x, nullptr);
          pg8::EpiWin E{WSP(bf16, WS_E), IN_F(17), 1};
          pg8::gemm_phase<pg8::EpiWin, pg8::TileOrder, true, true, false, true>(F.lds + RING_OFF, g, S, E); }
    });
    int p3rep = 0;
    PHASE(3, {
        for (int u = F.vcu; u < 512; u += F.G) p3_rnn_local_unit(F, args, u);
        if (p3rep++ == 0) { for (int u = F.vcu; u < 512; u += F.G) p3_knorm_unit(F, args, u); }
    });
    PHASE(4, { p4_phase(F, args); });
    PHASE(5, {
        pg8::Gemm g{WSP(bf16, WS_YCAT), WSP(bf16, WS_WB), NTOK, DM, 2 * DM}; pg8::TileOrder S; S.init(NTOK / 256, DM / 256, F.G, (int)blockIdx.x, nullptr);
        pg8::EpiBranch E{WSP(bf16, WS_E) + 5 * E_STRIDE, WSP(bf16, WS_E) + 6 * E_STRIDE, WSP(bf16, WS_HB)};
        pg8::gemm_phase<pg8::EpiBranch, pg8::TileOrder, false, true>(F.lds + RING_OFF, g, S, E);
    });
    PHASE(6, {
        pg8::Gemm g{WSP(bf16, WS_HB), WSP(bf16, WS_WO), NTOK, DM, DM}; pg8::TileOrder S; S.init(NTOK / 256, DM / 256, F.G, (int)blockIdx.x, nullptr);
        pg8::EpiWout E{WSP(bf16, WS_D1), WSP(float, WS_MOD)};
        pg8::gemm_phase<pg8::EpiWout, pg8::TileOrder, false, true>(F.lds + RING_OFF, g, S, E);
    });
    PHASE(7, { p7_router(F, args); });
    PHASE(9, {
        const int nblk = moe_tables(F);
        const LAS int* tbl = (const LAS int*)(F.lds + MOE_TBL_OFF); LAS int* lists = (LAS int*)(F.lds + MOE_LIST_OFF);
        pg8::Gemm g{WSP(bf16, WS_HB), WSP(bf16, WS_WUP), RMAX, 2048 * NEXP, DM / 2}; pg8::TileOrder S; S.init(nblk, 8, F.G, (int)blockIdx.x, tbl + 80, F.ws + WS_HB);
        if (F.tid < 256) { int rtok[9]; bool has[9];
_Pragma("unroll")
            for (int i = 0; i < 9; ++i) { pg8::Unit u; has[i] = S.next(i, u); rtok[i] = 0;
                if (has[i]) { const int e = u.pn >> 3, pos = (u.pm - tbl[32 + e]) * 256 + F.tid; if (pos < tbl[e]) rtok[i] = WSP(int, WS_ROWTOK)[(size_t)e * ECAP + pos]; } }
_Pragma("unroll")
            for (int i = 0; i < 9; ++i) if (has[i]) lists[i * 256 + F.tid] = rtok[i]; }
        __syncthreads();
        pg8::EpiUp E{WSP(unsigned char, WS_ACT), IN_F(23)};
        pg8::gemm_phase<pg8::EpiUp, pg8::TileOrder, true, true, true, true>(F.lds + RING_OFF, g, S, E, lists);
    });
    PHASE(10, {
        const int nblk = moe_tables(F, N_LAUNCHES == 1 && ((PHASE_MASK >> 9) & 1));
        const LAS int* tbl = (const LAS int*)(F.lds + MOE_TBL_OFF);
        pg8::Gemm g{WSP(bf16, WS_ACT), WSP(bf16, WS_WDN), RMAX, 1024 * NEXP, DM / 2}; pg8::TileOrder S; S.init(nblk, 4, F.G, (int)blockIdx.x, tbl + 80);
        pg8::EpiDown E{WSP(unsigned char, WS_YR), IN_F(25), WSP(float, WS_ROWGATE), tbl, F.lds + XTRA_OFF + 12288};
        pg8::gemm_phase<pg8::EpiDown, pg8::TileOrder, true, true, false, true>(F.lds + RING_OFF, g, S, E);
    });
    PHASE(11, { p11_combine(F, args, N_LAUNCHES == 1 && ((PHASE_MASK >> 9) & 1)); });
#undef PHASE
#ifdef PROBE_A
    if (F.tid == 0) __hip_atomic_store((unsigned*)(ctl + 20480 + F.vcu), (unsigned)(F.MISC[17] - F.MISC[16]), __ATOMIC_RELAXED, __HIP_MEMORY_SCOPE_AGENT);
    xcd_barrier(bar);
    { unsigned mx = 0, sm = 0;
      for (int w = 0; w < F.G; ++w) { const unsigned v = __hip_atomic_load((unsigned*)(ctl + 20480 + w), __ATOMIC_RELAXED, __HIP_MEMORY_SCOPE_AGENT); mx = v > mx ? v : mx; sm += v; }
#ifndef PROBE_STAT
#define PROBE_STAT 0
#endif
      const float eps = (PROBE_STAT == 0 ? (float)mx : (float)sm / (float)F.G) * 0.01f * PROBE_SCALE;
      const int gw = F.vcu * NWAVES + F.wave, NGW = F.G * NWAVES;
      for (int m = gw; m < NTOK; m += NGW) { f32x4* xr = (f32x4*)(F.out + (size_t)m * DM) + F.lane;
#pragma unroll
          for (int j = 0; j < 4; ++j) xr[64 * j] = xr[64 * j] + eps; } }
#endif
#undef IN
#undef SEAM
}

extern "C" void kernel_launch(void* const* d_in, const int* in_sizes, int n_in, void* d_out, int out_size, void* d_ws, size_t ws_size, hipStream_t stream) {
    static int grid = 0;
    if (grid == 0) {
        if (n_in != 26 || in_sizes[0] != NTOK * DM || out_size != NTOK * DM || ws_size < WS_END) {
            fprintf(stderr, "kernel_launch: shape/workspace mismatch (n_in %d, in0 %d, out %d, ws %zu; need ws >= %zu); nothing launched\n", n_in, n_in > 0 ? in_sizes[0] : -1, out_size, ws_size, (size_t)WS_END); grid = -1; return; }
        int dev = 0, cus = 0, per_cu = 0;
        if (hipGetDevice(&dev) != hipSuccess || hipDeviceGetAttribute(&cus, hipDeviceAttributeMultiprocessorCount, dev) != hipSuccess) { fprintf(stderr, "kernel_launch: device query failed\n"); grid = -1; return; }
        if (hipFuncSetAttribute((const void*)hybrid_fwd, hipFuncAttributeMaxDynamicSharedMemorySize, LDS_BYTES) != hipSuccess) { fprintf(stderr, "kernel_launch: hipFuncSetAttribute failed\n"); grid = -1; return; }
        if (hipOccupancyMaxActiveBlocksPerMultiprocessor(&per_cu, (const void*)hybrid_fwd, NWAVES * 64, LDS_BYTES) != hipSuccess || per_cu < 1) { fprintf(stderr, "kernel_launch: occupancy query says %d blocks/CU\n", per_cu); per_cu = 1; }
        (void)hipGetLastError();
        grid = cus;
        if (grid > 256) grid = 256;
    }
    if (grid < 0) return;
    (void)hipMemsetAsync((char*)d_ws + WS_CTL, 0, CTL_ZERO_BYTES, stream);
    Args a{};
    for (int i = 0; i < 26; ++i) a.in[i] = d_in[i];
    a.out = (float*)d_out; a.ws = (unsigned char*)d_ws;
    for (int li = 0; li < N_LAUNCHES; ++li) {
        a.ph_lo = (N_LAUNCHES == 1) ? 0 : li; a.ph_hi = (N_LAUNCHES == 1) ? PER_PHASE : li + 1;
        hipLaunchKernelGGL(hybrid_fwd, dim3(grid), dim3(NWAVES * 64), LDS_BYTES, stream, a);
        const hipError_t le = hipPeekAtLastError();
        if (le != hipSuccess) { fprintf(stderr, "kernel_launch: launch %d failed: %s\n", li, hipGetErrorName(le)); break; }
    }
}
```
